# Optimizing an MI355X kernel written in HIP

```python
import math
import jax, jax.numpy as jnp
from jax import lax
import numpy as np

D_MODEL = 2048
BATCH = 4
SEQ = 8192
DEPTH = 2
DEC_BATCH = 8
DEC_SEQ = 4096
PAST_LEN = 128

MIX_WIDTH = D_MODEL
POOL_WIDTH = MIX_WIDTH // 2
POOL_WINDOWS = (2, 4, 8, 16)
POOL_GROUPS = len(POOL_WINDOWS)
POOL_GROUP_WIDTH = POOL_WIDTH // POOL_GROUPS
ATTN_WIDTH = MIX_WIDTH - POOL_WIDTH
N_DIFF_HEADS = 8
DIFF_VDIM = ATTN_WIDTH // N_DIFF_HEADS
DIFF_QKDIM = DIFF_VDIM // 2
QK_WIDTH = N_DIFF_HEADS * 2 * DIFF_QKDIM
IN_WIDTH = 2 * QK_WIDTH + ATTN_WIDTH + POOL_WIDTH
N_MEM = 256
N_CROSS_HEADS = 4
CROSS_HDIM = D_MODEL // N_CROSS_HEADS
D_FF = 5632
CONV_WIDTH = 3
ROPE_THETA = 10000.0
EPS = 1e-6
Q_BLOCK = 128

kernel_name = 'hybrid_diffattn_pool_memory_encoder'


def rms_norm(x, g):
    xf = x.astype(jnp.float32)
    y = xf * lax.rsqrt(jnp.mean(xf * xf, axis=-1, keepdims=True) + EPS)
    return (y * g.astype(jnp.float32)).astype(x.dtype)


def rope(x):
    S, dh = x.shape[1], x.shape[-1]
    half = dh // 2
    inv = ROPE_THETA ** (-jnp.arange(half, dtype=jnp.float32) / half)
    ang = jnp.arange(S, dtype=jnp.float32)[:, None] * inv[None, :]
    shp = (S,) + (1,) * (x.ndim - 3) + (half,)
    cos = jnp.cos(ang).reshape(shp)
    sin = jnp.sin(ang).reshape(shp)
    xf = x.astype(jnp.float32)
    x1, x2 = xf[..., :half], xf[..., half:]
    out = jnp.concatenate([x1 * cos - x2 * sin, x2 * cos + x1 * sin], axis=-1)
    return out.astype(x.dtype)


def multiscale_pool(u, w_pool, pool_scale):
    B, S, _ = u.shape
    ug = u.reshape(B, S, POOL_GROUPS, POOL_GROUP_WIDTH)
    uf = ug.astype(jnp.float32)
    c = jnp.pad(jnp.cumsum(uf, axis=1), ((0, 0), (1, 0), (0, 0), (0, 0)))
    t = jnp.arange(S)
    outs = []
    for g, w in enumerate(POOL_WINDOWS):
        lo = jnp.clip(t - w // 2, 0, S)
        hi = jnp.clip(t + w // 2, 0, S)
        cg = c[:, :, g]
        win_sum = jnp.take(cg, hi, axis=1) - jnp.take(cg, lo, axis=1)
        mean = win_sum / (hi - lo).astype(jnp.float32)[None, :, None]
        outs.append(mean - uf[:, :, g])
    z = jnp.stack(outs, axis=2).astype(u.dtype)
    y = jnp.einsum('bsgc,gcd->bsgd', z, w_pool).reshape(B, S, POOL_WIDTH)
    return y * pool_scale


def diff_attention(q, k, v, lam, lam_init, g_sub):
    B, S = q.shape[0], q.shape[1]
    nb = S // Q_BLOCK
    scale = DIFF_QKDIM ** -0.5
    qb = q.reshape(B, nb, Q_BLOCK, N_DIFF_HEADS, 2, DIFF_QKDIM).transpose(1, 0, 2, 3, 4, 5)

    def block(qblk):
        s = jnp.einsum('bqhcd,bkhcd->bhcqk', qblk, k).astype(jnp.float32) * scale
        p = jax.nn.softmax(s, axis=-1)
        a = p[:, :, 0] - lam * p[:, :, 1]
        return jnp.einsum('bhqk,bkhd->bqhd', a.astype(v.dtype), v)

    o = lax.map(block, qb)
    o = o.transpose(1, 0, 2, 3, 4).reshape(B, S, N_DIFF_HEADS, DIFF_VDIM)
    o = rms_norm(o, g_sub) * (1.0 - lam_init)
    return o.reshape(B, S, ATTN_WIDTH)


def memory_cross_attention(h, mem, g_mem, wc_q, wc_kv, gc_q, gc_k, wc_o):
    B, S, _ = h.shape
    m = rms_norm(mem, g_mem)
    q = (h @ wc_q).reshape(B, S, N_CROSS_HEADS, CROSS_HDIM)
    kv = (m @ wc_kv).reshape(B, N_MEM, 2, N_CROSS_HEADS, CROSS_HDIM)
    q = rms_norm(q, gc_q)
    k = rms_norm(kv[:, :, 0], gc_k)
    v = kv[:, :, 1]
    s = jnp.einsum('bqhd,bkhd->bhqk', q, k).astype(jnp.float32) * (CROSS_HDIM ** -0.5)
    p = jax.nn.softmax(s, axis=-1)
    o = jnp.einsum('bhqk,bkhd->bqhd', p.astype(v.dtype), v).reshape(B, S, D_MODEL)
    return o @ wc_o


def conv_glu_ffn(h, w_up, conv_w, conv_b, w_down):
    u = h @ w_up
    up = jnp.pad(u, ((0, 0), (1, 1), (0, 0)))
    u = up[:, :-2] * conv_w[0] + up[:, 1:-1] * conv_w[1] + up[:, 2:] * conv_w[2] + conv_b
    gate, val = u[..., :D_FF], u[..., D_FF:]
    return (jax.nn.gelu(gate) * val) @ w_down


def run_trunk(x, mem, g_mix, w_in, g_q, g_k, lam_q1, lam_k1, lam_q2, lam_k2, g_sub, w_pool, pool_scale, w_out,
              g_cross, g_mem, wc_q, wc_kv, gc_q, gc_k, wc_o, g_ffn, w_up, conv_w, conv_b, w_down):
    B, S, _ = x.shape
    for l in range(DEPTH):
        lam_init = 0.8 - 0.6 * math.exp(-0.3 * l)
        lam = (jnp.exp(jnp.sum(lam_q1[l].astype(jnp.float32) * lam_k1[l].astype(jnp.float32)))
               - jnp.exp(jnp.sum(lam_q2[l].astype(jnp.float32) * lam_k2[l].astype(jnp.float32))) + lam_init)
        h = rms_norm(x, g_mix[l])
        z = h @ w_in[l]
        q = z[..., :QK_WIDTH].reshape(B, S, N_DIFF_HEADS, 2, DIFF_QKDIM)
        k = z[..., QK_WIDTH:2 * QK_WIDTH].reshape(B, S, N_DIFF_HEADS, 2, DIFF_QKDIM)
        v = z[..., 2 * QK_WIDTH:2 * QK_WIDTH + ATTN_WIDTH].reshape(B, S, N_DIFF_HEADS, DIFF_VDIM)
        u = z[..., 2 * QK_WIDTH + ATTN_WIDTH:]
        q = rope(rms_norm(q, g_q[l]))
        k = rope(rms_norm(k, g_k[l]))
        a_out = diff_attention(q, k, v, lam, lam_init, g_sub[l])
        p_out = multiscale_pool(u, w_pool[l], pool_scale[l])
        x = x + jnp.concatenate([a_out, p_out], axis=-1) @ w_out[l]
        x = x + memory_cross_attention(rms_norm(x, g_cross[l]), mem, g_mem[l], wc_q[l], wc_kv[l], gc_q[l], gc_k[l], wc_o[l])
        x = x + conv_glu_ffn(rms_norm(x, g_ffn[l]), w_up[l], conv_w[l], conv_b[l], w_down[l])
    return x


def setup_inputs(seed: int = 0) -> dict:
    key = jax.random.key(seed)
    ks = jax.random.split(key, 32)
    f32 = jnp.float32

    def nrm(k, shape, scale):
        return jax.random.normal(k, shape, f32) * scale

    def gain(k, shape):
        return 1.0 + 0.05 * jax.random.normal(k, shape, f32)

    L, D = DEPTH, D_MODEL
    return {
        'x_prompt': nrm(ks[0], (BATCH, SEQ, D), 1.0),
        'x_sample': nrm(ks[1], (DEC_BATCH, DEC_SEQ, D), 1.0),
        'mem_prompt': nrm(ks[2], (BATCH, N_MEM, D), 1.0),
        'mem_sample': nrm(ks[3], (DEC_BATCH, N_MEM, D), 1.0),
        'g_mix': gain(ks[4], (L, D)),
        'w_in': nrm(ks[5], (L, D, IN_WIDTH), D ** -0.5),
        'g_q': gain(ks[6], (L, DIFF_QKDIM)),
        'g_k': gain(ks[7], (L, DIFF_QKDIM)),
        'lam_q1': nrm(ks[8], (L, DIFF_QKDIM), 0.1),
        'lam_k1': nrm(ks[9], (L, DIFF_QKDIM), 0.1),
        'lam_q2': nrm(ks[10], (L, DIFF_QKDIM), 0.1),
        'lam_k2': nrm(ks[11], (L, DIFF_QKDIM), 0.1),
        'g_sub': gain(ks[12], (L, DIFF_VDIM)),
        'w_pool': nrm(ks[13], (L, POOL_GROUPS, POOL_GROUP_WIDTH, POOL_GROUP_WIDTH), POOL_GROUP_WIDTH ** -0.5),
        'pool_scale': gain(ks[14], (L, POOL_WIDTH)),
        'w_out': nrm(ks[15], (L, MIX_WIDTH, D), MIX_WIDTH ** -0.5),
        'g_cross': gain(ks[16], (L, D)),
        'g_mem': gain(ks[17], (L, D)),
        'wc_q': nrm(ks[18], (L, D, D), D ** -0.5),
        'wc_kv': nrm(ks[19], (L, D, 2 * D), D ** -0.5),
        'gc_q': gain(ks[20], (L, CROSS_HDIM)),
        'gc_k': gain(ks[21], (L, CROSS_HDIM)),
        'wc_o': nrm(ks[22], (L, D, D), D ** -0.5),
        'g_ffn': gain(ks[23], (L, D)),
        'w_up': nrm(ks[24], (L, D, 2 * D_FF), D ** -0.5),
        'conv_w': nrm(ks[25], (L, CONV_WIDTH, 2 * D_FF), CONV_WIDTH ** -0.5),
        'conv_b': nrm(ks[26], (L, 2 * D_FF), 0.02),
        'w_down': nrm(ks[27], (L, D_FF, D), D_FF ** -0.5),
    }


def reference(x_prompt, x_sample, mem_prompt, mem_sample, g_mix, w_in, g_q, g_k, lam_q1, lam_k1, lam_q2, lam_k2,
              g_sub, w_pool, pool_scale, w_out, g_cross, g_mem, wc_q, wc_kv, gc_q, gc_k, wc_o, g_ffn, w_up,
              conv_w, conv_b, w_down):
    y_prompt = run_trunk(x_prompt, mem_prompt, g_mix, w_in, g_q, g_k, lam_q1, lam_k1, lam_q2, lam_k2, g_sub,
                         w_pool, pool_scale, w_out, g_cross, g_mem, wc_q, wc_kv, gc_q, gc_k, wc_o, g_ffn, w_up,
                         conv_w, conv_b, w_down)
    y_sample = run_trunk(x_sample, mem_sample, g_mix, w_in, g_q, g_k, lam_q1, lam_k1, lam_q2, lam_k2, g_sub,
                         w_pool, pool_scale, w_out, g_cross, g_mem, wc_q, wc_kv, gc_q, gc_k, wc_o, g_ffn, w_up,
                         conv_w, conv_b, w_down)
    return (y_prompt, y_sample)
```

```cpp
#include <hip/hip_runtime.h>
#include <cstdio>
#include <cstdint>

#define SELFCHECK_LAYER 0
#ifndef ML_PER_PHASE
#define ML_PER_PHASE 0
#endif

#ifndef PHASE_MASK
#define PHASE_MASK 0xFFFFFFFFu
#endif
#define PH_EN(p) (((PHASE_MASK) >> (p)) & 1u)
#define LAS __attribute__((address_space(3)))
#define GAS __attribute__((address_space(1)))
typedef unsigned short bf16_t;
typedef short bf16x8 __attribute__((ext_vector_type(8)));
typedef short s16x4 __attribute__((ext_vector_type(4)));
typedef float f32x4 __attribute__((ext_vector_type(4)));
typedef float f32x2 __attribute__((ext_vector_type(2)));
typedef __bf16 bf16x2_t __attribute__((ext_vector_type(2)));
typedef float f32x16 __attribute__((ext_vector_type(16)));
typedef unsigned u32x4 __attribute__((ext_vector_type(4)));
typedef unsigned u32x2 __attribute__((ext_vector_type(2)));

constexpr int D_MODEL = 2048, DEPTH = 2;
constexpr int NTOK = 65536;
constexpr int NTOK_P = 32768;
constexpr int S_P = 8192, S_S = 4096;
constexpr int NMEMROWS = 3072;
constexpr int IN_W = 4096, D_FF = 5632, UP_W = 11264;
constexpr float EPS = 1e-6f;
constexpr float QSCALE = 0.125f * 1.4426950408889634f;
constexpr int FFN_CHUNK = 32768, N_FFN_CHUNKS = 2;
constexpr int FFN_MT = FFN_CHUNK / 256, FFN_BT = 2;
constexpr int PH_PER_LAYER = 8 + 2 * N_FFN_CHUNKS;
constexpr int N_PHASES = DEPTH * PH_PER_LAYER;

constexpr size_t MiB = 1u << 20;
constexpr size_t WS_CTL = 0, CTL_ZERO_BYTES = 5 * MiB;
constexpr size_t WS_ROWSS = 1 * MiB;
constexpr size_t WS_COS = 5 * MiB;
constexpr size_t WS_QSS = 6 * MiB;
constexpr size_t WS_LPART = 14 * MiB;
constexpr size_t WS_MB = 18 * MiB;
constexpr size_t WS_KRAW = 30 * MiB;
constexpr size_t WS_KC = 54 * MiB;
constexpr size_t WS_VT = 66 * MiB;
constexpr size_t WS_CHK = 78 * MiB;
constexpr size_t WS_WIN = 79 * MiB, WS_WP = 95 * MiB, WS_WOUT = 96 * MiB, WS_WCQ = 104 * MiB, WS_WCKV = 112 * MiB, WS_WCO = 128 * MiB, WS_WUP = 136 * MiB, WS_WDOWN = 180 * MiB;
constexpr size_t WS_HB = 203 * MiB;
constexpr size_t WS_R = 459 * MiB;
constexpr size_t WS_CWT = 987 * MiB;
constexpr size_t WS_END = 988 * MiB;
typedef unsigned long long rss_t;
__device__ __forceinline__ rss_t ss_fix(float s) { return (rss_t)(s * 1048576.0f + 0.5f); }
__device__ __forceinline__ float ss_rstd(rss_t v) { return __builtin_amdgcn_rsqf((float)v * (1.0f / (1048576.0f * 2048.0f)) + 1e-6f); }
constexpr size_t R_Q = WS_R, R_K = WS_R + 128 * MiB, R_V = WS_R + 256 * MiB, R_U = WS_R + 384 * MiB;
constexpr size_t R_QC = WS_R, R_P = WS_R + 256 * MiB, R_VW = WS_R + 384 * MiB;
constexpr size_t R_G = WS_R;
constexpr size_t R_POUT = WS_R + 128 * MiB;
static_assert(R_G + (size_t)FFN_CHUNK * D_FF * 2 <= WS_END, "ws map");
constexpr int CW_BAR = 4096;

constexpr int RING_BYTES = 131072;
constexpr int LDSCTL_OFF = RING_BYTES, MISC_OFF = LDSCTL_OFF + 320, XCH_OFF = LDSCTL_OFF + 1024, GLX_OFF = XCH_OFF + 4096;
constexpr int LDS_BYTES = 151552;
constexpr int NWAVES = 8;

__device__ __forceinline__ unsigned cvt_pk_bf16(float lo, float hi) { unsigned r; asm volatile("v_cvt_pk_bf16_f32 %0, %1, %2" : "=v"(r) : "v"(lo), "v"(hi)); return r; }
__device__ __forceinline__ float bf2f(unsigned short b) { return __uint_as_float(((unsigned)b) << 16); }
__device__ __forceinline__ float bflo(unsigned w) { return __uint_as_float(w << 16); }
__device__ __forceinline__ float bfhi(unsigned w) { return __uint_as_float(w & 0xffff0000u); }
__device__ __forceinline__ int tok_pos(int row) { return row < NTOK_P ? (row & (S_P - 1)) : (row & (S_S - 1)); }
__device__ __forceinline__ int tok_seqlen(int row) { return row < NTOK_P ? S_P : S_S; }
__device__ __forceinline__ int tile_batch(int pm) { return pm < 128 ? (pm >> 5) : 4 + ((pm - 128) >> 4); }

namespace pg8 {
constexpr int BM = 256, BK = 64, HALF = 128, HTB = HALF * BK * 2, STAGE_BYTES = 8 * HTB, NXCD = 8, WGM = 4;
__host__ __device__ __forceinline__ int lds_byte(int r, int c) { const int st = (r >> 4) * 2 + (c >> 5), rr = r & 15, cc = c & 31, ob = rr * 64 + cc * 2; return st * 1024 + (ob ^ (((ob >> 9) & 1) << 5)); }
__host__ __device__ __forceinline__ void stage_rc(int b, int& R, int& C) { const int st = b / 1024, sb = b % 1024, swz = sb ^ (((sb >> 9) & 1) << 5); R = (st >> 1) * 16 + swz / 64; C = (st & 1) * 32 + (swz % 64) / 2; }
__host__ __device__ __forceinline__ int perm32(int rho) { const int n = rho >> 4, i = rho & 15; return 8 * (i >> 2) + 4 * n + (i & 3); }
struct Unit { int pm, pn; };
struct StaticOrder {
    int nM, nN, nwg, G, c;
    __host__ __device__ void init(int nM_, int nN_, int G_, int c_) { nM = nM_; nN = nN_; nwg = nM * nN; G = G_; c = c_; }
    __host__ __device__ bool next(int i, Unit& u) const {
        const long L = (long)i * G + c; if (L >= nwg) return false;
        int wgid = (int)L; { const int q = nwg / NXCD, r = nwg % NXCD, xcd = wgid % NXCD, off = wgid / NXCD; wgid = (xcd < r ? xcd * (q + 1) : r * (q + 1) + (xcd - r) * q) + off; }
        const int nig = WGM * nN, gid = wgid / nig, fm = gid * WGM, gsz = (nM - fm) < WGM ? (nM - fm) : WGM;
        u.pm = fm + ((wgid % nig) % gsz); u.pn = (wgid % nig) / gsz; return true;
    }
};
struct ProbBase { static constexpr bool GATHER = false; int K, lda, ldb, tsplit; long long adelta; __device__ __forceinline__ unsigned rowoff(const Unit&, int) const { return 0u; } };

template <class Prob, class Epi, bool ALIGN_EPI, bool SP2>
__device__ __forceinline__ void gemm_phase(LAS unsigned char* lds, const Prob& P, const StaticOrder& S, const Epi& E) {
    static_assert(SP2, "only the two-super-phase loop is kept in this file");
    int tid_l = threadIdx.x; asm volatile("" : "+v"(tid_l));
    const int tid = tid_l, wid = __builtin_amdgcn_readfirstlane(tid >> 6), lane = tid & 63, wr = wid >> 2, wc = wid & 3, fr = lane & 15, fq = lane >> 4;
    const int K = P.K, nt = K / BK, lda = P.lda, ldb = P.ldb, tsplit = P.tsplit; const long long adelta = P.adelta;
    unsigned voffA[2], voffB[2];
#pragma unroll
    for (int i = 0; i < 2; ++i) { int R, C; stage_rc(tid * 16 + i * 8192, R, C); const int Rb = Epi::PERM ? ((R & ~31) + perm32(R & 31)) : R;
        voffA[i] = (unsigned)(R * lda + C) * 2u; voffB[i] = (unsigned)(Rb * ldb + C) * 2u; }
    const size_t kstep = (size_t)(BK * 2);
    const size_t hstepA = (size_t)HALF * lda * 2, hstepB = (size_t)HALF * ldb * 2;
    const unsigned ldsw = (unsigned)wid * 1024u;
    const int aoff = lds_byte(wr * 64 + fr, fq * 8), boff = lds_byte(wc * 32 + fr, fq * 8);
    unsigned vAc[2][2], vAn[2][2];
#define PG8_SA(b, h) (((b) * 2 + (h)) * HTB)
#define PG8_SB(b, h) ((4 + (b) * 2 + (h)) * HTB)
#define PG8_STAGE(bufoff, gbase, voff) do { _Pragma("unroll") for (int _i = 0; _i < 2; ++_i) \
        __builtin_amdgcn_global_load_lds((const unsigned*)((const char*)(gbase) + (voff)[_i]), (LAS unsigned*)(lds + (bufoff) + ldsw + _i * 8192), 16, 0, 0); } while (0)
#define PG8_STAGE_A(bufoff, kptr, h, NXT) do { if constexpr (Prob::GATHER) { _Pragma("unroll") for (int _i = 0; _i < 2; ++_i) \
        __builtin_amdgcn_global_load_lds((const unsigned*)((const char*)(kptr) + ((NXT) ? vAn[h][_i] : vAc[h][_i])), (LAS unsigned*)(lds + (bufoff) + ldsw + _i * 8192), 16, 0, 0); } \
        else { PG8_STAGE(bufoff, (kptr) + (h) * hstepA, voffA); } } while (0)
#define PG8_GATHER_OFFS(dst, unit) do { _Pragma("unroll") for (int _i = 0; _i < 2; ++_i) { int _R, _C; stage_rc(tid * 16 + _i * 8192, _R, _C); _Pragma("unroll") for (int _h = 0; _h < 2; ++_h) dst[_h][_i] = P.rowoff(unit, _R + 128 * _h) + (unsigned)_C * 2u; } } while (0)
#define PG8_LDA(dst, b, h) do { _Pragma("unroll") for (int m = 0; m < 4; ++m) _Pragma("unroll") for (int k = 0; k < 2; ++k) dst[m][k] = *(const LAS bf16x8*)(lds + PG8_SA(b, h) + aoff + m * 2048 + k * 1024); } while (0)
#define PG8_LDB(dst, b, h) do { _Pragma("unroll") for (int n = 0; n < 2; ++n) _Pragma("unroll") for (int k = 0; k < 2; ++k) dst[n][k] = *(const LAS bf16x8*)(lds + PG8_SB(b, h) + boff + n * 2048 + k * 1024); } while (0)
#define PG8_MMA(ai, bj, At, Bt) do { __builtin_amdgcn_s_setprio(1); _Pragma("unroll") for (int m = 0; m < 4; ++m) _Pragma("unroll") for (int n = 0; n < 2; ++n) _Pragma("unroll") for (int k = 0; k < 2; ++k) \
        acc[ai][bj][m][n] = __builtin_amdgcn_mfma_f32_16x16x32_bf16(Bt[n][k], At[m][k], acc[ai][bj][m][n], 0, 0, 0); __builtin_amdgcn_s_setprio(0); } while (0)
#define PG8_WAIT_V(n) asm volatile("s_waitcnt vmcnt(" #n ")" ::: "memory")
#define PG8_WAIT_L(n) asm volatile("s_waitcnt lgkmcnt(" #n ")" ::: "memory")
#define PG8_BAR __builtin_amdgcn_s_barrier()
#define PG8_SCHED __builtin_amdgcn_sched_barrier(0)
#define PG8_AK(base, t) ((base) + (size_t)(t) * kstep + (((t) >= tsplit) ? adelta : 0ll))
    Unit cur, nxt; int ui = 0;
    if (!S.next(0, cur)) return;
    f32x4 acc[2][2][4][2];
#pragma unroll
    for (int a = 0; a < 2; ++a)
#pragma unroll
        for (int b = 0; b < 2; ++b)
#pragma unroll
            for (int m = 0; m < 4; ++m)
#pragma unroll
                for (int n = 0; n < 2; ++n) acc[a][b][m][n] = (f32x4){0.f, 0.f, 0.f, 0.f};
    bf16x8 At[4][2], B0[2][2], B1[2][2];
    const char* cA = P.aptr(cur); const char* cB = P.bptr(cur);
    if constexpr (Prob::GATHER) { PG8_GATHER_OFFS(vAc, cur); }
    PG8_STAGE(PG8_SB(0, 0), cB, voffB); PG8_STAGE(PG8_SB(0, 1), cB + hstepB, voffB); PG8_STAGE_A(PG8_SA(0, 0), cA, 0, false); PG8_STAGE_A(PG8_SA(0, 1), cA, 1, false);
    if (wr == 1) PG8_BAR;
    PG8_WAIT_V(2); PG8_BAR;
    PG8_STAGE(PG8_SB(1, 0), cB + kstep, voffB); PG8_STAGE_A(PG8_SA(1, 0), PG8_AK(cA, 1), 0, false); PG8_STAGE(PG8_SB(1, 1), cB + hstepB + kstep, voffB);
    PG8_WAIT_V(6); PG8_BAR;
    for (;;) {
        const bool has_next = S.next(ui + 1, nxt);
        const char* nA = has_next ? P.aptr(nxt) : cA; const char* nB = has_next ? P.bptr(nxt) : cB;
        if constexpr (Prob::GATHER) { if (has_next) { PG8_GATHER_OFFS(vAn, nxt); } else {
#pragma unroll
            for (int _h = 0; _h < 2; ++_h)
#pragma unroll
                for (int _i = 0; _i < 2; ++_i) vAn[_h][_i] = vAc[_h][_i]; } }
        for (int t = 0; t < nt; t += 2) {
            const bool last = (t == nt - 2);
            const char* a1 = PG8_AK(cA, t + 1);
            const char* a2 = last ? nA : PG8_AK(cA, t + 2); const char* b2 = last ? nB : cB + (size_t)(t + 2) * kstep;
            const char* a3 = last ? PG8_AK(nA, 1) : PG8_AK(cA, t + 3); const char* b3 = b2 + kstep;
            PG8_LDB(B0, 0, 0); PG8_LDB(B1, 0, 1); PG8_SCHED; PG8_LDA(At, 0, 0); PG8_STAGE_A(PG8_SA(1, 1), a1, 1, false);
            PG8_WAIT_V(8); PG8_WAIT_L(0); PG8_BAR; PG8_MMA(0, 0, At, B0); PG8_MMA(0, 1, At, B1); PG8_BAR; PG8_SCHED;
            PG8_LDA(At, 0, 1); PG8_STAGE(PG8_SB(0, 0), b2, voffB); PG8_STAGE(PG8_SB(0, 1), b2 + hstepB, voffB); PG8_STAGE_A(PG8_SA(0, 0), a2, 0, last);
            PG8_WAIT_V(8); PG8_WAIT_L(0); PG8_BAR; PG8_MMA(1, 0, At, B0); PG8_MMA(1, 1, At, B1); PG8_BAR; PG8_SCHED;
            PG8_LDB(B0, 1, 0); PG8_LDB(B1, 1, 1); PG8_SCHED; PG8_LDA(At, 1, 0); PG8_STAGE_A(PG8_SA(0, 1), a2, 1, last);
            PG8_WAIT_V(8); PG8_WAIT_L(0); PG8_BAR; PG8_MMA(0, 0, At, B0); PG8_MMA(0, 1, At, B1); PG8_BAR; PG8_SCHED;
            PG8_LDA(At, 1, 1); PG8_STAGE(PG8_SB(1, 0), b3, voffB); PG8_STAGE(PG8_SB(1, 1), b3 + hstepB, voffB); PG8_STAGE_A(PG8_SA(1, 0), a3, 0, last);
            PG8_WAIT_V(8); PG8_WAIT_L(0); PG8_BAR; PG8_MMA(1, 0, At, B0); PG8_MMA(1, 1, At, B1); PG8_BAR; PG8_SCHED;
        }
        if constexpr (ALIGN_EPI) { if (wr == 0) PG8_BAR; }
        { int te = threadIdx.x; asm volatile("" : "+v"(te));
          const int we = __builtin_amdgcn_readfirstlane(te >> 6), le = te & 63; E(acc, cur, we >> 2, we & 3, le & 15, le >> 4); }
        if (!has_next) break;
#pragma unroll
        for (int a = 0; a < 2; ++a)
#pragma unroll
            for (int b = 0; b < 2; ++b)
#pragma unroll
                for (int m = 0; m < 4; ++m)
#pragma unroll
                    for (int n = 0; n < 2; ++n) acc[a][b][m][n] = (f32x4){0.f, 0.f, 0.f, 0.f};
        cur = nxt; cA = nA; cB = nB; ++ui;
        if constexpr (Prob::GATHER) {
#pragma unroll
            for (int _h = 0; _h < 2; ++_h)
#pragma unroll
                for (int _i = 0; _i < 2; ++_i) vAc[_h][_i] = vAn[_h][_i]; }
        if constexpr (ALIGN_EPI) { if (wr == 1) PG8_BAR; }
    }
    PG8_WAIT_V(0);
    if constexpr (!ALIGN_EPI) { if (wr == 0) PG8_BAR; }
    PG8_BAR;
#undef PG8_SA
#undef PG8_SB
#undef PG8_STAGE
#undef PG8_STAGE_A
#undef PG8_GATHER_OFFS
#undef PG8_LDA
#undef PG8_LDB
#undef PG8_MMA
#undef PG8_WAIT_V
#undef PG8_WAIT_L
#undef PG8_BAR
#undef PG8_SCHED
#undef PG8_AK
}

struct ProbSimple : ProbBase {
    const char* A; const char* B;
    __device__ __forceinline__ const char* aptr(const Unit& u) const { return A + (size_t)u.pm * 256 * lda * 2; }
    __device__ __forceinline__ const char* bptr(const Unit& u) const { return B + (size_t)u.pn * 256 * ldb * 2; }
};
struct ProbPool : ProbBase {
    const char* A; const char* B;
    __device__ __forceinline__ const char* aptr(const Unit& u) const { return A + ((size_t)u.pm * 256 * 1024 + (size_t)u.pn * 256) * 2; }
    __device__ __forceinline__ const char* bptr(const Unit& u) const { return B + (size_t)u.pn * 65536 * 2; }
};
struct ProbScores : ProbBase {
    const char* A; const char* B;
    __device__ __forceinline__ const char* aptr(const Unit& u) const { return A + ((size_t)u.pm * 256 * 2048 + (size_t)u.pn * 512) * 2; }
    __device__ __forceinline__ const char* bptr(const Unit& u) const { return B + ((size_t)tile_batch(u.pm) * 256 * 2048 + (size_t)u.pn * 512) * 2; }
};
struct ProbVW : ProbBase {
    const char* A; const char* B;
    __device__ __forceinline__ const char* aptr(const Unit& u) const { return A + ((size_t)u.pm * 256 * 2048 + (size_t)(u.pn & 3) * 512) * 2; }
    __device__ __forceinline__ const char* bptr(const Unit& u) const { return B + ((size_t)(u.pn >> 2) * 256 * 2048 + (size_t)(u.pn & 3) * 512) * 2; }
};
struct ProbFin : ProbBase {
    const char* A; const char* B;
    __device__ __forceinline__ const char* aptr(const Unit& u) const { return A + (size_t)u.pm * 256 * 1024 * 2; }
    __device__ __forceinline__ const char* bptr(const Unit& u) const { return B + ((size_t)tile_batch(u.pm) * 2048 + (size_t)u.pn * 256) * 1024 * 2; }
};
struct ProbPV : ProbBase {
    const char* A; const char* B;
    __device__ __forceinline__ const char* aptr(const Unit& u) const { return A + ((size_t)u.pm * 256 * 1024 + (size_t)(u.pn >> 1) * 256) * 2; }
    __device__ __forceinline__ const char* bptr(const Unit& u) const { return B + ((size_t)tile_batch(u.pm) * 2048 + (size_t)u.pn * 256) * 256 * 2; }
};

__device__ __forceinline__ u32x4 pack8(const f32x4& v0, const f32x4& v1) { u32x4 w; w.x = cvt_pk_bf16(v0[0], v0[1]); w.y = cvt_pk_bf16(v0[2], v0[3]); w.z = cvt_pk_bf16(v1[0], v1[1]); w.w = cvt_pk_bf16(v1[2], v1[3]); return w; }
__device__ __forceinline__ float sumsq4(const f32x4& x) { return (x[0] * x[0] + x[1] * x[1]) + (x[2] * x[2] + x[3] * x[3]); }
__device__ __forceinline__ float sum4(const f32x4& x) { return (x[0] + x[1]) + (x[2] + x[3]); }
__device__ __forceinline__ float red_fq(float s) { s += __shfl_xor(s, 16); s += __shfl_xor(s, 32); return s; }

struct EpiIn {
    static constexpr bool PERM = true;
    bf16_t* base; size_t spl; const unsigned* csT; const float* gq; const float* gk; const rss_t* rowss;
    __device__ __forceinline__ void operator()(const f32x4 (&acc)[2][2][4][2], const Unit& u, int wr, int wc, int fr, int fq) const {
        typedef _Float16 h2 __attribute__((ext_vector_type(2)));
        const int t = u.pn >> 2; bf16_t* O = base + (size_t)t * spl; const int colt = (u.pn & 3) * 256; const int row0 = u.pm * BM + wr * 64 + fr;
        if (t >= 2) {
            const int col0 = colt + wc * 32 + 8 * fq;
#pragma unroll
            for (int ai = 0; ai < 2; ++ai) { rss_t rx[4];
#pragma unroll
                for (int m = 0; m < 4; ++m) rx[m] = rowss[row0 + ai * HALF + m * 16];
#pragma unroll
                for (int m = 0; m < 4; ++m) { const float rxm = ss_rstd(rx[m]); bf16_t* rowp = O + (size_t)(row0 + ai * HALF + m * 16) * 1024 + col0;
#pragma unroll
                    for (int bj = 0; bj < 2; ++bj) *(u32x4*)(rowp + bj * HALF) = pack8(acc[ai][bj][m][0] * rxm, acc[ai][bj][m][1] * rxm); }
                asm volatile("" ::: "memory"); }
        } else {
            const float* g = t ? gk : gq; f32x4 g1[2], g2[2];
#pragma unroll
            for (int n = 0; n < 2; ++n) { g1[n] = *(const f32x4*)(g + 8 * fq + 4 * n); g2[n] = *(const f32x4*)(g + 32 + 8 * fq + 4 * n); }
            const int col0 = colt + 64 * wc + 8 * fq;
#pragma unroll
            for (int ah = 0; ah < 4; ++ah) { const int ai = ah >> 1, mb = (ah & 1) * 2;
                u32x4 cs[2][2]; rss_t rx[2];
#pragma unroll
                for (int mm = 0; mm < 2; ++mm) { const int m = mb + mm; const int pos = tok_pos(row0 + ai * HALF + m * 16); rx[mm] = rowss[row0 + ai * HALF + m * 16];
#pragma unroll
                    for (int n = 0; n < 2; ++n) cs[mm][n] = *(const u32x4*)(csT + pos * 32 + 8 * fq + 4 * n); }
#pragma unroll
                for (int mm = 0; mm < 2; ++mm) { const int m = mb + mm; const int row = row0 + ai * HALF + m * 16;
                    float ss = (sumsq4(acc[ai][0][m][0]) + sumsq4(acc[ai][0][m][1])) + (sumsq4(acc[ai][1][m][0]) + sumsq4(acc[ai][1][m][1]));
                    ss = red_fq(ss);
                    const float rxm = ss_rstd(rx[mm]);
                    const float r = __builtin_amdgcn_rsqf(ss * rxm * rxm * (1.0f / 64.0f) + EPS) * rxm * (t ? 1.0f : QSCALE);
                    f32x4 o1[2], o2[2];
#pragma unroll
                    for (int n = 0; n < 2; ++n) { f32x4 c, s;
#pragma unroll
                        for (int j = 0; j < 4; ++j) { const unsigned w = cs[mm][n][j]; const h2 v = __builtin_bit_cast(h2, w); c[j] = (float)v.x; s[j] = (float)v.y; }
                        const f32x4 x1 = acc[ai][0][m][n] * r * g1[n], x2 = acc[ai][1][m][n] * r * g2[n];
                        o1[n] = x1 * c - x2 * s; o2[n] = x2 * c + x1 * s; }
                    bf16_t* rowp = O + (size_t)row * 1024 + col0;
                    *(u32x4*)(rowp) = pack8(o1[0], o1[1]); *(u32x4*)(rowp + 32) = pack8(o2[0], o2[1]); }
                asm volatile("" ::: "memory"); }
        }
    }
};
template <int MODE> struct EpiBf {
    static constexpr bool PERM = true;
    bf16_t* O; int ldc; float* aux; float* aux2; LAS float* xl;
    __device__ __forceinline__ void operator()(f32x4 (&acc)[2][2][4][2], const Unit& u, int wr, int wc, int fr, int fq) const {
        const int row0 = u.pm * BM + wr * 64 + fr; const int col0 = u.pn * BM + wc * 32 + 8 * fq;
        float rs[2][4];
        if constexpr (MODE == 2) {
            f32x4 qa[2][4][2];
#pragma unroll
            for (int ai = 0; ai < 2; ++ai)
#pragma unroll
                for (int m = 0; m < 4; ++m) { const float* p = aux + (size_t)(row0 + ai * HALF + m * 16) * 32 + u.pn * 8; qa[ai][m][0] = *(const f32x4*)p; qa[ai][m][1] = *(const f32x4*)(p + 4); }
#pragma unroll
            for (int ai = 0; ai < 2; ++ai)
#pragma unroll
                for (int m = 0; m < 4; ++m) { const float sc = __builtin_amdgcn_rsqf((sum4(qa[ai][m][0]) + sum4(qa[ai][m][1])) * (1.0f / 512.0f) + EPS) * (0.044194173824159216f * 1.4426950408889634f); float ps = 0.f;
#pragma unroll
                    for (int bj = 0; bj < 2; ++bj)
#pragma unroll
                        for (int n = 0; n < 2; ++n) { f32x4 p;
#pragma unroll
                            for (int j = 0; j < 4; ++j) p[j] = __builtin_amdgcn_exp2f(acc[ai][bj][m][n][j] * sc);
                            acc[ai][bj][m][n] = p; ps += sum4(p); }
                    ps = red_fq(ps);
                    if (fq == 0) xl[(ai * HALF + wr * 64 + m * 16 + fr) * 4 + wc] = ps; }
            asm volatile("s_waitcnt lgkmcnt(0)" ::: "memory"); __builtin_amdgcn_s_barrier(); asm volatile("" ::: "memory");
#pragma unroll
            for (int ai = 0; ai < 2; ++ai)
#pragma unroll
                for (int m = 0; m < 4; ++m) { const f32x4 lv = *(const LAS f32x4*)(xl + (ai * HALF + wr * 64 + m * 16 + fr) * 4); rs[ai][m] = __builtin_amdgcn_rcpf(sum4(lv)); }
        }
        if constexpr (MODE == 1 || MODE == 4) { rss_t rv[2][4];
#pragma unroll
            for (int ai = 0; ai < 2; ++ai)
#pragma unroll
                for (int m = 0; m < 4; ++m) rv[ai][m] = ((const rss_t*)aux2)[row0 + ai * HALF + m * 16];
#pragma unroll
            for (int ai = 0; ai < 2; ++ai)
#pragma unroll
                for (int m = 0; m < 4; ++m) rs[ai][m] = ss_rstd(rv[ai][m]);
        }
        if constexpr (MODE == 3) {
            f32x4 la[2][4];
#pragma unroll
            for (int ai = 0; ai < 2; ++ai)
#pragma unroll
                for (int m = 0; m < 4; ++m) la[ai][m] = *(const f32x4*)(aux2 + (size_t)(row0 + ai * HALF + m * 16) * 16 + (u.pn >> 1) * 4);
#pragma unroll
            for (int ai = 0; ai < 2; ++ai)
#pragma unroll
                for (int m = 0; m < 4; ++m) rs[ai][m] = __builtin_amdgcn_rcpf(sum4(la[ai][m]));
        }
        bf16_t* Ob = O; int colb = col0;
        if constexpr (MODE == 5) { Ob = O + (size_t)(u.pn >> 2) * 2048 * 1024; colb = (u.pn & 3) * 256 + wc * 32 + 8 * fq; }
#pragma unroll
        for (int ai = 0; ai < 2; ++ai)
#pragma unroll
            for (int m = 0; m < 4; ++m) { const int row = row0 + ai * HALF + m * 16; bf16_t* rowp = Ob + (size_t)row * ldc + colb;
                if constexpr (MODE == 0 || MODE == 5) {
#pragma unroll
                    for (int bj = 0; bj < 2; ++bj) *(u32x4*)(rowp + bj * HALF) = pack8(acc[ai][bj][m][0], acc[ai][bj][m][1]);
                } else if constexpr (MODE == 1) {
                    float ss = (sumsq4(acc[ai][0][m][0]) + sumsq4(acc[ai][0][m][1])) + (sumsq4(acc[ai][1][m][0]) + sumsq4(acc[ai][1][m][1]));
                    ss = red_fq(ss); const float rxx = rs[ai][m];
                    if (fq == 0) aux[(size_t)row * 32 + u.pn * 4 + wc] = ss * rxx * rxx;
#pragma unroll
                    for (int bj = 0; bj < 2; ++bj) *(u32x4*)(rowp + bj * HALF) = pack8(acc[ai][bj][m][0] * rxx, acc[ai][bj][m][1] * rxx);
                } else {
                    const float rxx = rs[ai][m];
#pragma unroll
                    for (int bj = 0; bj < 2; ++bj) *(u32x4*)(rowp + bj * HALF) = pack8(acc[ai][bj][m][0] * rxx, acc[ai][bj][m][1] * rxx);
                }
            }
    }
};
struct EpiRes {
    static constexpr bool PERM = true;
    bf16_t* XB; rss_t* rowss; float* OUT;
    __device__ __forceinline__ void load_half(u32x4 (&t)[4][2], int row0, int col0, int ai) const {
#pragma unroll
        for (int m = 0; m < 4; ++m) { const bf16_t* rowb = XB + (size_t)(row0 + ai * HALF + m * 16) * D_MODEL + col0;
#pragma unroll
            for (int bj = 0; bj < 2; ++bj) t[m][bj] = *(const u32x4*)(rowb + bj * HALF); }
    }
    __device__ __forceinline__ void add_half(f32x4 (&acc)[2][2][4][2], const u32x4 (&t)[4][2], int ai) const {
#pragma unroll
        for (int m = 0; m < 4; ++m)
#pragma unroll
            for (int bj = 0; bj < 2; ++bj) { const u32x4 w = t[m][bj];
                acc[ai][bj][m][0] = acc[ai][bj][m][0] + (f32x4){bflo(w.x), bfhi(w.x), bflo(w.y), bfhi(w.y)}; acc[ai][bj][m][1] = acc[ai][bj][m][1] + (f32x4){bflo(w.z), bfhi(w.z), bflo(w.w), bfhi(w.w)}; }
    }
    __device__ __forceinline__ void store_half(const f32x4 (&acc)[2][2][4][2], int row0, int col0, int ai, int fq) const {
#pragma unroll
        for (int m = 0; m < 4; ++m) { const int row = row0 + ai * HALF + m * 16; bf16_t* rowb = XB + (size_t)row * D_MODEL + col0; float ss = 0.f;
#pragma unroll
            for (int bj = 0; bj < 2; ++bj) { const f32x4 v0 = acc[ai][bj][m][0], v1 = acc[ai][bj][m][1];
                if (OUT) { float* rowp = OUT + (size_t)row * D_MODEL + col0 + bj * HALF; *(f32x4*)rowp = v0; *(f32x4*)(rowp + 4) = v1; }
                else { *(u32x4*)(rowb + bj * HALF) = pack8(v0, v1); ss += sumsq4(v0) + sumsq4(v1); } }
            if (rowss) { ss = red_fq(ss); if (fq == 0) atomicAdd(rowss + row, ss_fix(ss)); } }
    }
    __device__ __forceinline__ void operator()(f32x4 (&acc)[2][2][4][2], const Unit& u, int wr, int wc, int fr, int fq) const {
        const int row0 = u.pm * BM + wr * 64 + fr, col0 = u.pn * BM + wc * 32 + 8 * fq;
        u32x4 t[4][2];
        load_half(t, row0, col0, 0);
        add_half(acc, t, 0);
        asm volatile("" : "+v"(acc[0][0][0][0]), "+v"(acc[0][1][3][1]));
        load_half(t, row0, col0, 1);
        asm volatile("" ::: "memory");
        store_half(acc, row0, col0, 0, fq);
        add_half(acc, t, 1);
        store_half(acc, row0, col0, 1, fq);
    }
};
__device__ __forceinline__ int ffn_tile_row(int pm, int R, int chunk, bool& valid) {
    R = (R & ~63) | ((R & 15) << 2) | ((R >> 4) & 3);
    valid = true; if (pm < FFN_MT) return pm * 256 + R;
    const int v = (pm - FFN_MT) * 256 + R; int g = v >> 2; const int k = v & 3; int tok;
    if (chunk == 0) { valid = g < 124; g = g < 124 ? g : 123; const int s = g / 31, bi = g - s * 31; tok = s * S_P + 256 * (bi + 1); }
    else { valid = g < 120; g = g < 120 ? g : 119; const int s = g / 15, bi = g - s * 15; tok = s * S_S + 256 * (bi + 1); }
    return tok + k - 2;
}
struct ProbUp : ProbBase {
    static constexpr bool GATHER = true;
    const char* A; const char* B; int chunk;
    __device__ __forceinline__ const char* aptr(const Unit&) const { return A; }
    __device__ __forceinline__ const char* bptr(const Unit& u) const { return B + (size_t)u.pn * 256 * ldb * 2; }
    __device__ __forceinline__ unsigned rowoff(const Unit& u, int R) const { bool v; return (unsigned)ffn_tile_row(u.pm, R, chunk, v) * (unsigned)(lda * 2); }
};
__device__ __forceinline__ float dpp_ror1(float v) { return __builtin_bit_cast(float, __builtin_amdgcn_update_dpp(0, __builtin_bit_cast(int, v), 0x121, 0xf, 0xf, false)); }
__device__ __forceinline__ float dpp_ror15(float v) { return __builtin_bit_cast(float, __builtin_amdgcn_update_dpp(0, __builtin_bit_cast(int, v), 0x12F, 0xf, 0xf, false)); }
struct EpiGlu {
    static constexpr bool PERM = true;
    bf16_t* G; const rss_t* rowss; const u32x4* cwt; int chunk; LAS float* xl;
    __device__ __forceinline__ void operator()(f32x4 (&acc)[2][2][4][2], const Unit& u, int wr, int wc, int fr, int fq) const {
        const bool bnd = u.pm >= FFN_MT; const int ch0 = u.pn * 128 + wc * 32 + 8 * fq;
        const int tidw = (wr * 4 + wc) * 64 + fq * 16 + fr; LAS unsigned char* wl = (LAS unsigned char*)xl + 12288;
        u32x4 wrec = (u32x4){0u, 0u, 0u, 0u}; if (tidw < 128) wrec = cwt[u.pn * 128 + tidw];
        int rowi[2][4]; unsigned stmask = 0u;
        { rss_t rv[2][4];
#pragma unroll
          for (int ai = 0; ai < 2; ++ai)
#pragma unroll
            for (int m = 0; m < 4; ++m) { const int RL = ai * HALF + wr * 64 + 4 * fr + m; bool valid; const int row = ffn_tile_row(u.pm, ai * HALF + wr * 64 + m * 16 + fr, chunk, valid); rowi[ai][m] = row; rv[ai][m] = rowss[row];
                const int gt = chunk * FFN_CHUNK + row, pos = tok_pos(gt), S = tok_seqlen(gt);
                const bool st = bnd ? (valid && (m == 1 || m == 2)) : !((RL == 0 && pos != 0) || (RL == 255 && pos != S - 1));
                stmask |= st ? (1u << (ai * 4 + m)) : 0u; }
#pragma unroll
          for (int ai = 0; ai < 2; ++ai)
#pragma unroll
            for (int m = 0; m < 4; ++m) { const float rx = ss_rstd(rv[ai][m]);
#pragma unroll
                for (int bj = 0; bj < 2; ++bj)
#pragma unroll
                    for (int n = 0; n < 2; ++n) acc[ai][bj][m][n] = acc[ai][bj][m][n] * rx; } }
#pragma unroll
        for (int ai = 0; ai < 2; ++ai) { const int s1 = 2 * ai + wr + 1;
            if (fr == 0) {
#pragma unroll
                for (int bj = 0; bj < 2; ++bj)
#pragma unroll
                    for (int n = 0; n < 2; ++n) *(LAS f32x4*)(xl + ((s1 * 2 + 0) * 4 + wc) * 64 + bj * 32 + 8 * fq + 4 * n) = acc[ai][bj][0][n]; }
            if (fr == 15) {
#pragma unroll
                for (int bj = 0; bj < 2; ++bj)
#pragma unroll
                    for (int n = 0; n < 2; ++n) *(LAS f32x4*)(xl + ((s1 * 2 + 1) * 4 + wc) * 64 + bj * 32 + 8 * fq + 4 * n) = acc[ai][bj][3][n]; } }
        if (tidw < 128) *(LAS u32x4*)(wl + tidw * 16) = wrec;
        asm volatile("s_waitcnt lgkmcnt(0)" ::: "memory"); __builtin_amdgcn_s_barrier(); asm volatile("" ::: "memory");
#pragma unroll
        for (int n = 0; n < 2; ++n) { unsigned wp[2][4][2];
#pragma unroll
            for (int jp = 0; jp < 2; ++jp) { float o[2][4][2];
#pragma unroll
                for (int jj = 0; jj < 2; ++jj) { const int j = 2 * jp + jj; const u32x4 w = *(const LAS u32x4*)(wl + (wc * 32 + 8 * fq + 4 * n + j) * 16);
                    const float g0w = bflo(w.x), g1w = bfhi(w.x), g2w = bflo(w.y), gbw = bfhi(w.y), v0w = bflo(w.z), v1w = bfhi(w.z), v2w = bflo(w.w), vbw = bfhi(w.w);
#pragma unroll
                    for (int ai = 0; ai < 2; ++ai) { const int s1 = 2 * ai + wr + 1; float cg[4], cv[4];
                        const LAS float* xp = xl + (((s1 - 1) * 2 + 1) * 4 + wc) * 64 + 8 * fq + 4 * n + j; const LAS float* xn = xl + (((s1 + 1) * 2 + 0) * 4 + wc) * 64 + 8 * fq + 4 * n + j;
                        { const float pe = xp[0], ne = xn[0]; const float r3 = dpp_ror1(acc[ai][0][3][n][j]), l0 = dpp_ror15(acc[ai][0][0][n][j]);
#pragma unroll
                          for (int m = 0; m < 4; ++m) { const float pv = m ? acc[ai][0][m ? m - 1 : 0][n][j] : (fr == 0 ? pe : r3), nx = m < 3 ? acc[ai][0][m < 3 ? m + 1 : 3][n][j] : (fr == 15 ? ne : l0);
                              cg[m] = gbw + g0w * pv + g1w * acc[ai][0][m][n][j] + g2w * nx; } }
                        { const float pe = xp[32], ne = xn[32]; const float r3 = dpp_ror1(acc[ai][1][3][n][j]), l0 = dpp_ror15(acc[ai][1][0][n][j]);
#pragma unroll
                          for (int m = 0; m < 4; ++m) { const float pv = m ? acc[ai][1][m ? m - 1 : 0][n][j] : (fr == 0 ? pe : r3), nx = m < 3 ? acc[ai][1][m < 3 ? m + 1 : 3][n][j] : (fr == 15 ? ne : l0);
                              cv[m] = vbw + v0w * pv + v1w * acc[ai][1][m][n][j] + v2w * nx; } }
#pragma unroll
                        for (int m = 0; m < 4; ++m) { const float g0 = cg[m];
                            const float ea = g0 * fmaf(g0 * g0, -0.10294324f, -2.3022082f);
                            o[ai][m][jj] = g0 * __builtin_amdgcn_rcpf(1.0f + __builtin_amdgcn_exp2f(ea)) * cv[m]; }
                        asm volatile("" : "+v"(o[ai][0][jj]), "+v"(o[ai][1][jj]), "+v"(o[ai][2][jj]), "+v"(o[ai][3][jj])); } }
#pragma unroll
                for (int ai = 0; ai < 2; ++ai)
#pragma unroll
                    for (int m = 0; m < 4; ++m) wp[ai][m][jp] = cvt_pk_bf16(o[ai][m][0], o[ai][m][1]); }
#pragma unroll
            for (int ai = 0; ai < 2; ++ai)
#pragma unroll
                for (int m = 0; m < 4; ++m) { u32x2 q; q.x = wp[ai][m][0]; q.y = wp[ai][m][1]; if (stmask & (1u << (ai * 4 + m))) *(u32x2*)(G + (size_t)rowi[ai][m] * D_FF + ch0 + 4 * n) = q; }
            asm volatile("" ::: "memory"); }
    }
};
struct EpiKV {
    static constexpr bool PERM = false;
    float* kraw; bf16_t* vT;
    __device__ __forceinline__ void operator()(const f32x4 (&acc)[2][2][4][2], const Unit& u, int wr, int wc, int fr, int fq) const {
        const int key0 = wr * 64 + fr, col0 = u.pn * BM + wc * 32 + 4 * fq;
        if (u.pn < 8) {
#pragma unroll
            for (int ai = 0; ai < 2; ++ai)
#pragma unroll
                for (int m = 0; m < 4; ++m) { float* rowp = kraw + (size_t)(u.pm * BM + key0 + ai * HALF + m * 16) * 2048 + col0;
#pragma unroll
                    for (int bj = 0; bj < 2; ++bj)
#pragma unroll
                        for (int n = 0; n < 2; ++n) *(f32x4*)(rowp + bj * HALF + n * 16) = acc[ai][bj][m][n]; }
        } else {
#pragma unroll
            for (int ai = 0; ai < 2; ++ai)
#pragma unroll
                for (int m = 0; m < 4; ++m) { bf16_t* rowp = vT + (size_t)(u.pm * BM + key0 + ai * HALF + m * 16) * 2048 + (col0 - 2048);
#pragma unroll
                    for (int bj = 0; bj < 2; ++bj)
#pragma unroll
                        for (int n = 0; n < 2; ++n) { const f32x4 v = acc[ai][bj][m][n]; u32x2 w; w.x = cvt_pk_bf16(v[0], v[1]); w.y = cvt_pk_bf16(v[2], v[3]); *(u32x2*)(rowp + bj * HALF + n * 16) = w; } }
        }
    }
};
}

namespace att {
constexpr int KVBLK = 64, SHM_V = 16384, SHM_K = 16384, OFF_V = 0, OFF_K = 3 * SHM_V, OFF_WS = 3 * SHM_V + 3 * SHM_K, LDP = 1024;
#define KSWZ(row, colB) ((row) * 256 + ((colB) ^ (((row) & 7) << 4)))
#define SBAR() __builtin_amdgcn_sched_barrier(0)
__device__ __forceinline__ int crow(int r, int hi) { return (r & 3) + 8 * (r >> 2) + 4 * hi; }
__device__ __forceinline__ void partialSM(f32x16& p0) {
#pragma unroll
  for (int r = 0; r < 16; ++r) p0[r] = __builtin_amdgcn_exp2f(p0[r]);
}
__device__ __forceinline__ void finishSM(f32x16& p0, f32x16& p1, float& l_reg, bf16x8& pa0, bf16x8& pa1, bf16x8& pa2, bf16x8& pa3) {
#pragma unroll
  for (int r = 0; r < 16; ++r) p1[r] = __builtin_amdgcn_exp2f(p1[r]);
  float ps = 0;
#pragma unroll
  for (int r = 0; r < 16; ++r) ps += p0[r];
#pragma unroll
  for (int r = 0; r < 16; ++r) ps += p1[r];
  l_reg += ps;
#define PK4(P, BASE, OUT) do { unsigned a0 = cvt_pk_bf16(P[BASE + 0], P[BASE + 1]), a1 = cvt_pk_bf16(P[BASE + 2], P[BASE + 3]);   \
    unsigned b0 = cvt_pk_bf16(P[BASE + 4], P[BASE + 5]), b1 = cvt_pk_bf16(P[BASE + 6], P[BASE + 7]);                              \
    auto r0 = __builtin_amdgcn_permlane32_swap(a0, b0, false, false); auto r1 = __builtin_amdgcn_permlane32_swap(a1, b1, false, false); \
    u32x4 w = {r0[0], r1[0], r0[1], r1[1]}; OUT = __builtin_bit_cast(bf16x8, w); } while (0)
  PK4(p0, 0, pa0); PK4(p0, 8, pa1); PK4(p1, 0, pa2); PK4(p1, 8, pa3);
#undef PK4
}
__device__ __forceinline__ void finishSM_tail(f32x16& p0, f32x16& p1, float& l_reg, bf16x8& pa0, bf16x8& pa1, bf16x8& pa2, bf16x8& pa3) {
  float ps = 0;
#pragma unroll
  for (int r = 0; r < 16; ++r) ps += p0[r];
#pragma unroll
  for (int r = 0; r < 16; ++r) ps += p1[r];
  l_reg += ps;
#define PK4(P, BASE, OUT) do { unsigned a0 = cvt_pk_bf16(P[BASE + 0], P[BASE + 1]), a1 = cvt_pk_bf16(P[BASE + 2], P[BASE + 3]);   \
    unsigned b0 = cvt_pk_bf16(P[BASE + 4], P[BASE + 5]), b1 = cvt_pk_bf16(P[BASE + 6], P[BASE + 7]);                              \
    auto r0 = __builtin_amdgcn_permlane32_swap(a0, b0, false, false); auto r1 = __builtin_amdgcn_permlane32_swap(a1, b1, false, false); \
    u32x4 w = {r0[0], r1[0], r0[1], r1[1]}; OUT = __builtin_bit_cast(bf16x8, w); } while (0)
  PK4(p0, 0, pa0); PK4(p0, 8, pa1); PK4(p1, 0, pa2); PK4(p1, 8, pa3);
#undef PK4
}
__device__ __forceinline__ void qkt(f32x16& p0, f32x16& p1, const LAS unsigned char* Ks, const bf16x8* qr, int r32, int hi, int cbase) {
  p0 = f32x16{}; p1 = f32x16{}; bf16x8 b0[4], b1[4];
#pragma unroll
  for (int d0 = 0; d0 < 4; ++d0) { const int cb = cbase + (d0 * 16 + hi * 8) * 2;
    b0[d0] = *(const LAS bf16x8*)(Ks + KSWZ(r32, cb)); b1[d0] = *(const LAS bf16x8*)(Ks + KSWZ(32 + r32, cb)); }
#define QK_STEP(D, N) do { asm volatile("s_waitcnt lgkmcnt(" #N ")" ::: "memory"); SBAR(); \
    p0 = __builtin_amdgcn_mfma_f32_32x32x16_bf16(b0[D], qr[D], p0, 0, 0, 0); p1 = __builtin_amdgcn_mfma_f32_32x32x16_bf16(b1[D], qr[D], p1, 0, 0, 0); } while (0)
  QK_STEP(0, 6); QK_STEP(1, 4); QK_STEP(2, 2); QK_STEP(3, 0);
#undef QK_STEP
}
__device__ __forceinline__ int v_st(int k, int c) { const int kk = (k & ~0xC) | ((k & 4) << 1) | ((k & 8) >> 1); return ((kk >> 3) * 4 + (c >> 5)) * 512 + ((kk & 7) * 32 + (c & 31)) * 2; }
__device__ __forceinline__ int v_rd_base(int lane) { return ((lane & 3) << 3) | (((lane >> 2) & 3) << 6) | (((lane >> 4) & 1) << 5) | (((lane >> 5) & 1) << 8); }
constexpr int v_rd_off(int d0, int ks, int half) { return d0 * 512 + ks * 4096 + half * 2048; }
template <int OFF> __device__ __forceinline__ s16x4 tr_read(int vb) {
  s16x4 r; asm volatile("ds_read_b64_tr_b16 %0, %1 offset:%2" : "=&v"(r) : "v"(vb), "i"(OFF) : "memory"); return r;
}
struct VFrag { s16x4 l0, h0, l1, h1, l2, h2, l3, h3; };
template <int D0> __device__ __forceinline__ void pv_read(VFrag& f, int vb) {
  f.l0 = tr_read<v_rd_off(D0, 0, 0)>(vb); f.h0 = tr_read<v_rd_off(D0, 0, 1)>(vb); f.l1 = tr_read<v_rd_off(D0, 1, 0)>(vb); f.h1 = tr_read<v_rd_off(D0, 1, 1)>(vb);
  f.l2 = tr_read<v_rd_off(D0, 2, 0)>(vb); f.h2 = tr_read<v_rd_off(D0, 2, 1)>(vb); f.l3 = tr_read<v_rd_off(D0, 3, 0)>(vb); f.h3 = tr_read<v_rd_off(D0, 3, 1)>(vb);
}
__device__ __forceinline__ void pv_mma(f32x16& od, const VFrag& f, bf16x8 pa0, bf16x8 pa1, bf16x8 pa2, bf16x8 pa3) {
#define PKV(L, H) (bf16x8){L[0], L[1], L[2], L[3], H[0], H[1], H[2], H[3]}
  od = __builtin_amdgcn_mfma_f32_32x32x16_bf16(pa0, PKV(f.l0, f.h0), od, 0, 0, 0);
  od = __builtin_amdgcn_mfma_f32_32x32x16_bf16(pa1, PKV(f.l1, f.h1), od, 0, 0, 0);
  od = __builtin_amdgcn_mfma_f32_32x32x16_bf16(pa2, PKV(f.l2, f.h2), od, 0, 0, 0);
  od = __builtin_amdgcn_mfma_f32_32x32x16_bf16(pa3, PKV(f.l3, f.h3), od, 0, 0, 0);
#undef PKV
}
__device__ __forceinline__ void pv_d0(f32x16* o, int vb, bf16x8 pa0, bf16x8 pa1, bf16x8 pa2, bf16x8 pa3) {
  VFrag fa, fb;
  pv_read<0>(fa, vb); pv_read<1>(fb, vb);
  asm volatile("s_waitcnt lgkmcnt(8)" ::: "memory"); SBAR(); pv_mma(o[0], fa, pa0, pa1, pa2, pa3); SBAR();
  pv_read<2>(fa, vb);
  asm volatile("s_waitcnt lgkmcnt(8)" ::: "memory"); SBAR(); pv_mma(o[1], fb, pa0, pa1, pa2, pa3); SBAR();
  pv_read<3>(fb, vb);
  asm volatile("s_waitcnt lgkmcnt(8)" ::: "memory"); SBAR(); pv_mma(o[2], fa, pa0, pa1, pa2, pa3); SBAR();
  asm volatile("s_waitcnt lgkmcnt(0)" ::: "memory"); SBAR(); pv_mma(o[3], fb, pa0, pa1, pa2, pa3);
}
__device__ __forceinline__ void att_step(f32x16& s0, f32x16& s1, const LAS unsigned char* Ks, const bf16x8* qr, int r32, int hi, int cbase,
                                         f32x16& e0, f32x16& e1, float& l_reg, bf16x8& pa0, bf16x8& pa1, bf16x8& pa2, bf16x8& pa3, f32x16* o, int vb) {
  bf16x8 b0[4], b1[4]; VFrag fa, fb; float ps = 0.f; u32x4 w0, w1, w2, w3; const bf16x2_t ones2 = {(__bf16)1.0f, (__bf16)1.0f};
#pragma unroll
  for (int d0 = 0; d0 < 4; ++d0) { const int cb = cbase + (d0 * 16 + hi * 8) * 2;
    b0[d0] = *(const LAS bf16x8*)(Ks + KSWZ(r32, cb)); b1[d0] = *(const LAS bf16x8*)(Ks + KSWZ(32 + r32, cb)); }
  s0 = f32x16{}; s1 = f32x16{};
#define PACK_H(E, BASE, H, W) do { const unsigned a_ = cvt_pk_bf16(E[BASE + 2 * H], E[BASE + 2 * H + 1]), b_ = cvt_pk_bf16(E[BASE + 4 + 2 * H], E[BASE + 5 + 2 * H]);  \
    ps = __builtin_amdgcn_fdot2_f32_bf16(__builtin_bit_cast(bf16x2_t, a_), ones2, ps, false); ps = __builtin_amdgcn_fdot2_f32_bf16(__builtin_bit_cast(bf16x2_t, b_), ones2, ps, false);     \
    auto r_ = __builtin_amdgcn_permlane32_swap(a_, b_, false, false); W[H] = r_[0]; W[2 + H] = r_[1]; } while (0)
#define QK_STEP(D, N, PRE, PK_A, PK_B) do { asm volatile("s_waitcnt lgkmcnt(" #N ")" ::: "memory"); PRE; SBAR();                                                  \
    s0 = __builtin_amdgcn_mfma_f32_32x32x16_bf16(b0[D], qr[D], s0, 0, 0, 0); SBAR(); PK_A; SBAR();                                                                 \
    s1 = __builtin_amdgcn_mfma_f32_32x32x16_bf16(b1[D], qr[D], s1, 0, 0, 0); SBAR(); PK_B; SBAR(); } while (0)
  QK_STEP(0, 6, (void)0, PACK_H(e0, 0, 0, w0), PACK_H(e0, 0, 1, w0));
  QK_STEP(1, 4, (void)0, PACK_H(e0, 8, 0, w1), PACK_H(e0, 8, 1, w1));
  QK_STEP(2, 2, (void)0, PACK_H(e1, 0, 0, w2), PACK_H(e1, 0, 1, w2));
  QK_STEP(3, 0, (pv_read<0>(fa, vb), pv_read<1>(fb, vb)), PACK_H(e1, 8, 0, w3), PACK_H(e1, 8, 1, w3));
#undef QK_STEP
#undef PACK_H
  l_reg += ps;
  pa0 = __builtin_bit_cast(bf16x8, w0); pa1 = __builtin_bit_cast(bf16x8, w1); pa2 = __builtin_bit_cast(bf16x8, w2); pa3 = __builtin_bit_cast(bf16x8, w3);
#define PKV(L, H) (bf16x8){L[0], L[1], L[2], L[3], H[0], H[1], H[2], H[3]}
#define EX2(X, I) do { X[I] = __builtin_amdgcn_exp2f(X[I]); X[I + 1] = __builtin_amdgcn_exp2f(X[I + 1]); } while (0)
#define PV_BLK(D0, F, N, X, XB) do { asm volatile("s_waitcnt lgkmcnt(" #N ")" ::: "memory"); SBAR();                                                              \
    o[D0] = __builtin_amdgcn_mfma_f32_32x32x16_bf16(pa0, PKV(F.l0, F.h0), o[D0], 0, 0, 0); SBAR(); EX2(X, XB + 0); SBAR();                                         \
    o[D0] = __builtin_amdgcn_mfma_f32_32x32x16_bf16(pa1, PKV(F.l1, F.h1), o[D0], 0, 0, 0); SBAR(); EX2(X, XB + 2); SBAR();                                         \
    o[D0] = __builtin_amdgcn_mfma_f32_32x32x16_bf16(pa2, PKV(F.l2, F.h2), o[D0], 0, 0, 0); SBAR(); EX2(X, XB + 4); SBAR();                                         \
    o[D0] = __builtin_amdgcn_mfma_f32_32x32x16_bf16(pa3, PKV(F.l3, F.h3), o[D0], 0, 0, 0); SBAR(); EX2(X, XB + 6); SBAR(); } while (0)
  PV_BLK(0, fa, 8, s0, 0); pv_read<2>(fa, vb);
  PV_BLK(1, fb, 8, s0, 8); pv_read<3>(fb, vb);
  PV_BLK(2, fa, 8, s1, 0);
  PV_BLK(3, fb, 0, s1, 8);
#undef PV_BLK
#undef EX2
#undef PKV
}
__device__ __forceinline__ void attn_unit(const bf16_t* Qg, const bf16_t* __restrict__ Kg, const bf16_t* __restrict__ Vg, bf16_t* Og, int seq, float lam, const float* gsub, float oscale, LAS unsigned char* lds) {
  int tid_l = threadIdx.x; asm volatile("" : "+v"(tid_l));
  const int tid = tid_l, wid = __builtin_amdgcn_readfirstlane(tid >> 6), lane = tid & 63, r32 = lane & 31, hi = lane >> 5;
  const int comp = wid & 1, rg = wid >> 1, cbase = comp * 128;
  LAS unsigned char* V_lds = lds + OFF_V; LAS unsigned char* K_lds = lds + OFF_K;
  LAS float* wsf = (LAS float*)(lds + OFF_WS) + wid * 64; LAS float* li_l = wsf;
  float l_reg = 0; f32x16 o[4] = {}; bf16x8 qr[4];
  const bf16_t* Qw = Qg + (size_t)(rg * 32 + r32) * LDP + comp * 64 + hi * 8;
#pragma unroll
  for (int d0 = 0; d0 < 4; ++d0) qr[d0] = *(const bf16x8*)(Qw + d0 * 16);
  unsigned koff[2], voff[2];
#pragma unroll
  for (int i = 0; i < 2; ++i) { const int L = (tid + 512 * i) * 16; { const int row = L >> 8, colB = (L & 255) ^ ((row & 7) << 4); koff[i] = (unsigned)(row * LDP * 2 + colB); }
    { const int sub = L >> 9, w = L & 511, kk = (sub >> 2) * 8 + (w >> 6), c = (sub & 3) * 32 + ((w & 63) >> 1), k = (kk & ~0xC) | ((kk & 4) << 1) | ((kk & 8) >> 1); voff[i] = (unsigned)(k * LDP * 2 + c * 2); } }
  const int vbb = (int)(unsigned)(size_t)V_lds + v_rd_base(lane);
  const int NT = seq / KVBLK; const size_t tstep = (size_t)KVBLK * LDP * 2;
#define DMA_K(t) do { const int t_ = (t) < NT ? (t) : NT - 1; const char* g_ = (const char*)Kg + (size_t)t_ * tstep; LAS unsigned char* d_ = K_lds + (t_ % 3) * SHM_K + wid * 1024; \
    __builtin_amdgcn_global_load_lds((const unsigned*)(g_ + koff[0]), (LAS unsigned*)d_, 16, 0, 0); __builtin_amdgcn_global_load_lds((const unsigned*)(g_ + koff[1]), (LAS unsigned*)(d_ + 8192), 16, 0, 0); } while (0)
#define DMA_V(t) do { const int t_ = (t) < NT ? (t) : NT - 1; const char* g_ = (const char*)Vg + (size_t)t_ * tstep; LAS unsigned char* d_ = V_lds + (t_ % 3) * SHM_V + wid * 1024; \
    __builtin_amdgcn_global_load_lds((const unsigned*)(g_ + voff[0]), (LAS unsigned*)d_, 16, 0, 0); __builtin_amdgcn_global_load_lds((const unsigned*)(g_ + voff[1]), (LAS unsigned*)(d_ + 8192), 16, 0, 0); } while (0)
#define WAIT4_BAR() do { asm volatile("s_waitcnt vmcnt(4)" ::: "memory"); __builtin_amdgcn_s_barrier(); asm volatile("" ::: "memory"); } while (0)
  f32x16 pA0, pA1, pB0, pB1; bf16x8 pa0, pa1, pa2, pa3;
  DMA_K(0); DMA_K(1); DMA_V(0);
  WAIT4_BAR();
  DMA_K(2); DMA_V(1);
  qkt(pA0, pA1, K_lds, qr, r32, hi, cbase); partialSM(pA0); partialSM(pA1);
  int sk = 1, sv = 0;
  for (int j = 1; j + 1 < NT; j += 2) {
    WAIT4_BAR(); DMA_K(j + 2); DMA_V(j + 1);
    SBAR(); att_step(pB0, pB1, K_lds + sk * SHM_K, qr, r32, hi, cbase, pA0, pA1, l_reg, pa0, pa1, pa2, pa3, o, vbb + sv * SHM_V); SBAR();
    sk = sk == 2 ? 0 : sk + 1; sv = sv == 2 ? 0 : sv + 1;
    WAIT4_BAR(); DMA_K(j + 3); DMA_V(j + 2);
    SBAR(); att_step(pA0, pA1, K_lds + sk * SHM_K, qr, r32, hi, cbase, pB0, pB1, l_reg, pa0, pa1, pa2, pa3, o, vbb + sv * SHM_V); SBAR();
    sk = sk == 2 ? 0 : sk + 1; sv = sv == 2 ? 0 : sv + 1;
  }
  WAIT4_BAR(); DMA_K(NT + 1); DMA_V(NT);
  SBAR(); att_step(pB0, pB1, K_lds + sk * SHM_K, qr, r32, hi, cbase, pA0, pA1, l_reg, pa0, pa1, pa2, pa3, o, vbb + sv * SHM_V); SBAR();
  sv = sv == 2 ? 0 : sv + 1;
  WAIT4_BAR();
  finishSM_tail(pB0, pB1, l_reg, pa0, pa1, pa2, pa3); SBAR();
  pv_d0(o, vbb + sv * SHM_V, pa0, pa1, pa2, pa3);
  asm volatile("s_waitcnt vmcnt(0)" ::: "memory");
#undef DMA_K
#undef DMA_V
#undef WAIT4_BAR
  { auto rr = __builtin_amdgcn_permlane32_swap(__float_as_uint(l_reg), __float_as_uint(l_reg), false, false); l_reg = __uint_as_float(rr[0]) + __uint_as_float(rr[1]); }
  if (hi == 0) li_l[r32] = l_reg; asm volatile("s_waitcnt lgkmcnt(0)" ::: "memory");
  float rli[16];
#pragma unroll
  for (int r = 0; r < 16; ++r) rli[r] = __builtin_amdgcn_rcpf(li_l[crow(r, hi)]);
  __syncthreads();
  LAS float* X = (LAS float*)(lds) + rg * 4096 + lane;
  if (comp == 1) {
#pragma unroll
    for (int d0 = 0; d0 < 4; ++d0)
#pragma unroll
      for (int r = 0; r < 16; ++r) X[(d0 * 16 + r) * 64] = o[d0][r] * rli[r] * lam;
  }
  __syncthreads();
  if (comp == 0) {
    float ss[16];
#pragma unroll
    for (int r = 0; r < 16; ++r) ss[r] = 0.f;
#pragma unroll
    for (int d0 = 0; d0 < 4; ++d0)
#pragma unroll
      for (int r = 0; r < 16; ++r) { const float v = o[d0][r] * rli[r] - X[(d0 * 16 + r) * 64]; o[d0][r] = v; ss[r] += v * v; }
#pragma unroll
    for (int r = 0; r < 16; ++r) { float s = ss[r]; s += __shfl_xor(s, 1); s += __shfl_xor(s, 2); s += __shfl_xor(s, 4); s += __shfl_xor(s, 8); s += __shfl_xor(s, 16);
      ss[r] = __builtin_amdgcn_rsqf(s * (1.0f / 128.0f) + EPS) * oscale; }
    bf16_t* Ow = Og + (size_t)(rg * 32) * LDP;
#pragma unroll
    for (int d0 = 0; d0 < 4; ++d0) { const float g = gsub[d0 * 32 + r32];
#pragma unroll
#ifdef PROBE_ZERO_ATTN
      for (int r = 0; r < 16; ++r) Ow[(size_t)crow(r, hi) * LDP + d0 * 32 + r32] = (bf16_t)0;
#else
      for (int r = 0; r < 16; ++r) Ow[(size_t)crow(r, hi) * LDP + d0 * 32 + r32] = (bf16_t)(cvt_pk_bf16(o[d0][r] * ss[r] * g, 0.f) & 0xffffu);
#endif
    }
  }
  __syncthreads();
}
}

#define XB_TMO      128
#define XB_XCNT(j)  (256  + 64 * (j))
#define XB_XSUB(j)  (1280 + 64 * (j))
#define XB_XGEN(j)  (2304 + 64 * (j))
#define XB_TOP      3328
#define XB_TOPGEN   3392
#define XCD_BAR_WORDS 3456
#define XB_SPIN_CAP (1u << 20)
__device__ __forceinline__ unsigned xb_ld(unsigned* p)              { return __hip_atomic_load(p, __ATOMIC_RELAXED, __HIP_MEMORY_SCOPE_AGENT); }
__device__ __forceinline__ unsigned xb_add(unsigned* p, unsigned v) { return __hip_atomic_fetch_add(p, v, __ATOMIC_RELAXED, __HIP_MEMORY_SCOPE_AGENT); }
__device__ __forceinline__ unsigned xb_xcc_id() { return (unsigned)__builtin_amdgcn_s_getreg((3 << 11) | 20) & 0xFu; }
#define XB_SPIN(cond, bar) do { unsigned _sp = 0; while (cond) { __builtin_amdgcn_s_sleep(1); \
    if ((++_sp & 255u) == 0u) { if (xb_ld(&(bar)[XB_TMO])) break; if (_sp > XB_SPIN_CAP) { atomicAdd(&(bar)[XB_TMO], 1u); break; } } } } while (0)
struct XcdBarrier { unsigned* bar; unsigned x; volatile LAS unsigned* st; };
__device__ __forceinline__ XcdBarrier xcd_barrier_post(unsigned* bar, volatile LAS unsigned* st) {
    XcdBarrier b; b.bar = bar; b.x = xb_xcc_id(); b.st = st;
    if (threadIdx.x == 0) (void)xb_add(&bar[XB_XCNT(b.x)], 1u);
    return b;
}
__device__ __forceinline__ void xcd_barrier_complete(unsigned* bar, unsigned x, unsigned& nloc, unsigned& nx) {
    const unsigned G = gridDim.x * gridDim.y * gridDim.z;
    unsigned sum, cnt, mine, sp = 0u;
    for (;;) {
        sum = 0u; cnt = 0u; mine = 0u;
#pragma unroll
        for (unsigned j = 0; j < 16; ++j) { const unsigned c = xb_ld(&bar[XB_XCNT(j)]); sum += c; cnt += (c > 0u) ? 1u : 0u; mine = (j == x) ? c : mine; }
        if (sum == G) break;
        __builtin_amdgcn_s_sleep(1);
        if ((++sp & 255u) == 0u) { if (xb_ld(&bar[XB_TMO])) break; if (sp > XB_SPIN_CAP) { atomicAdd(&bar[XB_TMO], 1u); break; } }
    }
    nloc = mine > 0u ? mine : 1u; nx = cnt > 0u ? cnt : 1u;
}
__device__ __forceinline__ void xcd_barrier(const XcdBarrier& b) {
    asm volatile("s_waitcnt vmcnt(0)" ::: "memory");
    __syncthreads();
    if (threadIdx.x == 0) {
        unsigned* bar = b.bar;
        __builtin_amdgcn_s_waitcnt(0);
        unsigned nloc = b.st[0], nx = b.st[1];
        if (nloc == 0u) { xcd_barrier_complete(bar, b.x, nloc, nx); b.st[0] = nloc; b.st[1] = nx; }
        const unsigned old = xb_add(&bar[XB_XSUB(b.x)], 1u);
        const unsigned gen = old / nloc;
        if (old + 1u == (gen + 1u) * nloc) {
            __builtin_amdgcn_fence(__ATOMIC_RELEASE, "agent");
            asm volatile("s_waitcnt vmcnt(0)" ::: "memory");
            const unsigned og = xb_add(&bar[XB_TOP], 1u);
            const unsigned tg = og / nx;
            if (og + 1u == (tg + 1u) * nx) xb_add(&bar[XB_TOPGEN], 1u);
            else XB_SPIN(xb_ld(&bar[XB_TOPGEN]) == tg, bar);
            __builtin_amdgcn_fence(__ATOMIC_ACQUIRE, "agent");
            xb_add(&bar[XB_XGEN(b.x)], 1u);
            asm volatile("s_waitcnt vmcnt(0)" ::: "memory");
        } else {
            XB_SPIN(xb_ld(&bar[XB_XGEN(b.x)]) == gen, bar);
            __builtin_amdgcn_fence(__ATOMIC_ACQUIRE, "agent");
            asm volatile("s_waitcnt vmcnt(0)" ::: "memory");
        }
    }
    __syncthreads();
}

#define LDS_WAIT() asm volatile("s_waitcnt lgkmcnt(0)" ::: "memory")
__device__ __forceinline__ float wave_sum(float v) {
#pragma unroll
    for (int o = 1; o < 64; o <<= 1) v += __shfl_xor(v, o);
    return v;
}
__device__ __forceinline__ void tr_item(const float* W, int K, int N, bf16_t* WT, const float* rs, const float* cs, int perm_limit, LAS float* scr, int item, int lane) {
    const int nblk = N / 32, kb = item / nblk, nb = item % nblk, k0 = 64 * kb, n0 = 32 * nb;
    const float csv = cs ? cs[n0 + (lane & 31)] : 1.f;
    float wv[32], rv[32];
#pragma unroll
    for (int i = 0; i < 32; ++i) { const int kk = 2 * i + (lane >> 5); wv[i] = W[(size_t)(k0 + kk) * N + n0 + (lane & 31)]; rv[i] = rs ? rs[k0 + kk] : 1.f; }
#pragma unroll
    for (int i = 0; i < 32; ++i) { const int kk = 2 * i + (lane >> 5); scr[kk * 33 + (lane & 31)] = wv[i] * rv[i] * csv; }
    LDS_WAIT(); asm volatile("" ::: "memory");
    int d0 = n0; if (n0 < perm_limit) { const int tile = n0 >> 8, lb = (n0 >> 5) & 7; d0 = (tile << 8) + ((4 * (lb & 1) + (lb >> 1)) << 5); }
    if (perm_limit < 0) { const int isv = n0 >= D_FF, ch = n0 - (isv ? D_FF : 0); d0 = (ch >> 7) * 256 + isv * 128 + (ch & 127); }
    const int c = lane & 7;
#pragma unroll
    for (int j = 0; j < 4; ++j) { const int n = (lane >> 3) + 8 * j; const LAS float* s = scr + (8 * c) * 33 + n;
        u32x4 o; o.x = cvt_pk_bf16(s[0 * 33], s[1 * 33]); o.y = cvt_pk_bf16(s[2 * 33], s[3 * 33]); o.z = cvt_pk_bf16(s[4 * 33], s[5 * 33]); o.w = cvt_pk_bf16(s[6 * 33], s[7 * 33]);
        *(u32x4*)(WT + (size_t)(d0 + n) * K + k0 + 8 * c) = o; }
    LDS_WAIT(); asm volatile("" ::: "memory");
}
__device__ __forceinline__ void norm_row(const float* xrow, bf16_t* orow, float* crow_, int lane) {
    f32x4 v[8]; float s = 0.f;
#pragma unroll
    for (int j = 0; j < 4; ++j) { v[2 * j] = *(const f32x4*)(xrow + j * 512 + lane * 8); v[2 * j + 1] = *(const f32x4*)(xrow + j * 512 + lane * 8 + 4); s += pg8::sumsq4(v[2 * j]) + pg8::sumsq4(v[2 * j + 1]); }
    const float rstd = __builtin_amdgcn_rsqf(wave_sum(s) * (1.0f / D_MODEL) + EPS);
#pragma unroll
    for (int j = 0; j < 4; ++j) { if (crow_) { *(f32x4*)(crow_ + j * 512 + lane * 8) = v[2 * j]; *(f32x4*)(crow_ + j * 512 + lane * 8 + 4) = v[2 * j + 1]; }
        *(u32x4*)(orow + j * 512 + lane * 8) = pg8::pack8(v[2 * j] * rstd, v[2 * j + 1] * rstd); }
}

__device__ __forceinline__ void raw_row(const float* xrow, bf16_t* orow, rss_t* ssq, int lane) {
    f32x4 v[8]; float s = 0.f;
#pragma unroll
    for (int j = 0; j < 4; ++j) { v[2 * j] = *(const f32x4*)(xrow + j * 512 + lane * 8); v[2 * j + 1] = *(const f32x4*)(xrow + j * 512 + lane * 8 + 4); s += pg8::sumsq4(v[2 * j]) + pg8::sumsq4(v[2 * j + 1]); }
    s = wave_sum(s); if (lane == 0) *ssq = ss_fix(s);
#pragma unroll
    for (int j = 0; j < 4; ++j) *(u32x4*)(orow + j * 512 + lane * 8) = pg8::pack8(v[2 * j], v[2 * j + 1]);
}

template <int WIN> __device__ __forceinline__ void pool_item(const bf16_t* U, bf16_t* ZP, int r0, int ch, bool big) {
    constexpr int NR = 3 + 2 * WIN, SM = WIN / 2;
    const int pos0 = tok_pos(r0), S = tok_seqlen(r0);
    u32x4 v[NR];
#pragma unroll
    for (int k = 0; k < NR; ++k) { const int p = pos0 - WIN + k; v[k] = (p >= 0 && p < S) ? *(const u32x4*)(U + (size_t)(r0 - WIN + k) * 1024 + ch) : (u32x4){0u, 0u, 0u, 0u}; }
    float sb[8], ss[8];
#pragma unroll
    for (int j = 0; j < 8; ++j) { sb[j] = 0.f; ss[j] = 0.f; }
#define POOL_ACC(dst, k, sgn) do { const u32x4 w_ = v[k]; dst[0] += sgn bflo(w_.x); dst[1] += sgn bfhi(w_.x); dst[2] += sgn bflo(w_.y); dst[3] += sgn bfhi(w_.y); dst[4] += sgn bflo(w_.z); dst[5] += sgn bfhi(w_.z); dst[6] += sgn bflo(w_.w); dst[7] += sgn bfhi(w_.w); } while (0)
#pragma unroll
    for (int k = 0; k < 2 * WIN; ++k) { POOL_ACC(sb, k, +); if (k >= WIN - SM && k < WIN + SM) POOL_ACC(ss, k, +); }
#pragma unroll
    for (int i = 0; i < 4; ++i) {
        if (i > 0) { POOL_ACC(sb, i + 2 * WIN - 1, +); POOL_ACC(sb, i - 1, -); POOL_ACC(ss, i + WIN + SM - 1, +); POOL_ACC(ss, i + WIN - SM - 1, -); }
        const int pos = pos0 + i, w2 = big ? WIN : SM; const int lo_ = pos - w2 < 0 ? 0 : pos - w2, hi_ = pos + w2 > S ? S : pos + w2; const float inv = 1.0f / (float)(hi_ - lo_);
        const u32x4 c = v[WIN + i]; float s[8];
#pragma unroll
        for (int j = 0; j < 8; ++j) s[j] = (big ? sb[j] : ss[j]) * inv;
        u32x4 o; o.x = cvt_pk_bf16(s[0] - bflo(c.x), s[1] - bfhi(c.x)); o.y = cvt_pk_bf16(s[2] - bflo(c.y), s[3] - bfhi(c.y)); o.z = cvt_pk_bf16(s[4] - bflo(c.z), s[5] - bfhi(c.z)); o.w = cvt_pk_bf16(s[6] - bflo(c.w), s[7] - bfhi(c.w));
        *(u32x4*)(ZP + (size_t)(r0 + i) * 1024 + ch) = o; }
#undef POOL_ACC
}

struct Args { const float* in[28]; float* out; unsigned char* ws; int ph_lo, ph_hi; };

__global__ void __launch_bounds__(NWAVES * 64, 2) trunk_fwd(Args args) {
    extern __shared__ __attribute__((aligned(16))) unsigned char lds_raw[];
    LAS unsigned char* lds = (LAS unsigned char*)lds_raw;
    volatile LAS unsigned* MISC = (volatile LAS unsigned*)(lds + MISC_OFF);
    for (int u = threadIdx.x; u < (LDS_BYTES - LDSCTL_OFF) / 4; u += NWAVES * 64) ((LAS unsigned*)(lds + LDSCTL_OFF))[u] = 0u;
    __syncthreads();
    const int lo = args.ph_lo, hi = args.ph_hi;
    XcdBarrier bar; bar.bar = (unsigned*)(args.ws + WS_CTL) + CW_BAR; bar.x = 0; bar.st = nullptr;
    if (hi - lo > 1) bar = xcd_barrier_post((unsigned*)(args.ws + WS_CTL) + CW_BAR, MISC + 8);
#define IN(k) ({ int lo_ = lo, hi_ = hi; asm volatile("" : "+s"(lo_), "+s"(hi_)); lo_ <= (k) && (k) < hi_; })
#define SEAM(k) do { if (IN(k) && IN((k) + 1)) { XcdBarrier b2_ = bar; asm volatile("" : "+s"(b2_.bar), "+s"(b2_.x)); xcd_barrier(b2_); } } while (0)
#define PHASE_BEGIN() int tid = threadIdx.x; asm volatile("" : "+v"(tid)); int zo = 0; asm volatile("" : "+s"(zo)); \
    const int lane = tid & 63, wave = __builtin_amdgcn_readfirstlane(tid >> 6); const int G = gridDim.x, bx = blockIdx.x; \
    const int vcu = (G % 8 == 0) ? (bx % 8) * (G / 8) + bx / 8 : bx; const int gw = vcu * NWAVES + wave, NGW = G * NWAVES; \
    unsigned char* ws = args.ws + zo; float* X = args.out + zo; (void)lane; (void)wave; (void)gw; (void)NGW; (void)ws; (void)X; (void)vcu; (void)tid
#define INP(i) (args.in[(i) + zo])
#define WSP(T, off) ((T*)(ws + (off)))

    for (int l = 0; l < DEPTH; ++l) {
        const int pb = l * PH_PER_LAYER;
        if (PH_EN(0) && IN(pb + 0)) {
            PHASE_BEGIN();
            LAS float* scr = (LAS float*)(lds + wave * 16384);
            constexpr int I_IN = 32 * 128, I_OUT = 32 * 64, I_CQ = 32 * 64, I_CKV = 32 * 128, I_CO = 32 * 64, I_UP = 32 * (UP_W / 32), I_DOWN = (D_FF / 64) * 64, I_P = 4 * 32;
            constexpr int NITEMS = I_IN + I_OUT + I_CQ + I_CKV + I_CO + I_UP + I_DOWN + I_P;
            for (int it = gw; it < NITEMS; it += NGW) {
                int r = it;
                if (r < I_UP) { tr_item(INP(24) + (size_t)l * 2048 * UP_W, 2048, UP_W, WSP(bf16_t, WS_WUP), INP(23) + l * 2048, nullptr, -1, scr, r, lane); continue; } r -= I_UP;
                if (r < I_DOWN) { tr_item(INP(27) + (size_t)l * D_FF * 2048, D_FF, 2048, WSP(bf16_t, WS_WDOWN), nullptr, nullptr, 0, scr, r, lane); continue; } r -= I_DOWN;
                if (r < I_IN) { tr_item(INP(5) + (size_t)l * 2048 * 4096, 2048, 4096, WSP(bf16_t, WS_WIN), INP(4) + l * 2048, nullptr, 2048, scr, r, lane); continue; } r -= I_IN;
                if (r < I_CKV) { tr_item(INP(19) + (size_t)l * 2048 * 4096, 2048, 4096, WSP(bf16_t, WS_WCKV), INP(17) + l * 2048, nullptr, 0, scr, r, lane); continue; } r -= I_CKV;
                if (r < I_OUT) { tr_item(INP(15) + (size_t)l * 2048 * 2048, 2048, 2048, WSP(bf16_t, WS_WOUT), nullptr, nullptr, 0, scr, r, lane); continue; } r -= I_OUT;
                if (r < I_CQ) { tr_item(INP(18) + (size_t)l * 2048 * 2048, 2048, 2048, WSP(bf16_t, WS_WCQ), INP(16) + l * 2048, nullptr, 0, scr, r, lane); continue; } r -= I_CQ;
                if (r < I_CO) { tr_item(INP(22) + (size_t)l * 2048 * 2048, 2048, 2048, WSP(bf16_t, WS_WCO), nullptr, nullptr, 0, scr, r, lane); continue; } r -= I_CO;
                { const int g = r >> 5; tr_item(INP(13) + (size_t)l * 4 * 65536 + (size_t)g * 65536, 256, 256, WSP(bf16_t, WS_WP) + (size_t)g * 65536, nullptr, INP(14) + l * 1024 + g * 256, 0, scr, r & 31, lane); }
            }
            { const float* cw = INP(25) + (size_t)l * 3 * UP_W; const float* cb = INP(26) + (size_t)l * UP_W; u32x4* cwt = WSP(u32x4, WS_CWT);
              for (int ch = vcu * 512 + tid; ch < D_FF; ch += G * 512) { u32x4 w;
                  w.x = cvt_pk_bf16(cw[ch], cw[UP_W + ch]); w.y = cvt_pk_bf16(cw[2 * UP_W + ch], cb[ch]); w.z = cvt_pk_bf16(cw[D_FF + ch], cw[UP_W + D_FF + ch]); w.w = cvt_pk_bf16(cw[2 * UP_W + D_FF + ch], cb[D_FF + ch]); cwt[ch] = w; } }
            bf16_t* HB = WSP(bf16_t, WS_HB);
            if (l == 0) {
                unsigned* csT = WSP(unsigned, WS_COS);
                for (int e = (vcu * 512 + tid); e < 8192 * 32; e += G * 512) { const int pos = e >> 5, i = e & 31;
                    double inv = 1.0; const double b = 0.74989420933245582730;
                    for (int k = 0; k < i; ++k) inv *= b;
                    double rev = (double)pos * inv * 0.15915494309189533577; rev -= __builtin_floor(rev);
                    const float fr_ = (float)rev;
                    const _Float16 hc = (_Float16)__builtin_amdgcn_cosf(fr_), hs = (_Float16)__builtin_amdgcn_sinf(fr_);
                    csT[e] = (unsigned)__builtin_bit_cast(unsigned short, hc) | ((unsigned)__builtin_bit_cast(unsigned short, hs) << 16); }
                bf16_t* MB = WSP(bf16_t, WS_MB);
                for (int m = gw; m < NMEMROWS; m += NGW) { const float* src = m < 1024 ? INP(2) + (size_t)m * 2048 : INP(3) + (size_t)(m - 1024) * 2048; norm_row(src, MB + (size_t)m * 2048, nullptr, lane); }
                rss_t* rss0 = WSP(rss_t, WS_ROWSS);
                for (int m = gw; m < NTOK; m += NGW) { const float* src = m < NTOK_P ? INP(0) + (size_t)m * 2048 : INP(1) + (size_t)(m - NTOK_P) * 2048; raw_row(src, HB + (size_t)m * 2048, rss0 + m, lane); }
            }
        }
        SEAM(pb + 0);
        if (PH_EN(1) && IN(pb + 1)) {
            PHASE_BEGIN(); pg8::StaticOrder SO;
            if (PH_EN(17)) { pg8::ProbSimple P; P.K = 2048; P.lda = 2048; P.ldb = 2048; P.tsplit = 1 << 30; P.adelta = 0; P.A = (const char*)WSP(bf16_t, WS_HB); P.B = (const char*)WSP(bf16_t, WS_WIN);
              SO.init(NTOK / 256, IN_W / 256, G, bx);
              pg8::EpiIn E{WSP(bf16_t, R_Q), (size_t)NTOK * 1024, WSP(const unsigned, WS_COS), INP(6) + l * 64, INP(7) + l * 64, WSP(const rss_t, WS_ROWSS) + (size_t)(l * 3 + 0) * NTOK};
              pg8::gemm_phase<pg8::ProbSimple, pg8::EpiIn, true, true>(lds, P, SO, E); }
            if (PH_EN(16)) { pg8::ProbSimple P; P.K = 2048; P.lda = 2048; P.ldb = 2048; P.tsplit = 1 << 30; P.adelta = 0; P.A = (const char*)WSP(bf16_t, WS_MB); P.B = (const char*)WSP(bf16_t, WS_WCKV);
              SO.init(NMEMROWS / 256, 4096 / 256, G, bx);
              pg8::EpiKV E{WSP(float, WS_KRAW), WSP(bf16_t, WS_VT)};
              pg8::gemm_phase<pg8::ProbSimple, pg8::EpiKV, true, true>(lds, P, SO, E); }
        }
        SEAM(pb + 1);
        if (PH_EN(2) && IN(pb + 2)) {
            if (PH_EN(14)) { PHASE_BEGIN(); const bf16_t* U = WSP(const bf16_t, R_U); bf16_t* ZP = (bf16_t*)X;
#ifdef PROBE_DOUBLE_PASSES
              int nrq = 2; asm volatile("" : "+s"(nrq)); for (int rq_ = 0; rq_ < nrq; ++rq_)
#endif
              for (int it = gw; it < (NTOK / 4) * 2; it += NGW) { const int r0 = (it >> 1) * 4, half = it & 1, ch = half * 512 + lane * 8;
                  if (half == 0) pool_item<2>(U, ZP, r0, ch, lane >= 32); else pool_item<8>(U, ZP, r0, ch, lane >= 32); } }
            if (PH_EN(15)) { PHASE_BEGIN(); const float* gcq = INP(20) + l * 512; const float* gck = INP(21) + l * 512; const float* KRAW = WSP(const float, WS_KRAW); bf16_t* KC = WSP(bf16_t, WS_KC);
              for (int it = gw; it < NMEMROWS * 4; it += NGW) { const int row = it >> 2, h = it & 3; const float* kr = KRAW + (size_t)row * 2048 + h * 512 + lane * 8;
                  const f32x4 a = *(const f32x4*)kr, b = *(const f32x4*)(kr + 4); const float ss = wave_sum(pg8::sumsq4(a) + pg8::sumsq4(b));
                  const float rk = __builtin_amdgcn_rsqf(ss * (1.0f / 512.0f) + EPS);
                  const f32x4 ga = *(const f32x4*)(gcq + lane * 8) * *(const f32x4*)(gck + lane * 8), gb = *(const f32x4*)(gcq + lane * 8 + 4) * *(const f32x4*)(gck + lane * 8 + 4);
                  *(u32x4*)(KC + (size_t)row * 2048 + h * 512 + lane * 8) = pg8::pack8(a * rk * ga, b * rk * gb); } }
            if (PH_EN(18)) {
              PHASE_BEGIN();
              const float lam_init = 0.8f - 0.6f * __expf(-0.3f * (float)l);
              float s1 = 0.f, s2 = 0.f; const float* q1 = INP(8) + l * 64; const float* k1 = INP(9) + l * 64; const float* q2 = INP(10) + l * 64; const float* k2 = INP(11) + l * 64;
              for (int i = 0; i < 64; ++i) { s1 += q1[i] * k1[i]; s2 += q2[i] * k2[i]; }
              const float lam = __expf(s1) - __expf(s2) + lam_init;
              const float* gsub = INP(12) + l * 128;
              bf16_t* Qb = WSP(bf16_t, R_Q); const bf16_t* Kb = WSP(const bf16_t, R_K); const bf16_t* Vb = WSP(const bf16_t, R_V);
              __syncthreads();
              { const int NX = (G % 8 == 0) ? 8 : 1, xcd = bx % NX, j = bx / NX, nb = G / NX, npr = 2048 / NX;
                  for (int kk = j; kk < 2 * npr; kk += nb) { int pair, qt, S; size_t t0;
                      if (kk < npr) { pair = xcd + NX * (kk >> 6); qt = kk & 63; S = S_P; t0 = (size_t)(pair >> 3) * S_P; }
                      else { const int k2_ = kk - npr; pair = xcd + NX * (k2_ >> 5); qt = k2_ & 31; S = S_S; t0 = (size_t)NTOK_P + (size_t)(pair >> 3) * S_S; }
                      const int h = pair & 7; bf16_t* qp = Qb + (t0 + (size_t)qt * 128) * 1024 + h * 128;
                      att::attn_unit(qp, Kb + t0 * 1024 + h * 128, Vb + t0 * 1024 + h * 128, qp, S, lam, gsub, 1.f - lam_init, lds); }
              }
            }
        }
        SEAM(pb + 2);
        if (PH_EN(3) && IN(pb + 3)) {
            PHASE_BEGIN(); pg8::StaticOrder SO;
            pg8::ProbPool P; P.K = 256; P.lda = 1024; P.ldb = 256; P.tsplit = 1 << 30; P.adelta = 0; P.A = (const char*)X; P.B = (const char*)WSP(bf16_t, WS_WP);
            SO.init(NTOK / 256, 4, G, bx);
            pg8::EpiBf<0> E{WSP(bf16_t, R_POUT), 1024, nullptr, nullptr, nullptr};
            pg8::gemm_phase<pg8::ProbPool, pg8::EpiBf<0>, true, true>(lds, P, SO, E);
            { pg8::ProbVW P2; P2.K = 512; P2.lda = 2048; P2.ldb = 2048; P2.tsplit = 1 << 30; P2.adelta = 0; P2.A = (const char*)WSP(bf16_t, WS_WCO); P2.B = (const char*)WSP(bf16_t, WS_VT);
              SO.init(8, 48, G, bx);
              pg8::EpiBf<5> E2{WSP(bf16_t, R_VW), 1024, nullptr, nullptr, nullptr};
              pg8::gemm_phase<pg8::ProbVW, pg8::EpiBf<5>, true, true>(lds, P2, SO, E2); }
#ifdef PROBE_DOUBLE_ATTN
            {
              const float* gsub = INP(12) + l * 128; bf16_t* Qb = WSP(bf16_t, R_Q); const bf16_t* Kb = WSP(const bf16_t, R_K); const bf16_t* Vb = WSP(const bf16_t, R_V); bf16_t* Ob = WSP(bf16_t, R_U);
              __syncthreads();
              const int NX = (G % 8 == 0) ? 8 : 1, xcd = bx % NX, j = bx / NX, nb = G / NX, npr = 2048 / NX;
              for (int kk = j; kk < 2 * npr; kk += nb) { int pair, qt, S; size_t t0;
                  if (kk < npr) { pair = xcd + NX * (kk >> 6); qt = kk & 63; S = S_P; t0 = (size_t)(pair >> 3) * S_P; }
                  else { const int k2_ = kk - npr; pair = xcd + NX * (k2_ >> 5); qt = k2_ & 31; S = S_S; t0 = (size_t)NTOK_P + (size_t)(pair >> 3) * S_S; }
                  const int h = pair & 7; const size_t qo = (t0 + (size_t)qt * 128) * 1024 + h * 128;
                  att::attn_unit(Qb + qo, Kb + t0 * 1024 + h * 128, Vb + t0 * 1024 + h * 128, Ob + qo, S, 0.3f, gsub, 1.f, lds); }
            }
#endif
        }
        SEAM(pb + 3);
        if (PH_EN(4) && IN(pb + 4)) {
            PHASE_BEGIN(); pg8::StaticOrder SO;
            pg8::ProbSimple P; P.K = 2048; P.lda = 1024; P.ldb = 2048; P.tsplit = 16; P.adelta = (long long)R_POUT - (long long)R_Q - 16ll * 128; P.A = (const char*)(ws + R_Q); P.B = (const char*)WSP(bf16_t, WS_WOUT);
            SO.init(NTOK / 256, 8, G, bx);
            pg8::EpiRes E{WSP(bf16_t, WS_HB), WSP(rss_t, WS_ROWSS) + (size_t)(l * 3 + 1) * NTOK, nullptr};
            pg8::gemm_phase<pg8::ProbSimple, pg8::EpiRes, true, true>(lds, P, SO, E);
        }
        SEAM(pb + 4);
        if (PH_EN(5) && IN(pb + 5)) {
            PHASE_BEGIN(); pg8::StaticOrder SO;
            pg8::ProbSimple P; P.K = 2048; P.lda = 2048; P.ldb = 2048; P.tsplit = 1 << 30; P.adelta = 0; P.A = (const char*)WSP(bf16_t, WS_HB); P.B = (const char*)WSP(bf16_t, WS_WCQ);
            SO.init(NTOK / 256, 8, G, bx);
            pg8::EpiBf<1> E{WSP(bf16_t, R_QC), 2048, WSP(float, WS_QSS), (float*)(WSP(rss_t, WS_ROWSS) + (size_t)(l * 3 + 1) * NTOK), nullptr};
            pg8::gemm_phase<pg8::ProbSimple, pg8::EpiBf<1>, true, true>(lds, P, SO, E);
        }
        SEAM(pb + 5);
        if (PH_EN(6) && IN(pb + 6)) {
            PHASE_BEGIN(); pg8::StaticOrder SO;
            pg8::ProbScores P; P.K = 512; P.lda = 2048; P.ldb = 2048; P.tsplit = 1 << 30; P.adelta = 0; P.A = (const char*)(ws + R_QC); P.B = (const char*)WSP(bf16_t, WS_KC);
            SO.init(NTOK / 256, 4, G, bx);
            pg8::EpiBf<2> E{WSP(bf16_t, R_P), 1024, WSP(float, WS_QSS), nullptr, (LAS float*)(lds + XCH_OFF)};
            pg8::gemm_phase<pg8::ProbScores, pg8::EpiBf<2>, true, true>(lds, P, SO, E);
        }
        SEAM(pb + 6);
        if (PH_EN(8) && IN(pb + 7)) {
            PHASE_BEGIN(); pg8::StaticOrder SO;
            pg8::ProbFin P; P.K = 1024; P.lda = 1024; P.ldb = 1024; P.tsplit = 1 << 30; P.adelta = 0; P.A = (const char*)(ws + R_P); P.B = (const char*)WSP(bf16_t, R_VW);
            SO.init(NTOK / 256, 8, G, bx);
            pg8::EpiRes E{WSP(bf16_t, WS_HB), WSP(rss_t, WS_ROWSS) + (size_t)(l * 3 + 2) * NTOK, nullptr};
            pg8::gemm_phase<pg8::ProbFin, pg8::EpiRes, true, true>(lds, P, SO, E);
        }
        SEAM(pb + 7);
        for (int c = 0; c < N_FFN_CHUNKS; ++c) {
            const int pc = pb + 8 + 2 * c; const size_t r0 = (size_t)c * FFN_CHUNK;
            if (PH_EN(11) && IN(pc)) {
                PHASE_BEGIN(); pg8::StaticOrder SO;
                pg8::ProbUp P; P.K = 2048; P.lda = 2048; P.ldb = 2048; P.tsplit = 1 << 30; P.adelta = 0; P.A = (const char*)(WSP(bf16_t, WS_HB) + r0 * 2048); P.B = (const char*)WSP(bf16_t, WS_WUP); P.chunk = c;
                SO.init(FFN_MT + FFN_BT, D_FF / 128, G, bx);
                pg8::EpiGlu E{WSP(bf16_t, R_G), WSP(const rss_t, WS_ROWSS) + (size_t)(l * 3 + 2) * NTOK + r0, WSP(const u32x4, WS_CWT), c, (LAS float*)(lds + GLX_OFF)};
                pg8::gemm_phase<pg8::ProbUp, pg8::EpiGlu, true, true>(lds, P, SO, E);
            }
            SEAM(pc);
            if (PH_EN(13) && IN(pc + 1)) {
                PHASE_BEGIN(); pg8::StaticOrder SO;
                pg8::ProbSimple P; P.K = D_FF; P.lda = D_FF; P.ldb = D_FF; P.tsplit = 1 << 30; P.adelta = 0; P.A = (const char*)(ws + R_G); P.B = (const char*)WSP(bf16_t, WS_WDOWN);
                SO.init(FFN_MT, 8, G, bx);
                pg8::EpiRes E{WSP(bf16_t, WS_HB) + r0 * 2048, (l + 1 < DEPTH) ? WSP(rss_t, WS_ROWSS) + (size_t)((l + 1) * 3 + 0) * NTOK + r0 : nullptr, (l + 1 < DEPTH) ? nullptr : X + r0 * 2048};
                pg8::gemm_phase<pg8::ProbSimple, pg8::EpiRes, true, true>(lds, P, SO, E);
            }
            SEAM(pc + 1);
        }
    }
#undef IN
#undef SEAM
#undef PHASE_BEGIN
#undef INP
#undef WSP
}


#ifdef SELFCHECK
constexpr int CHK_WORD = 1024;
__device__ __forceinline__ void chk_upd(unsigned* ctl, int idx, float got, float ref) { const float e = fabsf(got - ref) / (0.03f * fabsf(ref) + 0.03f); atomicMax(ctl + CHK_WORD + idx, __float_as_uint(e)); }
__device__ __forceinline__ int chk_token(int s) { const int tab[16] = {0, 1, 127, 128, 4095, 8191, 8192, 12345, 32767, 32768, 32769, 36863, 36864, 50000, 65534, 65535}; int t = 0;
#pragma unroll
    for (int i = 0; i < 16; ++i) t = (s & 15) == i ? tab[i] : t; return t; }
__global__ void __launch_bounds__(64) check_kernel(Args args, int after, int l) {
    const int s = blockIdx.x, lane = threadIdx.x; unsigned char* ws = args.ws; unsigned* ctl = (unsigned*)(ws + WS_CTL);
    const int tok = chk_token(s); float* X = args.out;
    const float* xin = tok < NTOK_P ? args.in[0] + (size_t)tok * 2048 : args.in[1] + (size_t)(tok - NTOK_P) * 2048;
    if (after == 1) {
        if (l == 0) {
            float ssx = 0.f; for (int k = lane; k < 2048; k += 64) ssx += xin[k] * xin[k]; ssx = wave_sum(ssx); const float rstd = 1.0f / sqrtf(ssx / 2048.f + EPS);
            const int vec = (s * 7) & 31, isk = vec >> 4, hc = vec & 15;
            const float* w_in = args.in[5]; const float* g_mix = args.in[4]; const int col = isk * 1024 + hc * 64 + lane;
            float z = 0.f; for (int k = 0; k < 2048; ++k) z += xin[k] * rstd * g_mix[k] * w_in[(size_t)k * 4096 + col];
            const float ss = wave_sum(z * z); const float g = (isk ? args.in[7] : args.in[6])[lane]; const float zn = z / sqrtf(ss / 64.f + EPS) * g;
            const float other = __shfl_xor(zn, 32); const int i = lane & 31; const int pos = tok_pos(tok);
            const float ang = (float)pos * powf(10000.f, -(float)i / 32.f); const float c = cosf(ang), sn = sinf(ang);
            const float ref = lane < 32 ? zn * c - other * sn : zn * c + other * sn;
            const bf16_t* Q = (const bf16_t*)(ws + (isk ? R_K : R_Q)); const float got = bf2f(Q[(size_t)tok * 1024 + hc * 64 + lane]);
            const float gother = __shfl_xor(got, 32);
            (void)gother; chk_upd(ctl, 0, got, ref);
            { const unsigned tv = ((const unsigned*)(ws + WS_COS))[pos * 32 + i]; typedef _Float16 h2 __attribute__((ext_vector_type(2))); const h2 hv = __builtin_bit_cast(h2, tv);
              chk_upd(ctl, 1, (float)hv.x, c); chk_upd(ctl, 1, (float)hv.y, sn); }
        }
        { const bf16_t* Q = (const bf16_t*)(ws + R_Q); bf16_t* sv = (bf16_t*)(ws + WS_CHK) + s * 128; const int h = s & 7; sv[lane] = Q[(size_t)tok * 1024 + h * 128 + lane]; sv[lane + 64] = Q[(size_t)tok * 1024 + h * 128 + 64 + lane]; }
    }
    if (after == 2) {
        const int h = s & 7; const bf16_t* sv = (const bf16_t*)(ws + WS_CHK) + s * 128; const int S = tok_seqlen(tok); const size_t t0 = (size_t)tok - tok_pos(tok);
        const bf16_t* K = (const bf16_t*)(ws + R_K) + t0 * 1024 + h * 128; const bf16_t* V = (const bf16_t*)(ws + R_V) + t0 * 1024 + h * 128;
        const float lam_init = 0.8f - 0.6f * expf(-0.3f * (float)l); float s1 = 0.f, s2 = 0.f;
        for (int i = 0; i < 64; ++i) { s1 += (args.in[8] + l * 64)[i] * (args.in[9] + l * 64)[i]; s2 += (args.in[10] + l * 64)[i] * (args.in[11] + l * 64)[i]; }
        const float lam = expf(s1) - expf(s2) + lam_init;
        float o[2][2];
        for (int c = 0; c < 2; ++c) { float mx = -1e30f;
            for (int k = lane; k < S; k += 64) { float d = 0.f; for (int e = 0; e < 64; ++e) d += bf2f(sv[c * 64 + e]) * bf2f(K[(size_t)k * 1024 + c * 64 + e]); mx = fmaxf(mx, d); }
            for (int o_ = 1; o_ < 64; o_ <<= 1) mx = fmaxf(mx, __shfl_xor(mx, o_));
            float lsum = 0.f, a0 = 0.f, a1 = 0.f;
            for (int k = 0; k < S; ++k) { float d = 0.f; for (int e = 0; e < 64; ++e) d += bf2f(sv[c * 64 + e]) * bf2f(K[(size_t)k * 1024 + c * 64 + e]);
                const float p = exp2f(d - mx); lsum += p; a0 += p * bf2f(V[(size_t)k * 1024 + lane]); a1 += p * bf2f(V[(size_t)k * 1024 + 64 + lane]); }
            o[c][0] = a0 / lsum; o[c][1] = a1 / lsum; }
        const float v0 = o[0][0] - lam * o[1][0], v1 = o[0][1] - lam * o[1][1]; const float ss = wave_sum(v0 * v0 + v1 * v1); const float rn = 1.0f / sqrtf(ss / 128.f + EPS) * (1.f - lam_init);
        const float* gsub = args.in[12] + l * 128; const bf16_t* A = (const bf16_t*)(ws + R_Q) + (size_t)tok * 1024 + h * 128;
        chk_upd(ctl, 2, bf2f(A[lane]), v0 * rn * gsub[lane]); chk_upd(ctl, 2, bf2f(A[64 + lane]), v1 * rn * gsub[64 + lane]);
    }
    if (after == 4 && l == 0) {
        const bf16_t* A = (const bf16_t*)(ws + R_Q) + (size_t)tok * 1024; const bf16_t* Pp = (const bf16_t*)(ws + R_POUT) + (size_t)tok * 1024; const float* w_out = args.in[15];
        const int col = (s * 131 + lane * 17) & 2047; float z = xin[col];
        for (int k = 0; k < 1024; ++k) z += bf2f(A[k]) * w_out[(size_t)k * 2048 + col];
        for (int k = 0; k < 1024; ++k) z += bf2f(Pp[k]) * w_out[(size_t)(1024 + k) * 2048 + col];
        chk_upd(ctl, 3, X[(size_t)tok * 2048 + col], z);
    }
    if (after == 8 && tok < FFN_CHUNK) {
        const bf16_t* HB = (const bf16_t*)(ws + WS_HB); const float* w_up = args.in[24] + (size_t)l * 2048 * UP_W; const float* g_ffn = args.in[23] + l * 2048;
        const float* cw = args.in[25] + (size_t)l * 3 * UP_W; const float* cb = args.in[26] + (size_t)l * UP_W;
        const int j = (s * 977 + lane * 53) % D_FF; const int pos = tok_pos(tok), S = tok_seqlen(tok); float u2[2];
        for (int half = 0; half < 2; ++half) { const int col = half * D_FF + j; float acc = cb[col];
            for (int tap = 0; tap < 3; ++tap) { const int pp = pos + tap - 1; if (pp < 0 || pp >= S) continue; const bf16_t* hr = HB + (size_t)(tok + tap - 1) * 2048; float d = 0.f;
                for (int k = 0; k < 2048; ++k) d += bf2f(hr[k]) * g_ffn[k] * w_up[(size_t)k * UP_W + col];
                const float rxx = ss_rstd(((const rss_t*)(ws + WS_ROWSS))[(size_t)(l * 3 + 2) * NTOK + tok + tap - 1]); acc += d * rxx * cw[(size_t)tap * UP_W + col]; }
            u2[half] = acc; }
        const float x = u2[0]; const float ref = 0.5f * x * (1.f + tanhf(0.7978845608028654f * (x + 0.044715f * x * x * x))) * u2[1];
        chk_upd(ctl, 4, bf2f(((const bf16_t*)(ws + R_G))[(size_t)tok * D_FF + j]), ref);
    }
    if (false) {
        const bf16_t* Gr = (const bf16_t*)(ws + R_G) + (size_t)tok * D_FF; const float* w_down = args.in[27] + (size_t)l * D_FF * 2048; const float* svx = (const float*)(ws + WS_CHK + 65536) + (size_t)s * 2048;
        const int col = (s * 131 + lane * 17) & 2047; float z = svx[col]; for (int k = 0; k < D_FF; ++k) z += bf2f(Gr[k]) * w_down[(size_t)k * 2048 + col];
        chk_upd(ctl, 5, X[(size_t)tok * 2048 + col], z);
    }
}
__global__ void __launch_bounds__(256) report_kernel(Args args) {
    unsigned* ctl = (unsigned*)(args.ws + WS_CTL); float* out = args.out;
    for (size_t i = (size_t)blockIdx.x * 256 + threadIdx.x; i < (size_t)NTOK * 2048; i += (size_t)gridDim.x * 256) {
        float v = 0.f;
        if (i == 0) { int mask = 0; for (int b = 0; b < 6; ++b) if (__uint_as_float(ctl[CHK_WORD + b]) > 1.0f) mask |= 1 << b; v = (10.f + (float)mask) * 1000.f; }
        out[i] = v; }
}
#endif

extern "C" void kernel_launch(void* const* d_in, const int* in_sizes, int n_in, void* d_out, int out_size, void* d_ws, size_t ws_size, hipStream_t stream) {
    static int grid = 0;
    if (grid == 0) {
        if (n_in != 28 || out_size != NTOK * D_MODEL || ws_size < WS_END) { fprintf(stderr, "kernel_launch: unexpected shapes: n_in %d out %d ws %zu (need >= %zu)\n", n_in, out_size, ws_size, (size_t)WS_END); grid = -1; return; }
        int dev = 0, cus = 0, per_cu = 0;
        if (hipGetDevice(&dev) != hipSuccess || hipDeviceGetAttribute(&cus, hipDeviceAttributeMultiprocessorCount, dev) != hipSuccess) { grid = -1; return; }
        if (hipFuncSetAttribute((const void*)trunk_fwd, hipFuncAttributeMaxDynamicSharedMemorySize, LDS_BYTES) != hipSuccess) { fprintf(stderr, "kernel_launch: hipFuncSetAttribute failed\n"); grid = -1; return; }
        if (hipOccupancyMaxActiveBlocksPerMultiprocessor(&per_cu, (const void*)trunk_fwd, NWAVES * 64, LDS_BYTES) != hipSuccess || per_cu < 1)
            fprintf(stderr, "kernel_launch: occupancy query reports %d workgroups per CU\n", per_cu);
        (void)hipGetLastError();
        grid = cus;
    }
    if (grid < 0) return;
    (void)hipMemsetAsync((char*)d_ws + WS_CTL, 0, CTL_ZERO_BYTES, stream);
    Args a{};
    for (int i = 0; i < 28; ++i) a.in[i] = (const float*)d_in[i];
    a.out = (float*)d_out; a.ws = (unsigned char*)d_ws;
#if ML_PER_PHASE
    for (int p = 0; p < N_PHASES; ++p) { a.ph_lo = p; a.ph_hi = p + 1; hipLaunchKernelGGL(trunk_fwd, dim3(grid), dim3(NWAVES * 64), LDS_BYTES, stream, a);
#ifdef SELFCHECK
        { const int l = p / PH_PER_LAYER, q = p % PH_PER_LAYER; if (l == SELFCHECK_LAYER && (q == 1 || q == 2 || q == 8)) hipLaunchKernelGGL(check_kernel, dim3(64), dim3(64), 0, stream, a, q, l); }
#endif
    }
#ifdef SELFCHECK
    hipLaunchKernelGGL(report_kernel, dim3(2048), dim3(256), 0, stream, a);
#endif
#else
    a.ph_lo = 0; a.ph_hi = N_PHASES;
    hipLaunchKernelGGL(trunk_fwd, dim3(grid), dim3(NWAVES * 64), LDS_BYTES, stream, a);
#endif
    const hipError_t le = hipPeekAtLastError();
    if (le != hipSuccess) fprintf(stderr, "kernel_launch: launch failed: %s\n", hipGetErrorName(le));
}
```

```cpp
#include <hip/hip_runtime.h>
#include <cstdio>
#include <cstdint>

#define SELFCHECK_LAYER 0
#ifndef ML_PER_PHASE
#define ML_PER_PHASE 0
#endif

#ifndef PHASE_MASK
#define PHASE_MASK 0xFFFFFFFFu
#endif
#define PH_EN(p) (((PHASE_MASK) >> (p)) & 1u)
#define LAS __attribute__((address_space(3)))
#define GAS __attribute__((address_space(1)))
typedef unsigned short bf16_t;
typedef short bf16x8 __attribute__((ext_vector_type(8)));
typedef short s16x4 __attribute__((ext_vector_type(4)));
typedef float f32x4 __attribute__((ext_vector_type(4)));
typedef float f32x2 __attribute__((ext_vector_type(2)));
typedef float f32x16 __attribute__((ext_vector_type(16)));
typedef unsigned u32x4 __attribute__((ext_vector_type(4)));
typedef unsigned u32x2 __attribute__((ext_vector_type(2)));

constexpr int D_MODEL = 2048, DEPTH = 2;
constexpr int NTOK = 65536;
constexpr int NTOK_P = 32768;
constexpr int S_P = 8192, S_S = 4096;
constexpr int NMEMROWS = 3072;
constexpr int IN_W = 4096, D_FF = 5632, UP_W = 11264;
constexpr float EPS = 1e-6f;
constexpr float QSCALE = 0.125f * 1.4426950408889634f;
constexpr int FFN_CHUNK = 32768, N_FFN_CHUNKS = 2;
constexpr int FFN_MT = FFN_CHUNK / 256, FFN_BT = 2;
constexpr int PH_PER_LAYER = 8 + 2 * N_FFN_CHUNKS;
constexpr int N_PHASES = DEPTH * PH_PER_LAYER;

constexpr size_t MiB = 1u << 20;
constexpr size_t WS_CTL = 0, CTL_ZERO_BYTES = 5 * MiB;
constexpr size_t WS_ROWSS = 1 * MiB;
constexpr size_t WS_COS = 5 * MiB;
constexpr size_t WS_QSS = 6 * MiB;
constexpr size_t WS_LPART = 14 * MiB;
constexpr size_t WS_MB = 18 * MiB;
constexpr size_t WS_KRAW = 30 * MiB;
constexpr size_t WS_KC = 54 * MiB;
constexpr size_t WS_VT = 66 * MiB;
constexpr size_t WS_CHK = 78 * MiB;
constexpr size_t WS_WIN = 79 * MiB, WS_WP = 95 * MiB, WS_WOUT = 96 * MiB, WS_WCQ = 104 * MiB, WS_WCKV = 112 * MiB, WS_WCO = 128 * MiB, WS_WUP = 136 * MiB, WS_WDOWN = 180 * MiB;
constexpr size_t WS_HB = 203 * MiB;
constexpr size_t WS_R = 459 * MiB;
constexpr size_t WS_CWT = 987 * MiB;
constexpr size_t WS_END = 988 * MiB;
typedef unsigned long long rss_t;
__device__ __forceinline__ rss_t ss_fix(float s) { return (rss_t)(s * 1048576.0f + 0.5f); }
__device__ __forceinline__ float ss_rstd(rss_t v) { return __builtin_amdgcn_rsqf((float)v * (1.0f / (1048576.0f * 2048.0f)) + 1e-6f); }
constexpr size_t R_Q = WS_R, R_K = WS_R + 128 * MiB, R_V = WS_R + 256 * MiB, R_U = WS_R + 384 * MiB;
constexpr size_t R_QC = WS_R, R_P = WS_R + 256 * MiB, R_VW = WS_R + 384 * MiB;
constexpr size_t R_G = WS_R;
constexpr size_t R_POUT = WS_R + 128 * MiB;
static_assert(R_G + (size_t)FFN_CHUNK * D_FF * 2 <= WS_END, "ws map");
constexpr int CW_BAR = 4096;

constexpr int RING_BYTES = 131072;
constexpr int LDSCTL_OFF = RING_BYTES, MISC_OFF = LDSCTL_OFF + 320, XCH_OFF = LDSCTL_OFF + 1024, GLX_OFF = XCH_OFF + 4096;
constexpr int LDS_BYTES = 151552;
constexpr int NWAVES = 8;

__device__ __forceinline__ unsigned cvt_pk_bf16(float lo, float hi) { unsigned r; asm volatile("v_cvt_pk_bf16_f32 %0, %1, %2" : "=v"(r) : "v"(lo), "v"(hi)); return r; }
__device__ __forceinline__ float bf2f(unsigned short b) { return __uint_as_float(((unsigned)b) << 16); }
__device__ __forceinline__ float bflo(unsigned w) { return __uint_as_float(w << 16); }
__device__ __forceinline__ float bfhi(unsigned w) { return __uint_as_float(w & 0xffff0000u); }
__device__ __forceinline__ int tok_pos(int row) { return row < NTOK_P ? (row & (S_P - 1)) : (row & (S_S - 1)); }
__device__ __forceinline__ int tok_seqlen(int row) { return row < NTOK_P ? S_P : S_S; }
__device__ __forceinline__ int tile_batch(int pm) { return pm < 128 ? (pm >> 5) : 4 + ((pm - 128) >> 4); }

namespace pg8 {
constexpr int BM = 256, BK = 64, HALF = 128, HTB = HALF * BK * 2, STAGE_BYTES = 8 * HTB, NXCD = 8, WGM = 4;
__host__ __device__ __forceinline__ int lds_byte(int r, int c) { const int st = (r >> 4) * 2 + (c >> 5), rr = r & 15, cc = c & 31, ob = rr * 64 + cc * 2; return st * 1024 + (ob ^ (((ob >> 9) & 1) << 5)); }
__host__ __device__ __forceinline__ void stage_rc(int b, int& R, int& C) { const int st = b / 1024, sb = b % 1024, swz = sb ^ (((sb >> 9) & 1) << 5); R = (st >> 1) * 16 + swz / 64; C = (st & 1) * 32 + (swz % 64) / 2; }
__host__ __device__ __forceinline__ int perm32(int rho) { const int n = rho >> 4, i = rho & 15; return 8 * (i >> 2) + 4 * n + (i & 3); }
struct Unit { int pm, pn; };
struct StaticOrder {
    int nM, nN, nwg, G, c;
    __host__ __device__ void init(int nM_, int nN_, int G_, int c_) { nM = nM_; nN = nN_; nwg = nM * nN; G = G_; c = c_; }
    __host__ __device__ bool next(int i, Unit& u) const {
        const long L = (long)i * G + c; if (L >= nwg) return false;
        int wgid = (int)L; { const int q = nwg / NXCD, r = nwg % NXCD, xcd = wgid % NXCD, off = wgid / NXCD; wgid = (xcd < r ? xcd * (q + 1) : r * (q + 1) + (xcd - r) * q) + off; }
        const int nig = WGM * nN, gid = wgid / nig, fm = gid * WGM, gsz = (nM - fm) < WGM ? (nM - fm) : WGM;
        u.pm = fm + ((wgid % nig) % gsz); u.pn = (wgid % nig) / gsz; return true;
    }
};
struct ProbBase { static constexpr bool GATHER = false; int K, lda, ldb, tsplit; long long adelta; __device__ __forceinline__ unsigned rowoff(const Unit&, int) const { return 0u; } };

template <class Prob, class Epi, bool ALIGN_EPI, bool SP2>
__device__ __forceinline__ void gemm_phase(LAS unsigned char* lds, const Prob& P, const StaticOrder& S, const Epi& E) {
    static_assert(SP2, "only the two-super-phase loop is kept in this file");
    int tid_l = threadIdx.x; asm volatile("" : "+v"(tid_l));
    const int tid = tid_l, wid = __builtin_amdgcn_readfirstlane(tid >> 6), lane = tid & 63, wr = wid >> 2, wc = wid & 3, fr = lane & 15, fq = lane >> 4;
    const int K = P.K, nt = K / BK, lda = P.lda, ldb = P.ldb, tsplit = P.tsplit; const long long adelta = P.adelta;
    unsigned voffA[2], voffB[2];
#pragma unroll
    for (int i = 0; i < 2; ++i) { int R, C; stage_rc(tid * 16 + i * 8192, R, C); const int Rb = Epi::PERM ? ((R & ~31) + perm32(R & 31)) : R;
        voffA[i] = (unsigned)(R * lda + C) * 2u; voffB[i] = (unsigned)(Rb * ldb + C) * 2u; }
    const size_t kstep = (size_t)(BK * 2);
    const size_t hstepA = (size_t)HALF * lda * 2, hstepB = (size_t)HALF * ldb * 2;
    const unsigned ldsw = (unsigned)wid * 1024u;
    const int aoff = lds_byte(wr * 64 + fr, fq * 8), boff = lds_byte(wc * 32 + fr, fq * 8);
    unsigned vAc[2][2], vAn[2][2];
#define PG8_SA(b, h) (((b) * 2 + (h)) * HTB)
#define PG8_SB(b, h) ((4 + (b) * 2 + (h)) * HTB)
#define PG8_STAGE(bufoff, gbase, voff) do { _Pragma("unroll") for (int _i = 0; _i < 2; ++_i) \
        __builtin_amdgcn_global_load_lds((const unsigned*)((const char*)(gbase) + (voff)[_i]), (LAS unsigned*)(lds + (bufoff) + ldsw + _i * 8192), 16, 0, 0); } while (0)
#define PG8_STAGE_A(bufoff, kptr, h, NXT) do { if constexpr (Prob::GATHER) { _Pragma("unroll") for (int _i = 0; _i < 2; ++_i) \
        __builtin_amdgcn_global_load_lds((const unsigned*)((const char*)(kptr) + ((NXT) ? vAn[h][_i] : vAc[h][_i])), (LAS unsigned*)(lds + (bufoff) + ldsw + _i * 8192), 16, 0, 0); } \
        else { PG8_STAGE(bufoff, (kptr) + (h) * hstepA, voffA); } } while (0)
#define PG8_GATHER_OFFS(dst, unit) do { _Pragma("unroll") for (int _i = 0; _i < 2; ++_i) { int _R, _C; stage_rc(tid * 16 + _i * 8192, _R, _C); _Pragma("unroll") for (int _h = 0; _h < 2; ++_h) dst[_h][_i] = P.rowoff(unit, _R + 128 * _h) + (unsigned)_C * 2u; } } while (0)
#define PG8_LDA(dst, b, h) do { _Pragma("unroll") for (int m = 0; m < 4; ++m) _Pragma("unroll") for (int k = 0; k < 2; ++k) dst[m][k] = *(const LAS bf16x8*)(lds + PG8_SA(b, h) + aoff + m * 2048 + k * 1024); } while (0)
#define PG8_LDB(dst, b, h) do { _Pragma("unroll") for (int n = 0; n < 2; ++n) _Pragma("unroll") for (int k = 0; k < 2; ++k) dst[n][k] = *(const LAS bf16x8*)(lds + PG8_SB(b, h) + boff + n * 2048 + k * 1024); } while (0)
#define PG8_MMA(ai, bj, At, Bt) do { __builtin_amdgcn_s_setprio(1); _Pragma("unroll") for (int m = 0; m < 4; ++m) _Pragma("unroll") for (int n = 0; n < 2; ++n) _Pragma("unroll") for (int k = 0; k < 2; ++k) \
        acc[ai][bj][m][n] = __builtin_amdgcn_mfma_f32_16x16x32_bf16(Bt[n][k], At[m][k], acc[ai][bj][m][n], 0, 0, 0); __builtin_amdgcn_s_setprio(0); } while (0)
#define PG8_WAIT_V(n) asm volatile("s_waitcnt vmcnt(" #n ")" ::: "memory")
#define PG8_WAIT_L(n) asm volatile("s_waitcnt lgkmcnt(" #n ")" ::: "memory")
#define PG8_BAR __builtin_amdgcn_s_barrier()
#define PG8_SCHED __builtin_amdgcn_sched_barrier(0)
#define PG8_AK(base, t) ((base) + (size_t)(t) * kstep + (((t) >= tsplit) ? adelta : 0ll))
    Unit cur, nxt; int ui = 0;
    if (!S.next(0, cur)) return;
    f32x4 acc[2][2][4][2];
#pragma unroll
    for (int a = 0; a < 2; ++a)
#pragma unroll
        for (int b = 0; b < 2; ++b)
#pragma unroll
            for (int m = 0; m < 4; ++m)
#pragma unroll
                for (int n = 0; n < 2; ++n) acc[a][b][m][n] = (f32x4){0.f, 0.f, 0.f, 0.f};
    bf16x8 At[4][2], B0[2][2], B1[2][2];
    const char* cA = P.aptr(cur); const char* cB = P.bptr(cur);
    if constexpr (Prob::GATHER) { PG8_GATHER_OFFS(vAc, cur); }
    PG8_STAGE(PG8_SB(0, 0), cB, voffB); PG8_STAGE(PG8_SB(0, 1), cB + hstepB, voffB); PG8_STAGE_A(PG8_SA(0, 0), cA, 0, false); PG8_STAGE_A(PG8_SA(0, 1), cA, 1, false);
    if (wr == 1) PG8_BAR;
    PG8_WAIT_V(2); PG8_BAR;
    PG8_STAGE(PG8_SB(1, 0), cB + kstep, voffB); PG8_STAGE_A(PG8_SA(1, 0), PG8_AK(cA, 1), 0, false); PG8_STAGE(PG8_SB(1, 1), cB + hstepB + kstep, voffB);
    PG8_WAIT_V(6); PG8_BAR;
    for (;;) {
        const bool has_next = S.next(ui + 1, nxt);
        const char* nA = has_next ? P.aptr(nxt) : cA; const char* nB = has_next ? P.bptr(nxt) : cB;
        if constexpr (Prob::GATHER) { if (has_next) { PG8_GATHER_OFFS(vAn, nxt); } else {
#pragma unroll
            for (int _h = 0; _h < 2; ++_h)
#pragma unroll
                for (int _i = 0; _i < 2; ++_i) vAn[_h][_i] = vAc[_h][_i]; } }
        for (int t = 0; t < nt; t += 2) {
            const bool last = (t == nt - 2);
            const char* a1 = PG8_AK(cA, t + 1);
            const char* a2 = last ? nA : PG8_AK(cA, t + 2); const char* b2 = last ? nB : cB + (size_t)(t + 2) * kstep;
            const char* a3 = last ? PG8_AK(nA, 1) : PG8_AK(cA, t + 3); const char* b3 = b2 + kstep;
            PG8_LDB(B0, 0, 0); PG8_LDB(B1, 0, 1); PG8_SCHED; PG8_LDA(At, 0, 0); PG8_STAGE_A(PG8_SA(1, 1), a1, 1, false);
            PG8_WAIT_V(8); PG8_WAIT_L(0); PG8_BAR; PG8_MMA(0, 0, At, B0); PG8_MMA(0, 1, At, B1); PG8_BAR; PG8_SCHED;
            PG8_LDA(At, 0, 1); PG8_STAGE(PG8_SB(0, 0), b2, voffB); PG8_STAGE(PG8_SB(0, 1), b2 + hstepB, voffB); PG8_STAGE_A(PG8_SA(0, 0), a2, 0, last);
            PG8_WAIT_V(8); PG8_WAIT_L(0); PG8_BAR; PG8_MMA(1, 0, At, B0); PG8_MMA(1, 1, At, B1); PG8_BAR; PG8_SCHED;
            PG8_LDB(B0, 1, 0); PG8_LDB(B1, 1, 1); PG8_SCHED; PG8_LDA(At, 1, 0); PG8_STAGE_A(PG8_SA(0, 1), a2, 1, last);
            PG8_WAIT_V(8); PG8_WAIT_L(0); PG8_BAR; PG8_MMA(0, 0, At, B0); PG8_MMA(0, 1, At, B1); PG8_BAR; PG8_SCHED;
            PG8_LDA(At, 1, 1); PG8_STAGE(PG8_SB(1, 0), b3, voffB); PG8_STAGE(PG8_SB(1, 1), b3 + hstepB, voffB); PG8_STAGE_A(PG8_SA(1, 0), a3, 0, last);
            PG8_WAIT_V(8); PG8_WAIT_L(0); PG8_BAR; PG8_MMA(1, 0, At, B0); PG8_MMA(1, 1, At, B1); PG8_BAR; PG8_SCHED;
        }
        if constexpr (ALIGN_EPI) { if (wr == 0) PG8_BAR; }
        { int te = threadIdx.x; asm volatile("" : "+v"(te));
          const int we = __builtin_amdgcn_readfirstlane(te >> 6), le = te & 63; E(acc, cur, we >> 2, we & 3, le & 15, le >> 4); }
        if (!has_next) break;
#pragma unroll
        for (int a = 0; a < 2; ++a)
#pragma unroll
            for (int b = 0; b < 2; ++b)
#pragma unroll
                for (int m = 0; m < 4; ++m)
#pragma unroll
                    for (int n = 0; n < 2; ++n) acc[a][b][m][n] = (f32x4){0.f, 0.f, 0.f, 0.f};
        cur = nxt; cA = nA; cB = nB; ++ui;
        if constexpr (Prob::GATHER) {
#pragma unroll
            for (int _h = 0; _h < 2; ++_h)
#pragma unroll
                for (int _i = 0; _i < 2; ++_i) vAc[_h][_i] = vAn[_h][_i]; }
        if constexpr (ALIGN_EPI) { if (wr == 1) PG8_BAR; }
    }
    PG8_WAIT_V(0);
    if constexpr (!ALIGN_EPI) { if (wr == 0) PG8_BAR; }
    PG8_BAR;
#undef PG8_SA
#undef PG8_SB
#undef PG8_STAGE
#undef PG8_STAGE_A
#undef PG8_GATHER_OFFS
#undef PG8_LDA
#undef PG8_LDB
#undef PG8_MMA
#undef PG8_WAIT_V
#undef PG8_WAIT_L
#undef PG8_BAR
#undef PG8_SCHED
#undef PG8_AK
}

struct ProbSimple : ProbBase {
    const char* A; const char* B;
    __device__ __forceinline__ const char* aptr(const Unit& u) const { return A + (size_t)u.pm * 256 * lda * 2; }
    __device__ __forceinline__ const char* bptr(const Unit& u) const { return B + (size_t)u.pn * 256 * ldb * 2; }
};
struct ProbPool : ProbBase {
    const char* A; const char* B;
    __device__ __forceinline__ const char* aptr(const Unit& u) const { return A + ((size_t)u.pm * 256 * 1024 + (size_t)u.pn * 256) * 2; }
    __device__ __forceinline__ const char* bptr(const Unit& u) const { return B + (size_t)u.pn * 65536 * 2; }
};
struct ProbScores : ProbBase {
    const char* A; const char* B;
    __device__ __forceinline__ const char* aptr(const Unit& u) const { return A + ((size_t)u.pm * 256 * 2048 + (size_t)u.pn * 512) * 2; }
    __device__ __forceinline__ const char* bptr(const Unit& u) const { return B + ((size_t)tile_batch(u.pm) * 256 * 2048 + (size_t)u.pn * 512) * 2; }
};
struct ProbVW : ProbBase {
    const char* A; const char* B;
    __device__ __forceinline__ const char* aptr(const Unit& u) const { return A + ((size_t)u.pm * 256 * 2048 + (size_t)(u.pn & 3) * 512) * 2; }
    __device__ __forceinline__ const char* bptr(const Unit& u) const { return B + ((size_t)(u.pn >> 2) * 256 * 2048 + (size_t)(u.pn & 3) * 512) * 2; }
};
struct ProbFin : ProbBase {
    const char* A; const char* B;
    __device__ __forceinline__ const char* aptr(const Unit& u) const { return A + (size_t)u.pm * 256 * 1024 * 2; }
    __device__ __forceinline__ const char* bptr(const Unit& u) const { return B + ((size_t)tile_batch(u.pm) * 2048 + (size_t)u.pn * 256) * 1024 * 2; }
};
struct ProbPV : ProbBase {
    const char* A; const char* B;
    __device__ __forceinline__ const char* aptr(const Unit& u) const { return A + ((size_t)u.pm * 256 * 1024 + (size_t)(u.pn >> 1) * 256) * 2; }
    __device__ __forceinline__ const char* bptr(const Unit& u) const { return B + ((size_t)tile_batch(u.pm) * 2048 + (size_t)u.pn * 256) * 256 * 2; }
};

__device__ __forceinline__ u32x4 pack8(const f32x4& v0, const f32x4& v1) { u32x4 w; w.x = cvt_pk_bf16(v0[0], v0[1]); w.y = cvt_pk_bf16(v0[2], v0[3]); w.z = cvt_pk_bf16(v1[0], v1[1]); w.w = cvt_pk_bf16(v1[2], v1[3]); return w; }
__device__ __forceinline__ float sumsq4(const f32x4& x) { return (x[0] * x[0] + x[1] * x[1]) + (x[2] * x[2] + x[3] * x[3]); }
__device__ __forceinline__ float sum4(const f32x4& x) { return (x[0] + x[1]) + (x[2] + x[3]); }
__device__ __forceinline__ float red_fq(float s) { s += __shfl_xor(s, 16); s += __shfl_xor(s, 32); return s; }

struct EpiIn {
    static constexpr bool PERM = true;
    bf16_t* base; size_t spl; const unsigned* csT; const float* gq; const float* gk; const rss_t* rowss;
    __device__ __forceinline__ void operator()(const f32x4 (&acc)[2][2][4][2], const Unit& u, int wr, int wc, int fr, int fq) const {
        typedef _Float16 h2 __attribute__((ext_vector_type(2)));
        const int t = u.pn >> 2; bf16_t* O = base + (size_t)t * spl; const int colt = (u.pn & 3) * 256; const int row0 = u.pm * BM + wr * 64 + fr;
        if (t >= 2) {
            const int col0 = colt + wc * 32 + 8 * fq;
#pragma unroll
            for (int ai = 0; ai < 2; ++ai) { rss_t rx[4];
#pragma unroll
                for (int m = 0; m < 4; ++m) rx[m] = rowss[row0 + ai * HALF + m * 16];
#pragma unroll
                for (int m = 0; m < 4; ++m) { const float rxm = ss_rstd(rx[m]); bf16_t* rowp = O + (size_t)(row0 + ai * HALF + m * 16) * 1024 + col0;
#pragma unroll
                    for (int bj = 0; bj < 2; ++bj) *(u32x4*)(rowp + bj * HALF) = pack8(acc[ai][bj][m][0] * rxm, acc[ai][bj][m][1] * rxm); }
                asm volatile("" ::: "memory"); }
        } else {
            const float* g = t ? gk : gq; f32x4 g1[2], g2[2];
#pragma unroll
            for (int n = 0; n < 2; ++n) { g1[n] = *(const f32x4*)(g + 8 * fq + 4 * n); g2[n] = *(const f32x4*)(g + 32 + 8 * fq + 4 * n); }
            const int col0 = colt + 64 * wc + 8 * fq;
#pragma unroll
            for (int ah = 0; ah < 4; ++ah) { const int ai = ah >> 1, mb = (ah & 1) * 2;
                u32x4 cs[2][2]; rss_t rx[2];
#pragma unroll
                for (int mm = 0; mm < 2; ++mm) { const int m = mb + mm; const int pos = tok_pos(row0 + ai * HALF + m * 16); rx[mm] = rowss[row0 + ai * HALF + m * 16];
#pragma unroll
                    for (int n = 0; n < 2; ++n) cs[mm][n] = *(const u32x4*)(csT + pos * 32 + 8 * fq + 4 * n); }
#pragma unroll
                for (int mm = 0; mm < 2; ++mm) { const int m = mb + mm; const int row = row0 + ai * HALF + m * 16;
                    float ss = (sumsq4(acc[ai][0][m][0]) + sumsq4(acc[ai][0][m][1])) + (sumsq4(acc[ai][1][m][0]) + sumsq4(acc[ai][1][m][1]));
                    ss = red_fq(ss);
                    const float rxm = ss_rstd(rx[mm]);
                    const float r = __builtin_amdgcn_rsqf(ss * rxm * rxm * (1.0f / 64.0f) + EPS) * rxm * (t ? 1.0f : QSCALE);
                    f32x4 o1[2], o2[2];
#pragma unroll
                    for (int n = 0; n < 2; ++n) { f32x4 c, s;
#pragma unroll
                        for (int j = 0; j < 4; ++j) { const unsigned w = cs[mm][n][j]; const h2 v = __builtin_bit_cast(h2, w); c[j] = (float)v.x; s[j] = (float)v.y; }
                        const f32x4 x1 = acc[ai][0][m][n] * r * g1[n], x2 = acc[ai][1][m][n] * r * g2[n];
                        o1[n] = x1 * c - x2 * s; o2[n] = x2 * c + x1 * s; }
                    bf16_t* rowp = O + (size_t)row * 1024 + col0;
                    *(u32x4*)(rowp) = pack8(o1[0], o1[1]); *(u32x4*)(rowp + 32) = pack8(o2[0], o2[1]); }
                asm volatile("" ::: "memory"); }
        }
    }
};
template <int MODE> struct EpiBf {
    static constexpr bool PERM = true;
    bf16_t* O; int ldc; float* aux; float* aux2; LAS float* xl;
    __device__ __forceinline__ void operator()(f32x4 (&acc)[2][2][4][2], const Unit& u, int wr, int wc, int fr, int fq) const {
        const int row0 = u.pm * BM + wr * 64 + fr; const int col0 = u.pn * BM + wc * 32 + 8 * fq;
        float rs[2][4];
        if constexpr (MODE == 2) {
            f32x4 qa[2][4][2];
#pragma unroll
            for (int ai = 0; ai < 2; ++ai)
#pragma unroll
                for (int m = 0; m < 4; ++m) { const float* p = aux + (size_t)(row0 + ai * HALF + m * 16) * 32 + u.pn * 8; qa[ai][m][0] = *(const f32x4*)p; qa[ai][m][1] = *(const f32x4*)(p + 4); }
#pragma unroll
            for (int ai = 0; ai < 2; ++ai)
#pragma unroll
                for (int m = 0; m < 4; ++m) { const float sc = __builtin_amdgcn_rsqf((sum4(qa[ai][m][0]) + sum4(qa[ai][m][1])) * (1.0f / 512.0f) + EPS) * (0.044194173824159216f * 1.4426950408889634f); float ps = 0.f;
#pragma unroll
                    for (int bj = 0; bj < 2; ++bj)
#pragma unroll
                        for (int n = 0; n < 2; ++n) { f32x4 p;
#pragma unroll
                            for (int j = 0; j < 4; ++j) p[j] = __builtin_amdgcn_exp2f(acc[ai][bj][m][n][j] * sc);
                            acc[ai][bj][m][n] = p; ps += sum4(p); }
                    ps = red_fq(ps);
                    if (fq == 0) xl[(ai * HALF + wr * 64 + m * 16 + fr) * 4 + wc] = ps; }
            asm volatile("s_waitcnt lgkmcnt(0)" ::: "memory"); __builtin_amdgcn_s_barrier(); asm volatile("" ::: "memory");
#pragma unroll
            for (int ai = 0; ai < 2; ++ai)
#pragma unroll
                for (int m = 0; m < 4; ++m) { const f32x4 lv = *(const LAS f32x4*)(xl + (ai * HALF + wr * 64 + m * 16 + fr) * 4); rs[ai][m] = __builtin_amdgcn_rcpf(sum4(lv)); }
        }
        if constexpr (MODE == 1 || MODE == 4) { rss_t rv[2][4];
#pragma unroll
            for (int ai = 0; ai < 2; ++ai)
#pragma unroll
                for (int m = 0; m < 4; ++m) rv[ai][m] = ((const rss_t*)aux2)[row0 + ai * HALF + m * 16];
#pragma unroll
            for (int ai = 0; ai < 2; ++ai)
#pragma unroll
                for (int m = 0; m < 4; ++m) rs[ai][m] = ss_rstd(rv[ai][m]);
        }
        if constexpr (MODE == 3) {
            f32x4 la[2][4];
#pragma unroll
            for (int ai = 0; ai < 2; ++ai)
#pragma unroll
                for (int m = 0; m < 4; ++m) la[ai][m] = *(const f32x4*)(aux2 + (size_t)(row0 + ai * HALF + m * 16) * 16 + (u.pn >> 1) * 4);
#pragma unroll
            for (int ai = 0; ai < 2; ++ai)
#pragma unroll
                for (int m = 0; m < 4; ++m) rs[ai][m] = __builtin_amdgcn_rcpf(sum4(la[ai][m]));
        }
        bf16_t* Ob = O; int colb = col0;
        if constexpr (MODE == 5) { Ob = O + (size_t)(u.pn >> 2) * 2048 * 1024; colb = (u.pn & 3) * 256 + wc * 32 + 8 * fq; }
#pragma unroll
        for (int ai = 0; ai < 2; ++ai)
#pragma unroll
            for (int m = 0; m < 4; ++m) { const int row = row0 + ai * HALF + m * 16; bf16_t* rowp = Ob + (size_t)row * ldc + colb;
                if constexpr (MODE == 0 || MODE == 5) {
#pragma unroll
                    for (int bj = 0; bj < 2; ++bj) *(u32x4*)(rowp + bj * HALF) = pack8(acc[ai][bj][m][0], acc[ai][bj][m][1]);
                } else if constexpr (MODE == 1) {
                    float ss = (sumsq4(acc[ai][0][m][0]) + sumsq4(acc[ai][0][m][1])) + (sumsq4(acc[ai][1][m][0]) + sumsq4(acc[ai][1][m][1]));
                    ss = red_fq(ss); const float rxx = rs[ai][m];
                    if (fq == 0) aux[(size_t)row * 32 + u.pn * 4 + wc] = ss * rxx * rxx;
#pragma unroll
                    for (int bj = 0; bj < 2; ++bj) *(u32x4*)(rowp + bj * HALF) = pack8(acc[ai][bj][m][0] * rxx, acc[ai][bj][m][1] * rxx);
                } else {
                    const float rxx = rs[ai][m];
#pragma unroll
                    for (int bj = 0; bj < 2; ++bj) *(u32x4*)(rowp + bj * HALF) = pack8(acc[ai][bj][m][0] * rxx, acc[ai][bj][m][1] * rxx);
                }
            }
    }
};
struct EpiRes {
    static constexpr bool PERM = true;
    bf16_t* XB; rss_t* rowss; float* OUT;
    __device__ __forceinline__ void load_half(u32x4 (&t)[4][2], int row0, int col0, int ai) const {
#pragma unroll
        for (int m = 0; m < 4; ++m) { const bf16_t* rowb = XB + (size_t)(row0 + ai * HALF + m * 16) * D_MODEL + col0;
#pragma unroll
            for (int bj = 0; bj < 2; ++bj) t[m][bj] = *(const u32x4*)(rowb + bj * HALF); }
    }
    __device__ __forceinline__ void add_half(f32x4 (&acc)[2][2][4][2], const u32x4 (&t)[4][2], int ai) const {
#pragma unroll
        for (int m = 0; m < 4; ++m)
#pragma unroll
            for (int bj = 0; bj < 2; ++bj) { const u32x4 w = t[m][bj];
                acc[ai][bj][m][0] = acc[ai][bj][m][0] + (f32x4){bflo(w.x), bfhi(w.x), bflo(w.y), bfhi(w.y)}; acc[ai][bj][m][1] = acc[ai][bj][m][1] + (f32x4){bflo(w.z), bfhi(w.z), bflo(w.w), bfhi(w.w)}; }
    }
    __device__ __forceinline__ void store_half(const f32x4 (&acc)[2][2][4][2], int row0, int col0, int ai, int fq) const {
#pragma unroll
        for (int m = 0; m < 4; ++m) { const int row = row0 + ai * HALF + m * 16; bf16_t* rowb = XB + (size_t)row * D_MODEL + col0; float ss = 0.f;
#pragma unroll
            for (int bj = 0; bj < 2; ++bj) { const f32x4 v0 = acc[ai][bj][m][0], v1 = acc[ai][bj][m][1];
                if (OUT) { float* rowp = OUT + (size_t)row * D_MODEL + col0 + bj * HALF; *(f32x4*)rowp = v0; *(f32x4*)(rowp + 4) = v1; }
                else { *(u32x4*)(rowb + bj * HALF) = pack8(v0, v1); ss += sumsq4(v0) + sumsq4(v1); } }
            if (rowss) { ss = red_fq(ss); if (fq == 0) atomicAdd(rowss + row, ss_fix(ss)); } }
    }
    __device__ __forceinline__ void operator()(f32x4 (&acc)[2][2][4][2], const Unit& u, int wr, int wc, int fr, int fq) const {
        const int row0 = u.pm * BM + wr * 64 + fr, col0 = u.pn * BM + wc * 32 + 8 * fq;
        u32x4 t[4][2];
        load_half(t, row0, col0, 0);
        add_half(acc, t, 0);
        asm volatile("" : "+v"(acc[0][0][0][0]), "+v"(acc[0][1][3][1]));
        load_half(t, row0, col0, 1);
        asm volatile("" ::: "memory");
        store_half(acc, row0, col0, 0, fq);
        add_half(acc, t, 1);
        store_half(acc, row0, col0, 1, fq);
    }
};
__device__ __forceinline__ int ffn_tile_row(int pm, int R, int chunk, bool& valid) {
    R = (R & ~63) | ((R & 15) << 2) | ((R >> 4) & 3);
    valid = true; if (pm < FFN_MT) return pm * 256 + R;
    const int v = (pm - FFN_MT) * 256 + R; int g = v >> 2; const int k = v & 3; int tok;
    if (chunk == 0) { valid = g < 124; g = g < 124 ? g : 123; const int s = g / 31, bi = g - s * 31; tok = s * S_P + 256 * (bi + 1); }
    else { valid = g < 120; g = g < 120 ? g : 119; const int s = g / 15, bi = g - s * 15; tok = s * S_S + 256 * (bi + 1); }
    return tok + k - 2;
}
struct ProbUp : ProbBase {
    static constexpr bool GATHER = true;
    const char* A; const char* B; int chunk;
    __device__ __forceinline__ const char* aptr(const Unit&) const { return A; }
    __device__ __forceinline__ const char* bptr(const Unit& u) const { return B + (size_t)u.pn * 256 * ldb * 2; }
    __device__ __forceinline__ unsigned rowoff(const Unit& u, int R) const { bool v; return (unsigned)ffn_tile_row(u.pm, R, chunk, v) * (unsigned)(lda * 2); }
};
__device__ __forceinline__ float dpp_ror1(float v) { return __builtin_bit_cast(float, __builtin_amdgcn_update_dpp(0, __builtin_bit_cast(int, v), 0x121, 0xf, 0xf, false)); }
__device__ __forceinline__ float dpp_ror15(float v) { return __builtin_bit_cast(float, __builtin_amdgcn_update_dpp(0, __builtin_bit_cast(int, v), 0x12F, 0xf, 0xf, false)); }
struct EpiGlu {
    static constexpr bool PERM = true;
    bf16_t* G; const rss_t* rowss; const u32x4* cwt; int chunk; LAS float* xl;
    __device__ __forceinline__ void operator()(f32x4 (&acc)[2][2][4][2], const Unit& u, int wr, int wc, int fr, int fq) const {
        const bool bnd = u.pm >= FFN_MT; const int ch0 = u.pn * 128 + wc * 32 + 8 * fq;
        const int tidw = (wr * 4 + wc) * 64 + fq * 16 + fr; LAS unsigned char* wl = (LAS unsigned char*)xl + 12288;
        u32x4 wrec = (u32x4){0u, 0u, 0u, 0u}; if (tidw < 128) wrec = cwt[u.pn * 128 + tidw];
        int rowi[2][4]; unsigned stmask = 0u;
        { rss_t rv[2][4];
#pragma unroll
          for (int ai = 0; ai < 2; ++ai)
#pragma unroll
            for (int m = 0; m < 4; ++m) { const int RL = ai * HALF + wr * 64 + 4 * fr + m; bool valid; const int row = ffn_tile_row(u.pm, ai * HALF + wr * 64 + m * 16 + fr, chunk, valid); rowi[ai][m] = row; rv[ai][m] = rowss[row];
                const int gt = chunk * FFN_CHUNK + row, pos = tok_pos(gt), S = tok_seqlen(gt);
                const bool st = bnd ? (valid && (m == 1 || m == 2)) : !((RL == 0 && pos != 0) || (RL == 255 && pos != S - 1));
                stmask |= st ? (1u << (ai * 4 + m)) : 0u; }
#pragma unroll
          for (int ai = 0; ai < 2; ++ai)
#pragma unroll
            for (int m = 0; m < 4; ++m) { const float rx = ss_rstd(rv[ai][m]);
#pragma unroll
                for (int bj = 0; bj < 2; ++bj)
#pragma unroll
                    for (int n = 0; n < 2; ++n) acc[ai][bj][m][n] = acc[ai][bj][m][n] * rx; } }
#pragma unroll
        for (int ai = 0; ai < 2; ++ai) { const int s1 = 2 * ai + wr + 1;
            if (fr == 0) {
#pragma unroll
                for (int bj = 0; bj < 2; ++bj)
#pragma unroll
                    for (int n = 0; n < 2; ++n) *(LAS f32x4*)(xl + ((s1 * 2 + 0) * 4 + wc) * 64 + bj * 32 + 8 * fq + 4 * n) = acc[ai][bj][0][n]; }
            if (fr == 15) {
#pragma unroll
                for (int bj = 0; bj < 2; ++bj)
#pragma unroll
                    for (int n = 0; n < 2; ++n) *(LAS f32x4*)(xl + ((s1 * 2 + 1) * 4 + wc) * 64 + bj * 32 + 8 * fq + 4 * n) = acc[ai][bj][3][n]; } }
        if (tidw < 128) *(LAS u32x4*)(wl + tidw * 16) = wrec;
        asm volatile("s_waitcnt lgkmcnt(0)" ::: "memory"); __builtin_amdgcn_s_barrier(); asm volatile("" ::: "memory");
#pragma unroll
        for (int n = 0; n < 2; ++n) { unsigned wp[2][4][2];
#pragma unroll
            for (int jp = 0; jp < 2; ++jp) { float o[2][4][2];
#pragma unroll
                for (int jj = 0; jj < 2; ++jj) { const int j = 2 * jp + jj; const u32x4 w = *(const LAS u32x4*)(wl + (wc * 32 + 8 * fq + 4 * n + j) * 16);
                    const float g0w = bflo(w.x), g1w = bfhi(w.x), g2w = bflo(w.y), gbw = bfhi(w.y), v0w = bflo(w.z), v1w = bfhi(w.z), v2w = bflo(w.w), vbw = bfhi(w.w);
#pragma unroll
                    for (int ai = 0; ai < 2; ++ai) { const int s1 = 2 * ai + wr + 1; float cg[4], cv[4];
                        const LAS float* xp = xl + (((s1 - 1) * 2 + 1) * 4 + wc) * 64 + 8 * fq + 4 * n + j; const LAS float* xn = xl + (((s1 + 1) * 2 + 0) * 4 + wc) * 64 + 8 * fq + 4 * n + j;
                        { const float pe = xp[0], ne = xn[0]; const float r3 = dpp_ror1(acc[ai][0][3][n][j]), l0 = dpp_ror15(acc[ai][0][0][n][j]);
#pragma unroll
                          for (int m = 0; m < 4; ++m) { const float pv = m ? acc[ai][0][m ? m - 1 : 0][n][j] : (fr == 0 ? pe : r3), nx = m < 3 ? acc[ai][0][m < 3 ? m + 1 : 3][n][j] : (fr == 15 ? ne : l0);
                              cg[m] = gbw + g0w * pv + g1w * acc[ai][0][m][n][j] + g2w * nx; } }
                        { const float pe = xp[32], ne = xn[32]; const float r3 = dpp_ror1(acc[ai][1][3][n][j]), l0 = dpp_ror15(acc[ai][1][0][n][j]);
#pragma unroll
                          for (int m = 0; m < 4; ++m) { const float pv = m ? acc[ai][1][m ? m - 1 : 0][n][j] : (fr == 0 ? pe : r3), nx = m < 3 ? acc[ai][1][m < 3 ? m + 1 : 3][n][j] : (fr == 15 ? ne : l0);
                              cv[m] = vbw + v0w * pv + v1w * acc[ai][1][m][n][j] + v2w * nx; } }
#pragma unroll
                        for (int m = 0; m < 4; ++m) { const float g0 = cg[m];
                            const float ea = g0 * fmaf(g0 * g0, -0.10294324f, -2.3022082f);
                            o[ai][m][jj] = g0 * __builtin_amdgcn_rcpf(1.0f + __builtin_amdgcn_exp2f(ea)) * cv[m]; }
                        asm volatile("" : "+v"(o[ai][0][jj]), "+v"(o[ai][1][jj]), "+v"(o[ai][2][jj]), "+v"(o[ai][3][jj])); } }
#pragma unroll
                for (int ai = 0; ai < 2; ++ai)
#pragma unroll
                    for (int m = 0; m < 4; ++m) wp[ai][m][jp] = cvt_pk_bf16(o[ai][m][0], o[ai][m][1]); }
#pragma unroll
            for (int ai = 0; ai < 2; ++ai)
#pragma unroll
                for (int m = 0; m < 4; ++m) { u32x2 q; q.x = wp[ai][m][0]; q.y = wp[ai][m][1]; if (stmask & (1u << (ai * 4 + m))) *(u32x2*)(G + (size_t)rowi[ai][m] * D_FF + ch0 + 4 * n) = q; }
            asm volatile("" ::: "memory"); }
    }
};
struct EpiKV {
    static constexpr bool PERM = false;
    float* kraw; bf16_t* vT;
    __device__ __forceinline__ void operator()(const f32x4 (&acc)[2][2][4][2], const Unit& u, int wr, int wc, int fr, int fq) const {
        const int key0 = wr * 64 + fr, col0 = u.pn * BM + wc * 32 + 4 * fq;
        if (u.pn < 8) {
#pragma unroll
            for (int ai = 0; ai < 2; ++ai)
#pragma unroll
                for (int m = 0; m < 4; ++m) { float* rowp = kraw + (size_t)(u.pm * BM + key0 + ai * HALF + m * 16) * 2048 + col0;
#pragma unroll
                    for (int bj = 0; bj < 2; ++bj)
#pragma unroll
                        for (int n = 0; n < 2; ++n) *(f32x4*)(rowp + bj * HALF + n * 16) = acc[ai][bj][m][n]; }
        } else {
#pragma unroll
            for (int ai = 0; ai < 2; ++ai)
#pragma unroll
                for (int m = 0; m < 4; ++m) { bf16_t* rowp = vT + (size_t)(u.pm * BM + key0 + ai * HALF + m * 16) * 2048 + (col0 - 2048);
#pragma unroll
                    for (int bj = 0; bj < 2; ++bj)
#pragma unroll
                        for (int n = 0; n < 2; ++n) { const f32x4 v = acc[ai][bj][m][n]; u32x2 w; w.x = cvt_pk_bf16(v[0], v[1]); w.y = cvt_pk_bf16(v[2], v[3]); *(u32x2*)(rowp + bj * HALF + n * 16) = w; } }
        }
    }
};
}

namespace att {
constexpr int KVBLK = 64, SHM_V = 16384, SHM_K = 16384, OFF_V = 0, OFF_K = 3 * SHM_V, OFF_WS = 3 * SHM_V + 3 * SHM_K, LDP = 1024;
#define KSWZ(row, colB) ((row) * 256 + ((colB) ^ (((row) & 7) << 4)))
#define SBAR() __builtin_amdgcn_sched_barrier(0)
__device__ __forceinline__ int crow(int r, int hi) { return (r & 3) + 8 * (r >> 2) + 4 * hi; }
__device__ __forceinline__ void partialSM(f32x16& p0) {
#pragma unroll
  for (int r = 0; r < 16; ++r) p0[r] = __builtin_amdgcn_exp2f(p0[r]);
}
__device__ __forceinline__ void finishSM(f32x16& p0, f32x16& p1, float& l_reg, bf16x8& pa0, bf16x8& pa1, bf16x8& pa2, bf16x8& pa3) {
#pragma unroll
  for (int r = 0; r < 16; ++r) p1[r] = __builtin_amdgcn_exp2f(p1[r]);
  float ps = 0;
#pragma unroll
  for (int r = 0; r < 16; ++r) ps += p0[r];
#pragma unroll
  for (int r = 0; r < 16; ++r) ps += p1[r];
  l_reg += ps;
#define PK4(P, BASE, OUT) do { unsigned a0 = cvt_pk_bf16(P[BASE + 0], P[BASE + 1]), a1 = cvt_pk_bf16(P[BASE + 2], P[BASE + 3]);   \
    unsigned b0 = cvt_pk_bf16(P[BASE + 4], P[BASE + 5]), b1 = cvt_pk_bf16(P[BASE + 6], P[BASE + 7]);                              \
    auto r0 = __builtin_amdgcn_permlane32_swap(a0, b0, false, false); auto r1 = __builtin_amdgcn_permlane32_swap(a1, b1, false, false); \
    u32x4 w = {r0[0], r1[0], r0[1], r1[1]}; OUT = __builtin_bit_cast(bf16x8, w); } while (0)
  PK4(p0, 0, pa0); PK4(p0, 8, pa1); PK4(p1, 0, pa2); PK4(p1, 8, pa3);
#undef PK4
}
__device__ __forceinline__ void finishSM_tail(f32x16& p0, f32x16& p1, float& l_reg, bf16x8& pa0, bf16x8& pa1, bf16x8& pa2, bf16x8& pa3) {
  float ps = 0;
#pragma unroll
  for (int r = 0; r < 16; ++r) ps += p0[r];
#pragma unroll
  for (int r = 0; r < 16; ++r) ps += p1[r];
  l_reg += ps;
#define PK4(P, BASE, OUT) do { unsigned a0 = cvt_pk_bf16(P[BASE + 0], P[BASE + 1]), a1 = cvt_pk_bf16(P[BASE + 2], P[BASE + 3]);   \
    unsigned b0 = cvt_pk_bf16(P[BASE + 4], P[BASE + 5]), b1 = cvt_pk_bf16(P[BASE + 6], P[BASE + 7]);                              \
    auto r0 = __builtin_amdgcn_permlane32_swap(a0, b0, false, false); auto r1 = __builtin_amdgcn_permlane32_swap(a1, b1, false, false); \
    u32x4 w = {r0[0], r1[0], r0[1], r1[1]}; OUT = __builtin_bit_cast(bf16x8, w); } while (0)
  PK4(p0, 0, pa0); PK4(p0, 8, pa1); PK4(p1, 0, pa2); PK4(p1, 8, pa3);
#undef PK4
}
__device__ __forceinline__ void qkt(f32x16& p0, f32x16& p1, const LAS unsigned char* Ks, const bf16x8* qr, int r32, int hi, int cbase) {
  p0 = f32x16{}; p1 = f32x16{}; bf16x8 b0[4], b1[4];
#pragma unroll
  for (int d0 = 0; d0 < 4; ++d0) { const int cb = cbase + (d0 * 16 + hi * 8) * 2;
    b0[d0] = *(const LAS bf16x8*)(Ks + KSWZ(r32, cb)); b1[d0] = *(const LAS bf16x8*)(Ks + KSWZ(32 + r32, cb)); }
#define QK_STEP(D, N) do { asm volatile("s_waitcnt lgkmcnt(" #N ")" ::: "memory"); SBAR(); \
    p0 = __builtin_amdgcn_mfma_f32_32x32x16_bf16(b0[D], qr[D], p0, 0, 0, 0); p1 = __builtin_amdgcn_mfma_f32_32x32x16_bf16(b1[D], qr[D], p1, 0, 0, 0); } while (0)
  QK_STEP(0, 6); QK_STEP(1, 4); QK_STEP(2, 2); QK_STEP(3, 0);
#undef QK_STEP
}
__device__ __forceinline__ int v_st(int k, int c) { const int kk = (k & ~0xC) | ((k & 4) << 1) | ((k & 8) >> 1); return ((kk >> 3) * 4 + (c >> 5)) * 512 + ((kk & 7) * 32 + (c & 31)) * 2; }
__device__ __forceinline__ int v_rd_base(int lane) { return ((lane & 3) << 3) | (((lane >> 2) & 3) << 6) | (((lane >> 4) & 1) << 5) | (((lane >> 5) & 1) << 8); }
constexpr int v_rd_off(int d0, int ks, int half) { return d0 * 512 + ks * 4096 + half * 2048; }
template <int OFF> __device__ __forceinline__ s16x4 tr_read(int vb) {
  s16x4 r; asm volatile("ds_read_b64_tr_b16 %0, %1 offset:%2" : "=&v"(r) : "v"(vb), "i"(OFF) : "memory"); return r;
}
struct VFrag { s16x4 l0, h0, l1, h1, l2, h2, l3, h3; };
template <int D0> __device__ __forceinline__ void pv_read(VFrag& f, int vb) {
  f.l0 = tr_read<v_rd_off(D0, 0, 0)>(vb); f.h0 = tr_read<v_rd_off(D0, 0, 1)>(vb); f.l1 = tr_read<v_rd_off(D0, 1, 0)>(vb); f.h1 = tr_read<v_rd_off(D0, 1, 1)>(vb);
  f.l2 = tr_read<v_rd_off(D0, 2, 0)>(vb); f.h2 = tr_read<v_rd_off(D0, 2, 1)>(vb); f.l3 = tr_read<v_rd_off(D0, 3, 0)>(vb); f.h3 = tr_read<v_rd_off(D0, 3, 1)>(vb);
}
__device__ __forceinline__ void pv_mma(f32x16& od, const VFrag& f, bf16x8 pa0, bf16x8 pa1, bf16x8 pa2, bf16x8 pa3) {
#define PKV(L, H) (bf16x8){L[0], L[1], L[2], L[3], H[0], H[1], H[2], H[3]}
  od = __builtin_amdgcn_mfma_f32_32x32x16_bf16(pa0, PKV(f.l0, f.h0), od, 0, 0, 0);
  od = __builtin_amdgcn_mfma_f32_32x32x16_bf16(pa1, PKV(f.l1, f.h1), od, 0, 0, 0);
  od = __builtin_amdgcn_mfma_f32_32x32x16_bf16(pa2, PKV(f.l2, f.h2), od, 0, 0, 0);
  od = __builtin_amdgcn_mfma_f32_32x32x16_bf16(pa3, PKV(f.l3, f.h3), od, 0, 0, 0);
#undef PKV
}
__device__ __forceinline__ void pv_d0(f32x16* o, int vb, bf16x8 pa0, bf16x8 pa1, bf16x8 pa2, bf16x8 pa3) {
  VFrag fa, fb;
  pv_read<0>(fa, vb); pv_read<1>(fb, vb);
  asm volatile("s_waitcnt lgkmcnt(8)" ::: "memory"); SBAR(); pv_mma(o[0], fa, pa0, pa1, pa2, pa3); SBAR();
  pv_read<2>(fa, vb);
  asm volatile("s_waitcnt lgkmcnt(8)" ::: "memory"); SBAR(); pv_mma(o[1], fb, pa0, pa1, pa2, pa3); SBAR();
  pv_read<3>(fb, vb);
  asm volatile("s_waitcnt lgkmcnt(8)" ::: "memory"); SBAR(); pv_mma(o[2], fa, pa0, pa1, pa2, pa3); SBAR();
  asm volatile("s_waitcnt lgkmcnt(0)" ::: "memory"); SBAR(); pv_mma(o[3], fb, pa0, pa1, pa2, pa3);
}
__device__ __forceinline__ void att_step(f32x16& s0, f32x16& s1, const LAS unsigned char* Ks, const bf16x8* qr, int r32, int hi, int cbase,
                                         f32x16& e0, f32x16& e1, float& l_reg, bf16x8& pa0, bf16x8& pa1, bf16x8& pa2, bf16x8& pa3, f32x16* o, int vb) {
  bf16x8 b0[4], b1[4]; VFrag fa, fb; float ps = 0.f, ps1 = 0.f, ps2 = 0.f, ps3 = 0.f; u32x4 w0, w1, w2, w3;
#pragma unroll
  for (int d0 = 0; d0 < 4; ++d0) { const int cb = cbase + (d0 * 16 + hi * 8) * 2;
    b0[d0] = *(const LAS bf16x8*)(Ks + KSWZ(r32, cb)); b1[d0] = *(const LAS bf16x8*)(Ks + KSWZ(32 + r32, cb)); }
  s0 = f32x16{}; s1 = f32x16{};
#define ADDF(acc, x) asm("v_add_f32 %0, %1, %0" : "+v"(acc) : "v"(x))
#define PACK_H(E, BASE, H, W) do { ADDF(ps, E[BASE + 2 * H]); ADDF(ps1, E[BASE + 2 * H + 1]); ADDF(ps2, E[BASE + 4 + 2 * H]); ADDF(ps3, E[BASE + 5 + 2 * H]);                       \
    const unsigned a_ = cvt_pk_bf16(E[BASE + 2 * H], E[BASE + 2 * H + 1]), b_ = cvt_pk_bf16(E[BASE + 4 + 2 * H], E[BASE + 5 + 2 * H]);                       \
    auto r_ = __builtin_amdgcn_permlane32_swap(a_, b_, false, false); W[H] = r_[0]; W[2 + H] = r_[1]; } while (0)
#define QK_STEP(D, N, PRE, PK_A, PK_B) do { asm volatile("s_waitcnt lgkmcnt(" #N ")" ::: "memory"); PRE; SBAR();                                                  \
    s0 = __builtin_amdgcn_mfma_f32_32x32x16_bf16(b0[D], qr[D], s0, 0, 0, 0); SBAR(); PK_A; SBAR();                                                                 \
    s1 = __builtin_amdgcn_mfma_f32_32x32x16_bf16(b1[D], qr[D], s1, 0, 0, 0); SBAR(); PK_B; SBAR(); } while (0)
  QK_STEP(0, 6, (void)0, PACK_H(e0, 0, 0, w0), PACK_H(e0, 0, 1, w0));
  QK_STEP(1, 4, (void)0, PACK_H(e0, 8, 0, w1), PACK_H(e0, 8, 1, w1));
  QK_STEP(2, 2, (void)0, PACK_H(e1, 0, 0, w2), PACK_H(e1, 0, 1, w2));
  QK_STEP(3, 0, (pv_read<0>(fa, vb), pv_read<1>(fb, vb)), PACK_H(e1, 8, 0, w3), PACK_H(e1, 8, 1, w3));
#undef QK_STEP
#undef PACK_H
#undef ADDF
  l_reg += (ps + ps1) + (ps2 + ps3);
  pa0 = __builtin_bit_cast(bf16x8, w0); pa1 = __builtin_bit_cast(bf16x8, w1); pa2 = __builtin_bit_cast(bf16x8, w2); pa3 = __builtin_bit_cast(bf16x8, w3);
#define PKV(L, H) (bf16x8){L[0], L[1], L[2], L[3], H[0], H[1], H[2], H[3]}
#define EX2(X, I) do { X[I] = __builtin_amdgcn_exp2f(X[I]); X[I + 1] = __builtin_amdgcn_exp2f(X[I + 1]); } while (0)
#define PV_BLK(D0, F, N, X, XB) do { asm volatile("s_waitcnt lgkmcnt(" #N ")" ::: "memory"); SBAR();                                                              \
    o[D0] = __builtin_amdgcn_mfma_f32_32x32x16_bf16(pa0, PKV(F.l0, F.h0), o[D0], 0, 0, 0); SBAR(); EX2(X, XB + 0); SBAR();                                         \
    o[D0] = __builtin_amdgcn_mfma_f32_32x32x16_bf16(pa1, PKV(F.l1, F.h1), o[D0], 0, 0, 0); SBAR(); EX2(X, XB + 2); SBAR();                                         \
    o[D0] = __builtin_amdgcn_mfma_f32_32x32x16_bf16(pa2, PKV(F.l2, F.h2), o[D0], 0, 0, 0); SBAR(); EX2(X, XB + 4); SBAR();                                         \
    o[D0] = __builtin_amdgcn_mfma_f32_32x32x16_bf16(pa3, PKV(F.l3, F.h3), o[D0], 0, 0, 0); SBAR(); EX2(X, XB + 6); SBAR(); } while (0)
  PV_BLK(0, fa, 8, s0, 0); pv_read<2>(fa, vb);
  PV_BLK(1, fb, 8, s0, 8); pv_read<3>(fb, vb);
  PV_BLK(2, fa, 8, s1, 0);
  PV_BLK(3, fb, 0, s1, 8);
#undef PV_BLK
#undef EX2
#undef PKV
}
__device__ __forceinline__ void attn_unit(const bf16_t* Qg, const bf16_t* __restrict__ Kg, const bf16_t* __restrict__ Vg, bf16_t* Og, int seq, float lam, const float* gsub, float oscale, LAS unsigned char* lds) {
  int tid_l = threadIdx.x; asm volatile("" : "+v"(tid_l));
  const int tid = tid_l, wid = __builtin_amdgcn_readfirstlane(tid >> 6), lane = tid & 63, r32 = lane & 31, hi = lane >> 5;
  const int comp = wid & 1, rg = wid >> 1, cbase = comp * 128;
  LAS unsigned char* V_lds = lds + OFF_V; LAS unsigned char* K_lds = lds + OFF_K;
  LAS float* wsf = (LAS float*)(lds + OFF_WS) + wid * 64; LAS float* li_l = wsf;
  float l_reg = 0; f32x16 o[4] = {}; bf16x8 qr[4];
  const bf16_t* Qw = Qg + (size_t)(rg * 32 + r32) * LDP + comp * 64 + hi * 8;
#pragma unroll
  for (int d0 = 0; d0 < 4; ++d0) qr[d0] = *(const bf16x8*)(Qw + d0 * 16);
  unsigned koff[2], voff[2];
#pragma unroll
  for (int i = 0; i < 2; ++i) { const int L = (tid + 512 * i) * 16; { const int row = L >> 8, colB = (L & 255) ^ ((row & 7) << 4); koff[i] = (unsigned)(row * LDP * 2 + colB); }
    { const int sub = L >> 9, w = L & 511, kk = (sub >> 2) * 8 + (w >> 6), c = (sub & 3) * 32 + ((w & 63) >> 1), k = (kk & ~0xC) | ((kk & 4) << 1) | ((kk & 8) >> 1); voff[i] = (unsigned)(k * LDP * 2 + c * 2); } }
  const int vbb = (int)(unsigned)(size_t)V_lds + v_rd_base(lane);
  const int NT = seq / KVBLK; const size_t tstep = (size_t)KVBLK * LDP * 2;
#define DMA_K(t) do { const int t_ = (t) < NT ? (t) : NT - 1; const char* g_ = (const char*)Kg + (size_t)t_ * tstep; LAS unsigned char* d_ = K_lds + (t_ % 3) * SHM_K + wid * 1024; \
    __builtin_amdgcn_global_load_lds((const unsigned*)(g_ + koff[0]), (LAS unsigned*)d_, 16, 0, 0); __builtin_amdgcn_global_load_lds((const unsigned*)(g_ + koff[1]), (LAS unsigned*)(d_ + 8192), 16, 0, 0); } while (0)
#define DMA_V(t) do { const int t_ = (t) < NT ? (t) : NT - 1; const char* g_ = (const char*)Vg + (size_t)t_ * tstep; LAS unsigned char* d_ = V_lds + (t_ % 3) * SHM_V + wid * 1024; \
    __builtin_amdgcn_global_load_lds((const unsigned*)(g_ + voff[0]), (LAS unsigned*)d_, 16, 0, 0); __builtin_amdgcn_global_load_lds((const unsigned*)(g_ + voff[1]), (LAS unsigned*)(d_ + 8192), 16, 0, 0); } while (0)
#define WAIT4_BAR() do { asm volatile("s_waitcnt vmcnt(4)" ::: "memory"); __builtin_amdgcn_s_barrier(); asm volatile("" ::: "memory"); } while (0)
  f32x16 pA0, pA1, pB0, pB1; bf16x8 pa0, pa1, pa2, pa3;
  DMA_K(0); DMA_K(1); DMA_V(0);
  WAIT4_BAR();
  DMA_K(2); DMA_V(1);
  qkt(pA0, pA1, K_lds, qr, r32, hi, cbase); partialSM(pA0); partialSM(pA1);
  int sk = 1, sv = 0;
  for (int j = 1; j + 1 < NT; j += 2) {
    WAIT4_BAR(); DMA_K(j + 2); DMA_V(j + 1);
    SBAR(); att_step(pB0, pB1, K_lds + sk * SHM_K, qr, r32, hi, cbase, pA0, pA1, l_reg, pa0, pa1, pa2, pa3, o, vbb + sv * SHM_V); SBAR();
    sk = sk == 2 ? 0 : sk + 1; sv = sv == 2 ? 0 : sv + 1;
    WAIT4_BAR(); DMA_K(j + 3); DMA_V(j + 2);
    SBAR(); att_step(pA0, pA1, K_lds + sk * SHM_K, qr, r32, hi, cbase, pB0, pB1, l_reg, pa0, pa1, pa2, pa3, o, vbb + sv * SHM_V); SBAR();
    sk = sk == 2 ? 0 : sk + 1; sv = sv == 2 ? 0 : sv + 1;
  }
  WAIT4_BAR(); DMA_K(NT + 1); DMA_V(NT);
  SBAR(); att_step(pB0, pB1, K_lds + sk * SHM_K, qr, r32, hi, cbase, pA0, pA1, l_reg, pa0, pa1, pa2, pa3, o, vbb + sv * SHM_V); SBAR();
  sv = sv == 2 ? 0 : sv + 1;
  WAIT4_BAR();
  finishSM_tail(pB0, pB1, l_reg, pa0, pa1, pa2, pa3); SBAR();
  pv_d0(o, vbb + sv * SHM_V, pa0, pa1, pa2, pa3);
  asm volatile("s_waitcnt vmcnt(0)" ::: "memory");
#undef DMA_K
#undef DMA_V
#undef WAIT4_BAR
  { auto rr = __builtin_amdgcn_permlane32_swap(__float_as_uint(l_reg), __float_as_uint(l_reg), false, false); l_reg = __uint_as_float(rr[0]) + __uint_as_float(rr[1]); }
  if (hi == 0) li_l[r32] = l_reg; asm volatile("s_waitcnt lgkmcnt(0)" ::: "memory");
  float rli[16];
#pragma unroll
  for (int r = 0; r < 16; ++r) rli[r] = __builtin_amdgcn_rcpf(li_l[crow(r, hi)]);
  __syncthreads();
  LAS float* X = (LAS float*)(lds) + rg * 4096 + lane;
  if (comp == 1) {
#pragma unroll
    for (int d0 = 0; d0 < 4; ++d0)
#pragma unroll
      for (int r = 0; r < 16; ++r) X[(d0 * 16 + r) * 64] = o[d0][r] * rli[r] * lam;
  }
  __syncthreads();
  if (comp == 0) {
    float ss[16];
#pragma unroll
    for (int r = 0; r < 16; ++r) ss[r] = 0.f;
#pragma unroll
    for (int d0 = 0; d0 < 4; ++d0)
#pragma unroll
      for (int r = 0; r < 16; ++r) { const float v = o[d0][r] * rli[r] - X[(d0 * 16 + r) * 64]; o[d0][r] = v; ss[r] += v * v; }
#pragma unroll
    for (int r = 0; r < 16; ++r) { float s = ss[r]; s += __shfl_xor(s, 1); s += __shfl_xor(s, 2); s += __shfl_xor(s, 4); s += __shfl_xor(s, 8); s += __shfl_xor(s, 16);
      ss[r] = __builtin_amdgcn_rsqf(s * (1.0f / 128.0f) + EPS) * oscale; }
    bf16_t* Ow = Og + (size_t)(rg * 32) * LDP;
#pragma unroll
    for (int d0 = 0; d0 < 4; ++d0) { const float g = gsub[d0 * 32 + r32];
#pragma unroll
#ifdef PROBE_ZERO_ATTN
      for (int r = 0; r < 16; ++r) Ow[(size_t)crow(r, hi) * LDP + d0 * 32 + r32] = (bf16_t)0;
#else
      for (int r = 0; r < 16; ++r) Ow[(size_t)crow(r, hi) * LDP + d0 * 32 + r32] = (bf16_t)(cvt_pk_bf16(o[d0][r] * ss[r] * g, 0.f) & 0xffffu);
#endif
    }
  }
  __syncthreads();
}
}

#define XB_TMO      128
#define XB_XCNT(j)  (256  + 64 * (j))
#define XB_XSUB(j)  (1280 + 64 * (j))
#define XB_XGEN(j)  (2304 + 64 * (j))
#define XB_TOP      3328
#define XB_TOPGEN   3392
#define XCD_BAR_WORDS 3456
#define XB_SPIN_CAP (1u << 20)
__device__ __forceinline__ unsigned xb_ld(unsigned* p)              { return __hip_atomic_load(p, __ATOMIC_RELAXED, __HIP_MEMORY_SCOPE_AGENT); }
__device__ __forceinline__ unsigned xb_add(unsigned* p, unsigned v) { return __hip_atomic_fetch_add(p, v, __ATOMIC_RELAXED, __HIP_MEMORY_SCOPE_AGENT); }
__device__ __forceinline__ unsigned xb_xcc_id() { return (unsigned)__builtin_amdgcn_s_getreg((3 << 11) | 20) & 0xFu; }
#define XB_SPIN(cond, bar) do { unsigned _sp = 0; while (cond) { __builtin_amdgcn_s_sleep(1); \
    if ((++_sp & 255u) == 0u) { if (xb_ld(&(bar)[XB_TMO])) break; if (_sp > XB_SPIN_CAP) { atomicAdd(&(bar)[XB_TMO], 1u); break; } } } } while (0)
struct XcdBarrier { unsigned* bar; unsigned x; volatile LAS unsigned* st; };
__device__ __forceinline__ XcdBarrier xcd_barrier_post(unsigned* bar, volatile LAS unsigned* st) {
    XcdBarrier b; b.bar = bar; b.x = xb_xcc_id(); b.st = st;
    if (threadIdx.x == 0) (void)xb_add(&bar[XB_XCNT(b.x)], 1u);
    return b;
}
__device__ __forceinline__ void xcd_barrier_complete(unsigned* bar, unsigned x, unsigned& nloc, unsigned& nx) {
    const unsigned G = gridDim.x * gridDim.y * gridDim.z;
    unsigned sum, cnt, mine, sp = 0u;
    for (;;) {
        sum = 0u; cnt = 0u; mine = 0u;
#pragma unroll
        for (unsigned j = 0; j < 16; ++j) { const unsigned c = xb_ld(&bar[XB_XCNT(j)]); sum += c; cnt += (c > 0u) ? 1u : 0u; mine = (j == x) ? c : mine; }
        if (sum == G) break;
        __builtin_amdgcn_s_sleep(1);
        if ((++sp & 255u) == 0u) { if (xb_ld(&bar[XB_TMO])) break; if (sp > XB_SPIN_CAP) { atomicAdd(&bar[XB_TMO], 1u); break; } }
    }
    nloc = mine > 0u ? mine : 1u; nx = cnt > 0u ? cnt : 1u;
}
__device__ __forceinline__ void xcd_barrier(const XcdBarrier& b) {
    asm volatile("s_waitcnt vmcnt(0)" ::: "memory");
    __syncthreads();
    if (threadIdx.x == 0) {
        unsigned* bar = b.bar;
        __builtin_amdgcn_s_waitcnt(0);
        unsigned nloc = b.st[0], nx = b.st[1];
        if (nloc == 0u) { xcd_barrier_complete(bar, b.x, nloc, nx); b.st[0] = nloc; b.st[1] = nx; }
        const unsigned old = xb_add(&bar[XB_XSUB(b.x)], 1u);
        const unsigned gen = old / nloc;
        if (old + 1u == (gen + 1u) * nloc) {
            __builtin_amdgcn_fence(__ATOMIC_RELEASE, "agent");
            asm volatile("s_waitcnt vmcnt(0)" ::: "memory");
            const unsigned og = xb_add(&bar[XB_TOP], 1u);
            const unsigned tg = og / nx;
            if (og + 1u == (tg + 1u) * nx) xb_add(&bar[XB_TOPGEN], 1u);
            else XB_SPIN(xb_ld(&bar[XB_TOPGEN]) == tg, bar);
            __builtin_amdgcn_fence(__ATOMIC_ACQUIRE, "agent");
            xb_add(&bar[XB_XGEN(b.x)], 1u);
            asm volatile("s_waitcnt vmcnt(0)" ::: "memory");
        } else {
            XB_SPIN(xb_ld(&bar[XB_XGEN(b.x)]) == gen, bar);
            __builtin_amdgcn_fence(__ATOMIC_ACQUIRE, "agent");
            asm volatile("s_waitcnt vmcnt(0)" ::: "memory");
        }
    }
    __syncthreads();
}

#define LDS_WAIT() asm volatile("s_waitcnt lgkmcnt(0)" ::: "memory")
__device__ __forceinline__ float wave_sum(float v) {
#pragma unroll
    for (int o = 1; o < 64; o <<= 1) v += __shfl_xor(v, o);
    return v;
}
__device__ __forceinline__ void tr_item(const float* W, int K, int N, bf16_t* WT, const float* rs, const float* cs, int perm_limit, LAS float* scr, int item, int lane) {
    const int nblk = N / 32, kb = item / nblk, nb = item % nblk, k0 = 64 * kb, n0 = 32 * nb;
    const float csv = cs ? cs[n0 + (lane & 31)] : 1.f;
    float wv[32], rv[32];
#pragma unroll
    for (int i = 0; i < 32; ++i) { const int kk = 2 * i + (lane >> 5); wv[i] = W[(size_t)(k0 + kk) * N + n0 + (lane & 31)]; rv[i] = rs ? rs[k0 + kk] : 1.f; }
#pragma unroll
    for (int i = 0; i < 32; ++i) { const int kk = 2 * i + (lane >> 5); scr[kk * 33 + (lane & 31)] = wv[i] * rv[i] * csv; }
    LDS_WAIT(); asm volatile("" ::: "memory");
    int d0 = n0; if (n0 < perm_limit) { const int tile = n0 >> 8, lb = (n0 >> 5) & 7; d0 = (tile << 8) + ((4 * (lb & 1) + (lb >> 1)) << 5); }
    if (perm_limit < 0) { const int isv = n0 >= D_FF, ch = n0 - (isv ? D_FF : 0); d0 = (ch >> 7) * 256 + isv * 128 + (ch & 127); }
    const int c = lane & 7;
#pragma unroll
    for (int j = 0; j < 4; ++j) { const int n = (lane >> 3) + 8 * j; const LAS float* s = scr + (8 * c) * 33 + n;
        u32x4 o; o.x = cvt_pk_bf16(s[0 * 33], s[1 * 33]); o.y = cvt_pk_bf16(s[2 * 33], s[3 * 33]); o.z = cvt_pk_bf16(s[4 * 33], s[5 * 33]); o.w = cvt_pk_bf16(s[6 * 33], s[7 * 33]);
        *(u32x4*)(WT + (size_t)(d0 + n) * K + k0 + 8 * c) = o; }
    LDS_WAIT(); asm volatile("" ::: "memory");
}
__device__ __forceinline__ void norm_row(const float* xrow, bf16_t* orow, float* crow_, int lane) {
    f32x4 v[8]; float s = 0.f;
#pragma unroll
    for (int j = 0; j < 4; ++j) { v[2 * j] = *(const f32x4*)(xrow + j * 512 + lane * 8); v[2 * j + 1] = *(const f32x4*)(xrow + j * 512 + lane * 8 + 4); s += pg8::sumsq4(v[2 * j]) + pg8::sumsq4(v[2 * j + 1]); }
    const float rstd = __builtin_amdgcn_rsqf(wave_sum(s) * (1.0f / D_MODEL) + EPS);
#pragma unroll
    for (int j = 0; j < 4; ++j) { if (crow_) { *(f32x4*)(crow_ + j * 512 + lane * 8) = v[2 * j]; *(f32x4*)(crow_ + j * 512 + lane * 8 + 4) = v[2 * j + 1]; }
        *(u32x4*)(orow + j * 512 + lane * 8) = pg8::pack8(v[2 * j] * rstd, v[2 * j + 1] * rstd); }
}

__device__ __forceinline__ void raw_row(const float* xrow, bf16_t* orow, rss_t* ssq, int lane) {
    f32x4 v[8]; float s = 0.f;
#pragma unroll
    for (int j = 0; j < 4; ++j) { v[2 * j] = *(const f32x4*)(xrow + j * 512 + lane * 8); v[2 * j + 1] = *(const f32x4*)(xrow + j * 512 + lane * 8 + 4); s += pg8::sumsq4(v[2 * j]) + pg8::sumsq4(v[2 * j + 1]); }
    s = wave_sum(s); if (lane == 0) *ssq = ss_fix(s);
#pragma unroll
    for (int j = 0; j < 4; ++j) *(u32x4*)(orow + j * 512 + lane * 8) = pg8::pack8(v[2 * j], v[2 * j + 1]);
}

template <int WIN> __device__ __forceinline__ void pool_item(const bf16_t* U, bf16_t* ZP, int r0, int ch, bool big) {
    constexpr int NR = 3 + 2 * WIN, SM = WIN / 2;
    const int pos0 = tok_pos(r0), S = tok_seqlen(r0);
    u32x4 v[NR];
#pragma unroll
    for (int k = 0; k < NR; ++k) { const int p = pos0 - WIN + k; v[k] = (p >= 0 && p < S) ? *(const u32x4*)(U + (size_t)(r0 - WIN + k) * 1024 + ch) : (u32x4){0u, 0u, 0u, 0u}; }
    float sb[8], ss[8];
#pragma unroll
    for (int j = 0; j < 8; ++j) { sb[j] = 0.f; ss[j] = 0.f; }
#define POOL_ACC(dst, k, sgn) do { const u32x4 w_ = v[k]; dst[0] += sgn bflo(w_.x); dst[1] += sgn bfhi(w_.x); dst[2] += sgn bflo(w_.y); dst[3] += sgn bfhi(w_.y); dst[4] += sgn bflo(w_.z); dst[5] += sgn bfhi(w_.z); dst[6] += sgn bflo(w_.w); dst[7] += sgn bfhi(w_.w); } while (0)
#pragma unroll
    for (int k = 0; k < 2 * WIN; ++k) { POOL_ACC(sb, k, +); if (k >= WIN - SM && k < WIN + SM) POOL_ACC(ss, k, +); }
#pragma unroll
    for (int i = 0; i < 4; ++i) {
        if (i > 0) { POOL_ACC(sb, i + 2 * WIN - 1, +); POOL_ACC(sb, i - 1, -); POOL_ACC(ss, i + WIN + SM - 1, +); POOL_ACC(ss, i + WIN - SM - 1, -); }
        const int pos = pos0 + i, w2 = big ? WIN : SM; const int lo_ = pos - w2 < 0 ? 0 : pos - w2, hi_ = pos + w2 > S ? S : pos + w2; const float inv = 1.0f / (float)(hi_ - lo_);
        const u32x4 c = v[WIN + i]; float s[8];
#pragma unroll
        for (int j = 0; j < 8; ++j) s[j] = (big ? sb[j] : ss[j]) * inv;
        u32x4 o; o.x = cvt_pk_bf16(s[0] - bflo(c.x), s[1] - bfhi(c.x)); o.y = cvt_pk_bf16(s[2] - bflo(c.y), s[3] - bfhi(c.y)); o.z = cvt_pk_bf16(s[4] - bflo(c.z), s[5] - bfhi(c.z)); o.w = cvt_pk_bf16(s[6] - bflo(c.w), s[7] - bfhi(c.w));
        *(u32x4*)(ZP + (size_t)(r0 + i) * 1024 + ch) = o; }
#undef POOL_ACC
}

struct Args { const float* in[28]; float* out; unsigned char* ws; int ph_lo, ph_hi; };

__global__ void __launch_bounds__(NWAVES * 64, 2) trunk_fwd(Args args) {
    extern __shared__ __attribute__((aligned(16))) unsigned char lds_raw[];
    LAS unsigned char* lds = (LAS unsigned char*)lds_raw;
    volatile LAS unsigned* MISC = (volatile LAS unsigned*)(lds + MISC_OFF);
    for (int u = threadIdx.x; u < (LDS_BYTES - LDSCTL_OFF) / 4; u += NWAVES * 64) ((LAS unsigned*)(lds + LDSCTL_OFF))[u] = 0u;
    __syncthreads();
    const int lo = args.ph_lo, hi = args.ph_hi;
    XcdBarrier bar; bar.bar = (unsigned*)(args.ws + WS_CTL) + CW_BAR; bar.x = 0; bar.st = nullptr;
    if (hi - lo > 1) bar = xcd_barrier_post((unsigned*)(args.ws + WS_CTL) + CW_BAR, MISC + 8);
#define IN(k) ({ int lo_ = lo, hi_ = hi; asm volatile("" : "+s"(lo_), "+s"(hi_)); lo_ <= (k) && (k) < hi_; })
#define SEAM(k) do { if (IN(k) && IN((k) + 1)) { XcdBarrier b2_ = bar; asm volatile("" : "+s"(b2_.bar), "+s"(b2_.x)); xcd_barrier(b2_); } } while (0)
#define PHASE_BEGIN() int tid = threadIdx.x; asm volatile("" : "+v"(tid)); int zo = 0; asm volatile("" : "+s"(zo)); \
    const int lane = tid & 63, wave = __builtin_amdgcn_readfirstlane(tid >> 6); const int G = gridDim.x, bx = blockIdx.x; \
    const int vcu = (G % 8 == 0) ? (bx % 8) * (G / 8) + bx / 8 : bx; const int gw = vcu * NWAVES + wave, NGW = G * NWAVES; \
    unsigned char* ws = args.ws + zo; float* X = args.out + zo; (void)lane; (void)wave; (void)gw; (void)NGW; (void)ws; (void)X; (void)vcu; (void)tid
#define INP(i) (args.in[(i) + zo])
#define WSP(T, off) ((T*)(ws + (off)))

    for (int l = 0; l < DEPTH; ++l) {
        const int pb = l * PH_PER_LAYER;
        if (PH_EN(0) && IN(pb + 0)) {
            PHASE_BEGIN();
            LAS float* scr = (LAS float*)(lds + wave * 16384);
            constexpr int I_IN = 32 * 128, I_OUT = 32 * 64, I_CQ = 32 * 64, I_CKV = 32 * 128, I_CO = 32 * 64, I_UP = 32 * (UP_W / 32), I_DOWN = (D_FF / 64) * 64, I_P = 4 * 32;
            constexpr int NITEMS = I_IN + I_OUT + I_CQ + I_CKV + I_CO + I_UP + I_DOWN + I_P;
            for (int it = gw; it < NITEMS; it += NGW) {
                int r = it;
                if (r < I_UP) { tr_item(INP(24) + (size_t)l * 2048 * UP_W, 2048, UP_W, WSP(bf16_t, WS_WUP), INP(23) + l * 2048, nullptr, -1, scr, r, lane); continue; } r -= I_UP;
                if (r < I_DOWN) { tr_item(INP(27) + (size_t)l * D_FF * 2048, D_FF, 2048, WSP(bf16_t, WS_WDOWN), nullptr, nullptr, 0, scr, r, lane); continue; } r -= I_DOWN;
                if (r < I_IN) { tr_item(INP(5) + (size_t)l * 2048 * 4096, 2048, 4096, WSP(bf16_t, WS_WIN), INP(4) + l * 2048, nullptr, 2048, scr, r, lane); continue; } r -= I_IN;
                if (r < I_CKV) { tr_item(INP(19) + (size_t)l * 2048 * 4096, 2048, 4096, WSP(bf16_t, WS_WCKV), INP(17) + l * 2048, nullptr, 0, scr, r, lane); continue; } r -= I_CKV;
                if (r < I_OUT) { tr_item(INP(15) + (size_t)l * 2048 * 2048, 2048, 2048, WSP(bf16_t, WS_WOUT), nullptr, nullptr, 0, scr, r, lane); continue; } r -= I_OUT;
                if (r < I_CQ) { tr_item(INP(18) + (size_t)l * 2048 * 2048, 2048, 2048, WSP(bf16_t, WS_WCQ), INP(16) + l * 2048, nullptr, 0, scr, r, lane); continue; } r -= I_CQ;
                if (r < I_CO) { tr_item(INP(22) + (size_t)l * 2048 * 2048, 2048, 2048, WSP(bf16_t, WS_WCO), nullptr, nullptr, 0, scr, r, lane); continue; } r -= I_CO;
                { const int g = r >> 5; tr_item(INP(13) + (size_t)l * 4 * 65536 + (size_t)g * 65536, 256, 256, WSP(bf16_t, WS_WP) + (size_t)g * 65536, nullptr, INP(14) + l * 1024 + g * 256, 0, scr, r & 31, lane); }
            }
            { const float* cw = INP(25) + (size_t)l * 3 * UP_W; const float* cb = INP(26) + (size_t)l * UP_W; u32x4* cwt = WSP(u32x4, WS_CWT);
              for (int ch = vcu * 512 + tid; ch < D_FF; ch += G * 512) { u32x4 w;
                  w.x = cvt_pk_bf16(cw[ch], cw[UP_W + ch]); w.y = cvt_pk_bf16(cw[2 * UP_W + ch], cb[ch]); w.z = cvt_pk_bf16(cw[D_FF + ch], cw[UP_W + D_FF + ch]); w.w = cvt_pk_bf16(cw[2 * UP_W + D_FF + ch], cb[D_FF + ch]); cwt[ch] = w; } }
            bf16_t* HB = WSP(bf16_t, WS_HB);
            if (l == 0) {
                unsigned* csT = WSP(unsigned, WS_COS);
                for (int e = (vcu * 512 + tid); e < 8192 * 32; e += G * 512) { const int pos = e >> 5, i = e & 31;
                    double inv = 1.0; const double b = 0.74989420933245582730;
                    for (int k = 0; k < i; ++k) inv *= b;
                    double rev = (double)pos * inv * 0.15915494309189533577; rev -= __builtin_floor(rev);
                    const float fr_ = (float)rev;
                    const _Float16 hc = (_Float16)__builtin_amdgcn_cosf(fr_), hs = (_Float16)__builtin_amdgcn_sinf(fr_);
                    csT[e] = (unsigned)__builtin_bit_cast(unsigned short, hc) | ((unsigned)__builtin_bit_cast(unsigned short, hs) << 16); }
                bf16_t* MB = WSP(bf16_t, WS_MB);
                for (int m = gw; m < NMEMROWS; m += NGW) { const float* src = m < 1024 ? INP(2) + (size_t)m * 2048 : INP(3) + (size_t)(m - 1024) * 2048; norm_row(src, MB + (size_t)m * 2048, nullptr, lane); }
                rss_t* rss0 = WSP(rss_t, WS_ROWSS);
                for (int m = gw; m < NTOK; m += NGW) { const float* src = m < NTOK_P ? INP(0) + (size_t)m * 2048 : INP(1) + (size_t)(m - NTOK_P) * 2048; raw_row(src, HB + (size_t)m * 2048, rss0 + m, lane); }
            }
        }
        SEAM(pb + 0);
        if (PH_EN(1) && IN(pb + 1)) {
            PHASE_BEGIN(); pg8::StaticOrder SO;
            if (PH_EN(17)) { pg8::ProbSimple P; P.K = 2048; P.lda = 2048; P.ldb = 2048; P.tsplit = 1 << 30; P.adelta = 0; P.A = (const char*)WSP(bf16_t, WS_HB); P.B = (const char*)WSP(bf16_t, WS_WIN);
              SO.init(NTOK / 256, IN_W / 256, G, bx);
              pg8::EpiIn E{WSP(bf16_t, R_Q), (size_t)NTOK * 1024, WSP(const unsigned, WS_COS), INP(6) + l * 64, INP(7) + l * 64, WSP(const rss_t, WS_ROWSS) + (size_t)(l * 3 + 0) * NTOK};
              pg8::gemm_phase<pg8::ProbSimple, pg8::EpiIn, true, true>(lds, P, SO, E); }
            if (PH_EN(16)) { pg8::ProbSimple P; P.K = 2048; P.lda = 2048; P.ldb = 2048; P.tsplit = 1 << 30; P.adelta = 0; P.A = (const char*)WSP(bf16_t, WS_MB); P.B = (const char*)WSP(bf16_t, WS_WCKV);
              SO.init(NMEMROWS / 256, 4096 / 256, G, bx);
              pg8::EpiKV E{WSP(float, WS_KRAW), WSP(bf16_t, WS_VT)};
              pg8::gemm_phase<pg8::ProbSimple, pg8::EpiKV, true, true>(lds, P, SO, E); }
        }
        SEAM(pb + 1);
        if (PH_EN(2) && IN(pb + 2)) {
            if (PH_EN(14)) { PHASE_BEGIN(); const bf16_t* U = WSP(const bf16_t, R_U); bf16_t* ZP = (bf16_t*)X;
#ifdef PROBE_DOUBLE_PASSES
              int nrq = 2; asm volatile("" : "+s"(nrq)); for (int rq_ = 0; rq_ < nrq; ++rq_)
#endif
              for (int it = gw; it < (NTOK / 4) * 2; it += NGW) { const int r0 = (it >> 1) * 4, half = it & 1, ch = half * 512 + lane * 8;
                  if (half == 0) pool_item<2>(U, ZP, r0, ch, lane >= 32); else pool_item<8>(U, ZP, r0, ch, lane >= 32); } }
            if (PH_EN(15)) { PHASE_BEGIN(); const float* gcq = INP(20) + l * 512; const float* gck = INP(21) + l * 512; const float* KRAW = WSP(const float, WS_KRAW); bf16_t* KC = WSP(bf16_t, WS_KC);
              for (int it = gw; it < NMEMROWS * 4; it += NGW) { const int row = it >> 2, h = it & 3; const float* kr = KRAW + (size_t)row * 2048 + h * 512 + lane * 8;
                  const f32x4 a = *(const f32x4*)kr, b = *(const f32x4*)(kr + 4); const float ss = wave_sum(pg8::sumsq4(a) + pg8::sumsq4(b));
                  const float rk = __builtin_amdgcn_rsqf(ss * (1.0f / 512.0f) + EPS);
                  const f32x4 ga = *(const f32x4*)(gcq + lane * 8) * *(const f32x4*)(gck + lane * 8), gb = *(const f32x4*)(gcq + lane * 8 + 4) * *(const f32x4*)(gck + lane * 8 + 4);
                  *(u32x4*)(KC + (size_t)row * 2048 + h * 512 + lane * 8) = pg8::pack8(a * rk * ga, b * rk * gb); } }
            if (PH_EN(18)) {
              PHASE_BEGIN();
              const float lam_init = 0.8f - 0.6f * __expf(-0.3f * (float)l);
              float s1 = 0.f, s2 = 0.f; const float* q1 = INP(8) + l * 64; const float* k1 = INP(9) + l * 64; const float* q2 = INP(10) + l * 64; const float* k2 = INP(11) + l * 64;
              for (int i = 0; i < 64; ++i) { s1 += q1[i] * k1[i]; s2 += q2[i] * k2[i]; }
              const float lam = __expf(s1) - __expf(s2) + lam_init;
              const float* gsub = INP(12) + l * 128;
              bf16_t* Qb = WSP(bf16_t, R_Q); const bf16_t* Kb = WSP(const bf16_t, R_K); const bf16_t* Vb = WSP(const bf16_t, R_V);
              __syncthreads();
              { const int NX = (G % 8 == 0) ? 8 : 1, xcd = bx % NX, j = bx / NX, nb = G / NX, npr = 2048 / NX;
                  for (int kk = j; kk < 2 * npr; kk += nb) { int pair, qt, S; size_t t0;
                      if (kk < npr) { pair = xcd + NX * (kk >> 6); qt = kk & 63; S = S_P; t0 = (size_t)(pair >> 3) * S_P; }
                      else { const int k2_ = kk - npr; pair = xcd + NX * (k2_ >> 5); qt = k2_ & 31; S = S_S; t0 = (size_t)NTOK_P + (size_t)(pair >> 3) * S_S; }
                      const int h = pair & 7; bf16_t* qp = Qb + (t0 + (size_t)qt * 128) * 1024 + h * 128;
                      att::attn_unit(qp, Kb + t0 * 1024 + h * 128, Vb + t0 * 1024 + h * 128, qp, S, lam, gsub, 1.f - lam_init, lds); }
              }
            }
        }
        SEAM(pb + 2);
        if (PH_EN(3) && IN(pb + 3)) {
            PHASE_BEGIN(); pg8::StaticOrder SO;
            pg8::ProbPool P; P.K = 256; P.lda = 1024; P.ldb = 256; P.tsplit = 1 << 30; P.adelta = 0; P.A = (const char*)X; P.B = (const char*)WSP(bf16_t, WS_WP);
            SO.init(NTOK / 256, 4, G, bx);
            pg8::EpiBf<0> E{WSP(bf16_t, R_POUT), 1024, nullptr, nullptr, nullptr};
            pg8::gemm_phase<pg8::ProbPool, pg8::EpiBf<0>, true, true>(lds, P, SO, E);
            { pg8::ProbVW P2; P2.K = 512; P2.lda = 2048; P2.ldb = 2048; P2.tsplit = 1 << 30; P2.adelta = 0; P2.A = (const char*)WSP(bf16_t, WS_WCO); P2.B = (const char*)WSP(bf16_t, WS_VT);
              SO.init(8, 48, G, bx);
              pg8::EpiBf<5> E2{WSP(bf16_t, R_VW), 1024, nullptr, nullptr, nullptr};
              pg8::gemm_phase<pg8::ProbVW, pg8::EpiBf<5>, true, true>(lds, P2, SO, E2); }
#ifdef PROBE_DOUBLE_ATTN
            {
              const float* gsub = INP(12) + l * 128; bf16_t* Qb = WSP(bf16_t, R_Q); const bf16_t* Kb = WSP(const bf16_t, R_K); const bf16_t* Vb = WSP(const bf16_t, R_V); bf16_t* Ob = WSP(bf16_t, R_U);
              __syncthreads();
              const int NX = (G % 8 == 0) ? 8 : 1, xcd = bx % NX, j = bx / NX, nb = G / NX, npr = 2048 / NX;
              for (int kk = j; kk < 2 * npr; kk += nb) { int pair, qt, S; size_t t0;
                  if (kk < npr) { pair = xcd + NX * (kk >> 6); qt = kk & 63; S = S_P; t0 = (size_t)(pair >> 3) * S_P; }
                  else { const int k2_ = kk - npr; pair = xcd + NX * (k2_ >> 5); qt = k2_ & 31; S = S_S; t0 = (size_t)NTOK_P + (size_t)(pair >> 3) * S_S; }
                  const int h = pair & 7; const size_t qo = (t0 + (size_t)qt * 128) * 1024 + h * 128;
                  att::attn_unit(Qb + qo, Kb + t0 * 1024 + h * 128, Vb + t0 * 1024 + h * 128, Ob + qo, S, 0.3f, gsub, 1.f, lds); }
            }
#endif
        }
        SEAM(pb + 3);
        if (PH_EN(4) && IN(pb + 4)) {
            PHASE_BEGIN(); pg8::StaticOrder SO;
            pg8::ProbSimple P; P.K = 2048; P.lda = 1024; P.ldb = 2048; P.tsplit = 16; P.adelta = (long long)R_POUT - (long long)R_Q - 16ll * 128; P.A = (const char*)(ws + R_Q); P.B = (const char*)WSP(bf16_t, WS_WOUT);
            SO.init(NTOK / 256, 8, G, bx);
            pg8::EpiRes E{WSP(bf16_t, WS_HB), WSP(rss_t, WS_ROWSS) + (size_t)(l * 3 + 1) * NTOK, nullptr};
            pg8::gemm_phase<pg8::ProbSimple, pg8::EpiRes, true, true>(lds, P, SO, E);
        }
        SEAM(pb + 4);
        if (PH_EN(5) && IN(pb + 5)) {
            PHASE_BEGIN(); pg8::StaticOrder SO;
            pg8::ProbSimple P; P.K = 2048; P.lda = 2048; P.ldb = 2048; P.tsplit = 1 << 30; P.adelta = 0; P.A = (const char*)WSP(bf16_t, WS_HB); P.B = (const char*)WSP(bf16_t, WS_WCQ);
            SO.init(NTOK / 256, 8, G, bx);
            pg8::EpiBf<1> E{WSP(bf16_t, R_QC), 2048, WSP(float, WS_QSS), (float*)(WSP(rss_t, WS_ROWSS) + (size_t)(l * 3 + 1) * NTOK), nullptr};
            pg8::gemm_phase<pg8::ProbSimple, pg8::EpiBf<1>, true, true>(lds, P, SO, E);
        }
        SEAM(pb + 5);
        if (PH_EN(6) && IN(pb + 6)) {
            PHASE_BEGIN(); pg8::StaticOrder SO;
            pg8::ProbScores P; P.K = 512; P.lda = 2048; P.ldb = 2048; P.tsplit = 1 << 30; P.adelta = 0; P.A = (const char*)(ws + R_QC); P.B = (const char*)WSP(bf16_t, WS_KC);
            SO.init(NTOK / 256, 4, G, bx);
            pg8::EpiBf<2> E{WSP(bf16_t, R_P), 1024, WSP(float, WS_QSS), nullptr, (LAS float*)(lds + XCH_OFF)};
            pg8::gemm_phase<pg8::ProbScores, pg8::EpiBf<2>, true, true>(lds, P, SO, E);
        }
        SEAM(pb + 6);
        if (PH_EN(8) && IN(pb + 7)) {
            PHASE_BEGIN(); pg8::StaticOrder SO;
            pg8::ProbFin P; P.K = 1024; P.lda = 1024; P.ldb = 1024; P.tsplit = 1 << 30; P.adelta = 0; P.A = (const char*)(ws + R_P); P.B = (const char*)WSP(bf16_t, R_VW);
            SO.init(NTOK / 256, 8, G, bx);
            pg8::EpiRes E{WSP(bf16_t, WS_HB), WSP(rss_t, WS_ROWSS) + (size_t)(l * 3 + 2) * NTOK, nullptr};
            pg8::gemm_phase<pg8::ProbFin, pg8::EpiRes, true, true>(lds, P, SO, E);
        }
        SEAM(pb + 7);
        for (int c = 0; c < N_FFN_CHUNKS; ++c) {
            const int pc = pb + 8 + 2 * c; const size_t r0 = (size_t)c * FFN_CHUNK;
            if (PH_EN(11) && IN(pc)) {
                PHASE_BEGIN(); pg8::StaticOrder SO;
                pg8::ProbUp P; P.K = 2048; P.lda = 2048; P.ldb = 2048; P.tsplit = 1 << 30; P.adelta = 0; P.A = (const char*)(WSP(bf16_t, WS_HB) + r0 * 2048); P.B = (const char*)WSP(bf16_t, WS_WUP); P.chunk = c;
                SO.init(FFN_MT + FFN_BT, D_FF / 128, G, bx);
                pg8::EpiGlu E{WSP(bf16_t, R_G), WSP(const rss_t, WS_ROWSS) + (size_t)(l * 3 + 2) * NTOK + r0, WSP(const u32x4, WS_CWT), c, (LAS float*)(lds + GLX_OFF)};
                pg8::gemm_phase<pg8::ProbUp, pg8::EpiGlu, true, true>(lds, P, SO, E);
            }
            SEAM(pc);
            if (PH_EN(13) && IN(pc + 1)) {
                PHASE_BEGIN(); pg8::StaticOrder SO;
                pg8::ProbSimple P; P.K = D_FF; P.lda = D_FF; P.ldb = D_FF; P.tsplit = 1 << 30; P.adelta = 0; P.A = (const char*)(ws + R_G); P.B = (const char*)WSP(bf16_t, WS_WDOWN);
                SO.init(FFN_MT, 8, G, bx);
                pg8::EpiRes E{WSP(bf16_t, WS_HB) + r0 * 2048, (l + 1 < DEPTH) ? WSP(rss_t, WS_ROWSS) + (size_t)((l + 1) * 3 + 0) * NTOK + r0 : nullptr, (l + 1 < DEPTH) ? nullptr : X + r0 * 2048};
                pg8::gemm_phase<pg8::ProbSimple, pg8::EpiRes, true, true>(lds, P, SO, E);
            }
            SEAM(pc + 1);
        }
    }
#undef IN
#undef SEAM
#undef PHASE_BEGIN
#undef INP
#undef WSP
}


#ifdef SELFCHECK
constexpr int CHK_WORD = 1024;
__device__ __forceinline__ void chk_upd(unsigned* ctl, int idx, float got, float ref) { const float e = fabsf(got - ref) / (0.03f * fabsf(ref) + 0.03f); atomicMax(ctl + CHK_WORD + idx, __float_as_uint(e)); }
__device__ __forceinline__ int chk_token(int s) { const int tab[16] = {0, 1, 127, 128, 4095, 8191, 8192, 12345, 32767, 32768, 32769, 36863, 36864, 50000, 65534, 65535}; int t = 0;
#pragma unroll
    for (int i = 0; i < 16; ++i) t = (s & 15) == i ? tab[i] : t; return t; }
__global__ void __launch_bounds__(64) check_kernel(Args args, int after, int l) {
    const int s = blockIdx.x, lane = threadIdx.x; unsigned char* ws = args.ws; unsigned* ctl = (unsigned*)(ws + WS_CTL);
    const int tok = chk_token(s); float* X = args.out;
    const float* xin = tok < NTOK_P ? args.in[0] + (size_t)tok * 2048 : args.in[1] + (size_t)(tok - NTOK_P) * 2048;
    if (after == 1) {
        if (l == 0) {
            float ssx = 0.f; for (int k = lane; k < 2048; k += 64) ssx += xin[k] * xin[k]; ssx = wave_sum(ssx); const float rstd = 1.0f / sqrtf(ssx / 2048.f + EPS);
            const int vec = (s * 7) & 31, isk = vec >> 4, hc = vec & 15;
            const float* w_in = args.in[5]; const float* g_mix = args.in[4]; const int col = isk * 1024 + hc * 64 + lane;
            float z = 0.f; for (int k = 0; k < 2048; ++k) z += xin[k] * rstd * g_mix[k] * w_in[(size_t)k * 4096 + col];
            const float ss = wave_sum(z * z); const float g = (isk ? args.in[7] : args.in[6])[lane]; const float zn = z / sqrtf(ss / 64.f + EPS) * g;
            const float other = __shfl_xor(zn, 32); const int i = lane & 31; const int pos = tok_pos(tok);
            const float ang = (float)pos * powf(10000.f, -(float)i / 32.f); const float c = cosf(ang), sn = sinf(ang);
            const float ref = lane < 32 ? zn * c - other * sn : zn * c + other * sn;
            const bf16_t* Q = (const bf16_t*)(ws + (isk ? R_K : R_Q)); const float got = bf2f(Q[(size_t)tok * 1024 + hc * 64 + lane]);
            const float gother = __shfl_xor(got, 32);
            (void)gother; chk_upd(ctl, 0, got, ref);
            { const unsigned tv = ((const unsigned*)(ws + WS_COS))[pos * 32 + i]; typedef _Float16 h2 __attribute__((ext_vector_type(2))); const h2 hv = __builtin_bit_cast(h2, tv);
              chk_upd(ctl, 1, (float)hv.x, c); chk_upd(ctl, 1, (float)hv.y, sn); }
        }
        { const bf16_t* Q = (const bf16_t*)(ws + R_Q); bf16_t* sv = (bf16_t*)(ws + WS_CHK) + s * 128; const int h = s & 7; sv[lane] = Q[(size_t)tok * 1024 + h * 128 + lane]; sv[lane + 64] = Q[(size_t)tok * 1024 + h * 128 + 64 + lane]; }
    }
    if (after == 2) {
        const int h = s & 7; const bf16_t* sv = (const bf16_t*)(ws + WS_CHK) + s * 128; const int S = tok_seqlen(tok); const size_t t0 = (size_t)tok - tok_pos(tok);
        const bf16_t* K = (const bf16_t*)(ws + R_K) + t0 * 1024 + h * 128; const bf16_t* V = (const bf16_t*)(ws + R_V) + t0 * 1024 + h * 128;
        const float lam_init = 0.8f - 0.6f * expf(-0.3f * (float)l); float s1 = 0.f, s2 = 0.f;
        for (int i = 0; i < 64; ++i) { s1 += (args.in[8] + l * 64)[i] * (args.in[9] + l * 64)[i]; s2 += (args.in[10] + l * 64)[i] * (args.in[11] + l * 64)[i]; }
        const float lam = expf(s1) - expf(s2) + lam_init;
        float o[2][2];
        for (int c = 0; c < 2; ++c) { float mx = -1e30f;
            for (int k = lane; k < S; k += 64) { float d = 0.f; for (int e = 0; e < 64; ++e) d += bf2f(sv[c * 64 + e]) * bf2f(K[(size_t)k * 1024 + c * 64 + e]); mx = fmaxf(mx, d); }
            for (int o_ = 1; o_ < 64; o_ <<= 1) mx = fmaxf(mx, __shfl_xor(mx, o_));
            float lsum = 0.f, a0 = 0.f, a1 = 0.f;
            for (int k = 0; k < S; ++k) { float d = 0.f; for (int e = 0; e < 64; ++e) d += bf2f(sv[c * 64 + e]) * bf2f(K[(size_t)k * 1024 + c * 64 + e]);
                const float p = exp2f(d - mx); lsum += p; a0 += p * bf2f(V[(size_t)k * 1024 + lane]); a1 += p * bf2f(V[(size_t)k * 1024 + 64 + lane]); }
            o[c][0] = a0 / lsum; o[c][1] = a1 / lsum; }
        const float v0 = o[0][0] - lam * o[1][0], v1 = o[0][1] - lam * o[1][1]; const float ss = wave_sum(v0 * v0 + v1 * v1); const float rn = 1.0f / sqrtf(ss / 128.f + EPS) * (1.f - lam_init);
        const float* gsub = args.in[12] + l * 128; const bf16_t* A = (const bf16_t*)(ws + R_Q) + (size_t)tok * 1024 + h * 128;
        chk_upd(ctl, 2, bf2f(A[lane]), v0 * rn * gsub[lane]); chk_upd(ctl, 2, bf2f(A[64 + lane]), v1 * rn * gsub[64 + lane]);
    }
    if (after == 4 && l == 0) {
        const bf16_t* A = (const bf16_t*)(ws + R_Q) + (size_t)tok * 1024; const bf16_t* Pp = (const bf16_t*)(ws + R_POUT) + (size_t)tok * 1024; const float* w_out = args.in[15];
        const int col = (s * 131 + lane * 17) & 2047; float z = xin[col];
        for (int k = 0; k < 1024; ++k) z += bf2f(A[k]) * w_out[(size_t)k * 2048 + col];
        for (int k = 0; k < 1024; ++k) z += bf2f(Pp[k]) * w_out[(size_t)(1024 + k) * 2048 + col];
        chk_upd(ctl, 3, X[(size_t)tok * 2048 + col], z);
    }
    if (after == 8 && tok < FFN_CHUNK) {
        const bf16_t* HB = (const bf16_t*)(ws + WS_HB); const float* w_up = args.in[24] + (size_t)l * 2048 * UP_W; const float* g_ffn = args.in[23] + l * 2048;
        const float* cw = args.in[25] + (size_t)l * 3 * UP_W; const float* cb = args.in[26] + (size_t)l * UP_W;
        const int j = (s * 977 + lane * 53) % D_FF; const int pos = tok_pos(tok), S = tok_seqlen(tok); float u2[2];
        for (int half = 0; half < 2; ++half) { const int col = half * D_FF + j; float acc = cb[col];
            for (int tap = 0; tap < 3; ++tap) { const int pp = pos + tap - 1; if (pp < 0 || pp >= S) continue; const bf16_t* hr = HB + (size_t)(tok + tap - 1) * 2048; float d = 0.f;
                for (int k = 0; k < 2048; ++k) d += bf2f(hr[k]) * g_ffn[k] * w_up[(size_t)k * UP_W + col];
                const float rxx = ss_rstd(((const rss_t*)(ws + WS_ROWSS))[(size_t)(l * 3 + 2) * NTOK + tok + tap - 1]); acc += d * rxx * cw[(size_t)tap * UP_W + col]; }
            u2[half] = acc; }
        const float x = u2[0]; const float ref = 0.5f * x * (1.f + tanhf(0.7978845608028654f * (x + 0.044715f * x * x * x))) * u2[1];
        chk_upd(ctl, 4, bf2f(((const bf16_t*)(ws + R_G))[(size_t)tok * D_FF + j]), ref);
    }
    if (false) {
        const bf16_t* Gr = (const bf16_t*)(ws + R_G) + (size_t)tok * D_FF; const float* w_down = args.in[27] + (size_t)l * D_FF * 2048; const float* svx = (const float*)(ws + WS_CHK + 65536) + (size_t)s * 2048;
        const int col = (s * 131 + lane * 17) & 2047; float z = svx[col]; for (int k = 0; k < D_FF; ++k) z += bf2f(Gr[k]) * w_down[(size_t)k * 2048 + col];
        chk_upd(ctl, 5, X[(size_t)tok * 2048 + col], z);
    }
}
__global__ void __launch_bounds__(256) report_kernel(Args args) {
    unsigned* ctl = (unsigned*)(args.ws + WS_CTL); float* out = args.out;
    for (size_t i = (size_t)blockIdx.x * 256 + threadIdx.x; i < (size_t)NTOK * 2048; i += (size_t)gridDim.x * 256) {
        float v = 0.f;
        if (i == 0) { int mask = 0; for (int b = 0; b < 6; ++b) if (__uint_as_float(ctl[CHK_WORD + b]) > 1.0f) mask |= 1 << b; v = (10.f + (float)mask) * 1000.f; }
        out[i] = v; }
}
#endif

extern "C" void kernel_launch(void* const* d_in, const int* in_sizes, int n_in, void* d_out, int out_size, void* d_ws, size_t ws_size, hipStream_t stream) {
    static int grid = 0;
    if (grid == 0) {
        if (n_in != 28 || out_size != NTOK * D_MODEL || ws_size < WS_END) { fprintf(stderr, "kernel_launch: unexpected shapes: n_in %d out %d ws %zu (need >= %zu)\n", n_in, out_size, ws_size, (size_t)WS_END); grid = -1; return; }
        int dev = 0, cus = 0, per_cu = 0;
        if (hipGetDevice(&dev) != hipSuccess || hipDeviceGetAttribute(&cus, hipDeviceAttributeMultiprocessorCount, dev) != hipSuccess) { grid = -1; return; }
        if (hipFuncSetAttribute((const void*)trunk_fwd, hipFuncAttributeMaxDynamicSharedMemorySize, LDS_BYTES) != hipSuccess) { fprintf(stderr, "kernel_launch: hipFuncSetAttribute failed\n"); grid = -1; return; }
        if (hipOccupancyMaxActiveBlocksPerMultiprocessor(&per_cu, (const void*)trunk_fwd, NWAVES * 64, LDS_BYTES) != hipSuccess || per_cu < 1)
            fprintf(stderr, "kernel_launch: occupancy query reports %d workgroups per CU\n", per_cu);
        (void)hipGetLastError();
        grid = cus;
    }
    if (grid < 0) return;
    (void)hipMemsetAsync((char*)d_ws + WS_CTL, 0, CTL_ZERO_BYTES, stream);
    Args a{};
    for (int i = 0; i < 28; ++i) a.in[i] = (const float*)d_in[i];
    a.out = (float*)d_out; a.ws = (unsigned char*)d_ws;
#if ML_PER_PHASE
    for (int p = 0; p < N_PHASES; ++p) { a.ph_lo = p; a.ph_hi = p + 1; hipLaunchKernelGGL(trunk_fwd, dim3(grid), dim3(NWAVES * 64), LDS_BYTES, stream, a);
#ifdef SELFCHECK
        { const int l = p / PH_PER_LAYER, q = p % PH_PER_LAYER; if (l == SELFCHECK_LAYER && (q == 1 || q == 2 || q == 8)) hipLaunchKernelGGL(check_kernel, dim3(64), dim3(64), 0, stream, a, q, l); }
#endif
    }
#ifdef SELFCHECK
    hipLaunchKernelGGL(report_kernel, dim3(2048), dim3(256), 0, stream, a);
#endif
#else
    a.ph_lo = 0; a.ph_hi = N_PHASES;
    hipLaunchKernelGGL(trunk_fwd, dim3(grid), dim3(NWAVES * 64), LDS_BYTES, stream, a);
#endif
    const hipError_t le = hipPeekAtLastError();
    if (le != hipSuccess) fprintf(stderr, "kernel_launch: launch failed: %s\n", hipGetErrorName(le));
}
```

```cpp
#include <hip/hip_runtime.h>
#include <cstdio>
#include <cstdint>

#define SELFCHECK_LAYER 0
#ifndef ML_PER_PHASE
#define ML_PER_PHASE 0
#endif

#ifndef PHASE_MASK
#define PHASE_MASK 0xFFFFFFFFu
#endif
#define PH_EN(p) (((PHASE_MASK) >> (p)) & 1u)
#define LAS __attribute__((address_space(3)))
#define GAS __attribute__((address_space(1)))
typedef unsigned short bf16_t;
typedef short bf16x8 __attribute__((ext_vector_type(8)));
typedef short s16x4 __attribute__((ext_vector_type(4)));
typedef float f32x4 __attribute__((ext_vector_type(4)));
typedef float f32x2 __attribute__((ext_vector_type(2)));
typedef float f32x16 __attribute__((ext_vector_type(16)));
typedef unsigned u32x4 __attribute__((ext_vector_type(4)));
typedef unsigned u32x2 __attribute__((ext_vector_type(2)));

constexpr int D_MODEL = 2048, DEPTH = 2;
constexpr int NTOK = 65536;
constexpr int NTOK_P = 32768;
constexpr int S_P = 8192, S_S = 4096;
constexpr int NMEMROWS = 3072;
constexpr int IN_W = 4096, D_FF = 5632, UP_W = 11264;
constexpr float EPS = 1e-6f;
constexpr float QSCALE = 0.125f * 1.4426950408889634f;
constexpr int FFN_CHUNK = 32768, N_FFN_CHUNKS = 2;
constexpr int FFN_MT = FFN_CHUNK / 256, FFN_BT = 2;
constexpr int PH_PER_LAYER = 8 + 2 * N_FFN_CHUNKS;
constexpr int N_PHASES = DEPTH * PH_PER_LAYER;

constexpr size_t MiB = 1u << 20;
constexpr size_t WS_CTL = 0, CTL_ZERO_BYTES = 5 * MiB;
constexpr size_t WS_ROWSS = 1 * MiB;
constexpr size_t WS_COS = 5 * MiB;
constexpr size_t WS_QSS = 6 * MiB;
constexpr size_t WS_LPART = 14 * MiB;
constexpr size_t WS_MB = 18 * MiB;
constexpr size_t WS_KRAW = 30 * MiB;
constexpr size_t WS_KC = 54 * MiB;
constexpr size_t WS_VT = 66 * MiB;
constexpr size_t WS_CHK = 78 * MiB;
constexpr size_t WS_WIN = 79 * MiB, WS_WP = 95 * MiB, WS_WOUT = 96 * MiB, WS_WCQ = 104 * MiB, WS_WCKV = 112 * MiB, WS_WCO = 128 * MiB, WS_WUP = 136 * MiB, WS_WDOWN = 180 * MiB;
constexpr size_t WS_HB = 203 * MiB;
constexpr size_t WS_R = 459 * MiB;
constexpr size_t WS_CWT = 987 * MiB;
constexpr size_t WS_END = 988 * MiB;
typedef unsigned long long rss_t;
__device__ __forceinline__ rss_t ss_fix(float s) { return (rss_t)(s * 1048576.0f + 0.5f); }
__device__ __forceinline__ float ss_rstd(rss_t v) { return __builtin_amdgcn_rsqf((float)v * (1.0f / (1048576.0f * 2048.0f)) + 1e-6f); }
constexpr size_t R_Q = WS_R, R_K = WS_R + 128 * MiB, R_V = WS_R + 256 * MiB, R_U = WS_R + 384 * MiB;
constexpr size_t R_QC = WS_R, R_P = WS_R + 256 * MiB, R_VW = WS_R + 384 * MiB;
constexpr size_t R_G = WS_R;
constexpr size_t R_POUT = WS_R + 128 * MiB;
static_assert(R_G + (size_t)FFN_CHUNK * D_FF * 2 <= WS_END, "ws map");
constexpr int CW_BAR = 4096;

constexpr int RING_BYTES = 131072;
constexpr int LDSCTL_OFF = RING_BYTES, MISC_OFF = LDSCTL_OFF + 320, XCH_OFF = LDSCTL_OFF + 1024, GLX_OFF = XCH_OFF + 4096;
constexpr int LDS_BYTES = 151552;
constexpr int NWAVES = 8;

__device__ __forceinline__ unsigned cvt_pk_bf16(float lo, float hi) { unsigned r; asm volatile("v_cvt_pk_bf16_f32 %0, %1, %2" : "=v"(r) : "v"(lo), "v"(hi)); return r; }
__device__ __forceinline__ float bf2f(unsigned short b) { return __uint_as_float(((unsigned)b) << 16); }
__device__ __forceinline__ float bflo(unsigned w) { return __uint_as_float(w << 16); }
__device__ __forceinline__ float bfhi(unsigned w) { return __uint_as_float(w & 0xffff0000u); }
__device__ __forceinline__ int tok_pos(int row) { return row < NTOK_P ? (row & (S_P - 1)) : (row & (S_S - 1)); }
__device__ __forceinline__ int tok_seqlen(int row) { return row < NTOK_P ? S_P : S_S; }
__device__ __forceinline__ int tile_batch(int pm) { return pm < 128 ? (pm >> 5) : 4 + ((pm - 128) >> 4); }

namespace pg8 {
constexpr int BM = 256, BK = 64, HALF = 128, HTB = HALF * BK * 2, STAGE_BYTES = 8 * HTB, NXCD = 8, WGM = 4;
__host__ __device__ __forceinline__ int lds_byte(int r, int c) { const int st = (r >> 4) * 2 + (c >> 5), rr = r & 15, cc = c & 31, ob = rr * 64 + cc * 2; return st * 1024 + (ob ^ (((ob >> 9) & 1) << 5)); }
__host__ __device__ __forceinline__ void stage_rc(int b, int& R, int& C) { const int st = b / 1024, sb = b % 1024, swz = sb ^ (((sb >> 9) & 1) << 5); R = (st >> 1) * 16 + swz / 64; C = (st & 1) * 32 + (swz % 64) / 2; }
__host__ __device__ __forceinline__ int perm32(int rho) { const int n = rho >> 4, i = rho & 15; return 8 * (i >> 2) + 4 * n + (i & 3); }
struct Unit { int pm, pn; };
struct StaticOrder {
    int nM, nN, nwg, G, c;
    __host__ __device__ void init(int nM_, int nN_, int G_, int c_) { nM = nM_; nN = nN_; nwg = nM * nN; G = G_; c = c_; }
    __host__ __device__ bool next(int i, Unit& u) const {
        const long L = (long)i * G + c; if (L >= nwg) return false;
        int wgid = (int)L; { const int q = nwg / NXCD, r = nwg % NXCD, xcd = wgid % NXCD, off = wgid / NXCD; wgid = (xcd < r ? xcd * (q + 1) : r * (q + 1) + (xcd - r) * q) + off; }
        const int nig = WGM * nN, gid = wgid / nig, fm = gid * WGM, gsz = (nM - fm) < WGM ? (nM - fm) : WGM;
        u.pm = fm + ((wgid % nig) % gsz); u.pn = (wgid % nig) / gsz; return true;
    }
};
struct ProbBase { static constexpr bool GATHER = false; int K, lda, ldb, tsplit; long long adelta; __device__ __forceinline__ unsigned rowoff(const Unit&, int) const { return 0u; } };

template <class Prob, class Epi, bool ALIGN_EPI, bool SP2>
__device__ __forceinline__ void gemm_phase(LAS unsigned char* lds, const Prob& P, const StaticOrder& S, const Epi& E) {
    static_assert(SP2, "only the two-super-phase loop is kept in this file");
    int tid_l = threadIdx.x; asm volatile("" : "+v"(tid_l));
    const int tid = tid_l, wid = __builtin_amdgcn_readfirstlane(tid >> 6), lane = tid & 63, wr = wid >> 2, wc = wid & 3, fr = lane & 15, fq = lane >> 4;
    const int K = P.K, nt = K / BK, lda = P.lda, ldb = P.ldb, tsplit = P.tsplit; const long long adelta = P.adelta;
    unsigned voffA[2], voffB[2];
#pragma unroll
    for (int i = 0; i < 2; ++i) { int R, C; stage_rc(tid * 16 + i * 8192, R, C); const int Rb = Epi::PERM ? ((R & ~31) + perm32(R & 31)) : R;
        voffA[i] = (unsigned)(R * lda + C) * 2u; voffB[i] = (unsigned)(Rb * ldb + C) * 2u; }
    const size_t kstep = (size_t)(BK * 2);
    const size_t hstepA = (size_t)HALF * lda * 2, hstepB = (size_t)HALF * ldb * 2;
    const unsigned ldsw = (unsigned)wid * 1024u;
    const int aoff = lds_byte(wr * 64 + fr, fq * 8), boff = lds_byte(wc * 32 + fr, fq * 8);
    unsigned vAc[2][2], vAn[2][2];
#define PG8_SA(b, h) (((b) * 2 + (h)) * HTB)
#define PG8_SB(b, h) ((4 + (b) * 2 + (h)) * HTB)
#define PG8_STAGE(bufoff, gbase, voff) do { _Pragma("unroll") for (int _i = 0; _i < 2; ++_i) \
        __builtin_amdgcn_global_load_lds((const unsigned*)((const char*)(gbase) + (voff)[_i]), (LAS unsigned*)(lds + (bufoff) + ldsw + _i * 8192), 16, 0, 0); } while (0)
#define PG8_STAGE_A(bufoff, kptr, h, NXT) do { if constexpr (Prob::GATHER) { _Pragma("unroll") for (int _i = 0; _i < 2; ++_i) \
        __builtin_amdgcn_global_load_lds((const unsigned*)((const char*)(kptr) + ((NXT) ? vAn[h][_i] : vAc[h][_i])), (LAS unsigned*)(lds + (bufoff) + ldsw + _i * 8192), 16, 0, 0); } \
        else { PG8_STAGE(bufoff, (kptr) + (h) * hstepA, voffA); } } while (0)
#define PG8_GATHER_OFFS(dst, unit) do { _Pragma("unroll") for (int _i = 0; _i < 2; ++_i) { int _R, _C; stage_rc(tid * 16 + _i * 8192, _R, _C); _Pragma("unroll") for (int _h = 0; _h < 2; ++_h) dst[_h][_i] = P.rowoff(unit, _R + 128 * _h) + (unsigned)_C * 2u; } } while (0)
#define PG8_LDA(dst, b, h) do { _Pragma("unroll") for (int m = 0; m < 4; ++m) _Pragma("unroll") for (int k = 0; k < 2; ++k) dst[m][k] = *(const LAS bf16x8*)(lds + PG8_SA(b, h) + aoff + m * 2048 + k * 1024); } while (0)
#define PG8_LDB(dst, b, h) do { _Pragma("unroll") for (int n = 0; n < 2; ++n) _Pragma("unroll") for (int k = 0; k < 2; ++k) dst[n][k] = *(const LAS bf16x8*)(lds + PG8_SB(b, h) + boff + n * 2048 + k * 1024); } while (0)
#define PG8_MMA(ai, bj, At, Bt) do { __builtin_amdgcn_s_setprio(1); _Pragma("unroll") for (int m = 0; m < 4; ++m) _Pragma("unroll") for (int n = 0; n < 2; ++n) _Pragma("unroll") for (int k = 0; k < 2; ++k) \
        acc[ai][bj][m][n] = __builtin_amdgcn_mfma_f32_16x16x32_bf16(Bt[n][k], At[m][k], acc[ai][bj][m][n], 0, 0, 0); __builtin_amdgcn_s_setprio(0); } while (0)
#define PG8_WAIT_V(n) asm volatile("s_waitcnt vmcnt(" #n ")" ::: "memory")
#define PG8_WAIT_L(n) asm volatile("s_waitcnt lgkmcnt(" #n ")" ::: "memory")
#define PG8_BAR __builtin_amdgcn_s_barrier()
#define PG8_SCHED __builtin_amdgcn_sched_barrier(0)
#define PG8_AK(base, t) ((base) + (size_t)(t) * kstep + (((t) >= tsplit) ? adelta : 0ll))
    Unit cur, nxt; int ui = 0;
    if (!S.next(0, cur)) return;
    f32x4 acc[2][2][4][2];
#pragma unroll
    for (int a = 0; a < 2; ++a)
#pragma unroll
        for (int b = 0; b < 2; ++b)
#pragma unroll
            for (int m = 0; m < 4; ++m)
#pragma unroll
                for (int n = 0; n < 2; ++n) acc[a][b][m][n] = (f32x4){0.f, 0.f, 0.f, 0.f};
    bf16x8 At[4][2], B0[2][2], B1[2][2];
    const char* cA = P.aptr(cur); const char* cB = P.bptr(cur);
    if constexpr (Prob::GATHER) { PG8_GATHER_OFFS(vAc, cur); }
    PG8_STAGE(PG8_SB(0, 0), cB, voffB); PG8_STAGE(PG8_SB(0, 1), cB + hstepB, voffB); PG8_STAGE_A(PG8_SA(0, 0), cA, 0, false); PG8_STAGE_A(PG8_SA(0, 1), cA, 1, false);
    if (wr == 1) PG8_BAR;
    PG8_WAIT_V(2); PG8_BAR;
    PG8_STAGE(PG8_SB(1, 0), cB + kstep, voffB); PG8_STAGE_A(PG8_SA(1, 0), PG8_AK(cA, 1), 0, false); PG8_STAGE(PG8_SB(1, 1), cB + hstepB + kstep, voffB);
    PG8_WAIT_V(6); PG8_BAR;
    for (;;) {
        const bool has_next = S.next(ui + 1, nxt);
        const char* nA = has_next ? P.aptr(nxt) : cA; const char* nB = has_next ? P.bptr(nxt) : cB;
        if constexpr (Prob::GATHER) { if (has_next) { PG8_GATHER_OFFS(vAn, nxt); } else {
#pragma unroll
            for (int _h = 0; _h < 2; ++_h)
#pragma unroll
                for (int _i = 0; _i < 2; ++_i) vAn[_h][_i] = vAc[_h][_i]; } }
        for (int t = 0; t < nt; t += 2) {
            const bool last = (t == nt - 2);
            const char* a1 = PG8_AK(cA, t + 1);
            const char* a2 = last ? nA : PG8_AK(cA, t + 2); const char* b2 = last ? nB : cB + (size_t)(t + 2) * kstep;
            const char* a3 = last ? PG8_AK(nA, 1) : PG8_AK(cA, t + 3); const char* b3 = b2 + kstep;
            PG8_LDB(B0, 0, 0); PG8_LDB(B1, 0, 1); PG8_SCHED; PG8_LDA(At, 0, 0); PG8_STAGE_A(PG8_SA(1, 1), a1, 1, false);
            PG8_WAIT_V(8); PG8_WAIT_L(0); PG8_BAR; PG8_MMA(0, 0, At, B0); PG8_MMA(0, 1, At, B1); PG8_BAR; PG8_SCHED;
            PG8_LDA(At, 0, 1); PG8_STAGE(PG8_SB(0, 0), b2, voffB); PG8_STAGE(PG8_SB(0, 1), b2 + hstepB, voffB); PG8_STAGE_A(PG8_SA(0, 0), a2, 0, last);
            PG8_WAIT_V(8); PG8_WAIT_L(0); PG8_BAR; PG8_MMA(1, 0, At, B0); PG8_MMA(1, 1, At, B1); PG8_BAR; PG8_SCHED;
            PG8_LDB(B0, 1, 0); PG8_LDB(B1, 1, 1); PG8_SCHED; PG8_LDA(At, 1, 0); PG8_STAGE_A(PG8_SA(0, 1), a2, 1, last);
            PG8_WAIT_V(8); PG8_WAIT_L(0); PG8_BAR; PG8_MMA(0, 0, At, B0); PG8_MMA(0, 1, At, B1); PG8_BAR; PG8_SCHED;
            PG8_LDA(At, 1, 1); PG8_STAGE(PG8_SB(1, 0), b3, voffB); PG8_STAGE(PG8_SB(1, 1), b3 + hstepB, voffB); PG8_STAGE_A(PG8_SA(1, 0), a3, 0, last);
            PG8_WAIT_V(8); PG8_WAIT_L(0); PG8_BAR; PG8_MMA(1, 0, At, B0); PG8_MMA(1, 1, At, B1); PG8_BAR; PG8_SCHED;
        }
        if constexpr (ALIGN_EPI) { if (wr == 0) PG8_BAR; }
        { int te = threadIdx.x; asm volatile("" : "+v"(te));
          const int we = __builtin_amdgcn_readfirstlane(te >> 6), le = te & 63; E(acc, cur, we >> 2, we & 3, le & 15, le >> 4); }
        if (!has_next) break;
#pragma unroll
        for (int a = 0; a < 2; ++a)
#pragma unroll
            for (int b = 0; b < 2; ++b)
#pragma unroll
                for (int m = 0; m < 4; ++m)
#pragma unroll
                    for (int n = 0; n < 2; ++n) acc[a][b][m][n] = (f32x4){0.f, 0.f, 0.f, 0.f};
        cur = nxt; cA = nA; cB = nB; ++ui;
        if constexpr (Prob::GATHER) {
#pragma unroll
            for (int _h = 0; _h < 2; ++_h)
#pragma unroll
                for (int _i = 0; _i < 2; ++_i) vAc[_h][_i] = vAn[_h][_i]; }
        if constexpr (ALIGN_EPI) { if (wr == 1) PG8_BAR; }
    }
    PG8_WAIT_V(0);
    if constexpr (!ALIGN_EPI) { if (wr == 0) PG8_BAR; }
    PG8_BAR;
#undef PG8_SA
#undef PG8_SB
#undef PG8_STAGE
#undef PG8_STAGE_A
#undef PG8_GATHER_OFFS
#undef PG8_LDA
#undef PG8_LDB
#undef PG8_MMA
#undef PG8_WAIT_V
#undef PG8_WAIT_L
#undef PG8_BAR
#undef PG8_SCHED
#undef PG8_AK
}

struct ProbSimple : ProbBase {
    const char* A; const char* B;
    __device__ __forceinline__ const char* aptr(const Unit& u) const { return A + (size_t)u.pm * 256 * lda * 2; }
    __device__ __forceinline__ const char* bptr(const Unit& u) const { return B + (size_t)u.pn * 256 * ldb * 2; }
};
struct ProbPool : ProbBase {
    const char* A; const char* B;
    __device__ __forceinline__ const char* aptr(const Unit& u) const { return A + ((size_t)u.pm * 256 * 1024 + (size_t)u.pn * 256) * 2; }
    __device__ __forceinline__ const char* bptr(const Unit& u) const { return B + (size_t)u.pn * 65536 * 2; }
};
struct ProbScores : ProbBase {
    const char* A; const char* B;
    __device__ __forceinline__ const char* aptr(const Unit& u) const { return A + ((size_t)u.pm * 256 * 2048 + (size_t)u.pn * 512) * 2; }
    __device__ __forceinline__ const char* bptr(const Unit& u) const { return B + ((size_t)tile_batch(u.pm) * 256 * 2048 + (size_t)u.pn * 512) * 2; }
};
struct ProbVW : ProbBase {
    const char* A; const char* B;
    __device__ __forceinline__ const char* aptr(const Unit& u) const { return A + ((size_t)u.pm * 256 * 2048 + (size_t)(u.pn & 3) * 512) * 2; }
    __device__ __forceinline__ const char* bptr(const Unit& u) const { return B + ((size_t)(u.pn >> 2) * 256 * 2048 + (size_t)(u.pn & 3) * 512) * 2; }
};
struct ProbFin : ProbBase {
    const char* A; const char* B;
    __device__ __forceinline__ const char* aptr(const Unit& u) const { return A + (size_t)u.pm * 256 * 1024 * 2; }
    __device__ __forceinline__ const char* bptr(const Unit& u) const { return B + ((size_t)tile_batch(u.pm) * 2048 + (size_t)u.pn * 256) * 1024 * 2; }
};
struct ProbPV : ProbBase {
    const char* A; const char* B;
    __device__ __forceinline__ const char* aptr(const Unit& u) const { return A + ((size_t)u.pm * 256 * 1024 + (size_t)(u.pn >> 1) * 256) * 2; }
    __device__ __forceinline__ const char* bptr(const Unit& u) const { return B + ((size_t)tile_batch(u.pm) * 2048 + (size_t)u.pn * 256) * 256 * 2; }
};

__device__ __forceinline__ u32x4 pack8(const f32x4& v0, const f32x4& v1) { u32x4 w; w.x = cvt_pk_bf16(v0[0], v0[1]); w.y = cvt_pk_bf16(v0[2], v0[3]); w.z = cvt_pk_bf16(v1[0], v1[1]); w.w = cvt_pk_bf16(v1[2], v1[3]); return w; }
__device__ __forceinline__ float sumsq4(const f32x4& x) { return (x[0] * x[0] + x[1] * x[1]) + (x[2] * x[2] + x[3] * x[3]); }
__device__ __forceinline__ float sum4(const f32x4& x) { return (x[0] + x[1]) + (x[2] + x[3]); }
__device__ __forceinline__ float red_fq(float s) { s += __shfl_xor(s, 16); s += __shfl_xor(s, 32); return s; }

struct EpiIn {
    static constexpr bool PERM = true;
    bf16_t* base; size_t spl; const unsigned* csT; const float* gq; const float* gk; const rss_t* rowss;
    __device__ __forceinline__ void operator()(const f32x4 (&acc)[2][2][4][2], const Unit& u, int wr, int wc, int fr, int fq) const {
        typedef _Float16 h2 __attribute__((ext_vector_type(2)));
        const int t = u.pn >> 2; bf16_t* O = base + (size_t)t * spl; const int colt = (u.pn & 3) * 256; const int row0 = u.pm * BM + wr * 64 + fr;
        if (t >= 2) {
            const int col0 = colt + wc * 32 + 8 * fq;
#pragma unroll
            for (int ai = 0; ai < 2; ++ai) { rss_t rx[4];
#pragma unroll
                for (int m = 0; m < 4; ++m) rx[m] = rowss[row0 + ai * HALF + m * 16];
#pragma unroll
                for (int m = 0; m < 4; ++m) { const float rxm = ss_rstd(rx[m]); bf16_t* rowp = O + (size_t)(row0 + ai * HALF + m * 16) * 1024 + col0;
#pragma unroll
                    for (int bj = 0; bj < 2; ++bj) *(u32x4*)(rowp + bj * HALF) = pack8(acc[ai][bj][m][0] * rxm, acc[ai][bj][m][1] * rxm); }
                asm volatile("" ::: "memory"); }
        } else {
            const float* g = t ? gk : gq; f32x4 g1[2], g2[2];
#pragma unroll
            for (int n = 0; n < 2; ++n) { g1[n] = *(const f32x4*)(g + 8 * fq + 4 * n); g2[n] = *(const f32x4*)(g + 32 + 8 * fq + 4 * n); }
            const int col0 = colt + 64 * wc + 8 * fq;
#pragma unroll
            for (int ah = 0; ah < 4; ++ah) { const int ai = ah >> 1, mb = (ah & 1) * 2;
                u32x4 cs[2][2]; rss_t rx[2];
#pragma unroll
                for (int mm = 0; mm < 2; ++mm) { const int m = mb + mm; const int pos = tok_pos(row0 + ai * HALF + m * 16); rx[mm] = rowss[row0 + ai * HALF + m * 16];
#pragma unroll
                    for (int n = 0; n < 2; ++n) cs[mm][n] = *(const u32x4*)(csT + pos * 32 + 8 * fq + 4 * n); }
#pragma unroll
                for (int mm = 0; mm < 2; ++mm) { const int m = mb + mm; const int row = row0 + ai * HALF + m * 16;
                    float ss = (sumsq4(acc[ai][0][m][0]) + sumsq4(acc[ai][0][m][1])) + (sumsq4(acc[ai][1][m][0]) + sumsq4(acc[ai][1][m][1]));
                    ss = red_fq(ss);
                    const float rxm = ss_rstd(rx[mm]);
                    const float r = __builtin_amdgcn_rsqf(ss * rxm * rxm * (1.0f / 64.0f) + EPS) * rxm * (t ? 1.0f : QSCALE);
                    f32x4 o1[2], o2[2];
#pragma unroll
                    for (int n = 0; n < 2; ++n) { f32x4 c, s;
#pragma unroll
                        for (int j = 0; j < 4; ++j) { const unsigned w = cs[mm][n][j]; const h2 v = __builtin_bit_cast(h2, w); c[j] = (float)v.x; s[j] = (float)v.y; }
                        const f32x4 x1 = acc[ai][0][m][n] * r * g1[n], x2 = acc[ai][1][m][n] * r * g2[n];
                        o1[n] = x1 * c - x2 * s; o2[n] = x2 * c + x1 * s; }
                    bf16_t* rowp = O + (size_t)row * 1024 + col0;
                    *(u32x4*)(rowp) = pack8(o1[0], o1[1]); *(u32x4*)(rowp + 32) = pack8(o2[0], o2[1]); }
                asm volatile("" ::: "memory"); }
        }
    }
};
template <int MODE> struct EpiBf {
    static constexpr bool PERM = true;
    bf16_t* O; int ldc; float* aux; float* aux2; LAS float* xl;
    __device__ __forceinline__ void operator()(f32x4 (&acc)[2][2][4][2], const Unit& u, int wr, int wc, int fr, int fq) const {
        const int row0 = u.pm * BM + wr * 64 + fr; const int col0 = u.pn * BM + wc * 32 + 8 * fq;
        float rs[2][4];
        if constexpr (MODE == 2) {
            f32x4 qa[2][4][2];
#pragma unroll
            for (int ai = 0; ai < 2; ++ai)
#pragma unroll
                for (int m = 0; m < 4; ++m) { const float* p = aux + (size_t)(row0 + ai * HALF + m * 16) * 32 + u.pn * 8; qa[ai][m][0] = *(const f32x4*)p; qa[ai][m][1] = *(const f32x4*)(p + 4); }
#pragma unroll
            for (int ai = 0; ai < 2; ++ai)
#pragma unroll
                for (int m = 0; m < 4; ++m) { const float sc = __builtin_amdgcn_rsqf((sum4(qa[ai][m][0]) + sum4(qa[ai][m][1])) * (1.0f / 512.0f) + EPS) * (0.044194173824159216f * 1.4426950408889634f); float ps = 0.f;
#pragma unroll
                    for (int bj = 0; bj < 2; ++bj)
#pragma unroll
                        for (int n = 0; n < 2; ++n) { f32x4 p;
#pragma unroll
                            for (int j = 0; j < 4; ++j) p[j] = __builtin_amdgcn_exp2f(acc[ai][bj][m][n][j] * sc);
                            acc[ai][bj][m][n] = p; ps += sum4(p); }
                    ps = red_fq(ps);
                    if (fq == 0) xl[(ai * HALF + wr * 64 + m * 16 + fr) * 4 + wc] = ps; }
            asm volatile("s_waitcnt lgkmcnt(0)" ::: "memory"); __builtin_amdgcn_s_barrier(); asm volatile("" ::: "memory");
#pragma unroll
            for (int ai = 0; ai < 2; ++ai)
#pragma unroll
                for (int m = 0; m < 4; ++m) { const f32x4 lv = *(const LAS f32x4*)(xl + (ai * HALF + wr * 64 + m * 16 + fr) * 4); rs[ai][m] = __builtin_amdgcn_rcpf(sum4(lv)); }
        }
        if constexpr (MODE == 1 || MODE == 4) { rss_t rv[2][4];
#pragma unroll
            for (int ai = 0; ai < 2; ++ai)
#pragma unroll
                for (int m = 0; m < 4; ++m) rv[ai][m] = ((const rss_t*)aux2)[row0 + ai * HALF + m * 16];
#pragma unroll
            for (int ai = 0; ai < 2; ++ai)
#pragma unroll
                for (int m = 0; m < 4; ++m) rs[ai][m] = ss_rstd(rv[ai][m]);
        }
        if constexpr (MODE == 3) {
            f32x4 la[2][4];
#pragma unroll
            for (int ai = 0; ai < 2; ++ai)
#pragma unroll
                for (int m = 0; m < 4; ++m) la[ai][m] = *(const f32x4*)(aux2 + (size_t)(row0 + ai * HALF + m * 16) * 16 + (u.pn >> 1) * 4);
#pragma unroll
            for (int ai = 0; ai < 2; ++ai)
#pragma unroll
                for (int m = 0; m < 4; ++m) rs[ai][m] = __builtin_amdgcn_rcpf(sum4(la[ai][m]));
        }
        bf16_t* Ob = O; int colb = col0;
        if constexpr (MODE == 5) { Ob = O + (size_t)(u.pn >> 2) * 2048 * 1024; colb = (u.pn & 3) * 256 + wc * 32 + 8 * fq; }
#pragma unroll
        for (int ai = 0; ai < 2; ++ai)
#pragma unroll
            for (int m = 0; m < 4; ++m) { const int row = row0 + ai * HALF + m * 16; bf16_t* rowp = Ob + (size_t)row * ldc + colb;
                if constexpr (MODE == 0 || MODE == 5) {
#pragma unroll
                    for (int bj = 0; bj < 2; ++bj) *(u32x4*)(rowp + bj * HALF) = pack8(acc[ai][bj][m][0], acc[ai][bj][m][1]);
                } else if constexpr (MODE == 1) {
                    float ss = (sumsq4(acc[ai][0][m][0]) + sumsq4(acc[ai][0][m][1])) + (sumsq4(acc[ai][1][m][0]) + sumsq4(acc[ai][1][m][1]));
                    ss = red_fq(ss); const float rxx = rs[ai][m];
                    if (fq == 0) aux[(size_t)row * 32 + u.pn * 4 + wc] = ss * rxx * rxx;
#pragma unroll
                    for (int bj = 0; bj < 2; ++bj) *(u32x4*)(rowp + bj * HALF) = pack8(acc[ai][bj][m][0] * rxx, acc[ai][bj][m][1] * rxx);
                } else {
                    const float rxx = rs[ai][m];
#pragma unroll
                    for (int bj = 0; bj < 2; ++bj) *(u32x4*)(rowp + bj * HALF) = pack8(acc[ai][bj][m][0] * rxx, acc[ai][bj][m][1] * rxx);
                }
            }
    }
};
struct EpiRes {
    static constexpr bool PERM = true;
    bf16_t* XB; rss_t* rowss; float* OUT;
    __device__ __forceinline__ void load_half(u32x4 (&t)[4][2], int row0, int col0, int ai) const {
#pragma unroll
        for (int m = 0; m < 4; ++m) { const bf16_t* rowb = XB + (size_t)(row0 + ai * HALF + m * 16) * D_MODEL + col0;
#pragma unroll
            for (int bj = 0; bj < 2; ++bj) t[m][bj] = *(const u32x4*)(rowb + bj * HALF); }
    }
    __device__ __forceinline__ void add_half(f32x4 (&acc)[2][2][4][2], const u32x4 (&t)[4][2], int ai) const {
#pragma unroll
        for (int m = 0; m < 4; ++m)
#pragma unroll
            for (int bj = 0; bj < 2; ++bj) { const u32x4 w = t[m][bj];
                acc[ai][bj][m][0] = acc[ai][bj][m][0] + (f32x4){bflo(w.x), bfhi(w.x), bflo(w.y), bfhi(w.y)}; acc[ai][bj][m][1] = acc[ai][bj][m][1] + (f32x4){bflo(w.z), bfhi(w.z), bflo(w.w), bfhi(w.w)}; }
    }
    __device__ __forceinline__ void store_half(const f32x4 (&acc)[2][2][4][2], int row0, int col0, int ai, int fq) const {
#pragma unroll
        for (int m = 0; m < 4; ++m) { const int row = row0 + ai * HALF + m * 16; bf16_t* rowb = XB + (size_t)row * D_MODEL + col0; float ss = 0.f;
#pragma unroll
            for (int bj = 0; bj < 2; ++bj) { const f32x4 v0 = acc[ai][bj][m][0], v1 = acc[ai][bj][m][1];
                if (OUT) { float* rowp = OUT + (size_t)row * D_MODEL + col0 + bj * HALF; *(f32x4*)rowp = v0; *(f32x4*)(rowp + 4) = v1; }
                else { *(u32x4*)(rowb + bj * HALF) = pack8(v0, v1); ss += sumsq4(v0) + sumsq4(v1); } }
            if (rowss) { ss = red_fq(ss); if (fq == 0) atomicAdd(rowss + row, ss_fix(ss)); } }
    }
    __device__ __forceinline__ void operator()(f32x4 (&acc)[2][2][4][2], const Unit& u, int wr, int wc, int fr, int fq) const {
        const int row0 = u.pm * BM + wr * 64 + fr, col0 = u.pn * BM + wc * 32 + 8 * fq;
        u32x4 t[4][2];
        load_half(t, row0, col0, 0);
        add_half(acc, t, 0);
        asm volatile("" : "+v"(acc[0][0][0][0]), "+v"(acc[0][1][3][1]));
        load_half(t, row0, col0, 1);
        asm volatile("" ::: "memory");
        store_half(acc, row0, col0, 0, fq);
        add_half(acc, t, 1);
        store_half(acc, row0, col0, 1, fq);
    }
};
__device__ __forceinline__ int ffn_tile_row(int pm, int R, int chunk, bool& valid) {
    R = (R & ~63) | ((R & 15) << 2) | ((R >> 4) & 3);
    valid = true; if (pm < FFN_MT) return pm * 256 + R;
    const int v = (pm - FFN_MT) * 256 + R; int g = v >> 2; const int k = v & 3; int tok;
    if (chunk == 0) { valid = g < 124; g = g < 124 ? g : 123; const int s = g / 31, bi = g - s * 31; tok = s * S_P + 256 * (bi + 1); }
    else { valid = g < 120; g = g < 120 ? g : 119; const int s = g / 15, bi = g - s * 15; tok = s * S_S + 256 * (bi + 1); }
    return tok + k - 2;
}
struct ProbUp : ProbBase {
    static constexpr bool GATHER = true;
    const char* A; const char* B; int chunk;
    __device__ __forceinline__ const char* aptr(const Unit&) const { return A; }
    __device__ __forceinline__ const char* bptr(const Unit& u) const { return B + (size_t)u.pn * 256 * ldb * 2; }
    __device__ __forceinline__ unsigned rowoff(const Unit& u, int R) const { bool v; return (unsigned)ffn_tile_row(u.pm, R, chunk, v) * (unsigned)(lda * 2); }
};
__device__ __forceinline__ float dpp_ror1(float v) { return __builtin_bit_cast(float, __builtin_amdgcn_update_dpp(0, __builtin_bit_cast(int, v), 0x121, 0xf, 0xf, false)); }
__device__ __forceinline__ float dpp_ror15(float v) { return __builtin_bit_cast(float, __builtin_amdgcn_update_dpp(0, __builtin_bit_cast(int, v), 0x12F, 0xf, 0xf, false)); }
struct EpiGlu {
    static constexpr bool PERM = true;
    bf16_t* G; const rss_t* rowss; const u32x4* cwt; int chunk; LAS float* xl;
    __device__ __forceinline__ void operator()(f32x4 (&acc)[2][2][4][2], const Unit& u, int wr, int wc, int fr, int fq) const {
        const bool bnd = u.pm >= FFN_MT; const int ch0 = u.pn * 128 + wc * 32 + 8 * fq;
        const int tidw = (wr * 4 + wc) * 64 + fq * 16 + fr; LAS unsigned char* wl = (LAS unsigned char*)xl + 12288;
        u32x4 wrec = (u32x4){0u, 0u, 0u, 0u}; if (tidw < 128) wrec = cwt[u.pn * 128 + tidw];
        int rowi[2][4]; unsigned stmask = 0u;
        { rss_t rv[2][4];
#pragma unroll
          for (int ai = 0; ai < 2; ++ai)
#pragma unroll
            for (int m = 0; m < 4; ++m) { const int RL = ai * HALF + wr * 64 + 4 * fr + m; bool valid; const int row = ffn_tile_row(u.pm, ai * HALF + wr * 64 + m * 16 + fr, chunk, valid); rowi[ai][m] = row; rv[ai][m] = rowss[row];
                const int gt = chunk * FFN_CHUNK + row, pos = tok_pos(gt), S = tok_seqlen(gt);
                const bool st = bnd ? (valid && (m == 1 || m == 2)) : !((RL == 0 && pos != 0) || (RL == 255 && pos != S - 1));
                stmask |= st ? (1u << (ai * 4 + m)) : 0u; }
#pragma unroll
          for (int ai = 0; ai < 2; ++ai)
#pragma unroll
            for (int m = 0; m < 4; ++m) { const float rx = ss_rstd(rv[ai][m]);
#pragma unroll
                for (int bj = 0; bj < 2; ++bj)
#pragma unroll
                    for (int n = 0; n < 2; ++n) acc[ai][bj][m][n] = acc[ai][bj][m][n] * rx; } }
#pragma unroll
        for (int ai = 0; ai < 2; ++ai) { const int s1 = 2 * ai + wr + 1;
            if (fr == 0) {
#pragma unroll
                for (int bj = 0; bj < 2; ++bj)
#pragma unroll
                    for (int n = 0; n < 2; ++n) *(LAS f32x4*)(xl + ((s1 * 2 + 0) * 4 + wc) * 64 + bj * 32 + 8 * fq + 4 * n) = acc[ai][bj][0][n]; }
            if (fr == 15) {
#pragma unroll
                for (int bj = 0; bj < 2; ++bj)
#pragma unroll
                    for (int n = 0; n < 2; ++n) *(LAS f32x4*)(xl + ((s1 * 2 + 1) * 4 + wc) * 64 + bj * 32 + 8 * fq + 4 * n) = acc[ai][bj][3][n]; } }
        if (tidw < 128) *(LAS u32x4*)(wl + tidw * 16) = wrec;
        asm volatile("s_waitcnt lgkmcnt(0)" ::: "memory"); __builtin_amdgcn_s_barrier(); asm volatile("" ::: "memory");
#pragma unroll
        for (int n = 0; n < 2; ++n) { unsigned wp[2][4][2];
#pragma unroll
            for (int jp = 0; jp < 2; ++jp) { float o[2][4][2];
#pragma unroll
                for (int jj = 0; jj < 2; ++jj) { const int j = 2 * jp + jj; const u32x4 w = *(const LAS u32x4*)(wl + (wc * 32 + 8 * fq + 4 * n + j) * 16);
                    const float g0w = bflo(w.x), g1w = bfhi(w.x), g2w = bflo(w.y), gbw = bfhi(w.y), v0w = bflo(w.z), v1w = bfhi(w.z), v2w = bflo(w.w), vbw = bfhi(w.w);
#pragma unroll
                    for (int ai = 0; ai < 2; ++ai) { const int s1 = 2 * ai + wr + 1; float cg[4], cv[4];
                        const LAS float* xp = xl + (((s1 - 1) * 2 + 1) * 4 + wc) * 64 + 8 * fq + 4 * n + j; const LAS float* xn = xl + (((s1 + 1) * 2 + 0) * 4 + wc) * 64 + 8 * fq + 4 * n + j;
                        { const float pe = xp[0], ne = xn[0]; const float r3 = dpp_ror1(acc[ai][0][3][n][j]), l0 = dpp_ror15(acc[ai][0][0][n][j]);
#pragma unroll
                          for (int m = 0; m < 4; ++m) { const float pv = m ? acc[ai][0][m ? m - 1 : 0][n][j] : (fr == 0 ? pe : r3), nx = m < 3 ? acc[ai][0][m < 3 ? m + 1 : 3][n][j] : (fr == 15 ? ne : l0);
                              cg[m] = gbw + g0w * pv + g1w * acc[ai][0][m][n][j] + g2w * nx; } }
                        { const float pe = xp[32], ne = xn[32]; const float r3 = dpp_ror1(acc[ai][1][3][n][j]), l0 = dpp_ror15(acc[ai][1][0][n][j]);
#pragma unroll
                          for (int m = 0; m < 4; ++m) { const float pv = m ? acc[ai][1][m ? m - 1 : 0][n][j] : (fr == 0 ? pe : r3), nx = m < 3 ? acc[ai][1][m < 3 ? m + 1 : 3][n][j] : (fr == 15 ? ne : l0);
                              cv[m] = vbw + v0w * pv + v1w * acc[ai][1][m][n][j] + v2w * nx; } }
#pragma unroll
                        for (int m = 0; m < 4; ++m) { const float g0 = cg[m];
                            const float ea = g0 * fmaf(g0 * g0, -0.10294324f, -2.3022082f);
                            o[ai][m][jj] = g0 * __builtin_amdgcn_rcpf(1.0f + __builtin_amdgcn_exp2f(ea)) * cv[m]; }
                        asm volatile("" : "+v"(o[ai][0][jj]), "+v"(o[ai][1][jj]), "+v"(o[ai][2][jj]), "+v"(o[ai][3][jj])); } }
#pragma unroll
                for (int ai = 0; ai < 2; ++ai)
#pragma unroll
                    for (int m = 0; m < 4; ++m) wp[ai][m][jp] = cvt_pk_bf16(o[ai][m][0], o[ai][m][1]); }
#pragma unroll
            for (int ai = 0; ai < 2; ++ai)
#pragma unroll
                for (int m = 0; m < 4; ++m) { u32x2 q; q.x = wp[ai][m][0]; q.y = wp[ai][m][1]; if (stmask & (1u << (ai * 4 + m))) *(u32x2*)(G + (size_t)rowi[ai][m] * D_FF + ch0 + 4 * n) = q; }
            asm volatile("" ::: "memory"); }
    }
};
struct EpiKV {
    static constexpr bool PERM = false;
    float* kraw; bf16_t* vT;
    __device__ __forceinline__ void operator()(const f32x4 (&acc)[2][2][4][2], const Unit& u, int wr, int wc, int fr, int fq) const {
        const int key0 = wr * 64 + fr, col0 = u.pn * BM + wc * 32 + 4 * fq;
        if (u.pn < 8) {
#pragma unroll
            for (int ai = 0; ai < 2; ++ai)
#pragma unroll
                for (int m = 0; m < 4; ++m) { float* rowp = kraw + (size_t)(u.pm * BM + key0 + ai * HALF + m * 16) * 2048 + col0;
#pragma unroll
                    for (int bj = 0; bj < 2; ++bj)
#pragma unroll
                        for (int n = 0; n < 2; ++n) *(f32x4*)(rowp + bj * HALF + n * 16) = acc[ai][bj][m][n]; }
        } else {
#pragma unroll
            for (int ai = 0; ai < 2; ++ai)
#pragma unroll
                for (int m = 0; m < 4; ++m) { bf16_t* rowp = vT + (size_t)(u.pm * BM + key0 + ai * HALF + m * 16) * 2048 + (col0 - 2048);
#pragma unroll
                    for (int bj = 0; bj < 2; ++bj)
#pragma unroll
                        for (int n = 0; n < 2; ++n) { const f32x4 v = acc[ai][bj][m][n]; u32x2 w; w.x = cvt_pk_bf16(v[0], v[1]); w.y = cvt_pk_bf16(v[2], v[3]); *(u32x2*)(rowp + bj * HALF + n * 16) = w; } }
        }
    }
};
}

namespace att {
constexpr int KVBLK = 64, SHM_V = 16384, SHM_K = 16384, OFF_V = 0, OFF_K = 3 * SHM_V, OFF_WS = 3 * SHM_V + 3 * SHM_K, LDP = 1024;
#define KSWZ(row, colB) ((row) * 256 + ((colB) ^ (((row) & 7) << 4)))
#define SBAR() __builtin_amdgcn_sched_barrier(0)
__device__ __forceinline__ int crow(int r, int hi) { return (r & 3) + 8 * (r >> 2) + 4 * hi; }
__device__ __forceinline__ void partialSM(f32x16& p0) {
#pragma unroll
  for (int r = 0; r < 16; ++r) p0[r] = __builtin_amdgcn_exp2f(p0[r]);
}
__device__ __forceinline__ void finishSM(f32x16& p0, f32x16& p1, float& l_reg, bf16x8& pa0, bf16x8& pa1, bf16x8& pa2, bf16x8& pa3) {
#pragma unroll
  for (int r = 0; r < 16; ++r) p1[r] = __builtin_amdgcn_exp2f(p1[r]);
  float ps = 0;
#pragma unroll
  for (int r = 0; r < 16; ++r) ps += p0[r];
#pragma unroll
  for (int r = 0; r < 16; ++r) ps += p1[r];
  l_reg += ps;
#define PK4(P, BASE, OUT) do { unsigned a0 = cvt_pk_bf16(P[BASE + 0], P[BASE + 1]), a1 = cvt_pk_bf16(P[BASE + 2], P[BASE + 3]);   \
    unsigned b0 = cvt_pk_bf16(P[BASE + 4], P[BASE + 5]), b1 = cvt_pk_bf16(P[BASE + 6], P[BASE + 7]);                              \
    auto r0 = __builtin_amdgcn_permlane32_swap(a0, b0, false, false); auto r1 = __builtin_amdgcn_permlane32_swap(a1, b1, false, false); \
    u32x4 w = {r0[0], r1[0], r0[1], r1[1]}; OUT = __builtin_bit_cast(bf16x8, w); } while (0)
  PK4(p0, 0, pa0); PK4(p0, 8, pa1); PK4(p1, 0, pa2); PK4(p1, 8, pa3);
#undef PK4
}
__device__ __forceinline__ void finishSM_tail(f32x16& p0, f32x16& p1, float& l_reg, bf16x8& pa0, bf16x8& pa1, bf16x8& pa2, bf16x8& pa3) {
  float ps = 0;
#pragma unroll
  for (int r = 0; r < 16; ++r) ps += p0[r];
#pragma unroll
  for (int r = 0; r < 16; ++r) ps += p1[r];
  l_reg += ps;
#define PK4(P, BASE, OUT) do { unsigned a0 = cvt_pk_bf16(P[BASE + 0], P[BASE + 1]), a1 = cvt_pk_bf16(P[BASE + 2], P[BASE + 3]);   \
    unsigned b0 = cvt_pk_bf16(P[BASE + 4], P[BASE + 5]), b1 = cvt_pk_bf16(P[BASE + 6], P[BASE + 7]);                              \
    u32x4 w = {a0, a1, b0, b1}; OUT = __builtin_bit_cast(bf16x8, w); } while (0)
  PK4(p0, 0, pa0); PK4(p0, 8, pa1); PK4(p1, 0, pa2); PK4(p1, 8, pa3);
#undef PK4
}
__device__ __forceinline__ void qkt(f32x16& p0, f32x16& p1, const LAS unsigned char* Ks, const bf16x8* qr, int r32, int hi, int cbase) {
  p0 = f32x16{}; p1 = f32x16{}; bf16x8 b0[4], b1[4];
#pragma unroll
  for (int d0 = 0; d0 < 4; ++d0) { const int cb = cbase + (d0 * 16 + hi * 8) * 2;
    b0[d0] = *(const LAS bf16x8*)(Ks + KSWZ(r32, cb)); b1[d0] = *(const LAS bf16x8*)(Ks + KSWZ(32 + r32, cb)); }
#define QK_STEP(D, N) do { asm volatile("s_waitcnt lgkmcnt(" #N ")" ::: "memory"); SBAR(); \
    p0 = __builtin_amdgcn_mfma_f32_32x32x16_bf16(b0[D], qr[D], p0, 0, 0, 0); p1 = __builtin_amdgcn_mfma_f32_32x32x16_bf16(b1[D], qr[D], p1, 0, 0, 0); } while (0)
  QK_STEP(0, 6); QK_STEP(1, 4); QK_STEP(2, 2); QK_STEP(3, 0);
#undef QK_STEP
}
__device__ __forceinline__ int v_st(int k, int c) { const int kk = k; return ((kk >> 3) * 4 + (c >> 5)) * 512 + ((kk & 7) * 32 + (c & 31)) * 2; }
__device__ __forceinline__ int v_rd_base(int lane) { return ((lane & 3) << 3) | (((lane >> 2) & 3) << 6) | (((lane >> 4) & 1) << 5) | (((lane >> 5) & 1) << 8); }
constexpr int v_rd_off(int d0, int ks, int half) { return d0 * 512 + ks * 4096 + half * 2048; }
template <int OFF> __device__ __forceinline__ s16x4 tr_read(int vb) {
  s16x4 r; asm volatile("ds_read_b64_tr_b16 %0, %1 offset:%2" : "=&v"(r) : "v"(vb), "i"(OFF) : "memory"); return r;
}
struct VFrag { s16x4 l0, h0, l1, h1, l2, h2, l3, h3; };
template <int D0> __device__ __forceinline__ void pv_read(VFrag& f, int vb) {
  f.l0 = tr_read<v_rd_off(D0, 0, 0)>(vb); f.h0 = tr_read<v_rd_off(D0, 0, 1)>(vb); f.l1 = tr_read<v_rd_off(D0, 1, 0)>(vb); f.h1 = tr_read<v_rd_off(D0, 1, 1)>(vb);
  f.l2 = tr_read<v_rd_off(D0, 2, 0)>(vb); f.h2 = tr_read<v_rd_off(D0, 2, 1)>(vb); f.l3 = tr_read<v_rd_off(D0, 3, 0)>(vb); f.h3 = tr_read<v_rd_off(D0, 3, 1)>(vb);
}
__device__ __forceinline__ void pv_mma(f32x16& od, const VFrag& f, bf16x8 pa0, bf16x8 pa1, bf16x8 pa2, bf16x8 pa3) {
#define PKV(L, H) (bf16x8){L[0], L[1], L[2], L[3], H[0], H[1], H[2], H[3]}
  od = __builtin_amdgcn_mfma_f32_32x32x16_bf16(pa0, PKV(f.l0, f.h0), od, 0, 0, 0);
  od = __builtin_amdgcn_mfma_f32_32x32x16_bf16(pa1, PKV(f.l1, f.h1), od, 0, 0, 0);
  od = __builtin_amdgcn_mfma_f32_32x32x16_bf16(pa2, PKV(f.l2, f.h2), od, 0, 0, 0);
  od = __builtin_amdgcn_mfma_f32_32x32x16_bf16(pa3, PKV(f.l3, f.h3), od, 0, 0, 0);
#undef PKV
}
__device__ __forceinline__ void pv_d0(f32x16* o, int vb, bf16x8 pa0, bf16x8 pa1, bf16x8 pa2, bf16x8 pa3) {
  VFrag fa, fb;
  pv_read<0>(fa, vb); pv_read<1>(fb, vb);
  asm volatile("s_waitcnt lgkmcnt(8)" ::: "memory"); SBAR(); pv_mma(o[0], fa, pa0, pa1, pa2, pa3); SBAR();
  pv_read<2>(fa, vb);
  asm volatile("s_waitcnt lgkmcnt(8)" ::: "memory"); SBAR(); pv_mma(o[1], fb, pa0, pa1, pa2, pa3); SBAR();
  pv_read<3>(fb, vb);
  asm volatile("s_waitcnt lgkmcnt(8)" ::: "memory"); SBAR(); pv_mma(o[2], fa, pa0, pa1, pa2, pa3); SBAR();
  asm volatile("s_waitcnt lgkmcnt(0)" ::: "memory"); SBAR(); pv_mma(o[3], fb, pa0, pa1, pa2, pa3);
}
__device__ __forceinline__ void att_step(f32x16& s0, f32x16& s1, const LAS unsigned char* Ks, const bf16x8* qr, int r32, int hi, int cbase,
                                         f32x16& e0, f32x16& e1, float& l_reg, bf16x8& pa0, bf16x8& pa1, bf16x8& pa2, bf16x8& pa3, f32x16* o, int vb) {
  bf16x8 b0[4], b1[4]; VFrag fa, fb; float ps = 0.f; u32x4 w0, w1, w2, w3;
#pragma unroll
  for (int d0 = 0; d0 < 4; ++d0) { const int cb = cbase + (d0 * 16 + hi * 8) * 2;
    b0[d0] = *(const LAS bf16x8*)(Ks + KSWZ(r32, cb)); b1[d0] = *(const LAS bf16x8*)(Ks + KSWZ(32 + r32, cb)); }
  s0 = f32x16{}; s1 = f32x16{};
#define PACK_H(E, BASE, H, W) do { ps += E[BASE + 2 * H]; ps += E[BASE + 2 * H + 1]; ps += E[BASE + 4 + 2 * H]; ps += E[BASE + 5 + 2 * H];                       \
    const unsigned a_ = cvt_pk_bf16(E[BASE + 2 * H], E[BASE + 2 * H + 1]), b_ = cvt_pk_bf16(E[BASE + 4 + 2 * H], E[BASE + 5 + 2 * H]);                       \
    W[H] = a_; W[2 + H] = b_; } while (0)
#define QK_STEP(D, N, PRE, PK_A, PK_B) do { asm volatile("s_waitcnt lgkmcnt(" #N ")" ::: "memory"); PRE; SBAR();                                                  \
    s0 = __builtin_amdgcn_mfma_f32_32x32x16_bf16(b0[D], qr[D], s0, 0, 0, 0); SBAR(); PK_A; SBAR();                                                                 \
    s1 = __builtin_amdgcn_mfma_f32_32x32x16_bf16(b1[D], qr[D], s1, 0, 0, 0); SBAR(); PK_B; SBAR(); } while (0)
  QK_STEP(0, 6, (void)0, PACK_H(e0, 0, 0, w0), PACK_H(e0, 0, 1, w0));
  QK_STEP(1, 4, (void)0, PACK_H(e0, 8, 0, w1), PACK_H(e0, 8, 1, w1));
  QK_STEP(2, 2, (void)0, PACK_H(e1, 0, 0, w2), PACK_H(e1, 0, 1, w2));
  QK_STEP(3, 0, (pv_read<0>(fa, vb), pv_read<1>(fb, vb)), PACK_H(e1, 8, 0, w3), PACK_H(e1, 8, 1, w3));
#undef QK_STEP
#undef PACK_H
  l_reg += ps;
  pa0 = __builtin_bit_cast(bf16x8, w0); pa1 = __builtin_bit_cast(bf16x8, w1); pa2 = __builtin_bit_cast(bf16x8, w2); pa3 = __builtin_bit_cast(bf16x8, w3);
#define PKV(L, H) (bf16x8){L[0], L[1], L[2], L[3], H[0], H[1], H[2], H[3]}
#define EX2(X, I) do { X[I] = __builtin_amdgcn_exp2f(X[I]); X[I + 1] = __builtin_amdgcn_exp2f(X[I + 1]); } while (0)
#define PV_BLK(D0, F, N, X, XB) do { asm volatile("s_waitcnt lgkmcnt(" #N ")" ::: "memory"); SBAR();                                                              \
    o[D0] = __builtin_amdgcn_mfma_f32_32x32x16_bf16(pa0, PKV(F.l0, F.h0), o[D0], 0, 0, 0); SBAR(); EX2(X, XB + 0); SBAR();                                         \
    o[D0] = __builtin_amdgcn_mfma_f32_32x32x16_bf16(pa1, PKV(F.l1, F.h1), o[D0], 0, 0, 0); SBAR(); EX2(X, XB + 2); SBAR();                                         \
    o[D0] = __builtin_amdgcn_mfma_f32_32x32x16_bf16(pa2, PKV(F.l2, F.h2), o[D0], 0, 0, 0); SBAR(); EX2(X, XB + 4); SBAR();                                         \
    o[D0] = __builtin_amdgcn_mfma_f32_32x32x16_bf16(pa3, PKV(F.l3, F.h3), o[D0], 0, 0, 0); SBAR(); EX2(X, XB + 6); SBAR(); } while (0)
  PV_BLK(0, fa, 8, s0, 0); pv_read<2>(fa, vb);
  PV_BLK(1, fb, 8, s0, 8); pv_read<3>(fb, vb);
  PV_BLK(2, fa, 8, s1, 0);
  PV_BLK(3, fb, 0, s1, 8);
#undef PV_BLK
#undef EX2
#undef PKV
}
__device__ __forceinline__ void attn_unit(const bf16_t* Qg, const bf16_t* __restrict__ Kg, const bf16_t* __restrict__ Vg, bf16_t* Og, int seq, float lam, const float* gsub, float oscale, LAS unsigned char* lds) {
  int tid_l = threadIdx.x; asm volatile("" : "+v"(tid_l));
  const int tid = tid_l, wid = __builtin_amdgcn_readfirstlane(tid >> 6), lane = tid & 63, r32 = lane & 31, hi = lane >> 5;
  const int comp = wid & 1, rg = wid >> 1, cbase = comp * 128;
  LAS unsigned char* V_lds = lds + OFF_V; LAS unsigned char* K_lds = lds + OFF_K;
  LAS float* wsf = (LAS float*)(lds + OFF_WS) + wid * 64; LAS float* li_l = wsf;
  float l_reg = 0; f32x16 o[4] = {}; bf16x8 qr[4];
  const bf16_t* Qw = Qg + (size_t)(rg * 32 + r32) * LDP + comp * 64 + hi * 8;
#pragma unroll
  for (int d0 = 0; d0 < 4; ++d0) qr[d0] = *(const bf16x8*)(Qw + d0 * 16);
  unsigned koff[2], voff[2];
#pragma unroll
  for (int i = 0; i < 2; ++i) { const int L = (tid + 512 * i) * 16; { const int row = L >> 8, colB = (L & 255) ^ ((row & 7) << 4); koff[i] = (unsigned)(row * LDP * 2 + colB); }
    { const int sub = L >> 9, w = L & 511, kk = (sub >> 2) * 8 + (w >> 6), c = (sub & 3) * 32 + ((w & 63) >> 1), k = kk; voff[i] = (unsigned)(k * LDP * 2 + c * 2); } }
  const int vbb = (int)(unsigned)(size_t)V_lds + v_rd_base(lane);
  const int NT = seq / KVBLK; const size_t tstep = (size_t)KVBLK * LDP * 2;
#define DMA_K(t) do { const int t_ = (t) < NT ? (t) : NT - 1; const char* g_ = (const char*)Kg + (size_t)t_ * tstep; LAS unsigned char* d_ = K_lds + (t_ % 3) * SHM_K + wid * 1024; \
    __builtin_amdgcn_global_load_lds((const unsigned*)(g_ + koff[0]), (LAS unsigned*)d_, 16, 0, 0); __builtin_amdgcn_global_load_lds((const unsigned*)(g_ + koff[1]), (LAS unsigned*)(d_ + 8192), 16, 0, 0); } while (0)
#define DMA_V(t) do { const int t_ = (t) < NT ? (t) : NT - 1; const char* g_ = (const char*)Vg + (size_t)t_ * tstep; LAS unsigned char* d_ = V_lds + (t_ % 3) * SHM_V + wid * 1024; \
    __builtin_amdgcn_global_load_lds((const unsigned*)(g_ + voff[0]), (LAS unsigned*)d_, 16, 0, 0); __builtin_amdgcn_global_load_lds((const unsigned*)(g_ + voff[1]), (LAS unsigned*)(d_ + 8192), 16, 0, 0); } while (0)
#define WAIT4_BAR() do { asm volatile("s_waitcnt vmcnt(4)" ::: "memory"); __builtin_amdgcn_s_barrier(); asm volatile("" ::: "memory"); } while (0)
  f32x16 pA0, pA1, pB0, pB1; bf16x8 pa0, pa1, pa2, pa3;
  DMA_K(0); DMA_K(1); DMA_V(0);
  WAIT4_BAR();
  DMA_K(2); DMA_V(1);
  qkt(pA0, pA1, K_lds, qr, r32, hi, cbase); partialSM(pA0); partialSM(pA1);
  int sk = 1, sv = 0;
  for (int j = 1; j + 1 < NT; j += 2) {
    WAIT4_BAR(); DMA_K(j + 2); DMA_V(j + 1);
    SBAR(); att_step(pB0, pB1, K_lds + sk * SHM_K, qr, r32, hi, cbase, pA0, pA1, l_reg, pa0, pa1, pa2, pa3, o, vbb + sv * SHM_V); SBAR();
    sk = sk == 2 ? 0 : sk + 1; sv = sv == 2 ? 0 : sv + 1;
    WAIT4_BAR(); DMA_K(j + 3); DMA_V(j + 2);
    SBAR(); att_step(pA0, pA1, K_lds + sk * SHM_K, qr, r32, hi, cbase, pB0, pB1, l_reg, pa0, pa1, pa2, pa3, o, vbb + sv * SHM_V); SBAR();
    sk = sk == 2 ? 0 : sk + 1; sv = sv == 2 ? 0 : sv + 1;
  }
  WAIT4_BAR(); DMA_K(NT + 1); DMA_V(NT);
  SBAR(); att_step(pB0, pB1, K_lds + sk * SHM_K, qr, r32, hi, cbase, pA0, pA1, l_reg, pa0, pa1, pa2, pa3, o, vbb + sv * SHM_V); SBAR();
  sv = sv == 2 ? 0 : sv + 1;
  WAIT4_BAR();
  finishSM_tail(pB0, pB1, l_reg, pa0, pa1, pa2, pa3); SBAR();
  pv_d0(o, vbb + sv * SHM_V, pa0, pa1, pa2, pa3);
  asm volatile("s_waitcnt vmcnt(0)" ::: "memory");
#undef DMA_K
#undef DMA_V
#undef WAIT4_BAR
  { auto rr = __builtin_amdgcn_permlane32_swap(__float_as_uint(l_reg), __float_as_uint(l_reg), false, false); l_reg = __uint_as_float(rr[0]) + __uint_as_float(rr[1]); }
  if (hi == 0) li_l[r32] = l_reg; asm volatile("s_waitcnt lgkmcnt(0)" ::: "memory");
  float rli[16];
#pragma unroll
  for (int r = 0; r < 16; ++r) rli[r] = __builtin_amdgcn_rcpf(li_l[crow(r, hi)]);
  __syncthreads();
  LAS float* X = (LAS float*)(lds) + rg * 4096 + lane;
  if (comp == 1) {
#pragma unroll
    for (int d0 = 0; d0 < 4; ++d0)
#pragma unroll
      for (int r = 0; r < 16; ++r) X[(d0 * 16 + r) * 64] = o[d0][r] * rli[r] * lam;
  }
  __syncthreads();
  if (comp == 0) {
    float ss[16];
#pragma unroll
    for (int r = 0; r < 16; ++r) ss[r] = 0.f;
#pragma unroll
    for (int d0 = 0; d0 < 4; ++d0)
#pragma unroll
      for (int r = 0; r < 16; ++r) { const float v = o[d0][r] * rli[r] - X[(d0 * 16 + r) * 64]; o[d0][r] = v; ss[r] += v * v; }
#pragma unroll
    for (int r = 0; r < 16; ++r) { float s = ss[r]; s += __shfl_xor(s, 1); s += __shfl_xor(s, 2); s += __shfl_xor(s, 4); s += __shfl_xor(s, 8); s += __shfl_xor(s, 16);
      ss[r] = __builtin_amdgcn_rsqf(s * (1.0f / 128.0f) + EPS) * oscale; }
    bf16_t* Ow = Og + (size_t)(rg * 32) * LDP;
#pragma unroll
    for (int d0 = 0; d0 < 4; ++d0) { const float g = gsub[d0 * 32 + r32];
#pragma unroll
#ifdef PROBE_ZERO_ATTN
      for (int r = 0; r < 16; ++r) Ow[(size_t)crow(r, hi) * LDP + d0 * 32 + r32] = (bf16_t)0;
#else
      for (int r = 0; r < 16; ++r) Ow[(size_t)crow(r, hi) * LDP + d0 * 32 + r32] = (bf16_t)(cvt_pk_bf16(o[d0][r] * ss[r] * g, 0.f) & 0xffffu);
#endif
    }
  }
  __syncthreads();
}
}

#define XB_TMO      128
#define XB_XCNT(j)  (256  + 64 * (j))
#define XB_XSUB(j)  (1280 + 64 * (j))
#define XB_XGEN(j)  (2304 + 64 * (j))
#define XB_TOP      3328
#define XB_TOPGEN   3392
#define XCD_BAR_WORDS 3456
#define XB_SPIN_CAP (1u << 20)
__device__ __forceinline__ unsigned xb_ld(unsigned* p)              { return __hip_atomic_load(p, __ATOMIC_RELAXED, __HIP_MEMORY_SCOPE_AGENT); }
__device__ __forceinline__ unsigned xb_add(unsigned* p, unsigned v) { return __hip_atomic_fetch_add(p, v, __ATOMIC_RELAXED, __HIP_MEMORY_SCOPE_AGENT); }
__device__ __forceinline__ unsigned xb_xcc_id() { return (unsigned)__builtin_amdgcn_s_getreg((3 << 11) | 20) & 0xFu; }
#define XB_SPIN(cond, bar) do { unsigned _sp = 0; while (cond) { __builtin_amdgcn_s_sleep(1); \
    if ((++_sp & 255u) == 0u) { if (xb_ld(&(bar)[XB_TMO])) break; if (_sp > XB_SPIN_CAP) { atomicAdd(&(bar)[XB_TMO], 1u); break; } } } } while (0)
struct XcdBarrier { unsigned* bar; unsigned x; volatile LAS unsigned* st; };
__device__ __forceinline__ XcdBarrier xcd_barrier_post(unsigned* bar, volatile LAS unsigned* st) {
    XcdBarrier b; b.bar = bar; b.x = xb_xcc_id(); b.st = st;
    if (threadIdx.x == 0) (void)xb_add(&bar[XB_XCNT(b.x)], 1u);
    return b;
}
__device__ __forceinline__ void xcd_barrier_complete(unsigned* bar, unsigned x, unsigned& nloc, unsigned& nx) {
    const unsigned G = gridDim.x * gridDim.y * gridDim.z;
    unsigned sum, cnt, mine, sp = 0u;
    for (;;) {
        sum = 0u; cnt = 0u; mine = 0u;
#pragma unroll
        for (unsigned j = 0; j < 16; ++j) { const unsigned c = xb_ld(&bar[XB_XCNT(j)]); sum += c; cnt += (c > 0u) ? 1u : 0u; mine = (j == x) ? c : mine; }
        if (sum == G) break;
        __builtin_amdgcn_s_sleep(1);
        if ((++sp & 255u) == 0u) { if (xb_ld(&bar[XB_TMO])) break; if (sp > XB_SPIN_CAP) { atomicAdd(&bar[XB_TMO], 1u); break; } }
    }
    nloc = mine > 0u ? mine : 1u; nx = cnt > 0u ? cnt : 1u;
}
__device__ __forceinline__ void xcd_barrier(const XcdBarrier& b) {
    asm volatile("s_waitcnt vmcnt(0)" ::: "memory");
    __syncthreads();
    if (threadIdx.x == 0) {
        unsigned* bar = b.bar;
        __builtin_amdgcn_s_waitcnt(0);
        unsigned nloc = b.st[0], nx = b.st[1];
        if (nloc == 0u) { xcd_barrier_complete(bar, b.x, nloc, nx); b.st[0] = nloc; b.st[1] = nx; }
        const unsigned old = xb_add(&bar[XB_XSUB(b.x)], 1u);
        const unsigned gen = old / nloc;
        if (old + 1u == (gen + 1u) * nloc) {
            __builtin_amdgcn_fence(__ATOMIC_RELEASE, "agent");
            asm volatile("s_waitcnt vmcnt(0)" ::: "memory");
            const unsigned og = xb_add(&bar[XB_TOP], 1u);
            const unsigned tg = og / nx;
            if (og + 1u == (tg + 1u) * nx) xb_add(&bar[XB_TOPGEN], 1u);
            else XB_SPIN(xb_ld(&bar[XB_TOPGEN]) == tg, bar);
            __builtin_amdgcn_fence(__ATOMIC_ACQUIRE, "agent");
            xb_add(&bar[XB_XGEN(b.x)], 1u);
            asm volatile("s_waitcnt vmcnt(0)" ::: "memory");
        } else {
            XB_SPIN(xb_ld(&bar[XB_XGEN(b.x)]) == gen, bar);
            __builtin_amdgcn_fence(__ATOMIC_ACQUIRE, "agent");
            asm volatile("s_waitcnt vmcnt(0)" ::: "memory");
        }
    }
    __syncthreads();
}

#define LDS_WAIT() asm volatile("s_waitcnt lgkmcnt(0)" ::: "memory")
__device__ __forceinline__ float wave_sum(float v) {
#pragma unroll
    for (int o = 1; o < 64; o <<= 1) v += __shfl_xor(v, o);
    return v;
}
__device__ __forceinline__ void tr_item(const float* W, int K, int N, bf16_t* WT, const float* rs, const float* cs, int perm_limit, LAS float* scr, int item, int lane) {
    const int nblk = N / 32, kb = item / nblk, nb = item % nblk, k0 = 64 * kb, n0 = 32 * nb;
    const float csv = cs ? cs[n0 + (lane & 31)] : 1.f;
    float wv[32], rv[32];
#pragma unroll
    for (int i = 0; i < 32; ++i) { const int kk = 2 * i + (lane >> 5); wv[i] = W[(size_t)(k0 + kk) * N + n0 + (lane & 31)]; rv[i] = rs ? rs[k0 + kk] : 1.f; }
#pragma unroll
    for (int i = 0; i < 32; ++i) { const int kk = 2 * i + (lane >> 5); scr[kk * 33 + (lane & 31)] = wv[i] * rv[i] * csv; }
    LDS_WAIT(); asm volatile("" ::: "memory");
    int d0 = n0; if (n0 < perm_limit) { const int tile = n0 >> 8, lb = (n0 >> 5) & 7; d0 = (tile << 8) + ((4 * (lb & 1) + (lb >> 1)) << 5); }
    if (perm_limit < 0) { const int isv = n0 >= D_FF, ch = n0 - (isv ? D_FF : 0); d0 = (ch >> 7) * 256 + isv * 128 + (ch & 127); }
    const int c = lane & 7;
#pragma unroll
    for (int j = 0; j < 4; ++j) { const int n = (lane >> 3) + 8 * j; const LAS float* s = scr + (8 * c) * 33 + n;
        u32x4 o; o.x = cvt_pk_bf16(s[0 * 33], s[1 * 33]); o.y = cvt_pk_bf16(s[2 * 33], s[3 * 33]); o.z = cvt_pk_bf16(s[4 * 33], s[5 * 33]); o.w = cvt_pk_bf16(s[6 * 33], s[7 * 33]);
        *(u32x4*)(WT + (size_t)(d0 + n) * K + k0 + 8 * c) = o; }
    LDS_WAIT(); asm volatile("" ::: "memory");
}
__device__ __forceinline__ void norm_row(const float* xrow, bf16_t* orow, float* crow_, int lane) {
    f32x4 v[8]; float s = 0.f;
#pragma unroll
    for (int j = 0; j < 4; ++j) { v[2 * j] = *(const f32x4*)(xrow + j * 512 + lane * 8); v[2 * j + 1] = *(const f32x4*)(xrow + j * 512 + lane * 8 + 4); s += pg8::sumsq4(v[2 * j]) + pg8::sumsq4(v[2 * j + 1]); }
    const float rstd = __builtin_amdgcn_rsqf(wave_sum(s) * (1.0f / D_MODEL) + EPS);
#pragma unroll
    for (int j = 0; j < 4; ++j) { if (crow_) { *(f32x4*)(crow_ + j * 512 + lane * 8) = v[2 * j]; *(f32x4*)(crow_ + j * 512 + lane * 8 + 4) = v[2 * j + 1]; }
        *(u32x4*)(orow + j * 512 + lane * 8) = pg8::pack8(v[2 * j] * rstd, v[2 * j + 1] * rstd); }
}

__device__ __forceinline__ void raw_row(const float* xrow, bf16_t* orow, rss_t* ssq, int lane) {
    f32x4 v[8]; float s = 0.f;
#pragma unroll
    for (int j = 0; j < 4; ++j) { v[2 * j] = *(const f32x4*)(xrow + j * 512 + lane * 8); v[2 * j + 1] = *(const f32x4*)(xrow + j * 512 + lane * 8 + 4); s += pg8::sumsq4(v[2 * j]) + pg8::sumsq4(v[2 * j + 1]); }
    s = wave_sum(s); if (lane == 0) *ssq = ss_fix(s);
#pragma unroll
    for (int j = 0; j < 4; ++j) *(u32x4*)(orow + j * 512 + lane * 8) = pg8::pack8(v[2 * j], v[2 * j + 1]);
}

template <int WIN> __device__ __forceinline__ void pool_item(const bf16_t* U, bf16_t* ZP, int r0, int ch, bool big) {
    constexpr int NR = 3 + 2 * WIN, SM = WIN / 2;
    const int pos0 = tok_pos(r0), S = tok_seqlen(r0);
    u32x4 v[NR];
#pragma unroll
    for (int k = 0; k < NR; ++k) { const int p = pos0 - WIN + k; v[k] = (p >= 0 && p < S) ? *(const u32x4*)(U + (size_t)(r0 - WIN + k) * 1024 + ch) : (u32x4){0u, 0u, 0u, 0u}; }
    float sb[8], ss[8];
#pragma unroll
    for (int j = 0; j < 8; ++j) { sb[j] = 0.f; ss[j] = 0.f; }
#define POOL_ACC(dst, k, sgn) do { const u32x4 w_ = v[k]; dst[0] += sgn bflo(w_.x); dst[1] += sgn bfhi(w_.x); dst[2] += sgn bflo(w_.y); dst[3] += sgn bfhi(w_.y); dst[4] += sgn bflo(w_.z); dst[5] += sgn bfhi(w_.z); dst[6] += sgn bflo(w_.w); dst[7] += sgn bfhi(w_.w); } while (0)
#pragma unroll
    for (int k = 0; k < 2 * WIN; ++k) { POOL_ACC(sb, k, +); if (k >= WIN - SM && k < WIN + SM) POOL_ACC(ss, k, +); }
#pragma unroll
    for (int i = 0; i < 4; ++i) {
        if (i > 0) { POOL_ACC(sb, i + 2 * WIN - 1, +); POOL_ACC(sb, i - 1, -); POOL_ACC(ss, i + WIN + SM - 1, +); POOL_ACC(ss, i + WIN - SM - 1, -); }
        const int pos = pos0 + i, w2 = big ? WIN : SM; const int lo_ = pos - w2 < 0 ? 0 : pos - w2, hi_ = pos + w2 > S ? S : pos + w2; const float inv = 1.0f / (float)(hi_ - lo_);
        const u32x4 c = v[WIN + i]; float s[8];
#pragma unroll
        for (int j = 0; j < 8; ++j) s[j] = (big ? sb[j] : ss[j]) * inv;
        u32x4 o; o.x = cvt_pk_bf16(s[0] - bflo(c.x), s[1] - bfhi(c.x)); o.y = cvt_pk_bf16(s[2] - bflo(c.y), s[3] - bfhi(c.y)); o.z = cvt_pk_bf16(s[4] - bflo(c.z), s[5] - bfhi(c.z)); o.w = cvt_pk_bf16(s[6] - bflo(c.w), s[7] - bfhi(c.w));
        *(u32x4*)(ZP + (size_t)(r0 + i) * 1024 + ch) = o; }
#undef POOL_ACC
}

struct Args { const float* in[28]; float* out; unsigned char* ws; int ph_lo, ph_hi; };

__global__ void __launch_bounds__(NWAVES * 64, 2) trunk_fwd(Args args) {
    extern __shared__ __attribute__((aligned(16))) unsigned char lds_raw[];
    LAS unsigned char* lds = (LAS unsigned char*)lds_raw;
    volatile LAS unsigned* MISC = (volatile LAS unsigned*)(lds + MISC_OFF);
    for (int u = threadIdx.x; u < (LDS_BYTES - LDSCTL_OFF) / 4; u += NWAVES * 64) ((LAS unsigned*)(lds + LDSCTL_OFF))[u] = 0u;
    __syncthreads();
    const int lo = args.ph_lo, hi = args.ph_hi;
    XcdBarrier bar; bar.bar = (unsigned*)(args.ws + WS_CTL) + CW_BAR; bar.x = 0; bar.st = nullptr;
    if (hi - lo > 1) bar = xcd_barrier_post((unsigned*)(args.ws + WS_CTL) + CW_BAR, MISC + 8);
#define IN(k) ({ int lo_ = lo, hi_ = hi; asm volatile("" : "+s"(lo_), "+s"(hi_)); lo_ <= (k) && (k) < hi_; })
#define SEAM(k) do { if (IN(k) && IN((k) + 1)) { XcdBarrier b2_ = bar; asm volatile("" : "+s"(b2_.bar), "+s"(b2_.x)); xcd_barrier(b2_); } } while (0)
#define PHASE_BEGIN() int tid = threadIdx.x; asm volatile("" : "+v"(tid)); int zo = 0; asm volatile("" : "+s"(zo)); \
    const int lane = tid & 63, wave = __builtin_amdgcn_readfirstlane(tid >> 6); const int G = gridDim.x, bx = blockIdx.x; \
    const int vcu = (G % 8 == 0) ? (bx % 8) * (G / 8) + bx / 8 : bx; const int gw = vcu * NWAVES + wave, NGW = G * NWAVES; \
    unsigned char* ws = args.ws + zo; float* X = args.out + zo; (void)lane; (void)wave; (void)gw; (void)NGW; (void)ws; (void)X; (void)vcu; (void)tid
#define INP(i) (args.in[(i) + zo])
#define WSP(T, off) ((T*)(ws + (off)))

    for (int l = 0; l < DEPTH; ++l) {
        const int pb = l * PH_PER_LAYER;
        if (PH_EN(0) && IN(pb + 0)) {
            PHASE_BEGIN();
            LAS float* scr = (LAS float*)(lds + wave * 16384);
            constexpr int I_IN = 32 * 128, I_OUT = 32 * 64, I_CQ = 32 * 64, I_CKV = 32 * 128, I_CO = 32 * 64, I_UP = 32 * (UP_W / 32), I_DOWN = (D_FF / 64) * 64, I_P = 4 * 32;
            constexpr int NITEMS = I_IN + I_OUT + I_CQ + I_CKV + I_CO + I_UP + I_DOWN + I_P;
            for (int it = gw; it < NITEMS; it += NGW) {
                int r = it;
                if (r < I_UP) { tr_item(INP(24) + (size_t)l * 2048 * UP_W, 2048, UP_W, WSP(bf16_t, WS_WUP), INP(23) + l * 2048, nullptr, -1, scr, r, lane); continue; } r -= I_UP;
                if (r < I_DOWN) { tr_item(INP(27) + (size_t)l * D_FF * 2048, D_FF, 2048, WSP(bf16_t, WS_WDOWN), nullptr, nullptr, 0, scr, r, lane); continue; } r -= I_DOWN;
                if (r < I_IN) { tr_item(INP(5) + (size_t)l * 2048 * 4096, 2048, 4096, WSP(bf16_t, WS_WIN), INP(4) + l * 2048, nullptr, 2048, scr, r, lane); continue; } r -= I_IN;
                if (r < I_CKV) { tr_item(INP(19) + (size_t)l * 2048 * 4096, 2048, 4096, WSP(bf16_t, WS_WCKV), INP(17) + l * 2048, nullptr, 0, scr, r, lane); continue; } r -= I_CKV;
                if (r < I_OUT) { tr_item(INP(15) + (size_t)l * 2048 * 2048, 2048, 2048, WSP(bf16_t, WS_WOUT), nullptr, nullptr, 0, scr, r, lane); continue; } r -= I_OUT;
                if (r < I_CQ) { tr_item(INP(18) + (size_t)l * 2048 * 2048, 2048, 2048, WSP(bf16_t, WS_WCQ), INP(16) + l * 2048, nullptr, 0, scr, r, lane); continue; } r -= I_CQ;
                if (r < I_CO) { tr_item(INP(22) + (size_t)l * 2048 * 2048, 2048, 2048, WSP(bf16_t, WS_WCO), nullptr, nullptr, 0, scr, r, lane); continue; } r -= I_CO;
                { const int g = r >> 5; tr_item(INP(13) + (size_t)l * 4 * 65536 + (size_t)g * 65536, 256, 256, WSP(bf16_t, WS_WP) + (size_t)g * 65536, nullptr, INP(14) + l * 1024 + g * 256, 0, scr, r & 31, lane); }
            }
            { const float* cw = INP(25) + (size_t)l * 3 * UP_W; const float* cb = INP(26) + (size_t)l * UP_W; u32x4* cwt = WSP(u32x4, WS_CWT);
              for (int ch = vcu * 512 + tid; ch < D_FF; ch += G * 512) { u32x4 w;
                  w.x = cvt_pk_bf16(cw[ch], cw[UP_W + ch]); w.y = cvt_pk_bf16(cw[2 * UP_W + ch], cb[ch]); w.z = cvt_pk_bf16(cw[D_FF + ch], cw[UP_W + D_FF + ch]); w.w = cvt_pk_bf16(cw[2 * UP_W + D_FF + ch], cb[D_FF + ch]); cwt[ch] = w; } }
            bf16_t* HB = WSP(bf16_t, WS_HB);
            if (l == 0) {
                unsigned* csT = WSP(unsigned, WS_COS);
                for (int e = (vcu * 512 + tid); e < 8192 * 32; e += G * 512) { const int pos = e >> 5, i = e & 31;
                    double inv = 1.0; const double b = 0.74989420933245582730;
                    for (int k = 0; k < i; ++k) inv *= b;
                    double rev = (double)pos * inv * 0.15915494309189533577; rev -= __builtin_floor(rev);
                    const float fr_ = (float)rev;
                    const _Float16 hc = (_Float16)__builtin_amdgcn_cosf(fr_), hs = (_Float16)__builtin_amdgcn_sinf(fr_);
                    csT[e] = (unsigned)__builtin_bit_cast(unsigned short, hc) | ((unsigned)__builtin_bit_cast(unsigned short, hs) << 16); }
                bf16_t* MB = WSP(bf16_t, WS_MB);
                for (int m = gw; m < NMEMROWS; m += NGW) { const float* src = m < 1024 ? INP(2) + (size_t)m * 2048 : INP(3) + (size_t)(m - 1024) * 2048; norm_row(src, MB + (size_t)m * 2048, nullptr, lane); }
                rss_t* rss0 = WSP(rss_t, WS_ROWSS);
                for (int m = gw; m < NTOK; m += NGW) { const float* src = m < NTOK_P ? INP(0) + (size_t)m * 2048 : INP(1) + (size_t)(m - NTOK_P) * 2048; raw_row(src, HB + (size_t)m * 2048, rss0 + m, lane); }
            }
        }
        SEAM(pb + 0);
        if (PH_EN(1) && IN(pb + 1)) {
            PHASE_BEGIN(); pg8::StaticOrder SO;
            if (PH_EN(17)) { pg8::ProbSimple P; P.K = 2048; P.lda = 2048; P.ldb = 2048; P.tsplit = 1 << 30; P.adelta = 0; P.A = (const char*)WSP(bf16_t, WS_HB); P.B = (const char*)WSP(bf16_t, WS_WIN);
              SO.init(NTOK / 256, IN_W / 256, G, bx);
              pg8::EpiIn E{WSP(bf16_t, R_Q), (size_t)NTOK * 1024, WSP(const unsigned, WS_COS), INP(6) + l * 64, INP(7) + l * 64, WSP(const rss_t, WS_ROWSS) + (size_t)(l * 3 + 0) * NTOK};
              pg8::gemm_phase<pg8::ProbSimple, pg8::EpiIn, true, true>(lds, P, SO, E); }
            if (PH_EN(16)) { pg8::ProbSimple P; P.K = 2048; P.lda = 2048; P.ldb = 2048; P.tsplit = 1 << 30; P.adelta = 0; P.A = (const char*)WSP(bf16_t, WS_MB); P.B = (const char*)WSP(bf16_t, WS_WCKV);
              SO.init(NMEMROWS / 256, 4096 / 256, G, bx);
              pg8::EpiKV E{WSP(float, WS_KRAW), WSP(bf16_t, WS_VT)};
              pg8::gemm_phase<pg8::ProbSimple, pg8::EpiKV, true, true>(lds, P, SO, E); }
        }
        SEAM(pb + 1);
        if (PH_EN(2) && IN(pb + 2)) {
            if (PH_EN(14)) { PHASE_BEGIN(); const bf16_t* U = WSP(const bf16_t, R_U); bf16_t* ZP = (bf16_t*)X;
#ifdef PROBE_DOUBLE_PASSES
              int nrq = 2; asm volatile("" : "+s"(nrq)); for (int rq_ = 0; rq_ < nrq; ++rq_)
#endif
              for (int it = gw; it < (NTOK / 4) * 2; it += NGW) { const int r0 = (it >> 1) * 4, half = it & 1, ch = half * 512 + lane * 8;
                  if (half == 0) pool_item<2>(U, ZP, r0, ch, lane >= 32); else pool_item<8>(U, ZP, r0, ch, lane >= 32); } }
            if (PH_EN(15)) { PHASE_BEGIN(); const float* gcq = INP(20) + l * 512; const float* gck = INP(21) + l * 512; const float* KRAW = WSP(const float, WS_KRAW); bf16_t* KC = WSP(bf16_t, WS_KC);
              for (int it = gw; it < NMEMROWS * 4; it += NGW) { const int row = it >> 2, h = it & 3; const float* kr = KRAW + (size_t)row * 2048 + h * 512 + lane * 8;
                  const f32x4 a = *(const f32x4*)kr, b = *(const f32x4*)(kr + 4); const float ss = wave_sum(pg8::sumsq4(a) + pg8::sumsq4(b));
                  const float rk = __builtin_amdgcn_rsqf(ss * (1.0f / 512.0f) + EPS);
                  const f32x4 ga = *(const f32x4*)(gcq + lane * 8) * *(const f32x4*)(gck + lane * 8), gb = *(const f32x4*)(gcq + lane * 8 + 4) * *(const f32x4*)(gck + lane * 8 + 4);
                  *(u32x4*)(KC + (size_t)row * 2048 + h * 512 + lane * 8) = pg8::pack8(a * rk * ga, b * rk * gb); } }
            if (PH_EN(18)) {
              PHASE_BEGIN();
              const float lam_init = 0.8f - 0.6f * __expf(-0.3f * (float)l);
              float s1 = 0.f, s2 = 0.f; const float* q1 = INP(8) + l * 64; const float* k1 = INP(9) + l * 64; const float* q2 = INP(10) + l * 64; const float* k2 = INP(11) + l * 64;
              for (int i = 0; i < 64; ++i) { s1 += q1[i] * k1[i]; s2 += q2[i] * k2[i]; }
              const float lam = __expf(s1) - __expf(s2) + lam_init;
              const float* gsub = INP(12) + l * 128;
              bf16_t* Qb = WSP(bf16_t, R_Q); const bf16_t* Kb = WSP(const bf16_t, R_K); const bf16_t* Vb = WSP(const bf16_t, R_V);
              __syncthreads();
              { const int NX = (G % 8 == 0) ? 8 : 1, xcd = bx % NX, j = bx / NX, nb = G / NX, npr = 2048 / NX;
                  for (int kk = j; kk < 2 * npr; kk += nb) { int pair, qt, S; size_t t0;
                      if (kk < npr) { pair = xcd + NX * (kk >> 6); qt = kk & 63; S = S_P; t0 = (size_t)(pair >> 3) * S_P; }
                      else { const int k2_ = kk - npr; pair = xcd + NX * (k2_ >> 5); qt = k2_ & 31; S = S_S; t0 = (size_t)NTOK_P + (size_t)(pair >> 3) * S_S; }
                      const int h = pair & 7; bf16_t* qp = Qb + (t0 + (size_t)qt * 128) * 1024 + h * 128;
                      att::attn_unit(qp, Kb + t0 * 1024 + h * 128, Vb + t0 * 1024 + h * 128, qp, S, lam, gsub, 1.f - lam_init, lds); }
              }
            }
        }
        SEAM(pb + 2);
        if (PH_EN(3) && IN(pb + 3)) {
            PHASE_BEGIN(); pg8::StaticOrder SO;
            pg8::ProbPool P; P.K = 256; P.lda = 1024; P.ldb = 256; P.tsplit = 1 << 30; P.adelta = 0; P.A = (const char*)X; P.B = (const char*)WSP(bf16_t, WS_WP);
            SO.init(NTOK / 256, 4, G, bx);
            pg8::EpiBf<0> E{WSP(bf16_t, R_POUT), 1024, nullptr, nullptr, nullptr};
            pg8::gemm_phase<pg8::ProbPool, pg8::EpiBf<0>, true, true>(lds, P, SO, E);
            { pg8::ProbVW P2; P2.K = 512; P2.lda = 2048; P2.ldb = 2048; P2.tsplit = 1 << 30; P2.adelta = 0; P2.A = (const char*)WSP(bf16_t, WS_WCO); P2.B = (const char*)WSP(bf16_t, WS_VT);
              SO.init(8, 48, G, bx);
              pg8::EpiBf<5> E2{WSP(bf16_t, R_VW), 1024, nullptr, nullptr, nullptr};
              pg8::gemm_phase<pg8::ProbVW, pg8::EpiBf<5>, true, true>(lds, P2, SO, E2); }
#ifdef PROBE_DOUBLE_ATTN
            {
              const float* gsub = INP(12) + l * 128; bf16_t* Qb = WSP(bf16_t, R_Q); const bf16_t* Kb = WSP(const bf16_t, R_K); const bf16_t* Vb = WSP(const bf16_t, R_V); bf16_t* Ob = WSP(bf16_t, R_U);
              __syncthreads();
              const int NX = (G % 8 == 0) ? 8 : 1, xcd = bx % NX, j = bx / NX, nb = G / NX, npr = 2048 / NX;
              for (int kk = j; kk < 2 * npr; kk += nb) { int pair, qt, S; size_t t0;
                  if (kk < npr) { pair = xcd + NX * (kk >> 6); qt = kk & 63; S = S_P; t0 = (size_t)(pair >> 3) * S_P; }
                  else { const int k2_ = kk - npr; pair = xcd + NX * (k2_ >> 5); qt = k2_ & 31; S = S_S; t0 = (size_t)NTOK_P + (size_t)(pair >> 3) * S_S; }
                  const int h = pair & 7; const size_t qo = (t0 + (size_t)qt * 128) * 1024 + h * 128;
                  att::attn_unit(Qb + qo, Kb + t0 * 1024 + h * 128, Vb + t0 * 1024 + h * 128, Ob + qo, S, 0.3f, gsub, 1.f, lds); }
            }
#endif
        }
        SEAM(pb + 3);
        if (PH_EN(4) && IN(pb + 4)) {
            PHASE_BEGIN(); pg8::StaticOrder SO;
            pg8::ProbSimple P; P.K = 2048; P.lda = 1024; P.ldb = 2048; P.tsplit = 16; P.adelta = (long long)R_POUT - (long long)R_Q - 16ll * 128; P.A = (const char*)(ws + R_Q); P.B = (const char*)WSP(bf16_t, WS_WOUT);
            SO.init(NTOK / 256, 8, G, bx);
            pg8::EpiRes E{WSP(bf16_t, WS_HB), WSP(rss_t, WS_ROWSS) + (size_t)(l * 3 + 1) * NTOK, nullptr};
            pg8::gemm_phase<pg8::ProbSimple, pg8::EpiRes, true, true>(lds, P, SO, E);
        }
        SEAM(pb + 4);
        if (PH_EN(5) && IN(pb + 5)) {
            PHASE_BEGIN(); pg8::StaticOrder SO;
            pg8::ProbSimple P; P.K = 2048; P.lda = 2048; P.ldb = 2048; P.tsplit = 1 << 30; P.adelta = 0; P.A = (const char*)WSP(bf16_t, WS_HB); P.B = (const char*)WSP(bf16_t, WS_WCQ);
            SO.init(NTOK / 256, 8, G, bx);
            pg8::EpiBf<1> E{WSP(bf16_t, R_QC), 2048, WSP(float, WS_QSS), (float*)(WSP(rss_t, WS_ROWSS) + (size_t)(l * 3 + 1) * NTOK), nullptr};
            pg8::gemm_phase<pg8::ProbSimple, pg8::EpiBf<1>, true, true>(lds, P, SO, E);
        }
        SEAM(pb + 5);
        if (PH_EN(6) && IN(pb + 6)) {
            PHASE_BEGIN(); pg8::StaticOrder SO;
            pg8::ProbScores P; P.K = 512; P.lda = 2048; P.ldb = 2048; P.tsplit = 1 << 30; P.adelta = 0; P.A = (const char*)(ws + R_QC); P.B = (const char*)WSP(bf16_t, WS_KC);
            SO.init(NTOK / 256, 4, G, bx);
            pg8::EpiBf<2> E{WSP(bf16_t, R_P), 1024, WSP(float, WS_QSS), nullptr, (LAS float*)(lds + XCH_OFF)};
            pg8::gemm_phase<pg8::ProbScores, pg8::EpiBf<2>, true, true>(lds, P, SO, E);
        }
        SEAM(pb + 6);
        if (PH_EN(8) && IN(pb + 7)) {
            PHASE_BEGIN(); pg8::StaticOrder SO;
            pg8::ProbFin P; P.K = 1024; P.lda = 1024; P.ldb = 1024; P.tsplit = 1 << 30; P.adelta = 0; P.A = (const char*)(ws + R_P); P.B = (const char*)WSP(bf16_t, R_VW);
            SO.init(NTOK / 256, 8, G, bx);
            pg8::EpiRes E{WSP(bf16_t, WS_HB), WSP(rss_t, WS_ROWSS) + (size_t)(l * 3 + 2) * NTOK, nullptr};
            pg8::gemm_phase<pg8::ProbFin, pg8::EpiRes, true, true>(lds, P, SO, E);
        }
        SEAM(pb + 7);
        for (int c = 0; c < N_FFN_CHUNKS; ++c) {
            const int pc = pb + 8 + 2 * c; const size_t r0 = (size_t)c * FFN_CHUNK;
            if (PH_EN(11) && IN(pc)) {
                PHASE_BEGIN(); pg8::StaticOrder SO;
                pg8::ProbUp P; P.K = 2048; P.lda = 2048; P.ldb = 2048; P.tsplit = 1 << 30; P.adelta = 0; P.A = (const char*)(WSP(bf16_t, WS_HB) + r0 * 2048); P.B = (const char*)WSP(bf16_t, WS_WUP); P.chunk = c;
                SO.init(FFN_MT + FFN_BT, D_FF / 128, G, bx);
                pg8::EpiGlu E{WSP(bf16_t, R_G), WSP(const rss_t, WS_ROWSS) + (size_t)(l * 3 + 2) * NTOK + r0, WSP(const u32x4, WS_CWT), c, (LAS float*)(lds + GLX_OFF)};
                pg8::gemm_phase<pg8::ProbUp, pg8::EpiGlu, true, true>(lds, P, SO, E);
            }
            SEAM(pc);
            if (PH_EN(13) && IN(pc + 1)) {
                PHASE_BEGIN(); pg8::StaticOrder SO;
                pg8::ProbSimple P; P.K = D_FF; P.lda = D_FF; P.ldb = D_FF; P.tsplit = 1 << 30; P.adelta = 0; P.A = (const char*)(ws + R_G); P.B = (const char*)WSP(bf16_t, WS_WDOWN);
                SO.init(FFN_MT, 8, G, bx);
                pg8::EpiRes E{WSP(bf16_t, WS_HB) + r0 * 2048, (l + 1 < DEPTH) ? WSP(rss_t, WS_ROWSS) + (size_t)((l + 1) * 3 + 0) * NTOK + r0 : nullptr, (l + 1 < DEPTH) ? nullptr : X + r0 * 2048};
                pg8::gemm_phase<pg8::ProbSimple, pg8::EpiRes, true, true>(lds, P, SO, E);
            }
            SEAM(pc + 1);
        }
    }
#undef IN
#undef SEAM
#undef PHASE_BEGIN
#undef INP
#undef WSP
}


#ifdef SELFCHECK
constexpr int CHK_WORD = 1024;
__device__ __forceinline__ void chk_upd(unsigned* ctl, int idx, float got, float ref) { const float e = fabsf(got - ref) / (0.03f * fabsf(ref) + 0.03f); atomicMax(ctl + CHK_WORD + idx, __float_as_uint(e)); }
__device__ __forceinline__ int chk_token(int s) { const int tab[16] = {0, 1, 127, 128, 4095, 8191, 8192, 12345, 32767, 32768, 32769, 36863, 36864, 50000, 65534, 65535}; int t = 0;
#pragma unroll
    for (int i = 0; i < 16; ++i) t = (s & 15) == i ? tab[i] : t; return t; }
__global__ void __launch_bounds__(64) check_kernel(Args args, int after, int l) {
    const int s = blockIdx.x, lane = threadIdx.x; unsigned char* ws = args.ws; unsigned* ctl = (unsigned*)(ws + WS_CTL);
    const int tok = chk_token(s); float* X = args.out;
    const float* xin = tok < NTOK_P ? args.in[0] + (size_t)tok * 2048 : args.in[1] + (size_t)(tok - NTOK_P) * 2048;
    if (after == 1) {
        if (l == 0) {
            float ssx = 0.f; for (int k = lane; k < 2048; k += 64) ssx += xin[k] * xin[k]; ssx = wave_sum(ssx); const float rstd = 1.0f / sqrtf(ssx / 2048.f + EPS);
            const int vec = (s * 7) & 31, isk = vec >> 4, hc = vec & 15;
            const float* w_in = args.in[5]; const float* g_mix = args.in[4]; const int col = isk * 1024 + hc * 64 + lane;
            float z = 0.f; for (int k = 0; k < 2048; ++k) z += xin[k] * rstd * g_mix[k] * w_in[(size_t)k * 4096 + col];
            const float ss = wave_sum(z * z); const float g = (isk ? args.in[7] : args.in[6])[lane]; const float zn = z / sqrtf(ss / 64.f + EPS) * g;
            const float other = __shfl_xor(zn, 32); const int i = lane & 31; const int pos = tok_pos(tok);
            const float ang = (float)pos * powf(10000.f, -(float)i / 32.f); const float c = cosf(ang), sn = sinf(ang);
            const float ref = lane < 32 ? zn * c - other * sn : zn * c + other * sn;
            const bf16_t* Q = (const bf16_t*)(ws + (isk ? R_K : R_Q)); const float got = bf2f(Q[(size_t)tok * 1024 + hc * 64 + lane]);
            const float gother = __shfl_xor(got, 32);
            (void)gother; chk_upd(ctl, 0, got, ref);
            { const unsigned tv = ((const unsigned*)(ws + WS_COS))[pos * 32 + i]; typedef _Float16 h2 __attribute__((ext_vector_type(2))); const h2 hv = __builtin_bit_cast(h2, tv);
              chk_upd(ctl, 1, (float)hv.x, c); chk_upd(ctl, 1, (float)hv.y, sn); }
        }
        { const bf16_t* Q = (const bf16_t*)(ws + R_Q); bf16_t* sv = (bf16_t*)(ws + WS_CHK) + s * 128; const int h = s & 7; sv[lane] = Q[(size_t)tok * 1024 + h * 128 + lane]; sv[lane + 64] = Q[(size_t)tok * 1024 + h * 128 + 64 + lane]; }
    }
    if (after == 2) {
        const int h = s & 7; const bf16_t* sv = (const bf16_t*)(ws + WS_CHK) + s * 128; const int S = tok_seqlen(tok); const size_t t0 = (size_t)tok - tok_pos(tok);
        const bf16_t* K = (const bf16_t*)(ws + R_K) + t0 * 1024 + h * 128; const bf16_t* V = (const bf16_t*)(ws + R_V) + t0 * 1024 + h * 128;
        const float lam_init = 0.8f - 0.6f * expf(-0.3f * (float)l); float s1 = 0.f, s2 = 0.f;
        for (int i = 0; i < 64; ++i) { s1 += (args.in[8] + l * 64)[i] * (args.in[9] + l * 64)[i]; s2 += (args.in[10] + l * 64)[i] * (args.in[11] + l * 64)[i]; }
        const float lam = expf(s1) - expf(s2) + lam_init;
        float o[2][2];
        for (int c = 0; c < 2; ++c) { float mx = -1e30f;
            for (int k = lane; k < S; k += 64) { float d = 0.f; for (int e = 0; e < 64; ++e) d += bf2f(sv[c * 64 + e]) * bf2f(K[(size_t)k * 1024 + c * 64 + e]); mx = fmaxf(mx, d); }
            for (int o_ = 1; o_ < 64; o_ <<= 1) mx = fmaxf(mx, __shfl_xor(mx, o_));
            float lsum = 0.f, a0 = 0.f, a1 = 0.f;
            for (int k = 0; k < S; ++k) { float d = 0.f; for (int e = 0; e < 64; ++e) d += bf2f(sv[c * 64 + e]) * bf2f(K[(size_t)k * 1024 + c * 64 + e]);
                const float p = exp2f(d - mx); lsum += p; a0 += p * bf2f(V[(size_t)k * 1024 + lane]); a1 += p * bf2f(V[(size_t)k * 1024 + 64 + lane]); }
            o[c][0] = a0 / lsum; o[c][1] = a1 / lsum; }
        const float v0 = o[0][0] - lam * o[1][0], v1 = o[0][1] - lam * o[1][1]; const float ss = wave_sum(v0 * v0 + v1 * v1); const float rn = 1.0f / sqrtf(ss / 128.f + EPS) * (1.f - lam_init);
        const float* gsub = args.in[12] + l * 128; const bf16_t* A = (const bf16_t*)(ws + R_Q) + (size_t)tok * 1024 + h * 128;
        chk_upd(ctl, 2, bf2f(A[lane]), v0 * rn * gsub[lane]); chk_upd(ctl, 2, bf2f(A[64 + lane]), v1 * rn * gsub[64 + lane]);
    }
    if (after == 4 && l == 0) {
        const bf16_t* A = (const bf16_t*)(ws + R_Q) + (size_t)tok * 1024; const bf16_t* Pp = (const bf16_t*)(ws + R_POUT) + (size_t)tok * 1024; const float* w_out = args.in[15];
        const int col = (s * 131 + lane * 17) & 2047; float z = xin[col];
        for (int k = 0; k < 1024; ++k) z += bf2f(A[k]) * w_out[(size_t)k * 2048 + col];
        for (int k = 0; k < 1024; ++k) z += bf2f(Pp[k]) * w_out[(size_t)(1024 + k) * 2048 + col];
        chk_upd(ctl, 3, X[(size_t)tok * 2048 + col], z);
    }
    if (after == 8 && tok < FFN_CHUNK) {
        const bf16_t* HB = (const bf16_t*)(ws + WS_HB); const float* w_up = args.in[24] + (size_t)l * 2048 * UP_W; const float* g_ffn = args.in[23] + l * 2048;
        const float* cw = args.in[25] + (size_t)l * 3 * UP_W; const float* cb = args.in[26] + (size_t)l * UP_W;
        const int j = (s * 977 + lane * 53) % D_FF; const int pos = tok_pos(tok), S = tok_seqlen(tok); float u2[2];
        for (int half = 0; half < 2; ++half) { const int col = half * D_FF + j; float acc = cb[col];
            for (int tap = 0; tap < 3; ++tap) { const int pp = pos + tap - 1; if (pp < 0 || pp >= S) continue; const bf16_t* hr = HB + (size_t)(tok + tap - 1) * 2048; float d = 0.f;
                for (int k = 0; k < 2048; ++k) d += bf2f(hr[k]) * g_ffn[k] * w_up[(size_t)k * UP_W + col];
                const float rxx = ss_rstd(((const rss_t*)(ws + WS_ROWSS))[(size_t)(l * 3 + 2) * NTOK + tok + tap - 1]); acc += d * rxx * cw[(size_t)tap * UP_W + col]; }
            u2[half] = acc; }
        const float x = u2[0]; const float ref = 0.5f * x * (1.f + tanhf(0.7978845608028654f * (x + 0.044715f * x * x * x))) * u2[1];
        chk_upd(ctl, 4, bf2f(((const bf16_t*)(ws + R_G))[(size_t)tok * D_FF + j]), ref);
    }
    if (false) {
        const bf16_t* Gr = (const bf16_t*)(ws + R_G) + (size_t)tok * D_FF; const float* w_down = args.in[27] + (size_t)l * D_FF * 2048; const float* svx = (const float*)(ws + WS_CHK + 65536) + (size_t)s * 2048;
        const int col = (s * 131 + lane * 17) & 2047; float z = svx[col]; for (int k = 0; k < D_FF; ++k) z += bf2f(Gr[k]) * w_down[(size_t)k * 2048 + col];
        chk_upd(ctl, 5, X[(size_t)tok * 2048 + col], z);
    }
}
__global__ void __launch_bounds__(256) report_kernel(Args args) {
    unsigned* ctl = (unsigned*)(args.ws + WS_CTL); float* out = args.out;
    for (size_t i = (size_t)blockIdx.x * 256 + threadIdx.x; i < (size_t)NTOK * 2048; i += (size_t)gridDim.x * 256) {
        float v = 0.f;
        if (i == 0) { int mask = 0; for (int b = 0; b < 6; ++b) if (__uint_as_float(ctl[CHK_WORD + b]) > 1.0f) mask |= 1 << b; v = (10.f + (float)mask) * 1000.f; }
        out[i] = v; }
}
#endif

extern "C" void kernel_launch(void* const* d_in, const int* in_sizes, int n_in, void* d_out, int out_size, void* d_ws, size_t ws_size, hipStream_t stream) {
    static int grid = 0;
    if (grid == 0) {
        if (n_in != 28 || out_size != NTOK * D_MODEL || ws_size < WS_END) { fprintf(stderr, "kernel_launch: unexpected shapes: n_in %d out %d ws %zu (need >= %zu)\n", n_in, out_size, ws_size, (size_t)WS_END); grid = -1; return; }
        int dev = 0, cus = 0, per_cu = 0;
        if (hipGetDevice(&dev) != hipSuccess || hipDeviceGetAttribute(&cus, hipDeviceAttributeMultiprocessorCount, dev) != hipSuccess) { grid = -1; return; }
        if (hipFuncSetAttribute((const void*)trunk_fwd, hipFuncAttributeMaxDynamicSharedMemorySize, LDS_BYTES) != hipSuccess) { fprintf(stderr, "kernel_launch: hipFuncSetAttribute failed\n"); grid = -1; return; }
        if (hipOccupancyMaxActiveBlocksPerMultiprocessor(&per_cu, (const void*)trunk_fwd, NWAVES * 64, LDS_BYTES) != hipSuccess || per_cu < 1)
            fprintf(stderr, "kernel_launch: occupancy query reports %d workgroups per CU\n", per_cu);
        (void)hipGetLastError();
        grid = cus;
    }
    if (grid < 0) return;
    (void)hipMemsetAsync((char*)d_ws + WS_CTL, 0, CTL_ZERO_BYTES, stream);
    Args a{};
    for (int i = 0; i < 28; ++i) a.in[i] = (const float*)d_in[i];
    a.out = (float*)d_out; a.ws = (unsigned char*)d_ws;
#if ML_PER_PHASE
    for (int p = 0; p < N_PHASES; ++p) { a.ph_lo = p; a.ph_hi = p + 1; hipLaunchKernelGGL(trunk_fwd, dim3(grid), dim3(NWAVES * 64), LDS_BYTES, stream, a);
#ifdef SELFCHECK
        { const int l = p / PH_PER_LAYER, q = p % PH_PER_LAYER; if (l == SELFCHECK_LAYER && (q == 1 || q == 2 || q == 8)) hipLaunchKernelGGL(check_kernel, dim3(64), dim3(64), 0, stream, a, q, l); }
#endif
    }
#ifdef SELFCHECK
    hipLaunchKernelGGL(report_kernel, dim3(2048), dim3(256), 0, stream, a);
#endif
#else
    a.ph_lo = 0; a.ph_hi = N_PHASES;
    hipLaunchKernelGGL(trunk_fwd, dim3(grid), dim3(NWAVES * 64), LDS_BYTES, stream, a);
#endif
    const hipError_t le = hipPeekAtLastError();
    if (le != hipSuccess) fprintf(stderr, "kernel_launch: launch failed: %s\n", hipGetErrorName(le));
}
```

```cpp
#include <hip/hip_runtime.h>
#include <cstdio>
#include <cstdint>

#define SELFCHECK_LAYER 0
#ifndef ML_PER_PHASE
#define ML_PER_PHASE 0
#endif

#ifndef PHASE_MASK
#define PHASE_MASK 0xFFFFFFFFu
#endif
#define PH_EN(p) (((PHASE_MASK) >> (p)) & 1u)
#ifndef ATTN_NS
#define ATTN_NS att16
#endif
#define LAS __attribute__((address_space(3)))
#define GAS __attribute__((address_space(1)))
typedef unsigned short bf16_t;
typedef short bf16x8 __attribute__((ext_vector_type(8)));
typedef short s16x4 __attribute__((ext_vector_type(4)));
typedef float f32x4 __attribute__((ext_vector_type(4)));
typedef float f32x2 __attribute__((ext_vector_type(2)));
typedef float f32x16 __attribute__((ext_vector_type(16)));
typedef unsigned u32x4 __attribute__((ext_vector_type(4)));
typedef unsigned u32x2 __attribute__((ext_vector_type(2)));
typedef _Float16 h2_t __attribute__((ext_vector_type(2)));
typedef _Float16 f16x8 __attribute__((ext_vector_type(8)));

constexpr int D_MODEL = 2048, DEPTH = 2;
constexpr int NTOK = 65536;
constexpr int NTOK_P = 32768;
constexpr int S_P = 8192, S_S = 4096;
constexpr int NMEMROWS = 3072;
constexpr int IN_W = 4096, D_FF = 5632, UP_W = 11264;
constexpr float EPS = 1e-6f;
constexpr float QSCALE = 0.125f * 1.4426950408889634f;
constexpr int FFN_CHUNK = 32768, N_FFN_CHUNKS = 2;
constexpr int FFN_MT = FFN_CHUNK / 256, FFN_BT = 0;
constexpr int PH_PER_LAYER = 8 + 2 * N_FFN_CHUNKS;
constexpr int N_PHASES = DEPTH * PH_PER_LAYER;

constexpr size_t MiB = 1u << 20;
constexpr size_t WS_CTL = 0, CTL_ZERO_BYTES = 5 * MiB;
constexpr size_t WS_ROWSS = 1 * MiB;
constexpr size_t WS_COS = 5 * MiB;
constexpr size_t WS_QSS = 6 * MiB;
constexpr size_t WS_LPART = 14 * MiB;
constexpr size_t WS_MB = 18 * MiB;
constexpr size_t WS_KRAW = 30 * MiB;
constexpr size_t WS_KC = 54 * MiB;
constexpr size_t WS_VT = 66 * MiB;
constexpr size_t WS_CHK = 78 * MiB;
constexpr size_t WS_WIN = 79 * MiB, WS_WP = 95 * MiB, WS_WOUT = 96 * MiB, WS_WCQ = 104 * MiB, WS_WCKV = 112 * MiB, WS_WCO = 128 * MiB, WS_WUP = 136 * MiB, WS_WDOWN = 180 * MiB;
constexpr size_t WS_HB = 203 * MiB;
constexpr size_t WS_R = 459 * MiB;
constexpr size_t WS_CWT = 987 * MiB;
constexpr size_t WS_END = 988 * MiB;
typedef unsigned long long rss_t;
__device__ __forceinline__ rss_t ss_fix(float s) { return (rss_t)(s * 1048576.0f + 0.5f); }
__device__ __forceinline__ float ss_rstd(rss_t v) { return __builtin_amdgcn_rsqf((float)v * (1.0f / (1048576.0f * 2048.0f)) + 1e-6f); }
constexpr size_t R_Q = WS_R, R_K = WS_R + 128 * MiB, R_V = WS_R + 256 * MiB, R_U = WS_R + 384 * MiB;
constexpr size_t R_QC = WS_R, R_P = WS_R + 256 * MiB, R_VW = WS_R + 384 * MiB;
constexpr size_t R_G = WS_R;
constexpr int FFN_GSPLIT_ROW = 49152;
constexpr size_t FFN_EB_OUT_OFF = 192 * MiB;
constexpr size_t R_EB = WS_R + 384 * MiB;
constexpr size_t R_POUT = WS_R + 128 * MiB;
static_assert(R_G + (size_t)FFN_CHUNK * D_FF * 2 <= WS_END, "ws map");
constexpr int CW_BAR = 4096;

constexpr int RING_BYTES = 131072;
constexpr int LDSCTL_OFF = RING_BYTES, MISC_OFF = LDSCTL_OFF + 320, XCH_OFF = LDSCTL_OFF + 1024, GLX_OFF = XCH_OFF + 4096;
constexpr int LDS_BYTES = 151552;
constexpr int NWAVES = 8;

__device__ __forceinline__ unsigned cvt_pk_bf16(float lo, float hi) { unsigned r; asm volatile("v_cvt_pk_bf16_f32 %0, %1, %2" : "=v"(r) : "v"(lo), "v"(hi)); return r; }
__device__ __forceinline__ float bf2f(unsigned short b) { return __uint_as_float(((unsigned)b) << 16); }
__device__ __forceinline__ float bflo(unsigned w) { return __uint_as_float(w << 16); }
__device__ __forceinline__ float bfhi(unsigned w) { return __uint_as_float(w & 0xffff0000u); }
__device__ __forceinline__ int tok_pos(int row) { return row < NTOK_P ? (row & (S_P - 1)) : (row & (S_S - 1)); }
__device__ __forceinline__ int tok_seqlen(int row) { return row < NTOK_P ? S_P : S_S; }
__device__ __forceinline__ int tile_batch(int pm) { return pm < 128 ? (pm >> 5) : 4 + ((pm - 128) >> 4); }

namespace pg8 {
constexpr int BM = 256, BK = 64, HALF = 128, HTB = HALF * BK * 2, STAGE_BYTES = 8 * HTB, NXCD = 8, WGM = 4;
__host__ __device__ __forceinline__ int lds_byte(int r, int c) { const int st = (r >> 4) * 2 + (c >> 5), rr = r & 15, cc = c & 31, ob = rr * 64 + cc * 2; return st * 1024 + (ob ^ (((ob >> 9) & 1) << 5)); }
__host__ __device__ __forceinline__ void stage_rc(int b, int& R, int& C) { const int st = b / 1024, sb = b % 1024, swz = sb ^ (((sb >> 9) & 1) << 5); R = (st >> 1) * 16 + swz / 64; C = (st & 1) * 32 + (swz % 64) / 2; }
__host__ __device__ __forceinline__ int perm32(int rho) { const int n = rho >> 4, i = rho & 15; return 8 * (i >> 2) + 4 * n + (i & 3); }
struct Unit { int pm, pn; };
struct StaticOrder {
    int nM, nN, nwg, G, c;
    __host__ __device__ void init(int nM_, int nN_, int G_, int c_) { nM = nM_; nN = nN_; nwg = nM * nN; G = G_; c = c_; }
    __host__ __device__ bool next(int i, Unit& u) const {
        const long L = (long)i * G + c; if (L >= nwg) return false;
        int wgid = (int)L; { const int q = nwg / NXCD, r = nwg % NXCD, xcd = wgid % NXCD, off = wgid / NXCD; wgid = (xcd < r ? xcd * (q + 1) : r * (q + 1) + (xcd - r) * q) + off; }
        const int nig = WGM * nN, gid = wgid / nig, fm = gid * WGM, gsz = (nM - fm) < WGM ? (nM - fm) : WGM;
        u.pm = fm + ((wgid % nig) % gsz); u.pn = (wgid % nig) / gsz; return true;
    }
};
struct ProbBase { static constexpr bool GATHER = false; static constexpr bool F16 = false; int K, lda, ldb, tsplit; long long adelta; __device__ __forceinline__ unsigned rowoff(const Unit&, int) const { return 0u; } };

template <class Prob, class Epi, bool ALIGN_EPI, bool SP2>
__device__ __forceinline__ void gemm_phase(LAS unsigned char* lds, const Prob& P, const StaticOrder& S, const Epi& E) {
    static_assert(SP2, "only the two-super-phase loop is kept in this file");
    int tid_l = threadIdx.x; asm volatile("" : "+v"(tid_l));
    const int tid = tid_l, wid = __builtin_amdgcn_readfirstlane(tid >> 6), lane = tid & 63, wr = wid >> 2, wc = wid & 3, fr = lane & 15, fq = lane >> 4;
    const int K = P.K, nt = K / BK, lda = P.lda, ldb = P.ldb, tsplit = P.tsplit; const long long adelta = P.adelta;
    unsigned voffA[2], voffB[2];
#pragma unroll
    for (int i = 0; i < 2; ++i) { int R, C; stage_rc(tid * 16 + i * 8192, R, C); const int Rb = Epi::PERM ? ((R & ~31) + perm32(R & 31)) : R;
        voffA[i] = (unsigned)(R * lda + C) * 2u; voffB[i] = (unsigned)(Rb * ldb + C) * 2u; }
    const size_t kstep = (size_t)(BK * 2);
    const size_t hstepA = (size_t)HALF * lda * 2, hstepB = (size_t)HALF * ldb * 2;
    const unsigned ldsw = (unsigned)wid * 1024u;
    const int aoff = lds_byte(wr * 64 + fr, fq * 8), boff = lds_byte(wc * 32 + fr, fq * 8);
    unsigned vAc[2][2], vAn[2][2];
#define PG8_SA(b, h) (((b) * 2 + (h)) * HTB)
#define PG8_SB(b, h) ((4 + (b) * 2 + (h)) * HTB)
#define PG8_STAGE(bufoff, gbase, voff) do { _Pragma("unroll") for (int _i = 0; _i < 2; ++_i) \
        __builtin_amdgcn_global_load_lds((const unsigned*)((const char*)(gbase) + (voff)[_i]), (LAS unsigned*)(lds + (bufoff) + ldsw + _i * 8192), 16, 0, 0); } while (0)
#define PG8_STAGE_A(bufoff, kptr, h, NXT) do { if constexpr (Prob::GATHER) { _Pragma("unroll") for (int _i = 0; _i < 2; ++_i) \
        __builtin_amdgcn_global_load_lds((const unsigned*)((const char*)(kptr) + ((NXT) ? vAn[h][_i] : vAc[h][_i])), (LAS unsigned*)(lds + (bufoff) + ldsw + _i * 8192), 16, 0, 0); } \
        else { PG8_STAGE(bufoff, (kptr) + (h) * hstepA, voffA); } } while (0)
#define PG8_GATHER_OFFS(dst, unit) do { _Pragma("unroll") for (int _i = 0; _i < 2; ++_i) { int _R, _C; stage_rc(tid * 16 + _i * 8192, _R, _C); _Pragma("unroll") for (int _h = 0; _h < 2; ++_h) dst[_h][_i] = P.rowoff(unit, _R + 128 * _h) + (unsigned)_C * 2u; } } while (0)
#define PG8_LDA(dst, b, h) do { _Pragma("unroll") for (int m = 0; m < 4; ++m) _Pragma("unroll") for (int k = 0; k < 2; ++k) dst[m][k] = *(const LAS bf16x8*)(lds + PG8_SA(b, h) + aoff + m * 2048 + k * 1024); } while (0)
#define PG8_LDB(dst, b, h) do { _Pragma("unroll") for (int n = 0; n < 2; ++n) _Pragma("unroll") for (int k = 0; k < 2; ++k) dst[n][k] = *(const LAS bf16x8*)(lds + PG8_SB(b, h) + boff + n * 2048 + k * 1024); } while (0)
#define PG8_MMA(ai, bj, At, Bt) do { __builtin_amdgcn_s_setprio(1); _Pragma("unroll") for (int m = 0; m < 4; ++m) _Pragma("unroll") for (int n = 0; n < 2; ++n) _Pragma("unroll") for (int k = 0; k < 2; ++k) \
        { if constexpr (Prob::F16) acc[ai][bj][m][n] = __builtin_amdgcn_mfma_f32_16x16x32_f16(__builtin_bit_cast(f16x8, Bt[n][k]), __builtin_bit_cast(f16x8, At[m][k]), acc[ai][bj][m][n], 0, 0, 0); \
          else acc[ai][bj][m][n] = __builtin_amdgcn_mfma_f32_16x16x32_bf16(Bt[n][k], At[m][k], acc[ai][bj][m][n], 0, 0, 0); } __builtin_amdgcn_s_setprio(0); } while (0)
#define PG8_WAIT_V(n) asm volatile("s_waitcnt vmcnt(" #n ")" ::: "memory")
#define PG8_WAIT_L(n) asm volatile("s_waitcnt lgkmcnt(" #n ")" ::: "memory")
#define PG8_BAR __builtin_amdgcn_s_barrier()
#define PG8_SCHED __builtin_amdgcn_sched_barrier(0)
#define PG8_AK(base, t) ((base) + (size_t)(t) * kstep + (((t) >= tsplit) ? adelta : 0ll))
    Unit cur, nxt; int ui = 0;
    if (!S.next(0, cur)) return;
    f32x4 acc[2][2][4][2];
#pragma unroll
    for (int a = 0; a < 2; ++a)
#pragma unroll
        for (int b = 0; b < 2; ++b)
#pragma unroll
            for (int m = 0; m < 4; ++m)
#pragma unroll
                for (int n = 0; n < 2; ++n) acc[a][b][m][n] = (f32x4){0.f, 0.f, 0.f, 0.f};
    bf16x8 At[4][2], B0[2][2], B1[2][2];
    const char* cA = P.aptr(cur); const char* cB = P.bptr(cur);
    if constexpr (Prob::GATHER) { PG8_GATHER_OFFS(vAc, cur); }
    PG8_STAGE(PG8_SB(0, 0), cB, voffB); PG8_STAGE(PG8_SB(0, 1), cB + hstepB, voffB); PG8_STAGE_A(PG8_SA(0, 0), cA, 0, false); PG8_STAGE_A(PG8_SA(0, 1), cA, 1, false);
    if (wr == 1) PG8_BAR;
    PG8_WAIT_V(2); PG8_BAR;
    PG8_STAGE(PG8_SB(1, 0), cB + kstep, voffB); PG8_STAGE_A(PG8_SA(1, 0), PG8_AK(cA, 1), 0, false); PG8_STAGE(PG8_SB(1, 1), cB + hstepB + kstep, voffB);
    PG8_WAIT_V(6); PG8_BAR;
    for (;;) {
        const bool has_next = S.next(ui + 1, nxt);
        const char* nA = has_next ? P.aptr(nxt) : cA; const char* nB = has_next ? P.bptr(nxt) : cB;
        if constexpr (Prob::GATHER) { if (has_next) { PG8_GATHER_OFFS(vAn, nxt); } else {
#pragma unroll
            for (int _h = 0; _h < 2; ++_h)
#pragma unroll
                for (int _i = 0; _i < 2; ++_i) vAn[_h][_i] = vAc[_h][_i]; } }
        for (int t = 0; t < nt; t += 2) {
            const bool last = (t == nt - 2);
            const int rv = ui & 1, nrv = rv ^ 1;
#define PG8_KT(r, tt) ((r) ? nt - 1 - (tt) : (tt))
            const char* a1 = PG8_AK(cA, PG8_KT(rv, t + 1));
            const char* a2 = last ? PG8_AK(nA, PG8_KT(nrv, 0)) : PG8_AK(cA, PG8_KT(rv, t + 2)); const char* b2 = last ? nB + (size_t)PG8_KT(nrv, 0) * kstep : cB + (size_t)PG8_KT(rv, t + 2) * kstep;
            const char* a3 = last ? PG8_AK(nA, PG8_KT(nrv, 1)) : PG8_AK(cA, PG8_KT(rv, t + 3)); const char* b3 = last ? nB + (size_t)PG8_KT(nrv, 1) * kstep : cB + (size_t)PG8_KT(rv, t + 3) * kstep;
#undef PG8_KT
            PG8_LDB(B0, 0, 0); PG8_LDB(B1, 0, 1); PG8_SCHED; PG8_LDA(At, 0, 0); PG8_STAGE_A(PG8_SA(1, 1), a1, 1, false);
            PG8_WAIT_V(8); PG8_WAIT_L(0); PG8_BAR; PG8_MMA(0, 0, At, B0); PG8_MMA(0, 1, At, B1); PG8_BAR; PG8_SCHED;
            PG8_LDA(At, 0, 1); PG8_STAGE(PG8_SB(0, 0), b2, voffB); PG8_STAGE(PG8_SB(0, 1), b2 + hstepB, voffB); PG8_STAGE_A(PG8_SA(0, 0), a2, 0, last);
            PG8_WAIT_V(8); PG8_WAIT_L(0); PG8_BAR; PG8_MMA(1, 0, At, B0); PG8_MMA(1, 1, At, B1); PG8_BAR; PG8_SCHED;
            PG8_LDB(B0, 1, 0); PG8_LDB(B1, 1, 1); PG8_SCHED; PG8_LDA(At, 1, 0); PG8_STAGE_A(PG8_SA(0, 1), a2, 1, last);
            PG8_WAIT_V(8); PG8_WAIT_L(0); PG8_BAR; PG8_MMA(0, 0, At, B0); PG8_MMA(0, 1, At, B1); PG8_BAR; PG8_SCHED;
            PG8_LDA(At, 1, 1); PG8_STAGE(PG8_SB(1, 0), b3, voffB); PG8_STAGE(PG8_SB(1, 1), b3 + hstepB, voffB); PG8_STAGE_A(PG8_SA(1, 0), a3, 0, last);
            PG8_WAIT_V(8); PG8_WAIT_L(0); PG8_BAR; PG8_MMA(1, 0, At, B0); PG8_MMA(1, 1, At, B1); PG8_BAR; PG8_SCHED;
        }
        if constexpr (ALIGN_EPI) { if (wr == 0) PG8_BAR; }
        { int te = threadIdx.x; asm volatile("" : "+v"(te));
          const int we = __builtin_amdgcn_readfirstlane(te >> 6), le = te & 63; E(acc, cur, we >> 2, we & 3, le & 15, le >> 4); }
        if (!has_next) break;
#pragma unroll
        for (int a = 0; a < 2; ++a)
#pragma unroll
            for (int b = 0; b < 2; ++b)
#pragma unroll
                for (int m = 0; m < 4; ++m)
#pragma unroll
                    for (int n = 0; n < 2; ++n) acc[a][b][m][n] = (f32x4){0.f, 0.f, 0.f, 0.f};
        cur = nxt; cA = nA; cB = nB; ++ui;
        if constexpr (Prob::GATHER) {
#pragma unroll
            for (int _h = 0; _h < 2; ++_h)
#pragma unroll
                for (int _i = 0; _i < 2; ++_i) vAc[_h][_i] = vAn[_h][_i]; }
        if constexpr (ALIGN_EPI) { if (wr == 1) PG8_BAR; }
    }
    PG8_WAIT_V(0);
    if constexpr (!ALIGN_EPI) { if (wr == 0) PG8_BAR; }
    PG8_BAR;
#undef PG8_SA
#undef PG8_SB
#undef PG8_STAGE
#undef PG8_STAGE_A
#undef PG8_GATHER_OFFS
#undef PG8_LDA
#undef PG8_LDB
#undef PG8_MMA
#undef PG8_WAIT_V
#undef PG8_WAIT_L
#undef PG8_BAR
#undef PG8_SCHED
#undef PG8_AK
}

struct ProbSimple : ProbBase {
    const char* A; const char* B;
    __device__ __forceinline__ const char* aptr(const Unit& u) const { return A + (size_t)u.pm * 256 * lda * 2; }
    __device__ __forceinline__ const char* bptr(const Unit& u) const { return B + (size_t)u.pn * 256 * ldb * 2; }
};
struct ProbSimpleF16 : ProbSimple { static constexpr bool F16 = true; };
struct ProbDown : ProbBase {
    static constexpr bool F16 = true;
    const char* A; const char* A2; const char* B; int split;
    __device__ __forceinline__ const char* aptr(const Unit& u) const { return (u.pm < split ? A : A2) + (size_t)u.pm * 256 * lda * 2; }
    __device__ __forceinline__ const char* bptr(const Unit& u) const { return B + (size_t)u.pn * 256 * ldb * 2; }
};
struct ProbPool : ProbBase {
    const char* A; const char* B;
    __device__ __forceinline__ const char* aptr(const Unit& u) const { return A + ((size_t)u.pm * 256 * 1024 + (size_t)u.pn * 256) * 2; }
    __device__ __forceinline__ const char* bptr(const Unit& u) const { return B + (size_t)u.pn * 65536 * 2; }
};
struct ProbScores : ProbBase {
    const char* A; const char* B;
    __device__ __forceinline__ const char* aptr(const Unit& u) const { return A + ((size_t)u.pm * 256 * 2048 + (size_t)u.pn * 512) * 2; }
    __device__ __forceinline__ const char* bptr(const Unit& u) const { return B + ((size_t)tile_batch(u.pm) * 256 * 2048 + (size_t)u.pn * 512) * 2; }
};
struct ProbVW : ProbBase {
    const char* A; const char* B;
    __device__ __forceinline__ const char* aptr(const Unit& u) const { return A + ((size_t)u.pm * 256 * 2048 + (size_t)(u.pn & 3) * 512) * 2; }
    __device__ __forceinline__ const char* bptr(const Unit& u) const { return B + ((size_t)(u.pn >> 2) * 256 * 2048 + (size_t)(u.pn & 3) * 512) * 2; }
};
struct ProbFin : ProbBase {
    const char* A; const char* B;
    __device__ __forceinline__ const char* aptr(const Unit& u) const { return A + (size_t)u.pm * 256 * 1024 * 2; }
    __device__ __forceinline__ const char* bptr(const Unit& u) const { return B + ((size_t)tile_batch(u.pm) * 2048 + (size_t)u.pn * 256) * 1024 * 2; }
};
struct ProbPV : ProbBase {
    const char* A; const char* B;
    __device__ __forceinline__ const char* aptr(const Unit& u) const { return A + ((size_t)u.pm * 256 * 1024 + (size_t)(u.pn >> 1) * 256) * 2; }
    __device__ __forceinline__ const char* bptr(const Unit& u) const { return B + ((size_t)tile_batch(u.pm) * 2048 + (size_t)u.pn * 256) * 256 * 2; }
};

__device__ __forceinline__ u32x4 pack8(const f32x4& v0, const f32x4& v1) { u32x4 w; w.x = cvt_pk_bf16(v0[0], v0[1]); w.y = cvt_pk_bf16(v0[2], v0[3]); w.z = cvt_pk_bf16(v1[0], v1[1]); w.w = cvt_pk_bf16(v1[2], v1[3]); return w; }
__device__ __forceinline__ float sumsq4(const f32x4& x) { return (x[0] * x[0] + x[1] * x[1]) + (x[2] * x[2] + x[3] * x[3]); }
__device__ __forceinline__ float sum4(const f32x4& x) { return (x[0] + x[1]) + (x[2] + x[3]); }
__device__ __forceinline__ float red_fq(float s) { s += __shfl_xor(s, 16); s += __shfl_xor(s, 32); return s; }

struct EpiIn {
    static constexpr bool PERM = true;
    bf16_t* base; size_t spl; const unsigned* csT; const float* gq; const float* gk; const rss_t* rowss;
    __device__ __forceinline__ void operator()(const f32x4 (&acc)[2][2][4][2], const Unit& u, int wr, int wc, int fr, int fq) const {
        typedef _Float16 h2 __attribute__((ext_vector_type(2)));
        const int t = u.pn >> 2; bf16_t* O = base + (size_t)t * spl; const int colt = (u.pn & 3) * 256; const int row0 = u.pm * BM + wr * 64 + fr;
        if (t >= 2) {
            const int col0 = colt + wc * 32 + 8 * fq;
#pragma unroll
            for (int ai = 0; ai < 2; ++ai) { rss_t rx[4];
#pragma unroll
                for (int m = 0; m < 4; ++m) rx[m] = rowss[row0 + ai * HALF + m * 16];
#pragma unroll
                for (int m = 0; m < 4; ++m) { const float rxm = ss_rstd(rx[m]); bf16_t* rowp = O + (size_t)(row0 + ai * HALF + m * 16) * 1024 + col0;
#pragma unroll
                    for (int bj = 0; bj < 2; ++bj) *(u32x4*)(rowp + bj * HALF) = pack8(acc[ai][bj][m][0] * rxm, acc[ai][bj][m][1] * rxm); }
                asm volatile("" ::: "memory"); }
        } else {
            const float* g = t ? gk : gq; f32x4 g1[2], g2[2];
#pragma unroll
            for (int n = 0; n < 2; ++n) { g1[n] = *(const f32x4*)(g + 8 * fq + 4 * n); g2[n] = *(const f32x4*)(g + 32 + 8 * fq + 4 * n); }
            const int col0 = colt + 64 * wc + 8 * fq;
#pragma unroll
            for (int ah = 0; ah < 4; ++ah) { const int ai = ah >> 1, mb = (ah & 1) * 2;
                u32x4 cs[2][2]; rss_t rx[2];
#pragma unroll
                for (int mm = 0; mm < 2; ++mm) { const int m = mb + mm; const int pos = tok_pos(row0 + ai * HALF + m * 16); rx[mm] = rowss[row0 + ai * HALF + m * 16];
#pragma unroll
                    for (int n = 0; n < 2; ++n) cs[mm][n] = *(const u32x4*)(csT + pos * 32 + 8 * fq + 4 * n); }
#pragma unroll
                for (int mm = 0; mm < 2; ++mm) { const int m = mb + mm; const int row = row0 + ai * HALF + m * 16;
                    float ss = (sumsq4(acc[ai][0][m][0]) + sumsq4(acc[ai][0][m][1])) + (sumsq4(acc[ai][1][m][0]) + sumsq4(acc[ai][1][m][1]));
                    ss = red_fq(ss);
                    const float rxm = ss_rstd(rx[mm]);
                    const float r = __builtin_amdgcn_rsqf(ss * rxm * rxm * (1.0f / 64.0f) + EPS) * rxm * (t ? 1.0f : QSCALE);
                    f32x4 o1[2], o2[2];
#pragma unroll
                    for (int n = 0; n < 2; ++n) { f32x4 c, s;
#pragma unroll
                        for (int j = 0; j < 4; ++j) { const unsigned w = cs[mm][n][j]; const h2 v = __builtin_bit_cast(h2, w); c[j] = (float)v.x; s[j] = (float)v.y; }
                        const f32x4 x1 = acc[ai][0][m][n] * r * g1[n], x2 = acc[ai][1][m][n] * r * g2[n];
                        o1[n] = x1 * c - x2 * s; o2[n] = x2 * c + x1 * s; }
                    bf16_t* rowp = O + (size_t)row * 1024 + col0;
                    *(u32x4*)(rowp) = pack8(o1[0], o1[1]); *(u32x4*)(rowp + 32) = pack8(o2[0], o2[1]); }
                asm volatile("" ::: "memory"); }
        }
    }
};
template <int MODE> struct EpiBf {
    static constexpr bool PERM = true;
    bf16_t* O; int ldc; float* aux; float* aux2; LAS float* xl;
    __device__ __forceinline__ void operator()(f32x4 (&acc)[2][2][4][2], const Unit& u, int wr, int wc, int fr, int fq) const {
        const int row0 = u.pm * BM + wr * 64 + fr; const int col0 = u.pn * BM + wc * 32 + 8 * fq;
        float rs[2][4];
        if constexpr (MODE == 2) {
            f32x4 qa[2][4][2];
#pragma unroll
            for (int ai = 0; ai < 2; ++ai)
#pragma unroll
                for (int m = 0; m < 4; ++m) { const float* p = aux + (size_t)(row0 + ai * HALF + m * 16) * 32 + u.pn * 8; qa[ai][m][0] = *(const f32x4*)p; qa[ai][m][1] = *(const f32x4*)(p + 4); }
#pragma unroll
            for (int ai = 0; ai < 2; ++ai)
#pragma unroll
                for (int m = 0; m < 4; ++m) { const float sc = __builtin_amdgcn_rsqf((sum4(qa[ai][m][0]) + sum4(qa[ai][m][1])) * (1.0f / 512.0f) + EPS) * (0.044194173824159216f * 1.4426950408889634f); float ps = 0.f;
#pragma unroll
                    for (int bj = 0; bj < 2; ++bj)
#pragma unroll
                        for (int n = 0; n < 2; ++n) { f32x4 p;
#pragma unroll
                            for (int j = 0; j < 4; ++j) p[j] = __builtin_amdgcn_exp2f(acc[ai][bj][m][n][j] * sc);
                            acc[ai][bj][m][n] = p; ps += sum4(p); }
                    ps = red_fq(ps);
                    if (fq == 0) xl[(ai * HALF + wr * 64 + m * 16 + fr) * 4 + wc] = ps; }
            asm volatile("s_waitcnt lgkmcnt(0)" ::: "memory"); __builtin_amdgcn_s_barrier(); asm volatile("" ::: "memory");
#pragma unroll
            for (int ai = 0; ai < 2; ++ai)
#pragma unroll
                for (int m = 0; m < 4; ++m) { const f32x4 lv = *(const LAS f32x4*)(xl + (ai * HALF + wr * 64 + m * 16 + fr) * 4); rs[ai][m] = __builtin_amdgcn_rcpf(sum4(lv)); }
        }
        if constexpr (MODE == 1 || MODE == 4) { rss_t rv[2][4];
#pragma unroll
            for (int ai = 0; ai < 2; ++ai)
#pragma unroll
                for (int m = 0; m < 4; ++m) rv[ai][m] = ((const rss_t*)aux2)[row0 + ai * HALF + m * 16];
#pragma unroll
            for (int ai = 0; ai < 2; ++ai)
#pragma unroll
                for (int m = 0; m < 4; ++m) rs[ai][m] = ss_rstd(rv[ai][m]);
        }
        if constexpr (MODE == 3) {
            f32x4 la[2][4];
#pragma unroll
            for (int ai = 0; ai < 2; ++ai)
#pragma unroll
                for (int m = 0; m < 4; ++m) la[ai][m] = *(const f32x4*)(aux2 + (size_t)(row0 + ai * HALF + m * 16) * 16 + (u.pn >> 1) * 4);
#pragma unroll
            for (int ai = 0; ai < 2; ++ai)
#pragma unroll
                for (int m = 0; m < 4; ++m) rs[ai][m] = __builtin_amdgcn_rcpf(sum4(la[ai][m]));
        }
        bf16_t* Ob = O; int colb = col0;
        if constexpr (MODE == 5) { Ob = O + (size_t)(u.pn >> 2) * 2048 * 1024; colb = (u.pn & 3) * 256 + wc * 32 + 8 * fq; }
#pragma unroll
        for (int ai = 0; ai < 2; ++ai)
#pragma unroll
            for (int m = 0; m < 4; ++m) { const int row = row0 + ai * HALF + m * 16; bf16_t* rowp = Ob + (size_t)row * ldc + colb;
                if constexpr (MODE == 0 || MODE == 5) {
#pragma unroll
                    for (int bj = 0; bj < 2; ++bj) *(u32x4*)(rowp + bj * HALF) = pack8(acc[ai][bj][m][0], acc[ai][bj][m][1]);
                } else if constexpr (MODE == 1) {
                    float ss = (sumsq4(acc[ai][0][m][0]) + sumsq4(acc[ai][0][m][1])) + (sumsq4(acc[ai][1][m][0]) + sumsq4(acc[ai][1][m][1]));
                    ss = red_fq(ss); const float rxx = rs[ai][m];
                    if (fq == 0) aux[(size_t)row * 32 + u.pn * 4 + wc] = ss * rxx * rxx;
#pragma unroll
                    for (int bj = 0; bj < 2; ++bj) *(u32x4*)(rowp + bj * HALF) = pack8(acc[ai][bj][m][0] * rxx, acc[ai][bj][m][1] * rxx);
                } else {
                    const float rxx = rs[ai][m];
#pragma unroll
                    for (int bj = 0; bj < 2; ++bj) *(u32x4*)(rowp + bj * HALF) = pack8(acc[ai][bj][m][0] * rxx, acc[ai][bj][m][1] * rxx);
                }
            }
    }
};
struct EpiRes {
    static constexpr bool PERM = true;
    bf16_t* XB; rss_t* rowss; float* OUT;
    __device__ __forceinline__ void load_half(u32x4 (&t)[4][2], int row0, int col0, int ai) const {
#pragma unroll
        for (int m = 0; m < 4; ++m) { const bf16_t* rowb = XB + (size_t)(row0 + ai * HALF + m * 16) * D_MODEL + col0;
#pragma unroll
            for (int bj = 0; bj < 2; ++bj) t[m][bj] = *(const u32x4*)(rowb + bj * HALF); }
    }
    __device__ __forceinline__ void add_half(f32x4 (&acc)[2][2][4][2], const u32x4 (&t)[4][2], int ai) const {
#pragma unroll
        for (int m = 0; m < 4; ++m)
#pragma unroll
            for (int bj = 0; bj < 2; ++bj) { const u32x4 w = t[m][bj];
#define ADDS_(d, x) asm("v_add_f32 %0, %1, %0" : "+v"(d) : "v"(x))
                ADDS_(acc[ai][bj][m][0][0], bflo(w.x)); ADDS_(acc[ai][bj][m][0][1], bfhi(w.x)); ADDS_(acc[ai][bj][m][0][2], bflo(w.y)); ADDS_(acc[ai][bj][m][0][3], bfhi(w.y));
                ADDS_(acc[ai][bj][m][1][0], bflo(w.z)); ADDS_(acc[ai][bj][m][1][1], bfhi(w.z)); ADDS_(acc[ai][bj][m][1][2], bflo(w.w)); ADDS_(acc[ai][bj][m][1][3], bfhi(w.w));
#undef ADDS_
            }
    }
    __device__ __forceinline__ void store_half(const f32x4 (&acc)[2][2][4][2], int row0, int col0, int ai, int fq) const {
#pragma unroll
        for (int m = 0; m < 4; ++m) { const int row = row0 + ai * HALF + m * 16; bf16_t* rowb = XB + (size_t)row * D_MODEL + col0; float ss = 0.f;
#pragma unroll
            for (int bj = 0; bj < 2; ++bj) { const f32x4 v0 = acc[ai][bj][m][0], v1 = acc[ai][bj][m][1];
                if (OUT) { float* rowp = OUT + (size_t)row * D_MODEL + col0 + bj * HALF; *(f32x4*)rowp = v0; *(f32x4*)(rowp + 4) = v1; }
                else { *(u32x4*)(rowb + bj * HALF) = pack8(v0, v1); ss += sumsq4(v0) + sumsq4(v1); } }
            if (rowss) { ss = red_fq(ss); if (fq == 0) atomicAdd(rowss + row, ss_fix(ss)); } }
    }
    __device__ __forceinline__ void operator()(f32x4 (&acc)[2][2][4][2], const Unit& u, int wr, int wc, int fr, int fq) const {
        const int row0 = u.pm * BM + wr * 64 + fr, col0 = u.pn * BM + wc * 32 + 8 * fq;
        u32x4 t[4][2];
        load_half(t, row0, col0, 0);
        add_half(acc, t, 0);
        asm volatile("" : "+v"(acc[0][0][0][0]), "+v"(acc[0][1][3][1]));
        load_half(t, row0, col0, 1);
        asm volatile("" ::: "memory");
        store_half(acc, row0, col0, 0, fq);
        add_half(acc, t, 1);
        store_half(acc, row0, col0, 1, fq);
    }
};
__device__ __forceinline__ int ffn_tile_row(int pm, int R, int chunk, bool& valid) {
    R = (R & ~63) | ((R & 15) << 2) | ((R >> 4) & 3);
    valid = true; (void)chunk; return pm * 256 + R;
}
struct ProbUp : ProbBase {
    static constexpr bool GATHER = true;
    const char* A; const char* B; int chunk;
    __device__ __forceinline__ const char* aptr(const Unit&) const { return A; }
    __device__ __forceinline__ const char* bptr(const Unit& u) const { return B + (size_t)u.pn * 256 * ldb * 2; }
    __device__ __forceinline__ unsigned rowoff(const Unit& u, int R) const { bool v; return (unsigned)ffn_tile_row(u.pm, R, chunk, v) * (unsigned)(lda * 2); }
};
__device__ __forceinline__ float dpp_ror1(float v) { return __builtin_bit_cast(float, __builtin_amdgcn_update_dpp(0, __builtin_bit_cast(int, v), 0x121, 0xf, 0xf, false)); }
__device__ __forceinline__ float dpp_ror15(float v) { return __builtin_bit_cast(float, __builtin_amdgcn_update_dpp(0, __builtin_bit_cast(int, v), 0x12F, 0xf, 0xf, false)); }
__device__ __forceinline__ h2_t u2h(unsigned u) { return __builtin_bit_cast(h2_t, u); }
__device__ __forceinline__ unsigned h2u(h2_t h) { return __builtin_bit_cast(unsigned, h); }
__device__ __forceinline__ unsigned dppu_ror1(unsigned v) { return (unsigned)__builtin_amdgcn_update_dpp(0, (int)v, 0x121, 0xf, 0xf, false); }
__device__ __forceinline__ unsigned dppu_ror15(unsigned v) { return (unsigned)__builtin_amdgcn_update_dpp(0, (int)v, 0x12F, 0xf, 0xf, false); }
#define H2X4_TRANS(OP, a, b, c, d) asm(OP " %0, %0 dst_sel:WORD_0 dst_unused:UNUSED_PRESERVE src0_sel:WORD_0\n\t" OP " %1, %1 dst_sel:WORD_0 dst_unused:UNUSED_PRESERVE src0_sel:WORD_0\n\t" \
    OP " %2, %2 dst_sel:WORD_0 dst_unused:UNUSED_PRESERVE src0_sel:WORD_0\n\t" OP " %3, %3 dst_sel:WORD_0 dst_unused:UNUSED_PRESERVE src0_sel:WORD_0\n\t"                                  \
    OP " %0, %0 dst_sel:WORD_1 dst_unused:UNUSED_PRESERVE src0_sel:WORD_1\n\t" OP " %1, %1 dst_sel:WORD_1 dst_unused:UNUSED_PRESERVE src0_sel:WORD_1\n\t"                                  \
    OP " %2, %2 dst_sel:WORD_1 dst_unused:UNUSED_PRESERVE src0_sel:WORD_1\n\t" OP " %3, %3 dst_sel:WORD_1 dst_unused:UNUSED_PRESERVE src0_sel:WORD_1\n\ts_nop 0" : "+v"(a), "+v"(b), "+v"(c), "+v"(d))
struct EpiGlu {
    static constexpr bool PERM = true;
    bf16_t* G; const rss_t* rowss; const u32x4* cwt; int chunk; LAS float* xl; bf16_t* EB; bf16_t* G2; int gsplit;
    __device__ __forceinline__ void operator()(f32x4 (&acc)[2][2][4][2], const Unit& u, int wr, int wc, int fr, int fq) const {
        const int ch0 = u.pn * 128 + wc * 32 + 8 * fq;
        const int tidw = (wr * 4 + wc) * 64 + fq * 16 + fr; LAS unsigned char* wl = (LAS unsigned char*)xl + 12288; LAS unsigned* xu = (LAS unsigned*)xl;
        u32x4 wrec = (u32x4){0u, 0u, 0u, 0u}; if (tidw < 128) wrec = cwt[u.pn * 128 + tidw];
        int rowi[2][4]; unsigned stmask = 0u; unsigned hh[2][2][4][4];
        { rss_t rv[2][4];
#pragma unroll
          for (int ai = 0; ai < 2; ++ai)
#pragma unroll
            for (int m = 0; m < 4; ++m) { const int RL = ai * HALF + wr * 64 + 4 * fr + m; bool valid; const int row = ffn_tile_row(u.pm, ai * HALF + wr * 64 + m * 16 + fr, chunk, valid); rowi[ai][m] = row; rv[ai][m] = rowss[row];
                const int gt = chunk * FFN_CHUNK + row, pos = tok_pos(gt), S = tok_seqlen(gt);
                const bool st = !((RL == 0 && pos != 0) || (RL == 255 && pos != S - 1)); (void)valid;
                stmask |= st ? (1u << (ai * 4 + m)) : 0u; }
#pragma unroll
          for (int ai = 0; ai < 2; ++ai)
#pragma unroll
            for (int m = 0; m < 4; ++m) { const float rx = ss_rstd(rv[ai][m]); const h2_t r2 = {(_Float16)rx, (_Float16)rx};
#pragma unroll
                for (int bj = 0; bj < 2; ++bj)
#pragma unroll
                    for (int n = 0; n < 2; ++n)
#pragma unroll
                        for (int jp = 0; jp < 2; ++jp) hh[ai][bj][m][2 * n + jp] = h2u(__builtin_bit_cast(h2_t, __builtin_amdgcn_cvt_pkrtz(acc[ai][bj][m][n][2 * jp], acc[ai][bj][m][n][2 * jp + 1])) * r2); } }
        if (wr == 0 && fr == 0) {
#pragma unroll
            for (int m = 0; m < 2; ++m)
#pragma unroll
                for (int bj = 0; bj < 2; ++bj) *(u32x4*)(EB + (size_t)(u.pm * 4 + m) * UP_W + bj * D_FF + ch0) = (u32x4){hh[0][bj][m][0], hh[0][bj][m][1], hh[0][bj][m][2], hh[0][bj][m][3]}; }
        if (wr == 1 && fr == 15) {
#pragma unroll
            for (int m = 2; m < 4; ++m)
#pragma unroll
                for (int bj = 0; bj < 2; ++bj) *(u32x4*)(EB + (size_t)(u.pm * 4 + m) * UP_W + bj * D_FF + ch0) = (u32x4){hh[1][bj][m][0], hh[1][bj][m][1], hh[1][bj][m][2], hh[1][bj][m][3]}; }
#pragma unroll
        for (int ai = 0; ai < 2; ++ai) { const int s1 = 2 * ai + wr + 1;
            if (fr == 0) {
#pragma unroll
                for (int bj = 0; bj < 2; ++bj) *(LAS u32x4*)(xu + ((s1 * 2 + 0) * 4 + wc) * 32 + bj * 16 + 4 * fq) = (u32x4){hh[ai][bj][0][0], hh[ai][bj][0][1], hh[ai][bj][0][2], hh[ai][bj][0][3]}; }
            if (fr == 15) {
#pragma unroll
                for (int bj = 0; bj < 2; ++bj) *(LAS u32x4*)(xu + ((s1 * 2 + 1) * 4 + wc) * 32 + bj * 16 + 4 * fq) = (u32x4){hh[ai][bj][3][0], hh[ai][bj][3][1], hh[ai][bj][3][2], hh[ai][bj][3][3]}; } }
        if (tidw < 128) *(LAS u32x4*)(wl + tidw * 16) = wrec;
        asm volatile("s_waitcnt lgkmcnt(0)" ::: "memory"); __builtin_amdgcn_s_barrier(); asm volatile("" ::: "memory");
        const h2_t c1 = {(_Float16)-0.10294324f, (_Float16)-0.10294324f}, c0 = {(_Float16)-2.3022082f, (_Float16)-2.3022082f}, one = {(_Float16)1.0f, (_Float16)1.0f};
        unsigned wq[2][2][4][2];
#pragma unroll
        for (int n = 0; n < 2; ++n) { unsigned (&wp)[2][4][2] = wq[n];
#pragma unroll
            for (int jp = 0; jp < 2; ++jp) { const int q = 2 * n + jp;
                const u32x4 wg = *(const LAS u32x4*)(wl + (wc * 16 + 4 * fq + q) * 32), wv = *(const LAS u32x4*)(wl + (wc * 16 + 4 * fq + q) * 32 + 16);
#pragma unroll
                for (int ai = 0; ai < 2; ++ai) { const int s1 = 2 * ai + wr + 1; h2_t cg[4], cv[4];
                    const LAS unsigned* xp = xu + (((s1 - 1) * 2 + 1) * 4 + wc) * 32 + 4 * fq + q; const LAS unsigned* xn = xu + (((s1 + 1) * 2 + 0) * 4 + wc) * 32 + 4 * fq + q;
                    { const unsigned pe = xp[0], ne = xn[0]; const unsigned r3 = dppu_ror1(hh[ai][0][3][q]), l0 = dppu_ror15(hh[ai][0][0][q]);
                      const h2_t w0 = u2h(wg.x), w1 = u2h(wg.y), w2 = u2h(wg.z), wb = u2h(wg.w);
#pragma unroll
                      for (int m = 0; m < 4; ++m) { const unsigned pv = m ? hh[ai][0][m ? m - 1 : 0][q] : (fr == 0 ? pe : r3), nx = m < 3 ? hh[ai][0][m < 3 ? m + 1 : 3][q] : (fr == 15 ? ne : l0);
                          cg[m] = wb + w0 * u2h(pv) + w1 * u2h(hh[ai][0][m][q]) + w2 * u2h(nx); } }
                    { const unsigned pe = xp[16], ne = xn[16]; const unsigned r3 = dppu_ror1(hh[ai][1][3][q]), l0 = dppu_ror15(hh[ai][1][0][q]);
                      const h2_t w0 = u2h(wv.x), w1 = u2h(wv.y), w2 = u2h(wv.z), wb = u2h(wv.w);
#pragma unroll
                      for (int m = 0; m < 4; ++m) { const unsigned pv = m ? hh[ai][1][m ? m - 1 : 0][q] : (fr == 0 ? pe : r3), nx = m < 3 ? hh[ai][1][m < 3 ? m + 1 : 3][q] : (fr == 15 ? ne : l0);
                          cv[m] = wb + w0 * u2h(pv) + w1 * u2h(hh[ai][1][m][q]) + w2 * u2h(nx); } }
                    unsigned e0 = h2u(cg[0] * (cg[0] * cg[0] * c1 + c0)), e1 = h2u(cg[1] * (cg[1] * cg[1] * c1 + c0)), e2 = h2u(cg[2] * (cg[2] * cg[2] * c1 + c0)), e3 = h2u(cg[3] * (cg[3] * cg[3] * c1 + c0));
                    H2X4_TRANS("v_exp_f16_sdwa", e0, e1, e2, e3);
                    e0 = h2u(u2h(e0) + one); e1 = h2u(u2h(e1) + one); e2 = h2u(u2h(e2) + one); e3 = h2u(u2h(e3) + one);
                    H2X4_TRANS("v_rcp_f16_sdwa", e0, e1, e2, e3);
                    wp[ai][0][jp] = h2u(cg[0] * u2h(e0) * cv[0]); wp[ai][1][jp] = h2u(cg[1] * u2h(e1) * cv[1]); wp[ai][2][jp] = h2u(cg[2] * u2h(e2) * cv[2]); wp[ai][3][jp] = h2u(cg[3] * u2h(e3) * cv[3]);
                    asm volatile("" : "+v"(wp[ai][0][jp]), "+v"(wp[ai][1][jp]), "+v"(wp[ai][2][jp]), "+v"(wp[ai][3][jp])); } }
            asm volatile("" ::: "memory"); }
#pragma unroll
        for (int ai = 0; ai < 2; ++ai)
#pragma unroll
            for (int m = 0; m < 4; ++m) { const u32x4 q = {wq[0][ai][m][0], wq[0][ai][m][1], wq[1][ai][m][0], wq[1][ai][m][1]}; if (stmask & (1u << (ai * 4 + m))) *(u32x4*)((u.pm < gsplit ? G : G2) + (size_t)rowi[ai][m] * D_FF + ch0) = q; }
    }
};
__device__ __forceinline__ void ffn_fix_item(const bf16_t* EB, const u32x4* cwt, bf16_t* G, bf16_t* G2, int gsplit_row, int t, int cb, int lane) {
    const int ti = (t >> 8) - 1, ch = cb * 512 + lane * 8;
    const bf16_t* ea = EB + (size_t)(ti * 4 + 2) * UP_W + ch; const bf16_t* ec = EB + (size_t)((ti + 1) * 4) * UP_W + ch;
    u32x4 ug[4], uv[4], w[8];
    ug[0] = *(const u32x4*)ea; uv[0] = *(const u32x4*)(ea + D_FF); ug[1] = *(const u32x4*)(ea + UP_W); uv[1] = *(const u32x4*)(ea + UP_W + D_FF);
    ug[2] = *(const u32x4*)ec; uv[2] = *(const u32x4*)(ec + D_FF); ug[3] = *(const u32x4*)(ec + UP_W); uv[3] = *(const u32x4*)(ec + UP_W + D_FF);
#pragma unroll
    for (int k = 0; k < 8; ++k) w[k] = cwt[(ch >> 1) * 2 + k];
    const h2_t c1 = {(_Float16)-0.10294324f, (_Float16)-0.10294324f}, c0 = {(_Float16)-2.3022082f, (_Float16)-2.3022082f}, one = {(_Float16)1.0f, (_Float16)1.0f};
    u32x4 oa, ob;
#pragma unroll
    for (int qp = 0; qp < 2; ++qp) { h2_t cg[4], cv[4];
#pragma unroll
        for (int qq = 0; qq < 2; ++qq) { const int q = 2 * qp + qq; const u32x4 wg = w[2 * q], wv = w[2 * q + 1];
            cg[2 * qq + 0] = u2h(wg.w) + u2h(wg.x) * u2h(ug[0][q]) + u2h(wg.y) * u2h(ug[1][q]) + u2h(wg.z) * u2h(ug[2][q]);
            cg[2 * qq + 1] = u2h(wg.w) + u2h(wg.x) * u2h(ug[1][q]) + u2h(wg.y) * u2h(ug[2][q]) + u2h(wg.z) * u2h(ug[3][q]);
            cv[2 * qq + 0] = u2h(wv.w) + u2h(wv.x) * u2h(uv[0][q]) + u2h(wv.y) * u2h(uv[1][q]) + u2h(wv.z) * u2h(uv[2][q]);
            cv[2 * qq + 1] = u2h(wv.w) + u2h(wv.x) * u2h(uv[1][q]) + u2h(wv.y) * u2h(uv[2][q]) + u2h(wv.z) * u2h(uv[3][q]); }
        unsigned e0 = h2u(cg[0] * (cg[0] * cg[0] * c1 + c0)), e1 = h2u(cg[1] * (cg[1] * cg[1] * c1 + c0)), e2 = h2u(cg[2] * (cg[2] * cg[2] * c1 + c0)), e3 = h2u(cg[3] * (cg[3] * cg[3] * c1 + c0));
        H2X4_TRANS("v_exp_f16_sdwa", e0, e1, e2, e3);
        e0 = h2u(u2h(e0) + one); e1 = h2u(u2h(e1) + one); e2 = h2u(u2h(e2) + one); e3 = h2u(u2h(e3) + one);
        H2X4_TRANS("v_rcp_f16_sdwa", e0, e1, e2, e3);
        oa[2 * qp] = h2u(cg[0] * u2h(e0) * cv[0]); ob[2 * qp] = h2u(cg[1] * u2h(e1) * cv[1]); oa[2 * qp + 1] = h2u(cg[2] * u2h(e2) * cv[2]); ob[2 * qp + 1] = h2u(cg[3] * u2h(e3) * cv[3]); }
    *(u32x4*)((t - 1 < gsplit_row ? G : G2) + (size_t)(t - 1) * D_FF + ch) = oa; *(u32x4*)((t < gsplit_row ? G : G2) + (size_t)t * D_FF + ch) = ob;
}
struct EpiKV {
    static constexpr bool PERM = false;
    float* kraw; bf16_t* vT;
    __device__ __forceinline__ void operator()(const f32x4 (&acc)[2][2][4][2], const Unit& u, int wr, int wc, int fr, int fq) const {
        const int key0 = wr * 64 + fr, col0 = u.pn * BM + wc * 32 + 4 * fq;
        if (u.pn < 8) {
#pragma unroll
            for (int ai = 0; ai < 2; ++ai)
#pragma unroll
                for (int m = 0; m < 4; ++m) { float* rowp = kraw + (size_t)(u.pm * BM + key0 + ai * HALF + m * 16) * 2048 + col0;
#pragma unroll
                    for (int bj = 0; bj < 2; ++bj)
#pragma unroll
                        for (int n = 0; n < 2; ++n) *(f32x4*)(rowp + bj * HALF + n * 16) = acc[ai][bj][m][n]; }
        } else {
#pragma unroll
            for (int ai = 0; ai < 2; ++ai)
#pragma unroll
                for (int m = 0; m < 4; ++m) { bf16_t* rowp = vT + (size_t)(u.pm * BM + key0 + ai * HALF + m * 16) * 2048 + (col0 - 2048);
#pragma unroll
                    for (int bj = 0; bj < 2; ++bj)
#pragma unroll
                        for (int n = 0; n < 2; ++n) { const f32x4 v = acc[ai][bj][m][n]; u32x2 w; w.x = cvt_pk_bf16(v[0], v[1]); w.y = cvt_pk_bf16(v[2], v[3]); *(u32x2*)(rowp + bj * HALF + n * 16) = w; } }
        }
    }
};
}

namespace att {
constexpr int KVBLK = 64, SHM_V = 16384, SHM_K = 16384, OFF_V = 0, OFF_K = 3 * SHM_V, OFF_WS = 3 * SHM_V + 3 * SHM_K, LDP = 1024;
#define KSWZ(row, colB) ((row) * 256 + ((colB) ^ (((row) & 15) << 4)))
#define SBAR() __builtin_amdgcn_sched_barrier(0)
__device__ __forceinline__ int crow(int r, int hi) { return (r & 3) + 8 * (r >> 2) + 4 * hi; }
__device__ __forceinline__ void partialSM(f32x16& p0) {
#pragma unroll
  for (int r = 0; r < 16; ++r) p0[r] = __builtin_amdgcn_exp2f(p0[r]);
}
__device__ __forceinline__ void finishSM(f32x16& p0, f32x16& p1, float& l_reg, bf16x8& pa0, bf16x8& pa1, bf16x8& pa2, bf16x8& pa3) {
#pragma unroll
  for (int r = 0; r < 16; ++r) p1[r] = __builtin_amdgcn_exp2f(p1[r]);
  float ps = 0;
#pragma unroll
  for (int r = 0; r < 16; ++r) ps += p0[r];
#pragma unroll
  for (int r = 0; r < 16; ++r) ps += p1[r];
  l_reg += ps;
#define PK4(P, BASE, OUT) do { unsigned a0 = cvt_pk_bf16(P[BASE + 0], P[BASE + 1]), a1 = cvt_pk_bf16(P[BASE + 2], P[BASE + 3]);   \
    unsigned b0 = cvt_pk_bf16(P[BASE + 4], P[BASE + 5]), b1 = cvt_pk_bf16(P[BASE + 6], P[BASE + 7]);                              \
    auto r0 = __builtin_amdgcn_permlane32_swap(a0, b0, false, false); auto r1 = __builtin_amdgcn_permlane32_swap(a1, b1, false, false); \
    u32x4 w = {r0[0], r1[0], r0[1], r1[1]}; OUT = __builtin_bit_cast(bf16x8, w); } while (0)
  PK4(p0, 0, pa0); PK4(p0, 8, pa1); PK4(p1, 0, pa2); PK4(p1, 8, pa3);
#undef PK4
}
__device__ __forceinline__ void finishSM_tail(f32x16& p0, f32x16& p1, float& l_reg, bf16x8& pa0, bf16x8& pa1, bf16x8& pa2, bf16x8& pa3) {
  float ps = 0;
#pragma unroll
  for (int r = 0; r < 16; ++r) ps += p0[r];
#pragma unroll
  for (int r = 0; r < 16; ++r) ps += p1[r];
  l_reg += ps;
#define PK4(P, BASE, OUT) do { unsigned a0 = cvt_pk_bf16(P[BASE + 0], P[BASE + 1]), a1 = cvt_pk_bf16(P[BASE + 2], P[BASE + 3]);   \
    unsigned b0 = cvt_pk_bf16(P[BASE + 4], P[BASE + 5]), b1 = cvt_pk_bf16(P[BASE + 6], P[BASE + 7]);                              \
    u32x4 w = {a0, a1, b0, b1}; OUT = __builtin_bit_cast(bf16x8, w); } while (0)
  PK4(p0, 0, pa0); PK4(p0, 8, pa1); PK4(p1, 0, pa2); PK4(p1, 8, pa3);
#undef PK4
}
__device__ __forceinline__ void qkt(f32x16& p0, f32x16& p1, const LAS unsigned char* Ks, const bf16x8* qr, int r32, int hi, int cbase) {
  p0 = f32x16{}; p1 = f32x16{}; bf16x8 b0[4], b1[4];
#pragma unroll
  for (int d0 = 0; d0 < 4; ++d0) { const int cb = cbase + (d0 * 16 + hi * 8) * 2;
    b0[d0] = *(const LAS bf16x8*)(Ks + KSWZ(r32, cb)); b1[d0] = *(const LAS bf16x8*)(Ks + KSWZ(32 + r32, cb)); }
#define QK_STEP(D, N) do { asm volatile("s_waitcnt lgkmcnt(" #N ")" ::: "memory"); SBAR(); \
    p0 = __builtin_amdgcn_mfma_f32_32x32x16_bf16(b0[D], qr[D], p0, 0, 0, 0); p1 = __builtin_amdgcn_mfma_f32_32x32x16_bf16(b1[D], qr[D], p1, 0, 0, 0); } while (0)
  QK_STEP(0, 6); QK_STEP(1, 4); QK_STEP(2, 2); QK_STEP(3, 0);
#undef QK_STEP
}
__device__ __forceinline__ int v_st(int k, int c) { const int kk = k; return ((kk >> 3) * 4 + (c >> 5)) * 512 + ((kk & 7) * 32 + (c & 31)) * 2; }
__device__ __forceinline__ int v_rd_base(int lane) { return ((lane & 3) << 3) | (((lane >> 2) & 3) << 6) | (((lane >> 4) & 1) << 5) | (((lane >> 5) & 1) << 8); }
constexpr int v_rd_off(int d0, int ks, int half) { return d0 * 512 + ks * 4096 + half * 2048; }
template <int OFF> __device__ __forceinline__ s16x4 tr_read(int vb) {
  s16x4 r; asm volatile("ds_read_b64_tr_b16 %0, %1 offset:%2" : "=&v"(r) : "v"(vb), "i"(OFF) : "memory"); return r;
}
struct VFrag { s16x4 l0, h0, l1, h1, l2, h2, l3, h3; };
template <int D0> __device__ __forceinline__ void pv_read(VFrag& f, int vb) {
  f.l0 = tr_read<v_rd_off(D0, 0, 0)>(vb); f.h0 = tr_read<v_rd_off(D0, 0, 1)>(vb); f.l1 = tr_read<v_rd_off(D0, 1, 0)>(vb); f.h1 = tr_read<v_rd_off(D0, 1, 1)>(vb);
  f.l2 = tr_read<v_rd_off(D0, 2, 0)>(vb); f.h2 = tr_read<v_rd_off(D0, 2, 1)>(vb); f.l3 = tr_read<v_rd_off(D0, 3, 0)>(vb); f.h3 = tr_read<v_rd_off(D0, 3, 1)>(vb);
}
__device__ __forceinline__ void pv_mma(f32x16& od, const VFrag& f, bf16x8 pa0, bf16x8 pa1, bf16x8 pa2, bf16x8 pa3) {
#define PKV(L, H) (bf16x8){L[0], L[1], L[2], L[3], H[0], H[1], H[2], H[3]}
  od = __builtin_amdgcn_mfma_f32_32x32x16_bf16(pa0, PKV(f.l0, f.h0), od, 0, 0, 0);
  od = __builtin_amdgcn_mfma_f32_32x32x16_bf16(pa1, PKV(f.l1, f.h1), od, 0, 0, 0);
  od = __builtin_amdgcn_mfma_f32_32x32x16_bf16(pa2, PKV(f.l2, f.h2), od, 0, 0, 0);
  od = __builtin_amdgcn_mfma_f32_32x32x16_bf16(pa3, PKV(f.l3, f.h3), od, 0, 0, 0);
#undef PKV
}
__device__ __forceinline__ void pv_d0(f32x16* o, int vb, bf16x8 pa0, bf16x8 pa1, bf16x8 pa2, bf16x8 pa3) {
  VFrag fa, fb;
  pv_read<0>(fa, vb); pv_read<1>(fb, vb);
  asm volatile("s_waitcnt lgkmcnt(8)" ::: "memory"); SBAR(); pv_mma(o[0], fa, pa0, pa1, pa2, pa3); SBAR();
  pv_read<2>(fa, vb);
  asm volatile("s_waitcnt lgkmcnt(8)" ::: "memory"); SBAR(); pv_mma(o[1], fb, pa0, pa1, pa2, pa3); SBAR();
  pv_read<3>(fb, vb);
  asm volatile("s_waitcnt lgkmcnt(8)" ::: "memory"); SBAR(); pv_mma(o[2], fa, pa0, pa1, pa2, pa3); SBAR();
  asm volatile("s_waitcnt lgkmcnt(0)" ::: "memory"); SBAR(); pv_mma(o[3], fb, pa0, pa1, pa2, pa3);
}
__device__ __forceinline__ void att_step(f32x16& s0, f32x16& s1, const LAS unsigned char* Ks, const bf16x8* qr, int r32, int hi, int cbase,
                                         f32x16& e0, f32x16& e1, float& l_reg, bf16x8& pa0, bf16x8& pa1, bf16x8& pa2, bf16x8& pa3, f32x16* o, int vb) {
  bf16x8 b0[4], b1[4]; VFrag fa, fb; float ps = 0.f; u32x4 w0, w1, w2, w3;
#pragma unroll
  for (int d0 = 0; d0 < 4; ++d0) { const int cb = cbase + (d0 * 16 + hi * 8) * 2;
    b0[d0] = *(const LAS bf16x8*)(Ks + KSWZ(r32, cb)); b1[d0] = *(const LAS bf16x8*)(Ks + KSWZ(32 + r32, cb)); }
  s0 = f32x16{}; s1 = f32x16{};
#define PACK_H(E, BASE, H, W) do { ps += E[BASE + 2 * H]; ps += E[BASE + 2 * H + 1]; ps += E[BASE + 4 + 2 * H]; ps += E[BASE + 5 + 2 * H];                       \
    const unsigned a_ = cvt_pk_bf16(E[BASE + 2 * H], E[BASE + 2 * H + 1]), b_ = cvt_pk_bf16(E[BASE + 4 + 2 * H], E[BASE + 5 + 2 * H]);                       \
    W[H] = a_; W[2 + H] = b_; } while (0)
#define QK_STEP(D, N, PRE, PK_A, PK_B) do { asm volatile("s_waitcnt lgkmcnt(" #N ")" ::: "memory"); PRE; SBAR();                                                  \
    s0 = __builtin_amdgcn_mfma_f32_32x32x16_bf16(b0[D], qr[D], s0, 0, 0, 0); SBAR(); PK_A; SBAR();                                                                 \
    s1 = __builtin_amdgcn_mfma_f32_32x32x16_bf16(b1[D], qr[D], s1, 0, 0, 0); SBAR(); PK_B; SBAR(); } while (0)
  QK_STEP(0, 6, (void)0, PACK_H(e0, 0, 0, w0), PACK_H(e0, 0, 1, w0));
  QK_STEP(1, 4, (void)0, PACK_H(e0, 8, 0, w1), PACK_H(e0, 8, 1, w1));
  QK_STEP(2, 2, (void)0, PACK_H(e1, 0, 0, w2), PACK_H(e1, 0, 1, w2));
  QK_STEP(3, 0, (pv_read<0>(fa, vb), pv_read<1>(fb, vb)), PACK_H(e1, 8, 0, w3), PACK_H(e1, 8, 1, w3));
#undef QK_STEP
#undef PACK_H
  l_reg += ps;
  pa0 = __builtin_bit_cast(bf16x8, w0); pa1 = __builtin_bit_cast(bf16x8, w1); pa2 = __builtin_bit_cast(bf16x8, w2); pa3 = __builtin_bit_cast(bf16x8, w3);
#define PKV(L, H) (bf16x8){L[0], L[1], L[2], L[3], H[0], H[1], H[2], H[3]}
#define EX2(X, I) do { X[I] = __builtin_amdgcn_exp2f(X[I]); X[I + 1] = __builtin_amdgcn_exp2f(X[I + 1]); } while (0)
#define PV_BLK(D0, F, N, X, XB) do { asm volatile("s_waitcnt lgkmcnt(" #N ")" ::: "memory"); SBAR();                                                              \
    o[D0] = __builtin_amdgcn_mfma_f32_32x32x16_bf16(pa0, PKV(F.l0, F.h0), o[D0], 0, 0, 0); SBAR(); EX2(X, XB + 0); SBAR();                                         \
    o[D0] = __builtin_amdgcn_mfma_f32_32x32x16_bf16(pa1, PKV(F.l1, F.h1), o[D0], 0, 0, 0); SBAR(); EX2(X, XB + 2); SBAR();                                         \
    o[D0] = __builtin_amdgcn_mfma_f32_32x32x16_bf16(pa2, PKV(F.l2, F.h2), o[D0], 0, 0, 0); SBAR(); EX2(X, XB + 4); SBAR();                                         \
    o[D0] = __builtin_amdgcn_mfma_f32_32x32x16_bf16(pa3, PKV(F.l3, F.h3), o[D0], 0, 0, 0); SBAR(); EX2(X, XB + 6); SBAR(); } while (0)
  PV_BLK(0, fa, 8, s0, 0); pv_read<2>(fa, vb);
  PV_BLK(1, fb, 8, s0, 8); pv_read<3>(fb, vb);
  PV_BLK(2, fa, 8, s1, 0);
  PV_BLK(3, fb, 0, s1, 8);
#undef PV_BLK
#undef EX2
#undef PKV
}
__device__ __forceinline__ void attn_unit(const bf16_t* Qg, const bf16_t* __restrict__ Kg, const bf16_t* __restrict__ Vg, bf16_t* Og, int seq, float lam, const float* gsub, float oscale, LAS unsigned char* lds) {
  int tid_l = threadIdx.x; asm volatile("" : "+v"(tid_l));
  const int tid = tid_l, wid = __builtin_amdgcn_readfirstlane(tid >> 6), lane = tid & 63, r32 = lane & 31, hi = lane >> 5;
  const int comp = wid & 1, rg = wid >> 1, cbase = comp * 128;
  LAS unsigned char* V_lds = lds + OFF_V; LAS unsigned char* K_lds = lds + OFF_K;
  LAS float* wsf = (LAS float*)(lds + OFF_WS) + wid * 64; LAS float* li_l = wsf;
  float l_reg = 0; f32x16 o[4] = {}; bf16x8 qr[4];
  const bf16_t* Qw = Qg + (size_t)(rg * 32 + r32) * LDP + comp * 64 + hi * 8;
#pragma unroll
  for (int d0 = 0; d0 < 4; ++d0) qr[d0] = *(const bf16x8*)(Qw + d0 * 16);
  unsigned koff[2], voff[2];
#pragma unroll
  for (int i = 0; i < 2; ++i) { const int L = (tid + 512 * i) * 16; { const int row = L >> 8, colB = (L & 255) ^ ((row & 15) << 4); koff[i] = (unsigned)(row * LDP * 2 + colB); }
    { const int sub = L >> 9, w = L & 511, kk = (sub >> 2) * 8 + (w >> 6), c = (sub & 3) * 32 + ((w & 63) >> 1), k = kk; voff[i] = (unsigned)(k * LDP * 2 + c * 2); } }
  const int vbb = (int)(unsigned)(size_t)V_lds + v_rd_base(lane);
  const int NT = seq / KVBLK; const size_t tstep = (size_t)KVBLK * LDP * 2;
#define DMA_K(t) do { const int t_ = (t) < NT ? (t) : NT - 1; const char* g_ = (const char*)Kg + (size_t)t_ * tstep; LAS unsigned char* d_ = K_lds + (t_ % 3) * SHM_K + wid * 1024; \
    __builtin_amdgcn_global_load_lds((const unsigned*)(g_ + koff[0]), (LAS unsigned*)d_, 16, 0, 0); __builtin_amdgcn_global_load_lds((const unsigned*)(g_ + koff[1]), (LAS unsigned*)(d_ + 8192), 16, 0, 0); } while (0)
#define DMA_V(t) do { const int t_ = (t) < NT ? (t) : NT - 1; const char* g_ = (const char*)Vg + (size_t)t_ * tstep; LAS unsigned char* d_ = V_lds + (t_ % 3) * SHM_V + wid * 1024; \
    __builtin_amdgcn_global_load_lds((const unsigned*)(g_ + voff[0]), (LAS unsigned*)d_, 16, 0, 0); __builtin_amdgcn_global_load_lds((const unsigned*)(g_ + voff[1]), (LAS unsigned*)(d_ + 8192), 16, 0, 0); } while (0)
#define WAIT4_BAR() do { asm volatile("s_waitcnt vmcnt(4)" ::: "memory"); __builtin_amdgcn_s_barrier(); asm volatile("" ::: "memory"); } while (0)
  f32x16 pA0, pA1, pB0, pB1; bf16x8 pa0, pa1, pa2, pa3;
  DMA_K(0); DMA_K(1); DMA_V(0);
  WAIT4_BAR();
  DMA_K(2); DMA_V(1);
  qkt(pA0, pA1, K_lds, qr, r32, hi, cbase); partialSM(pA0); partialSM(pA1);
  int sk = 1, sv = 0;
  for (int j = 1; j + 1 < NT; j += 2) {
    WAIT4_BAR(); DMA_K(j + 2); DMA_V(j + 1);
    SBAR(); att_step(pB0, pB1, K_lds + sk * SHM_K, qr, r32, hi, cbase, pA0, pA1, l_reg, pa0, pa1, pa2, pa3, o, vbb + sv * SHM_V); SBAR();
    sk = sk == 2 ? 0 : sk + 1; sv = sv == 2 ? 0 : sv + 1;
    WAIT4_BAR(); DMA_K(j + 3); DMA_V(j + 2);
    SBAR(); att_step(pA0, pA1, K_lds + sk * SHM_K, qr, r32, hi, cbase, pB0, pB1, l_reg, pa0, pa1, pa2, pa3, o, vbb + sv * SHM_V); SBAR();
    sk = sk == 2 ? 0 : sk + 1; sv = sv == 2 ? 0 : sv + 1;
  }
  WAIT4_BAR(); DMA_K(NT + 1); DMA_V(NT);
  SBAR(); att_step(pB0, pB1, K_lds + sk * SHM_K, qr, r32, hi, cbase, pA0, pA1, l_reg, pa0, pa1, pa2, pa3, o, vbb + sv * SHM_V); SBAR();
  sv = sv == 2 ? 0 : sv + 1;
  WAIT4_BAR();
  finishSM_tail(pB0, pB1, l_reg, pa0, pa1, pa2, pa3); SBAR();
  pv_d0(o, vbb + sv * SHM_V, pa0, pa1, pa2, pa3);
  asm volatile("s_waitcnt vmcnt(0)" ::: "memory");
#undef DMA_K
#undef DMA_V
#undef WAIT4_BAR
  { auto rr = __builtin_amdgcn_permlane32_swap(__float_as_uint(l_reg), __float_as_uint(l_reg), false, false); l_reg = __uint_as_float(rr[0]) + __uint_as_float(rr[1]); }
  if (hi == 0) li_l[r32] = l_reg; asm volatile("s_waitcnt lgkmcnt(0)" ::: "memory");
  float rli[16];
#pragma unroll
  for (int r = 0; r < 16; ++r) rli[r] = __builtin_amdgcn_rcpf(li_l[crow(r, hi)]);
  __syncthreads();
  LAS float* X = (LAS float*)(lds) + rg * 4096 + lane;
  if (comp == 1) {
#pragma unroll
    for (int d0 = 0; d0 < 4; ++d0)
#pragma unroll
      for (int r = 0; r < 16; ++r) X[(d0 * 16 + r) * 64] = o[d0][r] * rli[r] * lam;
  }
  __syncthreads();
  if (comp == 0) {
    float ss[16];
#pragma unroll
    for (int r = 0; r < 16; ++r) ss[r] = 0.f;
#pragma unroll
    for (int d0 = 0; d0 < 4; ++d0)
#pragma unroll
      for (int r = 0; r < 16; ++r) { const float v = o[d0][r] * rli[r] - X[(d0 * 16 + r) * 64]; o[d0][r] = v; ss[r] += v * v; }
#pragma unroll
    for (int r = 0; r < 16; ++r) { float s = ss[r]; s += __shfl_xor(s, 1); s += __shfl_xor(s, 2); s += __shfl_xor(s, 4); s += __shfl_xor(s, 8); s += __shfl_xor(s, 16);
      ss[r] = __builtin_amdgcn_rsqf(s * (1.0f / 128.0f) + EPS) * oscale; }
    bf16_t* Ow = Og + (size_t)(rg * 32) * LDP;
#pragma unroll
    for (int d0 = 0; d0 < 4; ++d0) { const float g = gsub[d0 * 32 + r32];
#pragma unroll
#ifdef PROBE_ZERO_ATTN
      for (int r = 0; r < 16; ++r) Ow[(size_t)crow(r, hi) * LDP + d0 * 32 + r32] = (bf16_t)0;
#else
      for (int r = 0; r < 16; ++r) Ow[(size_t)crow(r, hi) * LDP + d0 * 32 + r32] = (bf16_t)(cvt_pk_bf16(o[d0][r] * ss[r] * g, 0.f) & 0xffffu);
#endif
    }
  }
  __syncthreads();
}
}


namespace att16 {
using att::KVBLK; using att::SHM_V; using att::SHM_K; using att::OFF_V; using att::OFF_K; using att::OFF_WS; using att::LDP;
typedef f32x4 S8[4][2];
__device__ __forceinline__ f32x4 mma16(bf16x8 a, bf16x8 b, f32x4 c) { return __builtin_amdgcn_mfma_f32_16x16x32_bf16(a, b, c, 0, 0, 0); }
template <int OFF> __device__ __forceinline__ s16x4 tr_read(int vb) { s16x4 r; asm volatile("ds_read_b64_tr_b16 %0, %1 offset:%2" : "=&v"(r) : "v"(vb), "i"(OFF) : "memory"); return r; }
struct VF { s16x4 l0, h0, l1, h1; };
constexpr int v_off(int db, int ks, int half) { return ks * 8192 + half * 4096 + (db >> 1) * 512; }
template <int DP> __device__ __forceinline__ void pv_read(VF& fe, VF& fo, int vbe, int vbo) {
  fe.l0 = tr_read<v_off(2 * DP, 0, 0)>(vbe); fe.h0 = tr_read<v_off(2 * DP, 0, 1)>(vbe); fe.l1 = tr_read<v_off(2 * DP, 1, 0)>(vbe); fe.h1 = tr_read<v_off(2 * DP, 1, 1)>(vbe);
  fo.l0 = tr_read<v_off(2 * DP + 1, 0, 0)>(vbo); fo.h0 = tr_read<v_off(2 * DP + 1, 0, 1)>(vbo); fo.l1 = tr_read<v_off(2 * DP + 1, 1, 0)>(vbo); fo.h1 = tr_read<v_off(2 * DP + 1, 1, 1)>(vbo);
}
#define PKV16(L, H) (bf16x8){L[0], L[1], L[2], L[3], H[0], H[1], H[2], H[3]}
__device__ __forceinline__ void kf_read(bf16x8 (&kf)[4][2], const LAS unsigned char* Ks, int c16, int g, int cbase) {
#pragma unroll
  for (int kb = 0; kb < 4; ++kb)
#pragma unroll
    for (int ks = 0; ks < 2; ++ks) kf[kb][ks] = *(const LAS bf16x8*)(Ks + KSWZ(16 * kb + c16, cbase + (32 * ks + 8 * g) * 2));
}
__device__ __forceinline__ void qk_first(S8& S, const LAS unsigned char* Ks, const bf16x8 (&qf)[2][2], int c16, int g, int cbase) {
  bf16x8 kf[4][2]; kf_read(kf, Ks, c16, g, cbase);
#pragma unroll
  for (int kb = 0; kb < 4; ++kb)
#pragma unroll
    for (int qb = 0; qb < 2; ++qb) { f32x4 a = {0.f, 0.f, 0.f, 0.f}; a = mma16(kf[kb][0], qf[qb][0], a); a = mma16(kf[kb][1], qf[qb][1], a);
#pragma unroll
      for (int r = 0; r < 4; ++r) a[r] = __builtin_amdgcn_exp2f(a[r]);
      S[kb][qb] = a; }
}
#define ADDF16(acc, x) asm("v_add_f32 %0, %1, %0" : "+v"(acc) : "v"(x))
#define PACK16(E, KS, QB, W) do { const f32x4& e_ = E[2 * (KS) + ((W) >> 1)][QB]; pw[KS][QB][W] = cvt_pk_bf16(e_[2 * ((W) & 1)], e_[2 * ((W) & 1) + 1]); } while (0)
#define LSUM16() do { const bf16x8 on_ = {0x3F80, 0x3F80, 0x3F80, 0x3F80, 0x3F80, 0x3F80, 0x3F80, 0x3F80};                                                        \
    l2[0] = mma16(on_, __builtin_bit_cast(bf16x8, pw[0][0]), l2[0]); l2[1] = mma16(on_, __builtin_bit_cast(bf16x8, pw[0][1]), l2[1]);                               \
    l2[0] = mma16(on_, __builtin_bit_cast(bf16x8, pw[1][0]), l2[0]); l2[1] = mma16(on_, __builtin_bit_cast(bf16x8, pw[1][1]), l2[1]); } while (0)
__device__ __forceinline__ void pack_all(const S8& E, u32x4 (&pw)[2][2]) {
#pragma unroll
  for (int ks = 0; ks < 2; ++ks)
#pragma unroll
    for (int qb = 0; qb < 2; ++qb) { PACK16(E, ks, qb, 0); PACK16(E, ks, qb, 1); PACK16(E, ks, qb, 2); PACK16(E, ks, qb, 3); }
}
#define PV16(DB, F) do { _Pragma("unroll") for (int qb_ = 0; qb_ < 2; ++qb_) { o[DB][qb_] = mma16(PKV16(F.l0, F.h0), __builtin_bit_cast(bf16x8, pw[0][qb_]), o[DB][qb_]); \
    o[DB][qb_] = mma16(PKV16(F.l1, F.h1), __builtin_bit_cast(bf16x8, pw[1][qb_]), o[DB][qb_]); } } while (0)
__device__ __forceinline__ void pv_last(f32x4 (&o)[8][2], const u32x4 (&pw)[2][2], int vbe, int vbo) {
  VF ae, ao, be, bo;
  pv_read<0>(ae, ao, vbe, vbo); pv_read<1>(be, bo, vbe, vbo);
  asm volatile("s_waitcnt lgkmcnt(8)" ::: "memory"); SBAR(); PV16(0, ae); PV16(1, ao); SBAR();
  pv_read<2>(ae, ao, vbe, vbo);
  asm volatile("s_waitcnt lgkmcnt(8)" ::: "memory"); SBAR(); PV16(2, be); PV16(3, bo); SBAR();
  pv_read<3>(be, bo, vbe, vbo);
  asm volatile("s_waitcnt lgkmcnt(8)" ::: "memory"); SBAR(); PV16(4, ae); PV16(5, ao); SBAR();
  asm volatile("s_waitcnt lgkmcnt(0)" ::: "memory"); SBAR(); PV16(6, be); PV16(7, bo);
}
__device__ __forceinline__ void att_step(S8& S, const LAS unsigned char* Ks, const bf16x8 (&qf)[2][2], int c16, int g, int cbase, const S8& E, f32x4 (&l2)[2], f32x4 (&o)[8][2], int vbe, int vbo) {
  bf16x8 kf[4][2]; u32x4 pw[2][2]; VF ae, ao, be, bo;
  kf_read(kf, Ks, c16, g, cbase);
#define QK16(KB, N, PRE, P0, P1, P2, P3) do { asm volatile("s_waitcnt lgkmcnt(" #N ")" ::: "memory"); PRE; SBAR(); f32x4 a0_ = {0.f, 0.f, 0.f, 0.f}, a1_ = {0.f, 0.f, 0.f, 0.f};  \
    a0_ = mma16(kf[KB][0], qf[0][0], a0_); SBAR(); P0; SBAR(); a1_ = mma16(kf[KB][0], qf[1][0], a1_); SBAR(); P1; SBAR();                                     \
    a0_ = mma16(kf[KB][1], qf[0][1], a0_); SBAR(); P2; SBAR(); a1_ = mma16(kf[KB][1], qf[1][1], a1_); SBAR(); P3; SBAR(); S[KB][0] = a0_; S[KB][1] = a1_; } while (0)
  QK16(0, 6, (void)0, PACK16(E, 0, 0, 0), PACK16(E, 0, 0, 1), PACK16(E, 0, 0, 2), PACK16(E, 0, 0, 3));
  QK16(1, 4, (void)0, PACK16(E, 0, 1, 0), PACK16(E, 0, 1, 1), PACK16(E, 0, 1, 2), PACK16(E, 0, 1, 3));
  QK16(2, 2, (void)0, PACK16(E, 1, 0, 0), PACK16(E, 1, 0, 1), PACK16(E, 1, 0, 2), PACK16(E, 1, 0, 3));
  QK16(3, 0, (pv_read<0>(ae, ao, vbe, vbo), pv_read<1>(be, bo, vbe, vbo)), PACK16(E, 1, 1, 0), PACK16(E, 1, 1, 1), PACK16(E, 1, 1, 2), PACK16(E, 1, 1, 3));
#undef QK16
#define EX1(KB, QB, R) S[KB][QB][R] = __builtin_amdgcn_exp2f(S[KB][QB][R])
#define PVX(DB, F, KB) do { o[DB][0] = mma16(PKV16(F.l0, F.h0), __builtin_bit_cast(bf16x8, pw[0][0]), o[DB][0]); SBAR(); EX1(KB, 0, 0); SBAR();                    \
    o[DB][1] = mma16(PKV16(F.l0, F.h0), __builtin_bit_cast(bf16x8, pw[0][1]), o[DB][1]); SBAR(); EX1(KB, 0, 1); SBAR();                                          \
    o[DB][0] = mma16(PKV16(F.l1, F.h1), __builtin_bit_cast(bf16x8, pw[1][0]), o[DB][0]); SBAR(); EX1(KB, 0, 2); SBAR();                                          \
    o[DB][1] = mma16(PKV16(F.l1, F.h1), __builtin_bit_cast(bf16x8, pw[1][1]), o[DB][1]); SBAR(); EX1(KB, 0, 3); SBAR(); } while (0)
#define PVY(DB, F, KB) do { o[DB][0] = mma16(PKV16(F.l0, F.h0), __builtin_bit_cast(bf16x8, pw[0][0]), o[DB][0]); SBAR(); EX1(KB, 1, 0); SBAR();                    \
    o[DB][1] = mma16(PKV16(F.l0, F.h0), __builtin_bit_cast(bf16x8, pw[0][1]), o[DB][1]); SBAR(); EX1(KB, 1, 1); SBAR();                                          \
    o[DB][0] = mma16(PKV16(F.l1, F.h1), __builtin_bit_cast(bf16x8, pw[1][0]), o[DB][0]); SBAR(); EX1(KB, 1, 2); SBAR();                                          \
    o[DB][1] = mma16(PKV16(F.l1, F.h1), __builtin_bit_cast(bf16x8, pw[1][1]), o[DB][1]); SBAR(); EX1(KB, 1, 3); SBAR(); } while (0)
  SBAR(); LSUM16(); SBAR();
  asm volatile("s_waitcnt lgkmcnt(8)" ::: "memory"); SBAR(); PVX(0, ae, 0); PVY(1, ao, 0); pv_read<2>(ae, ao, vbe, vbo);
  asm volatile("s_waitcnt lgkmcnt(8)" ::: "memory"); SBAR(); PVX(2, be, 1); PVY(3, bo, 1); pv_read<3>(be, bo, vbe, vbo);
  asm volatile("s_waitcnt lgkmcnt(8)" ::: "memory"); SBAR(); PVX(4, ae, 2); PVY(5, ao, 2);
  asm volatile("s_waitcnt lgkmcnt(0)" ::: "memory"); SBAR(); PVX(6, be, 3); PVY(7, bo, 3);
#undef PVX
#undef PVY
#undef EX1
}
__device__ __forceinline__ void attn_unit(const bf16_t* Qg, const bf16_t* __restrict__ Kg, const bf16_t* __restrict__ Vg, bf16_t* Og, int seq, float lam, const float* gsub, float oscale, LAS unsigned char* lds, bool rev) {
  int tid_l = threadIdx.x; asm volatile("" : "+v"(tid_l));
  const int tid = tid_l, wid = __builtin_amdgcn_readfirstlane(tid >> 6), lane = tid & 63, c16 = lane & 15, g = lane >> 4;
  const int comp = wid & 1, rg = wid >> 1, cbase = comp * 128;
  LAS unsigned char* V_lds = lds + OFF_V; LAS unsigned char* K_lds = lds + OFF_K;
  LAS float* wsf = (LAS float*)(lds + OFF_WS) + wid * 64; (void)wsf;
  f32x4 l2[2] = {{0.f, 0.f, 0.f, 0.f}, {0.f, 0.f, 0.f, 0.f}}; f32x4 o[8][2]; bf16x8 qf[2][2];
#pragma unroll
  for (int db = 0; db < 8; ++db)
#pragma unroll
    for (int qb = 0; qb < 2; ++qb) o[db][qb] = (f32x4){0.f, 0.f, 0.f, 0.f};
#pragma unroll
  for (int qb = 0; qb < 2; ++qb)
#pragma unroll
    for (int ks = 0; ks < 2; ++ks) qf[qb][ks] = *(const bf16x8*)(Qg + (size_t)(rg * 32 + 16 * qb + c16) * LDP + comp * 64 + 32 * ks + 8 * g);
  unsigned koff[2], voff[2];
#pragma unroll
  for (int i = 0; i < 2; ++i) { const int L = (tid + 512 * i) * 16; { const int row = L >> 8, colB = (L & 255) ^ ((row & 15) << 4); koff[i] = (unsigned)(row * LDP * 2 + colB); }
    { const int sub = L >> 9, w = L & 511, k = (sub >> 2) * 8 + (w >> 6), cl = ((w & 63) >> 1) ^ (((k >> 2) & 1) << 4), c = (sub & 3) * 32 + cl; voff[i] = (unsigned)(k * LDP * 2 + c * 2); } }
  const int vb0 = (int)(unsigned)(size_t)V_lds + (g >> 1) * 2048 + (g & 1) * 256 + ((c16 >> 2) & 3) * 64 + (c16 & 3) * 8;
  const int vbe0 = vb0 + (g & 1) * 32, vbo0 = vb0 + ((g & 1) ^ 1) * 32;
  const int NT = seq / KVBLK; const size_t tstep = (size_t)KVBLK * LDP * 2;
#define DMA_K(t) do { const int t_ = (t) < NT ? (t) : NT - 1; const char* g_ = (const char*)Kg + (size_t)(rev ? NT - 1 - t_ : t_) * tstep; LAS unsigned char* d_ = K_lds + (t_ % 3) * SHM_K + wid * 1024; \
    __builtin_amdgcn_global_load_lds((const unsigned*)(g_ + koff[0]), (LAS unsigned*)d_, 16, 0, 0); __builtin_amdgcn_global_load_lds((const unsigned*)(g_ + koff[1]), (LAS unsigned*)(d_ + 8192), 16, 0, 0); } while (0)
#define DMA_V(t) do { const int t_ = (t) < NT ? (t) : NT - 1; const char* g_ = (const char*)Vg + (size_t)(rev ? NT - 1 - t_ : t_) * tstep; LAS unsigned char* d_ = V_lds + (t_ % 3) * SHM_V + wid * 1024; \
    __builtin_amdgcn_global_load_lds((const unsigned*)(g_ + voff[0]), (LAS unsigned*)d_, 16, 0, 0); __builtin_amdgcn_global_load_lds((const unsigned*)(g_ + voff[1]), (LAS unsigned*)(d_ + 8192), 16, 0, 0); } while (0)
#define WAIT4_BAR() do { asm volatile("s_waitcnt vmcnt(4)" ::: "memory"); __builtin_amdgcn_s_barrier(); asm volatile("" ::: "memory"); } while (0)
  S8 pA, pB;
  DMA_K(0); DMA_K(1); DMA_V(0);
  WAIT4_BAR();
  DMA_K(2); DMA_V(1);
  qk_first(pA, K_lds, qf, c16, g, cbase);
  int sk = 1, sv = 0;
  for (int j = 1; j + 1 < NT; j += 2) {
    WAIT4_BAR(); DMA_K(j + 2); DMA_V(j + 1);
    SBAR(); att_step(pB, K_lds + sk * SHM_K, qf, c16, g, cbase, pA, l2, o, vbe0 + sv * SHM_V, vbo0 + sv * SHM_V); SBAR();
    sk = sk == 2 ? 0 : sk + 1; sv = sv == 2 ? 0 : sv + 1;
    WAIT4_BAR(); DMA_K(j + 3); DMA_V(j + 2);
    SBAR(); att_step(pA, K_lds + sk * SHM_K, qf, c16, g, cbase, pB, l2, o, vbe0 + sv * SHM_V, vbo0 + sv * SHM_V); SBAR();
    sk = sk == 2 ? 0 : sk + 1; sv = sv == 2 ? 0 : sv + 1;
  }
  WAIT4_BAR(); DMA_K(NT + 1); DMA_V(NT);
  SBAR(); att_step(pB, K_lds + sk * SHM_K, qf, c16, g, cbase, pA, l2, o, vbe0 + sv * SHM_V, vbo0 + sv * SHM_V); SBAR();
  sv = sv == 2 ? 0 : sv + 1;
  WAIT4_BAR();
  { u32x4 pw[2][2]; pack_all(pB, pw); SBAR(); LSUM16(); SBAR(); pv_last(o, pw, vbe0 + sv * SHM_V, vbo0 + sv * SHM_V); }
  asm volatile("s_waitcnt vmcnt(0)" ::: "memory");
#undef DMA_K
#undef DMA_V
#undef WAIT4_BAR
  float rl[2];
#pragma unroll
  for (int qb = 0; qb < 2; ++qb) rl[qb] = __builtin_amdgcn_rcpf(l2[qb][0]);
  __syncthreads();
  LAS float* X = (LAS float*)(lds) + rg * 4096 + lane;
  if (comp == 1) {
#pragma unroll
    for (int db = 0; db < 8; ++db)
#pragma unroll
      for (int qb = 0; qb < 2; ++qb)
#pragma unroll
        for (int r = 0; r < 4; ++r) X[((db * 2 + qb) * 4 + r) * 64] = o[db][qb][r] * rl[qb] * lam;
  }
  __syncthreads();
  if (comp == 0) {
    float ss[2] = {0.f, 0.f};
#pragma unroll
    for (int db = 0; db < 8; ++db)
#pragma unroll
      for (int qb = 0; qb < 2; ++qb)
#pragma unroll
        for (int r = 0; r < 4; ++r) { const float v = o[db][qb][r] * rl[qb] - X[((db * 2 + qb) * 4 + r) * 64]; o[db][qb][r] = v; ss[qb] += v * v; }
#pragma unroll
    for (int qb = 0; qb < 2; ++qb) { float t = ss[qb]; t += __shfl_xor(t, 16); t += __shfl_xor(t, 32); ss[qb] = __builtin_amdgcn_rsqf(t * (1.0f / 128.0f) + EPS) * oscale; }
#pragma unroll
    for (int db = 0; db < 8; ++db) { const f32x4 gs = *(const f32x4*)(gsub + 16 * db + 4 * g);
#pragma unroll
      for (int qb = 0; qb < 2; ++qb) { const f32x4 v = o[db][qb] * gs * ss[qb]; u32x2 w; w.x = cvt_pk_bf16(v[0], v[1]); w.y = cvt_pk_bf16(v[2], v[3]);
        *(u32x2*)(Og + (size_t)(rg * 32 + 16 * qb + c16) * LDP + 16 * db + 4 * g) = w; } }
  }
  __syncthreads();
}
#undef PV16
#undef PACK16
#undef LSUM16
#undef ADDF16
#undef PKV16
}

#define XB_TMO      128
#define XB_XCNT(j)  (256  + 64 * (j))
#define XB_XSUB(j)  (1280 + 64 * (j))
#define XB_XGEN(j)  (2304 + 64 * (j))
#define XB_TOP      3328
#define XB_TOPGEN   3392
#define XCD_BAR_WORDS 3456
#define XB_SPIN_CAP (1u << 20)
__device__ __forceinline__ unsigned xb_ld(unsigned* p)              { return __hip_atomic_load(p, __ATOMIC_RELAXED, __HIP_MEMORY_SCOPE_AGENT); }
__device__ __forceinline__ unsigned xb_add(unsigned* p, unsigned v) { return __hip_atomic_fetch_add(p, v, __ATOMIC_RELAXED, __HIP_MEMORY_SCOPE_AGENT); }
__device__ __forceinline__ unsigned xb_xcc_id() { return (unsigned)__builtin_amdgcn_s_getreg((3 << 11) | 20) & 0xFu; }
#define XB_SPIN(cond, bar) do { unsigned _sp = 0; while (cond) { __builtin_amdgcn_s_sleep(1); \
    if ((++_sp & 255u) == 0u) { if (xb_ld(&(bar)[XB_TMO])) break; if (_sp > XB_SPIN_CAP) { atomicAdd(&(bar)[XB_TMO], 1u); break; } } } } while (0)
struct XcdBarrier { unsigned* bar; unsigned x; volatile LAS unsigned* st; };
__device__ __forceinline__ XcdBarrier xcd_barrier_post(unsigned* bar, volatile LAS unsigned* st) {
    XcdBarrier b; b.bar = bar; b.x = xb_xcc_id(); b.st = st;
    if (threadIdx.x == 0) (void)xb_add(&bar[XB_XCNT(b.x)], 1u);
    return b;
}
__device__ __forceinline__ void xcd_barrier_complete(unsigned* bar, unsigned x, unsigned& nloc, unsigned& nx) {
    const unsigned G = gridDim.x * gridDim.y * gridDim.z;
    unsigned sum, cnt, mine, sp = 0u;
    for (;;) {
        sum = 0u; cnt = 0u; mine = 0u;
#pragma unroll
        for (unsigned j = 0; j < 16; ++j) { const unsigned c = xb_ld(&bar[XB_XCNT(j)]); sum += c; cnt += (c > 0u) ? 1u : 0u; mine = (j == x) ? c : mine; }
        if (sum == G) break;
        __builtin_amdgcn_s_sleep(1);
        if ((++sp & 255u) == 0u) { if (xb_ld(&bar[XB_TMO])) break; if (sp > XB_SPIN_CAP) { atomicAdd(&bar[XB_TMO], 1u); break; } }
    }
    nloc = mine > 0u ? mine : 1u; nx = cnt > 0u ? cnt : 1u;
}
__device__ __forceinline__ void xcd_barrier(const XcdBarrier& b) {
    asm volatile("s_waitcnt vmcnt(0)" ::: "memory");
    __syncthreads();
    if (threadIdx.x == 0) {
        unsigned* bar = b.bar;
        __builtin_amdgcn_s_waitcnt(0);
        unsigned nloc = b.st[0], nx = b.st[1];
        if (nloc == 0u) { xcd_barrier_complete(bar, b.x, nloc, nx); b.st[0] = nloc; b.st[1] = nx; }
        const unsigned old = xb_add(&bar[XB_XSUB(b.x)], 1u);
        const unsigned gen = old / nloc;
        if (old + 1u == (gen + 1u) * nloc) {
            __builtin_amdgcn_fence(__ATOMIC_RELEASE, "agent");
            asm volatile("s_waitcnt vmcnt(0)" ::: "memory");
            const unsigned og = xb_add(&bar[XB_TOP], 1u);
            const unsigned tg = og / nx;
            if (og + 1u == (tg + 1u) * nx) xb_add(&bar[XB_TOPGEN], 1u);
            else XB_SPIN(xb_ld(&bar[XB_TOPGEN]) == tg, bar);
            __builtin_amdgcn_fence(__ATOMIC_ACQUIRE, "agent");
            xb_add(&bar[XB_XGEN(b.x)], 1u);
            asm volatile("s_waitcnt vmcnt(0)" ::: "memory");
        } else {
            XB_SPIN(xb_ld(&bar[XB_XGEN(b.x)]) == gen, bar);
            __builtin_amdgcn_fence(__ATOMIC_ACQUIRE, "agent");
            asm volatile("s_waitcnt vmcnt(0)" ::: "memory");
        }
    }
    __syncthreads();
}

#define LDS_WAIT() asm volatile("s_waitcnt lgkmcnt(0)" ::: "memory")
__device__ __forceinline__ float wave_sum(float v) {
#pragma unroll
    for (int o = 1; o < 64; o <<= 1) v += __shfl_xor(v, o);
    return v;
}
typedef __bf16 bf16n2_t __attribute__((ext_vector_type(2)));
__device__ __forceinline__ unsigned cvt2_bf16_native(float lo, float hi) { const bf16n2_t v = {(__bf16)lo, (__bf16)hi}; return __builtin_bit_cast(unsigned, v); }
__device__ __forceinline__ void pool_fold_item(const float* Wp, const float* ps, const float* Wol, bf16_t* WT, int g_, int nb, int lane) {
    const int c16 = lane & 15, kg = lane >> 4, n0 = nb * 64;
    bf16x8 bfr[4][8];
#pragma unroll
    for (int ks = 0; ks < 8; ++ks) { const int d0 = ks * 32 + 8 * kg; const f32x4 p0 = *(const f32x4*)(ps + d0), p1 = *(const f32x4*)(ps + d0 + 4);
#pragma unroll
        for (int nh = 0; nh < 2; ++nh) { float t[2][8];
#pragma unroll
            for (int nq = 0; nq < 2; ++nq) { const float* bp = Wol + (size_t)d0 * 2048 + n0 + 16 * (2 * nh + nq) + c16;
#pragma unroll
                for (int j = 0; j < 8; ++j) t[nq][j] = bp[j * 2048]; }
            __builtin_amdgcn_sched_barrier(0);
#pragma unroll
            for (int nq = 0; nq < 2; ++nq) { u32x4 w;
                w.x = cvt2_bf16_native(t[nq][0] * p0[0], t[nq][1] * p0[1]); w.y = cvt2_bf16_native(t[nq][2] * p0[2], t[nq][3] * p0[3]);
                w.z = cvt2_bf16_native(t[nq][4] * p1[0], t[nq][5] * p1[1]); w.w = cvt2_bf16_native(t[nq][6] * p1[2], t[nq][7] * p1[3]); bfr[2 * nh + nq][ks] = __builtin_bit_cast(bf16x8, w); }
            __builtin_amdgcn_sched_barrier(0); } }
    for (int cb = 0; cb < 16; ++cb) { f32x4 acc[4];
#pragma unroll
        for (int nbk = 0; nbk < 4; ++nbk) acc[nbk] = (f32x4){0.f, 0.f, 0.f, 0.f};
#pragma unroll
        for (int kh = 0; kh < 2; ++kh) { f32x4 av[4][2];
#pragma unroll
            for (int k4 = 0; k4 < 4; ++k4) { const float* ap = Wp + (size_t)(cb * 16 + c16) * 256 + (kh * 4 + k4) * 32 + 8 * kg; av[k4][0] = *(const f32x4*)ap; av[k4][1] = *(const f32x4*)(ap + 4); }
            __builtin_amdgcn_sched_barrier(0);
#pragma unroll
            for (int k4 = 0; k4 < 4; ++k4) { const f32x4 a0 = av[k4][0], a1 = av[k4][1];
                u32x4 w; w.x = cvt2_bf16_native(a0[0], a0[1]); w.y = cvt2_bf16_native(a0[2], a0[3]); w.z = cvt2_bf16_native(a1[0], a1[1]); w.w = cvt2_bf16_native(a1[2], a1[3]); const bf16x8 af = __builtin_bit_cast(bf16x8, w);
#pragma unroll
                for (int nbk = 0; nbk < 4; ++nbk) acc[nbk] = __builtin_amdgcn_mfma_f32_16x16x32_bf16(af, bfr[nbk][kh * 4 + k4], acc[nbk], 0, 0, 0); }
            __builtin_amdgcn_sched_barrier(0); }
#pragma unroll
        for (int nbk = 0; nbk < 4; ++nbk) { u32x2 o; o.x = cvt2_bf16_native(acc[nbk][0], acc[nbk][1]); o.y = cvt2_bf16_native(acc[nbk][2], acc[nbk][3]);
            *(u32x2*)(WT + (size_t)(n0 + 16 * nbk + c16) * 2048 + 1024 + g_ * 256 + cb * 16 + 4 * kg) = o; }
        __builtin_amdgcn_sched_barrier(0); }
}
__device__ __forceinline__ unsigned cvt_pk_f16_rne(float a, float b) { const h2_t v = {(_Float16)a, (_Float16)b}; return __builtin_bit_cast(unsigned, v); }
template <bool F16 = false>
__device__ __forceinline__ void tr_item(const float* W, int K, int N, bf16_t* WT, const float* rs, const float* cs, int perm_limit, LAS float* scr, int item, int lane) {
    const int nblk = N / 32, kb = item / nblk, nb = item % nblk, k0 = 64 * kb, n0 = 32 * nb;
    const float csv = cs ? cs[n0 + (lane & 31)] : 1.f;
    float wv[32], rv[32];
#pragma unroll
    for (int i = 0; i < 32; ++i) { const int kk = 2 * i + (lane >> 5); wv[i] = W[(size_t)(k0 + kk) * N + n0 + (lane & 31)]; rv[i] = rs ? rs[k0 + kk] : 1.f; }
#pragma unroll
    for (int i = 0; i < 32; ++i) { const int kk = 2 * i + (lane >> 5); scr[kk * 33 + (lane & 31)] = wv[i] * rv[i] * csv; }
    LDS_WAIT(); asm volatile("" ::: "memory");
    int d0 = n0; if (n0 < perm_limit) { const int tile = n0 >> 8, lb = (n0 >> 5) & 7; d0 = (tile << 8) + ((4 * (lb & 1) + (lb >> 1)) << 5); }
    if (perm_limit < 0) { const int isv = n0 >= D_FF, ch = n0 - (isv ? D_FF : 0); d0 = (ch >> 7) * 256 + isv * 128 + (ch & 127); }
    const int c = lane & 7;
#pragma unroll
    for (int j = 0; j < 4; ++j) { const int n = (lane >> 3) + 8 * j; const LAS float* s = scr + (8 * c) * 33 + n;
        u32x4 o;
        if constexpr (F16) { o.x = cvt_pk_f16_rne(s[0 * 33], s[1 * 33]); o.y = cvt_pk_f16_rne(s[2 * 33], s[3 * 33]); o.z = cvt_pk_f16_rne(s[4 * 33], s[5 * 33]); o.w = cvt_pk_f16_rne(s[6 * 33], s[7 * 33]); }
        else { o.x = cvt_pk_bf16(s[0 * 33], s[1 * 33]); o.y = cvt_pk_bf16(s[2 * 33], s[3 * 33]); o.z = cvt_pk_bf16(s[4 * 33], s[5 * 33]); o.w = cvt_pk_bf16(s[6 * 33], s[7 * 33]); }
        *(u32x4*)(WT + (size_t)(d0 + n) * K + k0 + 8 * c) = o; }
    LDS_WAIT(); asm volatile("" ::: "memory");
}
__device__ __forceinline__ void norm_row(const float* xrow, bf16_t* orow, float* crow_, int lane) {
    f32x4 v[8]; float s = 0.f;
#pragma unroll
    for (int j = 0; j < 4; ++j) { v[2 * j] = *(const f32x4*)(xrow + j * 512 + lane * 8); v[2 * j + 1] = *(const f32x4*)(xrow + j * 512 + lane * 8 + 4); s += pg8::sumsq4(v[2 * j]) + pg8::sumsq4(v[2 * j + 1]); }
    const float rstd = __builtin_amdgcn_rsqf(wave_sum(s) * (1.0f / D_MODEL) + EPS);
#pragma unroll
    for (int j = 0; j < 4; ++j) { if (crow_) { *(f32x4*)(crow_ + j * 512 + lane * 8) = v[2 * j]; *(f32x4*)(crow_ + j * 512 + lane * 8 + 4) = v[2 * j + 1]; }
        *(u32x4*)(orow + j * 512 + lane * 8) = pg8::pack8(v[2 * j] * rstd, v[2 * j + 1] * rstd); }
}

__device__ __forceinline__ void raw_row(const float* xrow, bf16_t* orow, rss_t* ssq, int lane) {
    f32x4 v[8]; float s = 0.f;
#pragma unroll
    for (int j = 0; j < 4; ++j) { v[2 * j] = *(const f32x4*)(xrow + j * 512 + lane * 8); v[2 * j + 1] = *(const f32x4*)(xrow + j * 512 + lane * 8 + 4); s += pg8::sumsq4(v[2 * j]) + pg8::sumsq4(v[2 * j + 1]); }
    s = wave_sum(s); if (lane == 0) *ssq = ss_fix(s);
#pragma unroll
    for (int j = 0; j < 4; ++j) *(u32x4*)(orow + j * 512 + lane * 8) = pg8::pack8(v[2 * j], v[2 * j + 1]);
}

template <int WIN> __device__ __forceinline__ void pool_item(const bf16_t* U, bf16_t* ZP, int r0, int ch, bool big) {
    constexpr int NR = 3 + 2 * WIN, SM = WIN / 2;
    const int pos0 = tok_pos(r0), S = tok_seqlen(r0);
    u32x4 v[NR];
#pragma unroll
    for (int k = 0; k < NR; ++k) { const int p = pos0 - WIN + k; v[k] = (p >= 0 && p < S) ? *(const u32x4*)(U + (size_t)(r0 - WIN + k) * 1024 + ch) : (u32x4){0u, 0u, 0u, 0u}; }
    float sb[8], ss[8];
#pragma unroll
    for (int j = 0; j < 8; ++j) { sb[j] = 0.f; ss[j] = 0.f; }
#define POOL_ACC(dst, k, sgn) do { const u32x4 w_ = v[k]; dst[0] += sgn bflo(w_.x); dst[1] += sgn bfhi(w_.x); dst[2] += sgn bflo(w_.y); dst[3] += sgn bfhi(w_.y); dst[4] += sgn bflo(w_.z); dst[5] += sgn bfhi(w_.z); dst[6] += sgn bflo(w_.w); dst[7] += sgn bfhi(w_.w); } while (0)
#pragma unroll
    for (int k = 0; k < 2 * WIN; ++k) { POOL_ACC(sb, k, +); if (k >= WIN - SM && k < WIN + SM) POOL_ACC(ss, k, +); }
#pragma unroll
    for (int i = 0; i < 4; ++i) {
        if (i > 0) { POOL_ACC(sb, i + 2 * WIN - 1, +); POOL_ACC(sb, i - 1, -); POOL_ACC(ss, i + WIN + SM - 1, +); POOL_ACC(ss, i + WIN - SM - 1, -); }
        const int pos = pos0 + i, w2 = big ? WIN : SM; const int lo_ = pos - w2 < 0 ? 0 : pos - w2, hi_ = pos + w2 > S ? S : pos + w2; const float inv = 1.0f / (float)(hi_ - lo_);
        const u32x4 c = v[WIN + i]; float s[8];
#pragma unroll
        for (int j = 0; j < 8; ++j) s[j] = (big ? sb[j] : ss[j]) * inv;
        u32x4 o; o.x = cvt_pk_bf16(s[0] - bflo(c.x), s[1] - bfhi(c.x)); o.y = cvt_pk_bf16(s[2] - bflo(c.y), s[3] - bfhi(c.y)); o.z = cvt_pk_bf16(s[4] - bflo(c.z), s[5] - bfhi(c.z)); o.w = cvt_pk_bf16(s[6] - bflo(c.w), s[7] - bfhi(c.w));
        *(u32x4*)(ZP + (size_t)(r0 + i) * 1024 + ch) = o; }
#undef POOL_ACC
}

struct Args { const float* in[28]; float* out; unsigned char* ws; int ph_lo, ph_hi; };

__global__ void __launch_bounds__(NWAVES * 64, 2) trunk_fwd(Args args) {
    extern __shared__ __attribute__((aligned(16))) unsigned char lds_raw[];
    LAS unsigned char* lds = (LAS unsigned char*)lds_raw;
    volatile LAS unsigned* MISC = (volatile LAS unsigned*)(lds + MISC_OFF);
    for (int u = threadIdx.x; u < (LDS_BYTES - LDSCTL_OFF) / 4; u += NWAVES * 64) ((LAS unsigned*)(lds + LDSCTL_OFF))[u] = 0u;
    __syncthreads();
    const int lo = args.ph_lo, hi = args.ph_hi;
    XcdBarrier bar; bar.bar = (unsigned*)(args.ws + WS_CTL) + CW_BAR; bar.x = 0; bar.st = nullptr;
    if (hi - lo > 1) bar = xcd_barrier_post((unsigned*)(args.ws + WS_CTL) + CW_BAR, MISC + 8);
#define IN(k) ({ int lo_ = lo, hi_ = hi; asm volatile("" : "+s"(lo_), "+s"(hi_)); lo_ <= (k) && (k) < hi_; })
#define SEAM(k) do { if (IN(k) && IN((k) + 1)) { XcdBarrier b2_ = bar; asm volatile("" : "+s"(b2_.bar), "+s"(b2_.x)); xcd_barrier(b2_); } } while (0)
#define PHASE_BEGIN() int tid = threadIdx.x; asm volatile("" : "+v"(tid)); int zo = 0; asm volatile("" : "+s"(zo)); \
    const int lane = tid & 63, wave = __builtin_amdgcn_readfirstlane(tid >> 6); const int G = gridDim.x, bx = blockIdx.x; \
    const int vcu = (G % 8 == 0) ? (bx % 8) * (G / 8) + bx / 8 : bx; const int gw = vcu * NWAVES + wave, NGW = G * NWAVES; \
    unsigned char* ws = args.ws + zo; float* X = args.out + zo; (void)lane; (void)wave; (void)gw; (void)NGW; (void)ws; (void)X; (void)vcu; (void)tid
#define INP(i) (args.in[(i) + zo])
#define WSP(T, off) ((T*)(ws + (off)))

#define CG_UP 1u
#define CG_DOWN 2u
#define CG_IN 4u
#define CG_CKV 8u
#define CG_OUT 16u
#define CG_CQ 32u
#define CG_CO 64u
#define CONV_ITEMS(L_, MASK_) do { const int l_ = (L_); constexpr unsigned m_ = (MASK_); __syncthreads(); LAS float* scr = (LAS float*)(lds + wave * 16384);                                         \
    constexpr int I_IN = 32 * 128, I_OUT = 16 * 64, I_CQ = 32 * 64, I_CKV = 32 * 128, I_CO = 32 * 64, I_UP = 32 * (UP_W / 32), I_DOWN = (D_FF / 64) * 64, I_P = 4 * 32;                                 \
    constexpr int n_ = ((m_ & CG_UP) ? I_UP : 0) + ((m_ & CG_DOWN) ? I_DOWN : 0) + ((m_ & CG_IN) ? I_IN : 0) + ((m_ & CG_CKV) ? I_CKV : 0) + ((m_ & CG_OUT) ? I_OUT + I_P : 0) + ((m_ & CG_CQ) ? I_CQ : 0) + ((m_ & CG_CO) ? I_CO : 0); \
    for (int it = gw; it < n_; it += NGW) { int r = it;                                                                                                                                            \
        if constexpr ((m_ & CG_UP) != 0) { if (r < I_UP) { tr_item(INP(24) + (size_t)l_ * 2048 * UP_W, 2048, UP_W, WSP(bf16_t, WS_WUP), INP(23) + l_ * 2048, nullptr, -1, scr, r, lane); continue; } r -= I_UP; } \
        if constexpr ((m_ & CG_DOWN) != 0) { if (r < I_DOWN) { tr_item<true>(INP(27) + (size_t)l_ * D_FF * 2048, D_FF, 2048, WSP(bf16_t, WS_WDOWN), nullptr, nullptr, 0, scr, r, lane); continue; } r -= I_DOWN; } \
        if constexpr ((m_ & CG_IN) != 0) { if (r < I_IN) { tr_item(INP(5) + (size_t)l_ * 2048 * 4096, 2048, 4096, WSP(bf16_t, WS_WIN), INP(4) + l_ * 2048, nullptr, 2048, scr, r, lane); continue; } r -= I_IN; } \
        if constexpr ((m_ & CG_CKV) != 0) { if (r < I_CKV) { tr_item(INP(19) + (size_t)l_ * 2048 * 4096, 2048, 4096, WSP(bf16_t, WS_WCKV), INP(17) + l_ * 2048, nullptr, 0, scr, r, lane); continue; } r -= I_CKV; } \
        if constexpr ((m_ & CG_OUT) != 0) { if (r < I_OUT) { tr_item(INP(15) + (size_t)l_ * 2048 * 2048, 2048, 2048, WSP(bf16_t, WS_WOUT), nullptr, nullptr, 0, scr, r, lane); continue; } r -= I_OUT;   \
            if (r < I_P) { const int g = r >> 5; pool_fold_item(INP(13) + (size_t)l_ * 4 * 65536 + (size_t)g * 65536, INP(14) + l_ * 1024 + g * 256, INP(15) + (size_t)l_ * 2048 * 2048 + (size_t)(1024 + g * 256) * 2048, WSP(bf16_t, WS_WOUT), g, r & 31, lane); continue; } r -= I_P; } \
        if constexpr ((m_ & CG_CQ) != 0) { if (r < I_CQ) { tr_item(INP(18) + (size_t)l_ * 2048 * 2048, 2048, 2048, WSP(bf16_t, WS_WCQ), INP(16) + l_ * 2048, nullptr, 0, scr, r, lane); continue; } r -= I_CQ; } \
        if constexpr ((m_ & CG_CO) != 0) { if (r < I_CO) { tr_item(INP(22) + (size_t)l_ * 2048 * 2048, 2048, 2048, WSP(bf16_t, WS_WCO), nullptr, nullptr, 0, scr, r, lane); continue; } r -= I_CO; } }   \
    if constexpr ((m_ & CG_UP) != 0) { const float* cw = INP(25) + (size_t)l_ * 3 * UP_W; const float* cb = INP(26) + (size_t)l_ * UP_W; u32x4* cwt = WSP(u32x4, WS_CWT);        \
        for (int it = vcu * 512 + tid; it < D_FF; it += G * 512) { const int p = it >> 1, isv = it & 1, ch = 2 * p + isv * D_FF; u32x4 w;                                                          \
            w.x = cvt_pk_f16_rne(cw[ch], cw[ch + 1]); w.y = cvt_pk_f16_rne(cw[UP_W + ch], cw[UP_W + ch + 1]); w.z = cvt_pk_f16_rne(cw[2 * UP_W + ch], cw[2 * UP_W + ch + 1]); w.w = cvt_pk_f16_rne(cb[ch], cb[ch + 1]); cwt[it] = w; } } } while (0)
    for (int l = 0; l < DEPTH; ++l) {
        const int pb = l * PH_PER_LAYER;
        if (PH_EN(0) && IN(pb + 0)) {
            PHASE_BEGIN();
            if (l == 0) CONV_ITEMS(0, CG_IN | CG_CKV);
            bf16_t* HB = WSP(bf16_t, WS_HB);
            if (l == 0) {
                unsigned* csT = WSP(unsigned, WS_COS);
                for (int e = (vcu * 512 + tid); e < 8192 * 32; e += G * 512) { const int pos = e >> 5, i = e & 31;
                    double inv = 1.0; const double b = 0.74989420933245582730;
                    for (int k = 0; k < i; ++k) inv *= b;
                    double rev = (double)pos * inv * 0.15915494309189533577; rev -= __builtin_floor(rev);
                    const float fr_ = (float)rev;
                    const _Float16 hc = (_Float16)__builtin_amdgcn_cosf(fr_), hs = (_Float16)__builtin_amdgcn_sinf(fr_);
                    csT[e] = (unsigned)__builtin_bit_cast(unsigned short, hc) | ((unsigned)__builtin_bit_cast(unsigned short, hs) << 16); }
                bf16_t* MB = WSP(bf16_t, WS_MB);
                for (int m = gw; m < NMEMROWS; m += NGW) { const float* src = m < 1024 ? INP(2) + (size_t)m * 2048 : INP(3) + (size_t)(m - 1024) * 2048; norm_row(src, MB + (size_t)m * 2048, nullptr, lane); }
                rss_t* rss0 = WSP(rss_t, WS_ROWSS);
                for (int m = gw; m < NTOK; m += NGW) { const float* src = m < NTOK_P ? INP(0) + (size_t)m * 2048 : INP(1) + (size_t)(m - NTOK_P) * 2048; raw_row(src, HB + (size_t)m * 2048, rss0 + m, lane); }
            }
        }
        if (l == 0) SEAM(pb + 0);
        if (PH_EN(1) && IN(pb + 1)) {
            PHASE_BEGIN(); pg8::StaticOrder SO;
            if (PH_EN(17)) { pg8::ProbSimple P; P.K = 2048; P.lda = 2048; P.ldb = 2048; P.tsplit = 1 << 30; P.adelta = 0; P.A = (const char*)WSP(bf16_t, WS_HB); P.B = (const char*)WSP(bf16_t, WS_WIN);
              SO.init(NTOK / 256, IN_W / 256, G, bx);
              pg8::EpiIn E{WSP(bf16_t, R_Q), (size_t)NTOK * 1024, WSP(const unsigned, WS_COS), INP(6) + l * 64, INP(7) + l * 64, WSP(const rss_t, WS_ROWSS) + (size_t)(l * 3 + 0) * NTOK};
              pg8::gemm_phase<pg8::ProbSimple, pg8::EpiIn, true, true>(lds, P, SO, E); }
            if (PH_EN(16)) { pg8::ProbSimple P; P.K = 2048; P.lda = 2048; P.ldb = 2048; P.tsplit = 1 << 30; P.adelta = 0; P.A = (const char*)WSP(bf16_t, WS_MB); P.B = (const char*)WSP(bf16_t, WS_WCKV);
              SO.init(NMEMROWS / 256, 4096 / 256, G, bx);
              pg8::EpiKV E{WSP(float, WS_KRAW), WSP(bf16_t, WS_VT)};
              pg8::gemm_phase<pg8::ProbSimple, pg8::EpiKV, true, true>(lds, P, SO, E); }
            if (l == 0) CONV_ITEMS(0, CG_OUT | CG_CO | CG_CQ);
        }
        SEAM(pb + 1);
        if (PH_EN(2) && IN(pb + 2)) {
            if (PH_EN(18)) {
              PHASE_BEGIN();
              const float lam_init = 0.8f - 0.6f * __expf(-0.3f * (float)l);
              float s1 = 0.f, s2 = 0.f; const float* q1 = INP(8) + l * 64; const float* k1 = INP(9) + l * 64; const float* q2 = INP(10) + l * 64; const float* k2 = INP(11) + l * 64;
              for (int i = 0; i < 64; ++i) { s1 += q1[i] * k1[i]; s2 += q2[i] * k2[i]; }
              const float lam = __expf(s1) - __expf(s2) + lam_init;
              const float* gsub = INP(12) + l * 128;
              bf16_t* Qb = WSP(bf16_t, R_Q); const bf16_t* Kb = WSP(const bf16_t, R_K); const bf16_t* Vb = WSP(const bf16_t, R_V);
              __syncthreads();
              { const int NX = (G % 8 == 0) ? 8 : 1, xcd = bx % NX, j = bx / NX, nb = G / NX, npr = 2048 / NX;
                  for (int kk = j; kk < 2 * npr; kk += nb) { int pair, qt, S; size_t t0;
                      if (kk < npr) { pair = xcd + NX * (kk >> 6); qt = kk & 63; S = S_P; t0 = (size_t)(pair >> 3) * S_P; }
                      else { const int k2_ = kk - npr; pair = xcd + NX * (k2_ >> 5); qt = k2_ & 31; S = S_S; t0 = (size_t)NTOK_P + (size_t)(pair >> 3) * S_S; }
                      const int h = pair & 7; bf16_t* qp = Qb + (t0 + (size_t)qt * 128) * 1024 + h * 128;
                      ATTN_NS::attn_unit(qp, Kb + t0 * 1024 + h * 128, Vb + t0 * 1024 + h * 128, qp, S, lam, gsub, 1.f - lam_init, lds, kk < npr && ((kk / nb) & 1)); }
              }
            }
            if (PH_EN(14)) { PHASE_BEGIN(); const bf16_t* U = WSP(const bf16_t, R_U); bf16_t* ZP = (bf16_t*)X;
#ifdef PROBE_DOUBLE_PASSES
              int nrq = 2; asm volatile("" : "+s"(nrq)); for (int rq_ = 0; rq_ < nrq; ++rq_)
#endif
              for (int it = gw; it < (NTOK / 4) * 2; it += NGW) { const int r0 = (it >> 1) * 4, half = it & 1, ch = half * 512 + lane * 8;
                  if (half == 0) pool_item<2>(U, ZP, r0, ch, lane >= 32); else pool_item<8>(U, ZP, r0, ch, lane >= 32); } }
            if (PH_EN(15)) { PHASE_BEGIN(); const float* gcq = INP(20) + l * 512; const float* gck = INP(21) + l * 512; const float* KRAW = WSP(const float, WS_KRAW); bf16_t* KC = WSP(bf16_t, WS_KC);
              for (int it = gw; it < NMEMROWS * 4; it += NGW) { const int row = it >> 2, h = it & 3; const float* kr = KRAW + (size_t)row * 2048 + h * 512 + lane * 8;
                  const f32x4 a = *(const f32x4*)kr, b = *(const f32x4*)(kr + 4); const float ss = wave_sum(pg8::sumsq4(a) + pg8::sumsq4(b));
                  const float rk = __builtin_amdgcn_rsqf(ss * (1.0f / 512.0f) + EPS);
                  const f32x4 ga = *(const f32x4*)(gcq + lane * 8) * *(const f32x4*)(gck + lane * 8), gb = *(const f32x4*)(gcq + lane * 8 + 4) * *(const f32x4*)(gck + lane * 8 + 4);
                  *(u32x4*)(KC + (size_t)row * 2048 + h * 512 + lane * 8) = pg8::pack8(a * rk * ga, b * rk * gb); } }
            { PHASE_BEGIN(); if (l == 0) CONV_ITEMS(0, CG_UP); else CONV_ITEMS(l, CG_DOWN); }
        }
        SEAM(pb + 2);
        if (PH_EN(4) && IN(pb + 4)) {
            PHASE_BEGIN(); pg8::StaticOrder SO;
            pg8::ProbSimple P; P.K = 2048; P.lda = 1024; P.ldb = 2048; P.tsplit = 16; P.adelta = (long long)((const char*)X - (const char*)(ws + R_Q)) - 16ll * 128; P.A = (const char*)(ws + R_Q);   P.B = (const char*)WSP(bf16_t, WS_WOUT);
            SO.init(NTOK / 256, 8, G, bx);
            pg8::EpiRes E{WSP(bf16_t, WS_HB), WSP(rss_t, WS_ROWSS) + (size_t)(l * 3 + 1) * NTOK, nullptr};
            pg8::gemm_phase<pg8::ProbSimple, pg8::EpiRes, true, true>(lds, P, SO, E);
            if (PH_EN(3)) {

              pg8::ProbVW P2; P2.K = 512; P2.lda = 2048; P2.ldb = 2048; P2.tsplit = 1 << 30; P2.adelta = 0; P2.A = (const char*)WSP(bf16_t, WS_WCO); P2.B = (const char*)WSP(bf16_t, WS_VT);
              SO.init(8, 48, G, bx);
              pg8::EpiBf<5> E2{WSP(bf16_t, R_VW), 1024, nullptr, nullptr, nullptr};
              pg8::gemm_phase<pg8::ProbVW, pg8::EpiBf<5>, true, true>(lds, P2, SO, E2); }
            if (l == 0) CONV_ITEMS(0, CG_DOWN);
            if (l + 1 < DEPTH) CONV_ITEMS(l + 1, CG_IN | CG_CKV);
        }
        SEAM(pb + 4);
        if (PH_EN(5) && IN(pb + 5)) {
            PHASE_BEGIN(); pg8::StaticOrder SO;
            pg8::ProbSimple P; P.K = 2048; P.lda = 2048; P.ldb = 2048; P.tsplit = 1 << 30; P.adelta = 0; P.A = (const char*)WSP(bf16_t, WS_HB); P.B = (const char*)WSP(bf16_t, WS_WCQ);
            SO.init(NTOK / 256, 8, G, bx);
            pg8::EpiBf<1> E{WSP(bf16_t, R_QC), 2048, WSP(float, WS_QSS), (float*)(WSP(rss_t, WS_ROWSS) + (size_t)(l * 3 + 1) * NTOK), nullptr};
            pg8::gemm_phase<pg8::ProbSimple, pg8::EpiBf<1>, true, true>(lds, P, SO, E);
            if (l + 1 < DEPTH) CONV_ITEMS(l + 1, CG_OUT | CG_CO);
        }
        SEAM(pb + 5);
        if (PH_EN(6) && IN(pb + 6)) {
            PHASE_BEGIN(); pg8::StaticOrder SO;
            pg8::ProbScores P; P.K = 512; P.lda = 2048; P.ldb = 2048; P.tsplit = 1 << 30; P.adelta = 0; P.A = (const char*)(ws + R_QC); P.B = (const char*)WSP(bf16_t, WS_KC);
            SO.init(NTOK / 256, 4, G, bx);
            pg8::EpiBf<2> E{WSP(bf16_t, R_P), 1024, WSP(float, WS_QSS), nullptr, (LAS float*)(lds + XCH_OFF)};
            pg8::gemm_phase<pg8::ProbScores, pg8::EpiBf<2>, true, true>(lds, P, SO, E);
            if (l + 1 < DEPTH) CONV_ITEMS(l + 1, CG_CQ);
        }
        SEAM(pb + 6);
        if (PH_EN(8) && IN(pb + 7)) {
            PHASE_BEGIN(); pg8::StaticOrder SO;
            pg8::ProbFin P; P.K = 1024; P.lda = 1024; P.ldb = 1024; P.tsplit = 1 << 30; P.adelta = 0; P.A = (const char*)(ws + R_P); P.B = (const char*)WSP(bf16_t, R_VW);
            SO.init(NTOK / 256, 8, G, bx);
            pg8::EpiRes E{WSP(bf16_t, WS_HB), WSP(rss_t, WS_ROWSS) + (size_t)(l * 3 + 2) * NTOK, nullptr};
            pg8::gemm_phase<pg8::ProbFin, pg8::EpiRes, true, true>(lds, P, SO, E);
        }
        SEAM(pb + 7);
        const bool whole = (l + 1 < DEPTH); const int nch = whole ? 1 : N_FFN_CHUNKS;
        for (int c = 0; c < nch; ++c) {
            const int pc = pb + 8 + 2 * c; const size_t r0 = (size_t)c * FFN_CHUNK; const int MT = whole ? NTOK / 256 : FFN_MT;
            if (PH_EN(11) && IN(pc)) {
                PHASE_BEGIN(); pg8::StaticOrder SO;
                pg8::ProbUp P; P.K = 2048; P.lda = 2048; P.ldb = 2048; P.tsplit = 1 << 30; P.adelta = 0; P.A = (const char*)(WSP(bf16_t, WS_HB) + r0 * 2048); P.B = (const char*)WSP(bf16_t, WS_WUP); P.chunk = c;
                SO.init(MT, D_FF / 128, G, bx);
                bf16_t* G2p = (bf16_t*)((unsigned char*)X - (size_t)FFN_GSPLIT_ROW * D_FF * 2); bf16_t* EBp = whole ? (bf16_t*)((unsigned char*)X + FFN_EB_OUT_OFF) : WSP(bf16_t, R_EB);
                pg8::EpiGlu E{WSP(bf16_t, R_G), WSP(const rss_t, WS_ROWSS) + (size_t)(l * 3 + 2) * NTOK + r0, WSP(const u32x4, WS_CWT), c, (LAS float*)(lds + GLX_OFF), EBp, G2p, whole ? FFN_GSPLIT_ROW / 256 : (1 << 30)};
                pg8::gemm_phase<pg8::ProbUp, pg8::EpiGlu, true, true>(lds, P, SO, E);
            }
            SEAM(pc);
            if (PH_EN(13) && IN(pc + 1)) {
                PHASE_BEGIN(); pg8::StaticOrder SO;
                bf16_t* G2p = (bf16_t*)((unsigned char*)X - (size_t)FFN_GSPLIT_ROW * D_FF * 2);
                {
                  const bf16_t* EBp = whole ? (const bf16_t*)((unsigned char*)X + FFN_EB_OUT_OFF) : WSP(const bf16_t, R_EB); const u32x4* cwp = WSP(const u32x4, WS_CWT); bf16_t* Gp = WSP(bf16_t, R_G);
                  const int nb = whole ? 244 : (c == 0 ? 124 : 120), gsr = whole ? FFN_GSPLIT_ROW : (1 << 30);
                  for (int it = gw; it < nb * 11; it += NGW) { const int b = it / 11, cb = it - b * 11; int t;
                      if (whole ? b < 124 : c == 0) { const int sq = b / 31, bi = b - sq * 31; t = sq * S_P + 256 * (bi + 1); }
                      else { const int b2 = whole ? b - 124 : b, sq = b2 / 15, bi = b2 - sq * 15; t = (whole ? NTOK_P : 0) + sq * S_S + 256 * (bi + 1); }
                      pg8::ffn_fix_item(EBp, cwp, Gp, G2p, gsr, t, cb, lane); }
                  XcdBarrier b4_ = bar; asm volatile("" : "+s"(b4_.bar), "+s"(b4_.x)); xcd_barrier(b4_); }
                pg8::ProbDown P; P.K = D_FF; P.lda = D_FF; P.ldb = D_FF; P.tsplit = 1 << 30; P.adelta = 0; P.A = (const char*)(ws + R_G); P.A2 = (const char*)G2p; P.B = (const char*)WSP(bf16_t, WS_WDOWN); P.split = whole ? FFN_GSPLIT_ROW / 256 : (1 << 30);
                SO.init(MT, 8, G, bx);
                pg8::EpiRes E{WSP(bf16_t, WS_HB) + r0 * 2048, (l + 1 < DEPTH) ? WSP(rss_t, WS_ROWSS) + (size_t)((l + 1) * 3 + 0) * NTOK + r0 : nullptr, (l + 1 < DEPTH) ? nullptr : X + r0 * 2048};
                pg8::gemm_phase<pg8::ProbDown, pg8::EpiRes, true, true>(lds, P, SO, E);
                if (c == nch - 1 && l + 1 < DEPTH) CONV_ITEMS(l + 1, CG_UP);
            }
            SEAM(pc + 1);
        }
    }
#undef IN
#undef SEAM
#undef PHASE_BEGIN
#undef INP
#undef WSP
}


#ifdef SELFCHECK
constexpr int CHK_WORD = 1024;
__device__ __forceinline__ void chk_upd(unsigned* ctl, int idx, float got, float ref) { const float e = fabsf(got - ref) / (0.03f * fabsf(ref) + 0.03f); atomicMax(ctl + CHK_WORD + idx, __float_as_uint(e)); }
__device__ __forceinline__ int chk_token(int s) { const int tab[16] = {0, 1, 127, 128, 4095, 8191, 8192, 12345, 32767, 32768, 32769, 36863, 36864, 50000, 65534, 65535}; int t = 0;
#pragma unroll
    for (int i = 0; i < 16; ++i) t = (s & 15) == i ? tab[i] : t; return t; }
__global__ void __launch_bounds__(64) check_kernel(Args args, int after, int l) {
    const int s = blockIdx.x, lane = threadIdx.x; unsigned char* ws = args.ws; unsigned* ctl = (unsigned*)(ws + WS_CTL);
    const int tok = chk_token(s); float* X = args.out;
    const float* xin = tok < NTOK_P ? args.in[0] + (size_t)tok * 2048 : args.in[1] + (size_t)(tok - NTOK_P) * 2048;
    if (after == 1) {
        if (l == 0) {
            float ssx = 0.f; for (int k = lane; k < 2048; k += 64) ssx += xin[k] * xin[k]; ssx = wave_sum(ssx); const float rstd = 1.0f / sqrtf(ssx / 2048.f + EPS);
            const int vec = (s * 7) & 31, isk = vec >> 4, hc = vec & 15;
            const float* w_in = args.in[5]; const float* g_mix = args.in[4]; const int col = isk * 1024 + hc * 64 + lane;
            float z = 0.f; for (int k = 0; k < 2048; ++k) z += xin[k] * rstd * g_mix[k] * w_in[(size_t)k * 4096 + col];
            const float ss = wave_sum(z * z); const float g = (isk ? args.in[7] : args.in[6])[lane]; const float zn = z / sqrtf(ss / 64.f + EPS) * g;
            const float other = __shfl_xor(zn, 32); const int i = lane & 31; const int pos = tok_pos(tok);
            const float ang = (float)pos * powf(10000.f, -(float)i / 32.f); const float c = cosf(ang), sn = sinf(ang);
            const float ref = lane < 32 ? zn * c - other * sn : zn * c + other * sn;
            const bf16_t* Q = (const bf16_t*)(ws + (isk ? R_K : R_Q)); const float got = bf2f(Q[(size_t)tok * 1024 + hc * 64 + lane]);
            const float gother = __shfl_xor(got, 32);
            (void)gother; chk_upd(ctl, 0, got, ref);
            { const unsigned tv = ((const unsigned*)(ws + WS_COS))[pos * 32 + i]; typedef _Float16 h2 __attribute__((ext_vector_type(2))); const h2 hv = __builtin_bit_cast(h2, tv);
              chk_upd(ctl, 1, (float)hv.x, c); chk_upd(ctl, 1, (float)hv.y, sn); }
        }
        { const bf16_t* Q = (const bf16_t*)(ws + R_Q); bf16_t* sv = (bf16_t*)(ws + WS_CHK) + s * 128; const int h = s & 7; sv[lane] = Q[(size_t)tok * 1024 + h * 128 + lane]; sv[lane + 64] = Q[(size_t)tok * 1024 + h * 128 + 64 + lane]; }
    }
    if (after == 2) {
        const int h = s & 7; const bf16_t* sv = (const bf16_t*)(ws + WS_CHK) + s * 128; const int S = tok_seqlen(tok); const size_t t0 = (size_t)tok - tok_pos(tok);
        const bf16_t* K = (const bf16_t*)(ws + R_K) + t0 * 1024 + h * 128; const bf16_t* V = (const bf16_t*)(ws + R_V) + t0 * 1024 + h * 128;
        const float lam_init = 0.8f - 0.6f * expf(-0.3f * (float)l); float s1 = 0.f, s2 = 0.f;
        for (int i = 0; i < 64; ++i) { s1 += (args.in[8] + l * 64)[i] * (args.in[9] + l * 64)[i]; s2 += (args.in[10] + l * 64)[i] * (args.in[11] + l * 64)[i]; }
        const float lam = expf(s1) - expf(s2) + lam_init;
        float o[2][2];
        for (int c = 0; c < 2; ++c) { float mx = -1e30f;
            for (int k = lane; k < S; k += 64) { float d = 0.f; for (int e = 0; e < 64; ++e) d += bf2f(sv[c * 64 + e]) * bf2f(K[(size_t)k * 1024 + c * 64 + e]); mx = fmaxf(mx, d); }
            for (int o_ = 1; o_ < 64; o_ <<= 1) mx = fmaxf(mx, __shfl_xor(mx, o_));
            float lsum = 0.f, a0 = 0.f, a1 = 0.f;
            for (int k = 0; k < S; ++k) { float d = 0.f; for (int e = 0; e < 64; ++e) d += bf2f(sv[c * 64 + e]) * bf2f(K[(size_t)k * 1024 + c * 64 + e]);
                const float p = exp2f(d - mx); lsum += p; a0 += p * bf2f(V[(size_t)k * 1024 + lane]); a1 += p * bf2f(V[(size_t)k * 1024 + 64 + lane]); }
            o[c][0] = a0 / lsum; o[c][1] = a1 / lsum; }
        const float v0 = o[0][0] - lam * o[1][0], v1 = o[0][1] - lam * o[1][1]; const float ss = wave_sum(v0 * v0 + v1 * v1); const float rn = 1.0f / sqrtf(ss / 128.f + EPS) * (1.f - lam_init);
        const float* gsub = args.in[12] + l * 128; const bf16_t* A = (const bf16_t*)(ws + R_Q) + (size_t)tok * 1024 + h * 128;
        chk_upd(ctl, 2, bf2f(A[lane]), v0 * rn * gsub[lane]); chk_upd(ctl, 2, bf2f(A[64 + lane]), v1 * rn * gsub[64 + lane]);
    }
    if (after == 4 && l == 0) {
        const bf16_t* A = (const bf16_t*)(ws + R_Q) + (size_t)tok * 1024; const bf16_t* Pp = (const bf16_t*)(ws + R_POUT) + (size_t)tok * 1024; const float* w_out = args.in[15];
        const int col = (s * 131 + lane * 17) & 2047; float z = xin[col];
        for (int k = 0; k < 1024; ++k) z += bf2f(A[k]) * w_out[(size_t)k * 2048 + col];
        for (int k = 0; k < 1024; ++k) z += bf2f(Pp[k]) * w_out[(size_t)(1024 + k) * 2048 + col];
        chk_upd(ctl, 3, X[(size_t)tok * 2048 + col], z);
    }
    if (after == 8 && tok < FFN_CHUNK) {
        const bf16_t* HB = (const bf16_t*)(ws + WS_HB); const float* w_up = args.in[24] + (size_t)l * 2048 * UP_W; const float* g_ffn = args.in[23] + l * 2048;
        const float* cw = args.in[25] + (size_t)l * 3 * UP_W; const float* cb = args.in[26] + (size_t)l * UP_W;
        const int j = (s * 977 + lane * 53) % D_FF; const int pos = tok_pos(tok), S = tok_seqlen(tok); float u2[2];
        for (int half = 0; half < 2; ++half) { const int col = half * D_FF + j; float acc = cb[col];
            for (int tap = 0; tap < 3; ++tap) { const int pp = pos + tap - 1; if (pp < 0 || pp >= S) continue; const bf16_t* hr = HB + (size_t)(tok + tap - 1) * 2048; float d = 0.f;
                for (int k = 0; k < 2048; ++k) d += bf2f(hr[k]) * g_ffn[k] * w_up[(size_t)k * UP_W + col];
                const float rxx = ss_rstd(((const rss_t*)(ws + WS_ROWSS))[(size_t)(l * 3 + 2) * NTOK + tok + tap - 1]); acc += d * rxx * cw[(size_t)tap * UP_W + col]; }
            u2[half] = acc; }
        const float x = u2[0]; const float ref = 0.5f * x * (1.f + tanhf(0.7978845608028654f * (x + 0.044715f * x * x * x))) * u2[1];
        chk_upd(ctl, 4, bf2f(((const bf16_t*)(ws + R_G))[(size_t)tok * D_FF + j]), ref);
    }
    if (false) {
        const bf16_t* Gr = (const bf16_t*)(ws + R_G) + (size_t)tok * D_FF; const float* w_down = args.in[27] + (size_t)l * D_FF * 2048; const float* svx = (const float*)(ws + WS_CHK + 65536) + (size_t)s * 2048;
        const int col = (s * 131 + lane * 17) & 2047; float z = svx[col]; for (int k = 0; k < D_FF; ++k) z += bf2f(Gr[k]) * w_down[(size_t)k * 2048 + col];
        chk_upd(ctl, 5, X[(size_t)tok * 2048 + col], z);
    }
}
__global__ void __launch_bounds__(256) report_kernel(Args args) {
    unsigned* ctl = (unsigned*)(args.ws + WS_CTL); float* out = args.out;
    for (size_t i = (size_t)blockIdx.x * 256 + threadIdx.x; i < (size_t)NTOK * 2048; i += (size_t)gridDim.x * 256) {
        float v = 0.f;
        if (i == 0) { int mask = 0; for (int b = 0; b < 6; ++b) if (__uint_as_float(ctl[CHK_WORD + b]) > 1.0f) mask |= 1 << b; v = (10.f + (float)mask) * 1000.f; }
        out[i] = v; }
}
#endif

extern "C" void kernel_launch(void* const* d_in, const int* in_sizes, int n_in, void* d_out, int out_size, void* d_ws, size_t ws_size, hipStream_t stream) {
    static int grid = 0;
    if (grid == 0) {
        if (n_in != 28 || out_size != NTOK * D_MODEL || ws_size < WS_END) { fprintf(stderr, "kernel_launch: unexpected shapes: n_in %d out %d ws %zu (need >= %zu)\n", n_in, out_size, ws_size, (size_t)WS_END); grid = -1; return; }
        int dev = 0, cus = 0, per_cu = 0;
        if (hipGetDevice(&dev) != hipSuccess || hipDeviceGetAttribute(&cus, hipDeviceAttributeMultiprocessorCount, dev) != hipSuccess) { grid = -1; return; }
        if (hipFuncSetAttribute((const void*)trunk_fwd, hipFuncAttributeMaxDynamicSharedMemorySize, LDS_BYTES) != hipSuccess) { fprintf(stderr, "kernel_launch: hipFuncSetAttribute failed\n"); grid = -1; return; }
        if (hipOccupancyMaxActiveBlocksPerMultiprocessor(&per_cu, (const void*)trunk_fwd, NWAVES * 64, LDS_BYTES) != hipSuccess || per_cu < 1)
            fprintf(stderr, "kernel_launch: occupancy query reports %d workgroups per CU\n", per_cu);
        (void)hipGetLastError();
        grid = cus;
    }
    if (grid < 0) return;
    (void)hipMemsetAsync((char*)d_ws + WS_CTL, 0, CTL_ZERO_BYTES, stream);
    Args a{};
    for (int i = 0; i < 28; ++i) a.in[i] = (const float*)d_in[i];
    a.out = (float*)d_out; a.ws = (unsigned char*)d_ws;
#if ML_PER_PHASE
    for (int p = 0; p < N_PHASES; ++p) { a.ph_lo = p; a.ph_hi = p + 1; hipLaunchKernelGGL(trunk_fwd, dim3(grid), dim3(NWAVES * 64), LDS_BYTES, stream, a);
#ifdef SELFCHECK
        { const int l = p / PH_PER_LAYER, q = p % PH_PER_LAYER; if (l == SELFCHECK_LAYER && (q == 1 || q == 2 || q == 8)) hipLaunchKernelGGL(check_kernel, dim3(64), dim3(64), 0, stream, a, q, l); }
#endif
    }
#ifdef SELFCHECK
    hipLaunchKernelGGL(report_kernel, dim3(2048), dim3(256), 0, stream, a);
#endif
#else
    a.ph_lo = 0; a.ph_hi = N_PHASES;
    hipLaunchKernelGGL(trunk_fwd, dim3(grid), dim3(NWAVES * 64), LDS_BYTES, stream, a);
#endif
    const hipError_t le = hipPeekAtLastError();
    if (le != hipSuccess) fprintf(stderr, "kernel_launch: launch failed: %s\n", hipGetErrorName(le));
}
```

```cpp
#include <hip/hip_runtime.h>
#include <cstdio>
#include <cstdint>

#define SELFCHECK_LAYER 0
#ifndef ML_PER_PHASE
#define ML_PER_PHASE 0
#endif

#ifndef PHASE_MASK
#define PHASE_MASK 0xFFFFFFFFu
#endif
#define PH_EN(p) (((PHASE_MASK) >> (p)) & 1u)
#ifndef ATTN_NS
#define ATTN_NS att16
#endif
#define LAS __attribute__((address_space(3)))
#define GAS __attribute__((address_space(1)))
typedef unsigned short bf16_t;
typedef short bf16x8 __attribute__((ext_vector_type(8)));
typedef short s16x4 __attribute__((ext_vector_type(4)));
typedef float f32x4 __attribute__((ext_vector_type(4)));
typedef float f32x2 __attribute__((ext_vector_type(2)));
typedef float f32x16 __attribute__((ext_vector_type(16)));
typedef unsigned u32x4 __attribute__((ext_vector_type(4)));
typedef unsigned u32x2 __attribute__((ext_vector_type(2)));
typedef _Float16 h2_t __attribute__((ext_vector_type(2)));
typedef _Float16 f16x8 __attribute__((ext_vector_type(8)));

constexpr int D_MODEL = 2048, DEPTH = 2;
constexpr int NTOK = 65536;
constexpr int NTOK_P = 32768;
constexpr int S_P = 8192, S_S = 4096;
constexpr int NMEMROWS = 3072;
constexpr int IN_W = 4096, D_FF = 5632, UP_W = 11264;
constexpr float EPS = 1e-6f;
constexpr float QSCALE = 0.125f * 1.4426950408889634f;
constexpr int FFN_CHUNK = 32768, N_FFN_CHUNKS = 2;
constexpr int FFN_MT = FFN_CHUNK / 256, FFN_BT = 0;
constexpr int PH_PER_LAYER = 8 + 2 * N_FFN_CHUNKS;
constexpr int N_PHASES = DEPTH * PH_PER_LAYER;

constexpr size_t MiB = 1u << 20;
constexpr size_t WS_CTL = 0, CTL_ZERO_BYTES = 5 * MiB;
constexpr size_t WS_ROWSS = 1 * MiB;
constexpr size_t WS_COS = 5 * MiB;
constexpr size_t WS_QSS = 6 * MiB;
constexpr size_t WS_LPART = 14 * MiB;
constexpr size_t WS_MB = 18 * MiB;
constexpr size_t WS_KRAW = 30 * MiB;
constexpr size_t WS_KC = 54 * MiB;
constexpr size_t WS_VT = 66 * MiB;
constexpr size_t WS_CHK = 78 * MiB;
constexpr size_t WS_WIN = 79 * MiB, WS_WP = 95 * MiB, WS_WOUT = 96 * MiB, WS_WCQ = 104 * MiB, WS_WCKV = 112 * MiB, WS_WCO = 128 * MiB, WS_WUP = 136 * MiB, WS_WDOWN = 180 * MiB;
constexpr size_t WS_HB = 203 * MiB;
constexpr size_t WS_R = 459 * MiB;
constexpr size_t WS_CWT = 987 * MiB;
constexpr size_t WS_END = 988 * MiB;
typedef unsigned long long rss_t;
__device__ __forceinline__ rss_t ss_fix(float s) { return (rss_t)(s * 1048576.0f + 0.5f); }
__device__ __forceinline__ float ss_rstd(rss_t v) { return __builtin_amdgcn_rsqf((float)v * (1.0f / (1048576.0f * 2048.0f)) + 1e-6f); }
constexpr size_t R_Q = WS_R, R_K = WS_R + 128 * MiB, R_V = WS_R + 256 * MiB, R_U = WS_R + 384 * MiB;
constexpr size_t R_QC = WS_R, R_P = WS_R + 256 * MiB, R_VW = WS_R + 384 * MiB;
constexpr size_t R_G = WS_R;
constexpr int FFN_GSPLIT_ROW = 49152;
constexpr size_t FFN_EB_OUT_OFF = 192 * MiB;
constexpr size_t R_EB = WS_R + 384 * MiB;
constexpr size_t R_POUT = WS_R + 128 * MiB;
static_assert(R_G + (size_t)FFN_CHUNK * D_FF * 2 <= WS_END, "ws map");
constexpr int CW_BAR = 4096;

constexpr int RING_BYTES = 131072;
constexpr int LDSCTL_OFF = RING_BYTES, MISC_OFF = LDSCTL_OFF + 320, XCH_OFF = LDSCTL_OFF + 1024, GLX_OFF = XCH_OFF + 4096;
constexpr int LDS_BYTES = 151552;
constexpr int NWAVES = 8;

__device__ __forceinline__ unsigned cvt_pk_bf16(float lo, float hi) { unsigned r; asm volatile("v_cvt_pk_bf16_f32 %0, %1, %2" : "=v"(r) : "v"(lo), "v"(hi)); return r; }
__device__ __forceinline__ float bf2f(unsigned short b) { return __uint_as_float(((unsigned)b) << 16); }
__device__ __forceinline__ float bflo(unsigned w) { return __uint_as_float(w << 16); }
__device__ __forceinline__ float bfhi(unsigned w) { return __uint_as_float(w & 0xffff0000u); }
__device__ __forceinline__ int tok_pos(int row) { return row < NTOK_P ? (row & (S_P - 1)) : (row & (S_S - 1)); }
__device__ __forceinline__ int tok_seqlen(int row) { return row < NTOK_P ? S_P : S_S; }
__device__ __forceinline__ int tile_batch(int pm) { return pm < 128 ? (pm >> 5) : 4 + ((pm - 128) >> 4); }

namespace pg8 {
constexpr int BM = 256, BK = 64, HALF = 128, HTB = HALF * BK * 2, STAGE_BYTES = 8 * HTB, NXCD = 8, WGM = 4;
__host__ __device__ __forceinline__ int lds_byte(int r, int c) { const int st = (r >> 4) * 2 + (c >> 5), rr = r & 15, cc = c & 31, ob = rr * 64 + cc * 2; return st * 1024 + (ob ^ (((ob >> 9) & 1) << 5)); }
__host__ __device__ __forceinline__ void stage_rc(int b, int& R, int& C) { const int st = b / 1024, sb = b % 1024, swz = sb ^ (((sb >> 9) & 1) << 5); R = (st >> 1) * 16 + swz / 64; C = (st & 1) * 32 + (swz % 64) / 2; }
__host__ __device__ __forceinline__ int perm32(int rho) { const int n = rho >> 4, i = rho & 15; return 8 * (i >> 2) + 4 * n + (i & 3); }
struct Unit { int pm, pn; };
struct StaticOrder {
    int nM, nN, nwg, G, c;
    __host__ __device__ void init(int nM_, int nN_, int G_, int c_) { nM = nM_; nN = nN_; nwg = nM * nN; G = G_; c = c_; }
    __host__ __device__ bool next(int i, Unit& u) const {
        const long L = (long)i * G + c; if (L >= nwg) return false;
        int wgid = (int)L; { const int q = nwg / NXCD, r = nwg % NXCD, xcd = wgid % NXCD, off = wgid / NXCD; wgid = (xcd < r ? xcd * (q + 1) : r * (q + 1) + (xcd - r) * q) + off; }
        const int nig = WGM * nN, gid = wgid / nig, fm = gid * WGM, gsz = (nM - fm) < WGM ? (nM - fm) : WGM;
        u.pm = fm + ((wgid % nig) % gsz); u.pn = (wgid % nig) / gsz; return true;
    }
};
struct ProbBase { static constexpr bool GATHER = false; static constexpr bool F16 = false; int K, lda, ldb, tsplit; long long adelta; __device__ __forceinline__ unsigned rowoff(const Unit&, int) const { return 0u; } };

template <class Prob, class Epi, bool ALIGN_EPI, bool SP2>
__device__ __forceinline__ void gemm_phase(LAS unsigned char* lds, const Prob& P, const StaticOrder& S, const Epi& E) {
    static_assert(SP2, "only the two-super-phase loop is kept in this file");
    int tid_l = threadIdx.x; asm volatile("" : "+v"(tid_l));
    const int tid = tid_l, wid = __builtin_amdgcn_readfirstlane(tid >> 6), lane = tid & 63, wr = wid >> 2, wc = wid & 3, fr = lane & 15, fq = lane >> 4;
    const int K = P.K, nt = K / BK, lda = P.lda, ldb = P.ldb, tsplit = P.tsplit; const long long adelta = P.adelta;
    unsigned voffA[2], voffB[2];
#pragma unroll
    for (int i = 0; i < 2; ++i) { int R, C; stage_rc(tid * 16 + i * 8192, R, C); const int Rb = Epi::PERM ? ((R & ~31) + perm32(R & 31)) : R;
        voffA[i] = (unsigned)(R * lda + C) * 2u; voffB[i] = (unsigned)(Rb * ldb + C) * 2u; }
    const size_t kstep = (size_t)(BK * 2);
    const size_t hstepA = (size_t)HALF * lda * 2, hstepB = (size_t)HALF * ldb * 2;
    const unsigned ldsw = (unsigned)wid * 1024u;
    const int aoff = lds_byte(wr * 64 + fr, fq * 8), boff = lds_byte(wc * 32 + fr, fq * 8);
    unsigned vAc[2][2], vAn[2][2];
#define PG8_SA(b, h) (((b) * 2 + (h)) * HTB)
#define PG8_SB(b, h) ((4 + (b) * 2 + (h)) * HTB)
#define PG8_STAGE(bufoff, gbase, voff) do { _Pragma("unroll") for (int _i = 0; _i < 2; ++_i) \
        __builtin_amdgcn_global_load_lds((const unsigned*)((const char*)(gbase) + (voff)[_i]), (LAS unsigned*)(lds + (bufoff) + ldsw + _i * 8192), 16, 0, 0); } while (0)
#define PG8_STAGE_A(bufoff, kptr, h, NXT) do { if constexpr (Prob::GATHER) { _Pragma("unroll") for (int _i = 0; _i < 2; ++_i) \
        __builtin_amdgcn_global_load_lds((const unsigned*)((const char*)(kptr) + ((NXT) ? vAn[h][_i] : vAc[h][_i])), (LAS unsigned*)(lds + (bufoff) + ldsw + _i * 8192), 16, 0, 0); } \
        else { PG8_STAGE(bufoff, (kptr) + (h) * hstepA, voffA); } } while (0)
#define PG8_GATHER_OFFS(dst, unit) do { _Pragma("unroll") for (int _i = 0; _i < 2; ++_i) { int _R, _C; stage_rc(tid * 16 + _i * 8192, _R, _C); _Pragma("unroll") for (int _h = 0; _h < 2; ++_h) dst[_h][_i] = P.rowoff(unit, _R + 128 * _h) + (unsigned)_C * 2u; } } while (0)
#define PG8_LDA(dst, b, h) do { _Pragma("unroll") for (int m = 0; m < 4; ++m) _Pragma("unroll") for (int k = 0; k < 2; ++k) dst[m][k] = *(const LAS bf16x8*)(lds + PG8_SA(b, h) + aoff + m * 2048 + k * 1024); } while (0)
#define PG8_LDB(dst, b, h) do { _Pragma("unroll") for (int n = 0; n < 2; ++n) _Pragma("unroll") for (int k = 0; k < 2; ++k) dst[n][k] = *(const LAS bf16x8*)(lds + PG8_SB(b, h) + boff + n * 2048 + k * 1024); } while (0)
#define PG8_MMA(ai, bj, At, Bt) do { __builtin_amdgcn_s_setprio(1); _Pragma("unroll") for (int m = 0; m < 4; ++m) _Pragma("unroll") for (int n = 0; n < 2; ++n) _Pragma("unroll") for (int k = 0; k < 2; ++k) \
        { if constexpr (Prob::F16) acc[ai][bj][m][n] = __builtin_amdgcn_mfma_f32_16x16x32_f16(__builtin_bit_cast(f16x8, Bt[n][k]), __builtin_bit_cast(f16x8, At[m][k]), acc[ai][bj][m][n], 0, 0, 0); \
          else acc[ai][bj][m][n] = __builtin_amdgcn_mfma_f32_16x16x32_bf16(Bt[n][k], At[m][k], acc[ai][bj][m][n], 0, 0, 0); } __builtin_amdgcn_s_setprio(0); } while (0)
#define PG8_WAIT_V(n) asm volatile("s_waitcnt vmcnt(" #n ")" ::: "memory")
#define PG8_WAIT_L(n) asm volatile("s_waitcnt lgkmcnt(" #n ")" ::: "memory")
#define PG8_BAR __builtin_amdgcn_s_barrier()
#define PG8_SCHED __builtin_amdgcn_sched_barrier(0)
#define PG8_AK(base, t) ((base) + (size_t)(t) * kstep + (((t) >= tsplit) ? adelta : 0ll))
    Unit cur, nxt; int ui = 0;
    if (!S.next(0, cur)) return;
    f32x4 acc[2][2][4][2];
#pragma unroll
    for (int a = 0; a < 2; ++a)
#pragma unroll
        for (int b = 0; b < 2; ++b)
#pragma unroll
            for (int m = 0; m < 4; ++m)
#pragma unroll
                for (int n = 0; n < 2; ++n) acc[a][b][m][n] = (f32x4){0.f, 0.f, 0.f, 0.f};
    bf16x8 At[4][2], B0[2][2], B1[2][2];
    const char* cA = P.aptr(cur); const char* cB = P.bptr(cur);
    if constexpr (Prob::GATHER) { PG8_GATHER_OFFS(vAc, cur); }
    PG8_STAGE(PG8_SB(0, 0), cB, voffB); PG8_STAGE(PG8_SB(0, 1), cB + hstepB, voffB); PG8_STAGE_A(PG8_SA(0, 0), cA, 0, false); PG8_STAGE_A(PG8_SA(0, 1), cA, 1, false);
    if (wr == 1) PG8_BAR;
    PG8_WAIT_V(2); PG8_BAR;
    PG8_STAGE(PG8_SB(1, 0), cB + kstep, voffB); PG8_STAGE_A(PG8_SA(1, 0), PG8_AK(cA, 1), 0, false); PG8_STAGE(PG8_SB(1, 1), cB + hstepB + kstep, voffB);
    PG8_WAIT_V(6); PG8_BAR;
    for (;;) {
        const bool has_next = S.next(ui + 1, nxt);
        const char* nA = has_next ? P.aptr(nxt) : cA; const char* nB = has_next ? P.bptr(nxt) : cB;
        if constexpr (Prob::GATHER) { if (has_next) { PG8_GATHER_OFFS(vAn, nxt); } else {
#pragma unroll
            for (int _h = 0; _h < 2; ++_h)
#pragma unroll
                for (int _i = 0; _i < 2; ++_i) vAn[_h][_i] = vAc[_h][_i]; } }
        for (int t = 0; t < nt; t += 2) {
            const bool last = (t == nt - 2);
            const char* a1 = PG8_AK(cA, t + 1);
            const char* a2 = last ? nA : PG8_AK(cA, t + 2); const char* b2 = last ? nB : cB + (size_t)(t + 2) * kstep;
            const char* a3 = last ? PG8_AK(nA, 1) : PG8_AK(cA, t + 3); const char* b3 = b2 + kstep;
            PG8_LDB(B0, 0, 0); PG8_LDB(B1, 0, 1); PG8_SCHED; PG8_LDA(At, 0, 0); PG8_STAGE_A(PG8_SA(1, 1), a1, 1, false);
            PG8_WAIT_V(8); PG8_WAIT_L(0); PG8_BAR; PG8_MMA(0, 0, At, B0); PG8_MMA(0, 1, At, B1); PG8_BAR; PG8_SCHED;
            PG8_LDA(At, 0, 1); PG8_STAGE(PG8_SB(0, 0), b2, voffB); PG8_STAGE(PG8_SB(0, 1), b2 + hstepB, voffB); PG8_STAGE_A(PG8_SA(0, 0), a2, 0, last);
            PG8_WAIT_V(8); PG8_WAIT_L(0); PG8_BAR; PG8_MMA(1, 0, At, B0); PG8_MMA(1, 1, At, B1); PG8_BAR; PG8_SCHED;
            PG8_LDB(B0, 1, 0); PG8_LDB(B1, 1, 1); PG8_SCHED; PG8_LDA(At, 1, 0); PG8_STAGE_A(PG8_SA(0, 1), a2, 1, last);
            PG8_WAIT_V(8); PG8_WAIT_L(0); PG8_BAR; PG8_MMA(0, 0, At, B0); PG8_MMA(0, 1, At, B1); PG8_BAR; PG8_SCHED;
            PG8_LDA(At, 1, 1); PG8_STAGE(PG8_SB(1, 0), b3, voffB); PG8_STAGE(PG8_SB(1, 1), b3 + hstepB, voffB); PG8_STAGE_A(PG8_SA(1, 0), a3, 0, last);
            PG8_WAIT_V(8); PG8_WAIT_L(0); PG8_BAR; PG8_MMA(1, 0, At, B0); PG8_MMA(1, 1, At, B1); PG8_BAR; PG8_SCHED;
        }
        if constexpr (ALIGN_EPI) { if (wr == 0) PG8_BAR; }
        { int te = threadIdx.x; asm volatile("" : "+v"(te));
          const int we = __builtin_amdgcn_readfirstlane(te >> 6), le = te & 63; E(acc, cur, we >> 2, we & 3, le & 15, le >> 4); }
        if (!has_next) break;
#pragma unroll
        for (int a = 0; a < 2; ++a)
#pragma unroll
            for (int b = 0; b < 2; ++b)
#pragma unroll
                for (int m = 0; m < 4; ++m)
#pragma unroll
                    for (int n = 0; n < 2; ++n) acc[a][b][m][n] = (f32x4){0.f, 0.f, 0.f, 0.f};
        cur = nxt; cA = nA; cB = nB; ++ui;
        if constexpr (Prob::GATHER) {
#pragma unroll
            for (int _h = 0; _h < 2; ++_h)
#pragma unroll
                for (int _i = 0; _i < 2; ++_i) vAc[_h][_i] = vAn[_h][_i]; }
        if constexpr (ALIGN_EPI) { if (wr == 1) PG8_BAR; }
    }
    PG8_WAIT_V(0);
    if constexpr (!ALIGN_EPI) { if (wr == 0) PG8_BAR; }
    PG8_BAR;
#undef PG8_SA
#undef PG8_SB
#undef PG8_STAGE
#undef PG8_STAGE_A
#undef PG8_GATHER_OFFS
#undef PG8_LDA
#undef PG8_LDB
#undef PG8_MMA
#undef PG8_WAIT_V
#undef PG8_WAIT_L
#undef PG8_BAR
#undef PG8_SCHED
#undef PG8_AK
}

struct ProbSimple : ProbBase {
    const char* A; const char* B;
    __device__ __forceinline__ const char* aptr(const Unit& u) const { return A + (size_t)u.pm * 256 * lda * 2; }
    __device__ __forceinline__ const char* bptr(const Unit& u) const { return B + (size_t)u.pn * 256 * ldb * 2; }
};
struct ProbSimpleF16 : ProbSimple { static constexpr bool F16 = true; };
struct ProbDown : ProbBase {
    static constexpr bool F16 = true;
    const char* A; const char* A2; const char* B; int split;
    __device__ __forceinline__ const char* aptr(const Unit& u) const { return (u.pm < split ? A : A2) + (size_t)u.pm * 256 * lda * 2; }
    __device__ __forceinline__ const char* bptr(const Unit& u) const { return B + (size_t)u.pn * 256 * ldb * 2; }
};
struct ProbPool : ProbBase {
    const char* A; const char* B;
    __device__ __forceinline__ const char* aptr(const Unit& u) const { return A + ((size_t)u.pm * 256 * 1024 + (size_t)u.pn * 256) * 2; }
    __device__ __forceinline__ const char* bptr(const Unit& u) const { return B + (size_t)u.pn * 65536 * 2; }
};
struct ProbScores : ProbBase {
    const char* A; const char* B;
    __device__ __forceinline__ const char* aptr(const Unit& u) const { return A + ((size_t)u.pm * 256 * 2048 + (size_t)u.pn * 512) * 2; }
    __device__ __forceinline__ const char* bptr(const Unit& u) const { return B + ((size_t)tile_batch(u.pm) * 256 * 2048 + (size_t)u.pn * 512) * 2; }
};
struct ProbVW : ProbBase {
    const char* A; const char* B;
    __device__ __forceinline__ const char* aptr(const Unit& u) const { return A + ((size_t)u.pm * 256 * 2048 + (size_t)(u.pn & 3) * 512) * 2; }
    __device__ __forceinline__ const char* bptr(const Unit& u) const { return B + ((size_t)(u.pn >> 2) * 256 * 2048 + (size_t)(u.pn & 3) * 512) * 2; }
};
struct ProbFin : ProbBase {
    const char* A; const char* B;
    __device__ __forceinline__ const char* aptr(const Unit& u) const { return A + (size_t)u.pm * 256 * 1024 * 2; }
    __device__ __forceinline__ const char* bptr(const Unit& u) const { return B + ((size_t)tile_batch(u.pm) * 2048 + (size_t)u.pn * 256) * 1024 * 2; }
};
struct ProbPV : ProbBase {
    const char* A; const char* B;
    __device__ __forceinline__ const char* aptr(const Unit& u) const { return A + ((size_t)u.pm * 256 * 1024 + (size_t)(u.pn >> 1) * 256) * 2; }
    __device__ __forceinline__ const char* bptr(const Unit& u) const { return B + ((size_t)tile_batch(u.pm) * 2048 + (size_t)u.pn * 256) * 256 * 2; }
};

__device__ __forceinline__ u32x4 pack8(const f32x4& v0, const f32x4& v1) { u32x4 w; w.x = cvt_pk_bf16(v0[0], v0[1]); w.y = cvt_pk_bf16(v0[2], v0[3]); w.z = cvt_pk_bf16(v1[0], v1[1]); w.w = cvt_pk_bf16(v1[2], v1[3]); return w; }
__device__ __forceinline__ float sumsq4(const f32x4& x) { return (x[0] * x[0] + x[1] * x[1]) + (x[2] * x[2] + x[3] * x[3]); }
__device__ __forceinline__ float sum4(const f32x4& x) { return (x[0] + x[1]) + (x[2] + x[3]); }
__device__ __forceinline__ float red_fq(float s) { s += __shfl_xor(s, 16); s += __shfl_xor(s, 32); return s; }

struct EpiIn {
    static constexpr bool PERM = true;
    bf16_t* base; size_t spl; const unsigned* csT; const float* gq; const float* gk; const rss_t* rowss;
    __device__ __forceinline__ void operator()(const f32x4 (&acc)[2][2][4][2], const Unit& u, int wr, int wc, int fr, int fq) const {
        typedef _Float16 h2 __attribute__((ext_vector_type(2)));
        const int t = u.pn >> 2; bf16_t* O = base + (size_t)t * spl; const int colt = (u.pn & 3) * 256; const int row0 = u.pm * BM + wr * 64 + fr;
        if (t >= 2) {
            const int col0 = colt + wc * 32 + 8 * fq;
#pragma unroll
            for (int ai = 0; ai < 2; ++ai) { rss_t rx[4];
#pragma unroll
                for (int m = 0; m < 4; ++m) rx[m] = rowss[row0 + ai * HALF + m * 16];
#pragma unroll
                for (int m = 0; m < 4; ++m) { const float rxm = ss_rstd(rx[m]); bf16_t* rowp = O + (size_t)(row0 + ai * HALF + m * 16) * 1024 + col0;
#pragma unroll
                    for (int bj = 0; bj < 2; ++bj) *(u32x4*)(rowp + bj * HALF) = pack8(acc[ai][bj][m][0] * rxm, acc[ai][bj][m][1] * rxm); }
                asm volatile("" ::: "memory"); }
        } else {
            const float* g = t ? gk : gq; f32x4 g1[2], g2[2];
#pragma unroll
            for (int n = 0; n < 2; ++n) { g1[n] = *(const f32x4*)(g + 8 * fq + 4 * n); g2[n] = *(const f32x4*)(g + 32 + 8 * fq + 4 * n); }
            const int col0 = colt + 64 * wc + 8 * fq;
#pragma unroll
            for (int ah = 0; ah < 4; ++ah) { const int ai = ah >> 1, mb = (ah & 1) * 2;
                u32x4 cs[2][2]; rss_t rx[2];
#pragma unroll
                for (int mm = 0; mm < 2; ++mm) { const int m = mb + mm; const int pos = tok_pos(row0 + ai * HALF + m * 16); rx[mm] = rowss[row0 + ai * HALF + m * 16];
#pragma unroll
                    for (int n = 0; n < 2; ++n) cs[mm][n] = *(const u32x4*)(csT + pos * 32 + 8 * fq + 4 * n); }
#pragma unroll
                for (int mm = 0; mm < 2; ++mm) { const int m = mb + mm; const int row = row0 + ai * HALF + m * 16;
                    float ss = (sumsq4(acc[ai][0][m][0]) + sumsq4(acc[ai][0][m][1])) + (sumsq4(acc[ai][1][m][0]) + sumsq4(acc[ai][1][m][1]));
                    ss = red_fq(ss);
                    const float rxm = ss_rstd(rx[mm]);
                    const float r = __builtin_amdgcn_rsqf(ss * rxm * rxm * (1.0f / 64.0f) + EPS) * rxm * (t ? 1.0f : QSCALE);
                    f32x4 o1[2], o2[2];
#pragma unroll
                    for (int n = 0; n < 2; ++n) { f32x4 c, s;
#pragma unroll
                        for (int j = 0; j < 4; ++j) { const unsigned w = cs[mm][n][j]; const h2 v = __builtin_bit_cast(h2, w); c[j] = (float)v.x; s[j] = (float)v.y; }
                        const f32x4 x1 = acc[ai][0][m][n] * r * g1[n], x2 = acc[ai][1][m][n] * r * g2[n];
                        o1[n] = x1 * c - x2 * s; o2[n] = x2 * c + x1 * s; }
                    bf16_t* rowp = O + (size_t)row * 1024 + col0;
                    *(u32x4*)(rowp) = pack8(o1[0], o1[1]); *(u32x4*)(rowp + 32) = pack8(o2[0], o2[1]); }
                asm volatile("" ::: "memory"); }
        }
    }
};
template <int MODE> struct EpiBf {
    static constexpr bool PERM = true;
    bf16_t* O; int ldc; float* aux; float* aux2; LAS float* xl;
    __device__ __forceinline__ void operator()(f32x4 (&acc)[2][2][4][2], const Unit& u, int wr, int wc, int fr, int fq) const {
        const int row0 = u.pm * BM + wr * 64 + fr; const int col0 = u.pn * BM + wc * 32 + 8 * fq;
        float rs[2][4];
        if constexpr (MODE == 2) {
            f32x4 qa[2][4][2];
#pragma unroll
            for (int ai = 0; ai < 2; ++ai)
#pragma unroll
                for (int m = 0; m < 4; ++m) { const float* p = aux + (size_t)(row0 + ai * HALF + m * 16) * 32 + u.pn * 8; qa[ai][m][0] = *(const f32x4*)p; qa[ai][m][1] = *(const f32x4*)(p + 4); }
#pragma unroll
            for (int ai = 0; ai < 2; ++ai)
#pragma unroll
                for (int m = 0; m < 4; ++m) { const float sc = __builtin_amdgcn_rsqf((sum4(qa[ai][m][0]) + sum4(qa[ai][m][1])) * (1.0f / 512.0f) + EPS) * (0.044194173824159216f * 1.4426950408889634f); float ps = 0.f;
#pragma unroll
                    for (int bj = 0; bj < 2; ++bj)
#pragma unroll
                        for (int n = 0; n < 2; ++n) { f32x4 p;
#pragma unroll
                            for (int j = 0; j < 4; ++j) p[j] = __builtin_amdgcn_exp2f(acc[ai][bj][m][n][j] * sc);
                            acc[ai][bj][m][n] = p; ps += sum4(p); }
                    ps = red_fq(ps);
                    if (fq == 0) xl[(ai * HALF + wr * 64 + m * 16 + fr) * 4 + wc] = ps; }
            asm volatile("s_waitcnt lgkmcnt(0)" ::: "memory"); __builtin_amdgcn_s_barrier(); asm volatile("" ::: "memory");
#pragma unroll
            for (int ai = 0; ai < 2; ++ai)
#pragma unroll
                for (int m = 0; m < 4; ++m) { const f32x4 lv = *(const LAS f32x4*)(xl + (ai * HALF + wr * 64 + m * 16 + fr) * 4); rs[ai][m] = __builtin_amdgcn_rcpf(sum4(lv)); }
        }
        if constexpr (MODE == 1 || MODE == 4) { rss_t rv[2][4];
#pragma unroll
            for (int ai = 0; ai < 2; ++ai)
#pragma unroll
                for (int m = 0; m < 4; ++m) rv[ai][m] = ((const rss_t*)aux2)[row0 + ai * HALF + m * 16];
#pragma unroll
            for (int ai = 0; ai < 2; ++ai)
#pragma unroll
                for (int m = 0; m < 4; ++m) rs[ai][m] = ss_rstd(rv[ai][m]);
        }
        if constexpr (MODE == 3) {
            f32x4 la[2][4];
#pragma unroll
            for (int ai = 0; ai < 2; ++ai)
#pragma unroll
                for (int m = 0; m < 4; ++m) la[ai][m] = *(const f32x4*)(aux2 + (size_t)(row0 + ai * HALF + m * 16) * 16 + (u.pn >> 1) * 4);
#pragma unroll
            for (int ai = 0; ai < 2; ++ai)
#pragma unroll
                for (int m = 0; m < 4; ++m) rs[ai][m] = __builtin_amdgcn_rcpf(sum4(la[ai][m]));
        }
        bf16_t* Ob = O; int colb = col0;
        if constexpr (MODE == 5) { Ob = O + (size_t)(u.pn >> 2) * 2048 * 1024; colb = (u.pn & 3) * 256 + wc * 32 + 8 * fq; }
#pragma unroll
        for (int ai = 0; ai < 2; ++ai)
#pragma unroll
            for (int m = 0; m < 4; ++m) { const int row = row0 + ai * HALF + m * 16; bf16_t* rowp = Ob + (size_t)row * ldc + colb;
                if constexpr (MODE == 0 || MODE == 5) {
#pragma unroll
                    for (int bj = 0; bj < 2; ++bj) *(u32x4*)(rowp + bj * HALF) = pack8(acc[ai][bj][m][0], acc[ai][bj][m][1]);
                } else if constexpr (MODE == 1) {
                    float ss = (sumsq4(acc[ai][0][m][0]) + sumsq4(acc[ai][0][m][1])) + (sumsq4(acc[ai][1][m][0]) + sumsq4(acc[ai][1][m][1]));
                    ss = red_fq(ss); const float rxx = rs[ai][m];
                    if (fq == 0) aux[(size_t)row * 32 + u.pn * 4 + wc] = ss * rxx * rxx;
#pragma unroll
                    for (int bj = 0; bj < 2; ++bj) *(u32x4*)(rowp + bj * HALF) = pack8(acc[ai][bj][m][0] * rxx, acc[ai][bj][m][1] * rxx);
                } else {
                    const float rxx = rs[ai][m];
#pragma unroll
                    for (int bj = 0; bj < 2; ++bj) *(u32x4*)(rowp + bj * HALF) = pack8(acc[ai][bj][m][0] * rxx, acc[ai][bj][m][1] * rxx);
                }
            }
    }
};
struct EpiRes {
    static constexpr bool PERM = true;
    bf16_t* XB; rss_t* rowss; float* OUT;
    __device__ __forceinline__ void load_half(u32x4 (&t)[4][2], int row0, int col0, int ai) const {
#pragma unroll
        for (int m = 0; m < 4; ++m) { const bf16_t* rowb = XB + (size_t)(row0 + ai * HALF + m * 16) * D_MODEL + col0;
#pragma unroll
            for (int bj = 0; bj < 2; ++bj) t[m][bj] = *(const u32x4*)(rowb + bj * HALF); }
    }
    __device__ __forceinline__ void add_half(f32x4 (&acc)[2][2][4][2], const u32x4 (&t)[4][2], int ai) const {
#pragma unroll
        for (int m = 0; m < 4; ++m)
#pragma unroll
            for (int bj = 0; bj < 2; ++bj) { const u32x4 w = t[m][bj];
#define ADDS_(d, x) asm("v_add_f32 %0, %1, %0" : "+v"(d) : "v"(x))
                ADDS_(acc[ai][bj][m][0][0], bflo(w.x)); ADDS_(acc[ai][bj][m][0][1], bfhi(w.x)); ADDS_(acc[ai][bj][m][0][2], bflo(w.y)); ADDS_(acc[ai][bj][m][0][3], bfhi(w.y));
                ADDS_(acc[ai][bj][m][1][0], bflo(w.z)); ADDS_(acc[ai][bj][m][1][1], bfhi(w.z)); ADDS_(acc[ai][bj][m][1][2], bflo(w.w)); ADDS_(acc[ai][bj][m][1][3], bfhi(w.w));
#undef ADDS_
            }
    }
    __device__ __forceinline__ void store_half(const f32x4 (&acc)[2][2][4][2], int row0, int col0, int ai, int fq) const {
#pragma unroll
        for (int m = 0; m < 4; ++m) { const int row = row0 + ai * HALF + m * 16; bf16_t* rowb = XB + (size_t)row * D_MODEL + col0; float ss = 0.f;
#pragma unroll
            for (int bj = 0; bj < 2; ++bj) { const f32x4 v0 = acc[ai][bj][m][0], v1 = acc[ai][bj][m][1];
                if (OUT) { float* rowp = OUT + (size_t)row * D_MODEL + col0 + bj * HALF; *(f32x4*)rowp = v0; *(f32x4*)(rowp + 4) = v1; }
                else { *(u32x4*)(rowb + bj * HALF) = pack8(v0, v1); ss += sumsq4(v0) + sumsq4(v1); } }
            if (rowss) { ss = red_fq(ss); if (fq == 0) atomicAdd(rowss + row, ss_fix(ss)); } }
    }
    __device__ __forceinline__ void operator()(f32x4 (&acc)[2][2][4][2], const Unit& u, int wr, int wc, int fr, int fq) const {
        const int row0 = u.pm * BM + wr * 64 + fr, col0 = u.pn * BM + wc * 32 + 8 * fq;
        u32x4 t[4][2];
        load_half(t, row0, col0, 0);
        add_half(acc, t, 0);
        asm volatile("" : "+v"(acc[0][0][0][0]), "+v"(acc[0][1][3][1]));
        load_half(t, row0, col0, 1);
        asm volatile("" ::: "memory");
        store_half(acc, row0, col0, 0, fq);
        add_half(acc, t, 1);
        store_half(acc, row0, col0, 1, fq);
    }
};
__device__ __forceinline__ int ffn_tile_row(int pm, int R, int chunk, bool& valid) {
    R = (R & ~63) | ((R & 15) << 2) | ((R >> 4) & 3);
    valid = true; (void)chunk; return pm * 256 + R;
}
struct ProbUp : ProbBase {
    static constexpr bool GATHER = true;
    const char* A; const char* B; int chunk;
    __device__ __forceinline__ const char* aptr(const Unit&) const { return A; }
    __device__ __forceinline__ const char* bptr(const Unit& u) const { return B + (size_t)u.pn * 256 * ldb * 2; }
    __device__ __forceinline__ unsigned rowoff(const Unit& u, int R) const { bool v; return (unsigned)ffn_tile_row(u.pm, R, chunk, v) * (unsigned)(lda * 2); }
};
__device__ __forceinline__ float dpp_ror1(float v) { return __builtin_bit_cast(float, __builtin_amdgcn_update_dpp(0, __builtin_bit_cast(int, v), 0x121, 0xf, 0xf, false)); }
__device__ __forceinline__ float dpp_ror15(float v) { return __builtin_bit_cast(float, __builtin_amdgcn_update_dpp(0, __builtin_bit_cast(int, v), 0x12F, 0xf, 0xf, false)); }
__device__ __forceinline__ h2_t u2h(unsigned u) { return __builtin_bit_cast(h2_t, u); }
__device__ __forceinline__ unsigned h2u(h2_t h) { return __builtin_bit_cast(unsigned, h); }
__device__ __forceinline__ unsigned dppu_ror1(unsigned v) { return (unsigned)__builtin_amdgcn_update_dpp(0, (int)v, 0x121, 0xf, 0xf, false); }
__device__ __forceinline__ unsigned dppu_ror15(unsigned v) { return (unsigned)__builtin_amdgcn_update_dpp(0, (int)v, 0x12F, 0xf, 0xf, false); }
#define H2X4_TRANS(OP, a, b, c, d) asm(OP " %0, %0 dst_sel:WORD_0 dst_unused:UNUSED_PRESERVE src0_sel:WORD_0\n\t" OP " %1, %1 dst_sel:WORD_0 dst_unused:UNUSED_PRESERVE src0_sel:WORD_0\n\t" \
    OP " %2, %2 dst_sel:WORD_0 dst_unused:UNUSED_PRESERVE src0_sel:WORD_0\n\t" OP " %3, %3 dst_sel:WORD_0 dst_unused:UNUSED_PRESERVE src0_sel:WORD_0\n\t"                                  \
    OP " %0, %0 dst_sel:WORD_1 dst_unused:UNUSED_PRESERVE src0_sel:WORD_1\n\t" OP " %1, %1 dst_sel:WORD_1 dst_unused:UNUSED_PRESERVE src0_sel:WORD_1\n\t"                                  \
    OP " %2, %2 dst_sel:WORD_1 dst_unused:UNUSED_PRESERVE src0_sel:WORD_1\n\t" OP " %3, %3 dst_sel:WORD_1 dst_unused:UNUSED_PRESERVE src0_sel:WORD_1\n\ts_nop 0" : "+v"(a), "+v"(b), "+v"(c), "+v"(d))
struct EpiGlu {
    static constexpr bool PERM = true;
    bf16_t* G; const rss_t* rowss; const u32x4* cwt; int chunk; LAS float* xl; bf16_t* EB; bf16_t* G2; int gsplit;
    __device__ __forceinline__ void operator()(f32x4 (&acc)[2][2][4][2], const Unit& u, int wr, int wc, int fr, int fq) const {
        const int ch0 = u.pn * 128 + wc * 32 + 8 * fq;
        const int tidw = (wr * 4 + wc) * 64 + fq * 16 + fr; LAS unsigned char* wl = (LAS unsigned char*)xl + 12288; LAS unsigned* xu = (LAS unsigned*)xl;
        u32x4 wrec = (u32x4){0u, 0u, 0u, 0u}; if (tidw < 128) wrec = cwt[u.pn * 128 + tidw];
        int rowi[2][4]; unsigned stmask = 0u; unsigned hh[2][2][4][4];
        { rss_t rv[2][4];
#pragma unroll
          for (int ai = 0; ai < 2; ++ai)
#pragma unroll
            for (int m = 0; m < 4; ++m) { const int RL = ai * HALF + wr * 64 + 4 * fr + m; bool valid; const int row = ffn_tile_row(u.pm, ai * HALF + wr * 64 + m * 16 + fr, chunk, valid); rowi[ai][m] = row; rv[ai][m] = rowss[row];
                const int gt = chunk * FFN_CHUNK + row, pos = tok_pos(gt), S = tok_seqlen(gt);
                const bool st = !((RL == 0 && pos != 0) || (RL == 255 && pos != S - 1)); (void)valid;
                stmask |= st ? (1u << (ai * 4 + m)) : 0u; }
#pragma unroll
          for (int ai = 0; ai < 2; ++ai)
#pragma unroll
            for (int m = 0; m < 4; ++m) { const float rx = ss_rstd(rv[ai][m]); const h2_t r2 = {(_Float16)rx, (_Float16)rx};
#pragma unroll
                for (int bj = 0; bj < 2; ++bj)
#pragma unroll
                    for (int n = 0; n < 2; ++n)
#pragma unroll
                        for (int jp = 0; jp < 2; ++jp) hh[ai][bj][m][2 * n + jp] = h2u(__builtin_bit_cast(h2_t, __builtin_amdgcn_cvt_pkrtz(acc[ai][bj][m][n][2 * jp], acc[ai][bj][m][n][2 * jp + 1])) * r2); } }
        if (wr == 0 && fr == 0) {
#pragma unroll
            for (int m = 0; m < 2; ++m)
#pragma unroll
                for (int bj = 0; bj < 2; ++bj) *(u32x4*)(EB + (size_t)(u.pm * 4 + m) * UP_W + bj * D_FF + ch0) = (u32x4){hh[0][bj][m][0], hh[0][bj][m][1], hh[0][bj][m][2], hh[0][bj][m][3]}; }
        if (wr == 1 && fr == 15) {
#pragma unroll
            for (int m = 2; m < 4; ++m)
#pragma unroll
                for (int bj = 0; bj < 2; ++bj) *(u32x4*)(EB + (size_t)(u.pm * 4 + m) * UP_W + bj * D_FF + ch0) = (u32x4){hh[1][bj][m][0], hh[1][bj][m][1], hh[1][bj][m][2], hh[1][bj][m][3]}; }
#pragma unroll
        for (int ai = 0; ai < 2; ++ai) { const int s1 = 2 * ai + wr + 1;
            if (fr == 0) {
#pragma unroll
                for (int bj = 0; bj < 2; ++bj) *(LAS u32x4*)(xu + ((s1 * 2 + 0) * 4 + wc) * 32 + bj * 16 + 4 * fq) = (u32x4){hh[ai][bj][0][0], hh[ai][bj][0][1], hh[ai][bj][0][2], hh[ai][bj][0][3]}; }
            if (fr == 15) {
#pragma unroll
                for (int bj = 0; bj < 2; ++bj) *(LAS u32x4*)(xu + ((s1 * 2 + 1) * 4 + wc) * 32 + bj * 16 + 4 * fq) = (u32x4){hh[ai][bj][3][0], hh[ai][bj][3][1], hh[ai][bj][3][2], hh[ai][bj][3][3]}; } }
        if (tidw < 128) *(LAS u32x4*)(wl + tidw * 16) = wrec;
        asm volatile("s_waitcnt lgkmcnt(0)" ::: "memory"); __builtin_amdgcn_s_barrier(); asm volatile("" ::: "memory");
        const h2_t c1 = {(_Float16)-0.10294324f, (_Float16)-0.10294324f}, c0 = {(_Float16)-2.3022082f, (_Float16)-2.3022082f}, one = {(_Float16)1.0f, (_Float16)1.0f};
        unsigned wq[2][2][4][2];
#pragma unroll
        for (int n = 0; n < 2; ++n) { unsigned (&wp)[2][4][2] = wq[n];
#pragma unroll
            for (int jp = 0; jp < 2; ++jp) { const int q = 2 * n + jp;
                const u32x4 wg = *(const LAS u32x4*)(wl + (wc * 16 + 4 * fq + q) * 32), wv = *(const LAS u32x4*)(wl + (wc * 16 + 4 * fq + q) * 32 + 16);
#pragma unroll
                for (int ai = 0; ai < 2; ++ai) { const int s1 = 2 * ai + wr + 1; h2_t cg[4], cv[4];
                    const LAS unsigned* xp = xu + (((s1 - 1) * 2 + 1) * 4 + wc) * 32 + 4 * fq + q; const LAS unsigned* xn = xu + (((s1 + 1) * 2 + 0) * 4 + wc) * 32 + 4 * fq + q;
                    { const unsigned pe = xp[0], ne = xn[0]; const unsigned r3 = dppu_ror1(hh[ai][0][3][q]), l0 = dppu_ror15(hh[ai][0][0][q]);
                      const h2_t w0 = u2h(wg.x), w1 = u2h(wg.y), w2 = u2h(wg.z), wb = u2h(wg.w);
#pragma unroll
                      for (int m = 0; m < 4; ++m) { const unsigned pv = m ? hh[ai][0][m ? m - 1 : 0][q] : (fr == 0 ? pe : r3), nx = m < 3 ? hh[ai][0][m < 3 ? m + 1 : 3][q] : (fr == 15 ? ne : l0);
                          cg[m] = wb + w0 * u2h(pv) + w1 * u2h(hh[ai][0][m][q]) + w2 * u2h(nx); } }
                    { const unsigned pe = xp[16], ne = xn[16]; const unsigned r3 = dppu_ror1(hh[ai][1][3][q]), l0 = dppu_ror15(hh[ai][1][0][q]);
                      const h2_t w0 = u2h(wv.x), w1 = u2h(wv.y), w2 = u2h(wv.z), wb = u2h(wv.w);
#pragma unroll
                      for (int m = 0; m < 4; ++m) { const unsigned pv = m ? hh[ai][1][m ? m - 1 : 0][q] : (fr == 0 ? pe : r3), nx = m < 3 ? hh[ai][1][m < 3 ? m + 1 : 3][q] : (fr == 15 ? ne : l0);
                          cv[m] = wb + w0 * u2h(pv) + w1 * u2h(hh[ai][1][m][q]) + w2 * u2h(nx); } }
                    unsigned e0 = h2u(cg[0] * (cg[0] * cg[0] * c1 + c0)), e1 = h2u(cg[1] * (cg[1] * cg[1] * c1 + c0)), e2 = h2u(cg[2] * (cg[2] * cg[2] * c1 + c0)), e3 = h2u(cg[3] * (cg[3] * cg[3] * c1 + c0));
                    H2X4_TRANS("v_exp_f16_sdwa", e0, e1, e2, e3);
                    e0 = h2u(u2h(e0) + one); e1 = h2u(u2h(e1) + one); e2 = h2u(u2h(e2) + one); e3 = h2u(u2h(e3) + one);
                    H2X4_TRANS("v_rcp_f16_sdwa", e0, e1, e2, e3);
                    wp[ai][0][jp] = h2u(cg[0] * u2h(e0) * cv[0]); wp[ai][1][jp] = h2u(cg[1] * u2h(e1) * cv[1]); wp[ai][2][jp] = h2u(cg[2] * u2h(e2) * cv[2]); wp[ai][3][jp] = h2u(cg[3] * u2h(e3) * cv[3]);
                    asm volatile("" : "+v"(wp[ai][0][jp]), "+v"(wp[ai][1][jp]), "+v"(wp[ai][2][jp]), "+v"(wp[ai][3][jp])); } }
            asm volatile("" ::: "memory"); }
#pragma unroll
        for (int ai = 0; ai < 2; ++ai)
#pragma unroll
            for (int m = 0; m < 4; ++m) { const u32x4 q = {wq[0][ai][m][0], wq[0][ai][m][1], wq[1][ai][m][0], wq[1][ai][m][1]}; if (stmask & (1u << (ai * 4 + m))) *(u32x4*)((u.pm < gsplit ? G : G2) + (size_t)rowi[ai][m] * D_FF + ch0) = q; }
    }
};
__device__ __forceinline__ void ffn_fix_item(const bf16_t* EB, const u32x4* cwt, bf16_t* G, bf16_t* G2, int gsplit_row, int t, int cb, int lane) {
    const int ti = (t >> 8) - 1, ch = cb * 512 + lane * 8;
    const bf16_t* ea = EB + (size_t)(ti * 4 + 2) * UP_W + ch; const bf16_t* ec = EB + (size_t)((ti + 1) * 4) * UP_W + ch;
    u32x4 ug[4], uv[4], w[8];
    ug[0] = *(const u32x4*)ea; uv[0] = *(const u32x4*)(ea + D_FF); ug[1] = *(const u32x4*)(ea + UP_W); uv[1] = *(const u32x4*)(ea + UP_W + D_FF);
    ug[2] = *(const u32x4*)ec; uv[2] = *(const u32x4*)(ec + D_FF); ug[3] = *(const u32x4*)(ec + UP_W); uv[3] = *(const u32x4*)(ec + UP_W + D_FF);
#pragma unroll
    for (int k = 0; k < 8; ++k) w[k] = cwt[(ch >> 1) * 2 + k];
    const h2_t c1 = {(_Float16)-0.10294324f, (_Float16)-0.10294324f}, c0 = {(_Float16)-2.3022082f, (_Float16)-2.3022082f}, one = {(_Float16)1.0f, (_Float16)1.0f};
    u32x4 oa, ob;
#pragma unroll
    for (int qp = 0; qp < 2; ++qp) { h2_t cg[4], cv[4];
#pragma unroll
        for (int qq = 0; qq < 2; ++qq) { const int q = 2 * qp + qq; const u32x4 wg = w[2 * q], wv = w[2 * q + 1];
            cg[2 * qq + 0] = u2h(wg.w) + u2h(wg.x) * u2h(ug[0][q]) + u2h(wg.y) * u2h(ug[1][q]) + u2h(wg.z) * u2h(ug[2][q]);
            cg[2 * qq + 1] = u2h(wg.w) + u2h(wg.x) * u2h(ug[1][q]) + u2h(wg.y) * u2h(ug[2][q]) + u2h(wg.z) * u2h(ug[3][q]);
            cv[2 * qq + 0] = u2h(wv.w) + u2h(wv.x) * u2h(uv[0][q]) + u2h(wv.y) * u2h(uv[1][q]) + u2h(wv.z) * u2h(uv[2][q]);
            cv[2 * qq + 1] = u2h(wv.w) + u2h(wv.x) * u2h(uv[1][q]) + u2h(wv.y) * u2h(uv[2][q]) + u2h(wv.z) * u2h(uv[3][q]); }
        unsigned e0 = h2u(cg[0] * (cg[0] * cg[0] * c1 + c0)), e1 = h2u(cg[1] * (cg[1] * cg[1] * c1 + c0)), e2 = h2u(cg[2] * (cg[2] * cg[2] * c1 + c0)), e3 = h2u(cg[3] * (cg[3] * cg[3] * c1 + c0));
        H2X4_TRANS("v_exp_f16_sdwa", e0, e1, e2, e3);
        e0 = h2u(u2h(e0) + one); e1 = h2u(u2h(e1) + one); e2 = h2u(u2h(e2) + one); e3 = h2u(u2h(e3) + one);
        H2X4_TRANS("v_rcp_f16_sdwa", e0, e1, e2, e3);
        oa[2 * qp] = h2u(cg[0] * u2h(e0) * cv[0]); ob[2 * qp] = h2u(cg[1] * u2h(e1) * cv[1]); oa[2 * qp + 1] = h2u(cg[2] * u2h(e2) * cv[2]); ob[2 * qp + 1] = h2u(cg[3] * u2h(e3) * cv[3]); }
    *(u32x4*)((t - 1 < gsplit_row ? G : G2) + (size_t)(t - 1) * D_FF + ch) = oa; *(u32x4*)((t < gsplit_row ? G : G2) + (size_t)t * D_FF + ch) = ob;
}
struct EpiKV {
    static constexpr bool PERM = false;
    float* kraw; bf16_t* vT;
    __device__ __forceinline__ void operator()(const f32x4 (&acc)[2][2][4][2], const Unit& u, int wr, int wc, int fr, int fq) const {
        const int key0 = wr * 64 + fr, col0 = u.pn * BM + wc * 32 + 4 * fq;
        if (u.pn < 8) {
#pragma unroll
            for (int ai = 0; ai < 2; ++ai)
#pragma unroll
                for (int m = 0; m < 4; ++m) { float* rowp = kraw + (size_t)(u.pm * BM + key0 + ai * HALF + m * 16) * 2048 + col0;
#pragma unroll
                    for (int bj = 0; bj < 2; ++bj)
#pragma unroll
                        for (int n = 0; n < 2; ++n) *(f32x4*)(rowp + bj * HALF + n * 16) = acc[ai][bj][m][n]; }
        } else {
#pragma unroll
            for (int ai = 0; ai < 2; ++ai)
#pragma unroll
                for (int m = 0; m < 4; ++m) { bf16_t* rowp = vT + (size_t)(u.pm * BM + key0 + ai * HALF + m * 16) * 2048 + (col0 - 2048);
#pragma unroll
                    for (int bj = 0; bj < 2; ++bj)
#pragma unroll
                        for (int n = 0; n < 2; ++n) { const f32x4 v = acc[ai][bj][m][n]; u32x2 w; w.x = cvt_pk_bf16(v[0], v[1]); w.y = cvt_pk_bf16(v[2], v[3]); *(u32x2*)(rowp + bj * HALF + n * 16) = w; } }
        }
    }
};
}

namespace att {
constexpr int KVBLK = 64, SHM_V = 16384, SHM_K = 16384, OFF_V = 0, OFF_K = 3 * SHM_V, OFF_WS = 3 * SHM_V + 3 * SHM_K, LDP = 1024;
#define KSWZ(row, colB) ((row) * 256 + ((colB) ^ (((row) & 15) << 4)))
#define SBAR() __builtin_amdgcn_sched_barrier(0)
__device__ __forceinline__ int crow(int r, int hi) { return (r & 3) + 8 * (r >> 2) + 4 * hi; }
__device__ __forceinline__ void partialSM(f32x16& p0) {
#pragma unroll
  for (int r = 0; r < 16; ++r) p0[r] = __builtin_amdgcn_exp2f(p0[r]);
}
__device__ __forceinline__ void finishSM(f32x16& p0, f32x16& p1, float& l_reg, bf16x8& pa0, bf16x8& pa1, bf16x8& pa2, bf16x8& pa3) {
#pragma unroll
  for (int r = 0; r < 16; ++r) p1[r] = __builtin_amdgcn_exp2f(p1[r]);
  float ps = 0;
#pragma unroll
  for (int r = 0; r < 16; ++r) ps += p0[r];
#pragma unroll
  for (int r = 0; r < 16; ++r) ps += p1[r];
  l_reg += ps;
#define PK4(P, BASE, OUT) do { unsigned a0 = cvt_pk_bf16(P[BASE + 0], P[BASE + 1]), a1 = cvt_pk_bf16(P[BASE + 2], P[BASE + 3]);   \
    unsigned b0 = cvt_pk_bf16(P[BASE + 4], P[BASE + 5]), b1 = cvt_pk_bf16(P[BASE + 6], P[BASE + 7]);                              \
    auto r0 = __builtin_amdgcn_permlane32_swap(a0, b0, false, false); auto r1 = __builtin_amdgcn_permlane32_swap(a1, b1, false, false); \
    u32x4 w = {r0[0], r1[0], r0[1], r1[1]}; OUT = __builtin_bit_cast(bf16x8, w); } while (0)
  PK4(p0, 0, pa0); PK4(p0, 8, pa1); PK4(p1, 0, pa2); PK4(p1, 8, pa3);
#undef PK4
}
__device__ __forceinline__ void finishSM_tail(f32x16& p0, f32x16& p1, float& l_reg, bf16x8& pa0, bf16x8& pa1, bf16x8& pa2, bf16x8& pa3) {
  float ps = 0;
#pragma unroll
  for (int r = 0; r < 16; ++r) ps += p0[r];
#pragma unroll
  for (int r = 0; r < 16; ++r) ps += p1[r];
  l_reg += ps;
#define PK4(P, BASE, OUT) do { unsigned a0 = cvt_pk_bf16(P[BASE + 0], P[BASE + 1]), a1 = cvt_pk_bf16(P[BASE + 2], P[BASE + 3]);   \
    unsigned b0 = cvt_pk_bf16(P[BASE + 4], P[BASE + 5]), b1 = cvt_pk_bf16(P[BASE + 6], P[BASE + 7]);                              \
    u32x4 w = {a0, a1, b0, b1}; OUT = __builtin_bit_cast(bf16x8, w); } while (0)
  PK4(p0, 0, pa0); PK4(p0, 8, pa1); PK4(p1, 0, pa2); PK4(p1, 8, pa3);
#undef PK4
}
__device__ __forceinline__ void qkt(f32x16& p0, f32x16& p1, const LAS unsigned char* Ks, const bf16x8* qr, int r32, int hi, int cbase) {
  p0 = f32x16{}; p1 = f32x16{}; bf16x8 b0[4], b1[4];
#pragma unroll
  for (int d0 = 0; d0 < 4; ++d0) { const int cb = cbase + (d0 * 16 + hi * 8) * 2;
    b0[d0] = *(const LAS bf16x8*)(Ks + KSWZ(r32, cb)); b1[d0] = *(const LAS bf16x8*)(Ks + KSWZ(32 + r32, cb)); }
#define QK_STEP(D, N) do { asm volatile("s_waitcnt lgkmcnt(" #N ")" ::: "memory"); SBAR(); \
    p0 = __builtin_amdgcn_mfma_f32_32x32x16_bf16(b0[D], qr[D], p0, 0, 0, 0); p1 = __builtin_amdgcn_mfma_f32_32x32x16_bf16(b1[D], qr[D], p1, 0, 0, 0); } while (0)
  QK_STEP(0, 6); QK_STEP(1, 4); QK_STEP(2, 2); QK_STEP(3, 0);
#undef QK_STEP
}
__device__ __forceinline__ int v_st(int k, int c) { const int kk = k; return ((kk >> 3) * 4 + (c >> 5)) * 512 + ((kk & 7) * 32 + (c & 31)) * 2; }
__device__ __forceinline__ int v_rd_base(int lane) { return ((lane & 3) << 3) | (((lane >> 2) & 3) << 6) | (((lane >> 4) & 1) << 5) | (((lane >> 5) & 1) << 8); }
constexpr int v_rd_off(int d0, int ks, int half) { return d0 * 512 + ks * 4096 + half * 2048; }
template <int OFF> __device__ __forceinline__ s16x4 tr_read(int vb) {
  s16x4 r; asm volatile("ds_read_b64_tr_b16 %0, %1 offset:%2" : "=&v"(r) : "v"(vb), "i"(OFF) : "memory"); return r;
}
struct VFrag { s16x4 l0, h0, l1, h1, l2, h2, l3, h3; };
template <int D0> __device__ __forceinline__ void pv_read(VFrag& f, int vb) {
  f.l0 = tr_read<v_rd_off(D0, 0, 0)>(vb); f.h0 = tr_read<v_rd_off(D0, 0, 1)>(vb); f.l1 = tr_read<v_rd_off(D0, 1, 0)>(vb); f.h1 = tr_read<v_rd_off(D0, 1, 1)>(vb);
  f.l2 = tr_read<v_rd_off(D0, 2, 0)>(vb); f.h2 = tr_read<v_rd_off(D0, 2, 1)>(vb); f.l3 = tr_read<v_rd_off(D0, 3, 0)>(vb); f.h3 = tr_read<v_rd_off(D0, 3, 1)>(vb);
}
__device__ __forceinline__ void pv_mma(f32x16& od, const VFrag& f, bf16x8 pa0, bf16x8 pa1, bf16x8 pa2, bf16x8 pa3) {
#define PKV(L, H) (bf16x8){L[0], L[1], L[2], L[3], H[0], H[1], H[2], H[3]}
  od = __builtin_amdgcn_mfma_f32_32x32x16_bf16(pa0, PKV(f.l0, f.h0), od, 0, 0, 0);
  od = __builtin_amdgcn_mfma_f32_32x32x16_bf16(pa1, PKV(f.l1, f.h1), od, 0, 0, 0);
  od = __builtin_amdgcn_mfma_f32_32x32x16_bf16(pa2, PKV(f.l2, f.h2), od, 0, 0, 0);
  od = __builtin_amdgcn_mfma_f32_32x32x16_bf16(pa3, PKV(f.l3, f.h3), od, 0, 0, 0);
#undef PKV
}
__device__ __forceinline__ void pv_d0(f32x16* o, int vb, bf16x8 pa0, bf16x8 pa1, bf16x8 pa2, bf16x8 pa3) {
  VFrag fa, fb;
  pv_read<0>(fa, vb); pv_read<1>(fb, vb);
  asm volatile("s_waitcnt lgkmcnt(8)" ::: "memory"); SBAR(); pv_mma(o[0], fa, pa0, pa1, pa2, pa3); SBAR();
  pv_read<2>(fa, vb);
  asm volatile("s_waitcnt lgkmcnt(8)" ::: "memory"); SBAR(); pv_mma(o[1], fb, pa0, pa1, pa2, pa3); SBAR();
  pv_read<3>(fb, vb);
  asm volatile("s_waitcnt lgkmcnt(8)" ::: "memory"); SBAR(); pv_mma(o[2], fa, pa0, pa1, pa2, pa3); SBAR();
  asm volatile("s_waitcnt lgkmcnt(0)" ::: "memory"); SBAR(); pv_mma(o[3], fb, pa0, pa1, pa2, pa3);
}
__device__ __forceinline__ void att_step(f32x16& s0, f32x16& s1, const LAS unsigned char* Ks, const bf16x8* qr, int r32, int hi, int cbase,
                                         f32x16& e0, f32x16& e1, float& l_reg, bf16x8& pa0, bf16x8& pa1, bf16x8& pa2, bf16x8& pa3, f32x16* o, int vb) {
  bf16x8 b0[4], b1[4]; VFrag fa, fb; float ps = 0.f; u32x4 w0, w1, w2, w3;
#pragma unroll
  for (int d0 = 0; d0 < 4; ++d0) { const int cb = cbase + (d0 * 16 + hi * 8) * 2;
    b0[d0] = *(const LAS bf16x8*)(Ks + KSWZ(r32, cb)); b1[d0] = *(const LAS bf16x8*)(Ks + KSWZ(32 + r32, cb)); }
  s0 = f32x16{}; s1 = f32x16{};
#define PACK_H(E, BASE, H, W) do { ps += E[BASE + 2 * H]; ps += E[BASE + 2 * H + 1]; ps += E[BASE + 4 + 2 * H]; ps += E[BASE + 5 + 2 * H];                       \
    const unsigned a_ = cvt_pk_bf16(E[BASE + 2 * H], E[BASE + 2 * H + 1]), b_ = cvt_pk_bf16(E[BASE + 4 + 2 * H], E[BASE + 5 + 2 * H]);                       \
    W[H] = a_; W[2 + H] = b_; } while (0)
#define QK_STEP(D, N, PRE, PK_A, PK_B) do { asm volatile("s_waitcnt lgkmcnt(" #N ")" ::: "memory"); PRE; SBAR();                                                  \
    s0 = __builtin_amdgcn_mfma_f32_32x32x16_bf16(b0[D], qr[D], s0, 0, 0, 0); SBAR(); PK_A; SBAR();                                                                 \
    s1 = __builtin_amdgcn_mfma_f32_32x32x16_bf16(b1[D], qr[D], s1, 0, 0, 0); SBAR(); PK_B; SBAR(); } while (0)
  QK_STEP(0, 6, (void)0, PACK_H(e0, 0, 0, w0), PACK_H(e0, 0, 1, w0));
  QK_STEP(1, 4, (void)0, PACK_H(e0, 8, 0, w1), PACK_H(e0, 8, 1, w1));
  QK_STEP(2, 2, (void)0, PACK_H(e1, 0, 0, w2), PACK_H(e1, 0, 1, w2));
  QK_STEP(3, 0, (pv_read<0>(fa, vb), pv_read<1>(fb, vb)), PACK_H(e1, 8, 0, w3), PACK_H(e1, 8, 1, w3));
#undef QK_STEP
#undef PACK_H
  l_reg += ps;
  pa0 = __builtin_bit_cast(bf16x8, w0); pa1 = __builtin_bit_cast(bf16x8, w1); pa2 = __builtin_bit_cast(bf16x8, w2); pa3 = __builtin_bit_cast(bf16x8, w3);
#define PKV(L, H) (bf16x8){L[0], L[1], L[2], L[3], H[0], H[1], H[2], H[3]}
#define EX2(X, I) do { X[I] = __builtin_amdgcn_exp2f(X[I]); X[I + 1] = __builtin_amdgcn_exp2f(X[I + 1]); } while (0)
#define PV_BLK(D0, F, N, X, XB) do { asm volatile("s_waitcnt lgkmcnt(" #N ")" ::: "memory"); SBAR();                                                              \
    o[D0] = __builtin_amdgcn_mfma_f32_32x32x16_bf16(pa0, PKV(F.l0, F.h0), o[D0], 0, 0, 0); SBAR(); EX2(X, XB + 0); SBAR();                                         \
    o[D0] = __builtin_amdgcn_mfma_f32_32x32x16_bf16(pa1, PKV(F.l1, F.h1), o[D0], 0, 0, 0); SBAR(); EX2(X, XB + 2); SBAR();                                         \
    o[D0] = __builtin_amdgcn_mfma_f32_32x32x16_bf16(pa2, PKV(F.l2, F.h2), o[D0], 0, 0, 0); SBAR(); EX2(X, XB + 4); SBAR();                                         \
    o[D0] = __builtin_amdgcn_mfma_f32_32x32x16_bf16(pa3, PKV(F.l3, F.h3), o[D0], 0, 0, 0); SBAR(); EX2(X, XB + 6); SBAR(); } while (0)
  PV_BLK(0, fa, 8, s0, 0); pv_read<2>(fa, vb);
  PV_BLK(1, fb, 8, s0, 8); pv_read<3>(fb, vb);
  PV_BLK(2, fa, 8, s1, 0);
  PV_BLK(3, fb, 0, s1, 8);
#undef PV_BLK
#undef EX2
#undef PKV
}
__device__ __forceinline__ void attn_unit(const bf16_t* Qg, const bf16_t* __restrict__ Kg, const bf16_t* __restrict__ Vg, bf16_t* Og, int seq, float lam, const float* gsub, float oscale, LAS unsigned char* lds) {
  int tid_l = threadIdx.x; asm volatile("" : "+v"(tid_l));
  const int tid = tid_l, wid = __builtin_amdgcn_readfirstlane(tid >> 6), lane = tid & 63, r32 = lane & 31, hi = lane >> 5;
  const int comp = wid & 1, rg = wid >> 1, cbase = comp * 128;
  LAS unsigned char* V_lds = lds + OFF_V; LAS unsigned char* K_lds = lds + OFF_K;
  LAS float* wsf = (LAS float*)(lds + OFF_WS) + wid * 64; LAS float* li_l = wsf;
  float l_reg = 0; f32x16 o[4] = {}; bf16x8 qr[4];
  const bf16_t* Qw = Qg + (size_t)(rg * 32 + r32) * LDP + comp * 64 + hi * 8;
#pragma unroll
  for (int d0 = 0; d0 < 4; ++d0) qr[d0] = *(const bf16x8*)(Qw + d0 * 16);
  unsigned koff[2], voff[2];
#pragma unroll
  for (int i = 0; i < 2; ++i) { const int L = (tid + 512 * i) * 16; { const int row = L >> 8, colB = (L & 255) ^ ((row & 15) << 4); koff[i] = (unsigned)(row * LDP * 2 + colB); }
    { const int sub = L >> 9, w = L & 511, kk = (sub >> 2) * 8 + (w >> 6), c = (sub & 3) * 32 + ((w & 63) >> 1), k = kk; voff[i] = (unsigned)(k * LDP * 2 + c * 2); } }
  const int vbb = (int)(unsigned)(size_t)V_lds + v_rd_base(lane);
  const int NT = seq / KVBLK; const size_t tstep = (size_t)KVBLK * LDP * 2;
#define DMA_K(t) do { const int t_ = (t) < NT ? (t) : NT - 1; const char* g_ = (const char*)Kg + (size_t)t_ * tstep; LAS unsigned char* d_ = K_lds + (t_ % 3) * SHM_K + wid * 1024; \
    __builtin_amdgcn_global_load_lds((const unsigned*)(g_ + koff[0]), (LAS unsigned*)d_, 16, 0, 0); __builtin_amdgcn_global_load_lds((const unsigned*)(g_ + koff[1]), (LAS unsigned*)(d_ + 8192), 16, 0, 0); } while (0)
#define DMA_V(t) do { const int t_ = (t) < NT ? (t) : NT - 1; const char* g_ = (const char*)Vg + (size_t)t_ * tstep; LAS unsigned char* d_ = V_lds + (t_ % 3) * SHM_V + wid * 1024; \
    __builtin_amdgcn_global_load_lds((const unsigned*)(g_ + voff[0]), (LAS unsigned*)d_, 16, 0, 0); __builtin_amdgcn_global_load_lds((const unsigned*)(g_ + voff[1]), (LAS unsigned*)(d_ + 8192), 16, 0, 0); } while (0)
#define WAIT4_BAR() do { asm volatile("s_waitcnt vmcnt(4)" ::: "memory"); __builtin_amdgcn_s_barrier(); asm volatile("" ::: "memory"); } while (0)
  f32x16 pA0, pA1, pB0, pB1; bf16x8 pa0, pa1, pa2, pa3;
  DMA_K(0); DMA_K(1); DMA_V(0);
  WAIT4_BAR();
  DMA_K(2); DMA_V(1);
  qkt(pA0, pA1, K_lds, qr, r32, hi, cbase); partialSM(pA0); partialSM(pA1);
  int sk = 1, sv = 0;
  for (int j = 1; j + 1 < NT; j += 2) {
    WAIT4_BAR(); DMA_K(j + 2); DMA_V(j + 1);
    SBAR(); att_step(pB0, pB1, K_lds + sk * SHM_K, qr, r32, hi, cbase, pA0, pA1, l_reg, pa0, pa1, pa2, pa3, o, vbb + sv * SHM_V); SBAR();
    sk = sk == 2 ? 0 : sk + 1; sv = sv == 2 ? 0 : sv + 1;
    WAIT4_BAR(); DMA_K(j + 3); DMA_V(j + 2);
    SBAR(); att_step(pA0, pA1, K_lds + sk * SHM_K, qr, r32, hi, cbase, pB0, pB1, l_reg, pa0, pa1, pa2, pa3, o, vbb + sv * SHM_V); SBAR();
    sk = sk == 2 ? 0 : sk + 1; sv = sv == 2 ? 0 : sv + 1;
  }
  WAIT4_BAR(); DMA_K(NT + 1); DMA_V(NT);
  SBAR(); att_step(pB0, pB1, K_lds + sk * SHM_K, qr, r32, hi, cbase, pA0, pA1, l_reg, pa0, pa1, pa2, pa3, o, vbb + sv * SHM_V); SBAR();
  sv = sv == 2 ? 0 : sv + 1;
  WAIT4_BAR();
  finishSM_tail(pB0, pB1, l_reg, pa0, pa1, pa2, pa3); SBAR();
  pv_d0(o, vbb + sv * SHM_V, pa0, pa1, pa2, pa3);
  asm volatile("s_waitcnt vmcnt(0)" ::: "memory");
#undef DMA_K
#undef DMA_V
#undef WAIT4_BAR
  { auto rr = __builtin_amdgcn_permlane32_swap(__float_as_uint(l_reg), __float_as_uint(l_reg), false, false); l_reg = __uint_as_float(rr[0]) + __uint_as_float(rr[1]); }
  if (hi == 0) li_l[r32] = l_reg; asm volatile("s_waitcnt lgkmcnt(0)" ::: "memory");
  float rli[16];
#pragma unroll
  for (int r = 0; r < 16; ++r) rli[r] = __builtin_amdgcn_rcpf(li_l[crow(r, hi)]);
  __syncthreads();
  LAS float* X = (LAS float*)(lds) + rg * 4096 + lane;
  if (comp == 1) {
#pragma unroll
    for (int d0 = 0; d0 < 4; ++d0)
#pragma unroll
      for (int r = 0; r < 16; ++r) X[(d0 * 16 + r) * 64] = o[d0][r] * rli[r] * lam;
  }
  __syncthreads();
  if (comp == 0) {
    float ss[16];
#pragma unroll
    for (int r = 0; r < 16; ++r) ss[r] = 0.f;
#pragma unroll
    for (int d0 = 0; d0 < 4; ++d0)
#pragma unroll
      for (int r = 0; r < 16; ++r) { const float v = o[d0][r] * rli[r] - X[(d0 * 16 + r) * 64]; o[d0][r] = v; ss[r] += v * v; }
#pragma unroll
    for (int r = 0; r < 16; ++r) { float s = ss[r]; s += __shfl_xor(s, 1); s += __shfl_xor(s, 2); s += __shfl_xor(s, 4); s += __shfl_xor(s, 8); s += __shfl_xor(s, 16);
      ss[r] = __builtin_amdgcn_rsqf(s * (1.0f / 128.0f) + EPS) * oscale; }
    bf16_t* Ow = Og + (size_t)(rg * 32) * LDP;
#pragma unroll
    for (int d0 = 0; d0 < 4; ++d0) { const float g = gsub[d0 * 32 + r32];
#pragma unroll
#ifdef PROBE_ZERO_ATTN
      for (int r = 0; r < 16; ++r) Ow[(size_t)crow(r, hi) * LDP + d0 * 32 + r32] = (bf16_t)0;
#else
      for (int r = 0; r < 16; ++r) Ow[(size_t)crow(r, hi) * LDP + d0 * 32 + r32] = (bf16_t)(cvt_pk_bf16(o[d0][r] * ss[r] * g, 0.f) & 0xffffu);
#endif
    }
  }
  __syncthreads();
}
}


namespace att16 {
using att::KVBLK; using att::SHM_V; using att::SHM_K; using att::OFF_V; using att::OFF_K; using att::OFF_WS; using att::LDP;
typedef f32x4 S8[4][2];
__device__ __forceinline__ f32x4 mma16(bf16x8 a, bf16x8 b, f32x4 c) { return __builtin_amdgcn_mfma_f32_16x16x32_bf16(a, b, c, 0, 0, 0); }
template <int OFF> __device__ __forceinline__ s16x4 tr_read(int vb) { s16x4 r; asm volatile("ds_read_b64_tr_b16 %0, %1 offset:%2" : "=&v"(r) : "v"(vb), "i"(OFF) : "memory"); return r; }
struct VF { s16x4 l0, h0, l1, h1; };
constexpr int v_off(int db, int ks, int half) { return ks * 8192 + half * 4096 + (db >> 1) * 512; }
template <int DP> __device__ __forceinline__ void pv_read(VF& fe, VF& fo, int vbe, int vbo) {
  fe.l0 = tr_read<v_off(2 * DP, 0, 0)>(vbe); fe.h0 = tr_read<v_off(2 * DP, 0, 1)>(vbe); fe.l1 = tr_read<v_off(2 * DP, 1, 0)>(vbe); fe.h1 = tr_read<v_off(2 * DP, 1, 1)>(vbe);
  fo.l0 = tr_read<v_off(2 * DP + 1, 0, 0)>(vbo); fo.h0 = tr_read<v_off(2 * DP + 1, 0, 1)>(vbo); fo.l1 = tr_read<v_off(2 * DP + 1, 1, 0)>(vbo); fo.h1 = tr_read<v_off(2 * DP + 1, 1, 1)>(vbo);
}
#define PKV16(L, H) (bf16x8){L[0], L[1], L[2], L[3], H[0], H[1], H[2], H[3]}
__device__ __forceinline__ void kf_read(bf16x8 (&kf)[4][2], const LAS unsigned char* Ks, int c16, int g, int cbase) {
#pragma unroll
  for (int kb = 0; kb < 4; ++kb)
#pragma unroll
    for (int ks = 0; ks < 2; ++ks) kf[kb][ks] = *(const LAS bf16x8*)(Ks + KSWZ(16 * kb + c16, cbase + (32 * ks + 8 * g) * 2));
}
__device__ __forceinline__ void qk_first(S8& S, const LAS unsigned char* Ks, const bf16x8 (&qf)[2][2], int c16, int g, int cbase) {
  bf16x8 kf[4][2]; kf_read(kf, Ks, c16, g, cbase);
#pragma unroll
  for (int kb = 0; kb < 4; ++kb)
#pragma unroll
    for (int qb = 0; qb < 2; ++qb) { f32x4 a = {0.f, 0.f, 0.f, 0.f}; a = mma16(kf[kb][0], qf[qb][0], a); a = mma16(kf[kb][1], qf[qb][1], a);
#pragma unroll
      for (int r = 0; r < 4; ++r) a[r] = __builtin_amdgcn_exp2f(a[r]);
      S[kb][qb] = a; }
}
#define ADDF16(acc, x) asm("v_add_f32 %0, %1, %0" : "+v"(acc) : "v"(x))
#define PACK16(E, KS, QB, W) do { const f32x4& e_ = E[2 * (KS) + ((W) >> 1)][QB]; pw[KS][QB][W] = cvt_pk_bf16(e_[2 * ((W) & 1)], e_[2 * ((W) & 1) + 1]); } while (0)
#define LSUM16() do { const bf16x8 on_ = {0x3F80, 0x3F80, 0x3F80, 0x3F80, 0x3F80, 0x3F80, 0x3F80, 0x3F80};                                                        \
    l2[0] = mma16(on_, __builtin_bit_cast(bf16x8, pw[0][0]), l2[0]); l2[1] = mma16(on_, __builtin_bit_cast(bf16x8, pw[0][1]), l2[1]);                               \
    l2[0] = mma16(on_, __builtin_bit_cast(bf16x8, pw[1][0]), l2[0]); l2[1] = mma16(on_, __builtin_bit_cast(bf16x8, pw[1][1]), l2[1]); } while (0)
__device__ __forceinline__ void pack_all(const S8& E, u32x4 (&pw)[2][2]) {
#pragma unroll
  for (int ks = 0; ks < 2; ++ks)
#pragma unroll
    for (int qb = 0; qb < 2; ++qb) { PACK16(E, ks, qb, 0); PACK16(E, ks, qb, 1); PACK16(E, ks, qb, 2); PACK16(E, ks, qb, 3); }
}
#define PV16(DB, F) do { _Pragma("unroll") for (int qb_ = 0; qb_ < 2; ++qb_) { o[DB][qb_] = mma16(PKV16(F.l0, F.h0), __builtin_bit_cast(bf16x8, pw[0][qb_]), o[DB][qb_]); \
    o[DB][qb_] = mma16(PKV16(F.l1, F.h1), __builtin_bit_cast(bf16x8, pw[1][qb_]), o[DB][qb_]); } } while (0)
__device__ __forceinline__ void pv_last(f32x4 (&o)[8][2], const u32x4 (&pw)[2][2], int vbe, int vbo) {
  VF ae, ao, be, bo;
  pv_read<0>(ae, ao, vbe, vbo); pv_read<1>(be, bo, vbe, vbo);
  asm volatile("s_waitcnt lgkmcnt(8)" ::: "memory"); SBAR(); PV16(0, ae); PV16(1, ao); SBAR();
  pv_read<2>(ae, ao, vbe, vbo);
  asm volatile("s_waitcnt lgkmcnt(8)" ::: "memory"); SBAR(); PV16(2, be); PV16(3, bo); SBAR();
  pv_read<3>(be, bo, vbe, vbo);
  asm volatile("s_waitcnt lgkmcnt(8)" ::: "memory"); SBAR(); PV16(4, ae); PV16(5, ao); SBAR();
  asm volatile("s_waitcnt lgkmcnt(0)" ::: "memory"); SBAR(); PV16(6, be); PV16(7, bo);
}
__device__ __forceinline__ void att_step(S8& S, const LAS unsigned char* Ks, const bf16x8 (&qf)[2][2], int c16, int g, int cbase, const S8& E, f32x4 (&l2)[2], f32x4 (&o)[8][2], int vbe, int vbo) {
  bf16x8 kf[4][2]; u32x4 pw[2][2]; VF ae, ao, be, bo;
  kf_read(kf, Ks, c16, g, cbase);
#define QK16(KB, N, PRE, P0, P1, P2, P3) do { asm volatile("s_waitcnt lgkmcnt(" #N ")" ::: "memory"); PRE; SBAR(); f32x4 a0_ = {0.f, 0.f, 0.f, 0.f}, a1_ = {0.f, 0.f, 0.f, 0.f};  \
    a0_ = mma16(kf[KB][0], qf[0][0], a0_); SBAR(); P0; SBAR(); a1_ = mma16(kf[KB][0], qf[1][0], a1_); SBAR(); P1; SBAR();                                     \
    a0_ = mma16(kf[KB][1], qf[0][1], a0_); SBAR(); P2; SBAR(); a1_ = mma16(kf[KB][1], qf[1][1], a1_); SBAR(); P3; SBAR(); S[KB][0] = a0_; S[KB][1] = a1_; } while (0)
  QK16(0, 6, (void)0, PACK16(E, 0, 0, 0), PACK16(E, 0, 0, 1), PACK16(E, 0, 0, 2), PACK16(E, 0, 0, 3));
  QK16(1, 4, (void)0, PACK16(E, 0, 1, 0), PACK16(E, 0, 1, 1), PACK16(E, 0, 1, 2), PACK16(E, 0, 1, 3));
  QK16(2, 2, (void)0, PACK16(E, 1, 0, 0), PACK16(E, 1, 0, 1), PACK16(E, 1, 0, 2), PACK16(E, 1, 0, 3));
  QK16(3, 0, (pv_read<0>(ae, ao, vbe, vbo), pv_read<1>(be, bo, vbe, vbo)), PACK16(E, 1, 1, 0), PACK16(E, 1, 1, 1), PACK16(E, 1, 1, 2), PACK16(E, 1, 1, 3));
#undef QK16
#define EX1(KB, QB, R) S[KB][QB][R] = __builtin_amdgcn_exp2f(S[KB][QB][R])
#define PVX(DB, F, KB) do { o[DB][0] = mma16(PKV16(F.l0, F.h0), __builtin_bit_cast(bf16x8, pw[0][0]), o[DB][0]); SBAR(); EX1(KB, 0, 0); SBAR();                    \
    o[DB][1] = mma16(PKV16(F.l0, F.h0), __builtin_bit_cast(bf16x8, pw[0][1]), o[DB][1]); SBAR(); EX1(KB, 0, 1); SBAR();                                          \
    o[DB][0] = mma16(PKV16(F.l1, F.h1), __builtin_bit_cast(bf16x8, pw[1][0]), o[DB][0]); SBAR(); EX1(KB, 0, 2); SBAR();                                          \
    o[DB][1] = mma16(PKV16(F.l1, F.h1), __builtin_bit_cast(bf16x8, pw[1][1]), o[DB][1]); SBAR(); EX1(KB, 0, 3); SBAR(); } while (0)
#define PVY(DB, F, KB) do { o[DB][0] = mma16(PKV16(F.l0, F.h0), __builtin_bit_cast(bf16x8, pw[0][0]), o[DB][0]); SBAR(); EX1(KB, 1, 0); SBAR();                    \
    o[DB][1] = mma16(PKV16(F.l0, F.h0), __builtin_bit_cast(bf16x8, pw[0][1]), o[DB][1]); SBAR(); EX1(KB, 1, 1); SBAR();                                          \
    o[DB][0] = mma16(PKV16(F.l1, F.h1), __builtin_bit_cast(bf16x8, pw[1][0]), o[DB][0]); SBAR(); EX1(KB, 1, 2); SBAR();                                          \
    o[DB][1] = mma16(PKV16(F.l1, F.h1), __builtin_bit_cast(bf16x8, pw[1][1]), o[DB][1]); SBAR(); EX1(KB, 1, 3); SBAR(); } while (0)
  SBAR(); LSUM16(); SBAR();
  asm volatile("s_waitcnt lgkmcnt(8)" ::: "memory"); SBAR(); PVX(0, ae, 0); PVY(1, ao, 0); pv_read<2>(ae, ao, vbe, vbo);
  asm volatile("s_waitcnt lgkmcnt(8)" ::: "memory"); SBAR(); PVX(2, be, 1); PVY(3, bo, 1); pv_read<3>(be, bo, vbe, vbo);
  asm volatile("s_waitcnt lgkmcnt(8)" ::: "memory"); SBAR(); PVX(4, ae, 2); PVY(5, ao, 2);
  asm volatile("s_waitcnt lgkmcnt(0)" ::: "memory"); SBAR(); PVX(6, be, 3); PVY(7, bo, 3);
#undef PVX
#undef PVY
#undef EX1
}
__device__ __forceinline__ void attn_unit(const bf16_t* Qg, const bf16_t* __restrict__ Kg, const bf16_t* __restrict__ Vg, bf16_t* Og, int seq, float lam, const float* gsub, float oscale, LAS unsigned char* lds, bool rev) {
  int tid_l = threadIdx.x; asm volatile("" : "+v"(tid_l));
  const int tid = tid_l, wid = __builtin_amdgcn_readfirstlane(tid >> 6), lane = tid & 63, c16 = lane & 15, g = lane >> 4;
  const int comp = wid & 1, rg = wid >> 1, cbase = comp * 128;
  LAS unsigned char* V_lds = lds + OFF_V; LAS unsigned char* K_lds = lds + OFF_K;
  LAS float* wsf = (LAS float*)(lds + OFF_WS) + wid * 64; (void)wsf;
  f32x4 l2[2] = {{0.f, 0.f, 0.f, 0.f}, {0.f, 0.f, 0.f, 0.f}}; f32x4 o[8][2]; bf16x8 qf[2][2];
#pragma unroll
  for (int db = 0; db < 8; ++db)
#pragma unroll
    for (int qb = 0; qb < 2; ++qb) o[db][qb] = (f32x4){0.f, 0.f, 0.f, 0.f};
#pragma unroll
  for (int qb = 0; qb < 2; ++qb)
#pragma unroll
    for (int ks = 0; ks < 2; ++ks) qf[qb][ks] = *(const bf16x8*)(Qg + (size_t)(rg * 32 + 16 * qb + c16) * LDP + comp * 64 + 32 * ks + 8 * g);
  unsigned koff[2], voff[2];
#pragma unroll
  for (int i = 0; i < 2; ++i) { const int L = (tid + 512 * i) * 16; { const int row = L >> 8, colB = (L & 255) ^ ((row & 15) << 4); koff[i] = (unsigned)(row * LDP * 2 + colB); }
    { const int sub = L >> 9, w = L & 511, k = (sub >> 2) * 8 + (w >> 6), cl = ((w & 63) >> 1) ^ (((k >> 2) & 1) << 4), c = (sub & 3) * 32 + cl; voff[i] = (unsigned)(k * LDP * 2 + c * 2); } }
  const int vb0 = (int)(unsigned)(size_t)V_lds + (g >> 1) * 2048 + (g & 1) * 256 + ((c16 >> 2) & 3) * 64 + (c16 & 3) * 8;
  const int vbe0 = vb0 + (g & 1) * 32, vbo0 = vb0 + ((g & 1) ^ 1) * 32;
  const int NT = seq / KVBLK; const size_t tstep = (size_t)KVBLK * LDP * 2;
#define DMA_K(t) do { const int t_ = (t) < NT ? (t) : NT - 1; const char* g_ = (const char*)Kg + (size_t)(rev ? ((t_ + (NT >> 1)) & (NT - 1)) : t_) * tstep; LAS unsigned char* d_ = K_lds + (t_ % 3) * SHM_K + wid * 1024; \
    __builtin_amdgcn_global_load_lds((const unsigned*)(g_ + koff[0]), (LAS unsigned*)d_, 16, 0, 0); __builtin_amdgcn_global_load_lds((const unsigned*)(g_ + koff[1]), (LAS unsigned*)(d_ + 8192), 16, 0, 0); } while (0)
#define DMA_V(t) do { const int t_ = (t) < NT ? (t) : NT - 1; const char* g_ = (const char*)Vg + (size_t)(rev ? ((t_ + (NT >> 1)) & (NT - 1)) : t_) * tstep; LAS unsigned char* d_ = V_lds + (t_ % 3) * SHM_V + wid * 1024; \
    __builtin_amdgcn_global_load_lds((const unsigned*)(g_ + voff[0]), (LAS unsigned*)d_, 16, 0, 0); __builtin_amdgcn_global_load_lds((const unsigned*)(g_ + voff[1]), (LAS unsigned*)(d_ + 8192), 16, 0, 0); } while (0)
#define WAIT4_BAR() do { asm volatile("s_waitcnt vmcnt(4)" ::: "memory"); __builtin_amdgcn_s_barrier(); asm volatile("" ::: "memory"); } while (0)
  S8 pA, pB;
  DMA_K(0); DMA_K(1); DMA_V(0);
  WAIT4_BAR();
  DMA_K(2); DMA_V(1);
  qk_first(pA, K_lds, qf, c16, g, cbase);
  int sk = 1, sv = 0;
  for (int j = 1; j + 1 < NT; j += 2) {
    WAIT4_BAR(); DMA_K(j + 2); DMA_V(j + 1);
    SBAR(); att_step(pB, K_lds + sk * SHM_K, qf, c16, g, cbase, pA, l2, o, vbe0 + sv * SHM_V, vbo0 + sv * SHM_V); SBAR();
    sk = sk == 2 ? 0 : sk + 1; sv = sv == 2 ? 0 : sv + 1;
    WAIT4_BAR(); DMA_K(j + 3); DMA_V(j + 2);
    SBAR(); att_step(pA, K_lds + sk * SHM_K, qf, c16, g, cbase, pB, l2, o, vbe0 + sv * SHM_V, vbo0 + sv * SHM_V); SBAR();
    sk = sk == 2 ? 0 : sk + 1; sv = sv == 2 ? 0 : sv + 1;
  }
  WAIT4_BAR(); DMA_K(NT + 1); DMA_V(NT);
  SBAR(); att_step(pB, K_lds + sk * SHM_K, qf, c16, g, cbase, pA, l2, o, vbe0 + sv * SHM_V, vbo0 + sv * SHM_V); SBAR();
  sv = sv == 2 ? 0 : sv + 1;
  WAIT4_BAR();
  { u32x4 pw[2][2]; pack_all(pB, pw); SBAR(); LSUM16(); SBAR(); pv_last(o, pw, vbe0 + sv * SHM_V, vbo0 + sv * SHM_V); }
  asm volatile("s_waitcnt vmcnt(0)" ::: "memory");
#undef DMA_K
#undef DMA_V
#undef WAIT4_BAR
  float rl[2];
#pragma unroll
  for (int qb = 0; qb < 2; ++qb) rl[qb] = __builtin_amdgcn_rcpf(l2[qb][0]);
  __syncthreads();
  LAS float* X = (LAS float*)(lds) + rg * 4096 + lane;
  if (comp == 1) {
#pragma unroll
    for (int db = 0; db < 8; ++db)
#pragma unroll
      for (int qb = 0; qb < 2; ++qb)
#pragma unroll
        for (int r = 0; r < 4; ++r) X[((db * 2 + qb) * 4 + r) * 64] = o[db][qb][r] * rl[qb] * lam;
  }
  __syncthreads();
  if (comp == 0) {
    float ss[2] = {0.f, 0.f};
#pragma unroll
    for (int db = 0; db < 8; ++db)
#pragma unroll
      for (int qb = 0; qb < 2; ++qb)
#pragma unroll
        for (int r = 0; r < 4; ++r) { const float v = o[db][qb][r] * rl[qb] - X[((db * 2 + qb) * 4 + r) * 64]; o[db][qb][r] = v; ss[qb] += v * v; }
#pragma unroll
    for (int qb = 0; qb < 2; ++qb) { float t = ss[qb]; t += __shfl_xor(t, 16); t += __shfl_xor(t, 32); ss[qb] = __builtin_amdgcn_rsqf(t * (1.0f / 128.0f) + EPS) * oscale; }
#pragma unroll
    for (int db = 0; db < 8; ++db) { const f32x4 gs = *(const f32x4*)(gsub + 16 * db + 4 * g);
#pragma unroll
      for (int qb = 0; qb < 2; ++qb) { const f32x4 v = o[db][qb] * gs * ss[qb]; u32x2 w; w.x = cvt_pk_bf16(v[0], v[1]); w.y = cvt_pk_bf16(v[2], v[3]);
        *(u32x2*)(Og + (size_t)(rg * 32 + 16 * qb + c16) * LDP + 16 * db + 4 * g) = w; } }
  }
  __syncthreads();
}
#undef PV16
#undef PACK16
#undef LSUM16
#undef ADDF16
#undef PKV16
}

#define XB_TMO      128
#define XB_XCNT(j)  (256  + 64 * (j))
#define XB_XSUB(j)  (1280 + 64 * (j))
#define XB_XGEN(j)  (2304 + 64 * (j))
#define XB_TOP      3328
#define XB_TOPGEN   3392
#define XCD_BAR_WORDS 3456
#define XB_SPIN_CAP (1u << 20)
__device__ __forceinline__ unsigned xb_ld(unsigned* p)              { return __hip_atomic_load(p, __ATOMIC_RELAXED, __HIP_MEMORY_SCOPE_AGENT); }
__device__ __forceinline__ unsigned xb_add(unsigned* p, unsigned v) { return __hip_atomic_fetch_add(p, v, __ATOMIC_RELAXED, __HIP_MEMORY_SCOPE_AGENT); }
__device__ __forceinline__ unsigned xb_xcc_id() { return (unsigned)__builtin_amdgcn_s_getreg((3 << 11) | 20) & 0xFu; }
#define XB_SPIN(cond, bar) do { unsigned _sp = 0; while (cond) { __builtin_amdgcn_s_sleep(1); \
    if ((++_sp & 255u) == 0u) { if (xb_ld(&(bar)[XB_TMO])) break; if (_sp > XB_SPIN_CAP) { atomicAdd(&(bar)[XB_TMO], 1u); break; } } } } while (0)
struct XcdBarrier { unsigned* bar; unsigned x; volatile LAS unsigned* st; };
__device__ __forceinline__ XcdBarrier xcd_barrier_post(unsigned* bar, volatile LAS unsigned* st) {
    XcdBarrier b; b.bar = bar; b.x = xb_xcc_id(); b.st = st;
    if (threadIdx.x == 0) (void)xb_add(&bar[XB_XCNT(b.x)], 1u);
    return b;
}
__device__ __forceinline__ void xcd_barrier_complete(unsigned* bar, unsigned x, unsigned& nloc, unsigned& nx) {
    const unsigned G = gridDim.x * gridDim.y * gridDim.z;
    unsigned sum, cnt, mine, sp = 0u;
    for (;;) {
        sum = 0u; cnt = 0u; mine = 0u;
#pragma unroll
        for (unsigned j = 0; j < 16; ++j) { const unsigned c = xb_ld(&bar[XB_XCNT(j)]); sum += c; cnt += (c > 0u) ? 1u : 0u; mine = (j == x) ? c : mine; }
        if (sum == G) break;
        __builtin_amdgcn_s_sleep(1);
        if ((++sp & 255u) == 0u) { if (xb_ld(&bar[XB_TMO])) break; if (sp > XB_SPIN_CAP) { atomicAdd(&bar[XB_TMO], 1u); break; } }
    }
    nloc = mine > 0u ? mine : 1u; nx = cnt > 0u ? cnt : 1u;
}
__device__ __forceinline__ void xcd_barrier(const XcdBarrier& b) {
    asm volatile("s_waitcnt vmcnt(0)" ::: "memory");
    __syncthreads();
    if (threadIdx.x == 0) {
        unsigned* bar = b.bar;
        __builtin_amdgcn_s_waitcnt(0);
        unsigned nloc = b.st[0], nx = b.st[1];
        if (nloc == 0u) { xcd_barrier_complete(bar, b.x, nloc, nx); b.st[0] = nloc; b.st[1] = nx; }
        const unsigned old = xb_add(&bar[XB_XSUB(b.x)], 1u);
        const unsigned gen = old / nloc;
        if (old + 1u == (gen + 1u) * nloc) {
            __builtin_amdgcn_fence(__ATOMIC_RELEASE, "agent");
            asm volatile("s_waitcnt vmcnt(0)" ::: "memory");
            const unsigned og = xb_add(&bar[XB_TOP], 1u);
            const unsigned tg = og / nx;
            if (og + 1u == (tg + 1u) * nx) xb_add(&bar[XB_TOPGEN], 1u);
            else XB_SPIN(xb_ld(&bar[XB_TOPGEN]) == tg, bar);
            __builtin_amdgcn_fence(__ATOMIC_ACQUIRE, "agent");
            xb_add(&bar[XB_XGEN(b.x)], 1u);
            asm volatile("s_waitcnt vmcnt(0)" ::: "memory");
        } else {
            XB_SPIN(xb_ld(&bar[XB_XGEN(b.x)]) == gen, bar);
            __builtin_amdgcn_fence(__ATOMIC_ACQUIRE, "agent");
            asm volatile("s_waitcnt vmcnt(0)" ::: "memory");
        }
    }
    __syncthreads();
}

#define LDS_WAIT() asm volatile("s_waitcnt lgkmcnt(0)" ::: "memory")
__device__ __forceinline__ float wave_sum(float v) {
#pragma unroll
    for (int o = 1; o < 64; o <<= 1) v += __shfl_xor(v, o);
    return v;
}
typedef __bf16 bf16n2_t __attribute__((ext_vector_type(2)));
__device__ __forceinline__ unsigned cvt2_bf16_native(float lo, float hi) { const bf16n2_t v = {(__bf16)lo, (__bf16)hi}; return __builtin_bit_cast(unsigned, v); }
__device__ __forceinline__ void pool_fold_item(const float* Wp, const float* ps, const float* Wol, bf16_t* WT, int g_, int nb, int lane) {
    const int c16 = lane & 15, kg = lane >> 4, n0 = nb * 64;
    bf16x8 bfr[4][8];
#pragma unroll
    for (int ks = 0; ks < 8; ++ks) { const int d0 = ks * 32 + 8 * kg; const f32x4 p0 = *(const f32x4*)(ps + d0), p1 = *(const f32x4*)(ps + d0 + 4);
#pragma unroll
        for (int nh = 0; nh < 2; ++nh) { float t[2][8];
#pragma unroll
            for (int nq = 0; nq < 2; ++nq) { const float* bp = Wol + (size_t)d0 * 2048 + n0 + 16 * (2 * nh + nq) + c16;
#pragma unroll
                for (int j = 0; j < 8; ++j) t[nq][j] = bp[j * 2048]; }
            __builtin_amdgcn_sched_barrier(0);
#pragma unroll
            for (int nq = 0; nq < 2; ++nq) { u32x4 w;
                w.x = cvt2_bf16_native(t[nq][0] * p0[0], t[nq][1] * p0[1]); w.y = cvt2_bf16_native(t[nq][2] * p0[2], t[nq][3] * p0[3]);
                w.z = cvt2_bf16_native(t[nq][4] * p1[0], t[nq][5] * p1[1]); w.w = cvt2_bf16_native(t[nq][6] * p1[2], t[nq][7] * p1[3]); bfr[2 * nh + nq][ks] = __builtin_bit_cast(bf16x8, w); }
            __builtin_amdgcn_sched_barrier(0); } }
    for (int cb = 0; cb < 16; ++cb) { f32x4 acc[4];
#pragma unroll
        for (int nbk = 0; nbk < 4; ++nbk) acc[nbk] = (f32x4){0.f, 0.f, 0.f, 0.f};
#pragma unroll
        for (int kh = 0; kh < 2; ++kh) { f32x4 av[4][2];
#pragma unroll
            for (int k4 = 0; k4 < 4; ++k4) { const float* ap = Wp + (size_t)(cb * 16 + c16) * 256 + (kh * 4 + k4) * 32 + 8 * kg; av[k4][0] = *(const f32x4*)ap; av[k4][1] = *(const f32x4*)(ap + 4); }
            __builtin_amdgcn_sched_barrier(0);
#pragma unroll
            for (int k4 = 0; k4 < 4; ++k4) { const f32x4 a0 = av[k4][0], a1 = av[k4][1];
                u32x4 w; w.x = cvt2_bf16_native(a0[0], a0[1]); w.y = cvt2_bf16_native(a0[2], a0[3]); w.z = cvt2_bf16_native(a1[0], a1[1]); w.w = cvt2_bf16_native(a1[2], a1[3]); const bf16x8 af = __builtin_bit_cast(bf16x8, w);
#pragma unroll
                for (int nbk = 0; nbk < 4; ++nbk) acc[nbk] = __builtin_amdgcn_mfma_f32_16x16x32_bf16(af, bfr[nbk][kh * 4 + k4], acc[nbk], 0, 0, 0); }
            __builtin_amdgcn_sched_barrier(0); }
#pragma unroll
        for (int nbk = 0; nbk < 4; ++nbk) { u32x2 o; o.x = cvt2_bf16_native(acc[nbk][0], acc[nbk][1]); o.y = cvt2_bf16_native(acc[nbk][2], acc[nbk][3]);
            *(u32x2*)(WT + (size_t)(n0 + 16 * nbk + c16) * 2048 + 1024 + g_ * 256 + cb * 16 + 4 * kg) = o; }
        __builtin_amdgcn_sched_barrier(0); }
}
__device__ __forceinline__ unsigned cvt_pk_f16_rne(float a, float b) { const h2_t v = {(_Float16)a, (_Float16)b}; return __builtin_bit_cast(unsigned, v); }
template <bool F16 = false>
__device__ __forceinline__ void tr_item(const float* W, int K, int N, bf16_t* WT, const float* rs, const float* cs, int perm_limit, LAS float* scr, int item, int lane) {
    const int nblk = N / 32, kb = item / nblk, nb = item % nblk, k0 = 64 * kb, n0 = 32 * nb;
    const float csv = cs ? cs[n0 + (lane & 31)] : 1.f;
    float wv[32], rv[32];
#pragma unroll
    for (int i = 0; i < 32; ++i) { const int kk = 2 * i + (lane >> 5); wv[i] = W[(size_t)(k0 + kk) * N + n0 + (lane & 31)]; rv[i] = rs ? rs[k0 + kk] : 1.f; }
#pragma unroll
    for (int i = 0; i < 32; ++i) { const int kk = 2 * i + (lane >> 5); scr[kk * 33 + (lane & 31)] = wv[i] * rv[i] * csv; }
    LDS_WAIT(); asm volatile("" ::: "memory");
    int d0 = n0; if (n0 < perm_limit) { const int tile = n0 >> 8, lb = (n0 >> 5) & 7; d0 = (tile << 8) + ((4 * (lb & 1) + (lb >> 1)) << 5); }
    if (perm_limit < 0) { const int isv = n0 >= D_FF, ch = n0 - (isv ? D_FF : 0); d0 = (ch >> 7) * 256 + isv * 128 + (ch & 127); }
    const int c = lane & 7;
#pragma unroll
    for (int j = 0; j < 4; ++j) { const int n = (lane >> 3) + 8 * j; const LAS float* s = scr + (8 * c) * 33 + n;
        u32x4 o;
        if constexpr (F16) { o.x = cvt_pk_f16_rne(s[0 * 33], s[1 * 33]); o.y = cvt_pk_f16_rne(s[2 * 33], s[3 * 33]); o.z = cvt_pk_f16_rne(s[4 * 33], s[5 * 33]); o.w = cvt_pk_f16_rne(s[6 * 33], s[7 * 33]); }
        else { o.x = cvt_pk_bf16(s[0 * 33], s[1 * 33]); o.y = cvt_pk_bf16(s[2 * 33], s[3 * 33]); o.z = cvt_pk_bf16(s[4 * 33], s[5 * 33]); o.w = cvt_pk_bf16(s[6 * 33], s[7 * 33]); }
        *(u32x4*)(WT + (size_t)(d0 + n) * K + k0 + 8 * c) = o; }
    LDS_WAIT(); asm volatile("" ::: "memory");
}
__device__ __forceinline__ void norm_row(const float* xrow, bf16_t* orow, float* crow_, int lane) {
    f32x4 v[8]; float s = 0.f;
#pragma unroll
    for (int j = 0; j < 4; ++j) { v[2 * j] = *(const f32x4*)(xrow + j * 512 + lane * 8); v[2 * j + 1] = *(const f32x4*)(xrow + j * 512 + lane * 8 + 4); s += pg8::sumsq4(v[2 * j]) + pg8::sumsq4(v[2 * j + 1]); }
    const float rstd = __builtin_amdgcn_rsqf(wave_sum(s) * (1.0f / D_MODEL) + EPS);
#pragma unroll
    for (int j = 0; j < 4; ++j) { if (crow_) { *(f32x4*)(crow_ + j * 512 + lane * 8) = v[2 * j]; *(f32x4*)(crow_ + j * 512 + lane * 8 + 4) = v[2 * j + 1]; }
        *(u32x4*)(orow + j * 512 + lane * 8) = pg8::pack8(v[2 * j] * rstd, v[2 * j + 1] * rstd); }
}

__device__ __forceinline__ void raw_row(const float* xrow, bf16_t* orow, rss_t* ssq, int lane) {
    f32x4 v[8]; float s = 0.f;
#pragma unroll
    for (int j = 0; j < 4; ++j) { v[2 * j] = *(const f32x4*)(xrow + j * 512 + lane * 8); v[2 * j + 1] = *(const f32x4*)(xrow + j * 512 + lane * 8 + 4); s += pg8::sumsq4(v[2 * j]) + pg8::sumsq4(v[2 * j + 1]); }
    s = wave_sum(s); if (lane == 0) *ssq = ss_fix(s);
#pragma unroll
    for (int j = 0; j < 4; ++j) *(u32x4*)(orow + j * 512 + lane * 8) = pg8::pack8(v[2 * j], v[2 * j + 1]);
}

template <int WIN> __device__ __forceinline__ void pool_item(const bf16_t* U, bf16_t* ZP, int r0, int ch, bool big) {
    constexpr int NR = 3 + 2 * WIN, SM = WIN / 2;
    const int pos0 = tok_pos(r0), S = tok_seqlen(r0);
    u32x4 v[NR];
#pragma unroll
    for (int k = 0; k < NR; ++k) { const int p = pos0 - WIN + k; v[k] = (p >= 0 && p < S) ? *(const u32x4*)(U + (size_t)(r0 - WIN + k) * 1024 + ch) : (u32x4){0u, 0u, 0u, 0u}; }
    float sb[8], ss[8];
#pragma unroll
    for (int j = 0; j < 8; ++j) { sb[j] = 0.f; ss[j] = 0.f; }
#define POOL_ACC(dst, k, sgn) do { const u32x4 w_ = v[k]; dst[0] += sgn bflo(w_.x); dst[1] += sgn bfhi(w_.x); dst[2] += sgn bflo(w_.y); dst[3] += sgn bfhi(w_.y); dst[4] += sgn bflo(w_.z); dst[5] += sgn bfhi(w_.z); dst[6] += sgn bflo(w_.w); dst[7] += sgn bfhi(w_.w); } while (0)
#pragma unroll
    for (int k = 0; k < 2 * WIN; ++k) { POOL_ACC(sb, k, +); if (k >= WIN - SM && k < WIN + SM) POOL_ACC(ss, k, +); }
#pragma unroll
    for (int i = 0; i < 4; ++i) {
        if (i > 0) { POOL_ACC(sb, i + 2 * WIN - 1, +); POOL_ACC(sb, i - 1, -); POOL_ACC(ss, i + WIN + SM - 1, +); POOL_ACC(ss, i + WIN - SM - 1, -); }
        const int pos = pos0 + i, w2 = big ? WIN : SM; const int lo_ = pos - w2 < 0 ? 0 : pos - w2, hi_ = pos + w2 > S ? S : pos + w2; const float inv = 1.0f / (float)(hi_ - lo_);
        const u32x4 c = v[WIN + i]; float s[8];
#pragma unroll
        for (int j = 0; j < 8; ++j) s[j] = (big ? sb[j] : ss[j]) * inv;
        u32x4 o; o.x = cvt_pk_bf16(s[0] - bflo(c.x), s[1] - bfhi(c.x)); o.y = cvt_pk_bf16(s[2] - bflo(c.y), s[3] - bfhi(c.y)); o.z = cvt_pk_bf16(s[4] - bflo(c.z), s[5] - bfhi(c.z)); o.w = cvt_pk_bf16(s[6] - bflo(c.w), s[7] - bfhi(c.w));
        *(u32x4*)(ZP + (size_t)(r0 + i) * 1024 + ch) = o; }
#undef POOL_ACC
}

struct Args { const float* in[28]; float* out; unsigned char* ws; int ph_lo, ph_hi; };

__global__ void __launch_bounds__(NWAVES * 64, 2) trunk_fwd(Args args) {
    extern __shared__ __attribute__((aligned(16))) unsigned char lds_raw[];
    LAS unsigned char* lds = (LAS unsigned char*)lds_raw;
    volatile LAS unsigned* MISC = (volatile LAS unsigned*)(lds + MISC_OFF);
    for (int u = threadIdx.x; u < (LDS_BYTES - LDSCTL_OFF) / 4; u += NWAVES * 64) ((LAS unsigned*)(lds + LDSCTL_OFF))[u] = 0u;
    __syncthreads();
    const int lo = args.ph_lo, hi = args.ph_hi;
    XcdBarrier bar; bar.bar = (unsigned*)(args.ws + WS_CTL) + CW_BAR; bar.x = 0; bar.st = nullptr;
    if (hi - lo > 1) bar = xcd_barrier_post((unsigned*)(args.ws + WS_CTL) + CW_BAR, MISC + 8);
#define IN(k) ({ int lo_ = lo, hi_ = hi; asm volatile("" : "+s"(lo_), "+s"(hi_)); lo_ <= (k) && (k) < hi_; })
#define SEAM(k) do { if (IN(k) && IN((k) + 1)) { XcdBarrier b2_ = bar; asm volatile("" : "+s"(b2_.bar), "+s"(b2_.x)); xcd_barrier(b2_); } } while (0)
#define PHASE_BEGIN() int tid = threadIdx.x; asm volatile("" : "+v"(tid)); int zo = 0; asm volatile("" : "+s"(zo)); \
    const int lane = tid & 63, wave = __builtin_amdgcn_readfirstlane(tid >> 6); const int G = gridDim.x, bx = blockIdx.x; \
    const int vcu = (G % 8 == 0) ? (bx % 8) * (G / 8) + bx / 8 : bx; const int gw = vcu * NWAVES + wave, NGW = G * NWAVES; \
    unsigned char* ws = args.ws + zo; float* X = args.out + zo; (void)lane; (void)wave; (void)gw; (void)NGW; (void)ws; (void)X; (void)vcu; (void)tid
#define INP(i) (args.in[(i) + zo])
#define WSP(T, off) ((T*)(ws + (off)))

#define CG_UP 1u
#define CG_DOWN 2u
#define CG_IN 4u
#define CG_CKV 8u
#define CG_OUT 16u
#define CG_CQ 32u
#define CG_CO 64u
#define CONV_ITEMS(L_, MASK_) do { const int l_ = (L_); constexpr unsigned m_ = (MASK_); __syncthreads(); LAS float* scr = (LAS float*)(lds + wave * 16384);                                         \
    constexpr int I_IN = 32 * 128, I_OUT = 16 * 64, I_CQ = 32 * 64, I_CKV = 32 * 128, I_CO = 32 * 64, I_UP = 32 * (UP_W / 32), I_DOWN = (D_FF / 64) * 64, I_P = 4 * 32;                                 \
    constexpr int n_ = ((m_ & CG_UP) ? I_UP : 0) + ((m_ & CG_DOWN) ? I_DOWN : 0) + ((m_ & CG_IN) ? I_IN : 0) + ((m_ & CG_CKV) ? I_CKV : 0) + ((m_ & CG_OUT) ? I_OUT + I_P : 0) + ((m_ & CG_CQ) ? I_CQ : 0) + ((m_ & CG_CO) ? I_CO : 0); \
    for (int it = gw; it < n_; it += NGW) { int r = it;                                                                                                                                            \
        if constexpr ((m_ & CG_UP) != 0) { if (r < I_UP) { tr_item(INP(24) + (size_t)l_ * 2048 * UP_W, 2048, UP_W, WSP(bf16_t, WS_WUP), INP(23) + l_ * 2048, nullptr, -1, scr, r, lane); continue; } r -= I_UP; } \
        if constexpr ((m_ & CG_DOWN) != 0) { if (r < I_DOWN) { tr_item<true>(INP(27) + (size_t)l_ * D_FF * 2048, D_FF, 2048, WSP(bf16_t, WS_WDOWN), nullptr, nullptr, 0, scr, r, lane); continue; } r -= I_DOWN; } \
        if constexpr ((m_ & CG_IN) != 0) { if (r < I_IN) { tr_item(INP(5) + (size_t)l_ * 2048 * 4096, 2048, 4096, WSP(bf16_t, WS_WIN), INP(4) + l_ * 2048, nullptr, 2048, scr, r, lane); continue; } r -= I_IN; } \
        if constexpr ((m_ & CG_CKV) != 0) { if (r < I_CKV) { tr_item(INP(19) + (size_t)l_ * 2048 * 4096, 2048, 4096, WSP(bf16_t, WS_WCKV), INP(17) + l_ * 2048, nullptr, 0, scr, r, lane); continue; } r -= I_CKV; } \
        if constexpr ((m_ & CG_OUT) != 0) { if (r < I_OUT) { tr_item(INP(15) + (size_t)l_ * 2048 * 2048, 2048, 2048, WSP(bf16_t, WS_WOUT), nullptr, nullptr, 0, scr, r, lane); continue; } r -= I_OUT;   \
            if (r < I_P) { const int g = r >> 5; pool_fold_item(INP(13) + (size_t)l_ * 4 * 65536 + (size_t)g * 65536, INP(14) + l_ * 1024 + g * 256, INP(15) + (size_t)l_ * 2048 * 2048 + (size_t)(1024 + g * 256) * 2048, WSP(bf16_t, WS_WOUT), g, r & 31, lane); continue; } r -= I_P; } \
        if constexpr ((m_ & CG_CQ) != 0) { if (r < I_CQ) { tr_item(INP(18) + (size_t)l_ * 2048 * 2048, 2048, 2048, WSP(bf16_t, WS_WCQ), INP(16) + l_ * 2048, nullptr, 0, scr, r, lane); continue; } r -= I_CQ; } \
        if constexpr ((m_ & CG_CO) != 0) { if (r < I_CO) { tr_item(INP(22) + (size_t)l_ * 2048 * 2048, 2048, 2048, WSP(bf16_t, WS_WCO), nullptr, nullptr, 0, scr, r, lane); continue; } r -= I_CO; } }   \
    if constexpr ((m_ & CG_UP) != 0) { const float* cw = INP(25) + (size_t)l_ * 3 * UP_W; const float* cb = INP(26) + (size_t)l_ * UP_W; u32x4* cwt = WSP(u32x4, WS_CWT);        \
        for (int it = vcu * 512 + tid; it < D_FF; it += G * 512) { const int p = it >> 1, isv = it & 1, ch = 2 * p + isv * D_FF; u32x4 w;                                                          \
            w.x = cvt_pk_f16_rne(cw[ch], cw[ch + 1]); w.y = cvt_pk_f16_rne(cw[UP_W + ch], cw[UP_W + ch + 1]); w.z = cvt_pk_f16_rne(cw[2 * UP_W + ch], cw[2 * UP_W + ch + 1]); w.w = cvt_pk_f16_rne(cb[ch], cb[ch + 1]); cwt[it] = w; } } } while (0)
    for (int l = 0; l < DEPTH; ++l) {
        const int pb = l * PH_PER_LAYER;
        if (PH_EN(0) && IN(pb + 0)) {
            PHASE_BEGIN();
            if (l == 0) CONV_ITEMS(0, CG_IN | CG_CKV);
            bf16_t* HB = WSP(bf16_t, WS_HB);
            if (l == 0) {
                unsigned* csT = WSP(unsigned, WS_COS);
                for (int e = (vcu * 512 + tid); e < 8192 * 32; e += G * 512) { const int pos = e >> 5, i = e & 31;
                    double inv = 1.0; const double b = 0.74989420933245582730;
                    for (int k = 0; k < i; ++k) inv *= b;
                    double rev = (double)pos * inv * 0.15915494309189533577; rev -= __builtin_floor(rev);
                    const float fr_ = (float)rev;
                    const _Float16 hc = (_Float16)__builtin_amdgcn_cosf(fr_), hs = (_Float16)__builtin_amdgcn_sinf(fr_);
                    csT[e] = (unsigned)__builtin_bit_cast(unsigned short, hc) | ((unsigned)__builtin_bit_cast(unsigned short, hs) << 16); }
                bf16_t* MB = WSP(bf16_t, WS_MB);
                for (int m = gw; m < NMEMROWS; m += NGW) { const float* src = m < 1024 ? INP(2) + (size_t)m * 2048 : INP(3) + (size_t)(m - 1024) * 2048; norm_row(src, MB + (size_t)m * 2048, nullptr, lane); }
                rss_t* rss0 = WSP(rss_t, WS_ROWSS);
                for (int m = gw; m < NTOK; m += NGW) { const float* src = m < NTOK_P ? INP(0) + (size_t)m * 2048 : INP(1) + (size_t)(m - NTOK_P) * 2048; raw_row(src, HB + (size_t)m * 2048, rss0 + m, lane); }
            }
        }
        if (l == 0) SEAM(pb + 0);
        if (PH_EN(1) && IN(pb + 1)) {
            PHASE_BEGIN(); pg8::StaticOrder SO;
            if (PH_EN(17)) { pg8::ProbSimple P; P.K = 2048; P.lda = 2048; P.ldb = 2048; P.tsplit = 1 << 30; P.adelta = 0; P.A = (const char*)WSP(bf16_t, WS_HB); P.B = (const char*)WSP(bf16_t, WS_WIN);
              SO.init(NTOK / 256, IN_W / 256, G, bx);
              pg8::EpiIn E{WSP(bf16_t, R_Q), (size_t)NTOK * 1024, WSP(const unsigned, WS_COS), INP(6) + l * 64, INP(7) + l * 64, WSP(const rss_t, WS_ROWSS) + (size_t)(l * 3 + 0) * NTOK};
              pg8::gemm_phase<pg8::ProbSimple, pg8::EpiIn, true, true>(lds, P, SO, E); }
            if (PH_EN(16)) { pg8::ProbSimple P; P.K = 2048; P.lda = 2048; P.ldb = 2048; P.tsplit = 1 << 30; P.adelta = 0; P.A = (const char*)WSP(bf16_t, WS_MB); P.B = (const char*)WSP(bf16_t, WS_WCKV);
              SO.init(NMEMROWS / 256, 4096 / 256, G, bx);
              pg8::EpiKV E{WSP(float, WS_KRAW), WSP(bf16_t, WS_VT)};
              pg8::gemm_phase<pg8::ProbSimple, pg8::EpiKV, true, true>(lds, P, SO, E); }
            if (l == 0) CONV_ITEMS(0, CG_OUT | CG_CO | CG_CQ);
        }
        SEAM(pb + 1);
        if (PH_EN(2) && IN(pb + 2)) {
            if (PH_EN(18)) {
              PHASE_BEGIN();
              const float lam_init = 0.8f - 0.6f * __expf(-0.3f * (float)l);
              float s1 = 0.f, s2 = 0.f; const float* q1 = INP(8) + l * 64; const float* k1 = INP(9) + l * 64; const float* q2 = INP(10) + l * 64; const float* k2 = INP(11) + l * 64;
              for (int i = 0; i < 64; ++i) { s1 += q1[i] * k1[i]; s2 += q2[i] * k2[i]; }
              const float lam = __expf(s1) - __expf(s2) + lam_init;
              const float* gsub = INP(12) + l * 128;
              bf16_t* Qb = WSP(bf16_t, R_Q); const bf16_t* Kb = WSP(const bf16_t, R_K); const bf16_t* Vb = WSP(const bf16_t, R_V);
              __syncthreads();
              { const int NX = (G % 8 == 0) ? 8 : 1, xcd = bx % NX, j = bx / NX, nb = G / NX, npr = 2048 / NX;
                  for (int kk = j; kk < 2 * npr; kk += nb) { int pair, qt, S; size_t t0;
                      if (kk < npr) { pair = xcd + NX * (kk >> 6); qt = kk & 63; S = S_P; t0 = (size_t)(pair >> 3) * S_P; }
                      else { const int k2_ = kk - npr; pair = xcd + NX * (k2_ >> 5); qt = k2_ & 31; S = S_S; t0 = (size_t)NTOK_P + (size_t)(pair >> 3) * S_S; }
                      const int h = pair & 7; bf16_t* qp = Qb + (t0 + (size_t)qt * 128) * 1024 + h * 128;
                      ATTN_NS::attn_unit(qp, Kb + t0 * 1024 + h * 128, Vb + t0 * 1024 + h * 128, qp, S, lam, gsub, 1.f - lam_init, lds, kk < npr && ((kk / nb) & 1)); }
              }
            }
            if (PH_EN(14)) { PHASE_BEGIN(); const bf16_t* U = WSP(const bf16_t, R_U); bf16_t* ZP = (bf16_t*)X;
#ifdef PROBE_DOUBLE_PASSES
              int nrq = 2; asm volatile("" : "+s"(nrq)); for (int rq_ = 0; rq_ < nrq; ++rq_)
#endif
              for (int it = gw; it < (NTOK / 4) * 2; it += NGW) { const int r0 = (it >> 1) * 4, half = it & 1, ch = half * 512 + lane * 8;
                  if (half == 0) pool_item<2>(U, ZP, r0, ch, lane >= 32); else pool_item<8>(U, ZP, r0, ch, lane >= 32); } }
            if (PH_EN(15)) { PHASE_BEGIN(); const float* gcq = INP(20) + l * 512; const float* gck = INP(21) + l * 512; const float* KRAW = WSP(const float, WS_KRAW); bf16_t* KC = WSP(bf16_t, WS_KC);
              for (int it = gw; it < NMEMROWS * 4; it += NGW) { const int row = it >> 2, h = it & 3; const float* kr = KRAW + (size_t)row * 2048 + h * 512 + lane * 8;
                  const f32x4 a = *(const f32x4*)kr, b = *(const f32x4*)(kr + 4); const float ss = wave_sum(pg8::sumsq4(a) + pg8::sumsq4(b));
                  const float rk = __builtin_amdgcn_rsqf(ss * (1.0f / 512.0f) + EPS);
                  const f32x4 ga = *(const f32x4*)(gcq + lane * 8) * *(const f32x4*)(gck + lane * 8), gb = *(const f32x4*)(gcq + lane * 8 + 4) * *(const f32x4*)(gck + lane * 8 + 4);
                  *(u32x4*)(KC + (size_t)row * 2048 + h * 512 + lane * 8) = pg8::pack8(a * rk * ga, b * rk * gb); } }
            { PHASE_BEGIN(); if (l == 0) CONV_ITEMS(0, CG_UP); else CONV_ITEMS(l, CG_DOWN); }
        }
        SEAM(pb + 2);
        if (PH_EN(4) && IN(pb + 4)) {
            PHASE_BEGIN(); pg8::StaticOrder SO;
            pg8::ProbSimple P; P.K = 2048; P.lda = 1024; P.ldb = 2048; P.tsplit = 16; P.adelta = (long long)((const char*)X - (const char*)(ws + R_Q)) - 16ll * 128; P.A = (const char*)(ws + R_Q);   P.B = (const char*)WSP(bf16_t, WS_WOUT);
            SO.init(NTOK / 256, 8, G, bx);
            pg8::EpiRes E{WSP(bf16_t, WS_HB), WSP(rss_t, WS_ROWSS) + (size_t)(l * 3 + 1) * NTOK, nullptr};
            pg8::gemm_phase<pg8::ProbSimple, pg8::EpiRes, true, true>(lds, P, SO, E);
            if (PH_EN(3)) {

              pg8::ProbVW P2; P2.K = 512; P2.lda = 2048; P2.ldb = 2048; P2.tsplit = 1 << 30; P2.adelta = 0; P2.A = (const char*)WSP(bf16_t, WS_WCO); P2.B = (const char*)WSP(bf16_t, WS_VT);
              SO.init(8, 48, G, bx);
              pg8::EpiBf<5> E2{WSP(bf16_t, R_VW), 1024, nullptr, nullptr, nullptr};
              pg8::gemm_phase<pg8::ProbVW, pg8::EpiBf<5>, true, true>(lds, P2, SO, E2); }
            if (l == 0) CONV_ITEMS(0, CG_DOWN);
            if (l + 1 < DEPTH) CONV_ITEMS(l + 1, CG_IN | CG_CKV);
        }
        SEAM(pb + 4);
        if (PH_EN(5) && IN(pb + 5)) {
            PHASE_BEGIN(); pg8::StaticOrder SO;
            pg8::ProbSimple P; P.K = 2048; P.lda = 2048; P.ldb = 2048; P.tsplit = 1 << 30; P.adelta = 0; P.A = (const char*)WSP(bf16_t, WS_HB); P.B = (const char*)WSP(bf16_t, WS_WCQ);
            SO.init(NTOK / 256, 8, G, bx);
            pg8::EpiBf<1> E{WSP(bf16_t, R_QC), 2048, WSP(float, WS_QSS), (float*)(WSP(rss_t, WS_ROWSS) + (size_t)(l * 3 + 1) * NTOK), nullptr};
            pg8::gemm_phase<pg8::ProbSimple, pg8::EpiBf<1>, true, true>(lds, P, SO, E);
            if (l + 1 < DEPTH) CONV_ITEMS(l + 1, CG_OUT | CG_CO);
        }
        SEAM(pb + 5);
        if (PH_EN(6) && IN(pb + 6)) {
            PHASE_BEGIN(); pg8::StaticOrder SO;
            pg8::ProbScores P; P.K = 512; P.lda = 2048; P.ldb = 2048; P.tsplit = 1 << 30; P.adelta = 0; P.A = (const char*)(ws + R_QC); P.B = (const char*)WSP(bf16_t, WS_KC);
            SO.init(NTOK / 256, 4, G, bx);
            pg8::EpiBf<2> E{WSP(bf16_t, R_P), 1024, WSP(float, WS_QSS), nullptr, (LAS float*)(lds + XCH_OFF)};
            pg8::gemm_phase<pg8::ProbScores, pg8::EpiBf<2>, true, true>(lds, P, SO, E);
            if (l + 1 < DEPTH) CONV_ITEMS(l + 1, CG_CQ);
        }
        SEAM(pb + 6);
        if (PH_EN(8) && IN(pb + 7)) {
            PHASE_BEGIN(); pg8::StaticOrder SO;
            pg8::ProbFin P; P.K = 1024; P.lda = 1024; P.ldb = 1024; P.tsplit = 1 << 30; P.adelta = 0; P.A = (const char*)(ws + R_P); P.B = (const char*)WSP(bf16_t, R_VW);
            SO.init(NTOK / 256, 8, G, bx);
            pg8::EpiRes E{WSP(bf16_t, WS_HB), WSP(rss_t, WS_ROWSS) + (size_t)(l * 3 + 2) * NTOK, nullptr};
            pg8::gemm_phase<pg8::ProbFin, pg8::EpiRes, true, true>(lds, P, SO, E);
        }
        SEAM(pb + 7);
        const bool whole = (l + 1 < DEPTH); const int nch = whole ? 1 : N_FFN_CHUNKS;
        for (int c = 0; c < nch; ++c) {
            const int pc = pb + 8 + 2 * c; const size_t r0 = (size_t)c * FFN_CHUNK; const int MT = whole ? NTOK / 256 : FFN_MT;
            if (PH_EN(11) && IN(pc)) {
                PHASE_BEGIN(); pg8::StaticOrder SO;
                pg8::ProbUp P; P.K = 2048; P.lda = 2048; P.ldb = 2048; P.tsplit = 1 << 30; P.adelta = 0; P.A = (const char*)(WSP(bf16_t, WS_HB) + r0 * 2048); P.B = (const char*)WSP(bf16_t, WS_WUP); P.chunk = c;
                SO.init(MT, D_FF / 128, G, bx);
                bf16_t* G2p = (bf16_t*)((unsigned char*)X - (size_t)FFN_GSPLIT_ROW * D_FF * 2); bf16_t* EBp = whole ? (bf16_t*)((unsigned char*)X + FFN_EB_OUT_OFF) : WSP(bf16_t, R_EB);
                pg8::EpiGlu E{WSP(bf16_t, R_G), WSP(const rss_t, WS_ROWSS) + (size_t)(l * 3 + 2) * NTOK + r0, WSP(const u32x4, WS_CWT), c, (LAS float*)(lds + GLX_OFF), EBp, G2p, whole ? FFN_GSPLIT_ROW / 256 : (1 << 30)};
                pg8::gemm_phase<pg8::ProbUp, pg8::EpiGlu, true, true>(lds, P, SO, E);
            }
            SEAM(pc);
            if (PH_EN(13) && IN(pc + 1)) {
                PHASE_BEGIN(); pg8::StaticOrder SO;
                bf16_t* G2p = (bf16_t*)((unsigned char*)X - (size_t)FFN_GSPLIT_ROW * D_FF * 2);
                {
                  const bf16_t* EBp = whole ? (const bf16_t*)((unsigned char*)X + FFN_EB_OUT_OFF) : WSP(const bf16_t, R_EB); const u32x4* cwp = WSP(const u32x4, WS_CWT); bf16_t* Gp = WSP(bf16_t, R_G);
                  const int nb = whole ? 244 : (c == 0 ? 124 : 120), gsr = whole ? FFN_GSPLIT_ROW : (1 << 30);
                  for (int it = gw; it < nb * 11; it += NGW) { const int b = it / 11, cb = it - b * 11; int t;
                      if (whole ? b < 124 : c == 0) { const int sq = b / 31, bi = b - sq * 31; t = sq * S_P + 256 * (bi + 1); }
                      else { const int b2 = whole ? b - 124 : b, sq = b2 / 15, bi = b2 - sq * 15; t = (whole ? NTOK_P : 0) + sq * S_S + 256 * (bi + 1); }
                      pg8::ffn_fix_item(EBp, cwp, Gp, G2p, gsr, t, cb, lane); }
                  XcdBarrier b4_ = bar; asm volatile("" : "+s"(b4_.bar), "+s"(b4_.x)); xcd_barrier(b4_); }
                pg8::ProbDown P; P.K = D_FF; P.lda = D_FF; P.ldb = D_FF; P.tsplit = 1 << 30; P.adelta = 0; P.A = (const char*)(ws + R_G); P.A2 = (const char*)G2p; P.B = (const char*)WSP(bf16_t, WS_WDOWN); P.split = whole ? FFN_GSPLIT_ROW / 256 : (1 << 30);
                SO.init(MT, 8, G, bx);
                pg8::EpiRes E{WSP(bf16_t, WS_HB) + r0 * 2048, (l + 1 < DEPTH) ? WSP(rss_t, WS_ROWSS) + (size_t)((l + 1) * 3 + 0) * NTOK + r0 : nullptr, (l + 1 < DEPTH) ? nullptr : X + r0 * 2048};
                pg8::gemm_phase<pg8::ProbDown, pg8::EpiRes, true, true>(lds, P, SO, E);
                if (c == nch - 1 && l + 1 < DEPTH) CONV_ITEMS(l + 1, CG_UP);
            }
            SEAM(pc + 1);
        }
    }
#undef IN
#undef SEAM
#undef PHASE_BEGIN
#undef INP
#undef WSP
}


#ifdef SELFCHECK
constexpr int CHK_WORD = 1024;
__device__ __forceinline__ void chk_upd(unsigned* ctl, int idx, float got, float ref) { const float e = fabsf(got - ref) / (0.03f * fabsf(ref) + 0.03f); atomicMax(ctl + CHK_WORD + idx, __float_as_uint(e)); }
__device__ __forceinline__ int chk_token(int s) { const int tab[16] = {0, 1, 127, 128, 4095, 8191, 8192, 12345, 32767, 32768, 32769, 36863, 36864, 50000, 65534, 65535}; int t = 0;
#pragma unroll
    for (int i = 0; i < 16; ++i) t = (s & 15) == i ? tab[i] : t; return t; }
__global__ void __launch_bounds__(64) check_kernel(Args args, int after, int l) {
    const int s = blockIdx.x, lane = threadIdx.x; unsigned char* ws = args.ws; unsigned* ctl = (unsigned*)(ws + WS_CTL);
    const int tok = chk_token(s); float* X = args.out;
    const float* xin = tok < NTOK_P ? args.in[0] + (size_t)tok * 2048 : args.in[1] + (size_t)(tok - NTOK_P) * 2048;
    if (after == 1) {
        if (l == 0) {
            float ssx = 0.f; for (int k = lane; k < 2048; k += 64) ssx += xin[k] * xin[k]; ssx = wave_sum(ssx); const float rstd = 1.0f / sqrtf(ssx / 2048.f + EPS);
            const int vec = (s * 7) & 31, isk = vec >> 4, hc = vec & 15;
            const float* w_in = args.in[5]; const float* g_mix = args.in[4]; const int col = isk * 1024 + hc * 64 + lane;
            float z = 0.f; for (int k = 0; k < 2048; ++k) z += xin[k] * rstd * g_mix[k] * w_in[(size_t)k * 4096 + col];
            const float ss = wave_sum(z * z); const float g = (isk ? args.in[7] : args.in[6])[lane]; const float zn = z / sqrtf(ss / 64.f + EPS) * g;
            const float other = __shfl_xor(zn, 32); const int i = lane & 31; const int pos = tok_pos(tok);
            const float ang = (float)pos * powf(10000.f, -(float)i / 32.f); const float c = cosf(ang), sn = sinf(ang);
            const float ref = lane < 32 ? zn * c - other * sn : zn * c + other * sn;
            const bf16_t* Q = (const bf16_t*)(ws + (isk ? R_K : R_Q)); const float got = bf2f(Q[(size_t)tok * 1024 + hc * 64 + lane]);
            const float gother = __shfl_xor(got, 32);
            (void)gother; chk_upd(ctl, 0, got, ref);
            { const unsigned tv = ((const unsigned*)(ws + WS_COS))[pos * 32 + i]; typedef _Float16 h2 __attribute__((ext_vector_type(2))); const h2 hv = __builtin_bit_cast(h2, tv);
              chk_upd(ctl, 1, (float)hv.x, c); chk_upd(ctl, 1, (float)hv.y, sn); }
        }
        { const bf16_t* Q = (const bf16_t*)(ws + R_Q); bf16_t* sv = (bf16_t*)(ws + WS_CHK) + s * 128; const int h = s & 7; sv[lane] = Q[(size_t)tok * 1024 + h * 128 + lane]; sv[lane + 64] = Q[(size_t)tok * 1024 + h * 128 + 64 + lane]; }
    }
    if (after == 2) {
        const int h = s & 7; const bf16_t* sv = (const bf16_t*)(ws + WS_CHK) + s * 128; const int S = tok_seqlen(tok); const size_t t0 = (size_t)tok - tok_pos(tok);
        const bf16_t* K = (const bf16_t*)(ws + R_K) + t0 * 1024 + h * 128; const bf16_t* V = (const bf16_t*)(ws + R_V) + t0 * 1024 + h * 128;
        const float lam_init = 0.8f - 0.6f * expf(-0.3f * (float)l); float s1 = 0.f, s2 = 0.f;
        for (int i = 0; i < 64; ++i) { s1 += (args.in[8] + l * 64)[i] * (args.in[9] + l * 64)[i]; s2 += (args.in[10] + l * 64)[i] * (args.in[11] + l * 64)[i]; }
        const float lam = expf(s1) - expf(s2) + lam_init;
        float o[2][2];
        for (int c = 0; c < 2; ++c) { float mx = -1e30f;
            for (int k = lane; k < S; k += 64) { float d = 0.f; for (int e = 0; e < 64; ++e) d += bf2f(sv[c * 64 + e]) * bf2f(K[(size_t)k * 1024 + c * 64 + e]); mx = fmaxf(mx, d); }
            for (int o_ = 1; o_ < 64; o_ <<= 1) mx = fmaxf(mx, __shfl_xor(mx, o_));
            float lsum = 0.f, a0 = 0.f, a1 = 0.f;
            for (int k = 0; k < S; ++k) { float d = 0.f; for (int e = 0; e < 64; ++e) d += bf2f(sv[c * 64 + e]) * bf2f(K[(size_t)k * 1024 + c * 64 + e]);
                const float p = exp2f(d - mx); lsum += p; a0 += p * bf2f(V[(size_t)k * 1024 + lane]); a1 += p * bf2f(V[(size_t)k * 1024 + 64 + lane]); }
            o[c][0] = a0 / lsum; o[c][1] = a1 / lsum; }
        const float v0 = o[0][0] - lam * o[1][0], v1 = o[0][1] - lam * o[1][1]; const float ss = wave_sum(v0 * v0 + v1 * v1); const float rn = 1.0f / sqrtf(ss / 128.f + EPS) * (1.f - lam_init);
        const float* gsub = args.in[12] + l * 128; const bf16_t* A = (const bf16_t*)(ws + R_Q) + (size_t)tok * 1024 + h * 128;
        chk_upd(ctl, 2, bf2f(A[lane]), v0 * rn * gsub[lane]); chk_upd(ctl, 2, bf2f(A[64 + lane]), v1 * rn * gsub[64 + lane]);
    }
    if (after == 4 && l == 0) {
        const bf16_t* A = (const bf16_t*)(ws + R_Q) + (size_t)tok * 1024; const bf16_t* Pp = (const bf16_t*)(ws + R_POUT) + (size_t)tok * 1024; const float* w_out = args.in[15];
        const int col = (s * 131 + lane * 17) & 2047; float z = xin[col];
        for (int k = 0; k < 1024; ++k) z += bf2f(A[k]) * w_out[(size_t)k * 2048 + col];
        for (int k = 0; k < 1024; ++k) z += bf2f(Pp[k]) * w_out[(size_t)(1024 + k) * 2048 + col];
        chk_upd(ctl, 3, X[(size_t)tok * 2048 + col], z);
    }
    if (after == 8 && tok < FFN_CHUNK) {
        const bf16_t* HB = (const bf16_t*)(ws + WS_HB); const float* w_up = args.in[24] + (size_t)l * 2048 * UP_W; const float* g_ffn = args.in[23] + l * 2048;
        const float* cw = args.in[25] + (size_t)l * 3 * UP_W; const float* cb = args.in[26] + (size_t)l * UP_W;
        const int j = (s * 977 + lane * 53) % D_FF; const int pos = tok_pos(tok), S = tok_seqlen(tok); float u2[2];
        for (int half = 0; half < 2; ++half) { const int col = half * D_FF + j; float acc = cb[col];
            for (int tap = 0; tap < 3; ++tap) { const int pp = pos + tap - 1; if (pp < 0 || pp >= S) continue; const bf16_t* hr = HB + (size_t)(tok + tap - 1) * 2048; float d = 0.f;
                for (int k = 0; k < 2048; ++k) d += bf2f(hr[k]) * g_ffn[k] * w_up[(size_t)k * UP_W + col];
                const float rxx = ss_rstd(((const rss_t*)(ws + WS_ROWSS))[(size_t)(l * 3 + 2) * NTOK + tok + tap - 1]); acc += d * rxx * cw[(size_t)tap * UP_W + col]; }
            u2[half] = acc; }
        const float x = u2[0]; const float ref = 0.5f * x * (1.f + tanhf(0.7978845608028654f * (x + 0.044715f * x * x * x))) * u2[1];
        chk_upd(ctl, 4, bf2f(((const bf16_t*)(ws + R_G))[(size_t)tok * D_FF + j]), ref);
    }
    if (false) {
        const bf16_t* Gr = (const bf16_t*)(ws + R_G) + (size_t)tok * D_FF; const float* w_down = args.in[27] + (size_t)l * D_FF * 2048; const float* svx = (const float*)(ws + WS_CHK + 65536) + (size_t)s * 2048;
        const int col = (s * 131 + lane * 17) & 2047; float z = svx[col]; for (int k = 0; k < D_FF; ++k) z += bf2f(Gr[k]) * w_down[(size_t)k * 2048 + col];
        chk_upd(ctl, 5, X[(size_t)tok * 2048 + col], z);
    }
}
__global__ void __launch_bounds__(256) report_kernel(Args args) {
    unsigned* ctl = (unsigned*)(args.ws + WS_CTL); float* out = args.out;
    for (size_t i = (size_t)blockIdx.x * 256 + threadIdx.x; i < (size_t)NTOK * 2048; i += (size_t)gridDim.x * 256) {
        float v = 0.f;
        if (i == 0) { int mask = 0; for (int b = 0; b < 6; ++b) if (__uint_as_float(ctl[CHK_WORD + b]) > 1.0f) mask |= 1 << b; v = (10.f + (float)mask) * 1000.f; }
        out[i] = v; }
}
#endif

extern "C" void kernel_launch(void* const* d_in, const int* in_sizes, int n_in, void* d_out, int out_size, void* d_ws, size_t ws_size, hipStream_t stream) {
    static int grid = 0;
    if (grid == 0) {
        if (n_in != 28 || out_size != NTOK * D_MODEL || ws_size < WS_END) { fprintf(stderr, "kernel_launch: unexpected shapes: n_in %d out %d ws %zu (need >= %zu)\n", n_in, out_size, ws_size, (size_t)WS_END); grid = -1; return; }
        int dev = 0, cus = 0, per_cu = 0;
        if (hipGetDevice(&dev) != hipSuccess || hipDeviceGetAttribute(&cus, hipDeviceAttributeMultiprocessorCount, dev) != hipSuccess) { grid = -1; return; }
        if (hipFuncSetAttribute((const void*)trunk_fwd, hipFuncAttributeMaxDynamicSharedMemorySize, LDS_BYTES) != hipSuccess) { fprintf(stderr, "kernel_launch: hipFuncSetAttribute failed\n"); grid = -1; return; }
        if (hipOccupancyMaxActiveBlocksPerMultiprocessor(&per_cu, (const void*)trunk_fwd, NWAVES * 64, LDS_BYTES) != hipSuccess || per_cu < 1)
            fprintf(stderr, "kernel_launch: occupancy query reports %d workgroups per CU\n", per_cu);
        (void)hipGetLastError();
        grid = cus;
    }
    if (grid < 0) return;
    (void)hipMemsetAsync((char*)d_ws + WS_CTL, 0, CTL_ZERO_BYTES, stream);
    Args a{};
    for (int i = 0; i < 28; ++i) a.in[i] = (const float*)d_in[i];
    a.out = (float*)d_out; a.ws = (unsigned char*)d_ws;
#if ML_PER_PHASE
    for (int p = 0; p < N_PHASES; ++p) { a.ph_lo = p; a.ph_hi = p + 1; hipLaunchKernelGGL(trunk_fwd, dim3(grid), dim3(NWAVES * 64), LDS_BYTES, stream, a);
#ifdef SELFCHECK
        { const int l = p / PH_PER_LAYER, q = p % PH_PER_LAYER; if (l == SELFCHECK_LAYER && (q == 1 || q == 2 || q == 8)) hipLaunchKernelGGL(check_kernel, dim3(64), dim3(64), 0, stream, a, q, l); }
#endif
    }
#ifdef SELFCHECK
    hipLaunchKernelGGL(report_kernel, dim3(2048), dim3(256), 0, stream, a);
#endif
#else
    a.ph_lo = 0; a.ph_hi = N_PHASES;
    hipLaunchKernelGGL(trunk_fwd, dim3(grid), dim3(NWAVES * 64), LDS_BYTES, stream, a);
#endif
    const hipError_t le = hipPeekAtLastError();
    if (le != hipSuccess) fprintf(stderr, "kernel_launch: launch failed: %s\n", hipGetErrorName(le));
}
```

```cpp
#include <hip/hip_runtime.h>
#include <cstdio>
#include <cstdint>

#define SELFCHECK_LAYER 0
#ifndef ML_PER_PHASE
#define ML_PER_PHASE 0
#endif

#ifndef PHASE_MASK
#define PHASE_MASK 0xFFFFFFFFu
#endif
#define PH_EN(p) (((PHASE_MASK) >> (p)) & 1u)
#ifndef ATTN_NS
#define ATTN_NS att16
#endif
#define LAS __attribute__((address_space(3)))
#define GAS __attribute__((address_space(1)))
typedef unsigned short bf16_t;
typedef short bf16x8 __attribute__((ext_vector_type(8)));
typedef short s16x4 __attribute__((ext_vector_type(4)));
typedef float f32x4 __attribute__((ext_vector_type(4)));
typedef float f32x2 __attribute__((ext_vector_type(2)));
typedef float f32x16 __attribute__((ext_vector_type(16)));
typedef unsigned u32x4 __attribute__((ext_vector_type(4)));
typedef unsigned u32x2 __attribute__((ext_vector_type(2)));
typedef _Float16 h2_t __attribute__((ext_vector_type(2)));
typedef _Float16 f16x8 __attribute__((ext_vector_type(8)));

constexpr int D_MODEL = 2048, DEPTH = 2;
constexpr int NTOK = 65536;
constexpr int NTOK_P = 32768;
constexpr int S_P = 8192, S_S = 4096;
constexpr int NMEMROWS = 3072;
constexpr int IN_W = 4096, D_FF = 5632, UP_W = 11264;
constexpr float EPS = 1e-6f;
constexpr float QSCALE = 0.125f * 1.4426950408889634f;
constexpr int FFN_CHUNK = 32768, N_FFN_CHUNKS = 2;
constexpr int FFN_MT = FFN_CHUNK / 256, FFN_BT = 0;
constexpr int PH_PER_LAYER = 8 + 2 * N_FFN_CHUNKS;
constexpr int N_PHASES = DEPTH * PH_PER_LAYER;

constexpr size_t MiB = 1u << 20;
constexpr size_t WS_CTL = 0, CTL_ZERO_BYTES = 5 * MiB;
constexpr size_t WS_ROWSS = 1 * MiB;
constexpr size_t WS_COS = 5 * MiB;
constexpr size_t WS_QSS = 6 * MiB;
constexpr size_t WS_LPART = 14 * MiB;
constexpr size_t WS_MB = 18 * MiB;
constexpr size_t WS_KRAW = 30 * MiB;
constexpr size_t WS_KC = 54 * MiB;
constexpr size_t WS_VT = 66 * MiB;
constexpr size_t WS_CHK = 78 * MiB;
constexpr size_t WS_WIN = 79 * MiB, WS_WP = 95 * MiB, WS_WOUT = 96 * MiB, WS_WCQ = 104 * MiB, WS_WCKV = 112 * MiB, WS_WCO = 128 * MiB, WS_WUP = 136 * MiB, WS_WDOWN = 180 * MiB;
constexpr size_t WS_HB = 203 * MiB;
constexpr size_t WS_R = 459 * MiB;
constexpr size_t WS_CWT = 987 * MiB;
constexpr size_t WS_END = 988 * MiB;
typedef unsigned long long rss_t;
__device__ __forceinline__ rss_t ss_fix(float s) { return (rss_t)(s * 1048576.0f + 0.5f); }
__device__ __forceinline__ float ss_rstd(rss_t v) { return __builtin_amdgcn_rsqf((float)v * (1.0f / (1048576.0f * 2048.0f)) + 1e-6f); }
constexpr size_t R_Q = WS_R, R_K = WS_R + 128 * MiB, R_V = WS_R + 256 * MiB, R_U = WS_R + 384 * MiB;
constexpr size_t R_QC = WS_R, R_P = WS_R + 256 * MiB, R_VW = WS_R + 384 * MiB;
constexpr size_t R_G = WS_R;
constexpr int FFN_GSPLIT_ROW = 49152;
constexpr size_t FFN_EB_OUT_OFF = 192 * MiB;
constexpr size_t R_EB = WS_R + 384 * MiB;
constexpr size_t R_POUT = WS_R + 128 * MiB;
static_assert(R_G + (size_t)FFN_CHUNK * D_FF * 2 <= WS_END, "ws map");
constexpr int CW_BAR = 4096;

constexpr int RING_BYTES = 131072;
constexpr int LDSCTL_OFF = RING_BYTES, MISC_OFF = LDSCTL_OFF + 320, XCH_OFF = LDSCTL_OFF + 1024, GLX_OFF = XCH_OFF + 4096;
constexpr int LDS_BYTES = 151552;
constexpr int NWAVES = 8;

__device__ __forceinline__ unsigned cvt_pk_bf16(float lo, float hi) { unsigned r; asm volatile("v_cvt_pk_bf16_f32 %0, %1, %2" : "=v"(r) : "v"(lo), "v"(hi)); return r; }
__device__ __forceinline__ float bf2f(unsigned short b) { return __uint_as_float(((unsigned)b) << 16); }
__device__ __forceinline__ float bflo(unsigned w) { return __uint_as_float(w << 16); }
__device__ __forceinline__ float bfhi(unsigned w) { return __uint_as_float(w & 0xffff0000u); }
__device__ __forceinline__ int tok_pos(int row) { return row < NTOK_P ? (row & (S_P - 1)) : (row & (S_S - 1)); }
__device__ __forceinline__ int tok_seqlen(int row) { return row < NTOK_P ? S_P : S_S; }
__device__ __forceinline__ int tile_batch(int pm) { return pm < 128 ? (pm >> 5) : 4 + ((pm - 128) >> 4); }

namespace pg8 {
constexpr int BM = 256, BK = 64, HALF = 128, HTB = HALF * BK * 2, STAGE_BYTES = 8 * HTB, NXCD = 8, WGM = 4;
__host__ __device__ __forceinline__ int lds_byte(int r, int c) { const int st = (r >> 4) * 2 + (c >> 5), rr = r & 15, cc = c & 31, ob = rr * 64 + cc * 2; return st * 1024 + (ob ^ (((ob >> 9) & 1) << 5)); }
__host__ __device__ __forceinline__ void stage_rc(int b, int& R, int& C) { const int st = b / 1024, sb = b % 1024, swz = sb ^ (((sb >> 9) & 1) << 5); R = (st >> 1) * 16 + swz / 64; C = (st & 1) * 32 + (swz % 64) / 2; }
__host__ __device__ __forceinline__ int perm32(int rho) { const int n = rho >> 4, i = rho & 15; return 8 * (i >> 2) + 4 * n + (i & 3); }
struct Unit { int pm, pn; };
struct StaticOrder {
    int nM, nN, nwg, G, c, rv;
    __host__ __device__ void init(int nM_, int nN_, int G_, int c_, int rv_ = 0) { nM = nM_; nN = nN_; nwg = nM * nN; G = G_; c = c_; rv = rv_; }
    __host__ __device__ bool next(int i, Unit& u) const {
        const long L = (long)i * G + c; if (L >= nwg) return false;
        int wgid = (int)L; { const int q = nwg / NXCD, r = nwg % NXCD, xcd = wgid % NXCD; int off = wgid / NXCD; if (rv && r == 0) off = q - 1 - off; wgid = (xcd < r ? xcd * (q + 1) : r * (q + 1) + (xcd - r) * q) + off; }
        const int nig = WGM * nN, gid = wgid / nig, fm = gid * WGM, gsz = (nM - fm) < WGM ? (nM - fm) : WGM;
        u.pm = fm + ((wgid % nig) % gsz); u.pn = (wgid % nig) / gsz; return true;
    }
};
struct ProbBase { static constexpr bool GATHER = false; static constexpr bool F16 = false; int K, lda, ldb, tsplit; long long adelta; __device__ __forceinline__ unsigned rowoff(const Unit&, int) const { return 0u; } };

template <class Prob, class Epi, bool ALIGN_EPI, bool SP2>
__device__ __forceinline__ void gemm_phase(LAS unsigned char* lds, const Prob& P, const StaticOrder& S, const Epi& E) {
    static_assert(SP2, "only the two-super-phase loop is kept in this file");
    int tid_l = threadIdx.x; asm volatile("" : "+v"(tid_l));
    const int tid = tid_l, wid = __builtin_amdgcn_readfirstlane(tid >> 6), lane = tid & 63, wr = wid >> 2, wc = wid & 3, fr = lane & 15, fq = lane >> 4;
    const int K = P.K, nt = K / BK, lda = P.lda, ldb = P.ldb, tsplit = P.tsplit; const long long adelta = P.adelta;
    unsigned voffA[2], voffB[2];
#pragma unroll
    for (int i = 0; i < 2; ++i) { int R, C; stage_rc(tid * 16 + i * 8192, R, C); const int Rb = Epi::PERM ? ((R & ~31) + perm32(R & 31)) : R;
        voffA[i] = (unsigned)(R * lda + C) * 2u; voffB[i] = (unsigned)(Rb * ldb + C) * 2u; }
    const size_t kstep = (size_t)(BK * 2);
    const size_t hstepA = (size_t)HALF * lda * 2, hstepB = (size_t)HALF * ldb * 2;
    const unsigned ldsw = (unsigned)wid * 1024u;
    const int aoff = lds_byte(wr * 64 + fr, fq * 8), boff = lds_byte(wc * 32 + fr, fq * 8);
    unsigned vAc[2][2], vAn[2][2];
#define PG8_SA(b, h) (((b) * 2 + (h)) * HTB)
#define PG8_SB(b, h) ((4 + (b) * 2 + (h)) * HTB)
#define PG8_STAGE(bufoff, gbase, voff) do { _Pragma("unroll") for (int _i = 0; _i < 2; ++_i) \
        __builtin_amdgcn_global_load_lds((const unsigned*)((const char*)(gbase) + (voff)[_i]), (LAS unsigned*)(lds + (bufoff) + ldsw + _i * 8192), 16, 0, 0); } while (0)
#define PG8_STAGE_A(bufoff, kptr, h, NXT) do { if constexpr (Prob::GATHER) { _Pragma("unroll") for (int _i = 0; _i < 2; ++_i) \
        __builtin_amdgcn_global_load_lds((const unsigned*)((const char*)(kptr) + ((NXT) ? vAn[h][_i] : vAc[h][_i])), (LAS unsigned*)(lds + (bufoff) + ldsw + _i * 8192), 16, 0, 0); } \
        else { PG8_STAGE(bufoff, (kptr) + (h) * hstepA, voffA); } } while (0)
#define PG8_GATHER_OFFS(dst, unit) do { _Pragma("unroll") for (int _i = 0; _i < 2; ++_i) { int _R, _C; stage_rc(tid * 16 + _i * 8192, _R, _C); _Pragma("unroll") for (int _h = 0; _h < 2; ++_h) dst[_h][_i] = P.rowoff(unit, _R + 128 * _h) + (unsigned)_C * 2u; } } while (0)
#define PG8_LDA(dst, b, h) do { _Pragma("unroll") for (int m = 0; m < 4; ++m) _Pragma("unroll") for (int k = 0; k < 2; ++k) dst[m][k] = *(const LAS bf16x8*)(lds + PG8_SA(b, h) + aoff + m * 2048 + k * 1024); } while (0)
#define PG8_LDB(dst, b, h) do { _Pragma("unroll") for (int n = 0; n < 2; ++n) _Pragma("unroll") for (int k = 0; k < 2; ++k) dst[n][k] = *(const LAS bf16x8*)(lds + PG8_SB(b, h) + boff + n * 2048 + k * 1024); } while (0)
#define PG8_MMA(ai, bj, At, Bt) do { __builtin_amdgcn_s_setprio(1); _Pragma("unroll") for (int m = 0; m < 4; ++m) _Pragma("unroll") for (int n = 0; n < 2; ++n) _Pragma("unroll") for (int k = 0; k < 2; ++k) \
        { if constexpr (Prob::F16) acc[ai][bj][m][n] = __builtin_amdgcn_mfma_f32_16x16x32_f16(__builtin_bit_cast(f16x8, Bt[n][k]), __builtin_bit_cast(f16x8, At[m][k]), acc[ai][bj][m][n], 0, 0, 0); \
          else acc[ai][bj][m][n] = __builtin_amdgcn_mfma_f32_16x16x32_bf16(Bt[n][k], At[m][k], acc[ai][bj][m][n], 0, 0, 0); } __builtin_amdgcn_s_setprio(0); } while (0)
#define PG8_WAIT_V(n) asm volatile("s_waitcnt vmcnt(" #n ")" ::: "memory")
#define PG8_WAIT_L(n) asm volatile("s_waitcnt lgkmcnt(" #n ")" ::: "memory")
#define PG8_BAR __builtin_amdgcn_s_barrier()
#define PG8_SCHED __builtin_amdgcn_sched_barrier(0)
#define PG8_AK(base, t) ((base) + (size_t)(t) * kstep + (((t) >= tsplit) ? adelta : 0ll))
    Unit cur, nxt; int ui = 0;
    if (!S.next(0, cur)) return;
    f32x4 acc[2][2][4][2];
#pragma unroll
    for (int a = 0; a < 2; ++a)
#pragma unroll
        for (int b = 0; b < 2; ++b)
#pragma unroll
            for (int m = 0; m < 4; ++m)
#pragma unroll
                for (int n = 0; n < 2; ++n) acc[a][b][m][n] = (f32x4){0.f, 0.f, 0.f, 0.f};
    bf16x8 At[4][2], B0[2][2], B1[2][2];
    const char* cA = P.aptr(cur); const char* cB = P.bptr(cur);
    if constexpr (Prob::GATHER) { PG8_GATHER_OFFS(vAc, cur); }
    PG8_STAGE(PG8_SB(0, 0), cB, voffB); PG8_STAGE(PG8_SB(0, 1), cB + hstepB, voffB); PG8_STAGE_A(PG8_SA(0, 0), cA, 0, false); PG8_STAGE_A(PG8_SA(0, 1), cA, 1, false);
    if (wr == 1) PG8_BAR;
    PG8_WAIT_V(2); PG8_BAR;
    PG8_STAGE(PG8_SB(1, 0), cB + kstep, voffB); PG8_STAGE_A(PG8_SA(1, 0), PG8_AK(cA, 1), 0, false); PG8_STAGE(PG8_SB(1, 1), cB + hstepB + kstep, voffB);
    PG8_WAIT_V(6); PG8_BAR;
    for (;;) {
        const bool has_next = S.next(ui + 1, nxt);
        const char* nA = has_next ? P.aptr(nxt) : cA; const char* nB = has_next ? P.bptr(nxt) : cB;
        if constexpr (Prob::GATHER) { if (has_next) { PG8_GATHER_OFFS(vAn, nxt); } else {
#pragma unroll
            for (int _h = 0; _h < 2; ++_h)
#pragma unroll
                for (int _i = 0; _i < 2; ++_i) vAn[_h][_i] = vAc[_h][_i]; } }
        for (int t = 0; t < nt; t += 2) {
            const bool last = (t == nt - 2);
            const char* a1 = PG8_AK(cA, t + 1);
            const char* a2 = last ? nA : PG8_AK(cA, t + 2); const char* b2 = last ? nB : cB + (size_t)(t + 2) * kstep;
            const char* a3 = last ? PG8_AK(nA, 1) : PG8_AK(cA, t + 3); const char* b3 = b2 + kstep;
            PG8_LDB(B0, 0, 0); PG8_LDB(B1, 0, 1); PG8_SCHED; PG8_LDA(At, 0, 0); PG8_STAGE_A(PG8_SA(1, 1), a1, 1, false);
            PG8_WAIT_V(8); PG8_WAIT_L(0); PG8_BAR; PG8_MMA(0, 0, At, B0); PG8_MMA(0, 1, At, B1); PG8_BAR; PG8_SCHED;
            PG8_LDA(At, 0, 1); PG8_STAGE(PG8_SB(0, 0), b2, voffB); PG8_STAGE(PG8_SB(0, 1), b2 + hstepB, voffB); PG8_STAGE_A(PG8_SA(0, 0), a2, 0, last);
            PG8_WAIT_V(8); PG8_WAIT_L(0); PG8_BAR; PG8_MMA(1, 0, At, B0); PG8_MMA(1, 1, At, B1); PG8_BAR; PG8_SCHED;
            PG8_LDB(B0, 1, 0); PG8_LDB(B1, 1, 1); PG8_SCHED; PG8_LDA(At, 1, 0); PG8_STAGE_A(PG8_SA(0, 1), a2, 1, last);
            PG8_WAIT_V(8); PG8_WAIT_L(0); PG8_BAR; PG8_MMA(0, 0, At, B0); PG8_MMA(0, 1, At, B1); PG8_BAR; PG8_SCHED;
            PG8_LDA(At, 1, 1); PG8_STAGE(PG8_SB(1, 0), b3, voffB); PG8_STAGE(PG8_SB(1, 1), b3 + hstepB, voffB); PG8_STAGE_A(PG8_SA(1, 0), a3, 0, last);
            PG8_WAIT_V(8); PG8_WAIT_L(0); PG8_BAR; PG8_MMA(1, 0, At, B0); PG8_MMA(1, 1, At, B1); PG8_BAR; PG8_SCHED;
        }
        if constexpr (ALIGN_EPI) { if (wr == 0) PG8_BAR; }
        { int te = threadIdx.x; asm volatile("" : "+v"(te));
          const int we = __builtin_amdgcn_readfirstlane(te >> 6), le = te & 63; E(acc, cur, we >> 2, we & 3, le & 15, le >> 4); }
        if (!has_next) break;
#pragma unroll
        for (int a = 0; a < 2; ++a)
#pragma unroll
            for (int b = 0; b < 2; ++b)
#pragma unroll
                for (int m = 0; m < 4; ++m)
#pragma unroll
                    for (int n = 0; n < 2; ++n) acc[a][b][m][n] = (f32x4){0.f, 0.f, 0.f, 0.f};
        cur = nxt; cA = nA; cB = nB; ++ui;
        if constexpr (Prob::GATHER) {
#pragma unroll
            for (int _h = 0; _h < 2; ++_h)
#pragma unroll
                for (int _i = 0; _i < 2; ++_i) vAc[_h][_i] = vAn[_h][_i]; }
        if constexpr (ALIGN_EPI) { if (wr == 1) PG8_BAR; }
    }
    PG8_WAIT_V(0);
    if constexpr (!ALIGN_EPI) { if (wr == 0) PG8_BAR; }
    PG8_BAR;
#undef PG8_SA
#undef PG8_SB
#undef PG8_STAGE
#undef PG8_STAGE_A
#undef PG8_GATHER_OFFS
#undef PG8_LDA
#undef PG8_LDB
#undef PG8_MMA
#undef PG8_WAIT_V
#undef PG8_WAIT_L
#undef PG8_BAR
#undef PG8_SCHED
#undef PG8_AK
}

struct ProbSimple : ProbBase {
    const char* A; const char* B;
    __device__ __forceinline__ const char* aptr(const Unit& u) const { return A + (size_t)u.pm * 256 * lda * 2; }
    __device__ __forceinline__ const char* bptr(const Unit& u) const { return B + (size_t)u.pn * 256 * ldb * 2; }
};
struct ProbSimpleF16 : ProbSimple { static constexpr bool F16 = true; };
struct ProbDown : ProbBase {
    static constexpr bool F16 = true;
    const char* A; const char* A2; const char* B; int split;
    __device__ __forceinline__ const char* aptr(const Unit& u) const { return (u.pm < split ? A : A2) + (size_t)u.pm * 256 * lda * 2; }
    __device__ __forceinline__ const char* bptr(const Unit& u) const { return B + (size_t)u.pn * 256 * ldb * 2; }
};
struct ProbPool : ProbBase {
    const char* A; const char* B;
    __device__ __forceinline__ const char* aptr(const Unit& u) const { return A + ((size_t)u.pm * 256 * 1024 + (size_t)u.pn * 256) * 2; }
    __device__ __forceinline__ const char* bptr(const Unit& u) const { return B + (size_t)u.pn * 65536 * 2; }
};
struct ProbScores : ProbBase {
    const char* A; const char* B;
    __device__ __forceinline__ const char* aptr(const Unit& u) const { return A + ((size_t)u.pm * 256 * 2048 + (size_t)u.pn * 512) * 2; }
    __device__ __forceinline__ const char* bptr(const Unit& u) const { return B + ((size_t)tile_batch(u.pm) * 256 * 2048 + (size_t)u.pn * 512) * 2; }
};
struct ProbVW : ProbBase {
    const char* A; const char* B;
    __device__ __forceinline__ const char* aptr(const Unit& u) const { return A + ((size_t)u.pm * 256 * 2048 + (size_t)(u.pn & 3) * 512) * 2; }
    __device__ __forceinline__ const char* bptr(const Unit& u) const { return B + ((size_t)(u.pn >> 2) * 256 * 2048 + (size_t)(u.pn & 3) * 512) * 2; }
};
struct ProbFin : ProbBase {
    const char* A; const char* B;
    __device__ __forceinline__ const char* aptr(const Unit& u) const { return A + (size_t)u.pm * 256 * 1024 * 2; }
    __device__ __forceinline__ const char* bptr(const Unit& u) const { return B + ((size_t)tile_batch(u.pm) * 2048 + (size_t)u.pn * 256) * 1024 * 2; }
};
struct ProbPV : ProbBase {
    const char* A; const char* B;
    __device__ __forceinline__ const char* aptr(const Unit& u) const { return A + ((size_t)u.pm * 256 * 1024 + (size_t)(u.pn >> 1) * 256) * 2; }
    __device__ __forceinline__ const char* bptr(const Unit& u) const { return B + ((size_t)tile_batch(u.pm) * 2048 + (size_t)u.pn * 256) * 256 * 2; }
};

__device__ __forceinline__ u32x4 pack8(const f32x4& v0, const f32x4& v1) { u32x4 w; w.x = cvt_pk_bf16(v0[0], v0[1]); w.y = cvt_pk_bf16(v0[2], v0[3]); w.z = cvt_pk_bf16(v1[0], v1[1]); w.w = cvt_pk_bf16(v1[2], v1[3]); return w; }
__device__ __forceinline__ float sumsq4(const f32x4& x) { return (x[0] * x[0] + x[1] * x[1]) + (x[2] * x[2] + x[3] * x[3]); }
__device__ __forceinline__ float sum4(const f32x4& x) { return (x[0] + x[1]) + (x[2] + x[3]); }
__device__ __forceinline__ float red_fq(float s) { s += __shfl_xor(s, 16); s += __shfl_xor(s, 32); return s; }

struct EpiIn {
    static constexpr bool PERM = true;
    bf16_t* base; size_t spl; const unsigned* csT; const float* gq; const float* gk; const rss_t* rowss;
    __device__ __forceinline__ void operator()(const f32x4 (&acc)[2][2][4][2], const Unit& u, int wr, int wc, int fr, int fq) const {
        typedef _Float16 h2 __attribute__((ext_vector_type(2)));
        const int t = u.pn >> 2; bf16_t* O = base + (size_t)t * spl; const int colt = (u.pn & 3) * 256; const int row0 = u.pm * BM + wr * 64 + fr;
        if (t >= 2) {
            const int col0 = colt + wc * 32 + 8 * fq;
#pragma unroll
            for (int ai = 0; ai < 2; ++ai) { rss_t rx[4];
#pragma unroll
                for (int m = 0; m < 4; ++m) rx[m] = rowss[row0 + ai * HALF + m * 16];
#pragma unroll
                for (int m = 0; m < 4; ++m) { const float rxm = ss_rstd(rx[m]); bf16_t* rowp = O + (size_t)(row0 + ai * HALF + m * 16) * 1024 + col0;
#pragma unroll
                    for (int bj = 0; bj < 2; ++bj) *(u32x4*)(rowp + bj * HALF) = pack8(acc[ai][bj][m][0] * rxm, acc[ai][bj][m][1] * rxm); }
                asm volatile("" ::: "memory"); }
        } else {
            const float* g = t ? gk : gq; f32x4 g1[2], g2[2];
#pragma unroll
            for (int n = 0; n < 2; ++n) { g1[n] = *(const f32x4*)(g + 8 * fq + 4 * n); g2[n] = *(const f32x4*)(g + 32 + 8 * fq + 4 * n); }
            const int col0 = colt + 64 * wc + 8 * fq;
#pragma unroll
            for (int ah = 0; ah < 4; ++ah) { const int ai = ah >> 1, mb = (ah & 1) * 2;
                u32x4 cs[2][2]; rss_t rx[2];
#pragma unroll
                for (int mm = 0; mm < 2; ++mm) { const int m = mb + mm; const int pos = tok_pos(row0 + ai * HALF + m * 16); rx[mm] = rowss[row0 + ai * HALF + m * 16];
#pragma unroll
                    for (int n = 0; n < 2; ++n) cs[mm][n] = *(const u32x4*)(csT + pos * 32 + 8 * fq + 4 * n); }
#pragma unroll
                for (int mm = 0; mm < 2; ++mm) { const int m = mb + mm; const int row = row0 + ai * HALF + m * 16;
                    float ss = (sumsq4(acc[ai][0][m][0]) + sumsq4(acc[ai][0][m][1])) + (sumsq4(acc[ai][1][m][0]) + sumsq4(acc[ai][1][m][1]));
                    ss = red_fq(ss);
                    const float rxm = ss_rstd(rx[mm]);
                    const float r = __builtin_amdgcn_rsqf(ss * rxm * rxm * (1.0f / 64.0f) + EPS) * rxm * (t ? 1.0f : QSCALE);
                    f32x4 o1[2], o2[2];
#pragma unroll
                    for (int n = 0; n < 2; ++n) { f32x4 c, s;
#pragma unroll
                        for (int j = 0; j < 4; ++j) { const unsigned w = cs[mm][n][j]; const h2 v = __builtin_bit_cast(h2, w); c[j] = (float)v.x; s[j] = (float)v.y; }
                        const f32x4 x1 = acc[ai][0][m][n] * r * g1[n], x2 = acc[ai][1][m][n] * r * g2[n];
                        o1[n] = x1 * c - x2 * s; o2[n] = x2 * c + x1 * s; }
                    bf16_t* rowp = O + (size_t)row * 1024 + col0;
                    *(u32x4*)(rowp) = pack8(o1[0], o1[1]); *(u32x4*)(rowp + 32) = pack8(o2[0], o2[1]); }
                asm volatile("" ::: "memory"); }
        }
    }
};
template <int MODE> struct EpiBf {
    static constexpr bool PERM = true;
    bf16_t* O; int ldc; float* aux; float* aux2; LAS float* xl;
    __device__ __forceinline__ void operator()(f32x4 (&acc)[2][2][4][2], const Unit& u, int wr, int wc, int fr, int fq) const {
        const int row0 = u.pm * BM + wr * 64 + fr; const int col0 = u.pn * BM + wc * 32 + 8 * fq;
        float rs[2][4];
        if constexpr (MODE == 2) {
            f32x4 qa[2][4][2];
#pragma unroll
            for (int ai = 0; ai < 2; ++ai)
#pragma unroll
                for (int m = 0; m < 4; ++m) { const float* p = aux + (size_t)(row0 + ai * HALF + m * 16) * 32 + u.pn * 8; qa[ai][m][0] = *(const f32x4*)p; qa[ai][m][1] = *(const f32x4*)(p + 4); }
#pragma unroll
            for (int ai = 0; ai < 2; ++ai)
#pragma unroll
                for (int m = 0; m < 4; ++m) { const float sc = __builtin_amdgcn_rsqf((sum4(qa[ai][m][0]) + sum4(qa[ai][m][1])) * (1.0f / 512.0f) + EPS) * (0.044194173824159216f * 1.4426950408889634f); float ps = 0.f;
#pragma unroll
                    for (int bj = 0; bj < 2; ++bj)
#pragma unroll
                        for (int n = 0; n < 2; ++n) { f32x4 p;
#pragma unroll
                            for (int j = 0; j < 4; ++j) p[j] = __builtin_amdgcn_exp2f(acc[ai][bj][m][n][j] * sc);
                            acc[ai][bj][m][n] = p; ps += sum4(p); }
                    ps = red_fq(ps);
                    if (fq == 0) xl[(ai * HALF + wr * 64 + m * 16 + fr) * 4 + wc] = ps; }
            asm volatile("s_waitcnt lgkmcnt(0)" ::: "memory"); __builtin_amdgcn_s_barrier(); asm volatile("" ::: "memory");
#pragma unroll
            for (int ai = 0; ai < 2; ++ai)
#pragma unroll
                for (int m = 0; m < 4; ++m) { const f32x4 lv = *(const LAS f32x4*)(xl + (ai * HALF + wr * 64 + m * 16 + fr) * 4); rs[ai][m] = __builtin_amdgcn_rcpf(sum4(lv)); }
        }
        if constexpr (MODE == 1 || MODE == 4) { rss_t rv[2][4];
#pragma unroll
            for (int ai = 0; ai < 2; ++ai)
#pragma unroll
                for (int m = 0; m < 4; ++m) rv[ai][m] = ((const rss_t*)aux2)[row0 + ai * HALF + m * 16];
#pragma unroll
            for (int ai = 0; ai < 2; ++ai)
#pragma unroll
                for (int m = 0; m < 4; ++m) rs[ai][m] = ss_rstd(rv[ai][m]);
        }
        if constexpr (MODE == 3) {
            f32x4 la[2][4];
#pragma unroll
            for (int ai = 0; ai < 2; ++ai)
#pragma unroll
                for (int m = 0; m < 4; ++m) la[ai][m] = *(const f32x4*)(aux2 + (size_t)(row0 + ai * HALF + m * 16) * 16 + (u.pn >> 1) * 4);
#pragma unroll
            for (int ai = 0; ai < 2; ++ai)
#pragma unroll
                for (int m = 0; m < 4; ++m) rs[ai][m] = __builtin_amdgcn_rcpf(sum4(la[ai][m]));
        }
        bf16_t* Ob = O; int colb = col0;
        if constexpr (MODE == 5) { Ob = O + (size_t)(u.pn >> 2) * 2048 * 1024; colb = (u.pn & 3) * 256 + wc * 32 + 8 * fq; }
#pragma unroll
        for (int ai = 0; ai < 2; ++ai)
#pragma unroll
            for (int m = 0; m < 4; ++m) { const int row = row0 + ai * HALF + m * 16; bf16_t* rowp = Ob + (size_t)row * ldc + colb;
                if constexpr (MODE == 0 || MODE == 5) {
#pragma unroll
                    for (int bj = 0; bj < 2; ++bj) *(u32x4*)(rowp + bj * HALF) = pack8(acc[ai][bj][m][0], acc[ai][bj][m][1]);
                } else if constexpr (MODE == 1) {
                    float ss = (sumsq4(acc[ai][0][m][0]) + sumsq4(acc[ai][0][m][1])) + (sumsq4(acc[ai][1][m][0]) + sumsq4(acc[ai][1][m][1]));
                    ss = red_fq(ss); const float rxx = rs[ai][m];
                    if (fq == 0) aux[(size_t)row * 32 + u.pn * 4 + wc] = ss * rxx * rxx;
#pragma unroll
                    for (int bj = 0; bj < 2; ++bj) *(u32x4*)(rowp + bj * HALF) = pack8(acc[ai][bj][m][0] * rxx, acc[ai][bj][m][1] * rxx);
                } else {
                    const float rxx = rs[ai][m];
#pragma unroll
                    for (int bj = 0; bj < 2; ++bj) *(u32x4*)(rowp + bj * HALF) = pack8(acc[ai][bj][m][0] * rxx, acc[ai][bj][m][1] * rxx);
                }
            }
    }
};
struct EpiRes {
    static constexpr bool PERM = true;
    bf16_t* XB; rss_t* rowss; float* OUT;
    __device__ __forceinline__ void load_half(u32x4 (&t)[4][2], int row0, int col0, int ai) const {
#pragma unroll
        for (int m = 0; m < 4; ++m) { const bf16_t* rowb = XB + (size_t)(row0 + ai * HALF + m * 16) * D_MODEL + col0;
#pragma unroll
            for (int bj = 0; bj < 2; ++bj) t[m][bj] = *(const u32x4*)(rowb + bj * HALF); }
    }
    __device__ __forceinline__ void add_half(f32x4 (&acc)[2][2][4][2], const u32x4 (&t)[4][2], int ai) const {
#pragma unroll
        for (int m = 0; m < 4; ++m)
#pragma unroll
            for (int bj = 0; bj < 2; ++bj) { const u32x4 w = t[m][bj];
#define ADDS_(d, x) asm("v_add_f32 %0, %1, %0" : "+v"(d) : "v"(x))
                ADDS_(acc[ai][bj][m][0][0], bflo(w.x)); ADDS_(acc[ai][bj][m][0][1], bfhi(w.x)); ADDS_(acc[ai][bj][m][0][2], bflo(w.y)); ADDS_(acc[ai][bj][m][0][3], bfhi(w.y));
                ADDS_(acc[ai][bj][m][1][0], bflo(w.z)); ADDS_(acc[ai][bj][m][1][1], bfhi(w.z)); ADDS_(acc[ai][bj][m][1][2], bflo(w.w)); ADDS_(acc[ai][bj][m][1][3], bfhi(w.w));
#undef ADDS_
            }
    }
    __device__ __forceinline__ void store_half(const f32x4 (&acc)[2][2][4][2], int row0, int col0, int ai, int fq) const {
#pragma unroll
        for (int m = 0; m < 4; ++m) { const int row = row0 + ai * HALF + m * 16; bf16_t* rowb = XB + (size_t)row * D_MODEL + col0; float ss = 0.f;
#pragma unroll
            for (int bj = 0; bj < 2; ++bj) { const f32x4 v0 = acc[ai][bj][m][0], v1 = acc[ai][bj][m][1];
                if (OUT) { float* rowp = OUT + (size_t)row * D_MODEL + col0 + bj * HALF; *(f32x4*)rowp = v0; *(f32x4*)(rowp + 4) = v1; }
                else { *(u32x4*)(rowb + bj * HALF) = pack8(v0, v1); ss += sumsq4(v0) + sumsq4(v1); } }
            if (rowss) { ss = red_fq(ss); if (fq == 0) atomicAdd(rowss + row, ss_fix(ss)); } }
    }
    __device__ __forceinline__ void operator()(f32x4 (&acc)[2][2][4][2], const Unit& u, int wr, int wc, int fr, int fq) const {
        const int row0 = u.pm * BM + wr * 64 + fr, col0 = u.pn * BM + wc * 32 + 8 * fq;
        u32x4 t[4][2];
        load_half(t, row0, col0, 0);
        add_half(acc, t, 0);
        asm volatile("" : "+v"(acc[0][0][0][0]), "+v"(acc[0][1][3][1]));
        load_half(t, row0, col0, 1);
        asm volatile("" ::: "memory");
        store_half(acc, row0, col0, 0, fq);
        add_half(acc, t, 1);
        store_half(acc, row0, col0, 1, fq);
    }
};
__device__ __forceinline__ int ffn_tile_row(int pm, int R, int chunk, bool& valid) {
    R = (R & ~63) | ((R & 15) << 2) | ((R >> 4) & 3);
    valid = true; (void)chunk; return pm * 256 + R;
}
struct ProbUp : ProbBase {
    static constexpr bool GATHER = true;
    const char* A; const char* B; int chunk;
    __device__ __forceinline__ const char* aptr(const Unit&) const { return A; }
    __device__ __forceinline__ const char* bptr(const Unit& u) const { return B + (size_t)u.pn * 256 * ldb * 2; }
    __device__ __forceinline__ unsigned rowoff(const Unit& u, int R) const { bool v; return (unsigned)ffn_tile_row(u.pm, R, chunk, v) * (unsigned)(lda * 2); }
};
__device__ __forceinline__ float dpp_ror1(float v) { return __builtin_bit_cast(float, __builtin_amdgcn_update_dpp(0, __builtin_bit_cast(int, v), 0x121, 0xf, 0xf, false)); }
__device__ __forceinline__ float dpp_ror15(float v) { return __builtin_bit_cast(float, __builtin_amdgcn_update_dpp(0, __builtin_bit_cast(int, v), 0x12F, 0xf, 0xf, false)); }
__device__ __forceinline__ h2_t u2h(unsigned u) { return __builtin_bit_cast(h2_t, u); }
__device__ __forceinline__ unsigned h2u(h2_t h) { return __builtin_bit_cast(unsigned, h); }
__device__ __forceinline__ unsigned dppu_ror1(unsigned v) { return (unsigned)__builtin_amdgcn_update_dpp(0, (int)v, 0x121, 0xf, 0xf, false); }
__device__ __forceinline__ unsigned dppu_ror15(unsigned v) { return (unsigned)__builtin_amdgcn_update_dpp(0, (int)v, 0x12F, 0xf, 0xf, false); }
#define H2X4_TRANS(OP, a, b, c, d) asm(OP " %0, %0 dst_sel:WORD_0 dst_unused:UNUSED_PRESERVE src0_sel:WORD_0\n\t" OP " %1, %1 dst_sel:WORD_0 dst_unused:UNUSED_PRESERVE src0_sel:WORD_0\n\t" \
    OP " %2, %2 dst_sel:WORD_0 dst_unused:UNUSED_PRESERVE src0_sel:WORD_0\n\t" OP " %3, %3 dst_sel:WORD_0 dst_unused:UNUSED_PRESERVE src0_sel:WORD_0\n\t"                                  \
    OP " %0, %0 dst_sel:WORD_1 dst_unused:UNUSED_PRESERVE src0_sel:WORD_1\n\t" OP " %1, %1 dst_sel:WORD_1 dst_unused:UNUSED_PRESERVE src0_sel:WORD_1\n\t"                                  \
    OP " %2, %2 dst_sel:WORD_1 dst_unused:UNUSED_PRESERVE src0_sel:WORD_1\n\t" OP " %3, %3 dst_sel:WORD_1 dst_unused:UNUSED_PRESERVE src0_sel:WORD_1\n\ts_nop 0" : "+v"(a), "+v"(b), "+v"(c), "+v"(d))
struct EpiGlu {
    static constexpr bool PERM = true;
    bf16_t* G; const rss_t* rowss; const u32x4* cwt; int chunk; LAS float* xl; bf16_t* EB; bf16_t* G2; int gsplit;
    __device__ __forceinline__ void operator()(f32x4 (&acc)[2][2][4][2], const Unit& u, int wr, int wc, int fr, int fq) const {
        const int ch0 = u.pn * 128 + wc * 32 + 8 * fq;
        const int tidw = (wr * 4 + wc) * 64 + fq * 16 + fr; LAS unsigned char* wl = (LAS unsigned char*)xl + 12288; LAS unsigned* xu = (LAS unsigned*)xl;
        u32x4 wrec = (u32x4){0u, 0u, 0u, 0u}; if (tidw < 128) wrec = cwt[u.pn * 128 + tidw];
        int rowi[2][4]; unsigned stmask = 0u; unsigned hh[2][2][4][4];
        { rss_t rv[2][4];
#pragma unroll
          for (int ai = 0; ai < 2; ++ai)
#pragma unroll
            for (int m = 0; m < 4; ++m) { const int RL = ai * HALF + wr * 64 + 4 * fr + m; bool valid; const int row = ffn_tile_row(u.pm, ai * HALF + wr * 64 + m * 16 + fr, chunk, valid); rowi[ai][m] = row; rv[ai][m] = rowss[row];
                const int gt = chunk * FFN_CHUNK + row, pos = tok_pos(gt), S = tok_seqlen(gt);
                const bool st = !((RL == 0 && pos != 0) || (RL == 255 && pos != S - 1)); (void)valid;
                stmask |= st ? (1u << (ai * 4 + m)) : 0u; }
#pragma unroll
          for (int ai = 0; ai < 2; ++ai)
#pragma unroll
            for (int m = 0; m < 4; ++m) { const float rx = ss_rstd(rv[ai][m]); const h2_t r2 = {(_Float16)rx, (_Float16)rx};
#pragma unroll
                for (int bj = 0; bj < 2; ++bj)
#pragma unroll
                    for (int n = 0; n < 2; ++n)
#pragma unroll
                        for (int jp = 0; jp < 2; ++jp) hh[ai][bj][m][2 * n + jp] = h2u(__builtin_bit_cast(h2_t, __builtin_amdgcn_cvt_pkrtz(acc[ai][bj][m][n][2 * jp], acc[ai][bj][m][n][2 * jp + 1])) * r2); } }
        if (wr == 0 && fr == 0) {
#pragma unroll
            for (int m = 0; m < 2; ++m)
#pragma unroll
                for (int bj = 0; bj < 2; ++bj) *(u32x4*)(EB + (size_t)(u.pm * 4 + m) * UP_W + bj * D_FF + ch0) = (u32x4){hh[0][bj][m][0], hh[0][bj][m][1], hh[0][bj][m][2], hh[0][bj][m][3]}; }
        if (wr == 1 && fr == 15) {
#pragma unroll
            for (int m = 2; m < 4; ++m)
#pragma unroll
                for (int bj = 0; bj < 2; ++bj) *(u32x4*)(EB + (size_t)(u.pm * 4 + m) * UP_W + bj * D_FF + ch0) = (u32x4){hh[1][bj][m][0], hh[1][bj][m][1], hh[1][bj][m][2], hh[1][bj][m][3]}; }
#pragma unroll
        for (int ai = 0; ai < 2; ++ai) { const int s1 = 2 * ai + wr + 1;
            if (fr == 0) {
#pragma unroll
                for (int bj = 0; bj < 2; ++bj) *(LAS u32x4*)(xu + ((s1 * 2 + 0) * 4 + wc) * 32 + bj * 16 + 4 * fq) = (u32x4){hh[ai][bj][0][0], hh[ai][bj][0][1], hh[ai][bj][0][2], hh[ai][bj][0][3]}; }
            if (fr == 15) {
#pragma unroll
                for (int bj = 0; bj < 2; ++bj) *(LAS u32x4*)(xu + ((s1 * 2 + 1) * 4 + wc) * 32 + bj * 16 + 4 * fq) = (u32x4){hh[ai][bj][3][0], hh[ai][bj][3][1], hh[ai][bj][3][2], hh[ai][bj][3][3]}; } }
        if (tidw < 128) *(LAS u32x4*)(wl + tidw * 16) = wrec;
        asm volatile("s_waitcnt lgkmcnt(0)" ::: "memory"); __builtin_amdgcn_s_barrier(); asm volatile("" ::: "memory");
        const h2_t c1 = {(_Float16)-0.10294324f, (_Float16)-0.10294324f}, c0 = {(_Float16)-2.3022082f, (_Float16)-2.3022082f}, one = {(_Float16)1.0f, (_Float16)1.0f};
        unsigned wq[2][2][4][2];
#pragma unroll
        for (int n = 0; n < 2; ++n) { unsigned (&wp)[2][4][2] = wq[n];
#pragma unroll
            for (int jp = 0; jp < 2; ++jp) { const int q = 2 * n + jp;
                const u32x4 wg = *(const LAS u32x4*)(wl + (wc * 16 + 4 * fq + q) * 32), wv = *(const LAS u32x4*)(wl + (wc * 16 + 4 * fq + q) * 32 + 16);
#pragma unroll
                for (int ai = 0; ai < 2; ++ai) { const int s1 = 2 * ai + wr + 1; h2_t cg[4], cv[4];
                    const LAS unsigned* xp = xu + (((s1 - 1) * 2 + 1) * 4 + wc) * 32 + 4 * fq + q; const LAS unsigned* xn = xu + (((s1 + 1) * 2 + 0) * 4 + wc) * 32 + 4 * fq + q;
                    { const unsigned pe = xp[0], ne = xn[0]; const unsigned r3 = dppu_ror1(hh[ai][0][3][q]), l0 = dppu_ror15(hh[ai][0][0][q]);
                      const h2_t w0 = u2h(wg.x), w1 = u2h(wg.y), w2 = u2h(wg.z), wb = u2h(wg.w);
#pragma unroll
                      for (int m = 0; m < 4; ++m) { const unsigned pv = m ? hh[ai][0][m ? m - 1 : 0][q] : (fr == 0 ? pe : r3), nx = m < 3 ? hh[ai][0][m < 3 ? m + 1 : 3][q] : (fr == 15 ? ne : l0);
                          cg[m] = wb + w0 * u2h(pv) + w1 * u2h(hh[ai][0][m][q]) + w2 * u2h(nx); } }
                    { const unsigned pe = xp[16], ne = xn[16]; const unsigned r3 = dppu_ror1(hh[ai][1][3][q]), l0 = dppu_ror15(hh[ai][1][0][q]);
                      const h2_t w0 = u2h(wv.x), w1 = u2h(wv.y), w2 = u2h(wv.z), wb = u2h(wv.w);
#pragma unroll
                      for (int m = 0; m < 4; ++m) { const unsigned pv = m ? hh[ai][1][m ? m - 1 : 0][q] : (fr == 0 ? pe : r3), nx = m < 3 ? hh[ai][1][m < 3 ? m + 1 : 3][q] : (fr == 15 ? ne : l0);
                          cv[m] = wb + w0 * u2h(pv) + w1 * u2h(hh[ai][1][m][q]) + w2 * u2h(nx); } }
                    unsigned e0 = h2u(cg[0] * (cg[0] * cg[0] * c1 + c0)), e1 = h2u(cg[1] * (cg[1] * cg[1] * c1 + c0)), e2 = h2u(cg[2] * (cg[2] * cg[2] * c1 + c0)), e3 = h2u(cg[3] * (cg[3] * cg[3] * c1 + c0));
                    H2X4_TRANS("v_exp_f16_sdwa", e0, e1, e2, e3);
                    e0 = h2u(u2h(e0) + one); e1 = h2u(u2h(e1) + one); e2 = h2u(u2h(e2) + one); e3 = h2u(u2h(e3) + one);
                    H2X4_TRANS("v_rcp_f16_sdwa", e0, e1, e2, e3);
                    wp[ai][0][jp] = h2u(cg[0] * u2h(e0) * cv[0]); wp[ai][1][jp] = h2u(cg[1] * u2h(e1) * cv[1]); wp[ai][2][jp] = h2u(cg[2] * u2h(e2) * cv[2]); wp[ai][3][jp] = h2u(cg[3] * u2h(e3) * cv[3]);
                    asm volatile("" : "+v"(wp[ai][0][jp]), "+v"(wp[ai][1][jp]), "+v"(wp[ai][2][jp]), "+v"(wp[ai][3][jp])); } }
            asm volatile("" ::: "memory"); }
#pragma unroll
        for (int ai = 0; ai < 2; ++ai)
#pragma unroll
            for (int m = 0; m < 4; ++m) { const u32x4 q = {wq[0][ai][m][0], wq[0][ai][m][1], wq[1][ai][m][0], wq[1][ai][m][1]}; if (stmask & (1u << (ai * 4 + m))) *(u32x4*)((u.pm < gsplit ? G : G2) + (size_t)rowi[ai][m] * D_FF + ch0) = q; }
    }
};
__device__ __forceinline__ void ffn_fix_item(const bf16_t* EB, const u32x4* cwt, bf16_t* G, bf16_t* G2, int gsplit_row, int t, int cb, int lane) {
    const int ti = (t >> 8) - 1, ch = cb * 512 + lane * 8;
    const bf16_t* ea = EB + (size_t)(ti * 4 + 2) * UP_W + ch; const bf16_t* ec = EB + (size_t)((ti + 1) * 4) * UP_W + ch;
    u32x4 ug[4], uv[4], w[8];
    ug[0] = *(const u32x4*)ea; uv[0] = *(const u32x4*)(ea + D_FF); ug[1] = *(const u32x4*)(ea + UP_W); uv[1] = *(const u32x4*)(ea + UP_W + D_FF);
    ug[2] = *(const u32x4*)ec; uv[2] = *(const u32x4*)(ec + D_FF); ug[3] = *(const u32x4*)(ec + UP_W); uv[3] = *(const u32x4*)(ec + UP_W + D_FF);
#pragma unroll
    for (int k = 0; k < 8; ++k) w[k] = cwt[(ch >> 1) * 2 + k];
    const h2_t c1 = {(_Float16)-0.10294324f, (_Float16)-0.10294324f}, c0 = {(_Float16)-2.3022082f, (_Float16)-2.3022082f}, one = {(_Float16)1.0f, (_Float16)1.0f};
    u32x4 oa, ob;
#pragma unroll
    for (int qp = 0; qp < 2; ++qp) { h2_t cg[4], cv[4];
#pragma unroll
        for (int qq = 0; qq < 2; ++qq) { const int q = 2 * qp + qq; const u32x4 wg = w[2 * q], wv = w[2 * q + 1];
            cg[2 * qq + 0] = u2h(wg.w) + u2h(wg.x) * u2h(ug[0][q]) + u2h(wg.y) * u2h(ug[1][q]) + u2h(wg.z) * u2h(ug[2][q]);
            cg[2 * qq + 1] = u2h(wg.w) + u2h(wg.x) * u2h(ug[1][q]) + u2h(wg.y) * u2h(ug[2][q]) + u2h(wg.z) * u2h(ug[3][q]);
            cv[2 * qq + 0] = u2h(wv.w) + u2h(wv.x) * u2h(uv[0][q]) + u2h(wv.y) * u2h(uv[1][q]) + u2h(wv.z) * u2h(uv[2][q]);
            cv[2 * qq + 1] = u2h(wv.w) + u2h(wv.x) * u2h(uv[1][q]) + u2h(wv.y) * u2h(uv[2][q]) + u2h(wv.z) * u2h(uv[3][q]); }
        unsigned e0 = h2u(cg[0] * (cg[0] * cg[0] * c1 + c0)), e1 = h2u(cg[1] * (cg[1] * cg[1] * c1 + c0)), e2 = h2u(cg[2] * (cg[2] * cg[2] * c1 + c0)), e3 = h2u(cg[3] * (cg[3] * cg[3] * c1 + c0));
        H2X4_TRANS("v_exp_f16_sdwa", e0, e1, e2, e3);
        e0 = h2u(u2h(e0) + one); e1 = h2u(u2h(e1) + one); e2 = h2u(u2h(e2) + one); e3 = h2u(u2h(e3) + one);
        H2X4_TRANS("v_rcp_f16_sdwa", e0, e1, e2, e3);
        oa[2 * qp] = h2u(cg[0] * u2h(e0) * cv[0]); ob[2 * qp] = h2u(cg[1] * u2h(e1) * cv[1]); oa[2 * qp + 1] = h2u(cg[2] * u2h(e2) * cv[2]); ob[2 * qp + 1] = h2u(cg[3] * u2h(e3) * cv[3]); }
    *(u32x4*)((t - 1 < gsplit_row ? G : G2) + (size_t)(t - 1) * D_FF + ch) = oa; *(u32x4*)((t < gsplit_row ? G : G2) + (size_t)t * D_FF + ch) = ob;
}
struct EpiKV {
    static constexpr bool PERM = false;
    float* kraw; bf16_t* vT;
    __device__ __forceinline__ void operator()(const f32x4 (&acc)[2][2][4][2], const Unit& u, int wr, int wc, int fr, int fq) const {
        const int key0 = wr * 64 + fr, col0 = u.pn * BM + wc * 32 + 4 * fq;
        if (u.pn < 8) {
#pragma unroll
            for (int ai = 0; ai < 2; ++ai)
#pragma unroll
                for (int m = 0; m < 4; ++m) { float* rowp = kraw + (size_t)(u.pm * BM + key0 + ai * HALF + m * 16) * 2048 + col0;
#pragma unroll
                    for (int bj = 0; bj < 2; ++bj)
#pragma unroll
                        for (int n = 0; n < 2; ++n) *(f32x4*)(rowp + bj * HALF + n * 16) = acc[ai][bj][m][n]; }
        } else {
#pragma unroll
            for (int ai = 0; ai < 2; ++ai)
#pragma unroll
                for (int m = 0; m < 4; ++m) { bf16_t* rowp = vT + (size_t)(u.pm * BM + key0 + ai * HALF + m * 16) * 2048 + (col0 - 2048);
#pragma unroll
                    for (int bj = 0; bj < 2; ++bj)
#pragma unroll
                        for (int n = 0; n < 2; ++n) { const f32x4 v = acc[ai][bj][m][n]; u32x2 w; w.x = cvt_pk_bf16(v[0], v[1]); w.y = cvt_pk_bf16(v[2], v[3]); *(u32x2*)(rowp + bj * HALF + n * 16) = w; } }
        }
    }
};
}

namespace att {
constexpr int KVBLK = 64, SHM_V = 16384, SHM_K = 16384, OFF_V = 0, OFF_K = 3 * SHM_V, OFF_WS = 3 * SHM_V + 3 * SHM_K, LDP = 1024;
#define KSWZ(row, colB) ((row) * 256 + ((colB) ^ (((row) & 15) << 4)))
#define SBAR() __builtin_amdgcn_sched_barrier(0)
__device__ __forceinline__ int crow(int r, int hi) { return (r & 3) + 8 * (r >> 2) + 4 * hi; }
__device__ __forceinline__ void partialSM(f32x16& p0) {
#pragma unroll
  for (int r = 0; r < 16; ++r) p0[r] = __builtin_amdgcn_exp2f(p0[r]);
}
__device__ __forceinline__ void finishSM(f32x16& p0, f32x16& p1, float& l_reg, bf16x8& pa0, bf16x8& pa1, bf16x8& pa2, bf16x8& pa3) {
#pragma unroll
  for (int r = 0; r < 16; ++r) p1[r] = __builtin_amdgcn_exp2f(p1[r]);
  float ps = 0;
#pragma unroll
  for (int r = 0; r < 16; ++r) ps += p0[r];
#pragma unroll
  for (int r = 0; r < 16; ++r) ps += p1[r];
  l_reg += ps;
#define PK4(P, BASE, OUT) do { unsigned a0 = cvt_pk_bf16(P[BASE + 0], P[BASE + 1]), a1 = cvt_pk_bf16(P[BASE + 2], P[BASE + 3]);   \
    unsigned b0 = cvt_pk_bf16(P[BASE + 4], P[BASE + 5]), b1 = cvt_pk_bf16(P[BASE + 6], P[BASE + 7]);                              \
    auto r0 = __builtin_amdgcn_permlane32_swap(a0, b0, false, false); auto r1 = __builtin_amdgcn_permlane32_swap(a1, b1, false, false); \
    u32x4 w = {r0[0], r1[0], r0[1], r1[1]}; OUT = __builtin_bit_cast(bf16x8, w); } while (0)
  PK4(p0, 0, pa0); PK4(p0, 8, pa1); PK4(p1, 0, pa2); PK4(p1, 8, pa3);
#undef PK4
}
__device__ __forceinline__ void finishSM_tail(f32x16& p0, f32x16& p1, float& l_reg, bf16x8& pa0, bf16x8& pa1, bf16x8& pa2, bf16x8& pa3) {
  float ps = 0;
#pragma unroll
  for (int r = 0; r < 16; ++r) ps += p0[r];
#pragma unroll
  for (int r = 0; r < 16; ++r) ps += p1[r];
  l_reg += ps;
#define PK4(P, BASE, OUT) do { unsigned a0 = cvt_pk_bf16(P[BASE + 0], P[BASE + 1]), a1 = cvt_pk_bf16(P[BASE + 2], P[BASE + 3]);   \
    unsigned b0 = cvt_pk_bf16(P[BASE + 4], P[BASE + 5]), b1 = cvt_pk_bf16(P[BASE + 6], P[BASE + 7]);                              \
    u32x4 w = {a0, a1, b0, b1}; OUT = __builtin_bit_cast(bf16x8, w); } while (0)
  PK4(p0, 0, pa0); PK4(p0, 8, pa1); PK4(p1, 0, pa2); PK4(p1, 8, pa3);
#undef PK4
}
__device__ __forceinline__ void qkt(f32x16& p0, f32x16& p1, const LAS unsigned char* Ks, const bf16x8* qr, int r32, int hi, int cbase) {
  p0 = f32x16{}; p1 = f32x16{}; bf16x8 b0[4], b1[4];
#pragma unroll
  for (int d0 = 0; d0 < 4; ++d0) { const int cb = cbase + (d0 * 16 + hi * 8) * 2;
    b0[d0] = *(const LAS bf16x8*)(Ks + KSWZ(r32, cb)); b1[d0] = *(const LAS bf16x8*)(Ks + KSWZ(32 + r32, cb)); }
#define QK_STEP(D, N) do { asm volatile("s_waitcnt lgkmcnt(" #N ")" ::: "memory"); SBAR(); \
    p0 = __builtin_amdgcn_mfma_f32_32x32x16_bf16(b0[D], qr[D], p0, 0, 0, 0); p1 = __builtin_amdgcn_mfma_f32_32x32x16_bf16(b1[D], qr[D], p1, 0, 0, 0); } while (0)
  QK_STEP(0, 6); QK_STEP(1, 4); QK_STEP(2, 2); QK_STEP(3, 0);
#undef QK_STEP
}
__device__ __forceinline__ int v_st(int k, int c) { const int kk = k; return ((kk >> 3) * 4 + (c >> 5)) * 512 + ((kk & 7) * 32 + (c & 31)) * 2; }
__device__ __forceinline__ int v_rd_base(int lane) { return ((lane & 3) << 3) | (((lane >> 2) & 3) << 6) | (((lane >> 4) & 1) << 5) | (((lane >> 5) & 1) << 8); }
constexpr int v_rd_off(int d0, int ks, int half) { return d0 * 512 + ks * 4096 + half * 2048; }
template <int OFF> __device__ __forceinline__ s16x4 tr_read(int vb) {
  s16x4 r; asm volatile("ds_read_b64_tr_b16 %0, %1 offset:%2" : "=&v"(r) : "v"(vb), "i"(OFF) : "memory"); return r;
}
struct VFrag { s16x4 l0, h0, l1, h1, l2, h2, l3, h3; };
template <int D0> __device__ __forceinline__ void pv_read(VFrag& f, int vb) {
  f.l0 = tr_read<v_rd_off(D0, 0, 0)>(vb); f.h0 = tr_read<v_rd_off(D0, 0, 1)>(vb); f.l1 = tr_read<v_rd_off(D0, 1, 0)>(vb); f.h1 = tr_read<v_rd_off(D0, 1, 1)>(vb);
  f.l2 = tr_read<v_rd_off(D0, 2, 0)>(vb); f.h2 = tr_read<v_rd_off(D0, 2, 1)>(vb); f.l3 = tr_read<v_rd_off(D0, 3, 0)>(vb); f.h3 = tr_read<v_rd_off(D0, 3, 1)>(vb);
}
__device__ __forceinline__ void pv_mma(f32x16& od, const VFrag& f, bf16x8 pa0, bf16x8 pa1, bf16x8 pa2, bf16x8 pa3) {
#define PKV(L, H) (bf16x8){L[0], L[1], L[2], L[3], H[0], H[1], H[2], H[3]}
  od = __builtin_amdgcn_mfma_f32_32x32x16_bf16(pa0, PKV(f.l0, f.h0), od, 0, 0, 0);
  od = __builtin_amdgcn_mfma_f32_32x32x16_bf16(pa1, PKV(f.l1, f.h1), od, 0, 0, 0);
  od = __builtin_amdgcn_mfma_f32_32x32x16_bf16(pa2, PKV(f.l2, f.h2), od, 0, 0, 0);
  od = __builtin_amdgcn_mfma_f32_32x32x16_bf16(pa3, PKV(f.l3, f.h3), od, 0, 0, 0);
#undef PKV
}
__device__ __forceinline__ void pv_d0(f32x16* o, int vb, bf16x8 pa0, bf16x8 pa1, bf16x8 pa2, bf16x8 pa3) {
  VFrag fa, fb;
  pv_read<0>(fa, vb); pv_read<1>(fb, vb);
  asm volatile("s_waitcnt lgkmcnt(8)" ::: "memory"); SBAR(); pv_mma(o[0], fa, pa0, pa1, pa2, pa3); SBAR();
  pv_read<2>(fa, vb);
  asm volatile("s_waitcnt lgkmcnt(8)" ::: "memory"); SBAR(); pv_mma(o[1], fb, pa0, pa1, pa2, pa3); SBAR();
  pv_read<3>(fb, vb);
  asm volatile("s_waitcnt lgkmcnt(8)" ::: "memory"); SBAR(); pv_mma(o[2], fa, pa0, pa1, pa2, pa3); SBAR();
  asm volatile("s_waitcnt lgkmcnt(0)" ::: "memory"); SBAR(); pv_mma(o[3], fb, pa0, pa1, pa2, pa3);
}
__device__ __forceinline__ void att_step(f32x16& s0, f32x16& s1, const LAS unsigned char* Ks, const bf16x8* qr, int r32, int hi, int cbase,
                                         f32x16& e0, f32x16& e1, float& l_reg, bf16x8& pa0, bf16x8& pa1, bf16x8& pa2, bf16x8& pa3, f32x16* o, int vb) {
  bf16x8 b0[4], b1[4]; VFrag fa, fb; float ps = 0.f; u32x4 w0, w1, w2, w3;
#pragma unroll
  for (int d0 = 0; d0 < 4; ++d0) { const int cb = cbase + (d0 * 16 + hi * 8) * 2;
    b0[d0] = *(const LAS bf16x8*)(Ks + KSWZ(r32, cb)); b1[d0] = *(const LAS bf16x8*)(Ks + KSWZ(32 + r32, cb)); }
  s0 = f32x16{}; s1 = f32x16{};
#define PACK_H(E, BASE, H, W) do { ps += E[BASE + 2 * H]; ps += E[BASE + 2 * H + 1]; ps += E[BASE + 4 + 2 * H]; ps += E[BASE + 5 + 2 * H];                       \
    const unsigned a_ = cvt_pk_bf16(E[BASE + 2 * H], E[BASE + 2 * H + 1]), b_ = cvt_pk_bf16(E[BASE + 4 + 2 * H], E[BASE + 5 + 2 * H]);                       \
    W[H] = a_; W[2 + H] = b_; } while (0)
#define QK_STEP(D, N, PRE, PK_A, PK_B) do { asm volatile("s_waitcnt lgkmcnt(" #N ")" ::: "memory"); PRE; SBAR();                                                  \
    s0 = __builtin_amdgcn_mfma_f32_32x32x16_bf16(b0[D], qr[D], s0, 0, 0, 0); SBAR(); PK_A; SBAR();                                                                 \
    s1 = __builtin_amdgcn_mfma_f32_32x32x16_bf16(b1[D], qr[D], s1, 0, 0, 0); SBAR(); PK_B; SBAR(); } while (0)
  QK_STEP(0, 6, (void)0, PACK_H(e0, 0, 0, w0), PACK_H(e0, 0, 1, w0));
  QK_STEP(1, 4, (void)0, PACK_H(e0, 8, 0, w1), PACK_H(e0, 8, 1, w1));
  QK_STEP(2, 2, (void)0, PACK_H(e1, 0, 0, w2), PACK_H(e1, 0, 1, w2));
  QK_STEP(3, 0, (pv_read<0>(fa, vb), pv_read<1>(fb, vb)), PACK_H(e1, 8, 0, w3), PACK_H(e1, 8, 1, w3));
#undef QK_STEP
#undef PACK_H
  l_reg += ps;
  pa0 = __builtin_bit_cast(bf16x8, w0); pa1 = __builtin_bit_cast(bf16x8, w1); pa2 = __builtin_bit_cast(bf16x8, w2); pa3 = __builtin_bit_cast(bf16x8, w3);
#define PKV(L, H) (bf16x8){L[0], L[1], L[2], L[3], H[0], H[1], H[2], H[3]}
#define EX2(X, I) do { X[I] = __builtin_amdgcn_exp2f(X[I]); X[I + 1] = __builtin_amdgcn_exp2f(X[I + 1]); } while (0)
#define PV_BLK(D0, F, N, X, XB) do { asm volatile("s_waitcnt lgkmcnt(" #N ")" ::: "memory"); SBAR();                                                              \
    o[D0] = __builtin_amdgcn_mfma_f32_32x32x16_bf16(pa0, PKV(F.l0, F.h0), o[D0], 0, 0, 0); SBAR(); EX2(X, XB + 0); SBAR();                                         \
    o[D0] = __builtin_amdgcn_mfma_f32_32x32x16_bf16(pa1, PKV(F.l1, F.h1), o[D0], 0, 0, 0); SBAR(); EX2(X, XB + 2); SBAR();                                         \
    o[D0] = __builtin_amdgcn_mfma_f32_32x32x16_bf16(pa2, PKV(F.l2, F.h2), o[D0], 0, 0, 0); SBAR(); EX2(X, XB + 4); SBAR();                                         \
    o[D0] = __builtin_amdgcn_mfma_f32_32x32x16_bf16(pa3, PKV(F.l3, F.h3), o[D0], 0, 0, 0); SBAR(); EX2(X, XB + 6); SBAR(); } while (0)
  PV_BLK(0, fa, 8, s0, 0); pv_read<2>(fa, vb);
  PV_BLK(1, fb, 8, s0, 8); pv_read<3>(fb, vb);
  PV_BLK(2, fa, 8, s1, 0);
  PV_BLK(3, fb, 0, s1, 8);
#undef PV_BLK
#undef EX2
#undef PKV
}
__device__ __forceinline__ void attn_unit(const bf16_t* Qg, const bf16_t* __restrict__ Kg, const bf16_t* __restrict__ Vg, bf16_t* Og, int seq, float lam, const float* gsub, float oscale, LAS unsigned char* lds) {
  int tid_l = threadIdx.x; asm volatile("" : "+v"(tid_l));
  const int tid = tid_l, wid = __builtin_amdgcn_readfirstlane(tid >> 6), lane = tid & 63, r32 = lane & 31, hi = lane >> 5;
  const int comp = wid & 1, rg = wid >> 1, cbase = comp * 128;
  LAS unsigned char* V_lds = lds + OFF_V; LAS unsigned char* K_lds = lds + OFF_K;
  LAS float* wsf = (LAS float*)(lds + OFF_WS) + wid * 64; LAS float* li_l = wsf;
  float l_reg = 0; f32x16 o[4] = {}; bf16x8 qr[4];
  const bf16_t* Qw = Qg + (size_t)(rg * 32 + r32) * LDP + comp * 64 + hi * 8;
#pragma unroll
  for (int d0 = 0; d0 < 4; ++d0) qr[d0] = *(const bf16x8*)(Qw + d0 * 16);
  unsigned koff[2], voff[2];
#pragma unroll
  for (int i = 0; i < 2; ++i) { const int L = (tid + 512 * i) * 16; { const int row = L >> 8, colB = (L & 255) ^ ((row & 15) << 4); koff[i] = (unsigned)(row * LDP * 2 + colB); }
    { const int sub = L >> 9, w = L & 511, kk = (sub >> 2) * 8 + (w >> 6), c = (sub & 3) * 32 + ((w & 63) >> 1), k = kk; voff[i] = (unsigned)(k * LDP * 2 + c * 2); } }
  const int vbb = (int)(unsigned)(size_t)V_lds + v_rd_base(lane);
  const int NT = seq / KVBLK; const size_t tstep = (size_t)KVBLK * LDP * 2;
#define DMA_K(t) do { const int t_ = (t) < NT ? (t) : NT - 1; const char* g_ = (const char*)Kg + (size_t)t_ * tstep; LAS unsigned char* d_ = K_lds + (t_ % 3) * SHM_K + wid * 1024; \
    __builtin_amdgcn_global_load_lds((const unsigned*)(g_ + koff[0]), (LAS unsigned*)d_, 16, 0, 0); __builtin_amdgcn_global_load_lds((const unsigned*)(g_ + koff[1]), (LAS unsigned*)(d_ + 8192), 16, 0, 0); } while (0)
#define DMA_V(t) do { const int t_ = (t) < NT ? (t) : NT - 1; const char* g_ = (const char*)Vg + (size_t)t_ * tstep; LAS unsigned char* d_ = V_lds + (t_ % 3) * SHM_V + wid * 1024; \
    __builtin_amdgcn_global_load_lds((const unsigned*)(g_ + voff[0]), (LAS unsigned*)d_, 16, 0, 0); __builtin_amdgcn_global_load_lds((const unsigned*)(g_ + voff[1]), (LAS unsigned*)(d_ + 8192), 16, 0, 0); } while (0)
#define WAIT4_BAR() do { asm volatile("s_waitcnt vmcnt(4)" ::: "memory"); __builtin_amdgcn_s_barrier(); asm volatile("" ::: "memory"); } while (0)
  f32x16 pA0, pA1, pB0, pB1; bf16x8 pa0, pa1, pa2, pa3;
  DMA_K(0); DMA_K(1); DMA_V(0);
  WAIT4_BAR();
  DMA_K(2); DMA_V(1);
  qkt(pA0, pA1, K_lds, qr, r32, hi, cbase); partialSM(pA0); partialSM(pA1);
  int sk = 1, sv = 0;
  for (int j = 1; j + 1 < NT; j += 2) {
    WAIT4_BAR(); DMA_K(j + 2); DMA_V(j + 1);
    SBAR(); att_step(pB0, pB1, K_lds + sk * SHM_K, qr, r32, hi, cbase, pA0, pA1, l_reg, pa0, pa1, pa2, pa3, o, vbb + sv * SHM_V); SBAR();
    sk = sk == 2 ? 0 : sk + 1; sv = sv == 2 ? 0 : sv + 1;
    WAIT4_BAR(); DMA_K(j + 3); DMA_V(j + 2);
    SBAR(); att_step(pA0, pA1, K_lds + sk * SHM_K, qr, r32, hi, cbase, pB0, pB1, l_reg, pa0, pa1, pa2, pa3, o, vbb + sv * SHM_V); SBAR();
    sk = sk == 2 ? 0 : sk + 1; sv = sv == 2 ? 0 : sv + 1;
  }
  WAIT4_BAR(); DMA_K(NT + 1); DMA_V(NT);
  SBAR(); att_step(pB0, pB1, K_lds + sk * SHM_K, qr, r32, hi, cbase, pA0, pA1, l_reg, pa0, pa1, pa2, pa3, o, vbb + sv * SHM_V); SBAR();
  sv = sv == 2 ? 0 : sv + 1;
  WAIT4_BAR();
  finishSM_tail(pB0, pB1, l_reg, pa0, pa1, pa2, pa3); SBAR();
  pv_d0(o, vbb + sv * SHM_V, pa0, pa1, pa2, pa3);
  asm volatile("s_waitcnt vmcnt(0)" ::: "memory");
#undef DMA_K
#undef DMA_V
#undef WAIT4_BAR
  { auto rr = __builtin_amdgcn_permlane32_swap(__float_as_uint(l_reg), __float_as_uint(l_reg), false, false); l_reg = __uint_as_float(rr[0]) + __uint_as_float(rr[1]); }
  if (hi == 0) li_l[r32] = l_reg; asm volatile("s_waitcnt lgkmcnt(0)" ::: "memory");
  float rli[16];
#pragma unroll
  for (int r = 0; r < 16; ++r) rli[r] = __builtin_amdgcn_rcpf(li_l[crow(r, hi)]);
  __syncthreads();
  LAS float* X = (LAS float*)(lds) + rg * 4096 + lane;
  if (comp == 1) {
#pragma unroll
    for (int d0 = 0; d0 < 4; ++d0)
#pragma unroll
      for (int r = 0; r < 16; ++r) X[(d0 * 16 + r) * 64] = o[d0][r] * rli[r] * lam;
  }
  __syncthreads();
  if (comp == 0) {
    float ss[16];
#pragma unroll
    for (int r = 0; r < 16; ++r) ss[r] = 0.f;
#pragma unroll
    for (int d0 = 0; d0 < 4; ++d0)
#pragma unroll
      for (int r = 0; r < 16; ++r) { const float v = o[d0][r] * rli[r] - X[(d0 * 16 + r) * 64]; o[d0][r] = v; ss[r] += v * v; }
#pragma unroll
    for (int r = 0; r < 16; ++r) { float s = ss[r]; s += __shfl_xor(s, 1); s += __shfl_xor(s, 2); s += __shfl_xor(s, 4); s += __shfl_xor(s, 8); s += __shfl_xor(s, 16);
      ss[r] = __builtin_amdgcn_rsqf(s * (1.0f / 128.0f) + EPS) * oscale; }
    bf16_t* Ow = Og + (size_t)(rg * 32) * LDP;
#pragma unroll
    for (int d0 = 0; d0 < 4; ++d0) { const float g = gsub[d0 * 32 + r32];
#pragma unroll
#ifdef PROBE_ZERO_ATTN
      for (int r = 0; r < 16; ++r) Ow[(size_t)crow(r, hi) * LDP + d0 * 32 + r32] = (bf16_t)0;
#else
      for (int r = 0; r < 16; ++r) Ow[(size_t)crow(r, hi) * LDP + d0 * 32 + r32] = (bf16_t)(cvt_pk_bf16(o[d0][r] * ss[r] * g, 0.f) & 0xffffu);
#endif
    }
  }
  __syncthreads();
}
}


namespace att16 {
using att::KVBLK; using att::SHM_V; using att::SHM_K; using att::OFF_V; using att::OFF_K; using att::OFF_WS; using att::LDP;
typedef f32x4 S8[4][2];
__device__ __forceinline__ f32x4 mma16(bf16x8 a, bf16x8 b, f32x4 c) { return __builtin_amdgcn_mfma_f32_16x16x32_bf16(a, b, c, 0, 0, 0); }
template <int OFF> __device__ __forceinline__ s16x4 tr_read(int vb) { s16x4 r; asm volatile("ds_read_b64_tr_b16 %0, %1 offset:%2" : "=&v"(r) : "v"(vb), "i"(OFF) : "memory"); return r; }
struct VF { s16x4 l0, h0, l1, h1; };
constexpr int v_off(int db, int ks, int half) { return ks * 8192 + half * 4096 + (db >> 1) * 512; }
template <int DP> __device__ __forceinline__ void pv_read(VF& fe, VF& fo, int vbe, int vbo) {
  fe.l0 = tr_read<v_off(2 * DP, 0, 0)>(vbe); fe.h0 = tr_read<v_off(2 * DP, 0, 1)>(vbe); fe.l1 = tr_read<v_off(2 * DP, 1, 0)>(vbe); fe.h1 = tr_read<v_off(2 * DP, 1, 1)>(vbe);
  fo.l0 = tr_read<v_off(2 * DP + 1, 0, 0)>(vbo); fo.h0 = tr_read<v_off(2 * DP + 1, 0, 1)>(vbo); fo.l1 = tr_read<v_off(2 * DP + 1, 1, 0)>(vbo); fo.h1 = tr_read<v_off(2 * DP + 1, 1, 1)>(vbo);
}
#define PKV16(L, H) (bf16x8){L[0], L[1], L[2], L[3], H[0], H[1], H[2], H[3]}
__device__ __forceinline__ void kf_read(bf16x8 (&kf)[4][2], const LAS unsigned char* Ks, int c16, int g, int cbase) {
#pragma unroll
  for (int kb = 0; kb < 4; ++kb)
#pragma unroll
    for (int ks = 0; ks < 2; ++ks) kf[kb][ks] = *(const LAS bf16x8*)(Ks + KSWZ(16 * kb + c16, cbase + (32 * ks + 8 * g) * 2));
}
__device__ __forceinline__ void qk_first(S8& S, const LAS unsigned char* Ks, const bf16x8 (&qf)[2][2], int c16, int g, int cbase) {
  bf16x8 kf[4][2]; kf_read(kf, Ks, c16, g, cbase);
#pragma unroll
  for (int kb = 0; kb < 4; ++kb)
#pragma unroll
    for (int qb = 0; qb < 2; ++qb) { f32x4 a = {0.f, 0.f, 0.f, 0.f}; a = mma16(kf[kb][0], qf[qb][0], a); a = mma16(kf[kb][1], qf[qb][1], a);
#pragma unroll
      for (int r = 0; r < 4; ++r) a[r] = __builtin_amdgcn_exp2f(a[r]);
      S[kb][qb] = a; }
}
#define ADDF16(acc, x) asm("v_add_f32 %0, %1, %0" : "+v"(acc) : "v"(x))
#define PACK16(E, KS, QB, W) do { const f32x4& e_ = E[2 * (KS) + ((W) >> 1)][QB]; pw[KS][QB][W] = cvt_pk_bf16(e_[2 * ((W) & 1)], e_[2 * ((W) & 1) + 1]); } while (0)
#define LSUM16() do { const bf16x8 on_ = {0x3F80, 0x3F80, 0x3F80, 0x3F80, 0x3F80, 0x3F80, 0x3F80, 0x3F80};                                                        \
    l2[0] = mma16(on_, __builtin_bit_cast(bf16x8, pw[0][0]), l2[0]); l2[1] = mma16(on_, __builtin_bit_cast(bf16x8, pw[0][1]), l2[1]);                               \
    l2[0] = mma16(on_, __builtin_bit_cast(bf16x8, pw[1][0]), l2[0]); l2[1] = mma16(on_, __builtin_bit_cast(bf16x8, pw[1][1]), l2[1]); } while (0)
__device__ __forceinline__ void pack_all(const S8& E, u32x4 (&pw)[2][2]) {
#pragma unroll
  for (int ks = 0; ks < 2; ++ks)
#pragma unroll
    for (int qb = 0; qb < 2; ++qb) { PACK16(E, ks, qb, 0); PACK16(E, ks, qb, 1); PACK16(E, ks, qb, 2); PACK16(E, ks, qb, 3); }
}
#define PV16(DB, F) do { _Pragma("unroll") for (int qb_ = 0; qb_ < 2; ++qb_) { o[DB][qb_] = mma16(PKV16(F.l0, F.h0), __builtin_bit_cast(bf16x8, pw[0][qb_]), o[DB][qb_]); \
    o[DB][qb_] = mma16(PKV16(F.l1, F.h1), __builtin_bit_cast(bf16x8, pw[1][qb_]), o[DB][qb_]); } } while (0)
__device__ __forceinline__ void pv_last(f32x4 (&o)[8][2], const u32x4 (&pw)[2][2], int vbe, int vbo) {
  VF ae, ao, be, bo;
  pv_read<0>(ae, ao, vbe, vbo); pv_read<1>(be, bo, vbe, vbo);
  asm volatile("s_waitcnt lgkmcnt(8)" ::: "memory"); SBAR(); PV16(0, ae); PV16(1, ao); SBAR();
  pv_read<2>(ae, ao, vbe, vbo);
  asm volatile("s_waitcnt lgkmcnt(8)" ::: "memory"); SBAR(); PV16(2, be); PV16(3, bo); SBAR();
  pv_read<3>(be, bo, vbe, vbo);
  asm volatile("s_waitcnt lgkmcnt(8)" ::: "memory"); SBAR(); PV16(4, ae); PV16(5, ao); SBAR();
  asm volatile("s_waitcnt lgkmcnt(0)" ::: "memory"); SBAR(); PV16(6, be); PV16(7, bo);
}
__device__ __forceinline__ void att_step(S8& S, const LAS unsigned char* Ks, const bf16x8 (&qf)[2][2], int c16, int g, int cbase, const S8& E, f32x4 (&l2)[2], f32x4 (&o)[8][2], int vbe, int vbo) {
  bf16x8 kf[4][2]; u32x4 pw[2][2]; VF ae, ao, be, bo;
  kf_read(kf, Ks, c16, g, cbase);
#define QK16(KB, N, PRE, P0, P1, P2, P3) do { asm volatile("s_waitcnt lgkmcnt(" #N ")" ::: "memory"); PRE; SBAR(); f32x4 a0_ = {0.f, 0.f, 0.f, 0.f}, a1_ = {0.f, 0.f, 0.f, 0.f};  \
    a0_ = mma16(kf[KB][0], qf[0][0], a0_); SBAR(); P0; SBAR(); a1_ = mma16(kf[KB][0], qf[1][0], a1_); SBAR(); P1; SBAR();                                     \
    a0_ = mma16(kf[KB][1], qf[0][1], a0_); SBAR(); P2; SBAR(); a1_ = mma16(kf[KB][1], qf[1][1], a1_); SBAR(); P3; SBAR(); S[KB][0] = a0_; S[KB][1] = a1_; } while (0)
  QK16(0, 6, (void)0, PACK16(E, 0, 0, 0), PACK16(E, 0, 0, 1), PACK16(E, 0, 0, 2), PACK16(E, 0, 0, 3));
  QK16(1, 4, (void)0, PACK16(E, 0, 1, 0), PACK16(E, 0, 1, 1), PACK16(E, 0, 1, 2), PACK16(E, 0, 1, 3));
  QK16(2, 2, (void)0, PACK16(E, 1, 0, 0), PACK16(E, 1, 0, 1), PACK16(E, 1, 0, 2), PACK16(E, 1, 0, 3));
  QK16(3, 0, (pv_read<0>(ae, ao, vbe, vbo), pv_read<1>(be, bo, vbe, vbo)), PACK16(E, 1, 1, 0), PACK16(E, 1, 1, 1), PACK16(E, 1, 1, 2), PACK16(E, 1, 1, 3));
#undef QK16
#define EX1(KB, QB, R) S[KB][QB][R] = __builtin_amdgcn_exp2f(S[KB][QB][R])
#define PVX(DB, F, KB) do { o[DB][0] = mma16(PKV16(F.l0, F.h0), __builtin_bit_cast(bf16x8, pw[0][0]), o[DB][0]); SBAR(); EX1(KB, 0, 0); SBAR();                    \
    o[DB][1] = mma16(PKV16(F.l0, F.h0), __builtin_bit_cast(bf16x8, pw[0][1]), o[DB][1]); SBAR(); EX1(KB, 0, 1); SBAR();                                          \
    o[DB][0] = mma16(PKV16(F.l1, F.h1), __builtin_bit_cast(bf16x8, pw[1][0]), o[DB][0]); SBAR(); EX1(KB, 0, 2); SBAR();                                          \
    o[DB][1] = mma16(PKV16(F.l1, F.h1), __builtin_bit_cast(bf16x8, pw[1][1]), o[DB][1]); SBAR(); EX1(KB, 0, 3); SBAR(); } while (0)
#define PVY(DB, F, KB) do { o[DB][0] = mma16(PKV16(F.l0, F.h0), __builtin_bit_cast(bf16x8, pw[0][0]), o[DB][0]); SBAR(); EX1(KB, 1, 0); SBAR();                    \
    o[DB][1] = mma16(PKV16(F.l0, F.h0), __builtin_bit_cast(bf16x8, pw[0][1]), o[DB][1]); SBAR(); EX1(KB, 1, 1); SBAR();                                          \
    o[DB][0] = mma16(PKV16(F.l1, F.h1), __builtin_bit_cast(bf16x8, pw[1][0]), o[DB][0]); SBAR(); EX1(KB, 1, 2); SBAR();                                          \
    o[DB][1] = mma16(PKV16(F.l1, F.h1), __builtin_bit_cast(bf16x8, pw[1][1]), o[DB][1]); SBAR(); EX1(KB, 1, 3); SBAR(); } while (0)
  SBAR(); LSUM16(); SBAR();
  asm volatile("s_waitcnt lgkmcnt(8)" ::: "memory"); SBAR(); PVX(0, ae, 0); PVY(1, ao, 0); pv_read<2>(ae, ao, vbe, vbo);
  asm volatile("s_waitcnt lgkmcnt(8)" ::: "memory"); SBAR(); PVX(2, be, 1); PVY(3, bo, 1); pv_read<3>(be, bo, vbe, vbo);
  asm volatile("s_waitcnt lgkmcnt(8)" ::: "memory"); SBAR(); PVX(4, ae, 2); PVY(5, ao, 2);
  asm volatile("s_waitcnt lgkmcnt(0)" ::: "memory"); SBAR(); PVX(6, be, 3); PVY(7, bo, 3);
#undef PVX
#undef PVY
#undef EX1
}
__device__ __forceinline__ void attn_unit(const bf16_t* Qg, const bf16_t* __restrict__ Kg, const bf16_t* __restrict__ Vg, bf16_t* Og, int seq, float lam, const float* gsub, float oscale, LAS unsigned char* lds, bool rev) {
  int tid_l = threadIdx.x; asm volatile("" : "+v"(tid_l));
  const int tid = tid_l, wid = __builtin_amdgcn_readfirstlane(tid >> 6), lane = tid & 63, c16 = lane & 15, g = lane >> 4;
  const int comp = wid & 1, rg = wid >> 1, cbase = comp * 128;
  LAS unsigned char* V_lds = lds + OFF_V; LAS unsigned char* K_lds = lds + OFF_K;
  LAS float* wsf = (LAS float*)(lds + OFF_WS) + wid * 64; (void)wsf;
  f32x4 l2[2] = {{0.f, 0.f, 0.f, 0.f}, {0.f, 0.f, 0.f, 0.f}}; f32x4 o[8][2]; bf16x8 qf[2][2];
#pragma unroll
  for (int db = 0; db < 8; ++db)
#pragma unroll
    for (int qb = 0; qb < 2; ++qb) o[db][qb] = (f32x4){0.f, 0.f, 0.f, 0.f};
#pragma unroll
  for (int qb = 0; qb < 2; ++qb)
#pragma unroll
    for (int ks = 0; ks < 2; ++ks) qf[qb][ks] = *(const bf16x8*)(Qg + (size_t)(rg * 32 + 16 * qb + c16) * LDP + comp * 64 + 32 * ks + 8 * g);
  unsigned koff[2], voff[2];
#pragma unroll
  for (int i = 0; i < 2; ++i) { const int L = (tid + 512 * i) * 16; { const int row = L >> 8, colB = (L & 255) ^ ((row & 15) << 4); koff[i] = (unsigned)(row * LDP * 2 + colB); }
    { const int sub = L >> 9, w = L & 511, k = (sub >> 2) * 8 + (w >> 6), cl = ((w & 63) >> 1) ^ (((k >> 2) & 1) << 4), c = (sub & 3) * 32 + cl; voff[i] = (unsigned)(k * LDP * 2 + c * 2); } }
  const int vb0 = (int)(unsigned)(size_t)V_lds + (g >> 1) * 2048 + (g & 1) * 256 + ((c16 >> 2) & 3) * 64 + (c16 & 3) * 8;
  const int vbe0 = vb0 + (g & 1) * 32, vbo0 = vb0 + ((g & 1) ^ 1) * 32;
  const int NT = seq / KVBLK; const size_t tstep = (size_t)KVBLK * LDP * 2;
#define DMA_K(t) do { const int t_ = (t) < NT ? (t) : NT - 1; const char* g_ = (const char*)Kg + (size_t)(rev ? NT - 1 - t_ : t_) * tstep; LAS unsigned char* d_ = K_lds + (t_ % 3) * SHM_K + wid * 1024; \
    __builtin_amdgcn_global_load_lds((const unsigned*)(g_ + koff[0]), (LAS unsigned*)d_, 16, 0, 0); __builtin_amdgcn_global_load_lds((const unsigned*)(g_ + koff[1]), (LAS unsigned*)(d_ + 8192), 16, 0, 0); } while (0)
#define DMA_V(t) do { const int t_ = (t) < NT ? (t) : NT - 1; const char* g_ = (const char*)Vg + (size_t)(rev ? NT - 1 - t_ : t_) * tstep; LAS unsigned char* d_ = V_lds + (t_ % 3) * SHM_V + wid * 1024; \
    __builtin_amdgcn_global_load_lds((const unsigned*)(g_ + voff[0]), (LAS unsigned*)d_, 16, 0, 0); __builtin_amdgcn_global_load_lds((const unsigned*)(g_ + voff[1]), (LAS unsigned*)(d_ + 8192), 16, 0, 0); } while (0)
#define WAIT4_BAR() do { asm volatile("s_waitcnt vmcnt(4)" ::: "memory"); __builtin_amdgcn_s_barrier(); asm volatile("" ::: "memory"); } while (0)
  S8 pA, pB;
  DMA_K(0); DMA_K(1); DMA_V(0);
  WAIT4_BAR();
  DMA_K(2); DMA_V(1);
  qk_first(pA, K_lds, qf, c16, g, cbase);
  int sk = 1, sv = 0;
  for (int j = 1; j + 1 < NT; j += 2) {
    WAIT4_BAR(); DMA_K(j + 2); DMA_V(j + 1);
    SBAR(); att_step(pB, K_lds + sk * SHM_K, qf, c16, g, cbase, pA, l2, o, vbe0 + sv * SHM_V, vbo0 + sv * SHM_V); SBAR();
    sk = sk == 2 ? 0 : sk + 1; sv = sv == 2 ? 0 : sv + 1;
    WAIT4_BAR(); DMA_K(j + 3); DMA_V(j + 2);
    SBAR(); att_step(pA, K_lds + sk * SHM_K, qf, c16, g, cbase, pB, l2, o, vbe0 + sv * SHM_V, vbo0 + sv * SHM_V); SBAR();
    sk = sk == 2 ? 0 : sk + 1; sv = sv == 2 ? 0 : sv + 1;
  }
  WAIT4_BAR(); DMA_K(NT + 1); DMA_V(NT);
  SBAR(); att_step(pB, K_lds + sk * SHM_K, qf, c16, g, cbase, pA, l2, o, vbe0 + sv * SHM_V, vbo0 + sv * SHM_V); SBAR();
  sv = sv == 2 ? 0 : sv + 1;
  WAIT4_BAR();
  { u32x4 pw[2][2]; pack_all(pB, pw); SBAR(); LSUM16(); SBAR(); pv_last(o, pw, vbe0 + sv * SHM_V, vbo0 + sv * SHM_V); }
  asm volatile("s_waitcnt vmcnt(0)" ::: "memory");
#undef DMA_K
#undef DMA_V
#undef WAIT4_BAR
  float rl[2];
#pragma unroll
  for (int qb = 0; qb < 2; ++qb) rl[qb] = __builtin_amdgcn_rcpf(l2[qb][0]);
  __syncthreads();
  LAS float* X = (LAS float*)(lds) + rg * 4096 + lane;
  if (comp == 1) {
#pragma unroll
    for (int db = 0; db < 8; ++db)
#pragma unroll
      for (int qb = 0; qb < 2; ++qb)
#pragma unroll
        for (int r = 0; r < 4; ++r) X[((db * 2 + qb) * 4 + r) * 64] = o[db][qb][r] * rl[qb] * lam;
  }
  __syncthreads();
  if (comp == 0) {
    float ss[2] = {0.f, 0.f};
#pragma unroll
    for (int db = 0; db < 8; ++db)
#pragma unroll
      for (int qb = 0; qb < 2; ++qb)
#pragma unroll
        for (int r = 0; r < 4; ++r) { const float v = o[db][qb][r] * rl[qb] - X[((db * 2 + qb) * 4 + r) * 64]; o[db][qb][r] = v; ss[qb] += v * v; }
#pragma unroll
    for (int qb = 0; qb < 2; ++qb) { float t = ss[qb]; t += __shfl_xor(t, 16); t += __shfl_xor(t, 32); ss[qb] = __builtin_amdgcn_rsqf(t * (1.0f / 128.0f) + EPS) * oscale; }
#pragma unroll
    for (int db = 0; db < 8; ++db) { const f32x4 gs = *(const f32x4*)(gsub + 16 * db + 4 * g);
#pragma unroll
      for (int qb = 0; qb < 2; ++qb) { const f32x4 v = o[db][qb] * gs * ss[qb]; u32x2 w; w.x = cvt_pk_bf16(v[0], v[1]); w.y = cvt_pk_bf16(v[2], v[3]);
        *(u32x2*)(Og + (size_t)(rg * 32 + 16 * qb + c16) * LDP + 16 * db + 4 * g) = w; } }
  }
  __syncthreads();
}
#undef PV16
#undef PACK16
#undef LSUM16
#undef ADDF16
#undef PKV16
}

#define XB_TMO      128
#define XB_XCNT(j)  (256  + 64 * (j))
#define XB_XSUB(j)  (1280 + 64 * (j))
#define XB_XGEN(j)  (2304 + 64 * (j))
#define XB_TOP      3328
#define XB_TOPGEN   3392
#define XCD_BAR_WORDS 3456
#define XB_SPIN_CAP (1u << 20)
__device__ __forceinline__ unsigned xb_ld(unsigned* p)              { return __hip_atomic_load(p, __ATOMIC_RELAXED, __HIP_MEMORY_SCOPE_AGENT); }
__device__ __forceinline__ unsigned xb_add(unsigned* p, unsigned v) { return __hip_atomic_fetch_add(p, v, __ATOMIC_RELAXED, __HIP_MEMORY_SCOPE_AGENT); }
__device__ __forceinline__ unsigned xb_xcc_id() { return (unsigned)__builtin_amdgcn_s_getreg((3 << 11) | 20) & 0xFu; }
#define XB_SPIN(cond, bar) do { unsigned _sp = 0; while (cond) { __builtin_amdgcn_s_sleep(1); \
    if ((++_sp & 255u) == 0u) { if (xb_ld(&(bar)[XB_TMO])) break; if (_sp > XB_SPIN_CAP) { atomicAdd(&(bar)[XB_TMO], 1u); break; } } } } while (0)
struct XcdBarrier { unsigned* bar; unsigned x; volatile LAS unsigned* st; };
__device__ __forceinline__ XcdBarrier xcd_barrier_post(unsigned* bar, volatile LAS unsigned* st) {
    XcdBarrier b; b.bar = bar; b.x = xb_xcc_id(); b.st = st;
    if (threadIdx.x == 0) (void)xb_add(&bar[XB_XCNT(b.x)], 1u);
    return b;
}
__device__ __forceinline__ void xcd_barrier_complete(unsigned* bar, unsigned x, unsigned& nloc, unsigned& nx) {
    const unsigned G = gridDim.x * gridDim.y * gridDim.z;
    unsigned sum, cnt, mine, sp = 0u;
    for (;;) {
        sum = 0u; cnt = 0u; mine = 0u;
#pragma unroll
        for (unsigned j = 0; j < 16; ++j) { const unsigned c = xb_ld(&bar[XB_XCNT(j)]); sum += c; cnt += (c > 0u) ? 1u : 0u; mine = (j == x) ? c : mine; }
        if (sum == G) break;
        __builtin_amdgcn_s_sleep(1);
        if ((++sp & 255u) == 0u) { if (xb_ld(&bar[XB_TMO])) break; if (sp > XB_SPIN_CAP) { atomicAdd(&bar[XB_TMO], 1u); break; } }
    }
    nloc = mine > 0u ? mine : 1u; nx = cnt > 0u ? cnt : 1u;
}
__device__ __forceinline__ void xcd_barrier(const XcdBarrier& b) {
    asm volatile("s_waitcnt vmcnt(0)" ::: "memory");
    __syncthreads();
    if (threadIdx.x == 0) {
        unsigned* bar = b.bar;
        __builtin_amdgcn_s_waitcnt(0);
        unsigned nloc = b.st[0], nx = b.st[1];
        if (nloc == 0u) { xcd_barrier_complete(bar, b.x, nloc, nx); b.st[0] = nloc; b.st[1] = nx; }
        const unsigned old = xb_add(&bar[XB_XSUB(b.x)], 1u);
        const unsigned gen = old / nloc;
        if (old + 1u == (gen + 1u) * nloc) {
            __builtin_amdgcn_fence(__ATOMIC_RELEASE, "agent");
            asm volatile("s_waitcnt vmcnt(0)" ::: "memory");
            const unsigned og = xb_add(&bar[XB_TOP], 1u);
            const unsigned tg = og / nx;
            if (og + 1u == (tg + 1u) * nx) xb_add(&bar[XB_TOPGEN], 1u);
            else XB_SPIN(xb_ld(&bar[XB_TOPGEN]) == tg, bar);
            __builtin_amdgcn_fence(__ATOMIC_ACQUIRE, "agent");
            xb_add(&bar[XB_XGEN(b.x)], 1u);
            asm volatile("s_waitcnt vmcnt(0)" ::: "memory");
        } else {
            XB_SPIN(xb_ld(&bar[XB_XGEN(b.x)]) == gen, bar);
            __builtin_amdgcn_fence(__ATOMIC_ACQUIRE, "agent");
            asm volatile("s_waitcnt vmcnt(0)" ::: "memory");
        }
    }
    __syncthreads();
}

#define LDS_WAIT() asm volatile("s_waitcnt lgkmcnt(0)" ::: "memory")
__device__ __forceinline__ float wave_sum(float v) {
#pragma unroll
    for (int o = 1; o < 64; o <<= 1) v += __shfl_xor(v, o);
    return v;
}
typedef __bf16 bf16n2_t __attribute__((ext_vector_type(2)));
__device__ __forceinline__ unsigned cvt2_bf16_native(float lo, float hi) { const bf16n2_t v = {(__bf16)lo, (__bf16)hi}; return __builtin_bit_cast(unsigned, v); }
__device__ __forceinline__ void pool_fold_item(const float* Wp, const float* ps, const float* Wol, bf16_t* WT, int g_, int nb, int lane) {
    const int c16 = lane & 15, kg = lane >> 4, n0 = nb * 64;
    bf16x8 bfr[4][8];
#pragma unroll
    for (int ks = 0; ks < 8; ++ks) { const int d0 = ks * 32 + 8 * kg; const f32x4 p0 = *(const f32x4*)(ps + d0), p1 = *(const f32x4*)(ps + d0 + 4);
#pragma unroll
        for (int nh = 0; nh < 2; ++nh) { float t[2][8];
#pragma unroll
            for (int nq = 0; nq < 2; ++nq) { const float* bp = Wol + (size_t)d0 * 2048 + n0 + 16 * (2 * nh + nq) + c16;
#pragma unroll
                for (int j = 0; j < 8; ++j) t[nq][j] = bp[j * 2048]; }
            __builtin_amdgcn_sched_barrier(0);
#pragma unroll
            for (int nq = 0; nq < 2; ++nq) { u32x4 w;
                w.x = cvt2_bf16_native(t[nq][0] * p0[0], t[nq][1] * p0[1]); w.y = cvt2_bf16_native(t[nq][2] * p0[2], t[nq][3] * p0[3]);
                w.z = cvt2_bf16_native(t[nq][4] * p1[0], t[nq][5] * p1[1]); w.w = cvt2_bf16_native(t[nq][6] * p1[2], t[nq][7] * p1[3]); bfr[2 * nh + nq][ks] = __builtin_bit_cast(bf16x8, w); }
            __builtin_amdgcn_sched_barrier(0); } }
    for (int cb = 0; cb < 16; ++cb) { f32x4 acc[4];
#pragma unroll
        for (int nbk = 0; nbk < 4; ++nbk) acc[nbk] = (f32x4){0.f, 0.f, 0.f, 0.f};
#pragma unroll
        for (int kh = 0; kh < 2; ++kh) { f32x4 av[4][2];
#pragma unroll
            for (int k4 = 0; k4 < 4; ++k4) { const float* ap = Wp + (size_t)(cb * 16 + c16) * 256 + (kh * 4 + k4) * 32 + 8 * kg; av[k4][0] = *(const f32x4*)ap; av[k4][1] = *(const f32x4*)(ap + 4); }
            __builtin_amdgcn_sched_barrier(0);
#pragma unroll
            for (int k4 = 0; k4 < 4; ++k4) { const f32x4 a0 = av[k4][0], a1 = av[k4][1];
                u32x4 w; w.x = cvt2_bf16_native(a0[0], a0[1]); w.y = cvt2_bf16_native(a0[2], a0[3]); w.z = cvt2_bf16_native(a1[0], a1[1]); w.w = cvt2_bf16_native(a1[2], a1[3]); const bf16x8 af = __builtin_bit_cast(bf16x8, w);
#pragma unroll
                for (int nbk = 0; nbk < 4; ++nbk) acc[nbk] = __builtin_amdgcn_mfma_f32_16x16x32_bf16(af, bfr[nbk][kh * 4 + k4], acc[nbk], 0, 0, 0); }
            __builtin_amdgcn_sched_barrier(0); }
#pragma unroll
        for (int nbk = 0; nbk < 4; ++nbk) { u32x2 o; o.x = cvt2_bf16_native(acc[nbk][0], acc[nbk][1]); o.y = cvt2_bf16_native(acc[nbk][2], acc[nbk][3]);
            *(u32x2*)(WT + (size_t)(n0 + 16 * nbk + c16) * 2048 + 1024 + g_ * 256 + cb * 16 + 4 * kg) = o; }
        __builtin_amdgcn_sched_barrier(0); }
}
__device__ __forceinline__ unsigned cvt_pk_f16_rne(float a, float b) { const h2_t v = {(_Float16)a, (_Float16)b}; return __builtin_bit_cast(unsigned, v); }
template <bool F16 = false>
__device__ __forceinline__ void tr_item(const float* W, int K, int N, bf16_t* WT, const float* rs, const float* cs, int perm_limit, LAS float* scr, int item, int lane) {
    const int nblk = N / 32, kb = item / nblk, nb = item % nblk, k0 = 64 * kb, n0 = 32 * nb;
    const float csv = cs ? cs[n0 + (lane & 31)] : 1.f;
    float wv[32], rv[32];
#pragma unroll
    for (int i = 0; i < 32; ++i) { const int kk = 2 * i + (lane >> 5); wv[i] = W[(size_t)(k0 + kk) * N + n0 + (lane & 31)]; rv[i] = rs ? rs[k0 + kk] : 1.f; }
#pragma unroll
    for (int i = 0; i < 32; ++i) { const int kk = 2 * i + (lane >> 5); scr[kk * 33 + (lane & 31)] = wv[i] * rv[i] * csv; }
    LDS_WAIT(); asm volatile("" ::: "memory");
    int d0 = n0; if (n0 < perm_limit) { const int tile = n0 >> 8, lb = (n0 >> 5) & 7; d0 = (tile << 8) + ((4 * (lb & 1) + (lb >> 1)) << 5); }
    if (perm_limit < 0) { const int isv = n0 >= D_FF, ch = n0 - (isv ? D_FF : 0); d0 = (ch >> 7) * 256 + isv * 128 + (ch & 127); }
    const int c = lane & 7;
#pragma unroll
    for (int j = 0; j < 4; ++j) { const int n = (lane >> 3) + 8 * j; const LAS float* s = scr + (8 * c) * 33 + n;
        u32x4 o;
        if constexpr (F16) { o.x = cvt_pk_f16_rne(s[0 * 33], s[1 * 33]); o.y = cvt_pk_f16_rne(s[2 * 33], s[3 * 33]); o.z = cvt_pk_f16_rne(s[4 * 33], s[5 * 33]); o.w = cvt_pk_f16_rne(s[6 * 33], s[7 * 33]); }
        else { o.x = cvt_pk_bf16(s[0 * 33], s[1 * 33]); o.y = cvt_pk_bf16(s[2 * 33], s[3 * 33]); o.z = cvt_pk_bf16(s[4 * 33], s[5 * 33]); o.w = cvt_pk_bf16(s[6 * 33], s[7 * 33]); }
        *(u32x4*)(WT + (size_t)(d0 + n) * K + k0 + 8 * c) = o; }
    LDS_WAIT(); asm volatile("" ::: "memory");
}
__device__ __forceinline__ void norm_row(const float* xrow, bf16_t* orow, float* crow_, int lane) {
    f32x4 v[8]; float s = 0.f;
#pragma unroll
    for (int j = 0; j < 4; ++j) { v[2 * j] = *(const f32x4*)(xrow + j * 512 + lane * 8); v[2 * j + 1] = *(const f32x4*)(xrow + j * 512 + lane * 8 + 4); s += pg8::sumsq4(v[2 * j]) + pg8::sumsq4(v[2 * j + 1]); }
    const float rstd = __builtin_amdgcn_rsqf(wave_sum(s) * (1.0f / D_MODEL) + EPS);
#pragma unroll
    for (int j = 0; j < 4; ++j) { if (crow_) { *(f32x4*)(crow_ + j * 512 + lane * 8) = v[2 * j]; *(f32x4*)(crow_ + j * 512 + lane * 8 + 4) = v[2 * j + 1]; }
        *(u32x4*)(orow + j * 512 + lane * 8) = pg8::pack8(v[2 * j] * rstd, v[2 * j + 1] * rstd); }
}

__device__ __forceinline__ void raw_row(const float* xrow, bf16_t* orow, rss_t* ssq, int lane) {
    f32x4 v[8]; float s = 0.f;
#pragma unroll
    for (int j = 0; j < 4; ++j) { v[2 * j] = *(const f32x4*)(xrow + j * 512 + lane * 8); v[2 * j + 1] = *(const f32x4*)(xrow + j * 512 + lane * 8 + 4); s += pg8::sumsq4(v[2 * j]) + pg8::sumsq4(v[2 * j + 1]); }
    s = wave_sum(s); if (lane == 0) *ssq = ss_fix(s);
#pragma unroll
    for (int j = 0; j < 4; ++j) *(u32x4*)(orow + j * 512 + lane * 8) = pg8::pack8(v[2 * j], v[2 * j + 1]);
}

template <int WIN> __device__ __forceinline__ void pool_item(const bf16_t* U, bf16_t* ZP, int r0, int ch, bool big) {
    constexpr int NR = 3 + 2 * WIN, SM = WIN / 2;
    const int pos0 = tok_pos(r0), S = tok_seqlen(r0);
    u32x4 v[NR];
#pragma unroll
    for (int k = 0; k < NR; ++k) { const int p = pos0 - WIN + k; v[k] = (p >= 0 && p < S) ? *(const u32x4*)(U + (size_t)(r0 - WIN + k) * 1024 + ch) : (u32x4){0u, 0u, 0u, 0u}; }
    float sb[8], ss[8];
#pragma unroll
    for (int j = 0; j < 8; ++j) { sb[j] = 0.f; ss[j] = 0.f; }
#define POOL_ACC(dst, k, sgn) do { const u32x4 w_ = v[k]; dst[0] += sgn bflo(w_.x); dst[1] += sgn bfhi(w_.x); dst[2] += sgn bflo(w_.y); dst[3] += sgn bfhi(w_.y); dst[4] += sgn bflo(w_.z); dst[5] += sgn bfhi(w_.z); dst[6] += sgn bflo(w_.w); dst[7] += sgn bfhi(w_.w); } while (0)
#pragma unroll
    for (int k = 0; k < 2 * WIN; ++k) { POOL_ACC(sb, k, +); if (k >= WIN - SM && k < WIN + SM) POOL_ACC(ss, k, +); }
#pragma unroll
    for (int i = 0; i < 4; ++i) {
        if (i > 0) { POOL_ACC(sb, i + 2 * WIN - 1, +); POOL_ACC(sb, i - 1, -); POOL_ACC(ss, i + WIN + SM - 1, +); POOL_ACC(ss, i + WIN - SM - 1, -); }
        const int pos = pos0 + i, w2 = big ? WIN : SM; const int lo_ = pos - w2 < 0 ? 0 : pos - w2, hi_ = pos + w2 > S ? S : pos + w2; const float inv = 1.0f / (float)(hi_ - lo_);
        const u32x4 c = v[WIN + i]; float s[8];
#pragma unroll
        for (int j = 0; j < 8; ++j) s[j] = (big ? sb[j] : ss[j]) * inv;
        u32x4 o; o.x = cvt_pk_bf16(s[0] - bflo(c.x), s[1] - bfhi(c.x)); o.y = cvt_pk_bf16(s[2] - bflo(c.y), s[3] - bfhi(c.y)); o.z = cvt_pk_bf16(s[4] - bflo(c.z), s[5] - bfhi(c.z)); o.w = cvt_pk_bf16(s[6] - bflo(c.w), s[7] - bfhi(c.w));
        *(u32x4*)(ZP + (size_t)(r0 + i) * 1024 + ch) = o; }
#undef POOL_ACC
}

struct Args { const float* in[28]; float* out; unsigned char* ws; int ph_lo, ph_hi; };

__global__ void __launch_bounds__(NWAVES * 64, 2) trunk_fwd(Args args) {
    extern __shared__ __attribute__((aligned(16))) unsigned char lds_raw[];
    LAS unsigned char* lds = (LAS unsigned char*)lds_raw;
    volatile LAS unsigned* MISC = (volatile LAS unsigned*)(lds + MISC_OFF);
    for (int u = threadIdx.x; u < (LDS_BYTES - LDSCTL_OFF) / 4; u += NWAVES * 64) ((LAS unsigned*)(lds + LDSCTL_OFF))[u] = 0u;
    __syncthreads();
    const int lo = args.ph_lo, hi = args.ph_hi;
    XcdBarrier bar; bar.bar = (unsigned*)(args.ws + WS_CTL) + CW_BAR; bar.x = 0; bar.st = nullptr;
    if (hi - lo > 1) bar = xcd_barrier_post((unsigned*)(args.ws + WS_CTL) + CW_BAR, MISC + 8);
#define IN(k) ({ int lo_ = lo, hi_ = hi; asm volatile("" : "+s"(lo_), "+s"(hi_)); lo_ <= (k) && (k) < hi_; })
#define SEAM(k) do { if (IN(k) && IN((k) + 1)) { XcdBarrier b2_ = bar; asm volatile("" : "+s"(b2_.bar), "+s"(b2_.x)); xcd_barrier(b2_); } } while (0)
#define PHASE_BEGIN() int tid = threadIdx.x; asm volatile("" : "+v"(tid)); int zo = 0; asm volatile("" : "+s"(zo)); \
    const int lane = tid & 63, wave = __builtin_amdgcn_readfirstlane(tid >> 6); const int G = gridDim.x, bx = blockIdx.x; \
    const int vcu = (G % 8 == 0) ? (bx % 8) * (G / 8) + bx / 8 : bx; const int gw = vcu * NWAVES + wave, NGW = G * NWAVES; \
    unsigned char* ws = args.ws + zo; float* X = args.out + zo; (void)lane; (void)wave; (void)gw; (void)NGW; (void)ws; (void)X; (void)vcu; (void)tid
#define INP(i) (args.in[(i) + zo])
#define WSP(T, off) ((T*)(ws + (off)))

#define CG_UP 1u
#define CG_DOWN 2u
#define CG_IN 4u
#define CG_CKV 8u
#define CG_OUT 16u
#define CG_CQ 32u
#define CG_CO 64u
#define CONV_ITEMS(L_, MASK_) do { const int l_ = (L_); constexpr unsigned m_ = (MASK_); __syncthreads(); LAS float* scr = (LAS float*)(lds + wave * 16384);                                         \
    constexpr int I_IN = 32 * 128, I_OUT = 16 * 64, I_CQ = 32 * 64, I_CKV = 32 * 128, I_CO = 32 * 64, I_UP = 32 * (UP_W / 32), I_DOWN = (D_FF / 64) * 64, I_P = 4 * 32;                                 \
    constexpr int n_ = ((m_ & CG_UP) ? I_UP : 0) + ((m_ & CG_DOWN) ? I_DOWN : 0) + ((m_ & CG_IN) ? I_IN : 0) + ((m_ & CG_CKV) ? I_CKV : 0) + ((m_ & CG_OUT) ? I_OUT + I_P : 0) + ((m_ & CG_CQ) ? I_CQ : 0) + ((m_ & CG_CO) ? I_CO : 0); \
    for (int it = gw; it < n_; it += NGW) { int r = it;                                                                                                                                            \
        if constexpr ((m_ & CG_UP) != 0) { if (r < I_UP) { tr_item(INP(24) + (size_t)l_ * 2048 * UP_W, 2048, UP_W, WSP(bf16_t, WS_WUP), INP(23) + l_ * 2048, nullptr, -1, scr, r, lane); continue; } r -= I_UP; } \
        if constexpr ((m_ & CG_DOWN) != 0) { if (r < I_DOWN) { tr_item<true>(INP(27) + (size_t)l_ * D_FF * 2048, D_FF, 2048, WSP(bf16_t, WS_WDOWN), nullptr, nullptr, 0, scr, r, lane); continue; } r -= I_DOWN; } \
        if constexpr ((m_ & CG_IN) != 0) { if (r < I_IN) { tr_item(INP(5) + (size_t)l_ * 2048 * 4096, 2048, 4096, WSP(bf16_t, WS_WIN), INP(4) + l_ * 2048, nullptr, 2048, scr, r, lane); continue; } r -= I_IN; } \
        if constexpr ((m_ & CG_CKV) != 0) { if (r < I_CKV) { tr_item(INP(19) + (size_t)l_ * 2048 * 4096, 2048, 4096, WSP(bf16_t, WS_WCKV), INP(17) + l_ * 2048, nullptr, 0, scr, r, lane); continue; } r -= I_CKV; } \
        if constexpr ((m_ & CG_OUT) != 0) { if (r < I_OUT) { tr_item(INP(15) + (size_t)l_ * 2048 * 2048, 2048, 2048, WSP(bf16_t, WS_WOUT), nullptr, nullptr, 0, scr, r, lane); continue; } r -= I_OUT;   \
            if (r < I_P) { const int g = r >> 5; pool_fold_item(INP(13) + (size_t)l_ * 4 * 65536 + (size_t)g * 65536, INP(14) + l_ * 1024 + g * 256, INP(15) + (size_t)l_ * 2048 * 2048 + (size_t)(1024 + g * 256) * 2048, WSP(bf16_t, WS_WOUT), g, r & 31, lane); continue; } r -= I_P; } \
        if constexpr ((m_ & CG_CQ) != 0) { if (r < I_CQ) { tr_item(INP(18) + (size_t)l_ * 2048 * 2048, 2048, 2048, WSP(bf16_t, WS_WCQ), INP(16) + l_ * 2048, nullptr, 0, scr, r, lane); continue; } r -= I_CQ; } \
        if constexpr ((m_ & CG_CO) != 0) { if (r < I_CO) { tr_item(INP(22) + (size_t)l_ * 2048 * 2048, 2048, 2048, WSP(bf16_t, WS_WCO), nullptr, nullptr, 0, scr, r, lane); continue; } r -= I_CO; } }   \
    if constexpr ((m_ & CG_UP) != 0) { const float* cw = INP(25) + (size_t)l_ * 3 * UP_W; const float* cb = INP(26) + (size_t)l_ * UP_W; u32x4* cwt = WSP(u32x4, WS_CWT);        \
        for (int it = vcu * 512 + tid; it < D_FF; it += G * 512) { const int p = it >> 1, isv = it & 1, ch = 2 * p + isv * D_FF; u32x4 w;                                                          \
            w.x = cvt_pk_f16_rne(cw[ch], cw[ch + 1]); w.y = cvt_pk_f16_rne(cw[UP_W + ch], cw[UP_W + ch + 1]); w.z = cvt_pk_f16_rne(cw[2 * UP_W + ch], cw[2 * UP_W + ch + 1]); w.w = cvt_pk_f16_rne(cb[ch], cb[ch + 1]); cwt[it] = w; } } } while (0)
    for (int l = 0; l < DEPTH; ++l) {
        const int pb = l * PH_PER_LAYER;
        if (PH_EN(0) && IN(pb + 0)) {
            PHASE_BEGIN();
            if (l == 0) CONV_ITEMS(0, CG_IN | CG_CKV);
            bf16_t* HB = WSP(bf16_t, WS_HB);
            if (l == 0) {
                unsigned* csT = WSP(unsigned, WS_COS);
                for (int e = (vcu * 512 + tid); e < 8192 * 32; e += G * 512) { const int pos = e >> 5, i = e & 31;
                    double inv = 1.0; const double b = 0.74989420933245582730;
                    for (int k = 0; k < i; ++k) inv *= b;
                    double rev = (double)pos * inv * 0.15915494309189533577; rev -= __builtin_floor(rev);
                    const float fr_ = (float)rev;
                    const _Float16 hc = (_Float16)__builtin_amdgcn_cosf(fr_), hs = (_Float16)__builtin_amdgcn_sinf(fr_);
                    csT[e] = (unsigned)__builtin_bit_cast(unsigned short, hc) | ((unsigned)__builtin_bit_cast(unsigned short, hs) << 16); }
                bf16_t* MB = WSP(bf16_t, WS_MB);
                for (int m = gw; m < NMEMROWS; m += NGW) { const float* src = m < 1024 ? INP(2) + (size_t)m * 2048 : INP(3) + (size_t)(m - 1024) * 2048; norm_row(src, MB + (size_t)m * 2048, nullptr, lane); }
                rss_t* rss0 = WSP(rss_t, WS_ROWSS);
                for (int m = gw; m < NTOK; m += NGW) { const float* src = m < NTOK_P ? INP(0) + (size_t)m * 2048 : INP(1) + (size_t)(m - NTOK_P) * 2048; raw_row(src, HB + (size_t)m * 2048, rss0 + m, lane); }
            }
        }
        if (l == 0) SEAM(pb + 0);
        if (PH_EN(1) && IN(pb + 1)) {
            PHASE_BEGIN(); pg8::StaticOrder SO;
            if (PH_EN(17)) { pg8::ProbSimple P; P.K = 2048; P.lda = 2048; P.ldb = 2048; P.tsplit = 1 << 30; P.adelta = 0; P.A = (const char*)WSP(bf16_t, WS_HB); P.B = (const char*)WSP(bf16_t, WS_WIN);
              SO.init(NTOK / 256, IN_W / 256, G, bx, l == 0 ? 1 : 0);
              pg8::EpiIn E{WSP(bf16_t, R_Q), (size_t)NTOK * 1024, WSP(const unsigned, WS_COS), INP(6) + l * 64, INP(7) + l * 64, WSP(const rss_t, WS_ROWSS) + (size_t)(l * 3 + 0) * NTOK};
              pg8::gemm_phase<pg8::ProbSimple, pg8::EpiIn, true, true>(lds, P, SO, E); }
            if (PH_EN(16)) { pg8::ProbSimple P; P.K = 2048; P.lda = 2048; P.ldb = 2048; P.tsplit = 1 << 30; P.adelta = 0; P.A = (const char*)WSP(bf16_t, WS_MB); P.B = (const char*)WSP(bf16_t, WS_WCKV);
              SO.init(NMEMROWS / 256, 4096 / 256, G, bx);
              pg8::EpiKV E{WSP(float, WS_KRAW), WSP(bf16_t, WS_VT)};
              pg8::gemm_phase<pg8::ProbSimple, pg8::EpiKV, true, true>(lds, P, SO, E); }
            if (l == 0) CONV_ITEMS(0, CG_OUT | CG_CO | CG_CQ);
        }
        SEAM(pb + 1);
        if (PH_EN(2) && IN(pb + 2)) {
            if (PH_EN(18)) {
              PHASE_BEGIN();
              const float lam_init = 0.8f - 0.6f * __expf(-0.3f * (float)l);
              float s1 = 0.f, s2 = 0.f; const float* q1 = INP(8) + l * 64; const float* k1 = INP(9) + l * 64; const float* q2 = INP(10) + l * 64; const float* k2 = INP(11) + l * 64;
              for (int i = 0; i < 64; ++i) { s1 += q1[i] * k1[i]; s2 += q2[i] * k2[i]; }
              const float lam = __expf(s1) - __expf(s2) + lam_init;
              const float* gsub = INP(12) + l * 128;
              bf16_t* Qb = WSP(bf16_t, R_Q); const bf16_t* Kb = WSP(const bf16_t, R_K); const bf16_t* Vb = WSP(const bf16_t, R_V);
              __syncthreads();
              { const int NX = (G % 8 == 0) ? 8 : 1, xcd = bx % NX, j = bx / NX, nb = G / NX, npr = 2048 / NX;
                  for (int kk = j; kk < 2 * npr; kk += nb) { int pair, qt, S; size_t t0;
                      if (kk < npr) { pair = xcd + NX * (kk >> 6); qt = kk & 63; S = S_P; t0 = (size_t)(pair >> 3) * S_P; }
                      else { const int k2_ = kk - npr; pair = xcd + NX * (k2_ >> 5); qt = k2_ & 31; S = S_S; t0 = (size_t)NTOK_P + (size_t)(pair >> 3) * S_S; }
                      const int h = pair & 7; bf16_t* qp = Qb + (t0 + (size_t)qt * 128) * 1024 + h * 128;
                      ATTN_NS::attn_unit(qp, Kb + t0 * 1024 + h * 128, Vb + t0 * 1024 + h * 128, qp, S, lam, gsub, 1.f - lam_init, lds, kk < npr && ((kk / nb) & 1)); }
              }
            }
            if (PH_EN(14)) { PHASE_BEGIN(); const bf16_t* U = WSP(const bf16_t, R_U); bf16_t* ZP = (bf16_t*)X;
#ifdef PROBE_DOUBLE_PASSES
              int nrq = 2; asm volatile("" : "+s"(nrq)); for (int rq_ = 0; rq_ < nrq; ++rq_)
#endif
              for (int it = gw; it < (NTOK / 4) * 2; it += NGW) { const int r0 = (it >> 1) * 4, half = it & 1, ch = half * 512 + lane * 8;
                  if (half == 0) pool_item<2>(U, ZP, r0, ch, lane >= 32); else pool_item<8>(U, ZP, r0, ch, lane >= 32); } }
            if (PH_EN(15)) { PHASE_BEGIN(); const float* gcq = INP(20) + l * 512; const float* gck = INP(21) + l * 512; const float* KRAW = WSP(const float, WS_KRAW); bf16_t* KC = WSP(bf16_t, WS_KC);
              for (int it = gw; it < NMEMROWS * 4; it += NGW) { const int row = it >> 2, h = it & 3; const float* kr = KRAW + (size_t)row * 2048 + h * 512 + lane * 8;
                  const f32x4 a = *(const f32x4*)kr, b = *(const f32x4*)(kr + 4); const float ss = wave_sum(pg8::sumsq4(a) + pg8::sumsq4(b));
                  const float rk = __builtin_amdgcn_rsqf(ss * (1.0f / 512.0f) + EPS);
                  const f32x4 ga = *(const f32x4*)(gcq + lane * 8) * *(const f32x4*)(gck + lane * 8), gb = *(const f32x4*)(gcq + lane * 8 + 4) * *(const f32x4*)(gck + lane * 8 + 4);
                  *(u32x4*)(KC + (size_t)row * 2048 + h * 512 + lane * 8) = pg8::pack8(a * rk * ga, b * rk * gb); } }
            { PHASE_BEGIN(); if (l == 0) CONV_ITEMS(0, CG_UP); else CONV_ITEMS(l, CG_DOWN); }
        }
        SEAM(pb + 2);
        if (PH_EN(4) && IN(pb + 4)) {
            PHASE_BEGIN(); pg8::StaticOrder SO;
            pg8::ProbSimple P; P.K = 2048; P.lda = 1024; P.ldb = 2048; P.tsplit = 16; P.adelta = (long long)((const char*)X - (const char*)(ws + R_Q)) - 16ll * 128; P.A = (const char*)(ws + R_Q);   P.B = (const char*)WSP(bf16_t, WS_WOUT);
            SO.init(NTOK / 256, 8, G, bx);
            pg8::EpiRes E{WSP(bf16_t, WS_HB), WSP(rss_t, WS_ROWSS) + (size_t)(l * 3 + 1) * NTOK, nullptr};
            pg8::gemm_phase<pg8::ProbSimple, pg8::EpiRes, true, true>(lds, P, SO, E);
            if (PH_EN(3)) {

              pg8::ProbVW P2; P2.K = 512; P2.lda = 2048; P2.ldb = 2048; P2.tsplit = 1 << 30; P2.adelta = 0; P2.A = (const char*)WSP(bf16_t, WS_WCO); P2.B = (const char*)WSP(bf16_t, WS_VT);
              SO.init(8, 48, G, bx);
              pg8::EpiBf<5> E2{WSP(bf16_t, R_VW), 1024, nullptr, nullptr, nullptr};
              pg8::gemm_phase<pg8::ProbVW, pg8::EpiBf<5>, true, true>(lds, P2, SO, E2); }
            if (l == 0) CONV_ITEMS(0, CG_DOWN);
            if (l + 1 < DEPTH) CONV_ITEMS(l + 1, CG_IN | CG_CKV);
        }
        SEAM(pb + 4);
        if (PH_EN(5) && IN(pb + 5)) {
            PHASE_BEGIN(); pg8::StaticOrder SO;
            pg8::ProbSimple P; P.K = 2048; P.lda = 2048; P.ldb = 2048; P.tsplit = 1 << 30; P.adelta = 0; P.A = (const char*)WSP(bf16_t, WS_HB); P.B = (const char*)WSP(bf16_t, WS_WCQ);
            SO.init(NTOK / 256, 8, G, bx, 1);
            pg8::EpiBf<1> E{WSP(bf16_t, R_QC), 2048, WSP(float, WS_QSS), (float*)(WSP(rss_t, WS_ROWSS) + (size_t)(l * 3 + 1) * NTOK), nullptr};
            pg8::gemm_phase<pg8::ProbSimple, pg8::EpiBf<1>, true, true>(lds, P, SO, E);
            if (l + 1 < DEPTH) CONV_ITEMS(l + 1, CG_OUT | CG_CO);
        }
        SEAM(pb + 5);
        if (PH_EN(6) && IN(pb + 6)) {
            PHASE_BEGIN(); pg8::StaticOrder SO;
            pg8::ProbScores P; P.K = 512; P.lda = 2048; P.ldb = 2048; P.tsplit = 1 << 30; P.adelta = 0; P.A = (const char*)(ws + R_QC); P.B = (const char*)WSP(bf16_t, WS_KC);
            SO.init(NTOK / 256, 4, G, bx);
            pg8::EpiBf<2> E{WSP(bf16_t, R_P), 1024, WSP(float, WS_QSS), nullptr, (LAS float*)(lds + XCH_OFF)};
            pg8::gemm_phase<pg8::ProbScores, pg8::EpiBf<2>, true, true>(lds, P, SO, E);
            if (l + 1 < DEPTH) CONV_ITEMS(l + 1, CG_CQ);
        }
        SEAM(pb + 6);
        if (PH_EN(8) && IN(pb + 7)) {
            PHASE_BEGIN(); pg8::StaticOrder SO;
            pg8::ProbFin P; P.K = 1024; P.lda = 1024; P.ldb = 1024; P.tsplit = 1 << 30; P.adelta = 0; P.A = (const char*)(ws + R_P); P.B = (const char*)WSP(bf16_t, R_VW);
            SO.init(NTOK / 256, 8, G, bx, 1);
            pg8::EpiRes E{WSP(bf16_t, WS_HB), WSP(rss_t, WS_ROWSS) + (size_t)(l * 3 + 2) * NTOK, nullptr};
            pg8::gemm_phase<pg8::ProbFin, pg8::EpiRes, true, true>(lds, P, SO, E);
        }
        SEAM(pb + 7);
        const bool whole = (l + 1 < DEPTH); const int nch = whole ? 1 : N_FFN_CHUNKS;
        for (int c = 0; c < nch; ++c) {
            const int pc = pb + 8 + 2 * c; const size_t r0 = (size_t)c * FFN_CHUNK; const int MT = whole ? NTOK / 256 : FFN_MT;
            if (PH_EN(11) && IN(pc)) {
                PHASE_BEGIN(); pg8::StaticOrder SO;
                pg8::ProbUp P; P.K = 2048; P.lda = 2048; P.ldb = 2048; P.tsplit = 1 << 30; P.adelta = 0; P.A = (const char*)(WSP(bf16_t, WS_HB) + r0 * 2048); P.B = (const char*)WSP(bf16_t, WS_WUP); P.chunk = c;
                SO.init(MT, D_FF / 128, G, bx);
                bf16_t* G2p = (bf16_t*)((unsigned char*)X - (size_t)FFN_GSPLIT_ROW * D_FF * 2); bf16_t* EBp = whole ? (bf16_t*)((unsigned char*)X + FFN_EB_OUT_OFF) : WSP(bf16_t, R_EB);
                pg8::EpiGlu E{WSP(bf16_t, R_G), WSP(const rss_t, WS_ROWSS) + (size_t)(l * 3 + 2) * NTOK + r0, WSP(const u32x4, WS_CWT), c, (LAS float*)(lds + GLX_OFF), EBp, G2p, whole ? FFN_GSPLIT_ROW / 256 : (1 << 30)};
                pg8::gemm_phase<pg8::ProbUp, pg8::EpiGlu, true, true>(lds, P, SO, E);
            }
            SEAM(pc);
            if (PH_EN(13) && IN(pc + 1)) {
                PHASE_BEGIN(); pg8::StaticOrder SO;
                bf16_t* G2p = (bf16_t*)((unsigned char*)X - (size_t)FFN_GSPLIT_ROW * D_FF * 2);
                {
                  const bf16_t* EBp = whole ? (const bf16_t*)((unsigned char*)X + FFN_EB_OUT_OFF) : WSP(const bf16_t, R_EB); const u32x4* cwp = WSP(const u32x4, WS_CWT); bf16_t* Gp = WSP(bf16_t, R_G);
                  const int nb = whole ? 244 : (c == 0 ? 124 : 120), gsr = whole ? FFN_GSPLIT_ROW : (1 << 30);
                  for (int it = gw; it < nb * 11; it += NGW) { const int b = it / 11, cb = it - b * 11; int t;
                      if (whole ? b < 124 : c == 0) { const int sq = b / 31, bi = b - sq * 31; t = sq * S_P + 256 * (bi + 1); }
                      else { const int b2 = whole ? b - 124 : b, sq = b2 / 15, bi = b2 - sq * 15; t = (whole ? NTOK_P : 0) + sq * S_S + 256 * (bi + 1); }
                      pg8::ffn_fix_item(EBp, cwp, Gp, G2p, gsr, t, cb, lane); }
                  XcdBarrier b4_ = bar; asm volatile("" : "+s"(b4_.bar), "+s"(b4_.x)); xcd_barrier(b4_); }
                pg8::ProbDown P; P.K = D_FF; P.lda = D_FF; P.ldb = D_FF; P.tsplit = 1 << 30; P.adelta = 0; P.A = (const char*)(ws + R_G); P.A2 = (const char*)G2p; P.B = (const char*)WSP(bf16_t, WS_WDOWN); P.split = whole ? FFN_GSPLIT_ROW / 256 : (1 << 30);
                SO.init(MT, 8, G, bx, 1);
                pg8::EpiRes E{WSP(bf16_t, WS_HB) + r0 * 2048, (l + 1 < DEPTH) ? WSP(rss_t, WS_ROWSS) + (size_t)((l + 1) * 3 + 0) * NTOK + r0 : nullptr, (l + 1 < DEPTH) ? nullptr : X + r0 * 2048};
                pg8::gemm_phase<pg8::ProbDown, pg8::EpiRes, true, true>(lds, P, SO, E);
                if (c == nch - 1 && l + 1 < DEPTH) CONV_ITEMS(l + 1, CG_UP);
            }
            SEAM(pc + 1);
        }
    }
#undef IN
#undef SEAM
#undef PHASE_BEGIN
#undef INP
#undef WSP
}


#ifdef SELFCHECK
constexpr int CHK_WORD = 1024;
__device__ __forceinline__ void chk_upd(unsigned* ctl, int idx, float got, float ref) { const float e = fabsf(got - ref) / (0.03f * fabsf(ref) + 0.03f); atomicMax(ctl + CHK_WORD + idx, __float_as_uint(e)); }
__device__ __forceinline__ int chk_token(int s) { const int tab[16] = {0, 1, 127, 128, 4095, 8191, 8192, 12345, 32767, 32768, 32769, 36863, 36864, 50000, 65534, 65535}; int t = 0;
#pragma unroll
    for (int i = 0; i < 16; ++i) t = (s & 15) == i ? tab[i] : t; return t; }
__global__ void __launch_bounds__(64) check_kernel(Args args, int after, int l) {
    const int s = blockIdx.x, lane = threadIdx.x; unsigned char* ws = args.ws; unsigned* ctl = (unsigned*)(ws + WS_CTL);
    const int tok = chk_token(s); float* X = args.out;
    const float* xin = tok < NTOK_P ? args.in[0] + (size_t)tok * 2048 : args.in[1] + (size_t)(tok - NTOK_P) * 2048;
    if (after == 1) {
        if (l == 0) {
            float ssx = 0.f; for (int k = lane; k < 2048; k += 64) ssx += xin[k] * xin[k]; ssx = wave_sum(ssx); const float rstd = 1.0f / sqrtf(ssx / 2048.f + EPS);
            const int vec = (s * 7) & 31, isk = vec >> 4, hc = vec & 15;
            const float* w_in = args.in[5]; const float* g_mix = args.in[4]; const int col = isk * 1024 + hc * 64 + lane;
            float z = 0.f; for (int k = 0; k < 2048; ++k) z += xin[k] * rstd * g_mix[k] * w_in[(size_t)k * 4096 + col];
            const float ss = wave_sum(z * z); const float g = (isk ? args.in[7] : args.in[6])[lane]; const float zn = z / sqrtf(ss / 64.f + EPS) * g;
            const float other = __shfl_xor(zn, 32); const int i = lane & 31; const int pos = tok_pos(tok);
            const float ang = (float)pos * powf(10000.f, -(float)i / 32.f); const float c = cosf(ang), sn = sinf(ang);
            const float ref = lane < 32 ? zn * c - other * sn : zn * c + other * sn;
            const bf16_t* Q = (const bf16_t*)(ws + (isk ? R_K : R_Q)); const float got = bf2f(Q[(size_t)tok * 1024 + hc * 64 + lane]);
            const float gother = __shfl_xor(got, 32);
            (void)gother; chk_upd(ctl, 0, got, ref);
            { const unsigned tv = ((const unsigned*)(ws + WS_COS))[pos * 32 + i]; typedef _Float16 h2 __attribute__((ext_vector_type(2))); const h2 hv = __builtin_bit_cast(h2, tv);
              chk_upd(ctl, 1, (float)hv.x, c); chk_upd(ctl, 1, (float)hv.y, sn); }
        }
        { const bf16_t* Q = (const bf16_t*)(ws + R_Q); bf16_t* sv = (bf16_t*)(ws + WS_CHK) + s * 128; const int h = s & 7; sv[lane] = Q[(size_t)tok * 1024 + h * 128 + lane]; sv[lane + 64] = Q[(size_t)tok * 1024 + h * 128 + 64 + lane]; }
    }
    if (after == 2) {
        const int h = s & 7; const bf16_t* sv = (const bf16_t*)(ws + WS_CHK) + s * 128; const int S = tok_seqlen(tok); const size_t t0 = (size_t)tok - tok_pos(tok);
        const bf16_t* K = (const bf16_t*)(ws + R_K) + t0 * 1024 + h * 128; const bf16_t* V = (const bf16_t*)(ws + R_V) + t0 * 1024 + h * 128;
        const float lam_init = 0.8f - 0.6f * expf(-0.3f * (float)l); float s1 = 0.f, s2 = 0.f;
        for (int i = 0; i < 64; ++i) { s1 += (args.in[8] + l * 64)[i] * (args.in[9] + l * 64)[i]; s2 += (args.in[10] + l * 64)[i] * (args.in[11] + l * 64)[i]; }
        const float lam = expf(s1) - expf(s2) + lam_init;
        float o[2][2];
        for (int c = 0; c < 2; ++c) { float mx = -1e30f;
            for (int k = lane; k < S; k += 64) { float d = 0.f; for (int e = 0; e < 64; ++e) d += bf2f(sv[c * 64 + e]) * bf2f(K[(size_t)k * 1024 + c * 64 + e]); mx = fmaxf(mx, d); }
            for (int o_ = 1; o_ < 64; o_ <<= 1) mx = fmaxf(mx, __shfl_xor(mx, o_));
            float lsum = 0.f, a0 = 0.f, a1 = 0.f;
            for (int k = 0; k < S; ++k) { float d = 0.f; for (int e = 0; e < 64; ++e) d += bf2f(sv[c * 64 + e]) * bf2f(K[(size_t)k * 1024 + c * 64 + e]);
                const float p = exp2f(d - mx); lsum += p; a0 += p * bf2f(V[(size_t)k * 1024 + lane]); a1 += p * bf2f(V[(size_t)k * 1024 + 64 + lane]); }
            o[c][0] = a0 / lsum; o[c][1] = a1 / lsum; }
        const float v0 = o[0][0] - lam * o[1][0], v1 = o[0][1] - lam * o[1][1]; const float ss = wave_sum(v0 * v0 + v1 * v1); const float rn = 1.0f / sqrtf(ss / 128.f + EPS) * (1.f - lam_init);
        const float* gsub = args.in[12] + l * 128; const bf16_t* A = (const bf16_t*)(ws + R_Q) + (size_t)tok * 1024 + h * 128;
        chk_upd(ctl, 2, bf2f(A[lane]), v0 * rn * gsub[lane]); chk_upd(ctl, 2, bf2f(A[64 + lane]), v1 * rn * gsub[64 + lane]);
    }
    if (after == 4 && l == 0) {
        const bf16_t* A = (const bf16_t*)(ws + R_Q) + (size_t)tok * 1024; const bf16_t* Pp = (const bf16_t*)(ws + R_POUT) + (size_t)tok * 1024; const float* w_out = args.in[15];
        const int col = (s * 131 + lane * 17) & 2047; float z = xin[col];
        for (int k = 0; k < 1024; ++k) z += bf2f(A[k]) * w_out[(size_t)k * 2048 + col];
        for (int k = 0; k < 1024; ++k) z += bf2f(Pp[k]) * w_out[(size_t)(1024 + k) * 2048 + col];
        chk_upd(ctl, 3, X[(size_t)tok * 2048 + col], z);
    }
    if (after == 8 && tok < FFN_CHUNK) {
        const bf16_t* HB = (const bf16_t*)(ws + WS_HB); const float* w_up = args.in[24] + (size_t)l * 2048 * UP_W; const float* g_ffn = args.in[23] + l * 2048;
        const float* cw = args.in[25] + (size_t)l * 3 * UP_W; const float* cb = args.in[26] + (size_t)l * UP_W;
        const int j = (s * 977 + lane * 53) % D_FF; const int pos = tok_pos(tok), S = tok_seqlen(tok); float u2[2];
        for (int half = 0; half < 2; ++half) { const int col = half * D_FF + j; float acc = cb[col];
            for (int tap = 0; tap < 3; ++tap) { const int pp = pos + tap - 1; if (pp < 0 || pp >= S) continue; const bf16_t* hr = HB + (size_t)(tok + tap - 1) * 2048; float d = 0.f;
                for (int k = 0; k < 2048; ++k) d += bf2f(hr[k]) * g_ffn[k] * w_up[(size_t)k * UP_W + col];
                const float rxx = ss_rstd(((const rss_t*)(ws + WS_ROWSS))[(size_t)(l * 3 + 2) * NTOK + tok + tap - 1]); acc += d * rxx * cw[(size_t)tap * UP_W + col]; }
            u2[half] = acc; }
        const float x = u2[0]; const float ref = 0.5f * x * (1.f + tanhf(0.7978845608028654f * (x + 0.044715f * x * x * x))) * u2[1];
        chk_upd(ctl, 4, bf2f(((const bf16_t*)(ws + R_G))[(size_t)tok * D_FF + j]), ref);
    }
    if (false) {
        const bf16_t* Gr = (const bf16_t*)(ws + R_G) + (size_t)tok * D_FF; const float* w_down = args.in[27] + (size_t)l * D_FF * 2048; const float* svx = (const float*)(ws + WS_CHK + 65536) + (size_t)s * 2048;
        const int col = (s * 131 + lane * 17) & 2047; float z = svx[col]; for (int k = 0; k < D_FF; ++k) z += bf2f(Gr[k]) * w_down[(size_t)k * 2048 + col];
        chk_upd(ctl, 5, X[(size_t)tok * 2048 + col], z);
    }
}
__global__ void __launch_bounds__(256) report_kernel(Args args) {
    unsigned* ctl = (unsigned*)(args.ws + WS_CTL); float* out = args.out;
    for (size_t i = (size_t)blockIdx.x * 256 + threadIdx.x; i < (size_t)NTOK * 2048; i += (size_t)gridDim.x * 256) {
        float v = 0.f;
        if (i == 0) { int mask = 0; for (int b = 0; b < 6; ++b) if (__uint_as_float(ctl[CHK_WORD + b]) > 1.0f) mask |= 1 << b; v = (10.f + (float)mask) * 1000.f; }
        out[i] = v; }
}
#endif

extern "C" void kernel_launch(void* const* d_in, const int* in_sizes, int n_in, void* d_out, int out_size, void* d_ws, size_t ws_size, hipStream_t stream) {
    static int grid = 0;
    if (grid == 0) {
        if (n_in != 28 || out_size != NTOK * D_MODEL || ws_size < WS_END) { fprintf(stderr, "kernel_launch: unexpected shapes: n_in %d out %d ws %zu (need >= %zu)\n", n_in, out_size, ws_size, (size_t)WS_END); grid = -1; return; }
        int dev = 0, cus = 0, per_cu = 0;
        if (hipGetDevice(&dev) != hipSuccess || hipDeviceGetAttribute(&cus, hipDeviceAttributeMultiprocessorCount, dev) != hipSuccess) { grid = -1; return; }
        if (hipFuncSetAttribute((const void*)trunk_fwd, hipFuncAttributeMaxDynamicSharedMemorySize, LDS_BYTES) != hipSuccess) { fprintf(stderr, "kernel_launch: hipFuncSetAttribute failed\n"); grid = -1; return; }
        if (hipOccupancyMaxActiveBlocksPerMultiprocessor(&per_cu, (const void*)trunk_fwd, NWAVES * 64, LDS_BYTES) != hipSuccess || per_cu < 1)
            fprintf(stderr, "kernel_launch: occupancy query reports %d workgroups per CU\n", per_cu);
        (void)hipGetLastError();
        grid = cus;
    }
    if (grid < 0) return;
    (void)hipMemsetAsync((char*)d_ws + WS_CTL, 0, CTL_ZERO_BYTES, stream);
    Args a{};
    for (int i = 0; i < 28; ++i) a.in[i] = (const float*)d_in[i];
    a.out = (float*)d_out; a.ws = (unsigned char*)d_ws;
#if ML_PER_PHASE
    for (int p = 0; p < N_PHASES; ++p) { a.ph_lo = p; a.ph_hi = p + 1; hipLaunchKernelGGL(trunk_fwd, dim3(grid), dim3(NWAVES * 64), LDS_BYTES, stream, a);
#ifdef SELFCHECK
        { const int l = p / PH_PER_LAYER, q = p % PH_PER_LAYER; if (l == SELFCHECK_LAYER && (q == 1 || q == 2 || q == 8)) hipLaunchKernelGGL(check_kernel, dim3(64), dim3(64), 0, stream, a, q, l); }
#endif
    }
#ifdef SELFCHECK
    hipLaunchKernelGGL(report_kernel, dim3(2048), dim3(256), 0, stream, a);
#endif
#else
    a.ph_lo = 0; a.ph_hi = N_PHASES;
    hipLaunchKernelGGL(trunk_fwd, dim3(grid), dim3(NWAVES * 64), LDS_BYTES, stream, a);
#endif
    const hipError_t le = hipPeekAtLastError();
    if (le != hipSuccess) fprintf(stderr, "kernel_launch: launch failed: %s\n", hipGetErrorName(le));
}
```

```cpp
#include <hip/hip_runtime.h>
#include <cstdio>
#include <cstdint>

#define SELFCHECK_LAYER 0
#ifndef ML_PER_PHASE
#define ML_PER_PHASE 0
#endif

#ifndef PHASE_MASK
#define PHASE_MASK 0xFFFFFFFFu
#endif
#define PH_EN(p) (((PHASE_MASK) >> (p)) & 1u)
#ifndef ATTN_NS
#define ATTN_NS att16
#endif
#define LAS __attribute__((address_space(3)))
#define GAS __attribute__((address_space(1)))
typedef unsigned short bf16_t;
typedef short bf16x8 __attribute__((ext_vector_type(8)));
typedef short s16x4 __attribute__((ext_vector_type(4)));
typedef float f32x4 __attribute__((ext_vector_type(4)));
typedef float f32x2 __attribute__((ext_vector_type(2)));
typedef float f32x16 __attribute__((ext_vector_type(16)));
typedef unsigned u32x4 __attribute__((ext_vector_type(4)));
typedef unsigned u32x2 __attribute__((ext_vector_type(2)));
typedef _Float16 h2_t __attribute__((ext_vector_type(2)));
typedef _Float16 f16x8 __attribute__((ext_vector_type(8)));

constexpr int D_MODEL = 2048, DEPTH = 2;
constexpr int NTOK = 65536;
constexpr int NTOK_P = 32768;
constexpr int S_P = 8192, S_S = 4096;
constexpr int NMEMROWS = 3072;
constexpr int IN_W = 4096, D_FF = 5632, UP_W = 11264;
constexpr float EPS = 1e-6f;
constexpr float QSCALE = 0.125f * 1.4426950408889634f;
constexpr int FFN_CHUNK = 32768, N_FFN_CHUNKS = 2;
constexpr int FFN_MT = FFN_CHUNK / 256, FFN_BT = 0;
constexpr int PH_PER_LAYER = 8 + 2 * N_FFN_CHUNKS;
constexpr int N_PHASES = DEPTH * PH_PER_LAYER;

constexpr size_t MiB = 1u << 20;
constexpr size_t WS_CTL = 0, CTL_ZERO_BYTES = 5 * MiB;
constexpr size_t WS_ROWSS = 1 * MiB;
constexpr size_t WS_COS = 5 * MiB;
constexpr size_t WS_QSS = 6 * MiB;
constexpr size_t WS_LPART = 14 * MiB;
constexpr size_t WS_MB = 18 * MiB;
constexpr size_t WS_KRAW = 30 * MiB;
constexpr size_t WS_KC = 54 * MiB;
constexpr size_t WS_VT = 66 * MiB;
constexpr size_t WS_CHK = 78 * MiB;
constexpr size_t WS_WIN = 79 * MiB, WS_WP = 95 * MiB, WS_WOUT = 96 * MiB, WS_WCQ = 104 * MiB, WS_WCKV = 112 * MiB, WS_WCO = 128 * MiB, WS_WUP = 136 * MiB, WS_WDOWN = 180 * MiB;
constexpr size_t WS_HB = 203 * MiB;
constexpr size_t WS_R = 459 * MiB;
constexpr size_t WS_CWT = 987 * MiB;
constexpr size_t WS_END = 988 * MiB;
typedef unsigned long long rss_t;
__device__ __forceinline__ rss_t ss_fix(float s) { return (rss_t)(s * 1048576.0f + 0.5f); }
__device__ __forceinline__ float ss_rstd(rss_t v) { return __builtin_amdgcn_rsqf((float)v * (1.0f / (1048576.0f * 2048.0f)) + 1e-6f); }
constexpr size_t R_Q = WS_R, R_K = WS_R + 128 * MiB, R_V = WS_R + 256 * MiB, R_U = WS_R + 384 * MiB;
constexpr size_t R_QC = WS_R, R_P = WS_R + 256 * MiB, R_VW = WS_R + 384 * MiB;
constexpr size_t R_G = WS_R;
constexpr int FFN_GSPLIT_ROW = 49152;
constexpr size_t FFN_EB_OUT_OFF = 192 * MiB;
constexpr size_t R_EB = WS_R + 384 * MiB;
constexpr size_t R_POUT = WS_R + 128 * MiB;
static_assert(R_G + (size_t)FFN_CHUNK * D_FF * 2 <= WS_END, "ws map");
constexpr int CW_BAR = 4096;

constexpr int RING_BYTES = 131072;
constexpr int LDSCTL_OFF = RING_BYTES, MISC_OFF = LDSCTL_OFF + 320, XCH_OFF = LDSCTL_OFF + 1024, GLX_OFF = XCH_OFF + 4096;
constexpr int LDS_BYTES = 151552;
constexpr int NWAVES = 8;

__device__ __forceinline__ unsigned cvt_pk_bf16(float lo, float hi) { unsigned r; asm volatile("v_cvt_pk_bf16_f32 %0, %1, %2" : "=v"(r) : "v"(lo), "v"(hi)); return r; }
__device__ __forceinline__ float bf2f(unsigned short b) { return __uint_as_float(((unsigned)b) << 16); }
__device__ __forceinline__ float bflo(unsigned w) { return __uint_as_float(w << 16); }
__device__ __forceinline__ float bfhi(unsigned w) { return __uint_as_float(w & 0xffff0000u); }
__device__ __forceinline__ int tok_pos(int row) { return row < NTOK_P ? (row & (S_P - 1)) : (row & (S_S - 1)); }
__device__ __forceinline__ int tok_seqlen(int row) { return row < NTOK_P ? S_P : S_S; }
__device__ __forceinline__ int tile_batch(int pm) { return pm < 128 ? (pm >> 5) : 4 + ((pm - 128) >> 4); }

namespace pg8 {
constexpr int BM = 256, BK = 64, HALF = 128, HTB = HALF * BK * 2, STAGE_BYTES = 8 * HTB, NXCD = 8, WGM = 4;
__host__ __device__ __forceinline__ int lds_byte(int r, int c) { const int st = (r >> 4) * 2 + (c >> 5), rr = r & 15, cc = c & 31, ob = rr * 64 + cc * 2; return st * 1024 + (ob ^ (((ob >> 9) & 1) << 5)); }
__host__ __device__ __forceinline__ void stage_rc(int b, int& R, int& C) { const int st = b / 1024, sb = b % 1024, swz = sb ^ (((sb >> 9) & 1) << 5); R = (st >> 1) * 16 + swz / 64; C = (st & 1) * 32 + (swz % 64) / 2; }
__host__ __device__ __forceinline__ int perm32(int rho) { const int n = rho >> 4, i = rho & 15; return 8 * (i >> 2) + 4 * n + (i & 3); }
struct Unit { int pm, pn; };
struct StaticOrder {
    int nM, nN, nwg, G, c, rv;
    __host__ __device__ void init(int nM_, int nN_, int G_, int c_, int rv_ = 0) { nM = nM_; nN = nN_; nwg = nM * nN; G = G_; c = c_; rv = rv_; }
    __host__ __device__ bool next(int i, Unit& u) const {
        const long L = (long)i * G + c; if (L >= nwg) return false;
        int wgid = (int)L; { const int q = nwg / NXCD, r = nwg % NXCD, xcd = wgid % NXCD; int off = wgid / NXCD; if (rv && r == 0) off = q - 1 - off; wgid = (xcd < r ? xcd * (q + 1) : r * (q + 1) + (xcd - r) * q) + off; }
        const int nig = WGM * nN, gid = wgid / nig, fm = gid * WGM, gsz = (nM - fm) < WGM ? (nM - fm) : WGM;
        u.pm = fm + ((wgid % nig) % gsz); u.pn = (wgid % nig) / gsz; return true;
    }
};
struct ProbBase { static constexpr bool GATHER = false; static constexpr bool F16 = false; int K, lda, ldb, tsplit; long long adelta; __device__ __forceinline__ unsigned rowoff(const Unit&, int) const { return 0u; } };

template <class Prob, class Epi, bool ALIGN_EPI, bool SP2>
__device__ __forceinline__ void gemm_phase(LAS unsigned char* lds, const Prob& P, const StaticOrder& S, const Epi& E) {
    static_assert(SP2, "only the two-super-phase loop is kept in this file");
    int tid_l = threadIdx.x; asm volatile("" : "+v"(tid_l));
    const int tid = tid_l, wid = __builtin_amdgcn_readfirstlane(tid >> 6), lane = tid & 63, wr = wid >> 2, wc = wid & 3, fr = lane & 15, fq = lane >> 4;
    const int K = P.K, nt = K / BK, lda = P.lda, ldb = P.ldb, tsplit = P.tsplit; const long long adelta = P.adelta;
    unsigned voffA[2], voffB[2];
#pragma unroll
    for (int i = 0; i < 2; ++i) { int R, C; stage_rc(tid * 16 + i * 8192, R, C); const int Rb = Epi::PERM ? ((R & ~31) + perm32(R & 31)) : R;
        voffA[i] = (unsigned)(R * lda + C) * 2u; voffB[i] = (unsigned)(Rb * ldb + C) * 2u; }
    const size_t kstep = (size_t)(BK * 2);
    const size_t hstepA = (size_t)HALF * lda * 2, hstepB = (size_t)HALF * ldb * 2;
    const unsigned ldsw = (unsigned)wid * 1024u;
    const int aoff = lds_byte(wr * 64 + fr, fq * 8), boff = lds_byte(wc * 32 + fr, fq * 8);
    unsigned vAc[2][2], vAn[2][2];
#define PG8_SA(b, h) (((b) * 2 + (h)) * HTB)
#define PG8_SB(b, h) ((4 + (b) * 2 + (h)) * HTB)
#define PG8_STAGE(bufoff, gbase, voff) do { _Pragma("unroll") for (int _i = 0; _i < 2; ++_i) \
        __builtin_amdgcn_global_load_lds((const unsigned*)((const char*)(gbase) + (voff)[_i]), (LAS unsigned*)(lds + (bufoff) + ldsw + _i * 8192), 16, 0, 0); } while (0)
#define PG8_STAGE_A(bufoff, kptr, h, NXT) do { if constexpr (Prob::GATHER) { _Pragma("unroll") for (int _i = 0; _i < 2; ++_i) \
        __builtin_amdgcn_global_load_lds((const unsigned*)((const char*)(kptr) + ((NXT) ? vAn[h][_i] : vAc[h][_i])), (LAS unsigned*)(lds + (bufoff) + ldsw + _i * 8192), 16, 0, 0); } \
        else { PG8_STAGE(bufoff, (kptr) + (h) * hstepA, voffA); } } while (0)
#define PG8_GATHER_OFFS(dst, unit) do { _Pragma("unroll") for (int _i = 0; _i < 2; ++_i) { int _R, _C; stage_rc(tid * 16 + _i * 8192, _R, _C); _Pragma("unroll") for (int _h = 0; _h < 2; ++_h) dst[_h][_i] = P.rowoff(unit, _R + 128 * _h) + (unsigned)_C * 2u; } } while (0)
#define PG8_LDA(dst, b, h) do { _Pragma("unroll") for (int m = 0; m < 4; ++m) _Pragma("unroll") for (int k = 0; k < 2; ++k) dst[m][k] = *(const LAS bf16x8*)(lds + PG8_SA(b, h) + aoff + m * 2048 + k * 1024); } while (0)
#define PG8_LDB(dst, b, h) do { _Pragma("unroll") for (int n = 0; n < 2; ++n) _Pragma("unroll") for (int k = 0; k < 2; ++k) dst[n][k] = *(const LAS bf16x8*)(lds + PG8_SB(b, h) + boff + n * 2048 + k * 1024); } while (0)
#define PG8_MMA(ai, bj, At, Bt) do { __builtin_amdgcn_s_setprio(1); _Pragma("unroll") for (int m = 0; m < 4; ++m) _Pragma("unroll") for (int n = 0; n < 2; ++n) _Pragma("unroll") for (int k = 0; k < 2; ++k) \
        { if constexpr (Prob::F16) acc[ai][bj][m][n] = __builtin_amdgcn_mfma_f32_16x16x32_f16(__builtin_bit_cast(f16x8, Bt[n][k]), __builtin_bit_cast(f16x8, At[m][k]), acc[ai][bj][m][n], 0, 0, 0); \
          else acc[ai][bj][m][n] = __builtin_amdgcn_mfma_f32_16x16x32_bf16(Bt[n][k], At[m][k], acc[ai][bj][m][n], 0, 0, 0); } __builtin_amdgcn_s_setprio(0); } while (0)
#define PG8_WAIT_V(n) asm volatile("s_waitcnt vmcnt(" #n ")" ::: "memory")
#define PG8_WAIT_L(n) asm volatile("s_waitcnt lgkmcnt(" #n ")" ::: "memory")
#define PG8_BAR __builtin_amdgcn_s_barrier()
#define PG8_SCHED __builtin_amdgcn_sched_barrier(0)
#define PG8_AK(base, t) ((base) + (size_t)(t) * kstep + (((t) >= tsplit) ? adelta : 0ll))
    Unit cur, nxt; int ui = 0;
    if (!S.next(0, cur)) return;
    f32x4 acc[2][2][4][2];
#pragma unroll
    for (int a = 0; a < 2; ++a)
#pragma unroll
        for (int b = 0; b < 2; ++b)
#pragma unroll
            for (int m = 0; m < 4; ++m)
#pragma unroll
                for (int n = 0; n < 2; ++n) acc[a][b][m][n] = (f32x4){0.f, 0.f, 0.f, 0.f};
    bf16x8 At[4][2], B0[2][2], B1[2][2];
    const char* cA = P.aptr(cur); const char* cB = P.bptr(cur);
    if constexpr (Prob::GATHER) { PG8_GATHER_OFFS(vAc, cur); }
    PG8_STAGE(PG8_SB(0, 0), cB, voffB); PG8_STAGE(PG8_SB(0, 1), cB + hstepB, voffB); PG8_STAGE_A(PG8_SA(0, 0), cA, 0, false); PG8_STAGE_A(PG8_SA(0, 1), cA, 1, false);
    if (wr == 1) PG8_BAR;
    PG8_WAIT_V(2); PG8_BAR;
    PG8_STAGE(PG8_SB(1, 0), cB + kstep, voffB); PG8_STAGE_A(PG8_SA(1, 0), PG8_AK(cA, 1), 0, false); PG8_STAGE(PG8_SB(1, 1), cB + hstepB + kstep, voffB);
    PG8_WAIT_V(6); PG8_BAR;
    for (;;) {
        const bool has_next = S.next(ui + 1, nxt);
        const char* nA = has_next ? P.aptr(nxt) : cA; const char* nB = has_next ? P.bptr(nxt) : cB;
        if constexpr (Prob::GATHER) { if (has_next) { PG8_GATHER_OFFS(vAn, nxt); } else {
#pragma unroll
            for (int _h = 0; _h < 2; ++_h)
#pragma unroll
                for (int _i = 0; _i < 2; ++_i) vAn[_h][_i] = vAc[_h][_i]; } }
        for (int t = 0; t < nt; t += 2) {
            const bool last = (t == nt - 2);
            const char* a1 = PG8_AK(cA, t + 1);
            const char* a2 = last ? nA : PG8_AK(cA, t + 2); const char* b2 = last ? nB : cB + (size_t)(t + 2) * kstep;
            const char* a3 = last ? PG8_AK(nA, 1) : PG8_AK(cA, t + 3); const char* b3 = b2 + kstep;
            PG8_LDB(B0, 0, 0); PG8_LDB(B1, 0, 1); PG8_SCHED; PG8_LDA(At, 0, 0); PG8_STAGE_A(PG8_SA(1, 1), a1, 1, false);
            PG8_WAIT_V(8); PG8_WAIT_L(0); PG8_BAR; PG8_MMA(0, 0, At, B0); PG8_MMA(0, 1, At, B1); PG8_BAR; PG8_SCHED;
            PG8_LDA(At, 0, 1); PG8_STAGE(PG8_SB(0, 0), b2, voffB); PG8_STAGE(PG8_SB(0, 1), b2 + hstepB, voffB); PG8_STAGE_A(PG8_SA(0, 0), a2, 0, last);
            PG8_WAIT_V(8); PG8_WAIT_L(0); PG8_BAR; PG8_MMA(1, 0, At, B0); PG8_MMA(1, 1, At, B1); PG8_BAR; PG8_SCHED;
            PG8_LDB(B0, 1, 0); PG8_LDB(B1, 1, 1); PG8_SCHED; PG8_LDA(At, 1, 0); PG8_STAGE_A(PG8_SA(0, 1), a2, 1, last);
            PG8_WAIT_V(8); PG8_WAIT_L(0); PG8_BAR; PG8_MMA(0, 0, At, B0); PG8_MMA(0, 1, At, B1); PG8_BAR; PG8_SCHED;
            PG8_LDA(At, 1, 1); PG8_STAGE(PG8_SB(1, 0), b3, voffB); PG8_STAGE(PG8_SB(1, 1), b3 + hstepB, voffB); PG8_STAGE_A(PG8_SA(1, 0), a3, 0, last);
            PG8_WAIT_V(8); PG8_WAIT_L(0); PG8_BAR; PG8_MMA(1, 0, At, B0); PG8_MMA(1, 1, At, B1); PG8_BAR; PG8_SCHED;
        }
        if constexpr (ALIGN_EPI) { if (wr == 0) PG8_BAR; }
        { int te = threadIdx.x; asm volatile("" : "+v"(te));
          const int we = __builtin_amdgcn_readfirstlane(te >> 6), le = te & 63; E(acc, cur, we >> 2, we & 3, le & 15, le >> 4); }
        if (!has_next) break;
#pragma unroll
        for (int a = 0; a < 2; ++a)
#pragma unroll
            for (int b = 0; b < 2; ++b)
#pragma unroll
                for (int m = 0; m < 4; ++m)
#pragma unroll
                    for (int n = 0; n < 2; ++n) acc[a][b][m][n] = (f32x4){0.f, 0.f, 0.f, 0.f};
        cur = nxt; cA = nA; cB = nB; ++ui;
        if constexpr (Prob::GATHER) {
#pragma unroll
            for (int _h = 0; _h < 2; ++_h)
#pragma unroll
                for (int _i = 0; _i < 2; ++_i) vAc[_h][_i] = vAn[_h][_i]; }
        if constexpr (ALIGN_EPI) { if (wr == 1) PG8_BAR; }
    }
    PG8_WAIT_V(0);
    if constexpr (!ALIGN_EPI) { if (wr == 0) PG8_BAR; }
    PG8_BAR;
#undef PG8_SA
#undef PG8_SB
#undef PG8_STAGE
#undef PG8_STAGE_A
#undef PG8_GATHER_OFFS
#undef PG8_LDA
#undef PG8_LDB
#undef PG8_MMA
#undef PG8_WAIT_V
#undef PG8_WAIT_L
#undef PG8_BAR
#undef PG8_SCHED
#undef PG8_AK
}

struct ProbSimple : ProbBase {
    const char* A; const char* B;
    __device__ __forceinline__ const char* aptr(const Unit& u) const { return A + (size_t)u.pm * 256 * lda * 2; }
    __device__ __forceinline__ const char* bptr(const Unit& u) const { return B + (size_t)u.pn * 256 * ldb * 2; }
};
struct ProbSimpleF16 : ProbSimple { static constexpr bool F16 = true; };
struct ProbDown : ProbBase {
    static constexpr bool F16 = true;
    const char* A; const char* A2; const char* B; int split;
    __device__ __forceinline__ const char* aptr(const Unit& u) const { return (u.pm < split ? A : A2) + (size_t)u.pm * 256 * lda * 2; }
    __device__ __forceinline__ const char* bptr(const Unit& u) const { return B + (size_t)u.pn * 256 * ldb * 2; }
};
struct ProbPool : ProbBase {
    const char* A; const char* B;
    __device__ __forceinline__ const char* aptr(const Unit& u) const { return A + ((size_t)u.pm * 256 * 1024 + (size_t)u.pn * 256) * 2; }
    __device__ __forceinline__ const char* bptr(const Unit& u) const { return B + (size_t)u.pn * 65536 * 2; }
};
struct ProbScores : ProbBase {
    const char* A; const char* B;
    __device__ __forceinline__ const char* aptr(const Unit& u) const { return A + ((size_t)u.pm * 256 * 2048 + (size_t)u.pn * 512) * 2; }
    __device__ __forceinline__ const char* bptr(const Unit& u) const { return B + ((size_t)tile_batch(u.pm) * 256 * 2048 + (size_t)u.pn * 512) * 2; }
};
struct ProbVW : ProbBase {
    const char* A; const char* B;
    __device__ __forceinline__ const char* aptr(const Unit& u) const { return A + ((size_t)u.pm * 256 * 2048 + (size_t)(u.pn & 3) * 512) * 2; }
    __device__ __forceinline__ const char* bptr(const Unit& u) const { return B + ((size_t)(u.pn >> 2) * 256 * 2048 + (size_t)(u.pn & 3) * 512) * 2; }
};
struct ProbFin : ProbBase {
    const char* A; const char* B;
    __device__ __forceinline__ const char* aptr(const Unit& u) const { return A + (size_t)u.pm * 256 * 1024 * 2; }
    __device__ __forceinline__ const char* bptr(const Unit& u) const { return B + ((size_t)tile_batch(u.pm) * 2048 + (size_t)u.pn * 256) * 1024 * 2; }
};
struct ProbPV : ProbBase {
    const char* A; const char* B;
    __device__ __forceinline__ const char* aptr(const Unit& u) const { return A + ((size_t)u.pm * 256 * 1024 + (size_t)(u.pn >> 1) * 256) * 2; }
    __device__ __forceinline__ const char* bptr(const Unit& u) const { return B + ((size_t)tile_batch(u.pm) * 2048 + (size_t)u.pn * 256) * 256 * 2; }
};

__device__ __forceinline__ u32x4 pack8(const f32x4& v0, const f32x4& v1) { u32x4 w; w.x = cvt_pk_bf16(v0[0], v0[1]); w.y = cvt_pk_bf16(v0[2], v0[3]); w.z = cvt_pk_bf16(v1[0], v1[1]); w.w = cvt_pk_bf16(v1[2], v1[3]); return w; }
__device__ __forceinline__ float sumsq4(const f32x4& x) { return (x[0] * x[0] + x[1] * x[1]) + (x[2] * x[2] + x[3] * x[3]); }
__device__ __forceinline__ float sum4(const f32x4& x) { return (x[0] + x[1]) + (x[2] + x[3]); }
__device__ __forceinline__ float red_fq(float s) { s += __shfl_xor(s, 16); s += __shfl_xor(s, 32); return s; }

struct EpiIn {
    static constexpr bool PERM = true;
    bf16_t* base; size_t spl; const unsigned* csT; const float* gq; const float* gk; const rss_t* rowss;
    __device__ __forceinline__ void operator()(const f32x4 (&acc)[2][2][4][2], const Unit& u, int wr, int wc, int fr, int fq) const {
        typedef _Float16 h2 __attribute__((ext_vector_type(2)));
        const int t = u.pn >> 2; bf16_t* O = base + (size_t)t * spl; const int colt = (u.pn & 3) * 256; const int row0 = u.pm * BM + wr * 64 + fr;
        if (t >= 2) {
            const int col0 = colt + wc * 32 + 8 * fq;
#pragma unroll
            for (int ai = 0; ai < 2; ++ai) { rss_t rx[4];
#pragma unroll
                for (int m = 0; m < 4; ++m) rx[m] = rowss[row0 + ai * HALF + m * 16];
#pragma unroll
                for (int m = 0; m < 4; ++m) { const float rxm = ss_rstd(rx[m]); bf16_t* rowp = O + (size_t)(row0 + ai * HALF + m * 16) * 1024 + col0;
#pragma unroll
                    for (int bj = 0; bj < 2; ++bj) *(u32x4*)(rowp + bj * HALF) = pack8(acc[ai][bj][m][0] * rxm, acc[ai][bj][m][1] * rxm); }
                asm volatile("" ::: "memory"); }
        } else {
            const float* g = t ? gk : gq; f32x4 g1[2], g2[2];
#pragma unroll
            for (int n = 0; n < 2; ++n) { g1[n] = *(const f32x4*)(g + 8 * fq + 4 * n); g2[n] = *(const f32x4*)(g + 32 + 8 * fq + 4 * n); }
            const int col0 = colt + 64 * wc + 8 * fq;
#pragma unroll
            for (int ah = 0; ah < 4; ++ah) { const int ai = ah >> 1, mb = (ah & 1) * 2;
                u32x4 cs[2][2]; rss_t rx[2];
#pragma unroll
                for (int mm = 0; mm < 2; ++mm) { const int m = mb + mm; const int pos = tok_pos(row0 + ai * HALF + m * 16); rx[mm] = rowss[row0 + ai * HALF + m * 16];
#pragma unroll
                    for (int n = 0; n < 2; ++n) cs[mm][n] = *(const u32x4*)(csT + pos * 32 + 8 * fq + 4 * n); }
#pragma unroll
                for (int mm = 0; mm < 2; ++mm) { const int m = mb + mm; const int row = row0 + ai * HALF + m * 16;
                    float ss = (sumsq4(acc[ai][0][m][0]) + sumsq4(acc[ai][0][m][1])) + (sumsq4(acc[ai][1][m][0]) + sumsq4(acc[ai][1][m][1]));
                    ss = red_fq(ss);
                    const float rxm = ss_rstd(rx[mm]);
                    const float r = __builtin_amdgcn_rsqf(ss * rxm * rxm * (1.0f / 64.0f) + EPS) * rxm * (t ? 1.0f : QSCALE);
                    f32x4 o1[2], o2[2];
#pragma unroll
                    for (int n = 0; n < 2; ++n) { f32x4 c, s;
#pragma unroll
                        for (int j = 0; j < 4; ++j) { const unsigned w = cs[mm][n][j]; const h2 v = __builtin_bit_cast(h2, w); c[j] = (float)v.x; s[j] = (float)v.y; }
                        const f32x4 x1 = acc[ai][0][m][n] * r * g1[n], x2 = acc[ai][1][m][n] * r * g2[n];
                        o1[n] = x1 * c - x2 * s; o2[n] = x2 * c + x1 * s; }
                    bf16_t* rowp = O + (size_t)row * 1024 + col0;
                    *(u32x4*)(rowp) = pack8(o1[0], o1[1]); *(u32x4*)(rowp + 32) = pack8(o2[0], o2[1]); }
                asm volatile("" ::: "memory"); }
        }
    }
};
template <int MODE> struct EpiBf {
    static constexpr bool PERM = true;
    bf16_t* O; int ldc; float* aux; float* aux2; LAS float* xl;
    __device__ __forceinline__ void operator()(f32x4 (&acc)[2][2][4][2], const Unit& u, int wr, int wc, int fr, int fq) const {
        const int row0 = u.pm * BM + wr * 64 + fr; const int col0 = u.pn * BM + wc * 32 + 8 * fq;
        float rs[2][4];
        if constexpr (MODE == 2) {
            f32x4 qa[2][4][2];
#pragma unroll
            for (int ai = 0; ai < 2; ++ai)
#pragma unroll
                for (int m = 0; m < 4; ++m) { const float* p = aux + (size_t)(row0 + ai * HALF + m * 16) * 32 + u.pn * 8; qa[ai][m][0] = *(const f32x4*)p; qa[ai][m][1] = *(const f32x4*)(p + 4); }
#pragma unroll
            for (int ai = 0; ai < 2; ++ai)
#pragma unroll
                for (int m = 0; m < 4; ++m) { const float sc = __builtin_amdgcn_rsqf((sum4(qa[ai][m][0]) + sum4(qa[ai][m][1])) * (1.0f / 512.0f) + EPS) * (0.044194173824159216f * 1.4426950408889634f); float ps = 0.f;
#pragma unroll
                    for (int bj = 0; bj < 2; ++bj)
#pragma unroll
                        for (int n = 0; n < 2; ++n) { f32x4 p;
#pragma unroll
                            for (int j = 0; j < 4; ++j) p[j] = __builtin_amdgcn_exp2f(acc[ai][bj][m][n][j] * sc);
                            acc[ai][bj][m][n] = p; ps += sum4(p); }
                    ps = red_fq(ps);
                    if (fq == 0) xl[(ai * HALF + wr * 64 + m * 16 + fr) * 4 + wc] = ps; }
            asm volatile("s_waitcnt lgkmcnt(0)" ::: "memory"); __builtin_amdgcn_s_barrier(); asm volatile("" ::: "memory");
#pragma unroll
            for (int ai = 0; ai < 2; ++ai)
#pragma unroll
                for (int m = 0; m < 4; ++m) { const f32x4 lv = *(const LAS f32x4*)(xl + (ai * HALF + wr * 64 + m * 16 + fr) * 4); rs[ai][m] = __builtin_amdgcn_rcpf(sum4(lv)); }
        }
        if constexpr (MODE == 1 || MODE == 4) { rss_t rv[2][4];
#pragma unroll
            for (int ai = 0; ai < 2; ++ai)
#pragma unroll
                for (int m = 0; m < 4; ++m) rv[ai][m] = ((const rss_t*)aux2)[row0 + ai * HALF + m * 16];
#pragma unroll
            for (int ai = 0; ai < 2; ++ai)
#pragma unroll
                for (int m = 0; m < 4; ++m) rs[ai][m] = ss_rstd(rv[ai][m]);
        }
        if constexpr (MODE == 3) {
            f32x4 la[2][4];
#pragma unroll
            for (int ai = 0; ai < 2; ++ai)
#pragma unroll
                for (int m = 0; m < 4; ++m) la[ai][m] = *(const f32x4*)(aux2 + (size_t)(row0 + ai * HALF + m * 16) * 16 + (u.pn >> 1) * 4);
#pragma unroll
            for (int ai = 0; ai < 2; ++ai)
#pragma unroll
                for (int m = 0; m < 4; ++m) rs[ai][m] = __builtin_amdgcn_rcpf(sum4(la[ai][m]));
        }
        bf16_t* Ob = O; int colb = col0;
        if constexpr (MODE == 5) { Ob = O + (size_t)(u.pn >> 2) * 2048 * 1024; colb = (u.pn & 3) * 256 + wc * 32 + 8 * fq; }
#pragma unroll
        for (int ai = 0; ai < 2; ++ai)
#pragma unroll
            for (int m = 0; m < 4; ++m) { const int row = row0 + ai * HALF + m * 16; bf16_t* rowp = Ob + (size_t)row * ldc + colb;
                if constexpr (MODE == 0 || MODE == 5) {
#pragma unroll
                    for (int bj = 0; bj < 2; ++bj) *(u32x4*)(rowp + bj * HALF) = pack8(acc[ai][bj][m][0], acc[ai][bj][m][1]);
                } else if constexpr (MODE == 1) {
                    float ss = (sumsq4(acc[ai][0][m][0]) + sumsq4(acc[ai][0][m][1])) + (sumsq4(acc[ai][1][m][0]) + sumsq4(acc[ai][1][m][1]));
                    ss = red_fq(ss); const float rxx = rs[ai][m];
                    if (fq == 0) aux[(size_t)row * 32 + u.pn * 4 + wc] = ss * rxx * rxx;
#pragma unroll
                    for (int bj = 0; bj < 2; ++bj) *(u32x4*)(rowp + bj * HALF) = pack8(acc[ai][bj][m][0] * rxx, acc[ai][bj][m][1] * rxx);
                } else {
                    const float rxx = rs[ai][m];
#pragma unroll
                    for (int bj = 0; bj < 2; ++bj) *(u32x4*)(rowp + bj * HALF) = pack8(acc[ai][bj][m][0] * rxx, acc[ai][bj][m][1] * rxx);
                }
            }
    }
};
struct EpiRes {
    static constexpr bool PERM = true;
    bf16_t* XB; rss_t* rowss; float* OUT;
    __device__ __forceinline__ void load_half(u32x4 (&t)[4][2], int row0, int col0, int ai) const {
#pragma unroll
        for (int m = 0; m < 4; ++m) { const bf16_t* rowb = XB + (size_t)(row0 + ai * HALF + m * 16) * D_MODEL + col0;
#pragma unroll
            for (int bj = 0; bj < 2; ++bj) t[m][bj] = *(const u32x4*)(rowb + bj * HALF); }
    }
    __device__ __forceinline__ void add_half(f32x4 (&acc)[2][2][4][2], const u32x4 (&t)[4][2], int ai) const {
#pragma unroll
        for (int m = 0; m < 4; ++m)
#pragma unroll
            for (int bj = 0; bj < 2; ++bj) { const u32x4 w = t[m][bj];
#define ADDS_(d, x) asm("v_add_f32 %0, %1, %0" : "+v"(d) : "v"(x))
                ADDS_(acc[ai][bj][m][0][0], bflo(w.x)); ADDS_(acc[ai][bj][m][0][1], bfhi(w.x)); ADDS_(acc[ai][bj][m][0][2], bflo(w.y)); ADDS_(acc[ai][bj][m][0][3], bfhi(w.y));
                ADDS_(acc[ai][bj][m][1][0], bflo(w.z)); ADDS_(acc[ai][bj][m][1][1], bfhi(w.z)); ADDS_(acc[ai][bj][m][1][2], bflo(w.w)); ADDS_(acc[ai][bj][m][1][3], bfhi(w.w));
#undef ADDS_
            }
    }
    __device__ __forceinline__ void store_half(const f32x4 (&acc)[2][2][4][2], int row0, int col0, int ai, int fq) const {
#pragma unroll
        for (int m = 0; m < 4; ++m) { const int row = row0 + ai * HALF + m * 16; bf16_t* rowb = XB + (size_t)row * D_MODEL + col0; float ss = 0.f;
#pragma unroll
            for (int bj = 0; bj < 2; ++bj) { const f32x4 v0 = acc[ai][bj][m][0], v1 = acc[ai][bj][m][1];
                if (OUT) { float* rowp = OUT + (size_t)row * D_MODEL + col0 + bj * HALF; *(f32x4*)rowp = v0; *(f32x4*)(rowp + 4) = v1; }
                else { *(u32x4*)(rowb + bj * HALF) = pack8(v0, v1); ss += sumsq4(v0) + sumsq4(v1); } }
            if (rowss) { ss = red_fq(ss); if (fq == 0) atomicAdd(rowss + row, ss_fix(ss)); } }
    }
    __device__ __forceinline__ void operator()(f32x4 (&acc)[2][2][4][2], const Unit& u, int wr, int wc, int fr, int fq) const {
        const int row0 = u.pm * BM + wr * 64 + fr, col0 = u.pn * BM + wc * 32 + 8 * fq;
        u32x4 t[4][2];
        load_half(t, row0, col0, 0);
        add_half(acc, t, 0);
        asm volatile("" : "+v"(acc[0][0][0][0]), "+v"(acc[0][1][3][1]));
        load_half(t, row0, col0, 1);
        asm volatile("" ::: "memory");
        store_half(acc, row0, col0, 0, fq);
        add_half(acc, t, 1);
        store_half(acc, row0, col0, 1, fq);
    }
};
__device__ __forceinline__ int ffn_tile_row(int pm, int R, int chunk, bool& valid) {
    R = (R & ~63) | ((R & 15) << 2) | ((R >> 4) & 3);
    valid = true; (void)chunk; return pm * 256 + R;
}
struct ProbUp : ProbBase {
    static constexpr bool GATHER = true;
    const char* A; const char* B; int chunk;
    __device__ __forceinline__ const char* aptr(const Unit&) const { return A; }
    __device__ __forceinline__ const char* bptr(const Unit& u) const { return B + (size_t)u.pn * 256 * ldb * 2; }
    __device__ __forceinline__ unsigned rowoff(const Unit& u, int R) const { bool v; return (unsigned)ffn_tile_row(u.pm, R, chunk, v) * (unsigned)(lda * 2); }
};
__device__ __forceinline__ float dpp_ror1(float v) { return __builtin_bit_cast(float, __builtin_amdgcn_update_dpp(0, __builtin_bit_cast(int, v), 0x121, 0xf, 0xf, false)); }
__device__ __forceinline__ float dpp_ror15(float v) { return __builtin_bit_cast(float, __builtin_amdgcn_update_dpp(0, __builtin_bit_cast(int, v), 0x12F, 0xf, 0xf, false)); }
__device__ __forceinline__ h2_t u2h(unsigned u) { return __builtin_bit_cast(h2_t, u); }
__device__ __forceinline__ unsigned h2u(h2_t h) { return __builtin_bit_cast(unsigned, h); }
__device__ __forceinline__ unsigned dppu_ror1(unsigned v) { return (unsigned)__builtin_amdgcn_update_dpp(0, (int)v, 0x121, 0xf, 0xf, false); }
__device__ __forceinline__ unsigned dppu_ror15(unsigned v) { return (unsigned)__builtin_amdgcn_update_dpp(0, (int)v, 0x12F, 0xf, 0xf, false); }
#define H2X4_TRANS(OP, a, b, c, d) asm(OP " %0, %0 dst_sel:WORD_0 dst_unused:UNUSED_PRESERVE src0_sel:WORD_0\n\t" OP " %1, %1 dst_sel:WORD_0 dst_unused:UNUSED_PRESERVE src0_sel:WORD_0\n\t" \
    OP " %2, %2 dst_sel:WORD_0 dst_unused:UNUSED_PRESERVE src0_sel:WORD_0\n\t" OP " %3, %3 dst_sel:WORD_0 dst_unused:UNUSED_PRESERVE src0_sel:WORD_0\n\t"                                  \
    OP " %0, %0 dst_sel:WORD_1 dst_unused:UNUSED_PRESERVE src0_sel:WORD_1\n\t" OP " %1, %1 dst_sel:WORD_1 dst_unused:UNUSED_PRESERVE src0_sel:WORD_1\n\t"                                  \
    OP " %2, %2 dst_sel:WORD_1 dst_unused:UNUSED_PRESERVE src0_sel:WORD_1\n\t" OP " %3, %3 dst_sel:WORD_1 dst_unused:UNUSED_PRESERVE src0_sel:WORD_1\n\ts_nop 0" : "+v"(a), "+v"(b), "+v"(c), "+v"(d))
struct EpiGlu {
    static constexpr bool PERM = true;
    bf16_t* G; const rss_t* rowss; const u32x4* cwt; int chunk; LAS float* xl; bf16_t* EB; bf16_t* G2; int gsplit;
    __device__ __forceinline__ void operator()(f32x4 (&acc)[2][2][4][2], const Unit& u, int wr, int wc, int fr, int fq) const {
        const int ch0 = u.pn * 128 + wc * 32 + 8 * fq;
        const int tidw = (wr * 4 + wc) * 64 + fq * 16 + fr; LAS unsigned char* wl = (LAS unsigned char*)xl + 12288; LAS unsigned* xu = (LAS unsigned*)xl;
        u32x4 wrec = (u32x4){0u, 0u, 0u, 0u}; if (tidw < 128) wrec = cwt[u.pn * 128 + tidw];
        int rowi[2][4]; unsigned stmask = 0u; unsigned hh[2][2][4][4];
        { rss_t rv[2][4];
#pragma unroll
          for (int ai = 0; ai < 2; ++ai)
#pragma unroll
            for (int m = 0; m < 4; ++m) { const int RL = ai * HALF + wr * 64 + 4 * fr + m; bool valid; const int row = ffn_tile_row(u.pm, ai * HALF + wr * 64 + m * 16 + fr, chunk, valid); rowi[ai][m] = row; rv[ai][m] = rowss[row];
                const int gt = chunk * FFN_CHUNK + row, pos = tok_pos(gt), S = tok_seqlen(gt);
                const bool st = !((RL == 0 && pos != 0) || (RL == 255 && pos != S - 1)); (void)valid;
                stmask |= st ? (1u << (ai * 4 + m)) : 0u; }
#pragma unroll
          for (int ai = 0; ai < 2; ++ai)
#pragma unroll
            for (int m = 0; m < 4; ++m) { const float rx = ss_rstd(rv[ai][m]); const h2_t r2 = {(_Float16)rx, (_Float16)rx};
#pragma unroll
                for (int bj = 0; bj < 2; ++bj)
#pragma unroll
                    for (int n = 0; n < 2; ++n)
#pragma unroll
                        for (int jp = 0; jp < 2; ++jp) hh[ai][bj][m][2 * n + jp] = h2u(__builtin_bit_cast(h2_t, __builtin_amdgcn_cvt_pkrtz(acc[ai][bj][m][n][2 * jp], acc[ai][bj][m][n][2 * jp + 1])) * r2); } }
        if (wr == 0 && fr == 0) {
#pragma unroll
            for (int m = 0; m < 2; ++m)
#pragma unroll
                for (int bj = 0; bj < 2; ++bj) *(u32x4*)(EB + (size_t)(u.pm * 4 + m) * UP_W + bj * D_FF + ch0) = (u32x4){hh[0][bj][m][0], hh[0][bj][m][1], hh[0][bj][m][2], hh[0][bj][m][3]}; }
        if (wr == 1 && fr == 15) {
#pragma unroll
            for (int m = 2; m < 4; ++m)
#pragma unroll
                for (int bj = 0; bj < 2; ++bj) *(u32x4*)(EB + (size_t)(u.pm * 4 + m) * UP_W + bj * D_FF + ch0) = (u32x4){hh[1][bj][m][0], hh[1][bj][m][1], hh[1][bj][m][2], hh[1][bj][m][3]}; }
#pragma unroll
        for (int ai = 0; ai < 2; ++ai) { const int s1 = 2 * ai + wr + 1;
            if (fr == 0) {
#pragma unroll
                for (int bj = 0; bj < 2; ++bj) *(LAS u32x4*)(xu + ((s1 * 2 + 0) * 4 + wc) * 32 + bj * 16 + 4 * fq) = (u32x4){hh[ai][bj][0][0], hh[ai][bj][0][1], hh[ai][bj][0][2], hh[ai][bj][0][3]}; }
            if (fr == 15) {
#pragma unroll
                for (int bj = 0; bj < 2; ++bj) *(LAS u32x4*)(xu + ((s1 * 2 + 1) * 4 + wc) * 32 + bj * 16 + 4 * fq) = (u32x4){hh[ai][bj][3][0], hh[ai][bj][3][1], hh[ai][bj][3][2], hh[ai][bj][3][3]}; } }
        if (tidw < 128) *(LAS u32x4*)(wl + tidw * 16) = wrec;
        asm volatile("s_waitcnt lgkmcnt(0)" ::: "memory"); __builtin_amdgcn_s_barrier(); asm volatile("" ::: "memory");
        const h2_t c1 = {(_Float16)-0.10294324f, (_Float16)-0.10294324f}, c0 = {(_Float16)-2.3022082f, (_Float16)-2.3022082f}, one = {(_Float16)1.0f, (_Float16)1.0f};
        unsigned wq[2][2][4][2];
#pragma unroll
        for (int n = 0; n < 2; ++n) { unsigned (&wp)[2][4][2] = wq[n];
#pragma unroll
            for (int jp = 0; jp < 2; ++jp) { const int q = 2 * n + jp;
                const u32x4 wg = *(const LAS u32x4*)(wl + (wc * 16 + 4 * fq + q) * 32), wv = *(const LAS u32x4*)(wl + (wc * 16 + 4 * fq + q) * 32 + 16);
#pragma unroll
                for (int ai = 0; ai < 2; ++ai) { const int s1 = 2 * ai + wr + 1; h2_t cg[4], cv[4];
                    const LAS unsigned* xp = xu + (((s1 - 1) * 2 + 1) * 4 + wc) * 32 + 4 * fq + q; const LAS unsigned* xn = xu + (((s1 + 1) * 2 + 0) * 4 + wc) * 32 + 4 * fq + q;
                    { const unsigned pe = xp[0], ne = xn[0]; const unsigned r3 = dppu_ror1(hh[ai][0][3][q]), l0 = dppu_ror15(hh[ai][0][0][q]);
                      const h2_t w0 = u2h(wg.x), w1 = u2h(wg.y), w2 = u2h(wg.z), wb = u2h(wg.w);
#pragma unroll
                      for (int m = 0; m < 4; ++m) { const unsigned pv = m ? hh[ai][0][m ? m - 1 : 0][q] : (fr == 0 ? pe : r3), nx = m < 3 ? hh[ai][0][m < 3 ? m + 1 : 3][q] : (fr == 15 ? ne : l0);
                          cg[m] = wb + w0 * u2h(pv) + w1 * u2h(hh[ai][0][m][q]) + w2 * u2h(nx); } }
                    { const unsigned pe = xp[16], ne = xn[16]; const unsigned r3 = dppu_ror1(hh[ai][1][3][q]), l0 = dppu_ror15(hh[ai][1][0][q]);
                      const h2_t w0 = u2h(wv.x), w1 = u2h(wv.y), w2 = u2h(wv.z), wb = u2h(wv.w);
#pragma unroll
                      for (int m = 0; m < 4; ++m) { const unsigned pv = m ? hh[ai][1][m ? m - 1 : 0][q] : (fr == 0 ? pe : r3), nx = m < 3 ? hh[ai][1][m < 3 ? m + 1 : 3][q] : (fr == 15 ? ne : l0);
                          cv[m] = wb + w0 * u2h(pv) + w1 * u2h(hh[ai][1][m][q]) + w2 * u2h(nx); } }
                    unsigned e0 = h2u(cg[0] * (cg[0] * cg[0] * c1 + c0)), e1 = h2u(cg[1] * (cg[1] * cg[1] * c1 + c0)), e2 = h2u(cg[2] * (cg[2] * cg[2] * c1 + c0)), e3 = h2u(cg[3] * (cg[3] * cg[3] * c1 + c0));
                    H2X4_TRANS("v_exp_f16_sdwa", e0, e1, e2, e3);
                    e0 = h2u(u2h(e0) + one); e1 = h2u(u2h(e1) + one); e2 = h2u(u2h(e2) + one); e3 = h2u(u2h(e3) + one);
                    H2X4_TRANS("v_rcp_f16_sdwa", e0, e1, e2, e3);
                    wp[ai][0][jp] = h2u(cg[0] * u2h(e0) * cv[0]); wp[ai][1][jp] = h2u(cg[1] * u2h(e1) * cv[1]); wp[ai][2][jp] = h2u(cg[2] * u2h(e2) * cv[2]); wp[ai][3][jp] = h2u(cg[3] * u2h(e3) * cv[3]);
                    asm volatile("" : "+v"(wp[ai][0][jp]), "+v"(wp[ai][1][jp]), "+v"(wp[ai][2][jp]), "+v"(wp[ai][3][jp])); } }
            asm volatile("" ::: "memory"); }
#pragma unroll
        for (int ai = 0; ai < 2; ++ai)
#pragma unroll
            for (int m = 0; m < 4; ++m) { const u32x4 q = {wq[0][ai][m][0], wq[0][ai][m][1], wq[1][ai][m][0], wq[1][ai][m][1]}; if (stmask & (1u << (ai * 4 + m))) *(u32x4*)((u.pm < gsplit ? G : G2) + (size_t)rowi[ai][m] * D_FF + ch0) = q; }
    }
};
__device__ __forceinline__ void ffn_fix_item(const bf16_t* EB, const u32x4* cwt, bf16_t* G, bf16_t* G2, int gsplit_row, int t, int cb, int lane) {
    const int ti = (t >> 8) - 1, ch = cb * 512 + lane * 8;
    const bf16_t* ea = EB + (size_t)(ti * 4 + 2) * UP_W + ch; const bf16_t* ec = EB + (size_t)((ti + 1) * 4) * UP_W + ch;
    u32x4 ug[4], uv[4], w[8];
    ug[0] = *(const u32x4*)ea; uv[0] = *(const u32x4*)(ea + D_FF); ug[1] = *(const u32x4*)(ea + UP_W); uv[1] = *(const u32x4*)(ea + UP_W + D_FF);
    ug[2] = *(const u32x4*)ec; uv[2] = *(const u32x4*)(ec + D_FF); ug[3] = *(const u32x4*)(ec + UP_W); uv[3] = *(const u32x4*)(ec + UP_W + D_FF);
#pragma unroll
    for (int k = 0; k < 8; ++k) w[k] = cwt[(ch >> 1) * 2 + k];
    const h2_t c1 = {(_Float16)-0.10294324f, (_Float16)-0.10294324f}, c0 = {(_Float16)-2.3022082f, (_Float16)-2.3022082f}, one = {(_Float16)1.0f, (_Float16)1.0f};
    u32x4 oa, ob;
#pragma unroll
    for (int qp = 0; qp < 2; ++qp) { h2_t cg[4], cv[4];
#pragma unroll
        for (int qq = 0; qq < 2; ++qq) { const int q = 2 * qp + qq; const u32x4 wg = w[2 * q], wv = w[2 * q + 1];
            cg[2 * qq + 0] = u2h(wg.w) + u2h(wg.x) * u2h(ug[0][q]) + u2h(wg.y) * u2h(ug[1][q]) + u2h(wg.z) * u2h(ug[2][q]);
            cg[2 * qq + 1] = u2h(wg.w) + u2h(wg.x) * u2h(ug[1][q]) + u2h(wg.y) * u2h(ug[2][q]) + u2h(wg.z) * u2h(ug[3][q]);
            cv[2 * qq + 0] = u2h(wv.w) + u2h(wv.x) * u2h(uv[0][q]) + u2h(wv.y) * u2h(uv[1][q]) + u2h(wv.z) * u2h(uv[2][q]);
            cv[2 * qq + 1] = u2h(wv.w) + u2h(wv.x) * u2h(uv[1][q]) + u2h(wv.y) * u2h(uv[2][q]) + u2h(wv.z) * u2h(uv[3][q]); }
        unsigned e0 = h2u(cg[0] * (cg[0] * cg[0] * c1 + c0)), e1 = h2u(cg[1] * (cg[1] * cg[1] * c1 + c0)), e2 = h2u(cg[2] * (cg[2] * cg[2] * c1 + c0)), e3 = h2u(cg[3] * (cg[3] * cg[3] * c1 + c0));
        H2X4_TRANS("v_exp_f16_sdwa", e0, e1, e2, e3);
        e0 = h2u(u2h(e0) + one); e1 = h2u(u2h(e1) + one); e2 = h2u(u2h(e2) + one); e3 = h2u(u2h(e3) + one);
        H2X4_TRANS("v_rcp_f16_sdwa", e0, e1, e2, e3);
        oa[2 * qp] = h2u(cg[0] * u2h(e0) * cv[0]); ob[2 * qp] = h2u(cg[1] * u2h(e1) * cv[1]); oa[2 * qp + 1] = h2u(cg[2] * u2h(e2) * cv[2]); ob[2 * qp + 1] = h2u(cg[3] * u2h(e3) * cv[3]); }
    *(u32x4*)((t - 1 < gsplit_row ? G : G2) + (size_t)(t - 1) * D_FF + ch) = oa; *(u32x4*)((t < gsplit_row ? G : G2) + (size_t)t * D_FF + ch) = ob;
}
struct EpiKV {
    static constexpr bool PERM = false;
    float* kraw; bf16_t* vT;
    __device__ __forceinline__ void operator()(const f32x4 (&acc)[2][2][4][2], const Unit& u, int wr, int wc, int fr, int fq) const {
        const int key0 = wr * 64 + fr, col0 = u.pn * BM + wc * 32 + 4 * fq;
        if (u.pn < 8) {
#pragma unroll
            for (int ai = 0; ai < 2; ++ai)
#pragma unroll
                for (int m = 0; m < 4; ++m) { float* rowp = kraw + (size_t)(u.pm * BM + key0 + ai * HALF + m * 16) * 2048 + col0;
#pragma unroll
                    for (int bj = 0; bj < 2; ++bj)
#pragma unroll
                        for (int n = 0; n < 2; ++n) *(f32x4*)(rowp + bj * HALF + n * 16) = acc[ai][bj][m][n]; }
        } else {
#pragma unroll
            for (int ai = 0; ai < 2; ++ai)
#pragma unroll
                for (int m = 0; m < 4; ++m) { bf16_t* rowp = vT + (size_t)(u.pm * BM + key0 + ai * HALF + m * 16) * 2048 + (col0 - 2048);
#pragma unroll
                    for (int bj = 0; bj < 2; ++bj)
#pragma unroll
                        for (int n = 0; n < 2; ++n) { const f32x4 v = acc[ai][bj][m][n]; u32x2 w; w.x = cvt_pk_bf16(v[0], v[1]); w.y = cvt_pk_bf16(v[2], v[3]); *(u32x2*)(rowp + bj * HALF + n * 16) = w; } }
        }
    }
};
}

namespace att {
constexpr int KVBLK = 64, SHM_V = 16384, SHM_K = 16384, OFF_V = 0, OFF_K = 3 * SHM_V, OFF_WS = 3 * SHM_V + 3 * SHM_K, LDP = 1024;
#define KSWZ(row, colB) ((row) * 256 + ((colB) ^ (((row) & 15) << 4)))
#define SBAR() __builtin_amdgcn_sched_barrier(0)
__device__ __forceinline__ int crow(int r, int hi) { return (r & 3) + 8 * (r >> 2) + 4 * hi; }
__device__ __forceinline__ void partialSM(f32x16& p0) {
#pragma unroll
  for (int r = 0; r < 16; ++r) p0[r] = __builtin_amdgcn_exp2f(p0[r]);
}
__device__ __forceinline__ void finishSM(f32x16& p0, f32x16& p1, float& l_reg, bf16x8& pa0, bf16x8& pa1, bf16x8& pa2, bf16x8& pa3) {
#pragma unroll
  for (int r = 0; r < 16; ++r) p1[r] = __builtin_amdgcn_exp2f(p1[r]);
  float ps = 0;
#pragma unroll
  for (int r = 0; r < 16; ++r) ps += p0[r];
#pragma unroll
  for (int r = 0; r < 16; ++r) ps += p1[r];
  l_reg += ps;
#define PK4(P, BASE, OUT) do { unsigned a0 = cvt_pk_bf16(P[BASE + 0], P[BASE + 1]), a1 = cvt_pk_bf16(P[BASE + 2], P[BASE + 3]);   \
    unsigned b0 = cvt_pk_bf16(P[BASE + 4], P[BASE + 5]), b1 = cvt_pk_bf16(P[BASE + 6], P[BASE + 7]);                              \
    auto r0 = __builtin_amdgcn_permlane32_swap(a0, b0, false, false); auto r1 = __builtin_amdgcn_permlane32_swap(a1, b1, false, false); \
    u32x4 w = {r0[0], r1[0], r0[1], r1[1]}; OUT = __builtin_bit_cast(bf16x8, w); } while (0)
  PK4(p0, 0, pa0); PK4(p0, 8, pa1); PK4(p1, 0, pa2); PK4(p1, 8, pa3);
#undef PK4
}
__device__ __forceinline__ void finishSM_tail(f32x16& p0, f32x16& p1, float& l_reg, bf16x8& pa0, bf16x8& pa1, bf16x8& pa2, bf16x8& pa3) {
  float ps = 0;
#pragma unroll
  for (int r = 0; r < 16; ++r) ps += p0[r];
#pragma unroll
  for (int r = 0; r < 16; ++r) ps += p1[r];
  l_reg += ps;
#define PK4(P, BASE, OUT) do { unsigned a0 = cvt_pk_bf16(P[BASE + 0], P[BASE + 1]), a1 = cvt_pk_bf16(P[BASE + 2], P[BASE + 3]);   \
    unsigned b0 = cvt_pk_bf16(P[BASE + 4], P[BASE + 5]), b1 = cvt_pk_bf16(P[BASE + 6], P[BASE + 7]);                              \
    u32x4 w = {a0, a1, b0, b1}; OUT = __builtin_bit_cast(bf16x8, w); } while (0)
  PK4(p0, 0, pa0); PK4(p0, 8, pa1); PK4(p1, 0, pa2); PK4(p1, 8, pa3);
#undef PK4
}
__device__ __forceinline__ void qkt(f32x16& p0, f32x16& p1, const LAS unsigned char* Ks, const bf16x8* qr, int r32, int hi, int cbase) {
  p0 = f32x16{}; p1 = f32x16{}; bf16x8 b0[4], b1[4];
#pragma unroll
  for (int d0 = 0; d0 < 4; ++d0) { const int cb = cbase + (d0 * 16 + hi * 8) * 2;
    b0[d0] = *(const LAS bf16x8*)(Ks + KSWZ(r32, cb)); b1[d0] = *(const LAS bf16x8*)(Ks + KSWZ(32 + r32, cb)); }
#define QK_STEP(D, N) do { asm volatile("s_waitcnt lgkmcnt(" #N ")" ::: "memory"); SBAR(); \
    p0 = __builtin_amdgcn_mfma_f32_32x32x16_bf16(b0[D], qr[D], p0, 0, 0, 0); p1 = __builtin_amdgcn_mfma_f32_32x32x16_bf16(b1[D], qr[D], p1, 0, 0, 0); } while (0)
  QK_STEP(0, 6); QK_STEP(1, 4); QK_STEP(2, 2); QK_STEP(3, 0);
#undef QK_STEP
}
__device__ __forceinline__ int v_st(int k, int c) { const int kk = k; return ((kk >> 3) * 4 + (c >> 5)) * 512 + ((kk & 7) * 32 + (c & 31)) * 2; }
__device__ __forceinline__ int v_rd_base(int lane) { return ((lane & 3) << 3) | (((lane >> 2) & 3) << 6) | (((lane >> 4) & 1) << 5) | (((lane >> 5) & 1) << 8); }
constexpr int v_rd_off(int d0, int ks, int half) { return d0 * 512 + ks * 4096 + half * 2048; }
template <int OFF> __device__ __forceinline__ s16x4 tr_read(int vb) {
  s16x4 r; asm volatile("ds_read_b64_tr_b16 %0, %1 offset:%2" : "=&v"(r) : "v"(vb), "i"(OFF) : "memory"); return r;
}
struct VFrag { s16x4 l0, h0, l1, h1, l2, h2, l3, h3; };
template <int D0> __device__ __forceinline__ void pv_read(VFrag& f, int vb) {
  f.l0 = tr_read<v_rd_off(D0, 0, 0)>(vb); f.h0 = tr_read<v_rd_off(D0, 0, 1)>(vb); f.l1 = tr_read<v_rd_off(D0, 1, 0)>(vb); f.h1 = tr_read<v_rd_off(D0, 1, 1)>(vb);
  f.l2 = tr_read<v_rd_off(D0, 2, 0)>(vb); f.h2 = tr_read<v_rd_off(D0, 2, 1)>(vb); f.l3 = tr_read<v_rd_off(D0, 3, 0)>(vb); f.h3 = tr_read<v_rd_off(D0, 3, 1)>(vb);
}
__device__ __forceinline__ void pv_mma(f32x16& od, const VFrag& f, bf16x8 pa0, bf16x8 pa1, bf16x8 pa2, bf16x8 pa3) {
#define PKV(L, H) (bf16x8){L[0], L[1], L[2], L[3], H[0], H[1], H[2], H[3]}
  od = __builtin_amdgcn_mfma_f32_32x32x16_bf16(pa0, PKV(f.l0, f.h0), od, 0, 0, 0);
  od = __builtin_amdgcn_mfma_f32_32x32x16_bf16(pa1, PKV(f.l1, f.h1), od, 0, 0, 0);
  od = __builtin_amdgcn_mfma_f32_32x32x16_bf16(pa2, PKV(f.l2, f.h2), od, 0, 0, 0);
  od = __builtin_amdgcn_mfma_f32_32x32x16_bf16(pa3, PKV(f.l3, f.h3), od, 0, 0, 0);
#undef PKV
}
__device__ __forceinline__ void pv_d0(f32x16* o, int vb, bf16x8 pa0, bf16x8 pa1, bf16x8 pa2, bf16x8 pa3) {
  VFrag fa, fb;
  pv_read<0>(fa, vb); pv_read<1>(fb, vb);
  asm volatile("s_waitcnt lgkmcnt(8)" ::: "memory"); SBAR(); pv_mma(o[0], fa, pa0, pa1, pa2, pa3); SBAR();
  pv_read<2>(fa, vb);
  asm volatile("s_waitcnt lgkmcnt(8)" ::: "memory"); SBAR(); pv_mma(o[1], fb, pa0, pa1, pa2, pa3); SBAR();
  pv_read<3>(fb, vb);
  asm volatile("s_waitcnt lgkmcnt(8)" ::: "memory"); SBAR(); pv_mma(o[2], fa, pa0, pa1, pa2, pa3); SBAR();
  asm volatile("s_waitcnt lgkmcnt(0)" ::: "memory"); SBAR(); pv_mma(o[3], fb, pa0, pa1, pa2, pa3);
}
__device__ __forceinline__ void att_step(f32x16& s0, f32x16& s1, const LAS unsigned char* Ks, const bf16x8* qr, int r32, int hi, int cbase,
                                         f32x16& e0, f32x16& e1, float& l_reg, bf16x8& pa0, bf16x8& pa1, bf16x8& pa2, bf16x8& pa3, f32x16* o, int vb) {
  bf16x8 b0[4], b1[4]; VFrag fa, fb; float ps = 0.f; u32x4 w0, w1, w2, w3;
#pragma unroll
  for (int d0 = 0; d0 < 4; ++d0) { const int cb = cbase + (d0 * 16 + hi * 8) * 2;
    b0[d0] = *(const LAS bf16x8*)(Ks + KSWZ(r32, cb)); b1[d0] = *(const LAS bf16x8*)(Ks + KSWZ(32 + r32, cb)); }
  s0 = f32x16{}; s1 = f32x16{};
#define PACK_H(E, BASE, H, W) do { ps += E[BASE + 2 * H]; ps += E[BASE + 2 * H + 1]; ps += E[BASE + 4 + 2 * H]; ps += E[BASE + 5 + 2 * H];                       \
    const unsigned a_ = cvt_pk_bf16(E[BASE + 2 * H], E[BASE + 2 * H + 1]), b_ = cvt_pk_bf16(E[BASE + 4 + 2 * H], E[BASE + 5 + 2 * H]);                       \
    W[H] = a_; W[2 + H] = b_; } while (0)
#define QK_STEP(D, N, PRE, PK_A, PK_B) do { asm volatile("s_waitcnt lgkmcnt(" #N ")" ::: "memory"); PRE; SBAR();                                                  \
    s0 = __builtin_amdgcn_mfma_f32_32x32x16_bf16(b0[D], qr[D], s0, 0, 0, 0); SBAR(); PK_A; SBAR();                                                                 \
    s1 = __builtin_amdgcn_mfma_f32_32x32x16_bf16(b1[D], qr[D], s1, 0, 0, 0); SBAR(); PK_B; SBAR(); } while (0)
  QK_STEP(0, 6, (void)0, PACK_H(e0, 0, 0, w0), PACK_H(e0, 0, 1, w0));
  QK_STEP(1, 4, (void)0, PACK_H(e0, 8, 0, w1), PACK_H(e0, 8, 1, w1));
  QK_STEP(2, 2, (void)0, PACK_H(e1, 0, 0, w2), PACK_H(e1, 0, 1, w2));
  QK_STEP(3, 0, (pv_read<0>(fa, vb), pv_read<1>(fb, vb)), PACK_H(e1, 8, 0, w3), PACK_H(e1, 8, 1, w3));
#undef QK_STEP
#undef PACK_H
  l_reg += ps;
  pa0 = __builtin_bit_cast(bf16x8, w0); pa1 = __builtin_bit_cast(bf16x8, w1); pa2 = __builtin_bit_cast(bf16x8, w2); pa3 = __builtin_bit_cast(bf16x8, w3);
#define PKV(L, H) (bf16x8){L[0], L[1], L[2], L[3], H[0], H[1], H[2], H[3]}
#define EX2(X, I) do { X[I] = __builtin_amdgcn_exp2f(X[I]); X[I + 1] = __builtin_amdgcn_exp2f(X[I + 1]); } while (0)
#define PV_BLK(D0, F, N, X, XB) do { asm volatile("s_waitcnt lgkmcnt(" #N ")" ::: "memory"); SBAR();                                                              \
    o[D0] = __builtin_amdgcn_mfma_f32_32x32x16_bf16(pa0, PKV(F.l0, F.h0), o[D0], 0, 0, 0); SBAR(); EX2(X, XB + 0); SBAR();                                         \
    o[D0] = __builtin_amdgcn_mfma_f32_32x32x16_bf16(pa1, PKV(F.l1, F.h1), o[D0], 0, 0, 0); SBAR(); EX2(X, XB + 2); SBAR();                                         \
    o[D0] = __builtin_amdgcn_mfma_f32_32x32x16_bf16(pa2, PKV(F.l2, F.h2), o[D0], 0, 0, 0); SBAR(); EX2(X, XB + 4); SBAR();                                         \
    o[D0] = __builtin_amdgcn_mfma_f32_32x32x16_bf16(pa3, PKV(F.l3, F.h3), o[D0], 0, 0, 0); SBAR(); EX2(X, XB + 6); SBAR(); } while (0)
  PV_BLK(0, fa, 8, s0, 0); pv_read<2>(fa, vb);
  PV_BLK(1, fb, 8, s0, 8); pv_read<3>(fb, vb);
  PV_BLK(2, fa, 8, s1, 0);
  PV_BLK(3, fb, 0, s1, 8);
#undef PV_BLK
#undef EX2
#undef PKV
}
__device__ __forceinline__ void attn_unit(const bf16_t* Qg, const bf16_t* __restrict__ Kg, const bf16_t* __restrict__ Vg, bf16_t* Og, int seq, float lam, const float* gsub, float oscale, LAS unsigned char* lds) {
  int tid_l = threadIdx.x; asm volatile("" : "+v"(tid_l));
  const int tid = tid_l, wid = __builtin_amdgcn_readfirstlane(tid >> 6), lane = tid & 63, r32 = lane & 31, hi = lane >> 5;
  const int comp = wid & 1, rg = wid >> 1, cbase = comp * 128;
  LAS unsigned char* V_lds = lds + OFF_V; LAS unsigned char* K_lds = lds + OFF_K;
  LAS float* wsf = (LAS float*)(lds + OFF_WS) + wid * 64; LAS float* li_l = wsf;
  float l_reg = 0; f32x16 o[4] = {}; bf16x8 qr[4];
  const bf16_t* Qw = Qg + (size_t)(rg * 32 + r32) * LDP + comp * 64 + hi * 8;
#pragma unroll
  for (int d0 = 0; d0 < 4; ++d0) qr[d0] = *(const bf16x8*)(Qw + d0 * 16);
  unsigned koff[2], voff[2];
#pragma unroll
  for (int i = 0; i < 2; ++i) { const int L = (tid + 512 * i) * 16; { const int row = L >> 8, colB = (L & 255) ^ ((row & 15) << 4); koff[i] = (unsigned)(row * LDP * 2 + colB); }
    { const int sub = L >> 9, w = L & 511, kk = (sub >> 2) * 8 + (w >> 6), c = (sub & 3) * 32 + ((w & 63) >> 1), k = kk; voff[i] = (unsigned)(k * LDP * 2 + c * 2); } }
  const int vbb = (int)(unsigned)(size_t)V_lds + v_rd_base(lane);
  const int NT = seq / KVBLK; const size_t tstep = (size_t)KVBLK * LDP * 2;
#define DMA_K(t) do { const int t_ = (t) < NT ? (t) : NT - 1; const char* g_ = (const char*)Kg + (size_t)t_ * tstep; LAS unsigned char* d_ = K_lds + (t_ % 3) * SHM_K + wid * 1024; \
    __builtin_amdgcn_global_load_lds((const unsigned*)(g_ + koff[0]), (LAS unsigned*)d_, 16, 0, 0); __builtin_amdgcn_global_load_lds((const unsigned*)(g_ + koff[1]), (LAS unsigned*)(d_ + 8192), 16, 0, 0); } while (0)
#define DMA_V(t) do { const int t_ = (t) < NT ? (t) : NT - 1; const char* g_ = (const char*)Vg + (size_t)t_ * tstep; LAS unsigned char* d_ = V_lds + (t_ % 3) * SHM_V + wid * 1024; \
    __builtin_amdgcn_global_load_lds((const unsigned*)(g_ + voff[0]), (LAS unsigned*)d_, 16, 0, 0); __builtin_amdgcn_global_load_lds((const unsigned*)(g_ + voff[1]), (LAS unsigned*)(d_ + 8192), 16, 0, 0); } while (0)
#define WAIT4_BAR() do { asm volatile("s_waitcnt vmcnt(4)" ::: "memory"); __builtin_amdgcn_s_barrier(); asm volatile("" ::: "memory"); } while (0)
  f32x16 pA0, pA1, pB0, pB1; bf16x8 pa0, pa1, pa2, pa3;
  DMA_K(0); DMA_K(1); DMA_V(0);
  WAIT4_BAR();
  DMA_K(2); DMA_V(1);
  qkt(pA0, pA1, K_lds, qr, r32, hi, cbase); partialSM(pA0); partialSM(pA1);
  int sk = 1, sv = 0;
  for (int j = 1; j + 1 < NT; j += 2) {
    WAIT4_BAR(); DMA_K(j + 2); DMA_V(j + 1);
    SBAR(); att_step(pB0, pB1, K_lds + sk * SHM_K, qr, r32, hi, cbase, pA0, pA1, l_reg, pa0, pa1, pa2, pa3, o, vbb + sv * SHM_V); SBAR();
    sk = sk == 2 ? 0 : sk + 1; sv = sv == 2 ? 0 : sv + 1;
    WAIT4_BAR(); DMA_K(j + 3); DMA_V(j + 2);
    SBAR(); att_step(pA0, pA1, K_lds + sk * SHM_K, qr, r32, hi, cbase, pB0, pB1, l_reg, pa0, pa1, pa2, pa3, o, vbb + sv * SHM_V); SBAR();
    sk = sk == 2 ? 0 : sk + 1; sv = sv == 2 ? 0 : sv + 1;
  }
  WAIT4_BAR(); DMA_K(NT + 1); DMA_V(NT);
  SBAR(); att_step(pB0, pB1, K_lds + sk * SHM_K, qr, r32, hi, cbase, pA0, pA1, l_reg, pa0, pa1, pa2, pa3, o, vbb + sv * SHM_V); SBAR();
  sv = sv == 2 ? 0 : sv + 1;
  WAIT4_BAR();
  finishSM_tail(pB0, pB1, l_reg, pa0, pa1, pa2, pa3); SBAR();
  pv_d0(o, vbb + sv * SHM_V, pa0, pa1, pa2, pa3);
  asm volatile("s_waitcnt vmcnt(0)" ::: "memory");
#undef DMA_K
#undef DMA_V
#undef WAIT4_BAR
  { auto rr = __builtin_amdgcn_permlane32_swap(__float_as_uint(l_reg), __float_as_uint(l_reg), false, false); l_reg = __uint_as_float(rr[0]) + __uint_as_float(rr[1]); }
  if (hi == 0) li_l[r32] = l_reg; asm volatile("s_waitcnt lgkmcnt(0)" ::: "memory");
  float rli[16];
#pragma unroll
  for (int r = 0; r < 16; ++r) rli[r] = __builtin_amdgcn_rcpf(li_l[crow(r, hi)]);
  __syncthreads();
  LAS float* X = (LAS float*)(lds) + rg * 4096 + lane;
  if (comp == 1) {
#pragma unroll
    for (int d0 = 0; d0 < 4; ++d0)
#pragma unroll
      for (int r = 0; r < 16; ++r) X[(d0 * 16 + r) * 64] = o[d0][r] * rli[r] * lam;
  }
  __syncthreads();
  if (comp == 0) {
    float ss[16];
#pragma unroll
    for (int r = 0; r < 16; ++r) ss[r] = 0.f;
#pragma unroll
    for (int d0 = 0; d0 < 4; ++d0)
#pragma unroll
      for (int r = 0; r < 16; ++r) { const float v = o[d0][r] * rli[r] - X[(d0 * 16 + r) * 64]; o[d0][r] = v; ss[r] += v * v; }
#pragma unroll
    for (int r = 0; r < 16; ++r) { float s = ss[r]; s += __shfl_xor(s, 1); s += __shfl_xor(s, 2); s += __shfl_xor(s, 4); s += __shfl_xor(s, 8); s += __shfl_xor(s, 16);
      ss[r] = __builtin_amdgcn_rsqf(s * (1.0f / 128.0f) + EPS) * oscale; }
    bf16_t* Ow = Og + (size_t)(rg * 32) * LDP;
#pragma unroll
    for (int d0 = 0; d0 < 4; ++d0) { const float g = gsub[d0 * 32 + r32];
#pragma unroll
#ifdef PROBE_ZERO_ATTN
      for (int r = 0; r < 16; ++r) Ow[(size_t)crow(r, hi) * LDP + d0 * 32 + r32] = (bf16_t)0;
#else
      for (int r = 0; r < 16; ++r) Ow[(size_t)crow(r, hi) * LDP + d0 * 32 + r32] = (bf16_t)(cvt_pk_bf16(o[d0][r] * ss[r] * g, 0.f) & 0xffffu);
#endif
    }
  }
  __syncthreads();
}
}


namespace att16 {
using att::KVBLK; using att::SHM_V; using att::SHM_K; using att::LDP;
constexpr int OFF_V = 0, OFF_K = 4 * SHM_V;
typedef f32x4 S8[4][2];
__device__ __forceinline__ f32x4 mma16(bf16x8 a, bf16x8 b, f32x4 c) { return __builtin_amdgcn_mfma_f32_16x16x32_bf16(a, b, c, 0, 0, 0); }
template <int OFF> __device__ __forceinline__ s16x4 tr_read(int vb) { s16x4 r; asm volatile("ds_read_b64_tr_b16 %0, %1 offset:%2" : "=&v"(r) : "v"(vb), "i"(OFF) : "memory"); return r; }
struct VF { s16x4 l0, h0, l1, h1; };
constexpr int v_off(int db, int ks, int half) { return ks * 8192 + half * 4096 + (db >> 1) * 512; }
template <int DP> __device__ __forceinline__ void pv_read(VF& fe, VF& fo, int vbe, int vbo) {
  fe.l0 = tr_read<v_off(2 * DP, 0, 0)>(vbe); fe.h0 = tr_read<v_off(2 * DP, 0, 1)>(vbe); fe.l1 = tr_read<v_off(2 * DP, 1, 0)>(vbe); fe.h1 = tr_read<v_off(2 * DP, 1, 1)>(vbe);
  fo.l0 = tr_read<v_off(2 * DP + 1, 0, 0)>(vbo); fo.h0 = tr_read<v_off(2 * DP + 1, 0, 1)>(vbo); fo.l1 = tr_read<v_off(2 * DP + 1, 1, 0)>(vbo); fo.h1 = tr_read<v_off(2 * DP + 1, 1, 1)>(vbo);
}
#define PKV16(L, H) (bf16x8){L[0], L[1], L[2], L[3], H[0], H[1], H[2], H[3]}
__device__ __forceinline__ void kf_read(bf16x8 (&kf)[4][2], const LAS unsigned char* Ks, int c16, int g, int cbase) {
#pragma unroll
  for (int kb = 0; kb < 4; ++kb)
#pragma unroll
    for (int ks = 0; ks < 2; ++ks) kf[kb][ks] = *(const LAS bf16x8*)(Ks + KSWZ(16 * kb + c16, cbase + (32 * ks + 8 * g) * 2));
}
__device__ __forceinline__ void qk_first(S8& S, const LAS unsigned char* Ks, const bf16x8 (&qf)[2][2], int c16, int g, int cbase) {
  bf16x8 kf[4][2]; kf_read(kf, Ks, c16, g, cbase);
#pragma unroll
  for (int kb = 0; kb < 4; ++kb)
#pragma unroll
    for (int qb = 0; qb < 2; ++qb) { f32x4 a = {0.f, 0.f, 0.f, 0.f}; a = mma16(kf[kb][0], qf[qb][0], a); a = mma16(kf[kb][1], qf[qb][1], a);
#pragma unroll
      for (int r = 0; r < 4; ++r) a[r] = __builtin_amdgcn_exp2f(a[r]);
      S[kb][qb] = a; }
}
#define ADDF16(acc, x) asm("v_add_f32 %0, %1, %0" : "+v"(acc) : "v"(x))
#define PACK16(E, KS, QB, W) do { const f32x4& e_ = E[2 * (KS) + ((W) >> 1)][QB]; pw[KS][QB][W] = cvt_pk_bf16(e_[2 * ((W) & 1)], e_[2 * ((W) & 1) + 1]); } while (0)
#define LSUM16() do { const bf16x8 on_ = {0x3F80, 0x3F80, 0x3F80, 0x3F80, 0x3F80, 0x3F80, 0x3F80, 0x3F80};                                                        \
    l2[0] = mma16(on_, __builtin_bit_cast(bf16x8, pw[0][0]), l2[0]); l2[1] = mma16(on_, __builtin_bit_cast(bf16x8, pw[0][1]), l2[1]);                               \
    l2[0] = mma16(on_, __builtin_bit_cast(bf16x8, pw[1][0]), l2[0]); l2[1] = mma16(on_, __builtin_bit_cast(bf16x8, pw[1][1]), l2[1]); } while (0)
__device__ __forceinline__ void pack_all(const S8& E, u32x4 (&pw)[2][2]) {
#pragma unroll
  for (int ks = 0; ks < 2; ++ks)
#pragma unroll
    for (int qb = 0; qb < 2; ++qb) { PACK16(E, ks, qb, 0); PACK16(E, ks, qb, 1); PACK16(E, ks, qb, 2); PACK16(E, ks, qb, 3); }
}
#define PV16(DB, F) do { _Pragma("unroll") for (int qb_ = 0; qb_ < 2; ++qb_) { o[DB][qb_] = mma16(PKV16(F.l0, F.h0), __builtin_bit_cast(bf16x8, pw[0][qb_]), o[DB][qb_]); \
    o[DB][qb_] = mma16(PKV16(F.l1, F.h1), __builtin_bit_cast(bf16x8, pw[1][qb_]), o[DB][qb_]); } } while (0)
__device__ __forceinline__ void pv_last(f32x4 (&o)[8][2], const u32x4 (&pw)[2][2], int vbe, int vbo) {
  VF ae, ao, be, bo;
  pv_read<0>(ae, ao, vbe, vbo); pv_read<1>(be, bo, vbe, vbo);
  asm volatile("s_waitcnt lgkmcnt(8)" ::: "memory"); SBAR(); PV16(0, ae); PV16(1, ao); SBAR();
  pv_read<2>(ae, ao, vbe, vbo);
  asm volatile("s_waitcnt lgkmcnt(8)" ::: "memory"); SBAR(); PV16(2, be); PV16(3, bo); SBAR();
  pv_read<3>(be, bo, vbe, vbo);
  asm volatile("s_waitcnt lgkmcnt(8)" ::: "memory"); SBAR(); PV16(4, ae); PV16(5, ao); SBAR();
  asm volatile("s_waitcnt lgkmcnt(0)" ::: "memory"); SBAR(); PV16(6, be); PV16(7, bo);
}
__device__ __forceinline__ void att_step(S8& S, const LAS unsigned char* Ks, const bf16x8 (&qf)[2][2], int c16, int g, int cbase, const S8& E, f32x4 (&l2)[2], f32x4 (&o)[8][2], int vbe, int vbo) {
  bf16x8 kf[4][2]; u32x4 pw[2][2]; VF ae, ao, be, bo;
  kf_read(kf, Ks, c16, g, cbase);
#define QK16(KB, N, PRE, P0, P1, P2, P3) do { asm volatile("s_waitcnt lgkmcnt(" #N ")" ::: "memory"); PRE; SBAR(); f32x4 a0_ = {0.f, 0.f, 0.f, 0.f}, a1_ = {0.f, 0.f, 0.f, 0.f};  \
    a0_ = mma16(kf[KB][0], qf[0][0], a0_); SBAR(); P0; SBAR(); a1_ = mma16(kf[KB][0], qf[1][0], a1_); SBAR(); P1; SBAR();                                     \
    a0_ = mma16(kf[KB][1], qf[0][1], a0_); SBAR(); P2; SBAR(); a1_ = mma16(kf[KB][1], qf[1][1], a1_); SBAR(); P3; SBAR(); S[KB][0] = a0_; S[KB][1] = a1_; } while (0)
  QK16(0, 6, (void)0, PACK16(E, 0, 0, 0), PACK16(E, 0, 0, 1), PACK16(E, 0, 0, 2), PACK16(E, 0, 0, 3));
  QK16(1, 4, (void)0, PACK16(E, 0, 1, 0), PACK16(E, 0, 1, 1), PACK16(E, 0, 1, 2), PACK16(E, 0, 1, 3));
  QK16(2, 2, (void)0, PACK16(E, 1, 0, 0), PACK16(E, 1, 0, 1), PACK16(E, 1, 0, 2), PACK16(E, 1, 0, 3));
  QK16(3, 0, (pv_read<0>(ae, ao, vbe, vbo), pv_read<1>(be, bo, vbe, vbo)), PACK16(E, 1, 1, 0), PACK16(E, 1, 1, 1), PACK16(E, 1, 1, 2), PACK16(E, 1, 1, 3));
#undef QK16
#define EX1(KB, QB, R) S[KB][QB][R] = __builtin_amdgcn_exp2f(S[KB][QB][R])
#define PVX(DB, F, KB) do { o[DB][0] = mma16(PKV16(F.l0, F.h0), __builtin_bit_cast(bf16x8, pw[0][0]), o[DB][0]); SBAR(); EX1(KB, 0, 0); SBAR();                    \
    o[DB][1] = mma16(PKV16(F.l0, F.h0), __builtin_bit_cast(bf16x8, pw[0][1]), o[DB][1]); SBAR(); EX1(KB, 0, 1); SBAR();                                          \
    o[DB][0] = mma16(PKV16(F.l1, F.h1), __builtin_bit_cast(bf16x8, pw[1][0]), o[DB][0]); SBAR(); EX1(KB, 0, 2); SBAR();                                          \
    o[DB][1] = mma16(PKV16(F.l1, F.h1), __builtin_bit_cast(bf16x8, pw[1][1]), o[DB][1]); SBAR(); EX1(KB, 0, 3); SBAR(); } while (0)
#define PVY(DB, F, KB) do { o[DB][0] = mma16(PKV16(F.l0, F.h0), __builtin_bit_cast(bf16x8, pw[0][0]), o[DB][0]); SBAR(); EX1(KB, 1, 0); SBAR();                    \
    o[DB][1] = mma16(PKV16(F.l0, F.h0), __builtin_bit_cast(bf16x8, pw[0][1]), o[DB][1]); SBAR(); EX1(KB, 1, 1); SBAR();                                          \
    o[DB][0] = mma16(PKV16(F.l1, F.h1), __builtin_bit_cast(bf16x8, pw[1][0]), o[DB][0]); SBAR(); EX1(KB, 1, 2); SBAR();                                          \
    o[DB][1] = mma16(PKV16(F.l1, F.h1), __builtin_bit_cast(bf16x8, pw[1][1]), o[DB][1]); SBAR(); EX1(KB, 1, 3); SBAR(); } while (0)
  SBAR(); LSUM16(); SBAR();
  asm volatile("s_waitcnt lgkmcnt(8)" ::: "memory"); SBAR(); PVX(0, ae, 0); PVY(1, ao, 0); pv_read<2>(ae, ao, vbe, vbo);
  asm volatile("s_waitcnt lgkmcnt(8)" ::: "memory"); SBAR(); PVX(2, be, 1); PVY(3, bo, 1); pv_read<3>(be, bo, vbe, vbo);
  asm volatile("s_waitcnt lgkmcnt(8)" ::: "memory"); SBAR(); PVX(4, ae, 2); PVY(5, ao, 2);
  asm volatile("s_waitcnt lgkmcnt(0)" ::: "memory"); SBAR(); PVX(6, be, 3); PVY(7, bo, 3);
#undef PVX
#undef PVY
#undef EX1
}
__device__ __forceinline__ void attn_unit(const bf16_t* Qg, const bf16_t* __restrict__ Kg, const bf16_t* __restrict__ Vg, bf16_t* Og, int seq, float lam, const float* gsub, float oscale, LAS unsigned char* lds, bool rev) {
  int tid_l = threadIdx.x; asm volatile("" : "+v"(tid_l));
  const int tid = tid_l, wid = __builtin_amdgcn_readfirstlane(tid >> 6), lane = tid & 63, c16 = lane & 15, g = lane >> 4;
  const int comp = wid & 1, rg = wid >> 1, cbase = comp * 128;
  LAS unsigned char* V_lds = lds + OFF_V; LAS unsigned char* K_lds = lds + OFF_K;

  f32x4 l2[2] = {{0.f, 0.f, 0.f, 0.f}, {0.f, 0.f, 0.f, 0.f}}; f32x4 o[8][2]; bf16x8 qf[2][2];
#pragma unroll
  for (int db = 0; db < 8; ++db)
#pragma unroll
    for (int qb = 0; qb < 2; ++qb) o[db][qb] = (f32x4){0.f, 0.f, 0.f, 0.f};
#pragma unroll
  for (int qb = 0; qb < 2; ++qb)
#pragma unroll
    for (int ks = 0; ks < 2; ++ks) qf[qb][ks] = *(const bf16x8*)(Qg + (size_t)(rg * 32 + 16 * qb + c16) * LDP + comp * 64 + 32 * ks + 8 * g);
  unsigned koff[2], voff[2];
#pragma unroll
  for (int i = 0; i < 2; ++i) { const int L = (tid + 512 * i) * 16; { const int row = L >> 8, colB = (L & 255) ^ ((row & 15) << 4); koff[i] = (unsigned)(row * LDP * 2 + colB); }
    { const int sub = L >> 9, w = L & 511, k = (sub >> 2) * 8 + (w >> 6), cl = ((w & 63) >> 1) ^ (((k >> 2) & 1) << 4), c = (sub & 3) * 32 + cl; voff[i] = (unsigned)(k * LDP * 2 + c * 2); } }
  const int vb0 = (int)(unsigned)(size_t)V_lds + (g >> 1) * 2048 + (g & 1) * 256 + ((c16 >> 2) & 3) * 64 + (c16 & 3) * 8;
  const int vbe0 = vb0 + (g & 1) * 32, vbo0 = vb0 + ((g & 1) ^ 1) * 32;
  const int NT = seq / KVBLK; const size_t tstep = (size_t)KVBLK * LDP * 2;
#define DMA_K(t) do { const int t_ = (t) < NT ? (t) : NT - 1; const char* g_ = (const char*)Kg + (size_t)(rev ? NT - 1 - t_ : t_) * tstep; LAS unsigned char* d_ = K_lds + (t_ & 3) * SHM_K + wid * 1024; \
    __builtin_amdgcn_global_load_lds((const unsigned*)(g_ + koff[0]), (LAS unsigned*)d_, 16, 0, 0); __builtin_amdgcn_global_load_lds((const unsigned*)(g_ + koff[1]), (LAS unsigned*)(d_ + 8192), 16, 0, 0); } while (0)
#define DMA_V(t) do { const int t_ = (t) < NT ? (t) : NT - 1; const char* g_ = (const char*)Vg + (size_t)(rev ? NT - 1 - t_ : t_) * tstep; LAS unsigned char* d_ = V_lds + (t_ & 3) * SHM_V + wid * 1024; \
    __builtin_amdgcn_global_load_lds((const unsigned*)(g_ + voff[0]), (LAS unsigned*)d_, 16, 0, 0); __builtin_amdgcn_global_load_lds((const unsigned*)(g_ + voff[1]), (LAS unsigned*)(d_ + 8192), 16, 0, 0); } while (0)
#define WAIT4_BAR() do { asm volatile("s_waitcnt vmcnt(8)" ::: "memory"); __builtin_amdgcn_s_barrier(); asm volatile("" ::: "memory"); } while (0)
  S8 pA, pB;
  DMA_K(0); DMA_K(1); DMA_V(0); DMA_K(2); DMA_V(1);
  WAIT4_BAR();
  DMA_K(3); DMA_V(2);
  qk_first(pA, K_lds, qf, c16, g, cbase);
  for (int j = 1; j + 1 < NT; j += 2) {
    WAIT4_BAR(); DMA_K(j + 3); DMA_V(j + 2);
    SBAR(); att_step(pB, K_lds + (j & 3) * SHM_K, qf, c16, g, cbase, pA, l2, o, vbe0 + ((j - 1) & 3) * SHM_V, vbo0 + ((j - 1) & 3) * SHM_V); SBAR();
    WAIT4_BAR(); DMA_K(j + 4); DMA_V(j + 3);
    SBAR(); att_step(pA, K_lds + ((j + 1) & 3) * SHM_K, qf, c16, g, cbase, pB, l2, o, vbe0 + (j & 3) * SHM_V, vbo0 + (j & 3) * SHM_V); SBAR();
  }
  WAIT4_BAR(); DMA_K(NT + 2); DMA_V(NT + 1);
  SBAR(); att_step(pB, K_lds + ((NT - 1) & 3) * SHM_K, qf, c16, g, cbase, pA, l2, o, vbe0 + ((NT - 2) & 3) * SHM_V, vbo0 + ((NT - 2) & 3) * SHM_V); SBAR();
  WAIT4_BAR();
  const int sv = (NT - 1) & 3;
  { u32x4 pw[2][2]; pack_all(pB, pw); SBAR(); LSUM16(); SBAR(); pv_last(o, pw, vbe0 + sv * SHM_V, vbo0 + sv * SHM_V); }
  asm volatile("s_waitcnt vmcnt(0)" ::: "memory");
#undef DMA_K
#undef DMA_V
#undef WAIT4_BAR
  float rl[2];
#pragma unroll
  for (int qb = 0; qb < 2; ++qb) rl[qb] = __builtin_amdgcn_rcpf(l2[qb][0]);
  __syncthreads();
  LAS float* X = (LAS float*)(lds) + rg * 4096 + lane;
  if (comp == 1) {
#pragma unroll
    for (int db = 0; db < 8; ++db)
#pragma unroll
      for (int qb = 0; qb < 2; ++qb)
#pragma unroll
        for (int r = 0; r < 4; ++r) X[((db * 2 + qb) * 4 + r) * 64] = o[db][qb][r] * rl[qb] * lam;
  }
  __syncthreads();
  if (comp == 0) {
    float ss[2] = {0.f, 0.f};
#pragma unroll
    for (int db = 0; db < 8; ++db)
#pragma unroll
      for (int qb = 0; qb < 2; ++qb)
#pragma unroll
        for (int r = 0; r < 4; ++r) { const float v = o[db][qb][r] * rl[qb] - X[((db * 2 + qb) * 4 + r) * 64]; o[db][qb][r] = v; ss[qb] += v * v; }
#pragma unroll
    for (int qb = 0; qb < 2; ++qb) { float t = ss[qb]; t += __shfl_xor(t, 16); t += __shfl_xor(t, 32); ss[qb] = __builtin_amdgcn_rsqf(t * (1.0f / 128.0f) + EPS) * oscale; }
#pragma unroll
    for (int db = 0; db < 8; ++db) { const f32x4 gs = *(const f32x4*)(gsub + 16 * db + 4 * g);
#pragma unroll
      for (int qb = 0; qb < 2; ++qb) { const f32x4 v = o[db][qb] * gs * ss[qb]; u32x2 w; w.x = cvt_pk_bf16(v[0], v[1]); w.y = cvt_pk_bf16(v[2], v[3]);
        *(u32x2*)(Og + (size_t)(rg * 32 + 16 * qb + c16) * LDP + 16 * db + 4 * g) = w; } }
  }
  __syncthreads();
}
#undef PV16
#undef PACK16
#undef LSUM16
#undef ADDF16
#undef PKV16
}

#define XB_TMO      128
#define XB_XCNT(j)  (256  + 64 * (j))
#define XB_XSUB(j)  (1280 + 64 * (j))
#define XB_XGEN(j)  (2304 + 64 * (j))
#define XB_TOP      3328
#define XB_TOPGEN   3392
#define XCD_BAR_WORDS 3456
#define XB_SPIN_CAP (1u << 20)
__device__ __forceinline__ unsigned xb_ld(unsigned* p)              { return __hip_atomic_load(p, __ATOMIC_RELAXED, __HIP_MEMORY_SCOPE_AGENT); }
__device__ __forceinline__ unsigned xb_add(unsigned* p, unsigned v) { return __hip_atomic_fetch_add(p, v, __ATOMIC_RELAXED, __HIP_MEMORY_SCOPE_AGENT); }
__device__ __forceinline__ unsigned xb_xcc_id() { return (unsigned)__builtin_amdgcn_s_getreg((3 << 11) | 20) & 0xFu; }
#define XB_SPIN(cond, bar) do { unsigned _sp = 0; while (cond) { __builtin_amdgcn_s_sleep(1); \
    if ((++_sp & 255u) == 0u) { if (xb_ld(&(bar)[XB_TMO])) break; if (_sp > XB_SPIN_CAP) { atomicAdd(&(bar)[XB_TMO], 1u); break; } } } } while (0)
struct XcdBarrier { unsigned* bar; unsigned x; volatile LAS unsigned* st; };
__device__ __forceinline__ XcdBarrier xcd_barrier_post(unsigned* bar, volatile LAS unsigned* st) {
    XcdBarrier b; b.bar = bar; b.x = xb_xcc_id(); b.st = st;
    if (threadIdx.x == 0) (void)xb_add(&bar[XB_XCNT(b.x)], 1u);
    return b;
}
__device__ __forceinline__ void xcd_barrier_complete(unsigned* bar, unsigned x, unsigned& nloc, unsigned& nx) {
    const unsigned G = gridDim.x * gridDim.y * gridDim.z;
    unsigned sum, cnt, mine, sp = 0u;
    for (;;) {
        sum = 0u; cnt = 0u; mine = 0u;
#pragma unroll
        for (unsigned j = 0; j < 16; ++j) { const unsigned c = xb_ld(&bar[XB_XCNT(j)]); sum += c; cnt += (c > 0u) ? 1u : 0u; mine = (j == x) ? c : mine; }
        if (sum == G) break;
        __builtin_amdgcn_s_sleep(1);
        if ((++sp & 255u) == 0u) { if (xb_ld(&bar[XB_TMO])) break; if (sp > XB_SPIN_CAP) { atomicAdd(&bar[XB_TMO], 1u); break; } }
    }
    nloc = mine > 0u ? mine : 1u; nx = cnt > 0u ? cnt : 1u;
}
__device__ __forceinline__ void xcd_barrier(const XcdBarrier& b) {
    asm volatile("s_waitcnt vmcnt(0)" ::: "memory");
    __syncthreads();
    if (threadIdx.x == 0) {
        unsigned* bar = b.bar;
        __builtin_amdgcn_s_waitcnt(0);
        unsigned nloc = b.st[0], nx = b.st[1];
        if (nloc == 0u) { xcd_barrier_complete(bar, b.x, nloc, nx); b.st[0] = nloc; b.st[1] = nx; }
        const unsigned old = xb_add(&bar[XB_XSUB(b.x)], 1u);
        const unsigned gen = old / nloc;
        if (old + 1u == (gen + 1u) * nloc) {
            __builtin_amdgcn_fence(__ATOMIC_RELEASE, "agent");
            asm volatile("s_waitcnt vmcnt(0)" ::: "memory");
            const unsigned og = xb_add(&bar[XB_TOP], 1u);
            const unsigned tg = og / nx;
            if (og + 1u == (tg + 1u) * nx) xb_add(&bar[XB_TOPGEN], 1u);
            else XB_SPIN(xb_ld(&bar[XB_TOPGEN]) == tg, bar);
            __builtin_amdgcn_fence(__ATOMIC_ACQUIRE, "agent");
            xb_add(&bar[XB_XGEN(b.x)], 1u);
            asm volatile("s_waitcnt vmcnt(0)" ::: "memory");
        } else {
            XB_SPIN(xb_ld(&bar[XB_XGEN(b.x)]) == gen, bar);
            __builtin_amdgcn_fence(__ATOMIC_ACQUIRE, "agent");
            asm volatile("s_waitcnt vmcnt(0)" ::: "memory");
        }
    }
    __syncthreads();
}

#define LDS_WAIT() asm volatile("s_waitcnt lgkmcnt(0)" ::: "memory")
__device__ __forceinline__ float wave_sum(float v) {
#pragma unroll
    for (int o = 1; o < 64; o <<= 1) v += __shfl_xor(v, o);
    return v;
}
typedef __bf16 bf16n2_t __attribute__((ext_vector_type(2)));
__device__ __forceinline__ unsigned cvt2_bf16_native(float lo, float hi) { const bf16n2_t v = {(__bf16)lo, (__bf16)hi}; return __builtin_bit_cast(unsigned, v); }
__device__ __forceinline__ void pool_fold_item(const float* Wp, const float* ps, const float* Wol, bf16_t* WT, int g_, int nb, int lane) {
    const int c16 = lane & 15, kg = lane >> 4, n0 = nb * 64;
    bf16x8 bfr[4][8];
#pragma unroll
    for (int ks = 0; ks < 8; ++ks) { const int d0 = ks * 32 + 8 * kg; const f32x4 p0 = *(const f32x4*)(ps + d0), p1 = *(const f32x4*)(ps + d0 + 4);
#pragma unroll
        for (int nh = 0; nh < 2; ++nh) { float t[2][8];
#pragma unroll
            for (int nq = 0; nq < 2; ++nq) { const float* bp = Wol + (size_t)d0 * 2048 + n0 + 16 * (2 * nh + nq) + c16;
#pragma unroll
                for (int j = 0; j < 8; ++j) t[nq][j] = bp[j * 2048]; }
            __builtin_amdgcn_sched_barrier(0);
#pragma unroll
            for (int nq = 0; nq < 2; ++nq) { u32x4 w;
                w.x = cvt2_bf16_native(t[nq][0] * p0[0], t[nq][1] * p0[1]); w.y = cvt2_bf16_native(t[nq][2] * p0[2], t[nq][3] * p0[3]);
                w.z = cvt2_bf16_native(t[nq][4] * p1[0], t[nq][5] * p1[1]); w.w = cvt2_bf16_native(t[nq][6] * p1[2], t[nq][7] * p1[3]); bfr[2 * nh + nq][ks] = __builtin_bit_cast(bf16x8, w); }
            __builtin_amdgcn_sched_barrier(0); } }
    for (int cb = 0; cb < 16; ++cb) { f32x4 acc[4];
#pragma unroll
        for (int nbk = 0; nbk < 4; ++nbk) acc[nbk] = (f32x4){0.f, 0.f, 0.f, 0.f};
#pragma unroll
        for (int kh = 0; kh < 2; ++kh) { f32x4 av[4][2];
#pragma unroll
            for (int k4 = 0; k4 < 4; ++k4) { const float* ap = Wp + (size_t)(cb * 16 + c16) * 256 + (kh * 4 + k4) * 32 + 8 * kg; av[k4][0] = *(const f32x4*)ap; av[k4][1] = *(const f32x4*)(ap + 4); }
            __builtin_amdgcn_sched_barrier(0);
#pragma unroll
            for (int k4 = 0; k4 < 4; ++k4) { const f32x4 a0 = av[k4][0], a1 = av[k4][1];
                u32x4 w; w.x = cvt2_bf16_native(a0[0], a0[1]); w.y = cvt2_bf16_native(a0[2], a0[3]); w.z = cvt2_bf16_native(a1[0], a1[1]); w.w = cvt2_bf16_native(a1[2], a1[3]); const bf16x8 af = __builtin_bit_cast(bf16x8, w);
#pragma unroll
                for (int nbk = 0; nbk < 4; ++nbk) acc[nbk] = __builtin_amdgcn_mfma_f32_16x16x32_bf16(af, bfr[nbk][kh * 4 + k4], acc[nbk], 0, 0, 0); }
            __builtin_amdgcn_sched_barrier(0); }
#pragma unroll
        for (int nbk = 0; nbk < 4; ++nbk) { u32x2 o; o.x = cvt2_bf16_native(acc[nbk][0], acc[nbk][1]); o.y = cvt2_bf16_native(acc[nbk][2], acc[nbk][3]);
            *(u32x2*)(WT + (size_t)(n0 + 16 * nbk + c16) * 2048 + 1024 + g_ * 256 + cb * 16 + 4 * kg) = o; }
        __builtin_amdgcn_sched_barrier(0); }
}
__device__ __forceinline__ unsigned cvt_pk_f16_rne(float a, float b) { const h2_t v = {(_Float16)a, (_Float16)b}; return __builtin_bit_cast(unsigned, v); }
template <bool F16 = false>
__device__ __forceinline__ void tr_item(const float* W, int K, int N, bf16_t* WT, const float* rs, const float* cs, int perm_limit, LAS float* scr, int item, int lane) {
    const int nblk = N / 32, kb = item / nblk, nb = item % nblk, k0 = 64 * kb, n0 = 32 * nb;
    const float csv = cs ? cs[n0 + (lane & 31)] : 1.f;
    float wv[32], rv[32];
#pragma unroll
    for (int i = 0; i < 32; ++i) { const int kk = 2 * i + (lane >> 5); wv[i] = W[(size_t)(k0 + kk) * N + n0 + (lane & 31)]; rv[i] = rs ? rs[k0 + kk] : 1.f; }
#pragma unroll
    for (int i = 0; i < 32; ++i) { const int kk = 2 * i + (lane >> 5); scr[kk * 33 + (lane & 31)] = wv[i] * rv[i] * csv; }
    LDS_WAIT(); asm volatile("" ::: "memory");
    int d0 = n0; if (n0 < perm_limit) { const int tile = n0 >> 8, lb = (n0 >> 5) & 7; d0 = (tile << 8) + ((4 * (lb & 1) + (lb >> 1)) << 5); }
    if (perm_limit < 0) { const int isv = n0 >= D_FF, ch = n0 - (isv ? D_FF : 0); d0 = (ch >> 7) * 256 + isv * 128 + (ch & 127); }
    const int c = lane & 7;
#pragma unroll
    for (int j = 0; j < 4; ++j) { const int n = (lane >> 3) + 8 * j; const LAS float* s = scr + (8 * c) * 33 + n;
        u32x4 o;
        if constexpr (F16) { o.x = cvt_pk_f16_rne(s[0 * 33], s[1 * 33]); o.y = cvt_pk_f16_rne(s[2 * 33], s[3 * 33]); o.z = cvt_pk_f16_rne(s[4 * 33], s[5 * 33]); o.w = cvt_pk_f16_rne(s[6 * 33], s[7 * 33]); }
        else { o.x = cvt_pk_bf16(s[0 * 33], s[1 * 33]); o.y = cvt_pk_bf16(s[2 * 33], s[3 * 33]); o.z = cvt_pk_bf16(s[4 * 33], s[5 * 33]); o.w = cvt_pk_bf16(s[6 * 33], s[7 * 33]); }
        *(u32x4*)(WT + (size_t)(d0 + n) * K + k0 + 8 * c) = o; }
    LDS_WAIT(); asm volatile("" ::: "memory");
}
__device__ __forceinline__ void norm_row(const float* xrow, bf16_t* orow, float* crow_, int lane) {
    f32x4 v[8]; float s = 0.f;
#pragma unroll
    for (int j = 0; j < 4; ++j) { v[2 * j] = *(const f32x4*)(xrow + j * 512 + lane * 8); v[2 * j + 1] = *(const f32x4*)(xrow + j * 512 + lane * 8 + 4); s += pg8::sumsq4(v[2 * j]) + pg8::sumsq4(v[2 * j + 1]); }
    const float rstd = __builtin_amdgcn_rsqf(wave_sum(s) * (1.0f / D_MODEL) + EPS);
#pragma unroll
    for (int j = 0; j < 4; ++j) { if (crow_) { *(f32x4*)(crow_ + j * 512 + lane * 8) = v[2 * j]; *(f32x4*)(crow_ + j * 512 + lane * 8 + 4) = v[2 * j + 1]; }
        *(u32x4*)(orow + j * 512 + lane * 8) = pg8::pack8(v[2 * j] * rstd, v[2 * j + 1] * rstd); }
}

__device__ __forceinline__ void raw_row(const float* xrow, bf16_t* orow, rss_t* ssq, int lane) {
    f32x4 v[8]; float s = 0.f;
#pragma unroll
    for (int j = 0; j < 4; ++j) { v[2 * j] = *(const f32x4*)(xrow + j * 512 + lane * 8); v[2 * j + 1] = *(const f32x4*)(xrow + j * 512 + lane * 8 + 4); s += pg8::sumsq4(v[2 * j]) + pg8::sumsq4(v[2 * j + 1]); }
    s = wave_sum(s); if (lane == 0) *ssq = ss_fix(s);
#pragma unroll
    for (int j = 0; j < 4; ++j) *(u32x4*)(orow + j * 512 + lane * 8) = pg8::pack8(v[2 * j], v[2 * j + 1]);
}

template <int WIN> __device__ __forceinline__ void pool_item(const bf16_t* U, bf16_t* ZP, int r0, int ch, bool big) {
    constexpr int NR = 3 + 2 * WIN, SM = WIN / 2;
    const int pos0 = tok_pos(r0), S = tok_seqlen(r0);
    u32x4 v[NR];
#pragma unroll
    for (int k = 0; k < NR; ++k) { const int p = pos0 - WIN + k; v[k] = (p >= 0 && p < S) ? *(const u32x4*)(U + (size_t)(r0 - WIN + k) * 1024 + ch) : (u32x4){0u, 0u, 0u, 0u}; }
    float sb[8], ss[8];
#pragma unroll
    for (int j = 0; j < 8; ++j) { sb[j] = 0.f; ss[j] = 0.f; }
#define POOL_ACC(dst, k, sgn) do { const u32x4 w_ = v[k]; dst[0] += sgn bflo(w_.x); dst[1] += sgn bfhi(w_.x); dst[2] += sgn bflo(w_.y); dst[3] += sgn bfhi(w_.y); dst[4] += sgn bflo(w_.z); dst[5] += sgn bfhi(w_.z); dst[6] += sgn bflo(w_.w); dst[7] += sgn bfhi(w_.w); } while (0)
#pragma unroll
    for (int k = 0; k < 2 * WIN; ++k) { POOL_ACC(sb, k, +); if (k >= WIN - SM && k < WIN + SM) POOL_ACC(ss, k, +); }
#pragma unroll
    for (int i = 0; i < 4; ++i) {
        if (i > 0) { POOL_ACC(sb, i + 2 * WIN - 1, +); POOL_ACC(sb, i - 1, -); POOL_ACC(ss, i + WIN + SM - 1, +); POOL_ACC(ss, i + WIN - SM - 1, -); }
        const int pos = pos0 + i, w2 = big ? WIN : SM; const int lo_ = pos - w2 < 0 ? 0 : pos - w2, hi_ = pos + w2 > S ? S : pos + w2; const float inv = 1.0f / (float)(hi_ - lo_);
        const u32x4 c = v[WIN + i]; float s[8];
#pragma unroll
        for (int j = 0; j < 8; ++j) s[j] = (big ? sb[j] : ss[j]) * inv;
        u32x4 o; o.x = cvt_pk_bf16(s[0] - bflo(c.x), s[1] - bfhi(c.x)); o.y = cvt_pk_bf16(s[2] - bflo(c.y), s[3] - bfhi(c.y)); o.z = cvt_pk_bf16(s[4] - bflo(c.z), s[5] - bfhi(c.z)); o.w = cvt_pk_bf16(s[6] - bflo(c.w), s[7] - bfhi(c.w));
        *(u32x4*)(ZP + (size_t)(r0 + i) * 1024 + ch) = o; }
#undef POOL_ACC
}

struct Args { const float* in[28]; float* out; unsigned char* ws; int ph_lo, ph_hi; };

__global__ void __launch_bounds__(NWAVES * 64, 2) trunk_fwd(Args args) {
    extern __shared__ __attribute__((aligned(16))) unsigned char lds_raw[];
    LAS unsigned char* lds = (LAS unsigned char*)lds_raw;
    volatile LAS unsigned* MISC = (volatile LAS unsigned*)(lds + MISC_OFF);
    for (int u = threadIdx.x; u < (LDS_BYTES - LDSCTL_OFF) / 4; u += NWAVES * 64) ((LAS unsigned*)(lds + LDSCTL_OFF))[u] = 0u;
    __syncthreads();
    const int lo = args.ph_lo, hi = args.ph_hi;
    XcdBarrier bar; bar.bar = (unsigned*)(args.ws + WS_CTL) + CW_BAR; bar.x = 0; bar.st = nullptr;
    if (hi - lo > 1) bar = xcd_barrier_post((unsigned*)(args.ws + WS_CTL) + CW_BAR, MISC + 8);
#define IN(k) ({ int lo_ = lo, hi_ = hi; asm volatile("" : "+s"(lo_), "+s"(hi_)); lo_ <= (k) && (k) < hi_; })
#define SEAM(k) do { if (IN(k) && IN((k) + 1)) { XcdBarrier b2_ = bar; asm volatile("" : "+s"(b2_.bar), "+s"(b2_.x)); xcd_barrier(b2_); } } while (0)
#define PHASE_BEGIN() int tid = threadIdx.x; asm volatile("" : "+v"(tid)); int zo = 0; asm volatile("" : "+s"(zo)); \
    const int lane = tid & 63, wave = __builtin_amdgcn_readfirstlane(tid >> 6); const int G = gridDim.x, bx = blockIdx.x; \
    const int vcu = (G % 8 == 0) ? (bx % 8) * (G / 8) + bx / 8 : bx; const int gw = vcu * NWAVES + wave, NGW = G * NWAVES; \
    unsigned char* ws = args.ws + zo; float* X = args.out + zo; (void)lane; (void)wave; (void)gw; (void)NGW; (void)ws; (void)X; (void)vcu; (void)tid
#define INP(i) (args.in[(i) + zo])
#define WSP(T, off) ((T*)(ws + (off)))

#define CG_UP 1u
#define CG_DOWN 2u
#define CG_IN 4u
#define CG_CKV 8u
#define CG_OUT 16u
#define CG_CQ 32u
#define CG_CO 64u
#define CONV_ITEMS(L_, MASK_) do { const int l_ = (L_); constexpr unsigned m_ = (MASK_); __syncthreads(); LAS float* scr = (LAS float*)(lds + wave * 16384);                                         \
    constexpr int I_IN = 32 * 128, I_OUT = 16 * 64, I_CQ = 32 * 64, I_CKV = 32 * 128, I_CO = 32 * 64, I_UP = 32 * (UP_W / 32), I_DOWN = (D_FF / 64) * 64, I_P = 4 * 32;                                 \
    constexpr int n_ = ((m_ & CG_UP) ? I_UP : 0) + ((m_ & CG_DOWN) ? I_DOWN : 0) + ((m_ & CG_IN) ? I_IN : 0) + ((m_ & CG_CKV) ? I_CKV : 0) + ((m_ & CG_OUT) ? I_OUT + I_P : 0) + ((m_ & CG_CQ) ? I_CQ : 0) + ((m_ & CG_CO) ? I_CO : 0); \
    for (int it = gw; it < n_; it += NGW) { int r = it;                                                                                                                                            \
        if constexpr ((m_ & CG_UP) != 0) { if (r < I_UP) { tr_item(INP(24) + (size_t)l_ * 2048 * UP_W, 2048, UP_W, WSP(bf16_t, WS_WUP), INP(23) + l_ * 2048, nullptr, -1, scr, r, lane); continue; } r -= I_UP; } \
        if constexpr ((m_ & CG_DOWN) != 0) { if (r < I_DOWN) { tr_item<true>(INP(27) + (size_t)l_ * D_FF * 2048, D_FF, 2048, WSP(bf16_t, WS_WDOWN), nullptr, nullptr, 0, scr, r, lane); continue; } r -= I_DOWN; } \
        if constexpr ((m_ & CG_IN) != 0) { if (r < I_IN) { tr_item(INP(5) + (size_t)l_ * 2048 * 4096, 2048, 4096, WSP(bf16_t, WS_WIN), INP(4) + l_ * 2048, nullptr, 2048, scr, r, lane); continue; } r -= I_IN; } \
        if constexpr ((m_ & CG_CKV) != 0) { if (r < I_CKV) { tr_item(INP(19) + (size_t)l_ * 2048 * 4096, 2048, 4096, WSP(bf16_t, WS_WCKV), INP(17) + l_ * 2048, nullptr, 0, scr, r, lane); continue; } r -= I_CKV; } \
        if constexpr ((m_ & CG_OUT) != 0) { if (r < I_OUT) { tr_item(INP(15) + (size_t)l_ * 2048 * 2048, 2048, 2048, WSP(bf16_t, WS_WOUT), nullptr, nullptr, 0, scr, r, lane); continue; } r -= I_OUT;   \
            if (r < I_P) { const int g = r >> 5; pool_fold_item(INP(13) + (size_t)l_ * 4 * 65536 + (size_t)g * 65536, INP(14) + l_ * 1024 + g * 256, INP(15) + (size_t)l_ * 2048 * 2048 + (size_t)(1024 + g * 256) * 2048, WSP(bf16_t, WS_WOUT), g, r & 31, lane); continue; } r -= I_P; } \
        if constexpr ((m_ & CG_CQ) != 0) { if (r < I_CQ) { tr_item(INP(18) + (size_t)l_ * 2048 * 2048, 2048, 2048, WSP(bf16_t, WS_WCQ), INP(16) + l_ * 2048, nullptr, 0, scr, r, lane); continue; } r -= I_CQ; } \
        if constexpr ((m_ & CG_CO) != 0) { if (r < I_CO) { tr_item(INP(22) + (size_t)l_ * 2048 * 2048, 2048, 2048, WSP(bf16_t, WS_WCO), nullptr, nullptr, 0, scr, r, lane); continue; } r -= I_CO; } }   \
    if constexpr ((m_ & CG_UP) != 0) { const float* cw = INP(25) + (size_t)l_ * 3 * UP_W; const float* cb = INP(26) + (size_t)l_ * UP_W; u32x4* cwt = WSP(u32x4, WS_CWT);        \
        for (int it = vcu * 512 + tid; it < D_FF; it += G * 512) { const int p = it >> 1, isv = it & 1, ch = 2 * p + isv * D_FF; u32x4 w;                                                          \
            w.x = cvt_pk_f16_rne(cw[ch], cw[ch + 1]); w.y = cvt_pk_f16_rne(cw[UP_W + ch], cw[UP_W + ch + 1]); w.z = cvt_pk_f16_rne(cw[2 * UP_W + ch], cw[2 * UP_W + ch + 1]); w.w = cvt_pk_f16_rne(cb[ch], cb[ch + 1]); cwt[it] = w; } } } while (0)
    for (int l = 0; l < DEPTH; ++l) {
        const int pb = l * PH_PER_LAYER;
        if (PH_EN(0) && IN(pb + 0)) {
            PHASE_BEGIN();
            if (l == 0) CONV_ITEMS(0, CG_IN | CG_CKV);
            bf16_t* HB = WSP(bf16_t, WS_HB);
            if (l == 0) {
                unsigned* csT = WSP(unsigned, WS_COS);
                for (int e = (vcu * 512 + tid); e < 8192 * 32; e += G * 512) { const int pos = e >> 5, i = e & 31;
                    double inv = 1.0; const double b = 0.74989420933245582730;
                    for (int k = 0; k < i; ++k) inv *= b;
                    double rev = (double)pos * inv * 0.15915494309189533577; rev -= __builtin_floor(rev);
                    const float fr_ = (float)rev;
                    const _Float16 hc = (_Float16)__builtin_amdgcn_cosf(fr_), hs = (_Float16)__builtin_amdgcn_sinf(fr_);
                    csT[e] = (unsigned)__builtin_bit_cast(unsigned short, hc) | ((unsigned)__builtin_bit_cast(unsigned short, hs) << 16); }
                bf16_t* MB = WSP(bf16_t, WS_MB);
                for (int m = gw; m < NMEMROWS; m += NGW) { const float* src = m < 1024 ? INP(2) + (size_t)m * 2048 : INP(3) + (size_t)(m - 1024) * 2048; norm_row(src, MB + (size_t)m * 2048, nullptr, lane); }
                rss_t* rss0 = WSP(rss_t, WS_ROWSS);
                for (int m = gw; m < NTOK; m += NGW) { const float* src = m < NTOK_P ? INP(0) + (size_t)m * 2048 : INP(1) + (size_t)(m - NTOK_P) * 2048; raw_row(src, HB + (size_t)m * 2048, rss0 + m, lane); }
            }
        }
        if (l == 0) SEAM(pb + 0);
        if (PH_EN(1) && IN(pb + 1)) {
            PHASE_BEGIN(); pg8::StaticOrder SO;
            if (PH_EN(17)) { pg8::ProbSimple P; P.K = 2048; P.lda = 2048; P.ldb = 2048; P.tsplit = 1 << 30; P.adelta = 0; P.A = (const char*)WSP(bf16_t, WS_HB); P.B = (const char*)WSP(bf16_t, WS_WIN);
              SO.init(NTOK / 256, IN_W / 256, G, bx, l == 0 ? 1 : 0);
              pg8::EpiIn E{WSP(bf16_t, R_Q), (size_t)NTOK * 1024, WSP(const unsigned, WS_COS), INP(6) + l * 64, INP(7) + l * 64, WSP(const rss_t, WS_ROWSS) + (size_t)(l * 3 + 0) * NTOK};
              pg8::gemm_phase<pg8::ProbSimple, pg8::EpiIn, true, true>(lds, P, SO, E); }
            if (PH_EN(16)) { pg8::ProbSimple P; P.K = 2048; P.lda = 2048; P.ldb = 2048; P.tsplit = 1 << 30; P.adelta = 0; P.A = (const char*)WSP(bf16_t, WS_MB); P.B = (const char*)WSP(bf16_t, WS_WCKV);
              SO.init(NMEMROWS / 256, 4096 / 256, G, bx);
              pg8::EpiKV E{WSP(float, WS_KRAW), WSP(bf16_t, WS_VT)};
              pg8::gemm_phase<pg8::ProbSimple, pg8::EpiKV, true, true>(lds, P, SO, E); }
            if (l == 0) CONV_ITEMS(0, CG_OUT | CG_CO | CG_CQ);
        }
        SEAM(pb + 1);
        if (PH_EN(2) && IN(pb + 2)) {
            if (PH_EN(18)) {
              PHASE_BEGIN();
              const float lam_init = 0.8f - 0.6f * __expf(-0.3f * (float)l);
              float s1 = 0.f, s2 = 0.f; const float* q1 = INP(8) + l * 64; const float* k1 = INP(9) + l * 64; const float* q2 = INP(10) + l * 64; const float* k2 = INP(11) + l * 64;
              for (int i = 0; i < 64; ++i) { s1 += q1[i] * k1[i]; s2 += q2[i] * k2[i]; }
              const float lam = __expf(s1) - __expf(s2) + lam_init;
              const float* gsub = INP(12) + l * 128;
              bf16_t* Qb = WSP(bf16_t, R_Q); const bf16_t* Kb = WSP(const bf16_t, R_K); const bf16_t* Vb = WSP(const bf16_t, R_V);
              __syncthreads();
              { const int NX = (G % 8 == 0) ? 8 : 1, xcd = bx % NX, j = bx / NX, nb = G / NX, npr = 2048 / NX;
                  for (int kk = j; kk < 2 * npr; kk += nb) { int pair, qt, S; size_t t0;
                      if (kk < npr) { pair = xcd + NX * (kk >> 6); qt = kk & 63; S = S_P; t0 = (size_t)(pair >> 3) * S_P; }
                      else { const int k2_ = kk - npr; pair = xcd + NX * (k2_ >> 5); qt = k2_ & 31; S = S_S; t0 = (size_t)NTOK_P + (size_t)(pair >> 3) * S_S; }
                      const int h = pair & 7; bf16_t* qp = Qb + (t0 + (size_t)qt * 128) * 1024 + h * 128;
                      ATTN_NS::attn_unit(qp, Kb + t0 * 1024 + h * 128, Vb + t0 * 1024 + h * 128, qp, S, lam, gsub, 1.f - lam_init, lds, kk < npr && ((kk / nb) & 1)); }
              }
            }
            if (PH_EN(14)) { PHASE_BEGIN(); const bf16_t* U = WSP(const bf16_t, R_U); bf16_t* ZP = (bf16_t*)X;
#ifdef PROBE_DOUBLE_PASSES
              int nrq = 2; asm volatile("" : "+s"(nrq)); for (int rq_ = 0; rq_ < nrq; ++rq_)
#endif
              for (int it = gw; it < (NTOK / 4) * 2; it += NGW) { const int r0 = (it >> 1) * 4, half = it & 1, ch = half * 512 + lane * 8;
                  if (half == 0) pool_item<2>(U, ZP, r0, ch, lane >= 32); else pool_item<8>(U, ZP, r0, ch, lane >= 32); } }
            if (PH_EN(15)) { PHASE_BEGIN(); const float* gcq = INP(20) + l * 512; const float* gck = INP(21) + l * 512; const float* KRAW = WSP(const float, WS_KRAW); bf16_t* KC = WSP(bf16_t, WS_KC);
              for (int it = gw; it < NMEMROWS * 4; it += NGW) { const int row = it >> 2, h = it & 3; const float* kr = KRAW + (size_t)row * 2048 + h * 512 + lane * 8;
                  const f32x4 a = *(const f32x4*)kr, b = *(const f32x4*)(kr + 4); const float ss = wave_sum(pg8::sumsq4(a) + pg8::sumsq4(b));
                  const float rk = __builtin_amdgcn_rsqf(ss * (1.0f / 512.0f) + EPS);
                  const f32x4 ga = *(const f32x4*)(gcq + lane * 8) * *(const f32x4*)(gck + lane * 8), gb = *(const f32x4*)(gcq + lane * 8 + 4) * *(const f32x4*)(gck + lane * 8 + 4);
                  *(u32x4*)(KC + (size_t)row * 2048 + h * 512 + lane * 8) = pg8::pack8(a * rk * ga, b * rk * gb); } }
            { PHASE_BEGIN(); if (l == 0) CONV_ITEMS(0, CG_UP); else CONV_ITEMS(l, CG_DOWN); }
        }
        SEAM(pb + 2);
        if (PH_EN(4) && IN(pb + 4)) {
            PHASE_BEGIN(); pg8::StaticOrder SO;
            pg8::ProbSimple P; P.K = 2048; P.lda = 1024; P.ldb = 2048; P.tsplit = 16; P.adelta = (long long)((const char*)X - (const char*)(ws + R_Q)) - 16ll * 128; P.A = (const char*)(ws + R_Q);   P.B = (const char*)WSP(bf16_t, WS_WOUT);
            SO.init(NTOK / 256, 8, G, bx);
            pg8::EpiRes E{WSP(bf16_t, WS_HB), WSP(rss_t, WS_ROWSS) + (size_t)(l * 3 + 1) * NTOK, nullptr};
            pg8::gemm_phase<pg8::ProbSimple, pg8::EpiRes, true, true>(lds, P, SO, E);
            if (PH_EN(3)) {

              pg8::ProbVW P2; P2.K = 512; P2.lda = 2048; P2.ldb = 2048; P2.tsplit = 1 << 30; P2.adelta = 0; P2.A = (const char*)WSP(bf16_t, WS_WCO); P2.B = (const char*)WSP(bf16_t, WS_VT);
              SO.init(8, 48, G, bx);
              pg8::EpiBf<5> E2{WSP(bf16_t, R_VW), 1024, nullptr, nullptr, nullptr};
              pg8::gemm_phase<pg8::ProbVW, pg8::EpiBf<5>, true, true>(lds, P2, SO, E2); }
            if (l == 0) CONV_ITEMS(0, CG_DOWN);
            if (l + 1 < DEPTH) CONV_ITEMS(l + 1, CG_IN | CG_CKV);
        }
        SEAM(pb + 4);
        if (PH_EN(5) && IN(pb + 5)) {
            PHASE_BEGIN(); pg8::StaticOrder SO;
            pg8::ProbSimple P; P.K = 2048; P.lda = 2048; P.ldb = 2048; P.tsplit = 1 << 30; P.adelta = 0; P.A = (const char*)WSP(bf16_t, WS_HB); P.B = (const char*)WSP(bf16_t, WS_WCQ);
            SO.init(NTOK / 256, 8, G, bx, 1);
            pg8::EpiBf<1> E{WSP(bf16_t, R_QC), 2048, WSP(float, WS_QSS), (float*)(WSP(rss_t, WS_ROWSS) + (size_t)(l * 3 + 1) * NTOK), nullptr};
            pg8::gemm_phase<pg8::ProbSimple, pg8::EpiBf<1>, true, true>(lds, P, SO, E);
            if (l + 1 < DEPTH) CONV_ITEMS(l + 1, CG_OUT | CG_CO);
        }
        SEAM(pb + 5);
        if (PH_EN(6) && IN(pb + 6)) {
            PHASE_BEGIN(); pg8::StaticOrder SO;
            pg8::ProbScores P; P.K = 512; P.lda = 2048; P.ldb = 2048; P.tsplit = 1 << 30; P.adelta = 0; P.A = (const char*)(ws + R_QC); P.B = (const char*)WSP(bf16_t, WS_KC);
            SO.init(NTOK / 256, 4, G, bx);
            pg8::EpiBf<2> E{WSP(bf16_t, R_P), 1024, WSP(float, WS_QSS), nullptr, (LAS float*)(lds + XCH_OFF)};
            pg8::gemm_phase<pg8::ProbScores, pg8::EpiBf<2>, true, true>(lds, P, SO, E);
            if (l + 1 < DEPTH) CONV_ITEMS(l + 1, CG_CQ);
        }
        SEAM(pb + 6);
        if (PH_EN(8) && IN(pb + 7)) {
            PHASE_BEGIN(); pg8::StaticOrder SO;
            pg8::ProbFin P; P.K = 1024; P.lda = 1024; P.ldb = 1024; P.tsplit = 1 << 30; P.adelta = 0; P.A = (const char*)(ws + R_P); P.B = (const char*)WSP(bf16_t, R_VW);
            SO.init(NTOK / 256, 8, G, bx, 1);
            pg8::EpiRes E{WSP(bf16_t, WS_HB), WSP(rss_t, WS_ROWSS) + (size_t)(l * 3 + 2) * NTOK, nullptr};
            pg8::gemm_phase<pg8::ProbFin, pg8::EpiRes, true, true>(lds, P, SO, E);
        }
        SEAM(pb + 7);
        const bool whole = (l + 1 < DEPTH); const int nch = whole ? 1 : N_FFN_CHUNKS;
        for (int c = 0; c < nch; ++c) {
            const int pc = pb + 8 + 2 * c; const size_t r0 = (size_t)c * FFN_CHUNK; const int MT = whole ? NTOK / 256 : FFN_MT;
            if (PH_EN(11) && IN(pc)) {
                PHASE_BEGIN(); pg8::StaticOrder SO;
                pg8::ProbUp P; P.K = 2048; P.lda = 2048; P.ldb = 2048; P.tsplit = 1 << 30; P.adelta = 0; P.A = (const char*)(WSP(bf16_t, WS_HB) + r0 * 2048); P.B = (const char*)WSP(bf16_t, WS_WUP); P.chunk = c;
                SO.init(MT, D_FF / 128, G, bx);
                bf16_t* G2p = (bf16_t*)((unsigned char*)X - (size_t)FFN_GSPLIT_ROW * D_FF * 2); bf16_t* EBp = whole ? (bf16_t*)((unsigned char*)X + FFN_EB_OUT_OFF) : WSP(bf16_t, R_EB);
                pg8::EpiGlu E{WSP(bf16_t, R_G), WSP(const rss_t, WS_ROWSS) + (size_t)(l * 3 + 2) * NTOK + r0, WSP(const u32x4, WS_CWT), c, (LAS float*)(lds + GLX_OFF), EBp, G2p, whole ? FFN_GSPLIT_ROW / 256 : (1 << 30)};
                pg8::gemm_phase<pg8::ProbUp, pg8::EpiGlu, true, true>(lds, P, SO, E);
            }
            SEAM(pc);
            if (PH_EN(13) && IN(pc + 1)) {
                PHASE_BEGIN(); pg8::StaticOrder SO;
                bf16_t* G2p = (bf16_t*)((unsigned char*)X - (size_t)FFN_GSPLIT_ROW * D_FF * 2);
                {
                  const bf16_t* EBp = whole ? (const bf16_t*)((unsigned char*)X + FFN_EB_OUT_OFF) : WSP(const bf16_t, R_EB); const u32x4* cwp = WSP(const u32x4, WS_CWT); bf16_t* Gp = WSP(bf16_t, R_G);
                  const int nb = whole ? 244 : (c == 0 ? 124 : 120), gsr = whole ? FFN_GSPLIT_ROW : (1 << 30);
                  for (int it = gw; it < nb * 11; it += NGW) { const int b = it / 11, cb = it - b * 11; int t;
                      if (whole ? b < 124 : c == 0) { const int sq = b / 31, bi = b - sq * 31; t = sq * S_P + 256 * (bi + 1); }
                      else { const int b2 = whole ? b - 124 : b, sq = b2 / 15, bi = b2 - sq * 15; t = (whole ? NTOK_P : 0) + sq * S_S + 256 * (bi + 1); }
                      pg8::ffn_fix_item(EBp, cwp, Gp, G2p, gsr, t, cb, lane); }
                  XcdBarrier b4_ = bar; asm volatile("" : "+s"(b4_.bar), "+s"(b4_.x)); xcd_barrier(b4_); }
                pg8::ProbDown P; P.K = D_FF; P.lda = D_FF; P.ldb = D_FF; P.tsplit = 1 << 30; P.adelta = 0; P.A = (const char*)(ws + R_G); P.A2 = (const char*)G2p; P.B = (const char*)WSP(bf16_t, WS_WDOWN); P.split = whole ? FFN_GSPLIT_ROW / 256 : (1 << 30);
                SO.init(MT, 8, G, bx, 1);
                pg8::EpiRes E{WSP(bf16_t, WS_HB) + r0 * 2048, (l + 1 < DEPTH) ? WSP(rss_t, WS_ROWSS) + (size_t)((l + 1) * 3 + 0) * NTOK + r0 : nullptr, (l + 1 < DEPTH) ? nullptr : X + r0 * 2048};
                pg8::gemm_phase<pg8::ProbDown, pg8::EpiRes, true, true>(lds, P, SO, E);
                if (c == nch - 1 && l + 1 < DEPTH) CONV_ITEMS(l + 1, CG_UP);
            }
            SEAM(pc + 1);
        }
    }
#undef IN
#undef SEAM
#undef PHASE_BEGIN
#undef INP
#undef WSP
}


#ifdef SELFCHECK
constexpr int CHK_WORD = 1024;
__device__ __forceinline__ void chk_upd(unsigned* ctl, int idx, float got, float ref) { const float e = fabsf(got - ref) / (0.03f * fabsf(ref) + 0.03f); atomicMax(ctl + CHK_WORD + idx, __float_as_uint(e)); }
__device__ __forceinline__ int chk_token(int s) { const int tab[16] = {0, 1, 127, 128, 4095, 8191, 8192, 12345, 32767, 32768, 32769, 36863, 36864, 50000, 65534, 65535}; int t = 0;
#pragma unroll
    for (int i = 0; i < 16; ++i) t = (s & 15) == i ? tab[i] : t; return t; }
__global__ void __launch_bounds__(64) check_kernel(Args args, int after, int l) {
    const int s = blockIdx.x, lane = threadIdx.x; unsigned char* ws = args.ws; unsigned* ctl = (unsigned*)(ws + WS_CTL);
    const int tok = chk_token(s); float* X = args.out;
    const float* xin = tok < NTOK_P ? args.in[0] + (size_t)tok * 2048 : args.in[1] + (size_t)(tok - NTOK_P) * 2048;
    if (after == 1) {
        if (l == 0) {
            float ssx = 0.f; for (int k = lane; k < 2048; k += 64) ssx += xin[k] * xin[k]; ssx = wave_sum(ssx); const float rstd = 1.0f / sqrtf(ssx / 2048.f + EPS);
            const int vec = (s * 7) & 31, isk = vec >> 4, hc = vec & 15;
            const float* w_in = args.in[5]; const float* g_mix = args.in[4]; const int col = isk * 1024 + hc * 64 + lane;
            float z = 0.f; for (int k = 0; k < 2048; ++k) z += xin[k] * rstd * g_mix[k] * w_in[(size_t)k * 4096 + col];
            const float ss = wave_sum(z * z); const float g = (isk ? args.in[7] : args.in[6])[lane]; const float zn = z / sqrtf(ss / 64.f + EPS) * g;
            const float other = __shfl_xor(zn, 32); const int i = lane & 31; const int pos = tok_pos(tok);
            const float ang = (float)pos * powf(10000.f, -(float)i / 32.f); const float c = cosf(ang), sn = sinf(ang);
            const float ref = lane < 32 ? zn * c - other * sn : zn * c + other * sn;
            const bf16_t* Q = (const bf16_t*)(ws + (isk ? R_K : R_Q)); const float got = bf2f(Q[(size_t)tok * 1024 + hc * 64 + lane]);
            const float gother = __shfl_xor(got, 32);
            (void)gother; chk_upd(ctl, 0, got, ref);
            { const unsigned tv = ((const unsigned*)(ws + WS_COS))[pos * 32 + i]; typedef _Float16 h2 __attribute__((ext_vector_type(2))); const h2 hv = __builtin_bit_cast(h2, tv);
              chk_upd(ctl, 1, (float)hv.x, c); chk_upd(ctl, 1, (float)hv.y, sn); }
        }
        { const bf16_t* Q = (const bf16_t*)(ws + R_Q); bf16_t* sv = (bf16_t*)(ws + WS_CHK) + s * 128; const int h = s & 7; sv[lane] = Q[(size_t)tok * 1024 + h * 128 + lane]; sv[lane + 64] = Q[(size_t)tok * 1024 + h * 128 + 64 + lane]; }
    }
    if (after == 2) {
        const int h = s & 7; const bf16_t* sv = (const bf16_t*)(ws + WS_CHK) + s * 128; const int S = tok_seqlen(tok); const size_t t0 = (size_t)tok - tok_pos(tok);
        const bf16_t* K = (const bf16_t*)(ws + R_K) + t0 * 1024 + h * 128; const bf16_t* V = (const bf16_t*)(ws + R_V) + t0 * 1024 + h * 128;
        const float lam_init = 0.8f - 0.6f * expf(-0.3f * (float)l); float s1 = 0.f, s2 = 0.f;
        for (int i = 0; i < 64; ++i) { s1 += (args.in[8] + l * 64)[i] * (args.in[9] + l * 64)[i]; s2 += (args.in[10] + l * 64)[i] * (args.in[11] + l * 64)[i]; }
        const float lam = expf(s1) - expf(s2) + lam_init;
        float o[2][2];
        for (int c = 0; c < 2; ++c) { float mx = -1e30f;
            for (int k = lane; k < S; k += 64) { float d = 0.f; for (int e = 0; e < 64; ++e) d += bf2f(sv[c * 64 + e]) * bf2f(K[(size_t)k * 1024 + c * 64 + e]); mx = fmaxf(mx, d); }
            for (int o_ = 1; o_ < 64; o_ <<= 1) mx = fmaxf(mx, __shfl_xor(mx, o_));
            float lsum = 0.f, a0 = 0.f, a1 = 0.f;
            for (int k = 0; k < S; ++k) { float d = 0.f; for (int e = 0; e < 64; ++e) d += bf2f(sv[c * 64 + e]) * bf2f(K[(size_t)k * 1024 + c * 64 + e]);
                const float p = exp2f(d - mx); lsum += p; a0 += p * bf2f(V[(size_t)k * 1024 + lane]); a1 += p * bf2f(V[(size_t)k * 1024 + 64 + lane]); }
            o[c][0] = a0 / lsum; o[c][1] = a1 / lsum; }
        const float v0 = o[0][0] - lam * o[1][0], v1 = o[0][1] - lam * o[1][1]; const float ss = wave_sum(v0 * v0 + v1 * v1); const float rn = 1.0f / sqrtf(ss / 128.f + EPS) * (1.f - lam_init);
        const float* gsub = args.in[12] + l * 128; const bf16_t* A = (const bf16_t*)(ws + R_Q) + (size_t)tok * 1024 + h * 128;
        chk_upd(ctl, 2, bf2f(A[lane]), v0 * rn * gsub[lane]); chk_upd(ctl, 2, bf2f(A[64 + lane]), v1 * rn * gsub[64 + lane]);
    }
    if (after == 4 && l == 0) {
        const bf16_t* A = (const bf16_t*)(ws + R_Q) + (size_t)tok * 1024; const bf16_t* Pp = (const bf16_t*)(ws + R_POUT) + (size_t)tok * 1024; const float* w_out = args.in[15];
        const int col = (s * 131 + lane * 17) & 2047; float z = xin[col];
        for (int k = 0; k < 1024; ++k) z += bf2f(A[k]) * w_out[(size_t)k * 2048 + col];
        for (int k = 0; k < 1024; ++k) z += bf2f(Pp[k]) * w_out[(size_t)(1024 + k) * 2048 + col];
        chk_upd(ctl, 3, X[(size_t)tok * 2048 + col], z);
    }
    if (after == 8 && tok < FFN_CHUNK) {
        const bf16_t* HB = (const bf16_t*)(ws + WS_HB); const float* w_up = args.in[24] + (size_t)l * 2048 * UP_W; const float* g_ffn = args.in[23] + l * 2048;
        const float* cw = args.in[25] + (size_t)l * 3 * UP_W; const float* cb = args.in[26] + (size_t)l * UP_W;
        const int j = (s * 977 + lane * 53) % D_FF; const int pos = tok_pos(tok), S = tok_seqlen(tok); float u2[2];
        for (int half = 0; half < 2; ++half) { const int col = half * D_FF + j; float acc = cb[col];
            for (int tap = 0; tap < 3; ++tap) { const int pp = pos + tap - 1; if (pp < 0 || pp >= S) continue; const bf16_t* hr = HB + (size_t)(tok + tap - 1) * 2048; float d = 0.f;
                for (int k = 0; k < 2048; ++k) d += bf2f(hr[k]) * g_ffn[k] * w_up[(size_t)k * UP_W + col];
                const float rxx = ss_rstd(((const rss_t*)(ws + WS_ROWSS))[(size_t)(l * 3 + 2) * NTOK + tok + tap - 1]); acc += d * rxx * cw[(size_t)tap * UP_W + col]; }
            u2[half] = acc; }
        const float x = u2[0]; const float ref = 0.5f * x * (1.f + tanhf(0.7978845608028654f * (x + 0.044715f * x * x * x))) * u2[1];
        chk_upd(ctl, 4, bf2f(((const bf16_t*)(ws + R_G))[(size_t)tok * D_FF + j]), ref);
    }
    if (false) {
        const bf16_t* Gr = (const bf16_t*)(ws + R_G) + (size_t)tok * D_FF; const float* w_down = args.in[27] + (size_t)l * D_FF * 2048; const float* svx = (const float*)(ws + WS_CHK + 65536) + (size_t)s * 2048;
        const int col = (s * 131 + lane * 17) & 2047; float z = svx[col]; for (int k = 0; k < D_FF; ++k) z += bf2f(Gr[k]) * w_down[(size_t)k * 2048 + col];
        chk_upd(ctl, 5, X[(size_t)tok * 2048 + col], z);
    }
}
__global__ void __launch_bounds__(256) report_kernel(Args args) {
    unsigned* ctl = (unsigned*)(args.ws + WS_CTL); float* out = args.out;
    for (size_t i = (size_t)blockIdx.x * 256 + threadIdx.x; i < (size_t)NTOK * 2048; i += (size_t)gridDim.x * 256) {
        float v = 0.f;
        if (i == 0) { int mask = 0; for (int b = 0; b < 6; ++b) if (__uint_as_float(ctl[CHK_WORD + b]) > 1.0f) mask |= 1 << b; v = (10.f + (float)mask) * 1000.f; }
        out[i] = v; }
}
#endif

extern "C" void kernel_launch(void* const* d_in, const int* in_sizes, int n_in, void* d_out, int out_size, void* d_ws, size_t ws_size, hipStream_t stream) {
    static int grid = 0;
    if (grid == 0) {
        if (n_in != 28 || out_size != NTOK * D_MODEL || ws_size < WS_END) { fprintf(stderr, "kernel_launch: unexpected shapes: n_in %d out %d ws %zu (need >= %zu)\n", n_in, out_size, ws_size, (size_t)WS_END); grid = -1; return; }
        int dev = 0, cus = 0, per_cu = 0;
        if (hipGetDevice(&dev) != hipSuccess || hipDeviceGetAttribute(&cus, hipDeviceAttributeMultiprocessorCount, dev) != hipSuccess) { grid = -1; return; }
        if (hipFuncSetAttribute((const void*)trunk_fwd, hipFuncAttributeMaxDynamicSharedMemorySize, LDS_BYTES) != hipSuccess) { fprintf(stderr, "kernel_launch: hipFuncSetAttribute failed\n"); grid = -1; return; }
        if (hipOccupancyMaxActiveBlocksPerMultiprocessor(&per_cu, (const void*)trunk_fwd, NWAVES * 64, LDS_BYTES) != hipSuccess || per_cu < 1)
            fprintf(stderr, "kernel_launch: occupancy query reports %d workgroups per CU\n", per_cu);
        (void)hipGetLastError();
        grid = cus;
    }
    if (grid < 0) return;
    (void)hipMemsetAsync((char*)d_ws + WS_CTL, 0, CTL_ZERO_BYTES, stream);
    Args a{};
    for (int i = 0; i < 28; ++i) a.in[i] = (const float*)d_in[i];
    a.out = (float*)d_out; a.ws = (unsigned char*)d_ws;
#if ML_PER_PHASE
    for (int p = 0; p < N_PHASES; ++p) { a.ph_lo = p; a.ph_hi = p + 1; hipLaunchKernelGGL(trunk_fwd, dim3(grid), dim3(NWAVES * 64), LDS_BYTES, stream, a);
#ifdef SELFCHECK
        { const int l = p / PH_PER_LAYER, q = p % PH_PER_LAYER; if (l == SELFCHECK_LAYER && (q == 1 || q == 2 || q == 8)) hipLaunchKernelGGL(check_kernel, dim3(64), dim3(64), 0, stream, a, q, l); }
#endif
    }
#ifdef SELFCHECK
    hipLaunchKernelGGL(report_kernel, dim3(2048), dim3(256), 0, stream, a);
#endif
#else
    a.ph_lo = 0; a.ph_hi = N_PHASES;
    hipLaunchKernelGGL(trunk_fwd, dim3(grid), dim3(NWAVES * 64), LDS_BYTES, stream, a);
#endif
    const hipError_t le = hipPeekAtLastError();
    if (le != hipSuccess) fprintf(stderr, "kernel_launch: launch failed: %s\n", hipGetErrorName(le));
}
```

```cpp
#include <hip/hip_runtime.h>
#include <cstdio>
#include <cstdint>

#define SELFCHECK_LAYER 0
#ifndef ML_PER_PHASE
#define ML_PER_PHASE 0
#endif

#ifndef PHASE_MASK
#define PHASE_MASK 0xFFFFFFFFu
#endif
#define PH_EN(p) (((PHASE_MASK) >> (p)) & 1u)
#ifndef ATTN_NS
#define ATTN_NS att16
#endif
#define LAS __attribute__((address_space(3)))
#define GAS __attribute__((address_space(1)))
typedef unsigned short bf16_t;
typedef short bf16x8 __attribute__((ext_vector_type(8)));
typedef short s16x4 __attribute__((ext_vector_type(4)));
typedef float f32x4 __attribute__((ext_vector_type(4)));
typedef float f32x2 __attribute__((ext_vector_type(2)));
typedef float f32x16 __attribute__((ext_vector_type(16)));
typedef unsigned u32x4 __attribute__((ext_vector_type(4)));
typedef unsigned u32x2 __attribute__((ext_vector_type(2)));
typedef _Float16 h2_t __attribute__((ext_vector_type(2)));
typedef _Float16 f16x8 __attribute__((ext_vector_type(8)));

constexpr int D_MODEL = 2048, DEPTH = 2;
constexpr int NTOK = 65536;
constexpr int NTOK_P = 32768;
constexpr int S_P = 8192, S_S = 4096;
constexpr int NMEMROWS = 3072;
constexpr int IN_W = 4096, D_FF = 5632, UP_W = 11264;
constexpr float EPS = 1e-6f;
constexpr float QSCALE = 0.125f * 1.4426950408889634f;
constexpr int FFN_CHUNK = 32768, N_FFN_CHUNKS = 2;
constexpr int FFN_MT = FFN_CHUNK / 256, FFN_BT = 0;
constexpr int PH_PER_LAYER = 8 + 2 * N_FFN_CHUNKS;
constexpr int N_PHASES = DEPTH * PH_PER_LAYER;

constexpr size_t MiB = 1u << 20;
constexpr size_t WS_CTL = 0, CTL_ZERO_BYTES = 5 * MiB;
constexpr size_t WS_ROWSS = 1 * MiB;
constexpr size_t WS_COS = 5 * MiB;
constexpr size_t WS_QSS = 6 * MiB;
constexpr size_t WS_LPART = 14 * MiB;
constexpr size_t WS_MB = 18 * MiB;
constexpr size_t WS_KRAW = 30 * MiB;
constexpr size_t WS_KC = 54 * MiB;
constexpr size_t WS_VT = 66 * MiB;
constexpr size_t WS_CHK = 78 * MiB;
constexpr size_t WS_WIN = 79 * MiB, WS_WP = 95 * MiB, WS_WOUT = 96 * MiB, WS_WCQ = 104 * MiB, WS_WCKV = 112 * MiB, WS_WCO = 128 * MiB, WS_WUP = 136 * MiB, WS_WDOWN = 180 * MiB;
constexpr size_t WS_HB = 203 * MiB;
constexpr size_t WS_R = 459 * MiB;
constexpr size_t WS_CWT = 987 * MiB;
constexpr size_t WS_END = 988 * MiB;
typedef unsigned long long rss_t;
__device__ __forceinline__ rss_t ss_fix(float s) { return (rss_t)(s * 1048576.0f + 0.5f); }
__device__ __forceinline__ float ss_rstd(rss_t v) { return __builtin_amdgcn_rsqf((float)v * (1.0f / (1048576.0f * 2048.0f)) + 1e-6f); }
constexpr size_t R_Q = WS_R, R_K = WS_R + 128 * MiB, R_V = WS_R + 256 * MiB, R_U = WS_R + 384 * MiB;
constexpr size_t R_QC = WS_R, R_P = WS_R + 256 * MiB, R_VW = WS_R + 384 * MiB;
constexpr size_t R_G = WS_R;
constexpr int FFN_GSPLIT_ROW = 49152;
constexpr size_t FFN_EB_OUT_OFF = 192 * MiB;
constexpr size_t R_EB = WS_R + 384 * MiB;
constexpr size_t R_POUT = WS_R + 128 * MiB;
static_assert(R_G + (size_t)FFN_CHUNK * D_FF * 2 <= WS_END, "ws map");
constexpr int CW_BAR = 4096;

constexpr int RING_BYTES = 131072;
constexpr int LDSCTL_OFF = RING_BYTES, MISC_OFF = LDSCTL_OFF + 320, XCH_OFF = LDSCTL_OFF + 1024, GLX_OFF = XCH_OFF + 4096;
constexpr int LDS_BYTES = 151552;
constexpr int NWAVES = 8;

__device__ __forceinline__ unsigned cvt_pk_bf16(float lo, float hi) { unsigned r; asm volatile("v_cvt_pk_bf16_f32 %0, %1, %2" : "=v"(r) : "v"(lo), "v"(hi)); return r; }
__device__ __forceinline__ float bf2f(unsigned short b) { return __uint_as_float(((unsigned)b) << 16); }
__device__ __forceinline__ float bflo(unsigned w) { return __uint_as_float(w << 16); }
__device__ __forceinline__ float bfhi(unsigned w) { return __uint_as_float(w & 0xffff0000u); }
__device__ __forceinline__ int tok_pos(int row) { return row < NTOK_P ? (row & (S_P - 1)) : (row & (S_S - 1)); }
__device__ __forceinline__ int tok_seqlen(int row) { return row < NTOK_P ? S_P : S_S; }
__device__ __forceinline__ int tile_batch(int pm) { return pm < 128 ? (pm >> 5) : 4 + ((pm - 128) >> 4); }

namespace pg8 {
constexpr int BM = 256, BK = 64, HALF = 128, HTB = HALF * BK * 2, STAGE_BYTES = 8 * HTB, NXCD = 8, WGM = 4;
__host__ __device__ __forceinline__ int lds_byte(int r, int c) { const int st = (r >> 4) * 2 + (c >> 5), rr = r & 15, cc = c & 31, ob = rr * 64 + cc * 2; return st * 1024 + (ob ^ (((ob >> 9) & 1) << 5)); }
__host__ __device__ __forceinline__ void stage_rc(int b, int& R, int& C) { const int st = b / 1024, sb = b % 1024, swz = sb ^ (((sb >> 9) & 1) << 5); R = (st >> 1) * 16 + swz / 64; C = (st & 1) * 32 + (swz % 64) / 2; }
__host__ __device__ __forceinline__ int perm32(int rho) { const int n = rho >> 4, i = rho & 15; return 8 * (i >> 2) + 4 * n + (i & 3); }
struct Unit { int pm, pn; };
struct StaticOrder {
    int nM, nN, nwg, G, c, rv;
    __host__ __device__ void init(int nM_, int nN_, int G_, int c_, int rv_ = 0) { nM = nM_; nN = nN_; nwg = nM * nN; G = G_; c = c_; rv = rv_; }
    __host__ __device__ bool next(int i, Unit& u) const {
        const long L = (long)i * G + c; if (L >= nwg) return false;
        int wgid = (int)L; { const int q = nwg / NXCD, r = nwg % NXCD, xcd = wgid % NXCD; int off = wgid / NXCD; if (rv && r == 0) off = q - 1 - off; wgid = (xcd < r ? xcd * (q + 1) : r * (q + 1) + (xcd - r) * q) + off; }
        const int nig = WGM * nN, gid = wgid / nig, fm = gid * WGM, gsz = (nM - fm) < WGM ? (nM - fm) : WGM;
        u.pm = fm + ((wgid % nig) % gsz); u.pn = (wgid % nig) / gsz; return true;
    }
};
struct ProbBase { static constexpr bool GATHER = false; static constexpr bool F16 = false; int K, lda, ldb, tsplit; long long adelta; __device__ __forceinline__ unsigned rowoff(const Unit&, int) const { return 0u; } };

template <class Prob, class Epi, bool ALIGN_EPI, bool SP2>
__device__ __forceinline__ void gemm_phase(LAS unsigned char* lds, const Prob& P, const StaticOrder& S, const Epi& E) {
    static_assert(SP2, "only the two-super-phase loop is kept in this file");
    int tid_l = threadIdx.x; asm volatile("" : "+v"(tid_l));
    const int tid = tid_l, wid = __builtin_amdgcn_readfirstlane(tid >> 6), lane = tid & 63, wr = wid >> 2, wc = wid & 3, fr = lane & 15, fq = lane >> 4;
    const int K = P.K, nt = K / BK, lda = P.lda, ldb = P.ldb, tsplit = P.tsplit; const long long adelta = P.adelta;
    unsigned voffA[2], voffB[2];
#pragma unroll
    for (int i = 0; i < 2; ++i) { int R, C; stage_rc(tid * 16 + i * 8192, R, C); const int Rb = Epi::PERM ? ((R & ~31) + perm32(R & 31)) : R;
        voffA[i] = (unsigned)(R * lda + C) * 2u; voffB[i] = (unsigned)(Rb * ldb + C) * 2u; }
    const size_t kstep = (size_t)(BK * 2);
    const size_t hstepA = (size_t)HALF * lda * 2, hstepB = (size_t)HALF * ldb * 2;
    const unsigned ldsw = (unsigned)wid * 1024u;
    const int aoff = lds_byte(wr * 64 + fr, fq * 8), boff = lds_byte(wc * 32 + fr, fq * 8);
    unsigned vAc[2][2], vAn[2][2];
#define PG8_SA(b, h) (((b) * 2 + (h)) * HTB)
#define PG8_SB(b, h) ((4 + (b) * 2 + (h)) * HTB)
#define PG8_STAGE(bufoff, gbase, voff) do { _Pragma("unroll") for (int _i = 0; _i < 2; ++_i) \
        __builtin_amdgcn_global_load_lds((const unsigned*)((const char*)(gbase) + (voff)[_i]), (LAS unsigned*)(lds + (bufoff) + ldsw + _i * 8192), 16, 0, 0); } while (0)
#define PG8_STAGE_A(bufoff, kptr, h, NXT) do { if constexpr (Prob::GATHER) { _Pragma("unroll") for (int _i = 0; _i < 2; ++_i) \
        __builtin_amdgcn_global_load_lds((const unsigned*)((const char*)(kptr) + ((NXT) ? vAn[h][_i] : vAc[h][_i])), (LAS unsigned*)(lds + (bufoff) + ldsw + _i * 8192), 16, 0, 0); } \
        else { PG8_STAGE(bufoff, (kptr) + (h) * hstepA, voffA); } } while (0)
#define PG8_GATHER_OFFS(dst, unit) do { _Pragma("unroll") for (int _i = 0; _i < 2; ++_i) { int _R, _C; stage_rc(tid * 16 + _i * 8192, _R, _C); _Pragma("unroll") for (int _h = 0; _h < 2; ++_h) dst[_h][_i] = P.rowoff(unit, _R + 128 * _h) + (unsigned)_C * 2u; } } while (0)
#define PG8_LDA(dst, b, h) do { _Pragma("unroll") for (int m = 0; m < 4; ++m) _Pragma("unroll") for (int k = 0; k < 2; ++k) dst[m][k] = *(const LAS bf16x8*)(lds + PG8_SA(b, h) + aoff + m * 2048 + k * 1024); } while (0)
#define PG8_LDB(dst, b, h) do { _Pragma("unroll") for (int n = 0; n < 2; ++n) _Pragma("unroll") for (int k = 0; k < 2; ++k) dst[n][k] = *(const LAS bf16x8*)(lds + PG8_SB(b, h) + boff + n * 2048 + k * 1024); } while (0)
#define PG8_MMA(ai, bj, At, Bt) do { __builtin_amdgcn_s_setprio(1); _Pragma("unroll") for (int m = 0; m < 4; ++m) _Pragma("unroll") for (int n = 0; n < 2; ++n) _Pragma("unroll") for (int k = 0; k < 2; ++k) \
        { if constexpr (Prob::F16) acc[ai][bj][m][n] = __builtin_amdgcn_mfma_f32_16x16x32_f16(__builtin_bit_cast(f16x8, Bt[n][k]), __builtin_bit_cast(f16x8, At[m][k]), acc[ai][bj][m][n], 0, 0, 0); \
          else acc[ai][bj][m][n] = __builtin_amdgcn_mfma_f32_16x16x32_bf16(Bt[n][k], At[m][k], acc[ai][bj][m][n], 0, 0, 0); } __builtin_amdgcn_s_setprio(0); } while (0)
#define PG8_WAIT_V(n) asm volatile("s_waitcnt vmcnt(" #n ")" ::: "memory")
#define PG8_WAIT_L(n) asm volatile("s_waitcnt lgkmcnt(" #n ")" ::: "memory")
#define PG8_BAR __builtin_amdgcn_s_barrier()
#define PG8_SCHED __builtin_amdgcn_sched_barrier(0)
#define PG8_AK(base, t) ((base) + (size_t)(t) * kstep + (((t) >= tsplit) ? adelta : 0ll))
    Unit cur, nxt; int ui = 0;
    if (!S.next(0, cur)) return;
    f32x4 acc[2][2][4][2];
#pragma unroll
    for (int a = 0; a < 2; ++a)
#pragma unroll
        for (int b = 0; b < 2; ++b)
#pragma unroll
            for (int m = 0; m < 4; ++m)
#pragma unroll
                for (int n = 0; n < 2; ++n) acc[a][b][m][n] = (f32x4){0.f, 0.f, 0.f, 0.f};
    bf16x8 At[4][2], B0[2][2], B1[2][2];
    const char* cA = P.aptr(cur); const char* cB = P.bptr(cur);
    if constexpr (Prob::GATHER) { PG8_GATHER_OFFS(vAc, cur); }
    PG8_STAGE(PG8_SB(0, 0), cB, voffB); PG8_STAGE(PG8_SB(0, 1), cB + hstepB, voffB); PG8_STAGE_A(PG8_SA(0, 0), cA, 0, false); PG8_STAGE_A(PG8_SA(0, 1), cA, 1, false);
    if (wr == 1) PG8_BAR;
    PG8_WAIT_V(2); PG8_BAR;
    PG8_STAGE(PG8_SB(1, 0), cB + kstep, voffB); PG8_STAGE_A(PG8_SA(1, 0), PG8_AK(cA, 1), 0, false); PG8_STAGE(PG8_SB(1, 1), cB + hstepB + kstep, voffB);
    PG8_WAIT_V(6); PG8_BAR;
    for (;;) {
        const bool has_next = S.next(ui + 1, nxt);
        const char* nA = has_next ? P.aptr(nxt) : cA; const char* nB = has_next ? P.bptr(nxt) : cB;
        if constexpr (Prob::GATHER) { if (has_next) { PG8_GATHER_OFFS(vAn, nxt); } else {
#pragma unroll
            for (int _h = 0; _h < 2; ++_h)
#pragma unroll
                for (int _i = 0; _i < 2; ++_i) vAn[_h][_i] = vAc[_h][_i]; } }
        for (int t = 0; t < nt; t += 2) {
            const bool last = (t == nt - 2);
            const char* a1 = PG8_AK(cA, t + 1);
            const char* a2 = last ? nA : PG8_AK(cA, t + 2); const char* b2 = last ? nB : cB + (size_t)(t + 2) * kstep;
            const char* a3 = last ? PG8_AK(nA, 1) : PG8_AK(cA, t + 3); const char* b3 = b2 + kstep;
            PG8_LDB(B0, 0, 0); PG8_LDB(B1, 0, 1); PG8_SCHED; PG8_LDA(At, 0, 0); PG8_STAGE_A(PG8_SA(1, 1), a1, 1, false);
            PG8_WAIT_V(8); PG8_WAIT_L(0); PG8_BAR; PG8_MMA(0, 0, At, B0); PG8_MMA(0, 1, At, B1); PG8_BAR; PG8_SCHED;
            PG8_LDA(At, 0, 1); PG8_STAGE(PG8_SB(0, 0), b2, voffB); PG8_STAGE(PG8_SB(0, 1), b2 + hstepB, voffB); PG8_STAGE_A(PG8_SA(0, 0), a2, 0, last);
            PG8_WAIT_V(8); PG8_WAIT_L(0); PG8_BAR; PG8_MMA(1, 0, At, B0); PG8_MMA(1, 1, At, B1); PG8_BAR; PG8_SCHED;
            PG8_LDB(B0, 1, 0); PG8_LDB(B1, 1, 1); PG8_SCHED; PG8_LDA(At, 1, 0); PG8_STAGE_A(PG8_SA(0, 1), a2, 1, last);
            PG8_WAIT_V(8); PG8_WAIT_L(0); PG8_BAR; PG8_MMA(0, 0, At, B0); PG8_MMA(0, 1, At, B1); PG8_BAR; PG8_SCHED;
            PG8_LDA(At, 1, 1); PG8_STAGE(PG8_SB(1, 0), b3, voffB); PG8_STAGE(PG8_SB(1, 1), b3 + hstepB, voffB); PG8_STAGE_A(PG8_SA(1, 0), a3, 0, last);
            PG8_WAIT_V(8); PG8_WAIT_L(0); PG8_BAR; PG8_MMA(1, 0, At, B0); PG8_MMA(1, 1, At, B1); PG8_BAR; PG8_SCHED;
        }
        if constexpr (ALIGN_EPI) { if (wr == 0) PG8_BAR; }
        { int te = threadIdx.x; asm volatile("" : "+v"(te));
          const int we = __builtin_amdgcn_readfirstlane(te >> 6), le = te & 63; E(acc, cur, we >> 2, we & 3, le & 15, le >> 4); }
        if (!has_next) break;
#pragma unroll
        for (int a = 0; a < 2; ++a)
#pragma unroll
            for (int b = 0; b < 2; ++b)
#pragma unroll
                for (int m = 0; m < 4; ++m)
#pragma unroll
                    for (int n = 0; n < 2; ++n) acc[a][b][m][n] = (f32x4){0.f, 0.f, 0.f, 0.f};
        cur = nxt; cA = nA; cB = nB; ++ui;
        if constexpr (Prob::GATHER) {
#pragma unroll
            for (int _h = 0; _h < 2; ++_h)
#pragma unroll
                for (int _i = 0; _i < 2; ++_i) vAc[_h][_i] = vAn[_h][_i]; }
        if constexpr (ALIGN_EPI) { if (wr == 1) PG8_BAR; }
    }
    PG8_WAIT_V(0);
    if constexpr (!ALIGN_EPI) { if (wr == 0) PG8_BAR; }
    PG8_BAR;
#undef PG8_SA
#undef PG8_SB
#undef PG8_STAGE
#undef PG8_STAGE_A
#undef PG8_GATHER_OFFS
#undef PG8_LDA
#undef PG8_LDB
#undef PG8_MMA
#undef PG8_WAIT_V
#undef PG8_WAIT_L
#undef PG8_BAR
#undef PG8_SCHED
#undef PG8_AK
}

struct ProbSimple : ProbBase {
    const char* A; const char* B;
    __device__ __forceinline__ const char* aptr(const Unit& u) const { return A + (size_t)u.pm * 256 * lda * 2; }
    __device__ __forceinline__ const char* bptr(const Unit& u) const { return B + (size_t)u.pn * 256 * ldb * 2; }
};
struct ProbSimpleF16 : ProbSimple { static constexpr bool F16 = true; };
struct ProbDown : ProbBase {
    static constexpr bool F16 = true;
    const char* A; const char* A2; const char* B; int split;
    __device__ __forceinline__ const char* aptr(const Unit& u) const { return (u.pm < split ? A : A2) + (size_t)u.pm * 256 * lda * 2; }
    __device__ __forceinline__ const char* bptr(const Unit& u) const { return B + (size_t)u.pn * 256 * ldb * 2; }
};
struct ProbPool : ProbBase {
    const char* A; const char* B;
    __device__ __forceinline__ const char* aptr(const Unit& u) const { return A + ((size_t)u.pm * 256 * 1024 + (size_t)u.pn * 256) * 2; }
    __device__ __forceinline__ const char* bptr(const Unit& u) const { return B + (size_t)u.pn * 65536 * 2; }
};
struct ProbScores : ProbBase {
    const char* A; const char* B;
    __device__ __forceinline__ const char* aptr(const Unit& u) const { return A + ((size_t)u.pm * 256 * 2048 + (size_t)u.pn * 512) * 2; }
    __device__ __forceinline__ const char* bptr(const Unit& u) const { return B + ((size_t)tile_batch(u.pm) * 256 * 2048 + (size_t)u.pn * 512) * 2; }
};
struct ProbVW : ProbBase {
    const char* A; const char* B;
    __device__ __forceinline__ const char* aptr(const Unit& u) const { return A + ((size_t)u.pm * 256 * 2048 + (size_t)(u.pn & 3) * 512) * 2; }
    __device__ __forceinline__ const char* bptr(const Unit& u) const { return B + ((size_t)(u.pn >> 2) * 256 * 2048 + (size_t)(u.pn & 3) * 512) * 2; }
};
struct ProbFin : ProbBase {
    const char* A; const char* B;
    __device__ __forceinline__ const char* aptr(const Unit& u) const { return A + (size_t)u.pm * 256 * 1024 * 2; }
    __device__ __forceinline__ const char* bptr(const Unit& u) const { return B + ((size_t)tile_batch(u.pm) * 2048 + (size_t)u.pn * 256) * 1024 * 2; }
};
struct ProbPV : ProbBase {
    const char* A; const char* B;
    __device__ __forceinline__ const char* aptr(const Unit& u) const { return A + ((size_t)u.pm * 256 * 1024 + (size_t)(u.pn >> 1) * 256) * 2; }
    __device__ __forceinline__ const char* bptr(const Unit& u) const { return B + ((size_t)tile_batch(u.pm) * 2048 + (size_t)u.pn * 256) * 256 * 2; }
};

__device__ __forceinline__ u32x4 pack8(const f32x4& v0, const f32x4& v1) { u32x4 w; w.x = cvt_pk_bf16(v0[0], v0[1]); w.y = cvt_pk_bf16(v0[2], v0[3]); w.z = cvt_pk_bf16(v1[0], v1[1]); w.w = cvt_pk_bf16(v1[2], v1[3]); return w; }
__device__ __forceinline__ float sumsq4(const f32x4& x) { return (x[0] * x[0] + x[1] * x[1]) + (x[2] * x[2] + x[3] * x[3]); }
__device__ __forceinline__ float sum4(const f32x4& x) { return (x[0] + x[1]) + (x[2] + x[3]); }
__device__ __forceinline__ float red_fq(float s) { s += __shfl_xor(s, 16); s += __shfl_xor(s, 32); return s; }

struct EpiIn {
    static constexpr bool PERM = true;
    bf16_t* base; size_t spl; const unsigned* csT; const float* gq; const float* gk; const rss_t* rowss;
    __device__ __forceinline__ void operator()(const f32x4 (&acc)[2][2][4][2], const Unit& u, int wr, int wc, int fr, int fq) const {
        typedef _Float16 h2 __attribute__((ext_vector_type(2)));
        const int t = u.pn >> 2; bf16_t* O = base + (size_t)t * spl; const int colt = (u.pn & 3) * 256; const int row0 = u.pm * BM + wr * 64 + fr;
        if (t >= 2) {
            const int col0 = colt + wc * 32 + 8 * fq;
#pragma unroll
            for (int ai = 0; ai < 2; ++ai) { rss_t rx[4];
#pragma unroll
                for (int m = 0; m < 4; ++m) rx[m] = rowss[row0 + ai * HALF + m * 16];
#pragma unroll
                for (int m = 0; m < 4; ++m) { const float rxm = ss_rstd(rx[m]); bf16_t* rowp = O + (size_t)(row0 + ai * HALF + m * 16) * 1024 + col0;
#pragma unroll
                    for (int bj = 0; bj < 2; ++bj) *(u32x4*)(rowp + bj * HALF) = pack8(acc[ai][bj][m][0] * rxm, acc[ai][bj][m][1] * rxm); }
                asm volatile("" ::: "memory"); }
        } else {
            const float* g = t ? gk : gq; f32x4 g1[2], g2[2];
#pragma unroll
            for (int n = 0; n < 2; ++n) { g1[n] = *(const f32x4*)(g + 8 * fq + 4 * n); g2[n] = *(const f32x4*)(g + 32 + 8 * fq + 4 * n); }
            const int col0 = colt + 64 * wc + 8 * fq;
#pragma unroll
            for (int ah = 0; ah < 4; ++ah) { const int ai = ah >> 1, mb = (ah & 1) * 2;
                u32x4 cs[2][2]; rss_t rx[2];
#pragma unroll
                for (int mm = 0; mm < 2; ++mm) { const int m = mb + mm; const int pos = tok_pos(row0 + ai * HALF + m * 16); rx[mm] = rowss[row0 + ai * HALF + m * 16];
#pragma unroll
                    for (int n = 0; n < 2; ++n) cs[mm][n] = *(const u32x4*)(csT + pos * 32 + 8 * fq + 4 * n); }
#pragma unroll
                for (int mm = 0; mm < 2; ++mm) { const int m = mb + mm; const int row = row0 + ai * HALF + m * 16;
                    float ss = (sumsq4(acc[ai][0][m][0]) + sumsq4(acc[ai][0][m][1])) + (sumsq4(acc[ai][1][m][0]) + sumsq4(acc[ai][1][m][1]));
                    ss = red_fq(ss);
                    const float rxm = ss_rstd(rx[mm]);
                    const float r = __builtin_amdgcn_rsqf(ss * rxm * rxm * (1.0f / 64.0f) + EPS) * rxm * (t ? 1.0f : QSCALE);
                    f32x4 o1[2], o2[2];
#pragma unroll
                    for (int n = 0; n < 2; ++n) { f32x4 c, s;
#pragma unroll
                        for (int j = 0; j < 4; ++j) { const unsigned w = cs[mm][n][j]; const h2 v = __builtin_bit_cast(h2, w); c[j] = (float)v.x; s[j] = (float)v.y; }
                        const f32x4 x1 = acc[ai][0][m][n] * r * g1[n], x2 = acc[ai][1][m][n] * r * g2[n];
                        o1[n] = x1 * c - x2 * s; o2[n] = x2 * c + x1 * s; }
                    bf16_t* rowp = O + (size_t)row * 1024 + col0;
                    *(u32x4*)(rowp) = pack8(o1[0], o1[1]); *(u32x4*)(rowp + 32) = pack8(o2[0], o2[1]); }
                asm volatile("" ::: "memory"); }
        }
    }
};
template <int MODE> struct EpiBf {
    static constexpr bool PERM = true;
    bf16_t* O; int ldc; float* aux; float* aux2; LAS float* xl;
    __device__ __forceinline__ void operator()(f32x4 (&acc)[2][2][4][2], const Unit& u, int wr, int wc, int fr, int fq) const {
        const int row0 = u.pm * BM + wr * 64 + fr; const int col0 = u.pn * BM + wc * 32 + 8 * fq;
        float rs[2][4];
        if constexpr (MODE == 2) {
            f32x4 qa[2][4][2];
#pragma unroll
            for (int ai = 0; ai < 2; ++ai)
#pragma unroll
                for (int m = 0; m < 4; ++m) { const float* p = aux + (size_t)(row0 + ai * HALF + m * 16) * 32 + u.pn * 8; qa[ai][m][0] = *(const f32x4*)p; qa[ai][m][1] = *(const f32x4*)(p + 4); }
#pragma unroll
            for (int ai = 0; ai < 2; ++ai)
#pragma unroll
                for (int m = 0; m < 4; ++m) { const float sc = __builtin_amdgcn_rsqf((sum4(qa[ai][m][0]) + sum4(qa[ai][m][1])) * (1.0f / 512.0f) + EPS) * (0.044194173824159216f * 1.4426950408889634f); float ps = 0.f;
#pragma unroll
                    for (int bj = 0; bj < 2; ++bj)
#pragma unroll
                        for (int n = 0; n < 2; ++n) { f32x4 p;
#pragma unroll
                            for (int j = 0; j < 4; ++j) p[j] = __builtin_amdgcn_exp2f(acc[ai][bj][m][n][j] * sc);
                            acc[ai][bj][m][n] = p; ps += sum4(p); }
                    ps = red_fq(ps);
                    if (fq == 0) xl[(ai * HALF + wr * 64 + m * 16 + fr) * 4 + wc] = ps; }
            asm volatile("s_waitcnt lgkmcnt(0)" ::: "memory"); __builtin_amdgcn_s_barrier(); asm volatile("" ::: "memory");
#pragma unroll
            for (int ai = 0; ai < 2; ++ai)
#pragma unroll
                for (int m = 0; m < 4; ++m) { const f32x4 lv = *(const LAS f32x4*)(xl + (ai * HALF + wr * 64 + m * 16 + fr) * 4); rs[ai][m] = __builtin_amdgcn_rcpf(sum4(lv)); }
        }
        if constexpr (MODE == 1 || MODE == 4) { rss_t rv[2][4];
#pragma unroll
            for (int ai = 0; ai < 2; ++ai)
#pragma unroll
                for (int m = 0; m < 4; ++m) rv[ai][m] = ((const rss_t*)aux2)[row0 + ai * HALF + m * 16];
#pragma unroll
            for (int ai = 0; ai < 2; ++ai)
#pragma unroll
                for (int m = 0; m < 4; ++m) rs[ai][m] = ss_rstd(rv[ai][m]);
        }
        if constexpr (MODE == 3) {
            f32x4 la[2][4];
#pragma unroll
            for (int ai = 0; ai < 2; ++ai)
#pragma unroll
                for (int m = 0; m < 4; ++m) la[ai][m] = *(const f32x4*)(aux2 + (size_t)(row0 + ai * HALF + m * 16) * 16 + (u.pn >> 1) * 4);
#pragma unroll
            for (int ai = 0; ai < 2; ++ai)
#pragma unroll
                for (int m = 0; m < 4; ++m) rs[ai][m] = __builtin_amdgcn_rcpf(sum4(la[ai][m]));
        }
        bf16_t* Ob = O; int colb = col0;
        if constexpr (MODE == 5) { Ob = O + (size_t)(u.pn >> 2) * 2048 * 1024; colb = (u.pn & 3) * 256 + wc * 32 + 8 * fq; }
#pragma unroll
        for (int ai = 0; ai < 2; ++ai)
#pragma unroll
            for (int m = 0; m < 4; ++m) { const int row = row0 + ai * HALF + m * 16; bf16_t* rowp = Ob + (size_t)row * ldc + colb;
                if constexpr (MODE == 0 || MODE == 5) {
#pragma unroll
                    for (int bj = 0; bj < 2; ++bj) *(u32x4*)(rowp + bj * HALF) = pack8(acc[ai][bj][m][0], acc[ai][bj][m][1]);
                } else if constexpr (MODE == 1) {
                    float ss = (sumsq4(acc[ai][0][m][0]) + sumsq4(acc[ai][0][m][1])) + (sumsq4(acc[ai][1][m][0]) + sumsq4(acc[ai][1][m][1]));
                    ss = red_fq(ss); const float rxx = rs[ai][m];
                    if (fq == 0) aux[(size_t)row * 32 + u.pn * 4 + wc] = ss * rxx * rxx;
#pragma unroll
                    for (int bj = 0; bj < 2; ++bj) *(u32x4*)(rowp + bj * HALF) = pack8(acc[ai][bj][m][0] * rxx, acc[ai][bj][m][1] * rxx);
                } else {
                    const float rxx = rs[ai][m];
#pragma unroll
                    for (int bj = 0; bj < 2; ++bj) *(u32x4*)(rowp + bj * HALF) = pack8(acc[ai][bj][m][0] * rxx, acc[ai][bj][m][1] * rxx);
                }
            }
    }
};
struct EpiRes {
    static constexpr bool PERM = true;
    bf16_t* XB; rss_t* rowss; float* OUT;
    __device__ __forceinline__ void load_half(u32x4 (&t)[4][2], int row0, int col0, int ai) const {
#pragma unroll
        for (int m = 0; m < 4; ++m) { const bf16_t* rowb = XB + (size_t)(row0 + ai * HALF + m * 16) * D_MODEL + col0;
#pragma unroll
            for (int bj = 0; bj < 2; ++bj) t[m][bj] = *(const u32x4*)(rowb + bj * HALF); }
    }
    __device__ __forceinline__ void add_half(f32x4 (&acc)[2][2][4][2], const u32x4 (&t)[4][2], int ai) const {
#pragma unroll
        for (int m = 0; m < 4; ++m)
#pragma unroll
            for (int bj = 0; bj < 2; ++bj) { const u32x4 w = t[m][bj];
#define ADDS_(d, x) asm("v_add_f32 %0, %1, %0" : "+v"(d) : "v"(x))
                ADDS_(acc[ai][bj][m][0][0], bflo(w.x)); ADDS_(acc[ai][bj][m][0][1], bfhi(w.x)); ADDS_(acc[ai][bj][m][0][2], bflo(w.y)); ADDS_(acc[ai][bj][m][0][3], bfhi(w.y));
                ADDS_(acc[ai][bj][m][1][0], bflo(w.z)); ADDS_(acc[ai][bj][m][1][1], bfhi(w.z)); ADDS_(acc[ai][bj][m][1][2], bflo(w.w)); ADDS_(acc[ai][bj][m][1][3], bfhi(w.w));
#undef ADDS_
            }
    }
    __device__ __forceinline__ void store_half(const f32x4 (&acc)[2][2][4][2], int row0, int col0, int ai, int fq) const {
#pragma unroll
        for (int m = 0; m < 4; ++m) { const int row = row0 + ai * HALF + m * 16; bf16_t* rowb = XB + (size_t)row * D_MODEL + col0; float ss = 0.f;
#pragma unroll
            for (int bj = 0; bj < 2; ++bj) { const f32x4 v0 = acc[ai][bj][m][0], v1 = acc[ai][bj][m][1];
                if (OUT) { float* rowp = OUT + (size_t)row * D_MODEL + col0 + bj * HALF; *(f32x4*)rowp = v0; *(f32x4*)(rowp + 4) = v1; }
                else { *(u32x4*)(rowb + bj * HALF) = pack8(v0, v1); ss += sumsq4(v0) + sumsq4(v1); } }
            if (rowss) { ss = red_fq(ss); if (fq == 0) atomicAdd(rowss + row, ss_fix(ss)); } }
    }
    __device__ __forceinline__ void operator()(f32x4 (&acc)[2][2][4][2], const Unit& u, int wr, int wc, int fr, int fq) const {
        const int row0 = u.pm * BM + wr * 64 + fr, col0 = u.pn * BM + wc * 32 + 8 * fq;
        u32x4 t[4][2];
        load_half(t, row0, col0, 0);
        add_half(acc, t, 0);
        asm volatile("" : "+v"(acc[0][0][0][0]), "+v"(acc[0][1][3][1]));
        load_half(t, row0, col0, 1);
        asm volatile("" ::: "memory");
        store_half(acc, row0, col0, 0, fq);
        add_half(acc, t, 1);
        store_half(acc, row0, col0, 1, fq);
    }
};
__device__ __forceinline__ int ffn_tile_row(int pm, int R, int chunk, bool& valid) {
    R = (R & ~63) | ((R & 15) << 2) | ((R >> 4) & 3);
    valid = true; (void)chunk; return pm * 256 + R;
}
struct ProbUp : ProbBase {
    static constexpr bool GATHER = true;
    const char* A; const char* B; int chunk;
    __device__ __forceinline__ const char* aptr(const Unit&) const { return A; }
    __device__ __forceinline__ const char* bptr(const Unit& u) const { return B + (size_t)u.pn * 256 * ldb * 2; }
    __device__ __forceinline__ unsigned rowoff(const Unit& u, int R) const { bool v; return (unsigned)ffn_tile_row(u.pm, R, chunk, v) * (unsigned)(lda * 2); }
};
__device__ __forceinline__ float dpp_ror1(float v) { return __builtin_bit_cast(float, __builtin_amdgcn_update_dpp(0, __builtin_bit_cast(int, v), 0x121, 0xf, 0xf, false)); }
__device__ __forceinline__ float dpp_ror15(float v) { return __builtin_bit_cast(float, __builtin_amdgcn_update_dpp(0, __builtin_bit_cast(int, v), 0x12F, 0xf, 0xf, false)); }
__device__ __forceinline__ h2_t u2h(unsigned u) { return __builtin_bit_cast(h2_t, u); }
__device__ __forceinline__ unsigned h2u(h2_t h) { return __builtin_bit_cast(unsigned, h); }
__device__ __forceinline__ unsigned dppu_ror1(unsigned v) { return (unsigned)__builtin_amdgcn_update_dpp(0, (int)v, 0x121, 0xf, 0xf, false); }
__device__ __forceinline__ unsigned dppu_ror15(unsigned v) { return (unsigned)__builtin_amdgcn_update_dpp(0, (int)v, 0x12F, 0xf, 0xf, false); }
#define H2X4_TRANS(OP, a, b, c, d) asm(OP " %0, %0 dst_sel:WORD_0 dst_unused:UNUSED_PRESERVE src0_sel:WORD_0\n\t" OP " %1, %1 dst_sel:WORD_0 dst_unused:UNUSED_PRESERVE src0_sel:WORD_0\n\t" \
    OP " %2, %2 dst_sel:WORD_0 dst_unused:UNUSED_PRESERVE src0_sel:WORD_0\n\t" OP " %3, %3 dst_sel:WORD_0 dst_unused:UNUSED_PRESERVE src0_sel:WORD_0\n\t"                                  \
    OP " %0, %0 dst_sel:WORD_1 dst_unused:UNUSED_PRESERVE src0_sel:WORD_1\n\t" OP " %1, %1 dst_sel:WORD_1 dst_unused:UNUSED_PRESERVE src0_sel:WORD_1\n\t"                                  \
    OP " %2, %2 dst_sel:WORD_1 dst_unused:UNUSED_PRESERVE src0_sel:WORD_1\n\t" OP " %3, %3 dst_sel:WORD_1 dst_unused:UNUSED_PRESERVE src0_sel:WORD_1\n\ts_nop 0" : "+v"(a), "+v"(b), "+v"(c), "+v"(d))
struct EpiGlu {
    static constexpr bool PERM = true;
    bf16_t* G; const rss_t* rowss; const u32x4* cwt; int chunk; LAS float* xl; bf16_t* EB; bf16_t* G2; int gsplit;
    __device__ __forceinline__ void operator()(f32x4 (&acc)[2][2][4][2], const Unit& u, int wr, int wc, int fr, int fq) const {
        const int ch0 = u.pn * 128 + wc * 32 + 8 * fq;
        const int tidw = (wr * 4 + wc) * 64 + fq * 16 + fr; LAS unsigned char* wl = (LAS unsigned char*)xl + 12288; LAS unsigned* xu = (LAS unsigned*)xl;
        u32x4 wrec = (u32x4){0u, 0u, 0u, 0u}; if (tidw < 128) wrec = cwt[u.pn * 128 + tidw];
        int rowi[2][4]; unsigned stmask = 0u; unsigned hh[2][2][4][4];
        { rss_t rv[2][4];
#pragma unroll
          for (int ai = 0; ai < 2; ++ai)
#pragma unroll
            for (int m = 0; m < 4; ++m) { const int RL = ai * HALF + wr * 64 + 4 * fr + m; bool valid; const int row = ffn_tile_row(u.pm, ai * HALF + wr * 64 + m * 16 + fr, chunk, valid); rowi[ai][m] = row; rv[ai][m] = rowss[row];
                const int gt = chunk * FFN_CHUNK + row, pos = tok_pos(gt), S = tok_seqlen(gt);
                const bool st = !((RL == 0 && pos != 0) || (RL == 255 && pos != S - 1)); (void)valid;
                stmask |= st ? (1u << (ai * 4 + m)) : 0u; }
#pragma unroll
          for (int ai = 0; ai < 2; ++ai)
#pragma unroll
            for (int m = 0; m < 4; ++m) { const float rx = ss_rstd(rv[ai][m]); const h2_t r2 = {(_Float16)rx, (_Float16)rx};
#pragma unroll
                for (int bj = 0; bj < 2; ++bj)
#pragma unroll
                    for (int n = 0; n < 2; ++n)
#pragma unroll
                        for (int jp = 0; jp < 2; ++jp) hh[ai][bj][m][2 * n + jp] = h2u(__builtin_bit_cast(h2_t, __builtin_amdgcn_cvt_pkrtz(acc[ai][bj][m][n][2 * jp], acc[ai][bj][m][n][2 * jp + 1])) * r2); } }
        if (wr == 0 && fr == 0) {
#pragma unroll
            for (int m = 0; m < 2; ++m)
#pragma unroll
                for (int bj = 0; bj < 2; ++bj) *(u32x4*)(EB + (size_t)(u.pm * 4 + m) * UP_W + bj * D_FF + ch0) = (u32x4){hh[0][bj][m][0], hh[0][bj][m][1], hh[0][bj][m][2], hh[0][bj][m][3]}; }
        if (wr == 1 && fr == 15) {
#pragma unroll
            for (int m = 2; m < 4; ++m)
#pragma unroll
                for (int bj = 0; bj < 2; ++bj) *(u32x4*)(EB + (size_t)(u.pm * 4 + m) * UP_W + bj * D_FF + ch0) = (u32x4){hh[1][bj][m][0], hh[1][bj][m][1], hh[1][bj][m][2], hh[1][bj][m][3]}; }
#pragma unroll
        for (int ai = 0; ai < 2; ++ai) { const int s1 = 2 * ai + wr + 1;
            if (fr == 0) {
#pragma unroll
                for (int bj = 0; bj < 2; ++bj) *(LAS u32x4*)(xu + ((s1 * 2 + 0) * 4 + wc) * 32 + bj * 16 + 4 * fq) = (u32x4){hh[ai][bj][0][0], hh[ai][bj][0][1], hh[ai][bj][0][2], hh[ai][bj][0][3]}; }
            if (fr == 15) {
#pragma unroll
                for (int bj = 0; bj < 2; ++bj) *(LAS u32x4*)(xu + ((s1 * 2 + 1) * 4 + wc) * 32 + bj * 16 + 4 * fq) = (u32x4){hh[ai][bj][3][0], hh[ai][bj][3][1], hh[ai][bj][3][2], hh[ai][bj][3][3]}; } }
        if (tidw < 128) *(LAS u32x4*)(wl + tidw * 16) = wrec;
        asm volatile("s_waitcnt lgkmcnt(0)" ::: "memory"); __builtin_amdgcn_s_barrier(); asm volatile("" ::: "memory");
        const h2_t c1 = {(_Float16)-0.10294324f, (_Float16)-0.10294324f}, c0 = {(_Float16)-2.3022082f, (_Float16)-2.3022082f}, one = {(_Float16)1.0f, (_Float16)1.0f};
        unsigned wq[2][2][4][2];
#pragma unroll
        for (int n = 0; n < 2; ++n) { unsigned (&wp)[2][4][2] = wq[n];
#pragma unroll
            for (int jp = 0; jp < 2; ++jp) { const int q = 2 * n + jp;
                const u32x4 wg = *(const LAS u32x4*)(wl + (wc * 16 + 4 * fq + q) * 32), wv = *(const LAS u32x4*)(wl + (wc * 16 + 4 * fq + q) * 32 + 16);
#pragma unroll
                for (int ai = 0; ai < 2; ++ai) { const int s1 = 2 * ai + wr + 1; h2_t cg[4], cv[4];
                    const LAS unsigned* xp = xu + (((s1 - 1) * 2 + 1) * 4 + wc) * 32 + 4 * fq + q; const LAS unsigned* xn = xu + (((s1 + 1) * 2 + 0) * 4 + wc) * 32 + 4 * fq + q;
                    { const unsigned pe = xp[0], ne = xn[0]; const unsigned r3 = dppu_ror1(hh[ai][0][3][q]), l0 = dppu_ror15(hh[ai][0][0][q]);
                      const h2_t w0 = u2h(wg.x), w1 = u2h(wg.y), w2 = u2h(wg.z), wb = u2h(wg.w);
#pragma unroll
                      for (int m = 0; m < 4; ++m) { const unsigned pv = m ? hh[ai][0][m ? m - 1 : 0][q] : (fr == 0 ? pe : r3), nx = m < 3 ? hh[ai][0][m < 3 ? m + 1 : 3][q] : (fr == 15 ? ne : l0);
                          cg[m] = wb + w0 * u2h(pv) + w1 * u2h(hh[ai][0][m][q]) + w2 * u2h(nx); } }
                    { const unsigned pe = xp[16], ne = xn[16]; const unsigned r3 = dppu_ror1(hh[ai][1][3][q]), l0 = dppu_ror15(hh[ai][1][0][q]);
                      const h2_t w0 = u2h(wv.x), w1 = u2h(wv.y), w2 = u2h(wv.z), wb = u2h(wv.w);
#pragma unroll
                      for (int m = 0; m < 4; ++m) { const unsigned pv = m ? hh[ai][1][m ? m - 1 : 0][q] : (fr == 0 ? pe : r3), nx = m < 3 ? hh[ai][1][m < 3 ? m + 1 : 3][q] : (fr == 15 ? ne : l0);
                          cv[m] = wb + w0 * u2h(pv) + w1 * u2h(hh[ai][1][m][q]) + w2 * u2h(nx); } }
                    unsigned e0 = h2u(cg[0] * (cg[0] * cg[0] * c1 + c0)), e1 = h2u(cg[1] * (cg[1] * cg[1] * c1 + c0)), e2 = h2u(cg[2] * (cg[2] * cg[2] * c1 + c0)), e3 = h2u(cg[3] * (cg[3] * cg[3] * c1 + c0));
                    H2X4_TRANS("v_exp_f16_sdwa", e0, e1, e2, e3);
                    e0 = h2u(u2h(e0) + one); e1 = h2u(u2h(e1) + one); e2 = h2u(u2h(e2) + one); e3 = h2u(u2h(e3) + one);
                    H2X4_TRANS("v_rcp_f16_sdwa", e0, e1, e2, e3);
                    wp[ai][0][jp] = h2u(cg[0] * u2h(e0) * cv[0]); wp[ai][1][jp] = h2u(cg[1] * u2h(e1) * cv[1]); wp[ai][2][jp] = h2u(cg[2] * u2h(e2) * cv[2]); wp[ai][3][jp] = h2u(cg[3] * u2h(e3) * cv[3]);
                    asm volatile("" : "+v"(wp[ai][0][jp]), "+v"(wp[ai][1][jp]), "+v"(wp[ai][2][jp]), "+v"(wp[ai][3][jp])); } }
            asm volatile("" ::: "memory"); }
#pragma unroll
        for (int ai = 0; ai < 2; ++ai)
#pragma unroll
            for (int m = 0; m < 4; ++m) { const u32x4 q = {wq[0][ai][m][0], wq[0][ai][m][1], wq[1][ai][m][0], wq[1][ai][m][1]}; if (stmask & (1u << (ai * 4 + m))) *(u32x4*)((u.pm < gsplit ? G : G2) + (size_t)rowi[ai][m] * D_FF + ch0) = q; }
    }
};
__device__ __forceinline__ void ffn_fix_item(const bf16_t* EB, const u32x4* cwt, bf16_t* G, bf16_t* G2, int gsplit_row, int t, int cb, int lane) {
    const int ti = (t >> 8) - 1, ch = cb * 512 + lane * 8;
    const bf16_t* ea = EB + (size_t)(ti * 4 + 2) * UP_W + ch; const bf16_t* ec = EB + (size_t)((ti + 1) * 4) * UP_W + ch;
    u32x4 ug[4], uv[4], w[8];
    ug[0] = *(const u32x4*)ea; uv[0] = *(const u32x4*)(ea + D_FF); ug[1] = *(const u32x4*)(ea + UP_W); uv[1] = *(const u32x4*)(ea + UP_W + D_FF);
    ug[2] = *(const u32x4*)ec; uv[2] = *(const u32x4*)(ec + D_FF); ug[3] = *(const u32x4*)(ec + UP_W); uv[3] = *(const u32x4*)(ec + UP_W + D_FF);
#pragma unroll
    for (int k = 0; k < 8; ++k) w[k] = cwt[(ch >> 1) * 2 + k];
    const h2_t c1 = {(_Float16)-0.10294324f, (_Float16)-0.10294324f}, c0 = {(_Float16)-2.3022082f, (_Float16)-2.3022082f}, one = {(_Float16)1.0f, (_Float16)1.0f};
    u32x4 oa, ob;
#pragma unroll
    for (int qp = 0; qp < 2; ++qp) { h2_t cg[4], cv[4];
#pragma unroll
        for (int qq = 0; qq < 2; ++qq) { const int q = 2 * qp + qq; const u32x4 wg = w[2 * q], wv = w[2 * q + 1];
            cg[2 * qq + 0] = u2h(wg.w) + u2h(wg.x) * u2h(ug[0][q]) + u2h(wg.y) * u2h(ug[1][q]) + u2h(wg.z) * u2h(ug[2][q]);
            cg[2 * qq + 1] = u2h(wg.w) + u2h(wg.x) * u2h(ug[1][q]) + u2h(wg.y) * u2h(ug[2][q]) + u2h(wg.z) * u2h(ug[3][q]);
            cv[2 * qq + 0] = u2h(wv.w) + u2h(wv.x) * u2h(uv[0][q]) + u2h(wv.y) * u2h(uv[1][q]) + u2h(wv.z) * u2h(uv[2][q]);
            cv[2 * qq + 1] = u2h(wv.w) + u2h(wv.x) * u2h(uv[1][q]) + u2h(wv.y) * u2h(uv[2][q]) + u2h(wv.z) * u2h(uv[3][q]); }
        unsigned e0 = h2u(cg[0] * (cg[0] * cg[0] * c1 + c0)), e1 = h2u(cg[1] * (cg[1] * cg[1] * c1 + c0)), e2 = h2u(cg[2] * (cg[2] * cg[2] * c1 + c0)), e3 = h2u(cg[3] * (cg[3] * cg[3] * c1 + c0));
        H2X4_TRANS("v_exp_f16_sdwa", e0, e1, e2, e3);
        e0 = h2u(u2h(e0) + one); e1 = h2u(u2h(e1) + one); e2 = h2u(u2h(e2) + one); e3 = h2u(u2h(e3) + one);
        H2X4_TRANS("v_rcp_f16_sdwa", e0, e1, e2, e3);
        oa[2 * qp] = h2u(cg[0] * u2h(e0) * cv[0]); ob[2 * qp] = h2u(cg[1] * u2h(e1) * cv[1]); oa[2 * qp + 1] = h2u(cg[2] * u2h(e2) * cv[2]); ob[2 * qp + 1] = h2u(cg[3] * u2h(e3) * cv[3]); }
    *(u32x4*)((t - 1 < gsplit_row ? G : G2) + (size_t)(t - 1) * D_FF + ch) = oa; *(u32x4*)((t < gsplit_row ? G : G2) + (size_t)t * D_FF + ch) = ob;
}
struct EpiKV {
    static constexpr bool PERM = false;
    float* kraw; bf16_t* vT;
    __device__ __forceinline__ void operator()(const f32x4 (&acc)[2][2][4][2], const Unit& u, int wr, int wc, int fr, int fq) const {
        const int key0 = wr * 64 + fr, col0 = u.pn * BM + wc * 32 + 4 * fq;
        if (u.pn < 8) {
#pragma unroll
            for (int ai = 0; ai < 2; ++ai)
#pragma unroll
                for (int m = 0; m < 4; ++m) { float* rowp = kraw + (size_t)(u.pm * BM + key0 + ai * HALF + m * 16) * 2048 + col0;
#pragma unroll
                    for (int bj = 0; bj < 2; ++bj)
#pragma unroll
                        for (int n = 0; n < 2; ++n) *(f32x4*)(rowp + bj * HALF + n * 16) = acc[ai][bj][m][n]; }
        } else {
#pragma unroll
            for (int ai = 0; ai < 2; ++ai)
#pragma unroll
                for (int m = 0; m < 4; ++m) { bf16_t* rowp = vT + (size_t)(u.pm * BM + key0 + ai * HALF + m * 16) * 2048 + (col0 - 2048);
#pragma unroll
                    for (int bj = 0; bj < 2; ++bj)
#pragma unroll
                        for (int n = 0; n < 2; ++n) { const f32x4 v = acc[ai][bj][m][n]; u32x2 w; w.x = cvt_pk_bf16(v[0], v[1]); w.y = cvt_pk_bf16(v[2], v[3]); *(u32x2*)(rowp + bj * HALF + n * 16) = w; } }
        }
    }
};
}

namespace att {
constexpr int KVBLK = 64, SHM_V = 16384, SHM_K = 16384, OFF_V = 0, OFF_K = 3 * SHM_V, OFF_WS = 3 * SHM_V + 3 * SHM_K, LDP = 1024;
#define KSWZ(row, colB) ((row) * 256 + ((colB) ^ (((row) & 15) << 4)))
#define SBAR() __builtin_amdgcn_sched_barrier(0)
__device__ __forceinline__ int crow(int r, int hi) { return (r & 3) + 8 * (r >> 2) + 4 * hi; }
__device__ __forceinline__ void partialSM(f32x16& p0) {
#pragma unroll
  for (int r = 0; r < 16; ++r) p0[r] = __builtin_amdgcn_exp2f(p0[r]);
}
__device__ __forceinline__ void finishSM(f32x16& p0, f32x16& p1, float& l_reg, bf16x8& pa0, bf16x8& pa1, bf16x8& pa2, bf16x8& pa3) {
#pragma unroll
  for (int r = 0; r < 16; ++r) p1[r] = __builtin_amdgcn_exp2f(p1[r]);
  float ps = 0;
#pragma unroll
  for (int r = 0; r < 16; ++r) ps += p0[r];
#pragma unroll
  for (int r = 0; r < 16; ++r) ps += p1[r];
  l_reg += ps;
#define PK4(P, BASE, OUT) do { unsigned a0 = cvt_pk_bf16(P[BASE + 0], P[BASE + 1]), a1 = cvt_pk_bf16(P[BASE + 2], P[BASE + 3]);   \
    unsigned b0 = cvt_pk_bf16(P[BASE + 4], P[BASE + 5]), b1 = cvt_pk_bf16(P[BASE + 6], P[BASE + 7]);                              \
    auto r0 = __builtin_amdgcn_permlane32_swap(a0, b0, false, false); auto r1 = __builtin_amdgcn_permlane32_swap(a1, b1, false, false); \
    u32x4 w = {r0[0], r1[0], r0[1], r1[1]}; OUT = __builtin_bit_cast(bf16x8, w); } while (0)
  PK4(p0, 0, pa0); PK4(p0, 8, pa1); PK4(p1, 0, pa2); PK4(p1, 8, pa3);
#undef PK4
}
__device__ __forceinline__ void finishSM_tail(f32x16& p0, f32x16& p1, float& l_reg, bf16x8& pa0, bf16x8& pa1, bf16x8& pa2, bf16x8& pa3) {
  float ps = 0;
#pragma unroll
  for (int r = 0; r < 16; ++r) ps += p0[r];
#pragma unroll
  for (int r = 0; r < 16; ++r) ps += p1[r];
  l_reg += ps;
#define PK4(P, BASE, OUT) do { unsigned a0 = cvt_pk_bf16(P[BASE + 0], P[BASE + 1]), a1 = cvt_pk_bf16(P[BASE + 2], P[BASE + 3]);   \
    unsigned b0 = cvt_pk_bf16(P[BASE + 4], P[BASE + 5]), b1 = cvt_pk_bf16(P[BASE + 6], P[BASE + 7]);                              \
    u32x4 w = {a0, a1, b0, b1}; OUT = __builtin_bit_cast(bf16x8, w); } while (0)
  PK4(p0, 0, pa0); PK4(p0, 8, pa1); PK4(p1, 0, pa2); PK4(p1, 8, pa3);
#undef PK4
}
__device__ __forceinline__ void qkt(f32x16& p0, f32x16& p1, const LAS unsigned char* Ks, const bf16x8* qr, int r32, int hi, int cbase) {
  p0 = f32x16{}; p1 = f32x16{}; bf16x8 b0[4], b1[4];
#pragma unroll
  for (int d0 = 0; d0 < 4; ++d0) { const int cb = cbase + (d0 * 16 + hi * 8) * 2;
    b0[d0] = *(const LAS bf16x8*)(Ks + KSWZ(r32, cb)); b1[d0] = *(const LAS bf16x8*)(Ks + KSWZ(32 + r32, cb)); }
#define QK_STEP(D, N) do { asm volatile("s_waitcnt lgkmcnt(" #N ")" ::: "memory"); SBAR(); \
    p0 = __builtin_amdgcn_mfma_f32_32x32x16_bf16(b0[D], qr[D], p0, 0, 0, 0); p1 = __builtin_amdgcn_mfma_f32_32x32x16_bf16(b1[D], qr[D], p1, 0, 0, 0); } while (0)
  QK_STEP(0, 6); QK_STEP(1, 4); QK_STEP(2, 2); QK_STEP(3, 0);
#undef QK_STEP
}
__device__ __forceinline__ int v_st(int k, int c) { const int kk = k; return ((kk >> 3) * 4 + (c >> 5)) * 512 + ((kk & 7) * 32 + (c & 31)) * 2; }
__device__ __forceinline__ int v_rd_base(int lane) { return ((lane & 3) << 3) | (((lane >> 2) & 3) << 6) | (((lane >> 4) & 1) << 5) | (((lane >> 5) & 1) << 8); }
constexpr int v_rd_off(int d0, int ks, int half) { return d0 * 512 + ks * 4096 + half * 2048; }
template <int OFF> __device__ __forceinline__ s16x4 tr_read(int vb) {
  s16x4 r; asm volatile("ds_read_b64_tr_b16 %0, %1 offset:%2" : "=&v"(r) : "v"(vb), "i"(OFF) : "memory"); return r;
}
struct VFrag { s16x4 l0, h0, l1, h1, l2, h2, l3, h3; };
template <int D0> __device__ __forceinline__ void pv_read(VFrag& f, int vb) {
  f.l0 = tr_read<v_rd_off(D0, 0, 0)>(vb); f.h0 = tr_read<v_rd_off(D0, 0, 1)>(vb); f.l1 = tr_read<v_rd_off(D0, 1, 0)>(vb); f.h1 = tr_read<v_rd_off(D0, 1, 1)>(vb);
  f.l2 = tr_read<v_rd_off(D0, 2, 0)>(vb); f.h2 = tr_read<v_rd_off(D0, 2, 1)>(vb); f.l3 = tr_read<v_rd_off(D0, 3, 0)>(vb); f.h3 = tr_read<v_rd_off(D0, 3, 1)>(vb);
}
__device__ __forceinline__ void pv_mma(f32x16& od, const VFrag& f, bf16x8 pa0, bf16x8 pa1, bf16x8 pa2, bf16x8 pa3) {
#define PKV(L, H) (bf16x8){L[0], L[1], L[2], L[3], H[0], H[1], H[2], H[3]}
  od = __builtin_amdgcn_mfma_f32_32x32x16_bf16(pa0, PKV(f.l0, f.h0), od, 0, 0, 0);
  od = __builtin_amdgcn_mfma_f32_32x32x16_bf16(pa1, PKV(f.l1, f.h1), od, 0, 0, 0);
  od = __builtin_amdgcn_mfma_f32_32x32x16_bf16(pa2, PKV(f.l2, f.h2), od, 0, 0, 0);
  od = __builtin_amdgcn_mfma_f32_32x32x16_bf16(pa3, PKV(f.l3, f.h3), od, 0, 0, 0);
#undef PKV
}
__device__ __forceinline__ void pv_d0(f32x16* o, int vb, bf16x8 pa0, bf16x8 pa1, bf16x8 pa2, bf16x8 pa3) {
  VFrag fa, fb;
  pv_read<0>(fa, vb); pv_read<1>(fb, vb);
  asm volatile("s_waitcnt lgkmcnt(8)" ::: "memory"); SBAR(); pv_mma(o[0], fa, pa0, pa1, pa2, pa3); SBAR();
  pv_read<2>(fa, vb);
  asm volatile("s_waitcnt lgkmcnt(8)" ::: "memory"); SBAR(); pv_mma(o[1], fb, pa0, pa1, pa2, pa3); SBAR();
  pv_read<3>(fb, vb);
  asm volatile("s_waitcnt lgkmcnt(8)" ::: "memory"); SBAR(); pv_mma(o[2], fa, pa0, pa1, pa2, pa3); SBAR();
  asm volatile("s_waitcnt lgkmcnt(0)" ::: "memory"); SBAR(); pv_mma(o[3], fb, pa0, pa1, pa2, pa3);
}
__device__ __forceinline__ void att_step(f32x16& s0, f32x16& s1, const LAS unsigned char* Ks, const bf16x8* qr, int r32, int hi, int cbase,
                                         f32x16& e0, f32x16& e1, float& l_reg, bf16x8& pa0, bf16x8& pa1, bf16x8& pa2, bf16x8& pa3, f32x16* o, int vb) {
  bf16x8 b0[4], b1[4]; VFrag fa, fb; float ps = 0.f; u32x4 w0, w1, w2, w3;
#pragma unroll
  for (int d0 = 0; d0 < 4; ++d0) { const int cb = cbase + (d0 * 16 + hi * 8) * 2;
    b0[d0] = *(const LAS bf16x8*)(Ks + KSWZ(r32, cb)); b1[d0] = *(const LAS bf16x8*)(Ks + KSWZ(32 + r32, cb)); }
  s0 = f32x16{}; s1 = f32x16{};
#define PACK_H(E, BASE, H, W) do { ps += E[BASE + 2 * H]; ps += E[BASE + 2 * H + 1]; ps += E[BASE + 4 + 2 * H]; ps += E[BASE + 5 + 2 * H];                       \
    const unsigned a_ = cvt_pk_bf16(E[BASE + 2 * H], E[BASE + 2 * H + 1]), b_ = cvt_pk_bf16(E[BASE + 4 + 2 * H], E[BASE + 5 + 2 * H]);                       \
    W[H] = a_; W[2 + H] = b_; } while (0)
#define QK_STEP(D, N, PRE, PK_A, PK_B) do { asm volatile("s_waitcnt lgkmcnt(" #N ")" ::: "memory"); PRE; SBAR();                                                  \
    s0 = __builtin_amdgcn_mfma_f32_32x32x16_bf16(b0[D], qr[D], s0, 0, 0, 0); SBAR(); PK_A; SBAR();                                                                 \
    s1 = __builtin_amdgcn_mfma_f32_32x32x16_bf16(b1[D], qr[D], s1, 0, 0, 0); SBAR(); PK_B; SBAR(); } while (0)
  QK_STEP(0, 6, (void)0, PACK_H(e0, 0, 0, w0), PACK_H(e0, 0, 1, w0));
  QK_STEP(1, 4, (void)0, PACK_H(e0, 8, 0, w1), PACK_H(e0, 8, 1, w1));
  QK_STEP(2, 2, (void)0, PACK_H(e1, 0, 0, w2), PACK_H(e1, 0, 1, w2));
  QK_STEP(3, 0, (pv_read<0>(fa, vb), pv_read<1>(fb, vb)), PACK_H(e1, 8, 0, w3), PACK_H(e1, 8, 1, w3));
#undef QK_STEP
#undef PACK_H
  l_reg += ps;
  pa0 = __builtin_bit_cast(bf16x8, w0); pa1 = __builtin_bit_cast(bf16x8, w1); pa2 = __builtin_bit_cast(bf16x8, w2); pa3 = __builtin_bit_cast(bf16x8, w3);
#define PKV(L, H) (bf16x8){L[0], L[1], L[2], L[3], H[0], H[1], H[2], H[3]}
#define EX2(X, I) do { X[I] = __builtin_amdgcn_exp2f(X[I]); X[I + 1] = __builtin_amdgcn_exp2f(X[I + 1]); } while (0)
#define PV_BLK(D0, F, N, X, XB) do { asm volatile("s_waitcnt lgkmcnt(" #N ")" ::: "memory"); SBAR();                                                              \
    o[D0] = __builtin_amdgcn_mfma_f32_32x32x16_bf16(pa0, PKV(F.l0, F.h0), o[D0], 0, 0, 0); SBAR(); EX2(X, XB + 0); SBAR();                                         \
    o[D0] = __builtin_amdgcn_mfma_f32_32x32x16_bf16(pa1, PKV(F.l1, F.h1), o[D0], 0, 0, 0); SBAR(); EX2(X, XB + 2); SBAR();                                         \
    o[D0] = __builtin_amdgcn_mfma_f32_32x32x16_bf16(pa2, PKV(F.l2, F.h2), o[D0], 0, 0, 0); SBAR(); EX2(X, XB + 4); SBAR();                                         \
    o[D0] = __builtin_amdgcn_mfma_f32_32x32x16_bf16(pa3, PKV(F.l3, F.h3), o[D0], 0, 0, 0); SBAR(); EX2(X, XB + 6); SBAR(); } while (0)
  PV_BLK(0, fa, 8, s0, 0); pv_read<2>(fa, vb);
  PV_BLK(1, fb, 8, s0, 8); pv_read<3>(fb, vb);
  PV_BLK(2, fa, 8, s1, 0);
  PV_BLK(3, fb, 0, s1, 8);
#undef PV_BLK
#undef EX2
#undef PKV
}
__device__ __forceinline__ void attn_unit(const bf16_t* Qg, const bf16_t* __restrict__ Kg, const bf16_t* __restrict__ Vg, bf16_t* Og, int seq, float lam, const float* gsub, float oscale, LAS unsigned char* lds) {
  int tid_l = threadIdx.x; asm volatile("" : "+v"(tid_l));
  const int tid = tid_l, wid = __builtin_amdgcn_readfirstlane(tid >> 6), lane = tid & 63, r32 = lane & 31, hi = lane >> 5;
  const int comp = wid & 1, rg = wid >> 1, cbase = comp * 128;
  LAS unsigned char* V_lds = lds + OFF_V; LAS unsigned char* K_lds = lds + OFF_K;
  LAS float* wsf = (LAS float*)(lds + OFF_WS) + wid * 64; LAS float* li_l = wsf;
  float l_reg = 0; f32x16 o[4] = {}; bf16x8 qr[4];
  const bf16_t* Qw = Qg + (size_t)(rg * 32 + r32) * LDP + comp * 64 + hi * 8;
#pragma unroll
  for (int d0 = 0; d0 < 4; ++d0) qr[d0] = *(const bf16x8*)(Qw + d0 * 16);
  unsigned koff[2], voff[2];
#pragma unroll
  for (int i = 0; i < 2; ++i) { const int L = (tid + 512 * i) * 16; { const int row = L >> 8, colB = (L & 255) ^ ((row & 15) << 4); koff[i] = (unsigned)(row * LDP * 2 + colB); }
    { const int sub = L >> 9, w = L & 511, kk = (sub >> 2) * 8 + (w >> 6), c = (sub & 3) * 32 + ((w & 63) >> 1), k = kk; voff[i] = (unsigned)(k * LDP * 2 + c * 2); } }
  const int vbb = (int)(unsigned)(size_t)V_lds + v_rd_base(lane);
  const int NT = seq / KVBLK; const size_t tstep = (size_t)KVBLK * LDP * 2;
#define DMA_K(t) do { const int t_ = (t) < NT ? (t) : NT - 1; const char* g_ = (const char*)Kg + (size_t)t_ * tstep; LAS unsigned char* d_ = K_lds + (t_ % 3) * SHM_K + wid * 1024; \
    __builtin_amdgcn_global_load_lds((const unsigned*)(g_ + koff[0]), (LAS unsigned*)d_, 16, 0, 0); __builtin_amdgcn_global_load_lds((const unsigned*)(g_ + koff[1]), (LAS unsigned*)(d_ + 8192), 16, 0, 0); } while (0)
#define DMA_V(t) do { const int t_ = (t) < NT ? (t) : NT - 1; const char* g_ = (const char*)Vg + (size_t)t_ * tstep; LAS unsigned char* d_ = V_lds + (t_ % 3) * SHM_V + wid * 1024; \
    __builtin_amdgcn_global_load_lds((const unsigned*)(g_ + voff[0]), (LAS unsigned*)d_, 16, 0, 0); __builtin_amdgcn_global_load_lds((const unsigned*)(g_ + voff[1]), (LAS unsigned*)(d_ + 8192), 16, 0, 0); } while (0)
#define WAIT4_BAR() do { asm volatile("s_waitcnt vmcnt(4)" ::: "memory"); __builtin_amdgcn_s_barrier(); asm volatile("" ::: "memory"); } while (0)
  f32x16 pA0, pA1, pB0, pB1; bf16x8 pa0, pa1, pa2, pa3;
  DMA_K(0); DMA_K(1); DMA_V(0);
  WAIT4_BAR();
  DMA_K(2); DMA_V(1);
  qkt(pA0, pA1, K_lds, qr, r32, hi, cbase); partialSM(pA0); partialSM(pA1);
  int sk = 1, sv = 0;
  for (int j = 1; j + 1 < NT; j += 2) {
    WAIT4_BAR(); DMA_K(j + 2); DMA_V(j + 1);
    SBAR(); att_step(pB0, pB1, K_lds + sk * SHM_K, qr, r32, hi, cbase, pA0, pA1, l_reg, pa0, pa1, pa2, pa3, o, vbb + sv * SHM_V); SBAR();
    sk = sk == 2 ? 0 : sk + 1; sv = sv == 2 ? 0 : sv + 1;
    WAIT4_BAR(); DMA_K(j + 3); DMA_V(j + 2);
    SBAR(); att_step(pA0, pA1, K_lds + sk * SHM_K, qr, r32, hi, cbase, pB0, pB1, l_reg, pa0, pa1, pa2, pa3, o, vbb + sv * SHM_V); SBAR();
    sk = sk == 2 ? 0 : sk + 1; sv = sv == 2 ? 0 : sv + 1;
  }
  WAIT4_BAR(); DMA_K(NT + 1); DMA_V(NT);
  SBAR(); att_step(pB0, pB1, K_lds + sk * SHM_K, qr, r32, hi, cbase, pA0, pA1, l_reg, pa0, pa1, pa2, pa3, o, vbb + sv * SHM_V); SBAR();
  sv = sv == 2 ? 0 : sv + 1;
  WAIT4_BAR();
  finishSM_tail(pB0, pB1, l_reg, pa0, pa1, pa2, pa3); SBAR();
  pv_d0(o, vbb + sv * SHM_V, pa0, pa1, pa2, pa3);
  asm volatile("s_waitcnt vmcnt(0)" ::: "memory");
#undef DMA_K
#undef DMA_V
#undef WAIT4_BAR
  { auto rr = __builtin_amdgcn_permlane32_swap(__float_as_uint(l_reg), __float_as_uint(l_reg), false, false); l_reg = __uint_as_float(rr[0]) + __uint_as_float(rr[1]); }
  if (hi == 0) li_l[r32] = l_reg; asm volatile("s_waitcnt lgkmcnt(0)" ::: "memory");
  float rli[16];
#pragma unroll
  for (int r = 0; r < 16; ++r) rli[r] = __builtin_amdgcn_rcpf(li_l[crow(r, hi)]);
  __syncthreads();
  LAS float* X = (LAS float*)(lds) + rg * 4096 + lane;
  if (comp == 1) {
#pragma unroll
    for (int d0 = 0; d0 < 4; ++d0)
#pragma unroll
      for (int r = 0; r < 16; ++r) X[(d0 * 16 + r) * 64] = o[d0][r] * rli[r] * lam;
  }
  __syncthreads();
  if (comp == 0) {
    float ss[16];
#pragma unroll
    for (int r = 0; r < 16; ++r) ss[r] = 0.f;
#pragma unroll
    for (int d0 = 0; d0 < 4; ++d0)
#pragma unroll
      for (int r = 0; r < 16; ++r) { const float v = o[d0][r] * rli[r] - X[(d0 * 16 + r) * 64]; o[d0][r] = v; ss[r] += v * v; }
#pragma unroll
    for (int r = 0; r < 16; ++r) { float s = ss[r]; s += __shfl_xor(s, 1); s += __shfl_xor(s, 2); s += __shfl_xor(s, 4); s += __shfl_xor(s, 8); s += __shfl_xor(s, 16);
      ss[r] = __builtin_amdgcn_rsqf(s * (1.0f / 128.0f) + EPS) * oscale; }
    bf16_t* Ow = Og + (size_t)(rg * 32) * LDP;
#pragma unroll
    for (int d0 = 0; d0 < 4; ++d0) { const float g = gsub[d0 * 32 + r32];
#pragma unroll
#ifdef PROBE_ZERO_ATTN
      for (int r = 0; r < 16; ++r) Ow[(size_t)crow(r, hi) * LDP + d0 * 32 + r32] = (bf16_t)0;
#else
      for (int r = 0; r < 16; ++r) Ow[(size_t)crow(r, hi) * LDP + d0 * 32 + r32] = (bf16_t)(cvt_pk_bf16(o[d0][r] * ss[r] * g, 0.f) & 0xffffu);
#endif
    }
  }
  __syncthreads();
}
}


namespace att16 {
using att::KVBLK; using att::SHM_V; using att::SHM_K; using att::LDP;
constexpr int OFF_V = 0, OFF_K = 4 * SHM_V;
typedef f32x4 S8[4][2];
__device__ __forceinline__ f32x4 mma16(bf16x8 a, bf16x8 b, f32x4 c) { return __builtin_amdgcn_mfma_f32_16x16x32_bf16(a, b, c, 0, 0, 0); }
template <int OFF> __device__ __forceinline__ s16x4 tr_read(int vb) { s16x4 r; asm volatile("ds_read_b64_tr_b16 %0, %1 offset:%2" : "=&v"(r) : "v"(vb), "i"(OFF) : "memory"); return r; }
struct VF { s16x4 l0, h0, l1, h1; };
constexpr int v_off(int db, int ks, int half) { return ks * 8192 + half * 4096 + (db >> 1) * 512; }
template <int DP> __device__ __forceinline__ void pv_read(VF& fe, VF& fo, int vbe, int vbo) {
  fe.l0 = tr_read<v_off(2 * DP, 0, 0)>(vbe); fe.h0 = tr_read<v_off(2 * DP, 0, 1)>(vbe); fe.l1 = tr_read<v_off(2 * DP, 1, 0)>(vbe); fe.h1 = tr_read<v_off(2 * DP, 1, 1)>(vbe);
  fo.l0 = tr_read<v_off(2 * DP + 1, 0, 0)>(vbo); fo.h0 = tr_read<v_off(2 * DP + 1, 0, 1)>(vbo); fo.l1 = tr_read<v_off(2 * DP + 1, 1, 0)>(vbo); fo.h1 = tr_read<v_off(2 * DP + 1, 1, 1)>(vbo);
}
#define PKV16(L, H) (bf16x8){L[0], L[1], L[2], L[3], H[0], H[1], H[2], H[3]}
__device__ __forceinline__ void kf_read(bf16x8 (&kf)[4][2], const LAS unsigned char* Ks, int c16, int g, int cbase) {
#pragma unroll
  for (int kb = 0; kb < 4; ++kb)
#pragma unroll
    for (int ks = 0; ks < 2; ++ks) kf[kb][ks] = *(const LAS bf16x8*)(Ks + KSWZ(16 * kb + c16, cbase + (32 * ks + 8 * g) * 2));
}
__device__ __forceinline__ void qk_first(S8& S, const LAS unsigned char* Ks, const bf16x8 (&qf)[2][2], int c16, int g, int cbase) {
  bf16x8 kf[4][2]; kf_read(kf, Ks, c16, g, cbase);
#pragma unroll
  for (int kb = 0; kb < 4; ++kb)
#pragma unroll
    for (int qb = 0; qb < 2; ++qb) { f32x4 a = {0.f, 0.f, 0.f, 0.f}; a = mma16(kf[kb][0], qf[qb][0], a); a = mma16(kf[kb][1], qf[qb][1], a);
#pragma unroll
      for (int r = 0; r < 4; ++r) a[r] = __builtin_amdgcn_exp2f(a[r]);
      S[kb][qb] = a; }
}
#define ADDF16(acc, x) asm("v_add_f32 %0, %1, %0" : "+v"(acc) : "v"(x))
#define PACK16(E, KS, QB, W) do { const f32x4& e_ = E[2 * (KS) + ((W) >> 1)][QB]; pw[KS][QB][W] = cvt_pk_bf16(e_[2 * ((W) & 1)], e_[2 * ((W) & 1) + 1]); } while (0)
#define LSUM16() do { const bf16x8 on_ = {0x3F80, 0x3F80, 0x3F80, 0x3F80, 0x3F80, 0x3F80, 0x3F80, 0x3F80};                                                        \
    l2[0] = mma16(on_, __builtin_bit_cast(bf16x8, pw[0][0]), l2[0]); l2[1] = mma16(on_, __builtin_bit_cast(bf16x8, pw[0][1]), l2[1]);                               \
    l2[0] = mma16(on_, __builtin_bit_cast(bf16x8, pw[1][0]), l2[0]); l2[1] = mma16(on_, __builtin_bit_cast(bf16x8, pw[1][1]), l2[1]); } while (0)
__device__ __forceinline__ void pack_all(const S8& E, u32x4 (&pw)[2][2]) {
#pragma unroll
  for (int ks = 0; ks < 2; ++ks)
#pragma unroll
    for (int qb = 0; qb < 2; ++qb) { PACK16(E, ks, qb, 0); PACK16(E, ks, qb, 1); PACK16(E, ks, qb, 2); PACK16(E, ks, qb, 3); }
}
#define PV16(DB, F) do { _Pragma("unroll") for (int qb_ = 0; qb_ < 2; ++qb_) { o[DB][qb_] = mma16(PKV16(F.l0, F.h0), __builtin_bit_cast(bf16x8, pw[0][qb_]), o[DB][qb_]); \
    o[DB][qb_] = mma16(PKV16(F.l1, F.h1), __builtin_bit_cast(bf16x8, pw[1][qb_]), o[DB][qb_]); } } while (0)
__device__ __forceinline__ void pv_last(f32x4 (&o)[8][2], const u32x4 (&pw)[2][2], int vbe, int vbo) {
  VF ae, ao, be, bo;
  pv_read<0>(ae, ao, vbe, vbo); pv_read<1>(be, bo, vbe, vbo);
  asm volatile("s_waitcnt lgkmcnt(8)" ::: "memory"); SBAR(); PV16(0, ae); PV16(1, ao); SBAR();
  pv_read<2>(ae, ao, vbe, vbo);
  asm volatile("s_waitcnt lgkmcnt(8)" ::: "memory"); SBAR(); PV16(2, be); PV16(3, bo); SBAR();
  pv_read<3>(be, bo, vbe, vbo);
  asm volatile("s_waitcnt lgkmcnt(8)" ::: "memory"); SBAR(); PV16(4, ae); PV16(5, ao); SBAR();
  asm volatile("s_waitcnt lgkmcnt(0)" ::: "memory"); SBAR(); PV16(6, be); PV16(7, bo);
}
__device__ __forceinline__ void att_step(S8& S, const LAS unsigned char* Ks, const bf16x8 (&qf)[2][2], int c16, int g, int cbase, const S8& E, f32x4 (&l2)[2], f32x4 (&o)[8][2], int vbe, int vbo) {
  bf16x8 kf[4][2]; u32x4 pw[2][2]; VF ae, ao, be, bo;
  kf_read(kf, Ks, c16, g, cbase);
#define QK16(KB, N, PRE, P0, P1, P2, P3) do { asm volatile("s_waitcnt lgkmcnt(" #N ")" ::: "memory"); PRE; SBAR(); f32x4 a0_ = {0.f, 0.f, 0.f, 0.f}, a1_ = {0.f, 0.f, 0.f, 0.f};  \
    a0_ = mma16(kf[KB][0], qf[0][0], a0_); SBAR(); P0; SBAR(); a1_ = mma16(kf[KB][0], qf[1][0], a1_); SBAR(); P1; SBAR();                                     \
    a0_ = mma16(kf[KB][1], qf[0][1], a0_); SBAR(); P2; SBAR(); a1_ = mma16(kf[KB][1], qf[1][1], a1_); SBAR(); P3; SBAR(); S[KB][0] = a0_; S[KB][1] = a1_; } while (0)
  QK16(0, 6, (void)0, PACK16(E, 0, 0, 0), PACK16(E, 0, 0, 1), PACK16(E, 0, 0, 2), PACK16(E, 0, 0, 3));
  QK16(1, 4, (void)0, PACK16(E, 0, 1, 0), PACK16(E, 0, 1, 1), PACK16(E, 0, 1, 2), PACK16(E, 0, 1, 3));
  QK16(2, 2, (void)0, PACK16(E, 1, 0, 0), PACK16(E, 1, 0, 1), PACK16(E, 1, 0, 2), PACK16(E, 1, 0, 3));
  QK16(3, 0, (pv_read<0>(ae, ao, vbe, vbo), pv_read<1>(be, bo, vbe, vbo)), PACK16(E, 1, 1, 0), PACK16(E, 1, 1, 1), PACK16(E, 1, 1, 2), PACK16(E, 1, 1, 3));
#undef QK16
#define EX1(KB, QB, R) S[KB][QB][R] = __builtin_amdgcn_exp2f(S[KB][QB][R])
#define PVX(DB, F, KB) do { o[DB][0] = mma16(PKV16(F.l0, F.h0), __builtin_bit_cast(bf16x8, pw[0][0]), o[DB][0]); SBAR(); EX1(KB, 0, 0); SBAR();                    \
    o[DB][1] = mma16(PKV16(F.l0, F.h0), __builtin_bit_cast(bf16x8, pw[0][1]), o[DB][1]); SBAR(); EX1(KB, 0, 1); SBAR();                                          \
    o[DB][0] = mma16(PKV16(F.l1, F.h1), __builtin_bit_cast(bf16x8, pw[1][0]), o[DB][0]); SBAR(); EX1(KB, 0, 2); SBAR();                                          \
    o[DB][1] = mma16(PKV16(F.l1, F.h1), __builtin_bit_cast(bf16x8, pw[1][1]), o[DB][1]); SBAR(); EX1(KB, 0, 3); SBAR(); } while (0)
#define PVY(DB, F, KB) do { o[DB][0] = mma16(PKV16(F.l0, F.h0), __builtin_bit_cast(bf16x8, pw[0][0]), o[DB][0]); SBAR(); EX1(KB, 1, 0); SBAR();                    \
    o[DB][1] = mma16(PKV16(F.l0, F.h0), __builtin_bit_cast(bf16x8, pw[0][1]), o[DB][1]); SBAR(); EX1(KB, 1, 1); SBAR();                                          \
    o[DB][0] = mma16(PKV16(F.l1, F.h1), __builtin_bit_cast(bf16x8, pw[1][0]), o[DB][0]); SBAR(); EX1(KB, 1, 2); SBAR();                                          \
    o[DB][1] = mma16(PKV16(F.l1, F.h1), __builtin_bit_cast(bf16x8, pw[1][1]), o[DB][1]); SBAR(); EX1(KB, 1, 3); SBAR(); } while (0)
  SBAR(); LSUM16(); SBAR();
  asm volatile("s_waitcnt lgkmcnt(8)" ::: "memory"); SBAR(); PVX(0, ae, 0); PVY(1, ao, 0); pv_read<2>(ae, ao, vbe, vbo);
  asm volatile("s_waitcnt lgkmcnt(8)" ::: "memory"); SBAR(); PVX(2, be, 1); PVY(3, bo, 1); pv_read<3>(be, bo, vbe, vbo);
  asm volatile("s_waitcnt lgkmcnt(8)" ::: "memory"); SBAR(); PVX(4, ae, 2); PVY(5, ao, 2);
  asm volatile("s_waitcnt lgkmcnt(0)" ::: "memory"); SBAR(); PVX(6, be, 3); PVY(7, bo, 3);
#undef PVX
#undef PVY
#undef EX1
}
__device__ __forceinline__ void attn_unit(const bf16_t* Qg, const bf16_t* __restrict__ Kg, const bf16_t* __restrict__ Vg, bf16_t* Og, int seq, float lam, const float* gsub, float oscale, LAS unsigned char* lds, bool rev) {
  int tid_l = threadIdx.x; asm volatile("" : "+v"(tid_l));
  const int tid = tid_l, wid = __builtin_amdgcn_readfirstlane(tid >> 6), lane = tid & 63, c16 = lane & 15, g = lane >> 4;
  const int comp = wid & 1, rg = wid >> 1, cbase = comp * 128;
  LAS unsigned char* V_lds = lds + OFF_V; LAS unsigned char* K_lds = lds + OFF_K;

  f32x4 l2[2] = {{0.f, 0.f, 0.f, 0.f}, {0.f, 0.f, 0.f, 0.f}}; f32x4 o[8][2]; bf16x8 qf[2][2];
#pragma unroll
  for (int db = 0; db < 8; ++db)
#pragma unroll
    for (int qb = 0; qb < 2; ++qb) o[db][qb] = (f32x4){0.f, 0.f, 0.f, 0.f};
#pragma unroll
  for (int qb = 0; qb < 2; ++qb)
#pragma unroll
    for (int ks = 0; ks < 2; ++ks) qf[qb][ks] = *(const bf16x8*)(Qg + (size_t)(rg * 32 + 16 * qb + c16) * LDP + comp * 64 + 32 * ks + 8 * g);
  unsigned koff[2], voff[2];
#pragma unroll
  for (int i = 0; i < 2; ++i) { const int L = (tid + 512 * i) * 16; { const int row = L >> 8, colB = (L & 255) ^ ((row & 15) << 4); koff[i] = (unsigned)(row * LDP * 2 + colB); }
    { const int sub = L >> 9, w = L & 511, k = (sub >> 2) * 8 + (w >> 6), cl = ((w & 63) >> 1) ^ (((k >> 2) & 1) << 4), c = (sub & 3) * 32 + cl; voff[i] = (unsigned)(k * LDP * 2 + c * 2); } }
  const int vb0 = (int)(unsigned)(size_t)V_lds + (g >> 1) * 2048 + (g & 1) * 256 + ((c16 >> 2) & 3) * 64 + (c16 & 3) * 8;
  const int vbe0 = vb0 + (g & 1) * 32, vbo0 = vb0 + ((g & 1) ^ 1) * 32;
  const int NT = seq / KVBLK; const size_t tstep = (size_t)KVBLK * LDP * 2;
#define DMA_K(t) do { const int t_ = (t) < NT ? (t) : NT - 1; const char* g_ = (const char*)Kg + (size_t)(rev ? NT - 1 - t_ : t_) * tstep; LAS unsigned char* d_ = K_lds + (t_ & 3) * SHM_K + wid * 1024; \
    __builtin_amdgcn_global_load_lds((const unsigned*)(g_ + koff[0]), (LAS unsigned*)d_, 16, 0, 0); __builtin_amdgcn_global_load_lds((const unsigned*)(g_ + koff[1]), (LAS unsigned*)(d_ + 8192), 16, 0, 0); } while (0)
#define DMA_V(t) do { const int t_ = (t) < NT ? (t) : NT - 1; const char* g_ = (const char*)Vg + (size_t)(rev ? NT - 1 - t_ : t_) * tstep; LAS unsigned char* d_ = V_lds + (t_ & 3) * SHM_V + wid * 1024; \
    __builtin_amdgcn_global_load_lds((const unsigned*)(g_ + voff[0]), (LAS unsigned*)d_, 16, 0, 0); __builtin_amdgcn_global_load_lds((const unsigned*)(g_ + voff[1]), (LAS unsigned*)(d_ + 8192), 16, 0, 0); } while (0)
#define WAIT4_BAR() do { asm volatile("s_waitcnt vmcnt(8)" ::: "memory"); __builtin_amdgcn_s_barrier(); asm volatile("" ::: "memory"); } while (0)
  S8 pA, pB;
  DMA_K(0); DMA_K(1); DMA_V(0); DMA_K(2); DMA_V(1);
  WAIT4_BAR();
  DMA_K(3); DMA_V(2);
  qk_first(pA, K_lds, qf, c16, g, cbase);
  for (int j = 1; j + 1 < NT; j += 2) {
    WAIT4_BAR(); DMA_K(j + 3); DMA_V(j + 2);
    SBAR(); att_step(pB, K_lds + (j & 3) * SHM_K, qf, c16, g, cbase, pA, l2, o, vbe0 + ((j - 1) & 3) * SHM_V, vbo0 + ((j - 1) & 3) * SHM_V); SBAR();
    WAIT4_BAR(); DMA_K(j + 4); DMA_V(j + 3);
    SBAR(); att_step(pA, K_lds + ((j + 1) & 3) * SHM_K, qf, c16, g, cbase, pB, l2, o, vbe0 + (j & 3) * SHM_V, vbo0 + (j & 3) * SHM_V); SBAR();
  }
  WAIT4_BAR(); DMA_K(NT + 2); DMA_V(NT + 1);
  SBAR(); att_step(pB, K_lds + ((NT - 1) & 3) * SHM_K, qf, c16, g, cbase, pA, l2, o, vbe0 + ((NT - 2) & 3) * SHM_V, vbo0 + ((NT - 2) & 3) * SHM_V); SBAR();
  WAIT4_BAR();
  const int sv = (NT - 1) & 3;
  { u32x4 pw[2][2]; pack_all(pB, pw); SBAR(); LSUM16(); SBAR(); pv_last(o, pw, vbe0 + sv * SHM_V, vbo0 + sv * SHM_V); }
  asm volatile("s_waitcnt vmcnt(0)" ::: "memory");
#undef DMA_K
#undef DMA_V
#undef WAIT4_BAR
  float rl[2];
#pragma unroll
  for (int qb = 0; qb < 2; ++qb) rl[qb] = __builtin_amdgcn_rcpf(l2[qb][0]);
  __syncthreads();
  LAS float* X = (LAS float*)(lds) + rg * 4096 + lane;
  if (comp == 1) {
#pragma unroll
    for (int db = 0; db < 8; ++db)
#pragma unroll
      for (int qb = 0; qb < 2; ++qb)
#pragma unroll
        for (int r = 0; r < 4; ++r) X[((db * 2 + qb) * 4 + r) * 64] = o[db][qb][r] * rl[qb] * lam;
  }
  __syncthreads();
  if (comp == 0) {
    float ss[2] = {0.f, 0.f};
#pragma unroll
    for (int db = 0; db < 8; ++db)
#pragma unroll
      for (int qb = 0; qb < 2; ++qb)
#pragma unroll
        for (int r = 0; r < 4; ++r) { const float v = o[db][qb][r] * rl[qb] - X[((db * 2 + qb) * 4 + r) * 64]; o[db][qb][r] = v; ss[qb] += v * v; }
#pragma unroll
    for (int qb = 0; qb < 2; ++qb) { float t = ss[qb]; t += __shfl_xor(t, 16); t += __shfl_xor(t, 32); ss[qb] = __builtin_amdgcn_rsqf(t * (1.0f / 128.0f) + EPS) * oscale; }
#pragma unroll
    for (int db = 0; db < 8; ++db) { const f32x4 gs = *(const f32x4*)(gsub + 16 * db + 4 * g);
#pragma unroll
      for (int qb = 0; qb < 2; ++qb) { const f32x4 v = o[db][qb] * gs * ss[qb]; u32x2 w; w.x = cvt_pk_bf16(v[0], v[1]); w.y = cvt_pk_bf16(v[2], v[3]);
        *(u32x2*)(Og + (size_t)(rg * 32 + 16 * qb + c16) * LDP + 16 * db + 4 * g) = w; } }
  }
  __syncthreads();
}
#undef PV16
#undef PACK16
#undef LSUM16
#undef ADDF16
#undef PKV16
}

#define XB_TMO      128
#define XB_XCNT(j)  (256  + 64 * (j))
#define XB_XSUB(j)  (1280 + 64 * (j))
#define XB_XGEN(j)  (2304 + 64 * (j))
#define XB_TOP      3328
#define XB_TOPGEN   3392
#define XCD_BAR_WORDS 3456
#define XB_SPIN_CAP (1u << 20)
__device__ __forceinline__ unsigned xb_ld(unsigned* p)              { return __hip_atomic_load(p, __ATOMIC_RELAXED, __HIP_MEMORY_SCOPE_AGENT); }
__device__ __forceinline__ unsigned xb_add(unsigned* p, unsigned v) { return __hip_atomic_fetch_add(p, v, __ATOMIC_RELAXED, __HIP_MEMORY_SCOPE_AGENT); }
__device__ __forceinline__ unsigned xb_xcc_id() { return (unsigned)__builtin_amdgcn_s_getreg((3 << 11) | 20) & 0xFu; }
#define XB_SPIN(cond, bar) do { unsigned _sp = 0; while (cond) { __builtin_amdgcn_s_sleep(1); \
    if ((++_sp & 255u) == 0u) { if (xb_ld(&(bar)[XB_TMO])) break; if (_sp > XB_SPIN_CAP) { atomicAdd(&(bar)[XB_TMO], 1u); break; } } } } while (0)
struct XcdBarrier { unsigned* bar; unsigned x; volatile LAS unsigned* st; };
__device__ __forceinline__ XcdBarrier xcd_barrier_post(unsigned* bar, volatile LAS unsigned* st) {
    XcdBarrier b; b.bar = bar; b.x = xb_xcc_id(); b.st = st;
    if (threadIdx.x == 0) (void)xb_add(&bar[XB_XCNT(b.x)], 1u);
    return b;
}
__device__ __forceinline__ void xcd_barrier_complete(unsigned* bar, unsigned x, unsigned& nloc, unsigned& nx) {
    const unsigned G = gridDim.x * gridDim.y * gridDim.z;
    unsigned sum, cnt, mine, sp = 0u;
    for (;;) {
        sum = 0u; cnt = 0u; mine = 0u;
#pragma unroll
        for (unsigned j = 0; j < 16; ++j) { const unsigned c = xb_ld(&bar[XB_XCNT(j)]); sum += c; cnt += (c > 0u) ? 1u : 0u; mine = (j == x) ? c : mine; }
        if (sum == G) break;
        __builtin_amdgcn_s_sleep(1);
        if ((++sp & 255u) == 0u) { if (xb_ld(&bar[XB_TMO])) break; if (sp > XB_SPIN_CAP) { atomicAdd(&bar[XB_TMO], 1u); break; } }
    }
    nloc = mine > 0u ? mine : 1u; nx = cnt > 0u ? cnt : 1u;
}
__device__ __forceinline__ void xcd_barrier(const XcdBarrier& b) {
    asm volatile("s_waitcnt vmcnt(0)" ::: "memory");
    __syncthreads();
    if (threadIdx.x == 0) {
        unsigned* bar = b.bar;
        __builtin_amdgcn_s_waitcnt(0);
        unsigned nloc = b.st[0], nx = b.st[1];
        if (nloc == 0u) { xcd_barrier_complete(bar, b.x, nloc, nx); b.st[0] = nloc; b.st[1] = nx; }
        const unsigned old = xb_add(&bar[XB_XSUB(b.x)], 1u);
        const unsigned gen = old / nloc;
        if (old + 1u == (gen + 1u) * nloc) {
            __builtin_amdgcn_fence(__ATOMIC_RELEASE, "agent");
            asm volatile("s_waitcnt vmcnt(0)" ::: "memory");
            const unsigned og = xb_add(&bar[XB_TOP], 1u);
            const unsigned tg = og / nx;
            if (og + 1u == (tg + 1u) * nx) xb_add(&bar[XB_TOPGEN], 1u);
            else XB_SPIN(xb_ld(&bar[XB_TOPGEN]) == tg, bar);
            __builtin_amdgcn_fence(__ATOMIC_ACQUIRE, "agent");
            xb_add(&bar[XB_XGEN(b.x)], 1u);
            asm volatile("s_waitcnt vmcnt(0)" ::: "memory");
        } else {
            XB_SPIN(xb_ld(&bar[XB_XGEN(b.x)]) == gen, bar);
            __builtin_amdgcn_fence(__ATOMIC_ACQUIRE, "agent");
            asm volatile("s_waitcnt vmcnt(0)" ::: "memory");
        }
    }
    __syncthreads();
}

#define LDS_WAIT() asm volatile("s_waitcnt lgkmcnt(0)" ::: "memory")
__device__ __forceinline__ float wave_sum(float v) {
#pragma unroll
    for (int o = 1; o < 64; o <<= 1) v += __shfl_xor(v, o);
    return v;
}
typedef __bf16 bf16n2_t __attribute__((ext_vector_type(2)));
__device__ __forceinline__ unsigned cvt2_bf16_native(float lo, float hi) { const bf16n2_t v = {(__bf16)lo, (__bf16)hi}; return __builtin_bit_cast(unsigned, v); }
__device__ __forceinline__ void pool_fold_item(const float* Wp, const float* ps, const float* Wol, bf16_t* WT, int g_, int nb, int lane) {
    const int c16 = lane & 15, kg = lane >> 4, n0 = nb * 64;
    bf16x8 bfr[4][8];
#pragma unroll
    for (int ks = 0; ks < 8; ++ks) { const int d0 = ks * 32 + 8 * kg; const f32x4 p0 = *(const f32x4*)(ps + d0), p1 = *(const f32x4*)(ps + d0 + 4);
#pragma unroll
        for (int nh = 0; nh < 2; ++nh) { float t[2][8];
#pragma unroll
            for (int nq = 0; nq < 2; ++nq) { const float* bp = Wol + (size_t)d0 * 2048 + n0 + 16 * (2 * nh + nq) + c16;
#pragma unroll
                for (int j = 0; j < 8; ++j) t[nq][j] = bp[j * 2048]; }
            __builtin_amdgcn_sched_barrier(0);
#pragma unroll
            for (int nq = 0; nq < 2; ++nq) { u32x4 w;
                w.x = cvt2_bf16_native(t[nq][0] * p0[0], t[nq][1] * p0[1]); w.y = cvt2_bf16_native(t[nq][2] * p0[2], t[nq][3] * p0[3]);
                w.z = cvt2_bf16_native(t[nq][4] * p1[0], t[nq][5] * p1[1]); w.w = cvt2_bf16_native(t[nq][6] * p1[2], t[nq][7] * p1[3]); bfr[2 * nh + nq][ks] = __builtin_bit_cast(bf16x8, w); }
            __builtin_amdgcn_sched_barrier(0); } }
    for (int cb = 0; cb < 16; ++cb) { f32x4 acc[4];
#pragma unroll
        for (int nbk = 0; nbk < 4; ++nbk) acc[nbk] = (f32x4){0.f, 0.f, 0.f, 0.f};
#pragma unroll
        for (int kh = 0; kh < 2; ++kh) { f32x4 av[4][2];
#pragma unroll
            for (int k4 = 0; k4 < 4; ++k4) { const float* ap = Wp + (size_t)(cb * 16 + c16) * 256 + (kh * 4 + k4) * 32 + 8 * kg; av[k4][0] = *(const f32x4*)ap; av[k4][1] = *(const f32x4*)(ap + 4); }
            __builtin_amdgcn_sched_barrier(0);
#pragma unroll
            for (int k4 = 0; k4 < 4; ++k4) { const f32x4 a0 = av[k4][0], a1 = av[k4][1];
                u32x4 w; w.x = cvt2_bf16_native(a0[0], a0[1]); w.y = cvt2_bf16_native(a0[2], a0[3]); w.z = cvt2_bf16_native(a1[0], a1[1]); w.w = cvt2_bf16_native(a1[2], a1[3]); const bf16x8 af = __builtin_bit_cast(bf16x8, w);
#pragma unroll
                for (int nbk = 0; nbk < 4; ++nbk) acc[nbk] = __builtin_amdgcn_mfma_f32_16x16x32_bf16(af, bfr[nbk][kh * 4 + k4], acc[nbk], 0, 0, 0); }
            __builtin_amdgcn_sched_barrier(0); }
#pragma unroll
        for (int nbk = 0; nbk < 4; ++nbk) { u32x2 o; o.x = cvt2_bf16_native(acc[nbk][0], acc[nbk][1]); o.y = cvt2_bf16_native(acc[nbk][2], acc[nbk][3]);
            *(u32x2*)(WT + (size_t)(n0 + 16 * nbk + c16) * 2048 + 1024 + g_ * 256 + cb * 16 + 4 * kg) = o; }
        __builtin_amdgcn_sched_barrier(0); }
}
__device__ __forceinline__ unsigned cvt_pk_f16_rne(float a, float b) { const h2_t v = {(_Float16)a, (_Float16)b}; return __builtin_bit_cast(unsigned, v); }
template <bool F16 = false>
__device__ __forceinline__ void tr_item(const float* W, int K, int N, bf16_t* WT, const float* rs, const float* cs, int perm_limit, LAS float* scr, int item, int lane) {
    const int nblk = N / 32, kb = item / nblk, nb = item % nblk, k0 = 64 * kb, n0 = 32 * nb;
    const float csv = cs ? cs[n0 + (lane & 31)] : 1.f;
    float wv[32], rv[32];
#pragma unroll
    for (int i = 0; i < 32; ++i) { const int kk = 2 * i + (lane >> 5); wv[i] = W[(size_t)(k0 + kk) * N + n0 + (lane & 31)]; rv[i] = rs ? rs[k0 + kk] : 1.f; }
#pragma unroll
    for (int i = 0; i < 32; ++i) { const int kk = 2 * i + (lane >> 5); scr[kk * 33 + (lane & 31)] = wv[i] * rv[i] * csv; }
    LDS_WAIT(); asm volatile("" ::: "memory");
    int d0 = n0; if (n0 < perm_limit) { const int tile = n0 >> 8, lb = (n0 >> 5) & 7; d0 = (tile << 8) + ((4 * (lb & 1) + (lb >> 1)) << 5); }
    if (perm_limit < 0) { const int isv = n0 >= D_FF, ch = n0 - (isv ? D_FF : 0); d0 = (ch >> 7) * 256 + isv * 128 + (ch & 127); }
    const int c = lane & 7;
#pragma unroll
    for (int j = 0; j < 4; ++j) { const int n = (lane >> 3) + 8 * j; const LAS float* s = scr + (8 * c) * 33 + n;
        u32x4 o;
        if constexpr (F16) { o.x = cvt_pk_f16_rne(s[0 * 33], s[1 * 33]); o.y = cvt_pk_f16_rne(s[2 * 33], s[3 * 33]); o.z = cvt_pk_f16_rne(s[4 * 33], s[5 * 33]); o.w = cvt_pk_f16_rne(s[6 * 33], s[7 * 33]); }
        else { o.x = cvt_pk_bf16(s[0 * 33], s[1 * 33]); o.y = cvt_pk_bf16(s[2 * 33], s[3 * 33]); o.z = cvt_pk_bf16(s[4 * 33], s[5 * 33]); o.w = cvt_pk_bf16(s[6 * 33], s[7 * 33]); }
        *(u32x4*)(WT + (size_t)(d0 + n) * K + k0 + 8 * c) = o; }
    LDS_WAIT(); asm volatile("" ::: "memory");
}
__device__ __forceinline__ void norm_row(const float* xrow, bf16_t* orow, float* crow_, int lane) {
    f32x4 v[8]; float s = 0.f;
#pragma unroll
    for (int j = 0; j < 4; ++j) { v[2 * j] = *(const f32x4*)(xrow + j * 512 + lane * 8); v[2 * j + 1] = *(const f32x4*)(xrow + j * 512 + lane * 8 + 4); s += pg8::sumsq4(v[2 * j]) + pg8::sumsq4(v[2 * j + 1]); }
    const float rstd = __builtin_amdgcn_rsqf(wave_sum(s) * (1.0f / D_MODEL) + EPS);
#pragma unroll
    for (int j = 0; j < 4; ++j) { if (crow_) { *(f32x4*)(crow_ + j * 512 + lane * 8) = v[2 * j]; *(f32x4*)(crow_ + j * 512 + lane * 8 + 4) = v[2 * j + 1]; }
        *(u32x4*)(orow + j * 512 + lane * 8) = pg8::pack8(v[2 * j] * rstd, v[2 * j + 1] * rstd); }
}

__device__ __forceinline__ void raw_row(const float* xrow, bf16_t* orow, rss_t* ssq, int lane) {
    f32x4 v[8]; float s = 0.f;
#pragma unroll
    for (int j = 0; j < 4; ++j) { v[2 * j] = *(const f32x4*)(xrow + j * 512 + lane * 8); v[2 * j + 1] = *(const f32x4*)(xrow + j * 512 + lane * 8 + 4); s += pg8::sumsq4(v[2 * j]) + pg8::sumsq4(v[2 * j + 1]); }
    s = wave_sum(s); if (lane == 0) *ssq = ss_fix(s);
#pragma unroll
    for (int j = 0; j < 4; ++j) *(u32x4*)(orow + j * 512 + lane * 8) = pg8::pack8(v[2 * j], v[2 * j + 1]);
}

template <int WIN> __device__ __forceinline__ void pool_item(const bf16_t* U, bf16_t* ZP, int r0, int ch, bool big) {
    constexpr int NR = 3 + 2 * WIN, SM = WIN / 2;
    const int pos0 = tok_pos(r0), S = tok_seqlen(r0);
    u32x4 v[NR];
#pragma unroll
    for (int k = 0; k < NR; ++k) { const int p = pos0 - WIN + k; v[k] = (p >= 0 && p < S) ? *(const u32x4*)(U + (size_t)(r0 - WIN + k) * 1024 + ch) : (u32x4){0u, 0u, 0u, 0u}; }
    float sb[8], ss[8];
#pragma unroll
    for (int j = 0; j < 8; ++j) { sb[j] = 0.f; ss[j] = 0.f; }
#define POOL_ACC(dst, k, sgn) do { const u32x4 w_ = v[k]; dst[0] += sgn bflo(w_.x); dst[1] += sgn bfhi(w_.x); dst[2] += sgn bflo(w_.y); dst[3] += sgn bfhi(w_.y); dst[4] += sgn bflo(w_.z); dst[5] += sgn bfhi(w_.z); dst[6] += sgn bflo(w_.w); dst[7] += sgn bfhi(w_.w); } while (0)
#pragma unroll
    for (int k = 0; k < 2 * WIN; ++k) { POOL_ACC(sb, k, +); if (k >= WIN - SM && k < WIN + SM) POOL_ACC(ss, k, +); }
#pragma unroll
    for (int i = 0; i < 4; ++i) {
        if (i > 0) { POOL_ACC(sb, i + 2 * WIN - 1, +); POOL_ACC(sb, i - 1, -); POOL_ACC(ss, i + WIN + SM - 1, +); POOL_ACC(ss, i + WIN - SM - 1, -); }
        const int pos = pos0 + i, w2 = big ? WIN : SM; const int lo_ = pos - w2 < 0 ? 0 : pos - w2, hi_ = pos + w2 > S ? S : pos + w2; const float inv = 1.0f / (float)(hi_ - lo_);
        const u32x4 c = v[WIN + i]; float s[8];
#pragma unroll
        for (int j = 0; j < 8; ++j) s[j] = (big ? sb[j] : ss[j]) * inv;
        u32x4 o; o.x = cvt_pk_bf16(s[0] - bflo(c.x), s[1] - bfhi(c.x)); o.y = cvt_pk_bf16(s[2] - bflo(c.y), s[3] - bfhi(c.y)); o.z = cvt_pk_bf16(s[4] - bflo(c.z), s[5] - bfhi(c.z)); o.w = cvt_pk_bf16(s[6] - bflo(c.w), s[7] - bfhi(c.w));
        *(u32x4*)(ZP + (size_t)(r0 + i) * 1024 + ch) = o; }
#undef POOL_ACC
}

struct Args { const float* in[28]; float* out; unsigned char* ws; int ph_lo, ph_hi; };

__global__ void __launch_bounds__(NWAVES * 64, 2) trunk_fwd(Args args) {
    extern __shared__ __attribute__((aligned(16))) unsigned char lds_raw[];
    LAS unsigned char* lds = (LAS unsigned char*)lds_raw;
    volatile LAS unsigned* MISC = (volatile LAS unsigned*)(lds + MISC_OFF);
    for (int u = threadIdx.x; u < (LDS_BYTES - LDSCTL_OFF) / 4; u += NWAVES * 64) ((LAS unsigned*)(lds + LDSCTL_OFF))[u] = 0u;
    __syncthreads();
    const int lo = args.ph_lo, hi = args.ph_hi;
    XcdBarrier bar; bar.bar = (unsigned*)(args.ws + WS_CTL) + CW_BAR; bar.x = 0; bar.st = nullptr;
    if (hi - lo > 1) bar = xcd_barrier_post((unsigned*)(args.ws + WS_CTL) + CW_BAR, MISC + 8);
#define IN(k) ({ int lo_ = lo, hi_ = hi; asm volatile("" : "+s"(lo_), "+s"(hi_)); lo_ <= (k) && (k) < hi_; })
#define SEAM(k) do { if (IN(k) && IN((k) + 1)) { XcdBarrier b2_ = bar; asm volatile("" : "+s"(b2_.bar), "+s"(b2_.x)); xcd_barrier(b2_); } } while (0)
#define PHASE_BEGIN() int tid = threadIdx.x; asm volatile("" : "+v"(tid)); int zo = 0; asm volatile("" : "+s"(zo)); \
    const int lane = tid & 63, wave = __builtin_amdgcn_readfirstlane(tid >> 6); const int G = gridDim.x, bx = blockIdx.x; \
    const int vcu = (G % 8 == 0) ? (bx % 8) * (G / 8) + bx / 8 : bx; const int gw = vcu * NWAVES + wave, NGW = G * NWAVES; \
    unsigned char* ws = args.ws + zo; float* X = args.out + zo; (void)lane; (void)wave; (void)gw; (void)NGW; (void)ws; (void)X; (void)vcu; (void)tid
#define INP(i) (args.in[(i) + zo])
#define WSP(T, off) ((T*)(ws + (off)))

#define CG_UP 1u
#define CG_DOWN 2u
#define CG_IN 4u
#define CG_CKV 8u
#define CG_OUT 16u
#define CG_CQ 32u
#define CG_CO 64u
#define CONV_ITEMS(L_, MASK_) do { const int l_ = (L_); constexpr unsigned m_ = (MASK_); __syncthreads(); LAS float* scr = (LAS float*)(lds + wave * 16384);                                         \
    constexpr int I_IN = 32 * 128, I_OUT = 16 * 64, I_CQ = 32 * 64, I_CKV = 32 * 128, I_CO = 32 * 64, I_UP = 32 * (UP_W / 32), I_DOWN = (D_FF / 64) * 64, I_P = 4 * 32;                                 \
    constexpr int n_ = ((m_ & CG_UP) ? I_UP : 0) + ((m_ & CG_DOWN) ? I_DOWN : 0) + ((m_ & CG_IN) ? I_IN : 0) + ((m_ & CG_CKV) ? I_CKV : 0) + ((m_ & CG_OUT) ? I_OUT + I_P : 0) + ((m_ & CG_CQ) ? I_CQ : 0) + ((m_ & CG_CO) ? I_CO : 0); \
    for (int it = gw; it < n_; it += NGW) { int r = it;                                                                                                                                            \
        if constexpr ((m_ & CG_UP) != 0) { if (r < I_UP) { tr_item(INP(24) + (size_t)l_ * 2048 * UP_W, 2048, UP_W, WSP(bf16_t, WS_WUP), INP(23) + l_ * 2048, nullptr, -1, scr, r, lane); continue; } r -= I_UP; } \
        if constexpr ((m_ & CG_DOWN) != 0) { if (r < I_DOWN) { tr_item<true>(INP(27) + (size_t)l_ * D_FF * 2048, D_FF, 2048, WSP(bf16_t, WS_WDOWN), nullptr, nullptr, 0, scr, r, lane); continue; } r -= I_DOWN; } \
        if constexpr ((m_ & CG_IN) != 0) { if (r < I_IN) { tr_item(INP(5) + (size_t)l_ * 2048 * 4096, 2048, 4096, WSP(bf16_t, WS_WIN), INP(4) + l_ * 2048, nullptr, 2048, scr, r, lane); continue; } r -= I_IN; } \
        if constexpr ((m_ & CG_CKV) != 0) { if (r < I_CKV) { tr_item(INP(19) + (size_t)l_ * 2048 * 4096, 2048, 4096, WSP(bf16_t, WS_WCKV), INP(17) + l_ * 2048, nullptr, 0, scr, r, lane); continue; } r -= I_CKV; } \
        if constexpr ((m_ & CG_OUT) != 0) { if (r < I_OUT) { tr_item(INP(15) + (size_t)l_ * 2048 * 2048, 2048, 2048, WSP(bf16_t, WS_WOUT), nullptr, nullptr, 0, scr, r, lane); continue; } r -= I_OUT;   \
            if (r < I_P) { const int g = r >> 5; pool_fold_item(INP(13) + (size_t)l_ * 4 * 65536 + (size_t)g * 65536, INP(14) + l_ * 1024 + g * 256, INP(15) + (size_t)l_ * 2048 * 2048 + (size_t)(1024 + g * 256) * 2048, WSP(bf16_t, WS_WOUT), g, r & 31, lane); continue; } r -= I_P; } \
        if constexpr ((m_ & CG_CQ) != 0) { if (r < I_CQ) { tr_item(INP(18) + (size_t)l_ * 2048 * 2048, 2048, 2048, WSP(bf16_t, WS_WCQ), INP(16) + l_ * 2048, nullptr, 0, scr, r, lane); continue; } r -= I_CQ; } \
        if constexpr ((m_ & CG_CO) != 0) { if (r < I_CO) { tr_item(INP(22) + (size_t)l_ * 2048 * 2048, 2048, 2048, WSP(bf16_t, WS_WCO), nullptr, nullptr, 0, scr, r, lane); continue; } r -= I_CO; } }   \
    if constexpr ((m_ & CG_UP) != 0) { const float* cw = INP(25) + (size_t)l_ * 3 * UP_W; const float* cb = INP(26) + (size_t)l_ * UP_W; u32x4* cwt = WSP(u32x4, WS_CWT);        \
        for (int it = vcu * 512 + tid; it < D_FF; it += G * 512) { const int p = it >> 1, isv = it & 1, ch = 2 * p + isv * D_FF; u32x4 w;                                                          \
            w.x = cvt_pk_f16_rne(cw[ch], cw[ch + 1]); w.y = cvt_pk_f16_rne(cw[UP_W + ch], cw[UP_W + ch + 1]); w.z = cvt_pk_f16_rne(cw[2 * UP_W + ch], cw[2 * UP_W + ch + 1]); w.w = cvt_pk_f16_rne(cb[ch], cb[ch + 1]); cwt[it] = w; } } } while (0)
    for (int l = 0; l < DEPTH; ++l) {
        const int pb = l * PH_PER_LAYER;
        if (PH_EN(0) && IN(pb + 0)) {
            PHASE_BEGIN();
            if (l == 0) CONV_ITEMS(0, CG_IN | CG_CKV);
            bf16_t* HB = WSP(bf16_t, WS_HB);
            if (l == 0) {
                unsigned* csT = WSP(unsigned, WS_COS);
                for (int e = (vcu * 512 + tid); e < 8192 * 32; e += G * 512) { const int pos = e >> 5, i = e & 31;
                    double inv = 1.0; const double b = 0.74989420933245582730;
                    for (int k = 0; k < i; ++k) inv *= b;
                    double rev = (double)pos * inv * 0.15915494309189533577; rev -= __builtin_floor(rev);
                    const float fr_ = (float)rev;
                    const _Float16 hc = (_Float16)__builtin_amdgcn_cosf(fr_), hs = (_Float16)__builtin_amdgcn_sinf(fr_);
                    csT[e] = (unsigned)__builtin_bit_cast(unsigned short, hc) | ((unsigned)__builtin_bit_cast(unsigned short, hs) << 16); }
                bf16_t* MB = WSP(bf16_t, WS_MB);
                for (int m = gw; m < NMEMROWS; m += NGW) { const float* src = m < 1024 ? INP(2) + (size_t)m * 2048 : INP(3) + (size_t)(m - 1024) * 2048; norm_row(src, MB + (size_t)m * 2048, nullptr, lane); }
                rss_t* rss0 = WSP(rss_t, WS_ROWSS);
                for (int m = gw; m < NTOK; m += NGW) { const float* src = m < NTOK_P ? INP(0) + (size_t)m * 2048 : INP(1) + (size_t)(m - NTOK_P) * 2048; raw_row(src, HB + (size_t)m * 2048, rss0 + m, lane); }
            }
        }
        if (l == 0) SEAM(pb + 0);
        if (PH_EN(1) && IN(pb + 1)) {
            PHASE_BEGIN(); pg8::StaticOrder SO;
            if (PH_EN(17)) { pg8::ProbSimple P; P.K = 2048; P.lda = 2048; P.ldb = 2048; P.tsplit = 1 << 30; P.adelta = 0; P.A = (const char*)WSP(bf16_t, WS_HB); P.B = (const char*)WSP(bf16_t, WS_WIN);
              SO.init(NTOK / 256, IN_W / 256, G, bx, 1);
              pg8::EpiIn E{WSP(bf16_t, R_Q), (size_t)NTOK * 1024, WSP(const unsigned, WS_COS), INP(6) + l * 64, INP(7) + l * 64, WSP(const rss_t, WS_ROWSS) + (size_t)(l * 3 + 0) * NTOK};
              pg8::gemm_phase<pg8::ProbSimple, pg8::EpiIn, true, true>(lds, P, SO, E); }
            if (PH_EN(16)) { pg8::ProbSimple P; P.K = 2048; P.lda = 2048; P.ldb = 2048; P.tsplit = 1 << 30; P.adelta = 0; P.A = (const char*)WSP(bf16_t, WS_MB); P.B = (const char*)WSP(bf16_t, WS_WCKV);
              SO.init(NMEMROWS / 256, 4096 / 256, G, bx);
              pg8::EpiKV E{WSP(float, WS_KRAW), WSP(bf16_t, WS_VT)};
              pg8::gemm_phase<pg8::ProbSimple, pg8::EpiKV, true, true>(lds, P, SO, E); }
            if (l == 0) CONV_ITEMS(0, CG_OUT | CG_CO | CG_CQ);
        }
        SEAM(pb + 1);
        if (PH_EN(2) && IN(pb + 2)) {
            if (PH_EN(18)) {
              PHASE_BEGIN();
              const float lam_init = 0.8f - 0.6f * __expf(-0.3f * (float)l);
              float s1 = 0.f, s2 = 0.f; const float* q1 = INP(8) + l * 64; const float* k1 = INP(9) + l * 64; const float* q2 = INP(10) + l * 64; const float* k2 = INP(11) + l * 64;
              for (int i = 0; i < 64; ++i) { s1 += q1[i] * k1[i]; s2 += q2[i] * k2[i]; }
              const float lam = __expf(s1) - __expf(s2) + lam_init;
              const float* gsub = INP(12) + l * 128;
              bf16_t* Qb = WSP(bf16_t, R_Q); const bf16_t* Kb = WSP(const bf16_t, R_K); const bf16_t* Vb = WSP(const bf16_t, R_V);
              __syncthreads();
              { const int NX = (G % 8 == 0) ? 8 : 1, xcd = bx % NX, j = bx / NX, nb = G / NX, npr = 2048 / NX;
                  for (int kk = j; kk < 2 * npr; kk += nb) { int pair, qt, S; size_t t0;
                      if (kk < npr) { pair = xcd + NX * (kk >> 6); qt = kk & 63; S = S_P; t0 = (size_t)(pair >> 3) * S_P; }
                      else { const int k2_ = kk - npr; pair = xcd + NX * (k2_ >> 5); qt = k2_ & 31; S = S_S; t0 = (size_t)NTOK_P + (size_t)(pair >> 3) * S_S; }
                      const int h = pair & 7; bf16_t* qp = Qb + (t0 + (size_t)qt * 128) * 1024 + h * 128;
                      ATTN_NS::attn_unit(qp, Kb + t0 * 1024 + h * 128, Vb + t0 * 1024 + h * 128, qp, S, lam, gsub, 1.f - lam_init, lds, kk < npr && ((kk / nb) & 1)); }
              }
            }
            if (PH_EN(14)) { PHASE_BEGIN(); const bf16_t* U = WSP(const bf16_t, R_U); bf16_t* ZP = (bf16_t*)X;
#ifdef PROBE_DOUBLE_PASSES
              int nrq = 2; asm volatile("" : "+s"(nrq)); for (int rq_ = 0; rq_ < nrq; ++rq_)
#endif
              for (int it = gw; it < (NTOK / 4) * 2; it += NGW) { const int r0 = (it >> 1) * 4, half = it & 1, ch = half * 512 + lane * 8;
                  if (half == 0) pool_item<2>(U, ZP, r0, ch, lane >= 32); else pool_item<8>(U, ZP, r0, ch, lane >= 32); } }
            if (PH_EN(15)) { PHASE_BEGIN(); const float* gcq = INP(20) + l * 512; const float* gck = INP(21) + l * 512; const float* KRAW = WSP(const float, WS_KRAW); bf16_t* KC = WSP(bf16_t, WS_KC);
              for (int it = gw; it < NMEMROWS * 4; it += NGW) { const int row = it >> 2, h = it & 3; const float* kr = KRAW + (size_t)row * 2048 + h * 512 + lane * 8;
                  const f32x4 a = *(const f32x4*)kr, b = *(const f32x4*)(kr + 4); const float ss = wave_sum(pg8::sumsq4(a) + pg8::sumsq4(b));
                  const float rk = __builtin_amdgcn_rsqf(ss * (1.0f / 512.0f) + EPS);
                  const f32x4 ga = *(const f32x4*)(gcq + lane * 8) * *(const f32x4*)(gck + lane * 8), gb = *(const f32x4*)(gcq + lane * 8 + 4) * *(const f32x4*)(gck + lane * 8 + 4);
                  *(u32x4*)(KC + (size_t)row * 2048 + h * 512 + lane * 8) = pg8::pack8(a * rk * ga, b * rk * gb); } }
            { PHASE_BEGIN(); if (l == 0) CONV_ITEMS(0, CG_UP); else CONV_ITEMS(l, CG_DOWN); }
        }
        SEAM(pb + 2);
        if (PH_EN(4) && IN(pb + 4)) {
            PHASE_BEGIN(); pg8::StaticOrder SO;
            pg8::ProbSimple P; P.K = 2048; P.lda = 1024; P.ldb = 2048; P.tsplit = 16; P.adelta = (long long)((const char*)X - (const char*)(ws + R_Q)) - 16ll * 128; P.A = (const char*)(ws + R_Q);   P.B = (const char*)WSP(bf16_t, WS_WOUT);
            SO.init(NTOK / 256, 8, G, bx, 1);
            pg8::EpiRes E{WSP(bf16_t, WS_HB), WSP(rss_t, WS_ROWSS) + (size_t)(l * 3 + 1) * NTOK, nullptr};
            pg8::gemm_phase<pg8::ProbSimple, pg8::EpiRes, true, true>(lds, P, SO, E);
            if (PH_EN(3)) {

              pg8::ProbVW P2; P2.K = 512; P2.lda = 2048; P2.ldb = 2048; P2.tsplit = 1 << 30; P2.adelta = 0; P2.A = (const char*)WSP(bf16_t, WS_WCO); P2.B = (const char*)WSP(bf16_t, WS_VT);
              SO.init(8, 48, G, bx);
              pg8::EpiBf<5> E2{WSP(bf16_t, R_VW), 1024, nullptr, nullptr, nullptr};
              pg8::gemm_phase<pg8::ProbVW, pg8::EpiBf<5>, true, true>(lds, P2, SO, E2); }
            if (l == 0) CONV_ITEMS(0, CG_DOWN);
            if (l + 1 < DEPTH) CONV_ITEMS(l + 1, CG_IN | CG_CKV);
        }
        SEAM(pb + 4);
        if (PH_EN(5) && IN(pb + 5)) {
            PHASE_BEGIN(); pg8::StaticOrder SO;
            pg8::ProbSimple P; P.K = 2048; P.lda = 2048; P.ldb = 2048; P.tsplit = 1 << 30; P.adelta = 0; P.A = (const char*)WSP(bf16_t, WS_HB); P.B = (const char*)WSP(bf16_t, WS_WCQ);
            SO.init(NTOK / 256, 8, G, bx, 0);
            pg8::EpiBf<1> E{WSP(bf16_t, R_QC), 2048, WSP(float, WS_QSS), (float*)(WSP(rss_t, WS_ROWSS) + (size_t)(l * 3 + 1) * NTOK), nullptr};
            pg8::gemm_phase<pg8::ProbSimple, pg8::EpiBf<1>, true, true>(lds, P, SO, E);
            if (l + 1 < DEPTH) CONV_ITEMS(l + 1, CG_OUT | CG_CO);
        }
        SEAM(pb + 5);
        if (PH_EN(6) && IN(pb + 6)) {
            PHASE_BEGIN(); pg8::StaticOrder SO;
            pg8::ProbScores P; P.K = 512; P.lda = 2048; P.ldb = 2048; P.tsplit = 1 << 30; P.adelta = 0; P.A = (const char*)(ws + R_QC); P.B = (const char*)WSP(bf16_t, WS_KC);
            SO.init(NTOK / 256, 4, G, bx, 1);
            pg8::EpiBf<2> E{WSP(bf16_t, R_P), 1024, WSP(float, WS_QSS), nullptr, (LAS float*)(lds + XCH_OFF)};
            pg8::gemm_phase<pg8::ProbScores, pg8::EpiBf<2>, true, true>(lds, P, SO, E);
            if (l + 1 < DEPTH) CONV_ITEMS(l + 1, CG_CQ);
        }
        SEAM(pb + 6);
        if (PH_EN(8) && IN(pb + 7)) {
            PHASE_BEGIN(); pg8::StaticOrder SO;
            pg8::ProbFin P; P.K = 1024; P.lda = 1024; P.ldb = 1024; P.tsplit = 1 << 30; P.adelta = 0; P.A = (const char*)(ws + R_P); P.B = (const char*)WSP(bf16_t, R_VW);
            SO.init(NTOK / 256, 8, G, bx, 0);
            pg8::EpiRes E{WSP(bf16_t, WS_HB), WSP(rss_t, WS_ROWSS) + (size_t)(l * 3 + 2) * NTOK, nullptr};
            pg8::gemm_phase<pg8::ProbFin, pg8::EpiRes, true, true>(lds, P, SO, E);
        }
        SEAM(pb + 7);
        const bool whole = (l + 1 < DEPTH); const int nch = whole ? 1 : N_FFN_CHUNKS;
        for (int c = 0; c < nch; ++c) {
            const int pc = pb + 8 + 2 * c; const size_t r0 = (size_t)c * FFN_CHUNK; const int MT = whole ? NTOK / 256 : FFN_MT;
            if (PH_EN(11) && IN(pc)) {
                PHASE_BEGIN(); pg8::StaticOrder SO;
                pg8::ProbUp P; P.K = 2048; P.lda = 2048; P.ldb = 2048; P.tsplit = 1 << 30; P.adelta = 0; P.A = (const char*)(WSP(bf16_t, WS_HB) + r0 * 2048); P.B = (const char*)WSP(bf16_t, WS_WUP); P.chunk = c;
                SO.init(MT, D_FF / 128, G, bx, 1);
                bf16_t* G2p = (bf16_t*)((unsigned char*)X - (size_t)FFN_GSPLIT_ROW * D_FF * 2); bf16_t* EBp = whole ? (bf16_t*)((unsigned char*)X + FFN_EB_OUT_OFF) : WSP(bf16_t, R_EB);
                pg8::EpiGlu E{WSP(bf16_t, R_G), WSP(const rss_t, WS_ROWSS) + (size_t)(l * 3 + 2) * NTOK + r0, WSP(const u32x4, WS_CWT), c, (LAS float*)(lds + GLX_OFF), EBp, G2p, whole ? FFN_GSPLIT_ROW / 256 : (1 << 30)};
                pg8::gemm_phase<pg8::ProbUp, pg8::EpiGlu, true, true>(lds, P, SO, E);
            }
            SEAM(pc);
            if (PH_EN(13) && IN(pc + 1)) {
                PHASE_BEGIN(); pg8::StaticOrder SO;
                bf16_t* G2p = (bf16_t*)((unsigned char*)X - (size_t)FFN_GSPLIT_ROW * D_FF * 2);
                {
                  const bf16_t* EBp = whole ? (const bf16_t*)((unsigned char*)X + FFN_EB_OUT_OFF) : WSP(const bf16_t, R_EB); const u32x4* cwp = WSP(const u32x4, WS_CWT); bf16_t* Gp = WSP(bf16_t, R_G);
                  const int nb = whole ? 244 : (c == 0 ? 124 : 120), gsr = whole ? FFN_GSPLIT_ROW : (1 << 30);
                  for (int it = gw; it < nb * 11; it += NGW) { const int b = it / 11, cb = it - b * 11; int t;
                      if (whole ? b < 124 : c == 0) { const int sq = b / 31, bi = b - sq * 31; t = sq * S_P + 256 * (bi + 1); }
                      else { const int b2 = whole ? b - 124 : b, sq = b2 / 15, bi = b2 - sq * 15; t = (whole ? NTOK_P : 0) + sq * S_S + 256 * (bi + 1); }
                      pg8::ffn_fix_item(EBp, cwp, Gp, G2p, gsr, t, cb, lane); }
                  XcdBarrier b4_ = bar; asm volatile("" : "+s"(b4_.bar), "+s"(b4_.x)); xcd_barrier(b4_); }
                pg8::ProbDown P; P.K = D_FF; P.lda = D_FF; P.ldb = D_FF; P.tsplit = 1 << 30; P.adelta = 0; P.A = (const char*)(ws + R_G); P.A2 = (const char*)G2p; P.B = (const char*)WSP(bf16_t, WS_WDOWN); P.split = whole ? FFN_GSPLIT_ROW / 256 : (1 << 30);
                SO.init(MT, 8, G, bx, 0);
                pg8::EpiRes E{WSP(bf16_t, WS_HB) + r0 * 2048, (l + 1 < DEPTH) ? WSP(rss_t, WS_ROWSS) + (size_t)((l + 1) * 3 + 0) * NTOK + r0 : nullptr, (l + 1 < DEPTH) ? nullptr : X + r0 * 2048};
                pg8::gemm_phase<pg8::ProbDown, pg8::EpiRes, true, true>(lds, P, SO, E);
                if (c == nch - 1 && l + 1 < DEPTH) CONV_ITEMS(l + 1, CG_UP);
            }
            SEAM(pc + 1);
        }
    }
#undef IN
#undef SEAM
#undef PHASE_BEGIN
#undef INP
#undef WSP
}


#ifdef SELFCHECK
constexpr int CHK_WORD = 1024;
__device__ __forceinline__ void chk_upd(unsigned* ctl, int idx, float got, float ref) { const float e = fabsf(got - ref) / (0.03f * fabsf(ref) + 0.03f); atomicMax(ctl + CHK_WORD + idx, __float_as_uint(e)); }
__device__ __forceinline__ int chk_token(int s) { const int tab[16] = {0, 1, 127, 128, 4095, 8191, 8192, 12345, 32767, 32768, 32769, 36863, 36864, 50000, 65534, 65535}; int t = 0;
#pragma unroll
    for (int i = 0; i < 16; ++i) t = (s & 15) == i ? tab[i] : t; return t; }
__global__ void __launch_bounds__(64) check_kernel(Args args, int after, int l) {
    const int s = blockIdx.x, lane = threadIdx.x; unsigned char* ws = args.ws; unsigned* ctl = (unsigned*)(ws + WS_CTL);
    const int tok = chk_token(s); float* X = args.out;
    const float* xin = tok < NTOK_P ? args.in[0] + (size_t)tok * 2048 : args.in[1] + (size_t)(tok - NTOK_P) * 2048;
    if (after == 1) {
        if (l == 0) {
            float ssx = 0.f; for (int k = lane; k < 2048; k += 64) ssx += xin[k] * xin[k]; ssx = wave_sum(ssx); const float rstd = 1.0f / sqrtf(ssx / 2048.f + EPS);
            const int vec = (s * 7) & 31, isk = vec >> 4, hc = vec & 15;
            const float* w_in = args.in[5]; const float* g_mix = args.in[4]; const int col = isk * 1024 + hc * 64 + lane;
            float z = 0.f; for (int k = 0; k < 2048; ++k) z += xin[k] * rstd * g_mix[k] * w_in[(size_t)k * 4096 + col];
            const float ss = wave_sum(z * z); const float g = (isk ? args.in[7] : args.in[6])[lane]; const float zn = z / sqrtf(ss / 64.f + EPS) * g;
            const float other = __shfl_xor(zn, 32); const int i = lane & 31; const int pos = tok_pos(tok);
            const float ang = (float)pos * powf(10000.f, -(float)i / 32.f); const float c = cosf(ang), sn = sinf(ang);
            const float ref = lane < 32 ? zn * c - other * sn : zn * c + other * sn;
            const bf16_t* Q = (const bf16_t*)(ws + (isk ? R_K : R_Q)); const float got = bf2f(Q[(size_t)tok * 1024 + hc * 64 + lane]);
            const float gother = __shfl_xor(got, 32);
            (void)gother; chk_upd(ctl, 0, got, ref);
            { const unsigned tv = ((const unsigned*)(ws + WS_COS))[pos * 32 + i]; typedef _Float16 h2 __attribute__((ext_vector_type(2))); const h2 hv = __builtin_bit_cast(h2, tv);
              chk_upd(ctl, 1, (float)hv.x, c); chk_upd(ctl, 1, (float)hv.y, sn); }
        }
        { const bf16_t* Q = (const bf16_t*)(ws + R_Q); bf16_t* sv = (bf16_t*)(ws + WS_CHK) + s * 128; const int h = s & 7; sv[lane] = Q[(size_t)tok * 1024 + h * 128 + lane]; sv[lane + 64] = Q[(size_t)tok * 1024 + h * 128 + 64 + lane]; }
    }
    if (after == 2) {
        const int h = s & 7; const bf16_t* sv = (const bf16_t*)(ws + WS_CHK) + s * 128; const int S = tok_seqlen(tok); const size_t t0 = (size_t)tok - tok_pos(tok);
        const bf16_t* K = (const bf16_t*)(ws + R_K) + t0 * 1024 + h * 128; const bf16_t* V = (const bf16_t*)(ws + R_V) + t0 * 1024 + h * 128;
        const float lam_init = 0.8f - 0.6f * expf(-0.3f * (float)l); float s1 = 0.f, s2 = 0.f;
        for (int i = 0; i < 64; ++i) { s1 += (args.in[8] + l * 64)[i] * (args.in[9] + l * 64)[i]; s2 += (args.in[10] + l * 64)[i] * (args.in[11] + l * 64)[i]; }
        const float lam = expf(s1) - expf(s2) + lam_init;
        float o[2][2];
        for (int c = 0; c < 2; ++c) { float mx = -1e30f;
            for (int k = lane; k < S; k += 64) { float d = 0.f; for (int e = 0; e < 64; ++e) d += bf2f(sv[c * 64 + e]) * bf2f(K[(size_t)k * 1024 + c * 64 + e]); mx = fmaxf(mx, d); }
            for (int o_ = 1; o_ < 64; o_ <<= 1) mx = fmaxf(mx, __shfl_xor(mx, o_));
            float lsum = 0.f, a0 = 0.f, a1 = 0.f;
            for (int k = 0; k < S; ++k) { float d = 0.f; for (int e = 0; e < 64; ++e) d += bf2f(sv[c * 64 + e]) * bf2f(K[(size_t)k * 1024 + c * 64 + e]);
                const float p = exp2f(d - mx); lsum += p; a0 += p * bf2f(V[(size_t)k * 1024 + lane]); a1 += p * bf2f(V[(size_t)k * 1024 + 64 + lane]); }
            o[c][0] = a0 / lsum; o[c][1] = a1 / lsum; }
        const float v0 = o[0][0] - lam * o[1][0], v1 = o[0][1] - lam * o[1][1]; const float ss = wave_sum(v0 * v0 + v1 * v1); const float rn = 1.0f / sqrtf(ss / 128.f + EPS) * (1.f - lam_init);
        const float* gsub = args.in[12] + l * 128; const bf16_t* A = (const bf16_t*)(ws + R_Q) + (size_t)tok * 1024 + h * 128;
        chk_upd(ctl, 2, bf2f(A[lane]), v0 * rn * gsub[lane]); chk_upd(ctl, 2, bf2f(A[64 + lane]), v1 * rn * gsub[64 + lane]);
    }
    if (after == 4 && l == 0) {
        const bf16_t* A = (const bf16_t*)(ws + R_Q) + (size_t)tok * 1024; const bf16_t* Pp = (const bf16_t*)(ws + R_POUT) + (size_t)tok * 1024; const float* w_out = args.in[15];
        const int col = (s * 131 + lane * 17) & 2047; float z = xin[col];
        for (int k = 0; k < 1024; ++k) z += bf2f(A[k]) * w_out[(size_t)k * 2048 + col];
        for (int k = 0; k < 1024; ++k) z += bf2f(Pp[k]) * w_out[(size_t)(1024 + k) * 2048 + col];
        chk_upd(ctl, 3, X[(size_t)tok * 2048 + col], z);
    }
    if (after == 8 && tok < FFN_CHUNK) {
        const bf16_t* HB = (const bf16_t*)(ws + WS_HB); const float* w_up = args.in[24] + (size_t)l * 2048 * UP_W; const float* g_ffn = args.in[23] + l * 2048;
        const float* cw = args.in[25] + (size_t)l * 3 * UP_W; const float* cb = args.in[26] + (size_t)l * UP_W;
        const int j = (s * 977 + lane * 53) % D_FF; const int pos = tok_pos(tok), S = tok_seqlen(tok); float u2[2];
        for (int half = 0; half < 2; ++half) { const int col = half * D_FF + j; float acc = cb[col];
            for (int tap = 0; tap < 3; ++tap) { const int pp = pos + tap - 1; if (pp < 0 || pp >= S) continue; const bf16_t* hr = HB + (size_t)(tok + tap - 1) * 2048; float d = 0.f;
                for (int k = 0; k < 2048; ++k) d += bf2f(hr[k]) * g_ffn[k] * w_up[(size_t)k * UP_W + col];
                const float rxx = ss_rstd(((const rss_t*)(ws + WS_ROWSS))[(size_t)(l * 3 + 2) * NTOK + tok + tap - 1]); acc += d * rxx * cw[(size_t)tap * UP_W + col]; }
            u2[half] = acc; }
        const float x = u2[0]; const float ref = 0.5f * x * (1.f + tanhf(0.7978845608028654f * (x + 0.044715f * x * x * x))) * u2[1];
        chk_upd(ctl, 4, bf2f(((const bf16_t*)(ws + R_G))[(size_t)tok * D_FF + j]), ref);
    }
    if (false) {
        const bf16_t* Gr = (const bf16_t*)(ws + R_G) + (size_t)tok * D_FF; const float* w_down = args.in[27] + (size_t)l * D_FF * 2048; const float* svx = (const float*)(ws + WS_CHK + 65536) + (size_t)s * 2048;
        const int col = (s * 131 + lane * 17) & 2047; float z = svx[col]; for (int k = 0; k < D_FF; ++k) z += bf2f(Gr[k]) * w_down[(size_t)k * 2048 + col];
        chk_upd(ctl, 5, X[(size_t)tok * 2048 + col], z);
    }
}
__global__ void __launch_bounds__(256) report_kernel(Args args) {
    unsigned* ctl = (unsigned*)(args.ws + WS_CTL); float* out = args.out;
    for (size_t i = (size_t)blockIdx.x * 256 + threadIdx.x; i < (size_t)NTOK * 2048; i += (size_t)gridDim.x * 256) {
        float v = 0.f;
        if (i == 0) { int mask = 0; for (int b = 0; b < 6; ++b) if (__uint_as_float(ctl[CHK_WORD + b]) > 1.0f) mask |= 1 << b; v = (10.f + (float)mask) * 1000.f; }
        out[i] = v; }
}
#endif

extern "C" void kernel_launch(void* const* d_in, const int* in_sizes, int n_in, void* d_out, int out_size, void* d_ws, size_t ws_size, hipStream_t stream) {
    static int grid = 0;
    if (grid == 0) {
        if (n_in != 28 || out_size != NTOK * D_MODEL || ws_size < WS_END) { fprintf(stderr, "kernel_launch: unexpected shapes: n_in %d out %d ws %zu (need >= %zu)\n", n_in, out_size, ws_size, (size_t)WS_END); grid = -1; return; }
        int dev = 0, cus = 0, per_cu = 0;
        if (hipGetDevice(&dev) != hipSuccess || hipDeviceGetAttribute(&cus, hipDeviceAttributeMultiprocessorCount, dev) != hipSuccess) { grid = -1; return; }
        if (hipFuncSetAttribute((const void*)trunk_fwd, hipFuncAttributeMaxDynamicSharedMemorySize, LDS_BYTES) != hipSuccess) { fprintf(stderr, "kernel_launch: hipFuncSetAttribute failed\n"); grid = -1; return; }
        if (hipOccupancyMaxActiveBlocksPerMultiprocessor(&per_cu, (const void*)trunk_fwd, NWAVES * 64, LDS_BYTES) != hipSuccess || per_cu < 1)
            fprintf(stderr, "kernel_launch: occupancy query reports %d workgroups per CU\n", per_cu);
        (void)hipGetLastError();
        grid = cus;
    }
    if (grid < 0) return;
    (void)hipMemsetAsync((char*)d_ws + WS_CTL, 0, CTL_ZERO_BYTES, stream);
    Args a{};
    for (int i = 0; i < 28; ++i) a.in[i] = (const float*)d_in[i];
    a.out = (float*)d_out; a.ws = (unsigned char*)d_ws;
#if ML_PER_PHASE
    for (int p = 0; p < N_PHASES; ++p) { a.ph_lo = p; a.ph_hi = p + 1; hipLaunchKernelGGL(trunk_fwd, dim3(grid), dim3(NWAVES * 64), LDS_BYTES, stream, a);
#ifdef SELFCHECK
        { const int l = p / PH_PER_LAYER, q = p % PH_PER_LAYER; if (l == SELFCHECK_LAYER && (q == 1 || q == 2 || q == 8)) hipLaunchKernelGGL(check_kernel, dim3(64), dim3(64), 0, stream, a, q, l); }
#endif
    }
#ifdef SELFCHECK
    hipLaunchKernelGGL(report_kernel, dim3(2048), dim3(256), 0, stream, a);
#endif
#else
    a.ph_lo = 0; a.ph_hi = N_PHASES;
    hipLaunchKernelGGL(trunk_fwd, dim3(grid), dim3(NWAVES * 64), LDS_BYTES, stream, a);
#endif
    const hipError_t le = hipPeekAtLastError();
    if (le != hipSuccess) fprintf(stderr, "kernel_launch: launch failed: %s\n", hipGetErrorName(le));
}
```

```cpp
#include <hip/hip_runtime.h>
#include <cstdio>
#include <cstdint>

#define SELFCHECK_LAYER 0
#ifndef ML_PER_PHASE
#define ML_PER_PHASE 0
#endif

#ifndef PHASE_MASK
#define PHASE_MASK 0xFFFFFFFFu
#endif
#define PH_EN(p) (((PHASE_MASK) >> (p)) & 1u)
#ifndef ATTN_NS
#define ATTN_NS att16
#endif
#define LAS __attribute__((address_space(3)))
#define GAS __attribute__((address_space(1)))
typedef unsigned short bf16_t;
typedef short bf16x8 __attribute__((ext_vector_type(8)));
typedef short s16x4 __attribute__((ext_vector_type(4)));
typedef float f32x4 __attribute__((ext_vector_type(4)));
typedef float f32x2 __attribute__((ext_vector_type(2)));
typedef float f32x16 __attribute__((ext_vector_type(16)));
typedef unsigned u32x4 __attribute__((ext_vector_type(4)));
typedef unsigned u32x2 __attribute__((ext_vector_type(2)));
typedef _Float16 h2_t __attribute__((ext_vector_type(2)));
typedef _Float16 f16x8 __attribute__((ext_vector_type(8)));

constexpr int D_MODEL = 2048, DEPTH = 2;
constexpr int NTOK = 65536;
constexpr int NTOK_P = 32768;
constexpr int S_P = 8192, S_S = 4096;
constexpr int NMEMROWS = 3072;
constexpr int IN_W = 4096, D_FF = 5632, UP_W = 11264;
constexpr float EPS = 1e-6f;
constexpr float QSCALE = 0.125f * 1.4426950408889634f;
constexpr int FFN_CHUNK = 32768, N_FFN_CHUNKS = 2;
constexpr int FFN_MT = FFN_CHUNK / 256, FFN_BT = 0;
constexpr int PH_PER_LAYER = 8 + 2 * N_FFN_CHUNKS;
constexpr int N_PHASES = DEPTH * PH_PER_LAYER;

constexpr size_t MiB = 1u << 20;
constexpr size_t WS_CTL = 0, CTL_ZERO_BYTES = 5 * MiB;
constexpr size_t WS_ROWSS = 1 * MiB;
constexpr size_t WS_COS = 5 * MiB;
constexpr size_t WS_QSS = 6 * MiB;
constexpr size_t WS_LPART = 14 * MiB;
constexpr size_t WS_MB = 18 * MiB;
constexpr size_t WS_KRAW = 30 * MiB;
constexpr size_t WS_KC = 54 * MiB;
constexpr size_t WS_VT = 66 * MiB;
constexpr size_t WS_CHK = 78 * MiB;
constexpr size_t WS_WIN = 79 * MiB, WS_WP = 95 * MiB, WS_WOUT = 96 * MiB, WS_WCQ = 104 * MiB, WS_WCKV = 112 * MiB, WS_WCO = 128 * MiB, WS_WUP = 136 * MiB, WS_WDOWN = 180 * MiB;
constexpr size_t WS_HB = 203 * MiB;
constexpr size_t WS_R = 459 * MiB;
constexpr size_t WS_CWT = 987 * MiB;
constexpr size_t WS_END = 988 * MiB;
typedef unsigned long long rss_t;
__device__ __forceinline__ rss_t ss_fix(float s) { return (rss_t)(s * 1048576.0f + 0.5f); }
__device__ __forceinline__ float ss_rstd(rss_t v) { return __builtin_amdgcn_rsqf((float)v * (1.0f / (1048576.0f * 2048.0f)) + 1e-6f); }
constexpr size_t R_Q = WS_R, R_K = WS_R + 128 * MiB, R_V = WS_R + 256 * MiB, R_U = WS_R + 384 * MiB;
constexpr size_t R_QC = WS_R, R_P = WS_R + 256 * MiB, R_VW = WS_R + 384 * MiB;
constexpr size_t R_G = WS_R;
constexpr int FFN_GSPLIT_ROW = 49152;
constexpr size_t FFN_EB_OUT_OFF = 192 * MiB;
constexpr size_t R_EB = WS_R + 384 * MiB;
constexpr size_t R_POUT = WS_R + 128 * MiB;
static_assert(R_G + (size_t)FFN_CHUNK * D_FF * 2 <= WS_END, "ws map");
constexpr int CW_BAR = 4096;

constexpr int RING_BYTES = 131072;
constexpr int LDSCTL_OFF = RING_BYTES, MISC_OFF = LDSCTL_OFF + 320, XCH_OFF = LDSCTL_OFF + 1024, GLX_OFF = XCH_OFF + 4096;
constexpr int LDS_BYTES = 151552;
constexpr int NWAVES = 8;

__device__ __forceinline__ unsigned cvt_pk_bf16(float lo, float hi) { unsigned r; asm volatile("v_cvt_pk_bf16_f32 %0, %1, %2" : "=v"(r) : "v"(lo), "v"(hi)); return r; }
__device__ __forceinline__ float bf2f(unsigned short b) { return __uint_as_float(((unsigned)b) << 16); }
__device__ __forceinline__ float bflo(unsigned w) { return __uint_as_float(w << 16); }
__device__ __forceinline__ float bfhi(unsigned w) { return __uint_as_float(w & 0xffff0000u); }
__device__ __forceinline__ int tok_pos(int row) { return row < NTOK_P ? (row & (S_P - 1)) : (row & (S_S - 1)); }
__device__ __forceinline__ int tok_seqlen(int row) { return row < NTOK_P ? S_P : S_S; }
__device__ __forceinline__ int tile_batch(int pm) { return pm < 128 ? (pm >> 5) : 4 + ((pm - 128) >> 4); }

namespace pg8 {
constexpr int BM = 256, BK = 64, HALF = 128, HTB = HALF * BK * 2, STAGE_BYTES = 8 * HTB, NXCD = 8, WGM = 4;
__host__ __device__ __forceinline__ int lds_byte(int r, int c) { const int st = (r >> 4) * 2 + (c >> 5), rr = r & 15, cc = c & 31, ob = rr * 64 + cc * 2; return st * 1024 + (ob ^ (((ob >> 9) & 1) << 5)); }
__host__ __device__ __forceinline__ void stage_rc(int b, int& R, int& C) { const int st = b / 1024, sb = b % 1024, swz = sb ^ (((sb >> 9) & 1) << 5); R = (st >> 1) * 16 + swz / 64; C = (st & 1) * 32 + (swz % 64) / 2; }
__host__ __device__ __forceinline__ int perm32(int rho) { const int n = rho >> 4, i = rho & 15; return 8 * (i >> 2) + 4 * n + (i & 3); }
struct Unit { int pm, pn; };
struct StaticOrder {
    int nM, nN, nwg, G, c, rv;
    __host__ __device__ void init(int nM_, int nN_, int G_, int c_, int rv_ = 0) { nM = nM_; nN = nN_; nwg = nM * nN; G = G_; c = c_; rv = rv_; }
    __host__ __device__ bool next(int i, Unit& u) const {
        const long L = (long)i * G + c; if (L >= nwg) return false;
        int wgid = (int)L; { const int q = nwg / NXCD, r = nwg % NXCD, xcd = wgid % NXCD; int off = wgid / NXCD; if (rv && r == 0) off = q - 1 - off; wgid = (xcd < r ? xcd * (q + 1) : r * (q + 1) + (xcd - r) * q) + off; }
        const int nig = WGM * nN, gid = wgid / nig, fm = gid * WGM, gsz = (nM - fm) < WGM ? (nM - fm) : WGM;
        u.pm = fm + ((wgid % nig) % gsz); u.pn = (wgid % nig) / gsz; return true;
    }
};
struct ProbBase { static constexpr bool GATHER = false; static constexpr bool F16 = false; int K, lda, ldb, tsplit; long long adelta; __device__ __forceinline__ unsigned rowoff(const Unit&, int) const { return 0u; } };

template <class Prob, class Epi, bool ALIGN_EPI, bool SP2>
__device__ __forceinline__ void gemm_phase(LAS unsigned char* lds, const Prob& P, const StaticOrder& S, const Epi& E) {
    static_assert(SP2, "only the two-super-phase loop is kept in this file");
    int tid_l = threadIdx.x; asm volatile("" : "+v"(tid_l));
    const int tid = tid_l, wid = __builtin_amdgcn_readfirstlane(tid >> 6), lane = tid & 63, wr = wid >> 2, wc = wid & 3, fr = lane & 15, fq = lane >> 4;
    const int K = P.K, nt = K / BK, lda = P.lda, ldb = P.ldb, tsplit = P.tsplit; const long long adelta = P.adelta;
    unsigned voffA[2], voffB[2];
#pragma unroll
    for (int i = 0; i < 2; ++i) { int R, C; stage_rc(tid * 16 + i * 8192, R, C); const int Rb = Epi::PERM ? ((R & ~31) + perm32(R & 31)) : R;
        voffA[i] = (unsigned)(R * lda + C) * 2u; voffB[i] = (unsigned)(Rb * ldb + C) * 2u; }
    const size_t kstep = (size_t)(BK * 2);
    const size_t hstepA = (size_t)HALF * lda * 2, hstepB = (size_t)HALF * ldb * 2;
    const unsigned ldsw = (unsigned)wid * 1024u;
    const int aoff = lds_byte(wr * 64 + fr, fq * 8), boff = lds_byte(wc * 32 + fr, fq * 8);
    unsigned vAc[2][2], vAn[2][2];
#define PG8_SA(b, h) (((b) * 2 + (h)) * HTB)
#define PG8_SB(b, h) ((4 + (b) * 2 + (h)) * HTB)
#define PG8_STAGE(bufoff, gbase, voff) do { _Pragma("unroll") for (int _i = 0; _i < 2; ++_i) \
        __builtin_amdgcn_global_load_lds((const unsigned*)((const char*)(gbase) + (voff)[_i]), (LAS unsigned*)(lds + (bufoff) + ldsw + _i * 8192), 16, 0, 0); } while (0)
#define PG8_STAGE_A(bufoff, kptr, h, NXT) do { if constexpr (Prob::GATHER) { _Pragma("unroll") for (int _i = 0; _i < 2; ++_i) \
        __builtin_amdgcn_global_load_lds((const unsigned*)((const char*)(kptr) + ((NXT) ? vAn[h][_i] : vAc[h][_i])), (LAS unsigned*)(lds + (bufoff) + ldsw + _i * 8192), 16, 0, 0); } \
        else { PG8_STAGE(bufoff, (kptr) + (h) * hstepA, voffA); } } while (0)
#define PG8_GATHER_OFFS(dst, unit) do { _Pragma("unroll") for (int _i = 0; _i < 2; ++_i) { int _R, _C; stage_rc(tid * 16 + _i * 8192, _R, _C); _Pragma("unroll") for (int _h = 0; _h < 2; ++_h) dst[_h][_i] = P.rowoff(unit, _R + 128 * _h) + (unsigned)_C * 2u; } } while (0)
#define PG8_LDA(dst, b, h) do { _Pragma("unroll") for (int m = 0; m < 4; ++m) _Pragma("unroll") for (int k = 0; k < 2; ++k) dst[m][k] = *(const LAS bf16x8*)(lds + PG8_SA(b, h) + aoff + m * 2048 + k * 1024); } while (0)
#define PG8_LDB(dst, b, h) do { _Pragma("unroll") for (int n = 0; n < 2; ++n) _Pragma("unroll") for (int k = 0; k < 2; ++k) dst[n][k] = *(const LAS bf16x8*)(lds + PG8_SB(b, h) + boff + n * 2048 + k * 1024); } while (0)
#define PG8_MMA(ai, bj, At, Bt) do { __builtin_amdgcn_s_setprio(1); _Pragma("unroll") for (int m = 0; m < 4; ++m) _Pragma("unroll") for (int n = 0; n < 2; ++n) _Pragma("unroll") for (int k = 0; k < 2; ++k) \
        { if constexpr (Prob::F16) acc[ai][bj][m][n] = __builtin_amdgcn_mfma_f32_16x16x32_f16(__builtin_bit_cast(f16x8, Bt[n][k]), __builtin_bit_cast(f16x8, At[m][k]), acc[ai][bj][m][n], 0, 0, 0); \
          else acc[ai][bj][m][n] = __builtin_amdgcn_mfma_f32_16x16x32_bf16(Bt[n][k], At[m][k], acc[ai][bj][m][n], 0, 0, 0); } __builtin_amdgcn_s_setprio(0); } while (0)
#define PG8_WAIT_V(n) asm volatile("s_waitcnt vmcnt(" #n ")" ::: "memory")
#define PG8_WAIT_L(n) asm volatile("s_waitcnt lgkmcnt(" #n ")" ::: "memory")
#define PG8_BAR __builtin_amdgcn_s_barrier()
#define PG8_SCHED __builtin_amdgcn_sched_barrier(0)
#define PG8_AK(base, t) ((base) + (size_t)(t) * kstep + (((t) >= tsplit) ? adelta : 0ll))
    Unit cur, nxt; int ui = 0;
    if (!S.next(0, cur)) return;
    f32x4 acc[2][2][4][2];
#pragma unroll
    for (int a = 0; a < 2; ++a)
#pragma unroll
        for (int b = 0; b < 2; ++b)
#pragma unroll
            for (int m = 0; m < 4; ++m)
#pragma unroll
                for (int n = 0; n < 2; ++n) acc[a][b][m][n] = (f32x4){0.f, 0.f, 0.f, 0.f};
    bf16x8 At[4][2], B0[2][2], B1[2][2];
    const char* cA = P.aptr(cur); const char* cB = P.bptr(cur);
    if constexpr (Prob::GATHER) { PG8_GATHER_OFFS(vAc, cur); }
    PG8_STAGE(PG8_SB(0, 0), cB, voffB); PG8_STAGE(PG8_SB(0, 1), cB + hstepB, voffB); PG8_STAGE_A(PG8_SA(0, 0), cA, 0, false); PG8_STAGE_A(PG8_SA(0, 1), cA, 1, false);
    if (wr == 1) PG8_BAR;
    PG8_WAIT_V(2); PG8_BAR;
    PG8_STAGE(PG8_SB(1, 0), cB + kstep, voffB); PG8_STAGE_A(PG8_SA(1, 0), PG8_AK(cA, 1), 0, false); PG8_STAGE(PG8_SB(1, 1), cB + hstepB + kstep, voffB);
    PG8_WAIT_V(6); PG8_BAR;
    for (;;) {
        const bool has_next = S.next(ui + 1, nxt);
        const char* nA = has_next ? P.aptr(nxt) : cA; const char* nB = has_next ? P.bptr(nxt) : cB;
        if constexpr (Prob::GATHER) { if (has_next) { PG8_GATHER_OFFS(vAn, nxt); } else {
#pragma unroll
            for (int _h = 0; _h < 2; ++_h)
#pragma unroll
                for (int _i = 0; _i < 2; ++_i) vAn[_h][_i] = vAc[_h][_i]; } }
        for (int t = 0; t < nt; t += 2) {
            const bool last = (t == nt - 2);
            const char* a1 = PG8_AK(cA, t + 1);
            const char* a2 = last ? nA : PG8_AK(cA, t + 2); const char* b2 = last ? nB : cB + (size_t)(t + 2) * kstep;
            const char* a3 = last ? PG8_AK(nA, 1) : PG8_AK(cA, t + 3); const char* b3 = b2 + kstep;
            PG8_LDB(B0, 0, 0); PG8_LDB(B1, 0, 1); PG8_SCHED; PG8_LDA(At, 0, 0); PG8_STAGE_A(PG8_SA(1, 1), a1, 1, false);
            PG8_WAIT_V(8); PG8_WAIT_L(0); PG8_BAR; PG8_MMA(0, 0, At, B0); PG8_MMA(0, 1, At, B1); PG8_BAR; PG8_SCHED;
            PG8_LDA(At, 0, 1); PG8_STAGE(PG8_SB(0, 0), b2, voffB); PG8_STAGE(PG8_SB(0, 1), b2 + hstepB, voffB); PG8_STAGE_A(PG8_SA(0, 0), a2, 0, last);
            PG8_WAIT_V(8); PG8_WAIT_L(0); PG8_BAR; PG8_MMA(1, 0, At, B0); PG8_MMA(1, 1, At, B1); PG8_BAR; PG8_SCHED;
            PG8_LDB(B0, 1, 0); PG8_LDB(B1, 1, 1); PG8_SCHED; PG8_LDA(At, 1, 0); PG8_STAGE_A(PG8_SA(0, 1), a2, 1, last);
            PG8_WAIT_V(8); PG8_WAIT_L(0); PG8_BAR; PG8_MMA(0, 0, At, B0); PG8_MMA(0, 1, At, B1); PG8_BAR; PG8_SCHED;
            PG8_LDA(At, 1, 1); PG8_STAGE(PG8_SB(1, 0), b3, voffB); PG8_STAGE(PG8_SB(1, 1), b3 + hstepB, voffB); PG8_STAGE_A(PG8_SA(1, 0), a3, 0, last);
            PG8_WAIT_V(8); PG8_WAIT_L(0); PG8_BAR; PG8_MMA(1, 0, At, B0); PG8_MMA(1, 1, At, B1); PG8_BAR; PG8_SCHED;
        }
        if constexpr (ALIGN_EPI) { if (wr == 0) PG8_BAR; }
        { int te = threadIdx.x; asm volatile("" : "+v"(te));
          const int we = __builtin_amdgcn_readfirstlane(te >> 6), le = te & 63; E(acc, cur, we >> 2, we & 3, le & 15, le >> 4); }
        if (!has_next) break;
#pragma unroll
        for (int a = 0; a < 2; ++a)
#pragma unroll
            for (int b = 0; b < 2; ++b)
#pragma unroll
                for (int m = 0; m < 4; ++m)
#pragma unroll
                    for (int n = 0; n < 2; ++n) acc[a][b][m][n] = (f32x4){0.f, 0.f, 0.f, 0.f};
        cur = nxt; cA = nA; cB = nB; ++ui;
        if constexpr (Prob::GATHER) {
#pragma unroll
            for (int _h = 0; _h < 2; ++_h)
#pragma unroll
                for (int _i = 0; _i < 2; ++_i) vAc[_h][_i] = vAn[_h][_i]; }
        if constexpr (ALIGN_EPI) { if (wr == 1) PG8_BAR; }
    }
    PG8_WAIT_V(0);
    if constexpr (!ALIGN_EPI) { if (wr == 0) PG8_BAR; }
    PG8_BAR;
#undef PG8_SA
#undef PG8_SB
#undef PG8_STAGE
#undef PG8_STAGE_A
#undef PG8_GATHER_OFFS
#undef PG8_LDA
#undef PG8_LDB
#undef PG8_MMA
#undef PG8_WAIT_V
#undef PG8_WAIT_L
#undef PG8_BAR
#undef PG8_SCHED
#undef PG8_AK
}

struct ProbSimple : ProbBase {
    const char* A; const char* B;
    __device__ __forceinline__ const char* aptr(const Unit& u) const { return A + (size_t)u.pm * 256 * lda * 2; }
    __device__ __forceinline__ const char* bptr(const Unit& u) const { return B + (size_t)u.pn * 256 * ldb * 2; }
};
struct ProbSimpleF16 : ProbSimple { static constexpr bool F16 = true; };
struct ProbDown : ProbBase {
    static constexpr bool F16 = true;
    const char* A; const char* A2; const char* B; int split;
    __device__ __forceinline__ const char* aptr(const Unit& u) const { return (u.pm < split ? A : A2) + (size_t)u.pm * 256 * lda * 2; }
    __device__ __forceinline__ const char* bptr(const Unit& u) const { return B + (size_t)u.pn * 256 * ldb * 2; }
};
struct ProbPool : ProbBase {
    const char* A; const char* B;
    __device__ __forceinline__ const char* aptr(const Unit& u) const { return A + ((size_t)u.pm * 256 * 1024 + (size_t)u.pn * 256) * 2; }
    __device__ __forceinline__ const char* bptr(const Unit& u) const { return B + (size_t)u.pn * 65536 * 2; }
};
struct ProbScores : ProbBase {
    const char* A; const char* B;
    __device__ __forceinline__ const char* aptr(const Unit& u) const { return A + ((size_t)u.pm * 256 * 2048 + (size_t)u.pn * 512) * 2; }
    __device__ __forceinline__ const char* bptr(const Unit& u) const { return B + ((size_t)tile_batch(u.pm) * 256 * 2048 + (size_t)u.pn * 512) * 2; }
};
struct ProbVW : ProbBase {
    const char* A; const char* B;
    __device__ __forceinline__ const char* aptr(const Unit& u) const { return A + ((size_t)u.pm * 256 * 2048 + (size_t)(u.pn & 3) * 512) * 2; }
    __device__ __forceinline__ const char* bptr(const Unit& u) const { return B + ((size_t)(u.pn >> 2) * 256 * 2048 + (size_t)(u.pn & 3) * 512) * 2; }
};
struct ProbFin : ProbBase {
    const char* A; const char* B;
    __device__ __forceinline__ const char* aptr(const Unit& u) const { return A + (size_t)u.pm * 256 * 1024 * 2; }
    __device__ __forceinline__ const char* bptr(const Unit& u) const { return B + ((size_t)tile_batch(u.pm) * 2048 + (size_t)u.pn * 256) * 1024 * 2; }
};
struct ProbPV : ProbBase {
    const char* A; const char* B;
    __device__ __forceinline__ const char* aptr(const Unit& u) const { return A + ((size_t)u.pm * 256 * 1024 + (size_t)(u.pn >> 1) * 256) * 2; }
    __device__ __forceinline__ const char* bptr(const Unit& u) const { return B + ((size_t)tile_batch(u.pm) * 2048 + (size_t)u.pn * 256) * 256 * 2; }
};

__device__ __forceinline__ u32x4 pack8(const f32x4& v0, const f32x4& v1) { u32x4 w; w.x = cvt_pk_bf16(v0[0], v0[1]); w.y = cvt_pk_bf16(v0[2], v0[3]); w.z = cvt_pk_bf16(v1[0], v1[1]); w.w = cvt_pk_bf16(v1[2], v1[3]); return w; }
__device__ __forceinline__ float sumsq4(const f32x4& x) { return (x[0] * x[0] + x[1] * x[1]) + (x[2] * x[2] + x[3] * x[3]); }
__device__ __forceinline__ float sum4(const f32x4& x) { return (x[0] + x[1]) + (x[2] + x[3]); }
__device__ __forceinline__ float red_fq(float s) { s += __shfl_xor(s, 16); s += __shfl_xor(s, 32); return s; }

struct EpiIn {
    static constexpr bool PERM = true;
    bf16_t* base; size_t spl; const unsigned* csT; const float* gq; const float* gk; const rss_t* rowss;
    __device__ __forceinline__ void operator()(const f32x4 (&acc)[2][2][4][2], const Unit& u, int wr, int wc, int fr, int fq) const {
        typedef _Float16 h2 __attribute__((ext_vector_type(2)));
        const int t = u.pn >> 2; bf16_t* O = base + (size_t)t * spl; const int colt = (u.pn & 3) * 256; const int row0 = u.pm * BM + wr * 64 + fr;
        if (t >= 2) {
            const int col0 = colt + wc * 32 + 8 * fq;
#pragma unroll
            for (int ai = 0; ai < 2; ++ai) { rss_t rx[4];
#pragma unroll
                for (int m = 0; m < 4; ++m) rx[m] = rowss[row0 + ai * HALF + m * 16];
#pragma unroll
                for (int m = 0; m < 4; ++m) { const float rxm = ss_rstd(rx[m]); bf16_t* rowp = O + (size_t)(row0 + ai * HALF + m * 16) * 1024 + col0;
#pragma unroll
                    for (int bj = 0; bj < 2; ++bj) *(u32x4*)(rowp + bj * HALF) = pack8(acc[ai][bj][m][0] * rxm, acc[ai][bj][m][1] * rxm); }
                asm volatile("" ::: "memory"); }
        } else {
            const float* g = t ? gk : gq; f32x4 g1[2], g2[2];
#pragma unroll
            for (int n = 0; n < 2; ++n) { g1[n] = *(const f32x4*)(g + 8 * fq + 4 * n); g2[n] = *(const f32x4*)(g + 32 + 8 * fq + 4 * n); }
            const int col0 = colt + 64 * wc + 8 * fq;
#pragma unroll
            for (int ah = 0; ah < 4; ++ah) { const int ai = ah >> 1, mb = (ah & 1) * 2;
                u32x4 cs[2][2]; rss_t rx[2];
#pragma unroll
                for (int mm = 0; mm < 2; ++mm) { const int m = mb + mm; const int pos = tok_pos(row0 + ai * HALF + m * 16); rx[mm] = rowss[row0 + ai * HALF + m * 16];
#pragma unroll
                    for (int n = 0; n < 2; ++n) cs[mm][n] = *(const u32x4*)(csT + pos * 32 + 8 * fq + 4 * n); }
#pragma unroll
                for (int mm = 0; mm < 2; ++mm) { const int m = mb + mm; const int row = row0 + ai * HALF + m * 16;
                    float ss = (sumsq4(acc[ai][0][m][0]) + sumsq4(acc[ai][0][m][1])) + (sumsq4(acc[ai][1][m][0]) + sumsq4(acc[ai][1][m][1]));
                    ss = red_fq(ss);
                    const float rxm = ss_rstd(rx[mm]);
                    const float r = __builtin_amdgcn_rsqf(ss * rxm * rxm * (1.0f / 64.0f) + EPS) * rxm * (t ? 1.0f : QSCALE);
                    f32x4 o1[2], o2[2];
#pragma unroll
                    for (int n = 0; n < 2; ++n) { f32x4 c, s;
#pragma unroll
                        for (int j = 0; j < 4; ++j) { const unsigned w = cs[mm][n][j]; const h2 v = __builtin_bit_cast(h2, w); c[j] = (float)v.x; s[j] = (float)v.y; }
                        const f32x4 x1 = acc[ai][0][m][n] * r * g1[n], x2 = acc[ai][1][m][n] * r * g2[n];
                        o1[n] = x1 * c - x2 * s; o2[n] = x2 * c + x1 * s; }
                    bf16_t* rowp = O + (size_t)row * 1024 + col0;
                    *(u32x4*)(rowp) = pack8(o1[0], o1[1]); *(u32x4*)(rowp + 32) = pack8(o2[0], o2[1]); }
                asm volatile("" ::: "memory"); }
        }
    }
};
template <int MODE> struct EpiBf {
    static constexpr bool PERM = true;
    bf16_t* O; int ldc; float* aux; float* aux2; LAS float* xl;
    __device__ __forceinline__ void operator()(f32x4 (&acc)[2][2][4][2], const Unit& u, int wr, int wc, int fr, int fq) const {
        const int row0 = u.pm * BM + wr * 64 + fr; const int col0 = u.pn * BM + wc * 32 + 8 * fq;
        float rs[2][4];
        if constexpr (MODE == 2) {
            f32x4 qa[2][4][2];
#pragma unroll
            for (int ai = 0; ai < 2; ++ai)
#pragma unroll
                for (int m = 0; m < 4; ++m) { const float* p = aux + (size_t)(row0 + ai * HALF + m * 16) * 32 + u.pn * 8; qa[ai][m][0] = *(const f32x4*)p; qa[ai][m][1] = *(const f32x4*)(p + 4); }
#pragma unroll
            for (int ai = 0; ai < 2; ++ai)
#pragma unroll
                for (int m = 0; m < 4; ++m) { const float sc = __builtin_amdgcn_rsqf((sum4(qa[ai][m][0]) + sum4(qa[ai][m][1])) * (1.0f / 512.0f) + EPS) * (0.044194173824159216f * 1.4426950408889634f); float ps = 0.f;
#pragma unroll
                    for (int bj = 0; bj < 2; ++bj)
#pragma unroll
                        for (int n = 0; n < 2; ++n) { f32x4 p;
#pragma unroll
                            for (int j = 0; j < 4; ++j) p[j] = __builtin_amdgcn_exp2f(acc[ai][bj][m][n][j] * sc);
                            acc[ai][bj][m][n] = p; ps += sum4(p); }
                    ps = red_fq(ps);
                    if (fq == 0) xl[(ai * HALF + wr * 64 + m * 16 + fr) * 4 + wc] = ps; }
            asm volatile("s_waitcnt lgkmcnt(0)" ::: "memory"); __builtin_amdgcn_s_barrier(); asm volatile("" ::: "memory");
#pragma unroll
            for (int ai = 0; ai < 2; ++ai)
#pragma unroll
                for (int m = 0; m < 4; ++m) { const f32x4 lv = *(const LAS f32x4*)(xl + (ai * HALF + wr * 64 + m * 16 + fr) * 4); rs[ai][m] = __builtin_amdgcn_rcpf(sum4(lv)); }
        }
        if constexpr (MODE == 1 || MODE == 4) { rss_t rv[2][4];
#pragma unroll
            for (int ai = 0; ai < 2; ++ai)
#pragma unroll
                for (int m = 0; m < 4; ++m) rv[ai][m] = ((const rss_t*)aux2)[row0 + ai * HALF + m * 16];
#pragma unroll
            for (int ai = 0; ai < 2; ++ai)
#pragma unroll
                for (int m = 0; m < 4; ++m) rs[ai][m] = ss_rstd(rv[ai][m]);
        }
        if constexpr (MODE == 3) {
            f32x4 la[2][4];
#pragma unroll
            for (int ai = 0; ai < 2; ++ai)
#pragma unroll
                for (int m = 0; m < 4; ++m) la[ai][m] = *(const f32x4*)(aux2 + (size_t)(row0 + ai * HALF + m * 16) * 16 + (u.pn >> 1) * 4);
#pragma unroll
            for (int ai = 0; ai < 2; ++ai)
#pragma unroll
                for (int m = 0; m < 4; ++m) rs[ai][m] = __builtin_amdgcn_rcpf(sum4(la[ai][m]));
        }
        bf16_t* Ob = O; int colb = col0;
        if constexpr (MODE == 5) { Ob = O + (size_t)(u.pn >> 2) * 2048 * 1024; colb = (u.pn & 3) * 256 + wc * 32 + 8 * fq; }
#pragma unroll
        for (int ai = 0; ai < 2; ++ai)
#pragma unroll
            for (int m = 0; m < 4; ++m) { const int row = row0 + ai * HALF + m * 16; bf16_t* rowp = Ob + (size_t)row * ldc + colb;
                if constexpr (MODE == 0 || MODE == 5) {
#pragma unroll
                    for (int bj = 0; bj < 2; ++bj) *(u32x4*)(rowp + bj * HALF) = pack8(acc[ai][bj][m][0], acc[ai][bj][m][1]);
                } else if constexpr (MODE == 1) {
                    float ss = (sumsq4(acc[ai][0][m][0]) + sumsq4(acc[ai][0][m][1])) + (sumsq4(acc[ai][1][m][0]) + sumsq4(acc[ai][1][m][1]));
                    ss = red_fq(ss); const float rxx = rs[ai][m];
                    if (fq == 0) aux[(size_t)row * 32 + u.pn * 4 + wc] = ss * rxx * rxx;
#pragma unroll
                    for (int bj = 0; bj < 2; ++bj) *(u32x4*)(rowp + bj * HALF) = pack8(acc[ai][bj][m][0] * rxx, acc[ai][bj][m][1] * rxx);
                } else {
                    const float rxx = rs[ai][m];
#pragma unroll
                    for (int bj = 0; bj < 2; ++bj) *(u32x4*)(rowp + bj * HALF) = pack8(acc[ai][bj][m][0] * rxx, acc[ai][bj][m][1] * rxx);
                }
            }
    }
};
struct EpiRes {
    static constexpr bool PERM = true;
    bf16_t* XB; rss_t* rowss; float* OUT;
    __device__ __forceinline__ void load_half(u32x4 (&t)[4][2], int row0, int col0, int ai) const {
#pragma unroll
        for (int m = 0; m < 4; ++m) { const bf16_t* rowb = XB + (size_t)(row0 + ai * HALF + m * 16) * D_MODEL + col0;
#pragma unroll
            for (int bj = 0; bj < 2; ++bj) t[m][bj] = *(const u32x4*)(rowb + bj * HALF); }
    }
    __device__ __forceinline__ void add_half(f32x4 (&acc)[2][2][4][2], const u32x4 (&t)[4][2], int ai) const {
#pragma unroll
        for (int m = 0; m < 4; ++m)
#pragma unroll
            for (int bj = 0; bj < 2; ++bj) { const u32x4 w = t[m][bj];
#define ADDS_(d, x) asm("v_add_f32 %0, %1, %0" : "+v"(d) : "v"(x))
                ADDS_(acc[ai][bj][m][0][0], bflo(w.x)); ADDS_(acc[ai][bj][m][0][1], bfhi(w.x)); ADDS_(acc[ai][bj][m][0][2], bflo(w.y)); ADDS_(acc[ai][bj][m][0][3], bfhi(w.y));
                ADDS_(acc[ai][bj][m][1][0], bflo(w.z)); ADDS_(acc[ai][bj][m][1][1], bfhi(w.z)); ADDS_(acc[ai][bj][m][1][2], bflo(w.w)); ADDS_(acc[ai][bj][m][1][3], bfhi(w.w));
#undef ADDS_
            }
    }
    __device__ __forceinline__ void store_half(const f32x4 (&acc)[2][2][4][2], int row0, int col0, int ai, int fq) const {
#pragma unroll
        for (int m = 0; m < 4; ++m) { const int row = row0 + ai * HALF + m * 16; bf16_t* rowb = XB + (size_t)row * D_MODEL + col0; float ss = 0.f;
#pragma unroll
            for (int bj = 0; bj < 2; ++bj) { const f32x4 v0 = acc[ai][bj][m][0], v1 = acc[ai][bj][m][1];
                if (OUT) { float* rowp = OUT + (size_t)row * D_MODEL + col0 + bj * HALF; *(f32x4*)rowp = v0; *(f32x4*)(rowp + 4) = v1; }
                else { *(u32x4*)(rowb + bj * HALF) = pack8(v0, v1); ss += sumsq4(v0) + sumsq4(v1); } }
            if (rowss) { ss = red_fq(ss); if (fq == 0) atomicAdd(rowss + row, ss_fix(ss)); } }
    }
    __device__ __forceinline__ void operator()(f32x4 (&acc)[2][2][4][2], const Unit& u, int wr, int wc, int fr, int fq) const {
        const int row0 = u.pm * BM + wr * 64 + fr, col0 = u.pn * BM + wc * 32 + 8 * fq;
        u32x4 t[4][2];
        load_half(t, row0, col0, 0);
        add_half(acc, t, 0);
        asm volatile("" : "+v"(acc[0][0][0][0]), "+v"(acc[0][1][3][1]));
        load_half(t, row0, col0, 1);
        asm volatile("" ::: "memory");
        store_half(acc, row0, col0, 0, fq);
        add_half(acc, t, 1);
        store_half(acc, row0, col0, 1, fq);
    }
};
__device__ __forceinline__ int ffn_tile_row(int pm, int R, int chunk, bool& valid) {
    R = (R & ~63) | ((R & 15) << 2) | ((R >> 4) & 3);
    valid = true; (void)chunk; return pm * 256 + R;
}
struct ProbUp : ProbBase {
    static constexpr bool GATHER = true;
    const char* A; const char* B; int chunk;
    __device__ __forceinline__ const char* aptr(const Unit&) const { return A; }
    __device__ __forceinline__ const char* bptr(const Unit& u) const { return B + (size_t)u.pn * 256 * ldb * 2; }
    __device__ __forceinline__ unsigned rowoff(const Unit& u, int R) const { bool v; return (unsigned)ffn_tile_row(u.pm, R, chunk, v) * (unsigned)(lda * 2); }
};
__device__ __forceinline__ float dpp_ror1(float v) { return __builtin_bit_cast(float, __builtin_amdgcn_update_dpp(0, __builtin_bit_cast(int, v), 0x121, 0xf, 0xf, false)); }
__device__ __forceinline__ float dpp_ror15(float v) { return __builtin_bit_cast(float, __builtin_amdgcn_update_dpp(0, __builtin_bit_cast(int, v), 0x12F, 0xf, 0xf, false)); }
__device__ __forceinline__ h2_t u2h(unsigned u) { return __builtin_bit_cast(h2_t, u); }
__device__ __forceinline__ unsigned h2u(h2_t h) { return __builtin_bit_cast(unsigned, h); }
__device__ __forceinline__ unsigned dppu_ror1(unsigned v) { return (unsigned)__builtin_amdgcn_update_dpp(0, (int)v, 0x121, 0xf, 0xf, false); }
__device__ __forceinline__ unsigned dppu_ror15(unsigned v) { return (unsigned)__builtin_amdgcn_update_dpp(0, (int)v, 0x12F, 0xf, 0xf, false); }
#define H2X4_TRANS(OP, a, b, c, d) asm(OP " %0, %0 dst_sel:WORD_0 dst_unused:UNUSED_PRESERVE src0_sel:WORD_0\n\t" OP " %1, %1 dst_sel:WORD_0 dst_unused:UNUSED_PRESERVE src0_sel:WORD_0\n\t" \
    OP " %2, %2 dst_sel:WORD_0 dst_unused:UNUSED_PRESERVE src0_sel:WORD_0\n\t" OP " %3, %3 dst_sel:WORD_0 dst_unused:UNUSED_PRESERVE src0_sel:WORD_0\n\t"                                  \
    OP " %0, %0 dst_sel:WORD_1 dst_unused:UNUSED_PRESERVE src0_sel:WORD_1\n\t" OP " %1, %1 dst_sel:WORD_1 dst_unused:UNUSED_PRESERVE src0_sel:WORD_1\n\t"                                  \
    OP " %2, %2 dst_sel:WORD_1 dst_unused:UNUSED_PRESERVE src0_sel:WORD_1\n\t" OP " %3, %3 dst_sel:WORD_1 dst_unused:UNUSED_PRESERVE src0_sel:WORD_1\n\ts_nop 0" : "+v"(a), "+v"(b), "+v"(c), "+v"(d))
struct EpiGlu {
    static constexpr bool PERM = true;
    bf16_t* G; const rss_t* rowss; const u32x4* cwt; int chunk; LAS float* xl; bf16_t* EB; bf16_t* G2; int gsplit;
    __device__ __forceinline__ void operator()(f32x4 (&acc)[2][2][4][2], const Unit& u, int wr, int wc, int fr, int fq) const {
        const int ch0 = u.pn * 128 + wc * 32 + 8 * fq;
        const int tidw = (wr * 4 + wc) * 64 + fq * 16 + fr; LAS unsigned char* wl = (LAS unsigned char*)xl + 12288; LAS unsigned* xu = (LAS unsigned*)xl;
        u32x4 wrec = (u32x4){0u, 0u, 0u, 0u}; if (tidw < 128) wrec = cwt[u.pn * 128 + tidw];
        int rowi[2][4]; unsigned stmask = 0u; unsigned hh[2][2][4][4];
        { rss_t rv[2][4];
#pragma unroll
          for (int ai = 0; ai < 2; ++ai)
#pragma unroll
            for (int m = 0; m < 4; ++m) { const int RL = ai * HALF + wr * 64 + 4 * fr + m; bool valid; const int row = ffn_tile_row(u.pm, ai * HALF + wr * 64 + m * 16 + fr, chunk, valid); rowi[ai][m] = row; rv[ai][m] = rowss[row];
                const int gt = chunk * FFN_CHUNK + row, pos = tok_pos(gt), S = tok_seqlen(gt);
                const bool st = !((RL == 0 && pos != 0) || (RL == 255 && pos != S - 1)); (void)valid;
                stmask |= st ? (1u << (ai * 4 + m)) : 0u; }
#pragma unroll
          for (int ai = 0; ai < 2; ++ai)
#pragma unroll
            for (int m = 0; m < 4; ++m) { const float rx = ss_rstd(rv[ai][m]); const h2_t r2 = {(_Float16)rx, (_Float16)rx};
#pragma unroll
                for (int bj = 0; bj < 2; ++bj)
#pragma unroll
                    for (int n = 0; n < 2; ++n)
#pragma unroll
                        for (int jp = 0; jp < 2; ++jp) hh[ai][bj][m][2 * n + jp] = h2u(__builtin_bit_cast(h2_t, __builtin_amdgcn_cvt_pkrtz(acc[ai][bj][m][n][2 * jp], acc[ai][bj][m][n][2 * jp + 1])) * r2); } }
        if (wr == 0 && fr == 0) {
#pragma unroll
            for (int m = 0; m < 2; ++m)
#pragma unroll
                for (int bj = 0; bj < 2; ++bj) *(u32x4*)(EB + (size_t)(u.pm * 4 + m) * UP_W + bj * D_FF + ch0) = (u32x4){hh[0][bj][m][0], hh[0][bj][m][1], hh[0][bj][m][2], hh[0][bj][m][3]}; }
        if (wr == 1 && fr == 15) {
#pragma unroll
            for (int m = 2; m < 4; ++m)
#pragma unroll
                for (int bj = 0; bj < 2; ++bj) *(u32x4*)(EB + (size_t)(u.pm * 4 + m) * UP_W + bj * D_FF + ch0) = (u32x4){hh[1][bj][m][0], hh[1][bj][m][1], hh[1][bj][m][2], hh[1][bj][m][3]}; }
#pragma unroll
        for (int ai = 0; ai < 2; ++ai) { const int s1 = 2 * ai + wr + 1;
            if (fr == 0) {
#pragma unroll
                for (int bj = 0; bj < 2; ++bj) *(LAS u32x4*)(xu + ((s1 * 2 + 0) * 4 + wc) * 32 + bj * 16 + 4 * fq) = (u32x4){hh[ai][bj][0][0], hh[ai][bj][0][1], hh[ai][bj][0][2], hh[ai][bj][0][3]}; }
            if (fr == 15) {
#pragma unroll
                for (int bj = 0; bj < 2; ++bj) *(LAS u32x4*)(xu + ((s1 * 2 + 1) * 4 + wc) * 32 + bj * 16 + 4 * fq) = (u32x4){hh[ai][bj][3][0], hh[ai][bj][3][1], hh[ai][bj][3][2], hh[ai][bj][3][3]}; } }
        if (tidw < 128) *(LAS u32x4*)(wl + tidw * 16) = wrec;
        asm volatile("s_waitcnt lgkmcnt(0)" ::: "memory"); __builtin_amdgcn_s_barrier(); asm volatile("" ::: "memory");
        const h2_t c1 = {(_Float16)-0.10294324f, (_Float16)-0.10294324f}, c0 = {(_Float16)-2.3022082f, (_Float16)-2.3022082f}, one = {(_Float16)1.0f, (_Float16)1.0f};
        unsigned wq[2][2][4][2];
#pragma unroll
        for (int n = 0; n < 2; ++n) { unsigned (&wp)[2][4][2] = wq[n];
#pragma unroll
            for (int jp = 0; jp < 2; ++jp) { const int q = 2 * n + jp;
                const u32x4 wg = *(const LAS u32x4*)(wl + (wc * 16 + 4 * fq + q) * 32), wv = *(const LAS u32x4*)(wl + (wc * 16 + 4 * fq + q) * 32 + 16);
#pragma unroll
                for (int ai = 0; ai < 2; ++ai) { const int s1 = 2 * ai + wr + 1; h2_t cg[4], cv[4];
                    const LAS unsigned* xp = xu + (((s1 - 1) * 2 + 1) * 4 + wc) * 32 + 4 * fq + q; const LAS unsigned* xn = xu + (((s1 + 1) * 2 + 0) * 4 + wc) * 32 + 4 * fq + q;
                    { const unsigned pe = xp[0], ne = xn[0]; const unsigned r3 = dppu_ror1(hh[ai][0][3][q]), l0 = dppu_ror15(hh[ai][0][0][q]);
                      const h2_t w0 = u2h(wg.x), w1 = u2h(wg.y), w2 = u2h(wg.z), wb = u2h(wg.w);
#pragma unroll
                      for (int m = 0; m < 4; ++m) { const unsigned pv = m ? hh[ai][0][m ? m - 1 : 0][q] : (fr == 0 ? pe : r3), nx = m < 3 ? hh[ai][0][m < 3 ? m + 1 : 3][q] : (fr == 15 ? ne : l0);
                          cg[m] = wb + w0 * u2h(pv) + w1 * u2h(hh[ai][0][m][q]) + w2 * u2h(nx); } }
                    { const unsigned pe = xp[16], ne = xn[16]; const unsigned r3 = dppu_ror1(hh[ai][1][3][q]), l0 = dppu_ror15(hh[ai][1][0][q]);
                      const h2_t w0 = u2h(wv.x), w1 = u2h(wv.y), w2 = u2h(wv.z), wb = u2h(wv.w);
#pragma unroll
                      for (int m = 0; m < 4; ++m) { const unsigned pv = m ? hh[ai][1][m ? m - 1 : 0][q] : (fr == 0 ? pe : r3), nx = m < 3 ? hh[ai][1][m < 3 ? m + 1 : 3][q] : (fr == 15 ? ne : l0);
                          cv[m] = wb + w0 * u2h(pv) + w1 * u2h(hh[ai][1][m][q]) + w2 * u2h(nx); } }
                    unsigned e0 = h2u(cg[0] * (cg[0] * cg[0] * c1 + c0)), e1 = h2u(cg[1] * (cg[1] * cg[1] * c1 + c0)), e2 = h2u(cg[2] * (cg[2] * cg[2] * c1 + c0)), e3 = h2u(cg[3] * (cg[3] * cg[3] * c1 + c0));
                    H2X4_TRANS("v_exp_f16_sdwa", e0, e1, e2, e3);
                    e0 = h2u(u2h(e0) + one); e1 = h2u(u2h(e1) + one); e2 = h2u(u2h(e2) + one); e3 = h2u(u2h(e3) + one);
                    H2X4_TRANS("v_rcp_f16_sdwa", e0, e1, e2, e3);
                    wp[ai][0][jp] = h2u(cg[0] * u2h(e0) * cv[0]); wp[ai][1][jp] = h2u(cg[1] * u2h(e1) * cv[1]); wp[ai][2][jp] = h2u(cg[2] * u2h(e2) * cv[2]); wp[ai][3][jp] = h2u(cg[3] * u2h(e3) * cv[3]);
                    asm volatile("" : "+v"(wp[ai][0][jp]), "+v"(wp[ai][1][jp]), "+v"(wp[ai][2][jp]), "+v"(wp[ai][3][jp])); } }
            asm volatile("" ::: "memory"); }
#pragma unroll
        for (int ai = 0; ai < 2; ++ai)
#pragma unroll
            for (int m = 0; m < 4; ++m) { const u32x4 q = {wq[0][ai][m][0], wq[0][ai][m][1], wq[1][ai][m][0], wq[1][ai][m][1]}; if (stmask & (1u << (ai * 4 + m))) *(u32x4*)((u.pm < gsplit ? G : G2) + (size_t)rowi[ai][m] * D_FF + ch0) = q; }
    }
};
__device__ __forceinline__ void ffn_fix_item(const bf16_t* EB, const u32x4* cwt, bf16_t* G, bf16_t* G2, int gsplit_row, int t, int cb, int lane) {
    const int ti = (t >> 8) - 1, ch = cb * 512 + lane * 8;
    const bf16_t* ea = EB + (size_t)(ti * 4 + 2) * UP_W + ch; const bf16_t* ec = EB + (size_t)((ti + 1) * 4) * UP_W + ch;
    u32x4 ug[4], uv[4], w[8];
    ug[0] = *(const u32x4*)ea; uv[0] = *(const u32x4*)(ea + D_FF); ug[1] = *(const u32x4*)(ea + UP_W); uv[1] = *(const u32x4*)(ea + UP_W + D_FF);
    ug[2] = *(const u32x4*)ec; uv[2] = *(const u32x4*)(ec + D_FF); ug[3] = *(const u32x4*)(ec + UP_W); uv[3] = *(const u32x4*)(ec + UP_W + D_FF);
#pragma unroll
    for (int k = 0; k < 8; ++k) w[k] = cwt[(ch >> 1) * 2 + k];
    const h2_t c1 = {(_Float16)-0.10294324f, (_Float16)-0.10294324f}, c0 = {(_Float16)-2.3022082f, (_Float16)-2.3022082f}, one = {(_Float16)1.0f, (_Float16)1.0f};
    u32x4 oa, ob;
#pragma unroll
    for (int qp = 0; qp < 2; ++qp) { h2_t cg[4], cv[4];
#pragma unroll
        for (int qq = 0; qq < 2; ++qq) { const int q = 2 * qp + qq; const u32x4 wg = w[2 * q], wv = w[2 * q + 1];
            cg[2 * qq + 0] = u2h(wg.w) + u2h(wg.x) * u2h(ug[0][q]) + u2h(wg.y) * u2h(ug[1][q]) + u2h(wg.z) * u2h(ug[2][q]);
            cg[2 * qq + 1] = u2h(wg.w) + u2h(wg.x) * u2h(ug[1][q]) + u2h(wg.y) * u2h(ug[2][q]) + u2h(wg.z) * u2h(ug[3][q]);
            cv[2 * qq + 0] = u2h(wv.w) + u2h(wv.x) * u2h(uv[0][q]) + u2h(wv.y) * u2h(uv[1][q]) + u2h(wv.z) * u2h(uv[2][q]);
            cv[2 * qq + 1] = u2h(wv.w) + u2h(wv.x) * u2h(uv[1][q]) + u2h(wv.y) * u2h(uv[2][q]) + u2h(wv.z) * u2h(uv[3][q]); }
        unsigned e0 = h2u(cg[0] * (cg[0] * cg[0] * c1 + c0)), e1 = h2u(cg[1] * (cg[1] * cg[1] * c1 + c0)), e2 = h2u(cg[2] * (cg[2] * cg[2] * c1 + c0)), e3 = h2u(cg[3] * (cg[3] * cg[3] * c1 + c0));
        H2X4_TRANS("v_exp_f16_sdwa", e0, e1, e2, e3);
        e0 = h2u(u2h(e0) + one); e1 = h2u(u2h(e1) + one); e2 = h2u(u2h(e2) + one); e3 = h2u(u2h(e3) + one);
        H2X4_TRANS("v_rcp_f16_sdwa", e0, e1, e2, e3);
        oa[2 * qp] = h2u(cg[0] * u2h(e0) * cv[0]); ob[2 * qp] = h2u(cg[1] * u2h(e1) * cv[1]); oa[2 * qp + 1] = h2u(cg[2] * u2h(e2) * cv[2]); ob[2 * qp + 1] = h2u(cg[3] * u2h(e3) * cv[3]); }
    *(u32x4*)((t - 1 < gsplit_row ? G : G2) + (size_t)(t - 1) * D_FF + ch) = oa; *(u32x4*)((t < gsplit_row ? G : G2) + (size_t)t * D_FF + ch) = ob;
}
struct EpiKV {
    static constexpr bool PERM = false;
    float* kraw; bf16_t* vT;
    __device__ __forceinline__ void operator()(const f32x4 (&acc)[2][2][4][2], const Unit& u, int wr, int wc, int fr, int fq) const {
        const int key0 = wr * 64 + fr, col0 = u.pn * BM + wc * 32 + 4 * fq;
        if (u.pn < 8) {
#pragma unroll
            for (int ai = 0; ai < 2; ++ai)
#pragma unroll
                for (int m = 0; m < 4; ++m) { float* rowp = kraw + (size_t)(u.pm * BM + key0 + ai * HALF + m * 16) * 2048 + col0;
#pragma unroll
                    for (int bj = 0; bj < 2; ++bj)
#pragma unroll
                        for (int n = 0; n < 2; ++n) *(f32x4*)(rowp + bj * HALF + n * 16) = acc[ai][bj][m][n]; }
        } else {
#pragma unroll
            for (int ai = 0; ai < 2; ++ai)
#pragma unroll
                for (int m = 0; m < 4; ++m) { bf16_t* rowp = vT + (size_t)(u.pm * BM + key0 + ai * HALF + m * 16) * 2048 + (col0 - 2048);
#pragma unroll
                    for (int bj = 0; bj < 2; ++bj)
#pragma unroll
                        for (int n = 0; n < 2; ++n) { const f32x4 v = acc[ai][bj][m][n]; u32x2 w; w.x = cvt_pk_bf16(v[0], v[1]); w.y = cvt_pk_bf16(v[2], v[3]); *(u32x2*)(rowp + bj * HALF + n * 16) = w; } }
        }
    }
};
}

namespace att {
constexpr int KVBLK = 64, SHM_V = 16384, SHM_K = 16384, OFF_V = 0, OFF_K = 3 * SHM_V, OFF_WS = 3 * SHM_V + 3 * SHM_K, LDP = 1024;
#define KSWZ(row, colB) ((row) * 256 + ((colB) ^ (((row) & 15) << 4)))
#define SBAR() __builtin_amdgcn_sched_barrier(0)
__device__ __forceinline__ int crow(int r, int hi) { return (r & 3) + 8 * (r >> 2) + 4 * hi; }
__device__ __forceinline__ void partialSM(f32x16& p0) {
#pragma unroll
  for (int r = 0; r < 16; ++r) p0[r] = __builtin_amdgcn_exp2f(p0[r]);
}
__device__ __forceinline__ void finishSM(f32x16& p0, f32x16& p1, float& l_reg, bf16x8& pa0, bf16x8& pa1, bf16x8& pa2, bf16x8& pa3) {
#pragma unroll
  for (int r = 0; r < 16; ++r) p1[r] = __builtin_amdgcn_exp2f(p1[r]);
  float ps = 0;
#pragma unroll
  for (int r = 0; r < 16; ++r) ps += p0[r];
#pragma unroll
  for (int r = 0; r < 16; ++r) ps += p1[r];
  l_reg += ps;
#define PK4(P, BASE, OUT) do { unsigned a0 = cvt_pk_bf16(P[BASE + 0], P[BASE + 1]), a1 = cvt_pk_bf16(P[BASE + 2], P[BASE + 3]);   \
    unsigned b0 = cvt_pk_bf16(P[BASE + 4], P[BASE + 5]), b1 = cvt_pk_bf16(P[BASE + 6], P[BASE + 7]);                              \
    auto r0 = __builtin_amdgcn_permlane32_swap(a0, b0, false, false); auto r1 = __builtin_amdgcn_permlane32_swap(a1, b1, false, false); \
    u32x4 w = {r0[0], r1[0], r0[1], r1[1]}; OUT = __builtin_bit_cast(bf16x8, w); } while (0)
  PK4(p0, 0, pa0); PK4(p0, 8, pa1); PK4(p1, 0, pa2); PK4(p1, 8, pa3);
#undef PK4
}
__device__ __forceinline__ void finishSM_tail(f32x16& p0, f32x16& p1, float& l_reg, bf16x8& pa0, bf16x8& pa1, bf16x8& pa2, bf16x8& pa3) {
  float ps = 0;
#pragma unroll
  for (int r = 0; r < 16; ++r) ps += p0[r];
#pragma unroll
  for (int r = 0; r < 16; ++r) ps += p1[r];
  l_reg += ps;
#define PK4(P, BASE, OUT) do { unsigned a0 = cvt_pk_bf16(P[BASE + 0], P[BASE + 1]), a1 = cvt_pk_bf16(P[BASE + 2], P[BASE + 3]);   \
    unsigned b0 = cvt_pk_bf16(P[BASE + 4], P[BASE + 5]), b1 = cvt_pk_bf16(P[BASE + 6], P[BASE + 7]);                              \
    u32x4 w = {a0, a1, b0, b1}; OUT = __builtin_bit_cast(bf16x8, w); } while (0)
  PK4(p0, 0, pa0); PK4(p0, 8, pa1); PK4(p1, 0, pa2); PK4(p1, 8, pa3);
#undef PK4
}
__device__ __forceinline__ void qkt(f32x16& p0, f32x16& p1, const LAS unsigned char* Ks, const bf16x8* qr, int r32, int hi, int cbase) {
  p0 = f32x16{}; p1 = f32x16{}; bf16x8 b0[4], b1[4];
#pragma unroll
  for (int d0 = 0; d0 < 4; ++d0) { const int cb = cbase + (d0 * 16 + hi * 8) * 2;
    b0[d0] = *(const LAS bf16x8*)(Ks + KSWZ(r32, cb)); b1[d0] = *(const LAS bf16x8*)(Ks + KSWZ(32 + r32, cb)); }
#define QK_STEP(D, N) do { asm volatile("s_waitcnt lgkmcnt(" #N ")" ::: "memory"); SBAR(); \
    p0 = __builtin_amdgcn_mfma_f32_32x32x16_bf16(b0[D], qr[D], p0, 0, 0, 0); p1 = __builtin_amdgcn_mfma_f32_32x32x16_bf16(b1[D], qr[D], p1, 0, 0, 0); } while (0)
  QK_STEP(0, 6); QK_STEP(1, 4); QK_STEP(2, 2); QK_STEP(3, 0);
#undef QK_STEP
}
__device__ __forceinline__ int v_st(int k, int c) { const int kk = k; return ((kk >> 3) * 4 + (c >> 5)) * 512 + ((kk & 7) * 32 + (c & 31)) * 2; }
__device__ __forceinline__ int v_rd_base(int lane) { return ((lane & 3) << 3) | (((lane >> 2) & 3) << 6) | (((lane >> 4) & 1) << 5) | (((lane >> 5) & 1) << 8); }
constexpr int v_rd_off(int d0, int ks, int half) { return d0 * 512 + ks * 4096 + half * 2048; }
template <int OFF> __device__ __forceinline__ s16x4 tr_read(int vb) {
  s16x4 r; asm volatile("ds_read_b64_tr_b16 %0, %1 offset:%2" : "=&v"(r) : "v"(vb), "i"(OFF) : "memory"); return r;
}
struct VFrag { s16x4 l0, h0, l1, h1, l2, h2, l3, h3; };
template <int D0> __device__ __forceinline__ void pv_read(VFrag& f, int vb) {
  f.l0 = tr_read<v_rd_off(D0, 0, 0)>(vb); f.h0 = tr_read<v_rd_off(D0, 0, 1)>(vb); f.l1 = tr_read<v_rd_off(D0, 1, 0)>(vb); f.h1 = tr_read<v_rd_off(D0, 1, 1)>(vb);
  f.l2 = tr_read<v_rd_off(D0, 2, 0)>(vb); f.h2 = tr_read<v_rd_off(D0, 2, 1)>(vb); f.l3 = tr_read<v_rd_off(D0, 3, 0)>(vb); f.h3 = tr_read<v_rd_off(D0, 3, 1)>(vb);
}
__device__ __forceinline__ void pv_mma(f32x16& od, const VFrag& f, bf16x8 pa0, bf16x8 pa1, bf16x8 pa2, bf16x8 pa3) {
#define PKV(L, H) (bf16x8){L[0], L[1], L[2], L[3], H[0], H[1], H[2], H[3]}
  od = __builtin_amdgcn_mfma_f32_32x32x16_bf16(pa0, PKV(f.l0, f.h0), od, 0, 0, 0);
  od = __builtin_amdgcn_mfma_f32_32x32x16_bf16(pa1, PKV(f.l1, f.h1), od, 0, 0, 0);
  od = __builtin_amdgcn_mfma_f32_32x32x16_bf16(pa2, PKV(f.l2, f.h2), od, 0, 0, 0);
  od = __builtin_amdgcn_mfma_f32_32x32x16_bf16(pa3, PKV(f.l3, f.h3), od, 0, 0, 0);
#undef PKV
}
__device__ __forceinline__ void pv_d0(f32x16* o, int vb, bf16x8 pa0, bf16x8 pa1, bf16x8 pa2, bf16x8 pa3) {
  VFrag fa, fb;
  pv_read<0>(fa, vb); pv_read<1>(fb, vb);
  asm volatile("s_waitcnt lgkmcnt(8)" ::: "memory"); SBAR(); pv_mma(o[0], fa, pa0, pa1, pa2, pa3); SBAR();
  pv_read<2>(fa, vb);
  asm volatile("s_waitcnt lgkmcnt(8)" ::: "memory"); SBAR(); pv_mma(o[1], fb, pa0, pa1, pa2, pa3); SBAR();
  pv_read<3>(fb, vb);
  asm volatile("s_waitcnt lgkmcnt(8)" ::: "memory"); SBAR(); pv_mma(o[2], fa, pa0, pa1, pa2, pa3); SBAR();
  asm volatile("s_waitcnt lgkmcnt(0)" ::: "memory"); SBAR(); pv_mma(o[3], fb, pa0, pa1, pa2, pa3);
}
__device__ __forceinline__ void att_step(f32x16& s0, f32x16& s1, const LAS unsigned char* Ks, const bf16x8* qr, int r32, int hi, int cbase,
                                         f32x16& e0, f32x16& e1, float& l_reg, bf16x8& pa0, bf16x8& pa1, bf16x8& pa2, bf16x8& pa3, f32x16* o, int vb) {
  bf16x8 b0[4], b1[4]; VFrag fa, fb; float ps = 0.f; u32x4 w0, w1, w2, w3;
#pragma unroll
  for (int d0 = 0; d0 < 4; ++d0) { const int cb = cbase + (d0 * 16 + hi * 8) * 2;
    b0[d0] = *(const LAS bf16x8*)(Ks + KSWZ(r32, cb)); b1[d0] = *(const LAS bf16x8*)(Ks + KSWZ(32 + r32, cb)); }
  s0 = f32x16{}; s1 = f32x16{};
#define PACK_H(E, BASE, H, W) do { ps += E[BASE + 2 * H]; ps += E[BASE + 2 * H + 1]; ps += E[BASE + 4 + 2 * H]; ps += E[BASE + 5 + 2 * H];                       \
    const unsigned a_ = cvt_pk_bf16(E[BASE + 2 * H], E[BASE + 2 * H + 1]), b_ = cvt_pk_bf16(E[BASE + 4 + 2 * H], E[BASE + 5 + 2 * H]);                       \
    W[H] = a_; W[2 + H] = b_; } while (0)
#define QK_STEP(D, N, PRE, PK_A, PK_B) do { asm volatile("s_waitcnt lgkmcnt(" #N ")" ::: "memory"); PRE; SBAR();                                                  \
    s0 = __builtin_amdgcn_mfma_f32_32x32x16_bf16(b0[D], qr[D], s0, 0, 0, 0); SBAR(); PK_A; SBAR();                                                                 \
    s1 = __builtin_amdgcn_mfma_f32_32x32x16_bf16(b1[D], qr[D], s1, 0, 0, 0); SBAR(); PK_B; SBAR(); } while (0)
  QK_STEP(0, 6, (void)0, PACK_H(e0, 0, 0, w0), PACK_H(e0, 0, 1, w0));
  QK_STEP(1, 4, (void)0, PACK_H(e0, 8, 0, w1), PACK_H(e0, 8, 1, w1));
  QK_STEP(2, 2, (void)0, PACK_H(e1, 0, 0, w2), PACK_H(e1, 0, 1, w2));
  QK_STEP(3, 0, (pv_read<0>(fa, vb), pv_read<1>(fb, vb)), PACK_H(e1, 8, 0, w3), PACK_H(e1, 8, 1, w3));
#undef QK_STEP
#undef PACK_H
  l_reg += ps;
  pa0 = __builtin_bit_cast(bf16x8, w0); pa1 = __builtin_bit_cast(bf16x8, w1); pa2 = __builtin_bit_cast(bf16x8, w2); pa3 = __builtin_bit_cast(bf16x8, w3);
#define PKV(L, H) (bf16x8){L[0], L[1], L[2], L[3], H[0], H[1], H[2], H[3]}
#define EX2(X, I) do { X[I] = __builtin_amdgcn_exp2f(X[I]); X[I + 1] = __builtin_amdgcn_exp2f(X[I + 1]); } while (0)
#define PV_BLK(D0, F, N, X, XB) do { asm volatile("s_waitcnt lgkmcnt(" #N ")" ::: "memory"); SBAR();                                                              \
    o[D0] = __builtin_amdgcn_mfma_f32_32x32x16_bf16(pa0, PKV(F.l0, F.h0), o[D0], 0, 0, 0); SBAR(); EX2(X, XB + 0); SBAR();                                         \
    o[D0] = __builtin_amdgcn_mfma_f32_32x32x16_bf16(pa1, PKV(F.l1, F.h1), o[D0], 0, 0, 0); SBAR(); EX2(X, XB + 2); SBAR();                                         \
    o[D0] = __builtin_amdgcn_mfma_f32_32x32x16_bf16(pa2, PKV(F.l2, F.h2), o[D0], 0, 0, 0); SBAR(); EX2(X, XB + 4); SBAR();                                         \
    o[D0] = __builtin_amdgcn_mfma_f32_32x32x16_bf16(pa3, PKV(F.l3, F.h3), o[D0], 0, 0, 0); SBAR(); EX2(X, XB + 6); SBAR(); } while (0)
  PV_BLK(0, fa, 8, s0, 0); pv_read<2>(fa, vb);
  PV_BLK(1, fb, 8, s0, 8); pv_read<3>(fb, vb);
  PV_BLK(2, fa, 8, s1, 0);
  PV_BLK(3, fb, 0, s1, 8);
#undef PV_BLK
#undef EX2
#undef PKV
}
__device__ __forceinline__ void attn_unit(const bf16_t* Qg, const bf16_t* __restrict__ Kg, const bf16_t* __restrict__ Vg, bf16_t* Og, int seq, float lam, const float* gsub, float oscale, LAS unsigned char* lds) {
  int tid_l = threadIdx.x; asm volatile("" : "+v"(tid_l));
  const int tid = tid_l, wid = __builtin_amdgcn_readfirstlane(tid >> 6), lane = tid & 63, r32 = lane & 31, hi = lane >> 5;
  const int comp = wid & 1, rg = wid >> 1, cbase = comp * 128;
  LAS unsigned char* V_lds = lds + OFF_V; LAS unsigned char* K_lds = lds + OFF_K;
  LAS float* wsf = (LAS float*)(lds + OFF_WS) + wid * 64; LAS float* li_l = wsf;
  float l_reg = 0; f32x16 o[4] = {}; bf16x8 qr[4];
  const bf16_t* Qw = Qg + (size_t)(rg * 32 + r32) * LDP + comp * 64 + hi * 8;
#pragma unroll
  for (int d0 = 0; d0 < 4; ++d0) qr[d0] = *(const bf16x8*)(Qw + d0 * 16);
  unsigned koff[2], voff[2];
#pragma unroll
  for (int i = 0; i < 2; ++i) { const int L = (tid + 512 * i) * 16; { const int row = L >> 8, colB = (L & 255) ^ ((row & 15) << 4); koff[i] = (unsigned)(row * LDP * 2 + colB); }
    { const int sub = L >> 9, w = L & 511, kk = (sub >> 2) * 8 + (w >> 6), c = (sub & 3) * 32 + ((w & 63) >> 1), k = kk; voff[i] = (unsigned)(k * LDP * 2 + c * 2); } }
  const int vbb = (int)(unsigned)(size_t)V_lds + v_rd_base(lane);
  const int NT = seq / KVBLK; const size_t tstep = (size_t)KVBLK * LDP * 2;
#define DMA_K(t) do { const int t_ = (t) < NT ? (t) : NT - 1; const char* g_ = (const char*)Kg + (size_t)t_ * tstep; LAS unsigned char* d_ = K_lds + (t_ % 3) * SHM_K + wid * 1024; \
    __builtin_amdgcn_global_load_lds((const unsigned*)(g_ + koff[0]), (LAS unsigned*)d_, 16, 0, 0); __builtin_amdgcn_global_load_lds((const unsigned*)(g_ + koff[1]), (LAS unsigned*)(d_ + 8192), 16, 0, 0); } while (0)
#define DMA_V(t) do { const int t_ = (t) < NT ? (t) : NT - 1; const char* g_ = (const char*)Vg + (size_t)t_ * tstep; LAS unsigned char* d_ = V_lds + (t_ % 3) * SHM_V + wid * 1024; \
    __builtin_amdgcn_global_load_lds((const unsigned*)(g_ + voff[0]), (LAS unsigned*)d_, 16, 0, 0); __builtin_amdgcn_global_load_lds((const unsigned*)(g_ + voff[1]), (LAS unsigned*)(d_ + 8192), 16, 0, 0); } while (0)
#define WAIT4_BAR() do { asm volatile("s_waitcnt vmcnt(4)" ::: "memory"); __builtin_amdgcn_s_barrier(); asm volatile("" ::: "memory"); } while (0)
  f32x16 pA0, pA1, pB0, pB1; bf16x8 pa0, pa1, pa2, pa3;
  DMA_K(0); DMA_K(1); DMA_V(0);
  WAIT4_BAR();
  DMA_K(2); DMA_V(1);
  qkt(pA0, pA1, K_lds, qr, r32, hi, cbase); partialSM(pA0); partialSM(pA1);
  int sk = 1, sv = 0;
  for (int j = 1; j + 1 < NT; j += 2) {
    WAIT4_BAR(); DMA_K(j + 2); DMA_V(j + 1);
    SBAR(); att_step(pB0, pB1, K_lds + sk * SHM_K, qr, r32, hi, cbase, pA0, pA1, l_reg, pa0, pa1, pa2, pa3, o, vbb + sv * SHM_V); SBAR();
    sk = sk == 2 ? 0 : sk + 1; sv = sv == 2 ? 0 : sv + 1;
    WAIT4_BAR(); DMA_K(j + 3); DMA_V(j + 2);
    SBAR(); att_step(pA0, pA1, K_lds + sk * SHM_K, qr, r32, hi, cbase, pB0, pB1, l_reg, pa0, pa1, pa2, pa3, o, vbb + sv * SHM_V); SBAR();
    sk = sk == 2 ? 0 : sk + 1; sv = sv == 2 ? 0 : sv + 1;
  }
  WAIT4_BAR(); DMA_K(NT + 1); DMA_V(NT);
  SBAR(); att_step(pB0, pB1, K_lds + sk * SHM_K, qr, r32, hi, cbase, pA0, pA1, l_reg, pa0, pa1, pa2, pa3, o, vbb + sv * SHM_V); SBAR();
  sv = sv == 2 ? 0 : sv + 1;
  WAIT4_BAR();
  finishSM_tail(pB0, pB1, l_reg, pa0, pa1, pa2, pa3); SBAR();
  pv_d0(o, vbb + sv * SHM_V, pa0, pa1, pa2, pa3);
  asm volatile("s_waitcnt vmcnt(0)" ::: "memory");
#undef DMA_K
#undef DMA_V
#undef WAIT4_BAR
  { auto rr = __builtin_amdgcn_permlane32_swap(__float_as_uint(l_reg), __float_as_uint(l_reg), false, false); l_reg = __uint_as_float(rr[0]) + __uint_as_float(rr[1]); }
  if (hi == 0) li_l[r32] = l_reg; asm volatile("s_waitcnt lgkmcnt(0)" ::: "memory");
  float rli[16];
#pragma unroll
  for (int r = 0; r < 16; ++r) rli[r] = __builtin_amdgcn_rcpf(li_l[crow(r, hi)]);
  __syncthreads();
  LAS float* X = (LAS float*)(lds) + rg * 4096 + lane;
  if (comp == 1) {
#pragma unroll
    for (int d0 = 0; d0 < 4; ++d0)
#pragma unroll
      for (int r = 0; r < 16; ++r) X[(d0 * 16 + r) * 64] = o[d0][r] * rli[r] * lam;
  }
  __syncthreads();
  if (comp == 0) {
    float ss[16];
#pragma unroll
    for (int r = 0; r < 16; ++r) ss[r] = 0.f;
#pragma unroll
    for (int d0 = 0; d0 < 4; ++d0)
#pragma unroll
      for (int r = 0; r < 16; ++r) { const float v = o[d0][r] * rli[r] - X[(d0 * 16 + r) * 64]; o[d0][r] = v; ss[r] += v * v; }
#pragma unroll
    for (int r = 0; r < 16; ++r) { float s = ss[r]; s += __shfl_xor(s, 1); s += __shfl_xor(s, 2); s += __shfl_xor(s, 4); s += __shfl_xor(s, 8); s += __shfl_xor(s, 16);
      ss[r] = __builtin_amdgcn_rsqf(s * (1.0f / 128.0f) + EPS) * oscale; }
    bf16_t* Ow = Og + (size_t)(rg * 32) * LDP;
#pragma unroll
    for (int d0 = 0; d0 < 4; ++d0) { const float g = gsub[d0 * 32 + r32];
#pragma unroll
#ifdef PROBE_ZERO_ATTN
      for (int r = 0; r < 16; ++r) Ow[(size_t)crow(r, hi) * LDP + d0 * 32 + r32] = (bf16_t)0;
#else
      for (int r = 0; r < 16; ++r) Ow[(size_t)crow(r, hi) * LDP + d0 * 32 + r32] = (bf16_t)(cvt_pk_bf16(o[d0][r] * ss[r] * g, 0.f) & 0xffffu);
#endif
    }
  }
  __syncthreads();
}
}


namespace att16 {
using att::KVBLK; using att::SHM_V; using att::SHM_K; using att::LDP;
constexpr int OFF_V = 0, OFF_K = 4 * SHM_V;
typedef f32x4 S8[4][2];
__device__ __forceinline__ f32x4 mma16(bf16x8 a, bf16x8 b, f32x4 c) { return __builtin_amdgcn_mfma_f32_16x16x32_bf16(a, b, c, 0, 0, 0); }
template <int OFF> __device__ __forceinline__ s16x4 tr_read(int vb) { s16x4 r; asm volatile("ds_read_b64_tr_b16 %0, %1 offset:%2" : "=&v"(r) : "v"(vb), "i"(OFF) : "memory"); return r; }
struct VF { s16x4 l0, h0, l1, h1; };
constexpr int v_off(int db, int ks, int half) { return ks * 8192 + half * 4096 + (db >> 1) * 512; }
template <int DP> __device__ __forceinline__ void pv_read(VF& fe, VF& fo, int vbe, int vbo) {
  fe.l0 = tr_read<v_off(2 * DP, 0, 0)>(vbe); fe.h0 = tr_read<v_off(2 * DP, 0, 1)>(vbe); fe.l1 = tr_read<v_off(2 * DP, 1, 0)>(vbe); fe.h1 = tr_read<v_off(2 * DP, 1, 1)>(vbe);
  fo.l0 = tr_read<v_off(2 * DP + 1, 0, 0)>(vbo); fo.h0 = tr_read<v_off(2 * DP + 1, 0, 1)>(vbo); fo.l1 = tr_read<v_off(2 * DP + 1, 1, 0)>(vbo); fo.h1 = tr_read<v_off(2 * DP + 1, 1, 1)>(vbo);
}
#define PKV16(L, H) (bf16x8){L[0], L[1], L[2], L[3], H[0], H[1], H[2], H[3]}
__device__ __forceinline__ void kf_read(bf16x8 (&kf)[4][2], const LAS unsigned char* Ks, int c16, int g, int cbase) {
#pragma unroll
  for (int kb = 0; kb < 4; ++kb)
#pragma unroll
    for (int ks = 0; ks < 2; ++ks) kf[kb][ks] = *(const LAS bf16x8*)(Ks + KSWZ(16 * kb + c16, cbase + (32 * ks + 8 * g) * 2));
}
__device__ __forceinline__ void qk_first(S8& S, const LAS unsigned char* Ks, const bf16x8 (&qf)[2][2], int c16, int g, int cbase) {
  bf16x8 kf[4][2]; kf_read(kf, Ks, c16, g, cbase);
#pragma unroll
  for (int kb = 0; kb < 4; ++kb)
#pragma unroll
    for (int qb = 0; qb < 2; ++qb) { f32x4 a = {0.f, 0.f, 0.f, 0.f}; a = mma16(kf[kb][0], qf[qb][0], a); a = mma16(kf[kb][1], qf[qb][1], a);
#pragma unroll
      for (int r = 0; r < 4; ++r) a[r] = __builtin_amdgcn_exp2f(a[r]);
      S[kb][qb] = a; }
}
#define ADDF16(acc, x) asm("v_add_f32 %0, %1, %0" : "+v"(acc) : "v"(x))
#define PACK16(E, KS, QB, W) do { const f32x4& e_ = E[2 * (KS) + ((W) >> 1)][QB]; pw[KS][QB][W] = cvt_pk_bf16(e_[2 * ((W) & 1)], e_[2 * ((W) & 1) + 1]); } while (0)
#define LSUM16() do { const bf16x8 on_ = {0x3F80, 0x3F80, 0x3F80, 0x3F80, 0x3F80, 0x3F80, 0x3F80, 0x3F80};                                                        \
    l2[0] = mma16(on_, __builtin_bit_cast(bf16x8, pw[0][0]), l2[0]); l2[1] = mma16(on_, __builtin_bit_cast(bf16x8, pw[0][1]), l2[1]);                               \
    l2[0] = mma16(on_, __builtin_bit_cast(bf16x8, pw[1][0]), l2[0]); l2[1] = mma16(on_, __builtin_bit_cast(bf16x8, pw[1][1]), l2[1]); } while (0)
__device__ __forceinline__ void pack_all(const S8& E, u32x4 (&pw)[2][2]) {
#pragma unroll
  for (int ks = 0; ks < 2; ++ks)
#pragma unroll
    for (int qb = 0; qb < 2; ++qb) { PACK16(E, ks, qb, 0); PACK16(E, ks, qb, 1); PACK16(E, ks, qb, 2); PACK16(E, ks, qb, 3); }
}
#define PV16(DB, F) do { _Pragma("unroll") for (int qb_ = 0; qb_ < 2; ++qb_) { o[DB][qb_] = mma16(PKV16(F.l0, F.h0), __builtin_bit_cast(bf16x8, pw[0][qb_]), o[DB][qb_]); \
    o[DB][qb_] = mma16(PKV16(F.l1, F.h1), __builtin_bit_cast(bf16x8, pw[1][qb_]), o[DB][qb_]); } } while (0)
__device__ __forceinline__ void pv_last(f32x4 (&o)[8][2], const u32x4 (&pw)[2][2], int vbe, int vbo) {
  VF ae, ao, be, bo;
  pv_read<0>(ae, ao, vbe, vbo); pv_read<1>(be, bo, vbe, vbo);
  asm volatile("s_waitcnt lgkmcnt(8)" ::: "memory"); SBAR(); PV16(0, ae); PV16(1, ao); SBAR();
  pv_read<2>(ae, ao, vbe, vbo);
  asm volatile("s_waitcnt lgkmcnt(8)" ::: "memory"); SBAR(); PV16(2, be); PV16(3, bo); SBAR();
  pv_read<3>(be, bo, vbe, vbo);
  asm volatile("s_waitcnt lgkmcnt(8)" ::: "memory"); SBAR(); PV16(4, ae); PV16(5, ao); SBAR();
  asm volatile("s_waitcnt lgkmcnt(0)" ::: "memory"); SBAR(); PV16(6, be); PV16(7, bo);
}
__device__ __forceinline__ void att_step(S8& S, const LAS unsigned char* Ks, const bf16x8 (&qf)[2][2], int c16, int g, int cbase, const S8& E, f32x4 (&l2)[2], f32x4 (&o)[8][2], int vbe, int vbo) {
  bf16x8 kf[4][2]; u32x4 pw[2][2]; VF ae, ao, be, bo;
  kf_read(kf, Ks, c16, g, cbase);
#define QK16(KB, N, PRE, P0, P1, P2, P3) do { asm volatile("s_waitcnt lgkmcnt(" #N ")" ::: "memory"); PRE; SBAR(); f32x4 a0_ = {0.f, 0.f, 0.f, 0.f}, a1_ = {0.f, 0.f, 0.f, 0.f};  \
    a0_ = mma16(kf[KB][0], qf[0][0], a0_); SBAR(); P0; SBAR(); a1_ = mma16(kf[KB][0], qf[1][0], a1_); SBAR(); P1; SBAR();                                     \
    a0_ = mma16(kf[KB][1], qf[0][1], a0_); SBAR(); P2; SBAR(); a1_ = mma16(kf[KB][1], qf[1][1], a1_); SBAR(); P3; SBAR(); S[KB][0] = a0_; S[KB][1] = a1_; } while (0)
  QK16(0, 6, (void)0, PACK16(E, 0, 0, 0), PACK16(E, 0, 0, 1), PACK16(E, 0, 0, 2), PACK16(E, 0, 0, 3));
  QK16(1, 4, (void)0, PACK16(E, 0, 1, 0), PACK16(E, 0, 1, 1), PACK16(E, 0, 1, 2), PACK16(E, 0, 1, 3));
  QK16(2, 2, (void)0, PACK16(E, 1, 0, 0), PACK16(E, 1, 0, 1), PACK16(E, 1, 0, 2), PACK16(E, 1, 0, 3));
  QK16(3, 0, (pv_read<0>(ae, ao, vbe, vbo), pv_read<1>(be, bo, vbe, vbo)), PACK16(E, 1, 1, 0), PACK16(E, 1, 1, 1), PACK16(E, 1, 1, 2), PACK16(E, 1, 1, 3));
#undef QK16
#define EX1(KB, QB, R) S[KB][QB][R] = __builtin_amdgcn_exp2f(S[KB][QB][R])
#define PVX(DB, F, KB) do { o[DB][0] = mma16(PKV16(F.l0, F.h0), __builtin_bit_cast(bf16x8, pw[0][0]), o[DB][0]); SBAR(); EX1(KB, 0, 0); SBAR();                    \
    o[DB][1] = mma16(PKV16(F.l0, F.h0), __builtin_bit_cast(bf16x8, pw[0][1]), o[DB][1]); SBAR(); EX1(KB, 0, 1); SBAR();                                          \
    o[DB][0] = mma16(PKV16(F.l1, F.h1), __builtin_bit_cast(bf16x8, pw[1][0]), o[DB][0]); SBAR(); EX1(KB, 0, 2); SBAR();                                          \
    o[DB][1] = mma16(PKV16(F.l1, F.h1), __builtin_bit_cast(bf16x8, pw[1][1]), o[DB][1]); SBAR(); EX1(KB, 0, 3); SBAR(); } while (0)
#define PVY(DB, F, KB) do { o[DB][0] = mma16(PKV16(F.l0, F.h0), __builtin_bit_cast(bf16x8, pw[0][0]), o[DB][0]); SBAR(); EX1(KB, 1, 0); SBAR();                    \
    o[DB][1] = mma16(PKV16(F.l0, F.h0), __builtin_bit_cast(bf16x8, pw[0][1]), o[DB][1]); SBAR(); EX1(KB, 1, 1); SBAR();                                          \
    o[DB][0] = mma16(PKV16(F.l1, F.h1), __builtin_bit_cast(bf16x8, pw[1][0]), o[DB][0]); SBAR(); EX1(KB, 1, 2); SBAR();                                          \
    o[DB][1] = mma16(PKV16(F.l1, F.h1), __builtin_bit_cast(bf16x8, pw[1][1]), o[DB][1]); SBAR(); EX1(KB, 1, 3); SBAR(); } while (0)
  SBAR(); LSUM16(); SBAR();
  asm volatile("s_waitcnt lgkmcnt(8)" ::: "memory"); SBAR(); PVX(0, ae, 0); PVY(1, ao, 0); pv_read<2>(ae, ao, vbe, vbo);
  asm volatile("s_waitcnt lgkmcnt(8)" ::: "memory"); SBAR(); PVX(2, be, 1); PVY(3, bo, 1); pv_read<3>(be, bo, vbe, vbo);
  asm volatile("s_waitcnt lgkmcnt(8)" ::: "memory"); SBAR(); PVX(4, ae, 2); PVY(5, ao, 2);
  asm volatile("s_waitcnt lgkmcnt(0)" ::: "memory"); SBAR(); PVX(6, be, 3); PVY(7, bo, 3);
#undef PVX
#undef PVY
#undef EX1
}
__device__ __forceinline__ void attn_unit(const bf16_t* Qg, const bf16_t* __restrict__ Kg, const bf16_t* __restrict__ Vg, bf16_t* Og, int seq, float lam, const float* gsub, float oscale, LAS unsigned char* lds, bool rev) {
  int tid_l = threadIdx.x; asm volatile("" : "+v"(tid_l));
  const int tid = tid_l, wid = __builtin_amdgcn_readfirstlane(tid >> 6), lane = tid & 63, c16 = lane & 15, g = lane >> 4;
  const int comp = wid & 1, rg = wid >> 1, cbase = comp * 128;
  LAS unsigned char* V_lds = lds + OFF_V; LAS unsigned char* K_lds = lds + OFF_K;

  f32x4 l2[2] = {{0.f, 0.f, 0.f, 0.f}, {0.f, 0.f, 0.f, 0.f}}; f32x4 o[8][2]; bf16x8 qf[2][2];
#pragma unroll
  for (int db = 0; db < 8; ++db)
#pragma unroll
    for (int qb = 0; qb < 2; ++qb) o[db][qb] = (f32x4){0.f, 0.f, 0.f, 0.f};
#pragma unroll
  for (int qb = 0; qb < 2; ++qb)
#pragma unroll
    for (int ks = 0; ks < 2; ++ks) qf[qb][ks] = *(const bf16x8*)(Qg + (size_t)(rg * 32 + 16 * qb + c16) * LDP + comp * 64 + 32 * ks + 8 * g);
  unsigned koff[2], voff[2];
#pragma unroll
  for (int i = 0; i < 2; ++i) { const int L = (tid + 512 * i) * 16; { const int row = L >> 8, colB = (L & 255) ^ ((row & 15) << 4); koff[i] = (unsigned)(row * LDP * 2 + colB); }
    { const int sub = L >> 9, w = L & 511, k = (sub >> 2) * 8 + (w >> 6), cl = ((w & 63) >> 1) ^ (((k >> 2) & 1) << 4), c = (sub & 3) * 32 + cl; voff[i] = (unsigned)(k * LDP * 2 + c * 2); } }
  const int vb0 = (int)(unsigned)(size_t)V_lds + (g >> 1) * 2048 + (g & 1) * 256 + ((c16 >> 2) & 3) * 64 + (c16 & 3) * 8;
  const int vbe0 = vb0 + (g & 1) * 32, vbo0 = vb0 + ((g & 1) ^ 1) * 32;
  const int NT = seq / KVBLK; const size_t tstep = (size_t)KVBLK * LDP * 2;
#define DMA_K(t) do { const int t_ = (t) < NT ? (t) : NT - 1; const char* g_ = (const char*)Kg + (size_t)(rev ? NT - 1 - t_ : t_) * tstep; LAS unsigned char* d_ = K_lds + (t_ & 3) * SHM_K + wid * 1024; \
    __builtin_amdgcn_global_load_lds((const unsigned*)(g_ + koff[0]), (LAS unsigned*)d_, 16, 0, 0); __builtin_amdgcn_global_load_lds((const unsigned*)(g_ + koff[1]), (LAS unsigned*)(d_ + 8192), 16, 0, 0); } while (0)
#define DMA_V(t) do { const int t_ = (t) < NT ? (t) : NT - 1; const char* g_ = (const char*)Vg + (size_t)(rev ? NT - 1 - t_ : t_) * tstep; LAS unsigned char* d_ = V_lds + (t_ & 3) * SHM_V + wid * 1024; \
    __builtin_amdgcn_global_load_lds((const unsigned*)(g_ + voff[0]), (LAS unsigned*)d_, 16, 0, 0); __builtin_amdgcn_global_load_lds((const unsigned*)(g_ + voff[1]), (LAS unsigned*)(d_ + 8192), 16, 0, 0); } while (0)
#define WAIT4_BAR() do { asm volatile("s_waitcnt vmcnt(8)" ::: "memory"); __builtin_amdgcn_s_barrier(); asm volatile("" ::: "memory"); } while (0)
  S8 pA, pB;
  DMA_K(0); DMA_K(1); DMA_V(0); DMA_K(2); DMA_V(1);
  WAIT4_BAR();
  DMA_K(3); DMA_V(2);
  qk_first(pA, K_lds, qf, c16, g, cbase);
  for (int j = 1; j + 1 < NT; j += 2) {
    WAIT4_BAR(); DMA_K(j + 3); DMA_V(j + 2);
    SBAR(); att_step(pB, K_lds + (j & 3) * SHM_K, qf, c16, g, cbase, pA, l2, o, vbe0 + ((j - 1) & 3) * SHM_V, vbo0 + ((j - 1) & 3) * SHM_V); SBAR();
    WAIT4_BAR(); DMA_K(j + 4); DMA_V(j + 3);
    SBAR(); att_step(pA, K_lds + ((j + 1) & 3) * SHM_K, qf, c16, g, cbase, pB, l2, o, vbe0 + (j & 3) * SHM_V, vbo0 + (j & 3) * SHM_V); SBAR();
  }
  WAIT4_BAR(); DMA_K(NT + 2); DMA_V(NT + 1);
  SBAR(); att_step(pB, K_lds + ((NT - 1) & 3) * SHM_K, qf, c16, g, cbase, pA, l2, o, vbe0 + ((NT - 2) & 3) * SHM_V, vbo0 + ((NT - 2) & 3) * SHM_V); SBAR();
  WAIT4_BAR();
  const int sv = (NT - 1) & 3;
  { u32x4 pw[2][2]; pack_all(pB, pw); SBAR(); LSUM16(); SBAR(); pv_last(o, pw, vbe0 + sv * SHM_V, vbo0 + sv * SHM_V); }
  asm volatile("s_waitcnt vmcnt(0)" ::: "memory");
#undef DMA_K
#undef DMA_V
#undef WAIT4_BAR
  float rl[2];
#pragma unroll
  for (int qb = 0; qb < 2; ++qb) rl[qb] = __builtin_amdgcn_rcpf(l2[qb][0]);
  __syncthreads();
  LAS float* X = (LAS float*)(lds) + rg * 4096 + lane;
  if (comp == 1) {
#pragma unroll
    for (int db = 0; db < 8; ++db)
#pragma unroll
      for (int qb = 0; qb < 2; ++qb)
#pragma unroll
        for (int r = 0; r < 4; ++r) X[((db * 2 + qb) * 4 + r) * 64] = o[db][qb][r] * rl[qb] * lam;
  }
  __syncthreads();
  if (comp == 0) {
    float ss[2] = {0.f, 0.f};
#pragma unroll
    for (int db = 0; db < 8; ++db)
#pragma unroll
      for (int qb = 0; qb < 2; ++qb)
#pragma unroll
        for (int r = 0; r < 4; ++r) { const float v = o[db][qb][r] * rl[qb] - X[((db * 2 + qb) * 4 + r) * 64]; o[db][qb][r] = v; ss[qb] += v * v; }
#pragma unroll
    for (int qb = 0; qb < 2; ++qb) { float t = ss[qb]; t += __shfl_xor(t, 16); t += __shfl_xor(t, 32); ss[qb] = __builtin_amdgcn_rsqf(t * (1.0f / 128.0f) + EPS) * oscale; }
#pragma unroll
    for (int db = 0; db < 8; ++db) { const f32x4 gs = *(const f32x4*)(gsub + 16 * db + 4 * g);
#pragma unroll
      for (int qb = 0; qb < 2; ++qb) { const f32x4 v = o[db][qb] * gs * ss[qb]; u32x2 w; w.x = cvt_pk_bf16(v[0], v[1]); w.y = cvt_pk_bf16(v[2], v[3]);
        *(u32x2*)(Og + (size_t)(rg * 32 + 16 * qb + c16) * LDP + 16 * db + 4 * g) = w; } }
  }
  __syncthreads();
}
#undef PV16
#undef PACK16
#undef LSUM16
#undef ADDF16
#undef PKV16
}

#define XB_TMO      128
#define XB_XCNT(j)  (256  + 64 * (j))
#define XB_XSUB(j)  (1280 + 64 * (j))
#define XB_XGEN(j)  (2304 + 64 * (j))
#define XB_TOP      3328
#define XB_TOPGEN   3392
#define XCD_BAR_WORDS 3456
#define XB_SPIN_CAP (1u << 20)
__device__ __forceinline__ unsigned xb_ld(unsigned* p)              { return __hip_atomic_load(p, __ATOMIC_RELAXED, __HIP_MEMORY_SCOPE_AGENT); }
__device__ __forceinline__ unsigned xb_add(unsigned* p, unsigned v) { return __hip_atomic_fetch_add(p, v, __ATOMIC_RELAXED, __HIP_MEMORY_SCOPE_AGENT); }
__device__ __forceinline__ unsigned xb_xcc_id() { return (unsigned)__builtin_amdgcn_s_getreg((3 << 11) | 20) & 0xFu; }
#define XB_SPIN(cond, bar) do { unsigned _sp = 0; while (cond) { __builtin_amdgcn_s_sleep(1); \
    if ((++_sp & 255u) == 0u) { if (xb_ld(&(bar)[XB_TMO])) break; if (_sp > XB_SPIN_CAP) { atomicAdd(&(bar)[XB_TMO], 1u); break; } } } } while (0)
struct XcdBarrier { unsigned* bar; unsigned x; volatile LAS unsigned* st; };
__device__ __forceinline__ XcdBarrier xcd_barrier_post(unsigned* bar, volatile LAS unsigned* st) {
    XcdBarrier b; b.bar = bar; b.x = xb_xcc_id(); b.st = st;
    if (threadIdx.x == 0) (void)xb_add(&bar[XB_XCNT(b.x)], 1u);
    return b;
}
__device__ __forceinline__ void xcd_barrier_complete(unsigned* bar, unsigned x, unsigned& nloc, unsigned& nx) {
    const unsigned G = gridDim.x * gridDim.y * gridDim.z;
    unsigned sum, cnt, mine, sp = 0u;
    for (;;) {
        sum = 0u; cnt = 0u; mine = 0u;
#pragma unroll
        for (unsigned j = 0; j < 16; ++j) { const unsigned c = xb_ld(&bar[XB_XCNT(j)]); sum += c; cnt += (c > 0u) ? 1u : 0u; mine = (j == x) ? c : mine; }
        if (sum == G) break;
        __builtin_amdgcn_s_sleep(1);
        if ((++sp & 255u) == 0u) { if (xb_ld(&bar[XB_TMO])) break; if (sp > XB_SPIN_CAP) { atomicAdd(&bar[XB_TMO], 1u); break; } }
    }
    nloc = mine > 0u ? mine : 1u; nx = cnt > 0u ? cnt : 1u;
}
__device__ __forceinline__ void xcd_barrier(const XcdBarrier& b) {
    asm volatile("s_waitcnt vmcnt(0)" ::: "memory");
    __syncthreads();
    if (threadIdx.x == 0) {
        unsigned* bar = b.bar;
        __builtin_amdgcn_s_waitcnt(0);
        unsigned nloc = b.st[0], nx = b.st[1];
        if (nloc == 0u) { xcd_barrier_complete(bar, b.x, nloc, nx); b.st[0] = nloc; b.st[1] = nx; }
        const unsigned old = xb_add(&bar[XB_XSUB(b.x)], 1u);
        const unsigned gen = old / nloc;
        if (old + 1u == (gen + 1u) * nloc) {
            __builtin_amdgcn_fence(__ATOMIC_RELEASE, "agent");
            asm volatile("s_waitcnt vmcnt(0)" ::: "memory");
            const unsigned og = xb_add(&bar[XB_TOP], 1u);
            const unsigned tg = og / nx;
            if (og + 1u == (tg + 1u) * nx) xb_add(&bar[XB_TOPGEN], 1u);
            else XB_SPIN(xb_ld(&bar[XB_TOPGEN]) == tg, bar);
            __builtin_amdgcn_fence(__ATOMIC_ACQUIRE, "agent");
            xb_add(&bar[XB_XGEN(b.x)], 1u);
            asm volatile("s_waitcnt vmcnt(0)" ::: "memory");
        } else {
            XB_SPIN(xb_ld(&bar[XB_XGEN(b.x)]) == gen, bar);
            __builtin_amdgcn_fence(__ATOMIC_ACQUIRE, "agent");
            asm volatile("s_waitcnt vmcnt(0)" ::: "memory");
        }
    }
    __syncthreads();
}

#define LDS_WAIT() asm volatile("s_waitcnt lgkmcnt(0)" ::: "memory")
__device__ __forceinline__ float wave_sum(float v) {
#pragma unroll
    for (int o = 1; o < 64; o <<= 1) v += __shfl_xor(v, o);
    return v;
}
typedef __bf16 bf16n2_t __attribute__((ext_vector_type(2)));
__device__ __forceinline__ unsigned cvt2_bf16_native(float lo, float hi) { const bf16n2_t v = {(__bf16)lo, (__bf16)hi}; return __builtin_bit_cast(unsigned, v); }
__device__ __forceinline__ void pool_fold_item(const float* Wp, const float* ps, const float* Wol, bf16_t* WT, int g_, int nb, int lane) {
    const int c16 = lane & 15, kg = lane >> 4, n0 = nb * 64;
    bf16x8 bfr[4][8];
#pragma unroll
    for (int ks = 0; ks < 8; ++ks) { const int d0 = ks * 32 + 8 * kg; const f32x4 p0 = *(const f32x4*)(ps + d0), p1 = *(const f32x4*)(ps + d0 + 4);
#pragma unroll
        for (int nh = 0; nh < 2; ++nh) { float t[2][8];
#pragma unroll
            for (int nq = 0; nq < 2; ++nq) { const float* bp = Wol + (size_t)d0 * 2048 + n0 + 16 * (2 * nh + nq) + c16;
#pragma unroll
                for (int j = 0; j < 8; ++j) t[nq][j] = bp[j * 2048]; }
            __builtin_amdgcn_sched_barrier(0);
#pragma unroll
            for (int nq = 0; nq < 2; ++nq) { u32x4 w;
                w.x = cvt2_bf16_native(t[nq][0] * p0[0], t[nq][1] * p0[1]); w.y = cvt2_bf16_native(t[nq][2] * p0[2], t[nq][3] * p0[3]);
                w.z = cvt2_bf16_native(t[nq][4] * p1[0], t[nq][5] * p1[1]); w.w = cvt2_bf16_native(t[nq][6] * p1[2], t[nq][7] * p1[3]); bfr[2 * nh + nq][ks] = __builtin_bit_cast(bf16x8, w); }
            __builtin_amdgcn_sched_barrier(0); } }
    for (int cb = 0; cb < 16; ++cb) { f32x4 acc[4];
#pragma unroll
        for (int nbk = 0; nbk < 4; ++nbk) acc[nbk] = (f32x4){0.f, 0.f, 0.f, 0.f};
#pragma unroll
        for (int kh = 0; kh < 2; ++kh) { f32x4 av[4][2];
#pragma unroll
            for (int k4 = 0; k4 < 4; ++k4) { const float* ap = Wp + (size_t)(cb * 16 + c16) * 256 + (kh * 4 + k4) * 32 + 8 * kg; av[k4][0] = *(const f32x4*)ap; av[k4][1] = *(const f32x4*)(ap + 4); }
            __builtin_amdgcn_sched_barrier(0);
#pragma unroll
            for (int k4 = 0; k4 < 4; ++k4) { const f32x4 a0 = av[k4][0], a1 = av[k4][1];
                u32x4 w; w.x = cvt2_bf16_native(a0[0], a0[1]); w.y = cvt2_bf16_native(a0[2], a0[3]); w.z = cvt2_bf16_native(a1[0], a1[1]); w.w = cvt2_bf16_native(a1[2], a1[3]); const bf16x8 af = __builtin_bit_cast(bf16x8, w);
#pragma unroll
                for (int nbk = 0; nbk < 4; ++nbk) acc[nbk] = __builtin_amdgcn_mfma_f32_16x16x32_bf16(af, bfr[nbk][kh * 4 + k4], acc[nbk], 0, 0, 0); }
            __builtin_amdgcn_sched_barrier(0); }
#pragma unroll
        for (int nbk = 0; nbk < 4; ++nbk) { u32x2 o; o.x = cvt2_bf16_native(acc[nbk][0], acc[nbk][1]); o.y = cvt2_bf16_native(acc[nbk][2], acc[nbk][3]);
            *(u32x2*)(WT + (size_t)(n0 + 16 * nbk + c16) * 2048 + 1024 + g_ * 256 + cb * 16 + 4 * kg) = o; }
        __builtin_amdgcn_sched_barrier(0); }
}
__device__ __forceinline__ unsigned cvt_pk_f16_rne(float a, float b) { const h2_t v = {(_Float16)a, (_Float16)b}; return __builtin_bit_cast(unsigned, v); }
template <bool F16 = false>
__device__ __forceinline__ void tr_item(const float* W, int K, int N, bf16_t* WT, const float* rs, const float* cs, int perm_limit, LAS float* scr, int item, int lane) {
    const int nblk = N / 32, kb = item / nblk, nb = item % nblk, k0 = 64 * kb, n0 = 32 * nb;
    const float csv = cs ? cs[n0 + (lane & 31)] : 1.f;
    float wv[32], rv[32];
#pragma unroll
    for (int i = 0; i < 32; ++i) { const int kk = 2 * i + (lane >> 5); wv[i] = W[(size_t)(k0 + kk) * N + n0 + (lane & 31)]; rv[i] = rs ? rs[k0 + kk] : 1.f; }
#pragma unroll
    for (int i = 0; i < 32; ++i) { const int kk = 2 * i + (lane >> 5); scr[kk * 33 + (lane & 31)] = wv[i] * rv[i] * csv; }
    LDS_WAIT(); asm volatile("" ::: "memory");
    int d0 = n0; if (n0 < perm_limit) { const int tile = n0 >> 8, lb = (n0 >> 5) & 7; d0 = (tile << 8) + ((4 * (lb & 1) + (lb >> 1)) << 5); }
    if (perm_limit < 0) { const int isv = n0 >= D_FF, ch = n0 - (isv ? D_FF : 0); d0 = (ch >> 7) * 256 + isv * 128 + (ch & 127); }
    const int c = lane & 7;
#pragma unroll
    for (int j = 0; j < 4; ++j) { const int n = (lane >> 3) + 8 * j; const LAS float* s = scr + (8 * c) * 33 + n;
        u32x4 o;
        if constexpr (F16) { o.x = cvt_pk_f16_rne(s[0 * 33], s[1 * 33]); o.y = cvt_pk_f16_rne(s[2 * 33], s[3 * 33]); o.z = cvt_pk_f16_rne(s[4 * 33], s[5 * 33]); o.w = cvt_pk_f16_rne(s[6 * 33], s[7 * 33]); }
        else { o.x = cvt_pk_bf16(s[0 * 33], s[1 * 33]); o.y = cvt_pk_bf16(s[2 * 33], s[3 * 33]); o.z = cvt_pk_bf16(s[4 * 33], s[5 * 33]); o.w = cvt_pk_bf16(s[6 * 33], s[7 * 33]); }
        *(u32x4*)(WT + (size_t)(d0 + n) * K + k0 + 8 * c) = o; }
    LDS_WAIT(); asm volatile("" ::: "memory");
}
__device__ __forceinline__ void norm_row(const float* xrow, bf16_t* orow, float* crow_, int lane) {
    f32x4 v[8]; float s = 0.f;
#pragma unroll
    for (int j = 0; j < 4; ++j) { v[2 * j] = *(const f32x4*)(xrow + j * 512 + lane * 8); v[2 * j + 1] = *(const f32x4*)(xrow + j * 512 + lane * 8 + 4); s += pg8::sumsq4(v[2 * j]) + pg8::sumsq4(v[2 * j + 1]); }
    const float rstd = __builtin_amdgcn_rsqf(wave_sum(s) * (1.0f / D_MODEL) + EPS);
#pragma unroll
    for (int j = 0; j < 4; ++j) { if (crow_) { *(f32x4*)(crow_ + j * 512 + lane * 8) = v[2 * j]; *(f32x4*)(crow_ + j * 512 + lane * 8 + 4) = v[2 * j + 1]; }
        *(u32x4*)(orow + j * 512 + lane * 8) = pg8::pack8(v[2 * j] * rstd, v[2 * j + 1] * rstd); }
}

__device__ __forceinline__ void raw_row(const float* xrow, bf16_t* orow, rss_t* ssq, int lane) {
    f32x4 v[8]; float s = 0.f;
#pragma unroll
    for (int j = 0; j < 4; ++j) { v[2 * j] = *(const f32x4*)(xrow + j * 512 + lane * 8); v[2 * j + 1] = *(const f32x4*)(xrow + j * 512 + lane * 8 + 4); s += pg8::sumsq4(v[2 * j]) + pg8::sumsq4(v[2 * j + 1]); }
    s = wave_sum(s); if (lane == 0) *ssq = ss_fix(s);
#pragma unroll
    for (int j = 0; j < 4; ++j) *(u32x4*)(orow + j * 512 + lane * 8) = pg8::pack8(v[2 * j], v[2 * j + 1]);
}

template <int WIN> __device__ __forceinline__ void pool_item(const bf16_t* U, bf16_t* ZP, int r0, int ch, bool big) {
    constexpr int NR = 3 + 2 * WIN, SM = WIN / 2;
    const int pos0 = tok_pos(r0), S = tok_seqlen(r0);
    u32x4 v[NR];
#pragma unroll
    for (int k = 0; k < NR; ++k) { const int p = pos0 - WIN + k; v[k] = (p >= 0 && p < S) ? *(const u32x4*)(U + (size_t)(r0 - WIN + k) * 1024 + ch) : (u32x4){0u, 0u, 0u, 0u}; }
    float sb[8], ss[8];
#pragma unroll
    for (int j = 0; j < 8; ++j) { sb[j] = 0.f; ss[j] = 0.f; }
#define POOL_ACC(dst, k, sgn) do { const u32x4 w_ = v[k]; dst[0] += sgn bflo(w_.x); dst[1] += sgn bfhi(w_.x); dst[2] += sgn bflo(w_.y); dst[3] += sgn bfhi(w_.y); dst[4] += sgn bflo(w_.z); dst[5] += sgn bfhi(w_.z); dst[6] += sgn bflo(w_.w); dst[7] += sgn bfhi(w_.w); } while (0)
#pragma unroll
    for (int k = 0; k < 2 * WIN; ++k) { POOL_ACC(sb, k, +); if (k >= WIN - SM && k < WIN + SM) POOL_ACC(ss, k, +); }
#pragma unroll
    for (int i = 0; i < 4; ++i) {
        if (i > 0) { POOL_ACC(sb, i + 2 * WIN - 1, +); POOL_ACC(sb, i - 1, -); POOL_ACC(ss, i + WIN + SM - 1, +); POOL_ACC(ss, i + WIN - SM - 1, -); }
        const int pos = pos0 + i, w2 = big ? WIN : SM; const int lo_ = pos - w2 < 0 ? 0 : pos - w2, hi_ = pos + w2 > S ? S : pos + w2; const float inv = 1.0f / (float)(hi_ - lo_);
        const u32x4 c = v[WIN + i]; float s[8];
#pragma unroll
        for (int j = 0; j < 8; ++j) s[j] = (big ? sb[j] : ss[j]) * inv;
        u32x4 o; o.x = cvt_pk_bf16(s[0] - bflo(c.x), s[1] - bfhi(c.x)); o.y = cvt_pk_bf16(s[2] - bflo(c.y), s[3] - bfhi(c.y)); o.z = cvt_pk_bf16(s[4] - bflo(c.z), s[5] - bfhi(c.z)); o.w = cvt_pk_bf16(s[6] - bflo(c.w), s[7] - bfhi(c.w));
        *(u32x4*)(ZP + (size_t)(r0 + i) * 1024 + ch) = o; }
#undef POOL_ACC
}

struct Args { const float* in[28]; float* out; unsigned char* ws; int ph_lo, ph_hi; };

__global__ void __launch_bounds__(NWAVES * 64, 2) trunk_fwd(Args args) {
    extern __shared__ __attribute__((aligned(16))) unsigned char lds_raw[];
    LAS unsigned char* lds = (LAS unsigned char*)lds_raw;
    volatile LAS unsigned* MISC = (volatile LAS unsigned*)(lds + MISC_OFF);
    for (int u = threadIdx.x; u < (LDS_BYTES - LDSCTL_OFF) / 4; u += NWAVES * 64) ((LAS unsigned*)(lds + LDSCTL_OFF))[u] = 0u;
    __syncthreads();
    const int lo = args.ph_lo, hi = args.ph_hi;
    XcdBarrier bar; bar.bar = (unsigned*)(args.ws + WS_CTL) + CW_BAR; bar.x = 0; bar.st = nullptr;
    if (hi - lo > 1) bar = xcd_barrier_post((unsigned*)(args.ws + WS_CTL) + CW_BAR, MISC + 8);
#define IN(k) ({ int lo_ = lo, hi_ = hi; asm volatile("" : "+s"(lo_), "+s"(hi_)); lo_ <= (k) && (k) < hi_; })
#define SEAM(k) do { if (IN(k) && IN((k) + 1)) { XcdBarrier b2_ = bar; asm volatile("" : "+s"(b2_.bar), "+s"(b2_.x)); xcd_barrier(b2_); } } while (0)
#define PHASE_BEGIN() int tid = threadIdx.x; asm volatile("" : "+v"(tid)); int zo = 0; asm volatile("" : "+s"(zo)); \
    const int lane = tid & 63, wave = __builtin_amdgcn_readfirstlane(tid >> 6); const int G = gridDim.x, bx = blockIdx.x; \
    const int vcu = (G % 8 == 0) ? (bx % 8) * (G / 8) + bx / 8 : bx; const int gw = vcu * NWAVES + wave, NGW = G * NWAVES; \
    unsigned char* ws = args.ws + zo; float* X = args.out + zo; (void)lane; (void)wave; (void)gw; (void)NGW; (void)ws; (void)X; (void)vcu; (void)tid
#define INP(i) (args.in[(i) + zo])
#define WSP(T, off) ((T*)(ws + (off)))

#define CG_UP 1u
#define CG_DOWN 2u
#define CG_IN 4u
#define CG_CKV 8u
#define CG_OUT 16u
#define CG_CQ 32u
#define CG_CO 64u
#define CONV_ITEMS(L_, MASK_) do { const int l_ = (L_); constexpr unsigned m_ = (MASK_); __syncthreads(); LAS float* scr = (LAS float*)(lds + wave * 16384);                                         \
    constexpr int I_IN = 32 * 128, I_OUT = 16 * 64, I_CQ = 32 * 64, I_CKV = 32 * 128, I_CO = 32 * 64, I_UP = 32 * (UP_W / 32), I_DOWN = (D_FF / 64) * 64, I_P = 4 * 32;                                 \
    constexpr int n_ = ((m_ & CG_UP) ? I_UP : 0) + ((m_ & CG_DOWN) ? I_DOWN : 0) + ((m_ & CG_IN) ? I_IN : 0) + ((m_ & CG_CKV) ? I_CKV : 0) + ((m_ & CG_OUT) ? I_OUT + I_P : 0) + ((m_ & CG_CQ) ? I_CQ : 0) + ((m_ & CG_CO) ? I_CO : 0); \
    for (int it = gw; it < n_; it += NGW) { int r = it;                                                                                                                                            \
        if constexpr ((m_ & CG_UP) != 0) { if (r < I_UP) { tr_item(INP(24) + (size_t)l_ * 2048 * UP_W, 2048, UP_W, WSP(bf16_t, WS_WUP), INP(23) + l_ * 2048, nullptr, -1, scr, r, lane); continue; } r -= I_UP; } \
        if constexpr ((m_ & CG_DOWN) != 0) { if (r < I_DOWN) { tr_item<true>(INP(27) + (size_t)l_ * D_FF * 2048, D_FF, 2048, WSP(bf16_t, WS_WDOWN), nullptr, nullptr, 0, scr, r, lane); continue; } r -= I_DOWN; } \
        if constexpr ((m_ & CG_IN) != 0) { if (r < I_IN) { tr_item(INP(5) + (size_t)l_ * 2048 * 4096, 2048, 4096, WSP(bf16_t, WS_WIN), INP(4) + l_ * 2048, nullptr, 2048, scr, r, lane); continue; } r -= I_IN; } \
        if constexpr ((m_ & CG_CKV) != 0) { if (r < I_CKV) { tr_item(INP(19) + (size_t)l_ * 2048 * 4096, 2048, 4096, WSP(bf16_t, WS_WCKV), INP(17) + l_ * 2048, nullptr, 0, scr, r, lane); continue; } r -= I_CKV; } \
        if constexpr ((m_ & CG_OUT) != 0) { if (r < I_OUT) { tr_item(INP(15) + (size_t)l_ * 2048 * 2048, 2048, 2048, WSP(bf16_t, WS_WOUT), nullptr, nullptr, 0, scr, r, lane); continue; } r -= I_OUT;   \
            if (r < I_P) { const int g = r >> 5; pool_fold_item(INP(13) + (size_t)l_ * 4 * 65536 + (size_t)g * 65536, INP(14) + l_ * 1024 + g * 256, INP(15) + (size_t)l_ * 2048 * 2048 + (size_t)(1024 + g * 256) * 2048, WSP(bf16_t, WS_WOUT), g, r & 31, lane); continue; } r -= I_P; } \
        if constexpr ((m_ & CG_CQ) != 0) { if (r < I_CQ) { tr_item(INP(18) + (size_t)l_ * 2048 * 2048, 2048, 2048, WSP(bf16_t, WS_WCQ), INP(16) + l_ * 2048, nullptr, 0, scr, r, lane); continue; } r -= I_CQ; } \
        if constexpr ((m_ & CG_CO) != 0) { if (r < I_CO) { tr_item(INP(22) + (size_t)l_ * 2048 * 2048, 2048, 2048, WSP(bf16_t, WS_WCO), nullptr, nullptr, 0, scr, r, lane); continue; } r -= I_CO; } }   \
    if constexpr ((m_ & CG_UP) != 0) { const float* cw = INP(25) + (size_t)l_ * 3 * UP_W; const float* cb = INP(26) + (size_t)l_ * UP_W; u32x4* cwt = WSP(u32x4, WS_CWT);        \
        for (int it = vcu * 512 + tid; it < D_FF; it += G * 512) { const int p = it >> 1, isv = it & 1, ch = 2 * p + isv * D_FF; u32x4 w;                                                          \
            w.x = cvt_pk_f16_rne(cw[ch], cw[ch + 1]); w.y = cvt_pk_f16_rne(cw[UP_W + ch], cw[UP_W + ch + 1]); w.z = cvt_pk_f16_rne(cw[2 * UP_W + ch], cw[2 * UP_W + ch + 1]); w.w = cvt_pk_f16_rne(cb[ch], cb[ch + 1]); cwt[it] = w; } } } while (0)
    for (int l = 0; l < DEPTH; ++l) {
        const int pb = l * PH_PER_LAYER;
        if (PH_EN(0) && IN(pb + 0)) {
            PHASE_BEGIN();
            if (l == 0) CONV_ITEMS(0, CG_IN | CG_CKV);
            bf16_t* HB = WSP(bf16_t, WS_HB);
            if (l == 0) {
                unsigned* csT = WSP(unsigned, WS_COS);
                for (int e = (vcu * 512 + tid); e < 8192 * 32; e += G * 512) { const int pos = e >> 5, i = e & 31;
                    double inv = 1.0; const double b = 0.74989420933245582730;
                    for (int k = 0; k < i; ++k) inv *= b;
                    double rev = (double)pos * inv * 0.15915494309189533577; rev -= __builtin_floor(rev);
                    const float fr_ = (float)rev;
                    const _Float16 hc = (_Float16)__builtin_amdgcn_cosf(fr_), hs = (_Float16)__builtin_amdgcn_sinf(fr_);
                    csT[e] = (unsigned)__builtin_bit_cast(unsigned short, hc) | ((unsigned)__builtin_bit_cast(unsigned short, hs) << 16); }
                bf16_t* MB = WSP(bf16_t, WS_MB);
                for (int m = gw; m < NMEMROWS; m += NGW) { const float* src = m < 1024 ? INP(2) + (size_t)m * 2048 : INP(3) + (size_t)(m - 1024) * 2048; norm_row(src, MB + (size_t)m * 2048, nullptr, lane); }
                rss_t* rss0 = WSP(rss_t, WS_ROWSS);
                for (int m = gw; m < NTOK; m += NGW) { const float* src = m < NTOK_P ? INP(0) + (size_t)m * 2048 : INP(1) + (size_t)(m - NTOK_P) * 2048; raw_row(src, HB + (size_t)m * 2048, rss0 + m, lane); }
            }
        }
        if (l == 0) SEAM(pb + 0);
        if (PH_EN(1) && IN(pb + 1)) {
            PHASE_BEGIN(); pg8::StaticOrder SO;
            if (PH_EN(17)) { pg8::ProbSimple P; P.K = 2048; P.lda = 2048; P.ldb = 2048; P.tsplit = 1 << 30; P.adelta = 0; P.A = (const char*)WSP(bf16_t, WS_HB); P.B = (const char*)WSP(bf16_t, WS_WIN);
              SO.init(NTOK / 256, IN_W / 256, G, bx, 1);
              pg8::EpiIn E{WSP(bf16_t, R_Q), (size_t)NTOK * 1024, WSP(const unsigned, WS_COS), INP(6) + l * 64, INP(7) + l * 64, WSP(const rss_t, WS_ROWSS) + (size_t)(l * 3 + 0) * NTOK};
              pg8::gemm_phase<pg8::ProbSimple, pg8::EpiIn, true, true>(lds, P, SO, E); }
            if (PH_EN(16)) { pg8::ProbSimple P; P.K = 2048; P.lda = 2048; P.ldb = 2048; P.tsplit = 1 << 30; P.adelta = 0; P.A = (const char*)WSP(bf16_t, WS_MB); P.B = (const char*)WSP(bf16_t, WS_WCKV);
              SO.init(NMEMROWS / 256, 4096 / 256, G, bx);
              pg8::EpiKV E{WSP(float, WS_KRAW), WSP(bf16_t, WS_VT)};
              pg8::gemm_phase<pg8::ProbSimple, pg8::EpiKV, true, true>(lds, P, SO, E); }
            if (G == 256) { if (bx >= 192) { const int gw = (bx - 192) * NWAVES + wave, NGW = 64 * NWAVES; if (l == 0) CONV_ITEMS(0, CG_OUT | CG_CO | CG_CQ); else CONV_ITEMS(l, CG_DOWN); } }
            else { if (l == 0) CONV_ITEMS(0, CG_OUT | CG_CO | CG_CQ); else CONV_ITEMS(l, CG_DOWN); }
        }
        SEAM(pb + 1);
        if (PH_EN(2) && IN(pb + 2)) {
            if (PH_EN(18)) {
              PHASE_BEGIN();
              const float lam_init = 0.8f - 0.6f * __expf(-0.3f * (float)l);
              float s1 = 0.f, s2 = 0.f; const float* q1 = INP(8) + l * 64; const float* k1 = INP(9) + l * 64; const float* q2 = INP(10) + l * 64; const float* k2 = INP(11) + l * 64;
              for (int i = 0; i < 64; ++i) { s1 += q1[i] * k1[i]; s2 += q2[i] * k2[i]; }
              const float lam = __expf(s1) - __expf(s2) + lam_init;
              const float* gsub = INP(12) + l * 128;
              bf16_t* Qb = WSP(bf16_t, R_Q); const bf16_t* Kb = WSP(const bf16_t, R_K); const bf16_t* Vb = WSP(const bf16_t, R_V);
              __syncthreads();
              { const int NX = (G % 8 == 0) ? 8 : 1, xcd = bx % NX, j = bx / NX, nb = G / NX, npr = 2048 / NX;
                  for (int kk = j; kk < 2 * npr; kk += nb) { int pair, qt, S; size_t t0;
                      if (kk < npr) { pair = xcd + NX * (kk >> 6); qt = kk & 63; S = S_P; t0 = (size_t)(pair >> 3) * S_P; }
                      else { const int k2_ = kk - npr; pair = xcd + NX * (k2_ >> 5); qt = k2_ & 31; S = S_S; t0 = (size_t)NTOK_P + (size_t)(pair >> 3) * S_S; }
                      const int h = pair & 7; bf16_t* qp = Qb + (t0 + (size_t)qt * 128) * 1024 + h * 128;
                      ATTN_NS::attn_unit(qp, Kb + t0 * 1024 + h * 128, Vb + t0 * 1024 + h * 128, qp, S, lam, gsub, 1.f - lam_init, lds, kk < npr && ((kk / nb) & 1)); }
              }
            }
            if (PH_EN(14)) { PHASE_BEGIN(); const bf16_t* U = WSP(const bf16_t, R_U); bf16_t* ZP = (bf16_t*)X;
#ifdef PROBE_DOUBLE_PASSES
              int nrq = 2; asm volatile("" : "+s"(nrq)); for (int rq_ = 0; rq_ < nrq; ++rq_)
#endif
              for (int it = gw; it < (NTOK / 4) * 2; it += NGW) { const int r0 = (it >> 1) * 4, half = it & 1, ch = half * 512 + lane * 8;
                  if (half == 0) pool_item<2>(U, ZP, r0, ch, lane >= 32); else pool_item<8>(U, ZP, r0, ch, lane >= 32); } }
            if (PH_EN(15)) { PHASE_BEGIN(); const float* gcq = INP(20) + l * 512; const float* gck = INP(21) + l * 512; const float* KRAW = WSP(const float, WS_KRAW); bf16_t* KC = WSP(bf16_t, WS_KC);
              for (int it = gw; it < NMEMROWS * 4; it += NGW) { const int row = it >> 2, h = it & 3; const float* kr = KRAW + (size_t)row * 2048 + h * 512 + lane * 8;
                  const f32x4 a = *(const f32x4*)kr, b = *(const f32x4*)(kr + 4); const float ss = wave_sum(pg8::sumsq4(a) + pg8::sumsq4(b));
                  const float rk = __builtin_amdgcn_rsqf(ss * (1.0f / 512.0f) + EPS);
                  const f32x4 ga = *(const f32x4*)(gcq + lane * 8) * *(const f32x4*)(gck + lane * 8), gb = *(const f32x4*)(gcq + lane * 8 + 4) * *(const f32x4*)(gck + lane * 8 + 4);
                  *(u32x4*)(KC + (size_t)row * 2048 + h * 512 + lane * 8) = pg8::pack8(a * rk * ga, b * rk * gb); } }
            { PHASE_BEGIN(); if (l == 0) CONV_ITEMS(0, CG_UP); }
        }
        SEAM(pb + 2);
        if (PH_EN(4) && IN(pb + 4)) {
            PHASE_BEGIN(); pg8::StaticOrder SO;
            pg8::ProbSimple P; P.K = 2048; P.lda = 1024; P.ldb = 2048; P.tsplit = 16; P.adelta = (long long)((const char*)X - (const char*)(ws + R_Q)) - 16ll * 128; P.A = (const char*)(ws + R_Q);   P.B = (const char*)WSP(bf16_t, WS_WOUT);
            SO.init(NTOK / 256, 8, G, bx, 1);
            pg8::EpiRes E{WSP(bf16_t, WS_HB), WSP(rss_t, WS_ROWSS) + (size_t)(l * 3 + 1) * NTOK, nullptr};
            pg8::gemm_phase<pg8::ProbSimple, pg8::EpiRes, true, true>(lds, P, SO, E);
            if (PH_EN(3)) {

              pg8::ProbVW P2; P2.K = 512; P2.lda = 2048; P2.ldb = 2048; P2.tsplit = 1 << 30; P2.adelta = 0; P2.A = (const char*)WSP(bf16_t, WS_WCO); P2.B = (const char*)WSP(bf16_t, WS_VT);
              SO.init(8, 48, G, bx);
              pg8::EpiBf<5> E2{WSP(bf16_t, R_VW), 1024, nullptr, nullptr, nullptr};
              pg8::gemm_phase<pg8::ProbVW, pg8::EpiBf<5>, true, true>(lds, P2, SO, E2); }
            if (l == 0) CONV_ITEMS(0, CG_DOWN);
            if (l + 1 < DEPTH) CONV_ITEMS(l + 1, CG_IN | CG_CKV);
        }
        SEAM(pb + 4);
        if (PH_EN(5) && IN(pb + 5)) {
            PHASE_BEGIN(); pg8::StaticOrder SO;
            pg8::ProbSimple P; P.K = 2048; P.lda = 2048; P.ldb = 2048; P.tsplit = 1 << 30; P.adelta = 0; P.A = (const char*)WSP(bf16_t, WS_HB); P.B = (const char*)WSP(bf16_t, WS_WCQ);
            SO.init(NTOK / 256, 8, G, bx, 0);
            pg8::EpiBf<1> E{WSP(bf16_t, R_QC), 2048, WSP(float, WS_QSS), (float*)(WSP(rss_t, WS_ROWSS) + (size_t)(l * 3 + 1) * NTOK), nullptr};
            pg8::gemm_phase<pg8::ProbSimple, pg8::EpiBf<1>, true, true>(lds, P, SO, E);
            if (l + 1 < DEPTH) CONV_ITEMS(l + 1, CG_OUT | CG_CO);
        }
        SEAM(pb + 5);
        if (PH_EN(6) && IN(pb + 6)) {
            PHASE_BEGIN(); pg8::StaticOrder SO;
            pg8::ProbScores P; P.K = 512; P.lda = 2048; P.ldb = 2048; P.tsplit = 1 << 30; P.adelta = 0; P.A = (const char*)(ws + R_QC); P.B = (const char*)WSP(bf16_t, WS_KC);
            SO.init(NTOK / 256, 4, G, bx, 1);
            pg8::EpiBf<2> E{WSP(bf16_t, R_P), 1024, WSP(float, WS_QSS), nullptr, (LAS float*)(lds + XCH_OFF)};
            pg8::gemm_phase<pg8::ProbScores, pg8::EpiBf<2>, true, true>(lds, P, SO, E);
            if (l + 1 < DEPTH) CONV_ITEMS(l + 1, CG_CQ);
        }
        SEAM(pb + 6);
        if (PH_EN(8) && IN(pb + 7)) {
            PHASE_BEGIN(); pg8::StaticOrder SO;
            pg8::ProbFin P; P.K = 1024; P.lda = 1024; P.ldb = 1024; P.tsplit = 1 << 30; P.adelta = 0; P.A = (const char*)(ws + R_P); P.B = (const char*)WSP(bf16_t, R_VW);
            SO.init(NTOK / 256, 8, G, bx, 0);
            pg8::EpiRes E{WSP(bf16_t, WS_HB), WSP(rss_t, WS_ROWSS) + (size_t)(l * 3 + 2) * NTOK, nullptr};
            pg8::gemm_phase<pg8::ProbFin, pg8::EpiRes, true, true>(lds, P, SO, E);
        }
        SEAM(pb + 7);
        const bool whole = (l + 1 < DEPTH); const int nch = whole ? 1 : N_FFN_CHUNKS;
        for (int c = 0; c < nch; ++c) {
            const int pc = pb + 8 + 2 * c; const size_t r0 = (size_t)c * FFN_CHUNK; const int MT = whole ? NTOK / 256 : FFN_MT;
            if (PH_EN(11) && IN(pc)) {
                PHASE_BEGIN(); pg8::StaticOrder SO;
                pg8::ProbUp P; P.K = 2048; P.lda = 2048; P.ldb = 2048; P.tsplit = 1 << 30; P.adelta = 0; P.A = (const char*)(WSP(bf16_t, WS_HB) + r0 * 2048); P.B = (const char*)WSP(bf16_t, WS_WUP); P.chunk = c;
                SO.init(MT, D_FF / 128, G, bx, 1);
                bf16_t* G2p = (bf16_t*)((unsigned char*)X - (size_t)FFN_GSPLIT_ROW * D_FF * 2); bf16_t* EBp = whole ? (bf16_t*)((unsigned char*)X + FFN_EB_OUT_OFF) : WSP(bf16_t, R_EB);
                pg8::EpiGlu E{WSP(bf16_t, R_G), WSP(const rss_t, WS_ROWSS) + (size_t)(l * 3 + 2) * NTOK + r0, WSP(const u32x4, WS_CWT), c, (LAS float*)(lds + GLX_OFF), EBp, G2p, whole ? FFN_GSPLIT_ROW / 256 : (1 << 30)};
                pg8::gemm_phase<pg8::ProbUp, pg8::EpiGlu, true, true>(lds, P, SO, E);
            }
            SEAM(pc);
            if (PH_EN(13) && IN(pc + 1)) {
                PHASE_BEGIN(); pg8::StaticOrder SO;
                bf16_t* G2p = (bf16_t*)((unsigned char*)X - (size_t)FFN_GSPLIT_ROW * D_FF * 2);
                {
                  const bf16_t* EBp = whole ? (const bf16_t*)((unsigned char*)X + FFN_EB_OUT_OFF) : WSP(const bf16_t, R_EB); const u32x4* cwp = WSP(const u32x4, WS_CWT); bf16_t* Gp = WSP(bf16_t, R_G);
                  const int nb = whole ? 244 : (c == 0 ? 124 : 120), gsr = whole ? FFN_GSPLIT_ROW : (1 << 30);
                  for (int it = gw; it < nb * 11; it += NGW) { const int b = it / 11, cb = it - b * 11; int t;
                      if (whole ? b < 124 : c == 0) { const int sq = b / 31, bi = b - sq * 31; t = sq * S_P + 256 * (bi + 1); }
                      else { const int b2 = whole ? b - 124 : b, sq = b2 / 15, bi = b2 - sq * 15; t = (whole ? NTOK_P : 0) + sq * S_S + 256 * (bi + 1); }
                      pg8::ffn_fix_item(EBp, cwp, Gp, G2p, gsr, t, cb, lane); }
                  XcdBarrier b4_ = bar; asm volatile("" : "+s"(b4_.bar), "+s"(b4_.x)); xcd_barrier(b4_); }
                pg8::ProbDown P; P.K = D_FF; P.lda = D_FF; P.ldb = D_FF; P.tsplit = 1 << 30; P.adelta = 0; P.A = (const char*)(ws + R_G); P.A2 = (const char*)G2p; P.B = (const char*)WSP(bf16_t, WS_WDOWN); P.split = whole ? FFN_GSPLIT_ROW / 256 : (1 << 30);
                SO.init(MT, 8, G, bx, 0);
                pg8::EpiRes E{WSP(bf16_t, WS_HB) + r0 * 2048, (l + 1 < DEPTH) ? WSP(rss_t, WS_ROWSS) + (size_t)((l + 1) * 3 + 0) * NTOK + r0 : nullptr, (l + 1 < DEPTH) ? nullptr : X + r0 * 2048};
                pg8::gemm_phase<pg8::ProbDown, pg8::EpiRes, true, true>(lds, P, SO, E);
                if (c == nch - 1 && l + 1 < DEPTH) CONV_ITEMS(l + 1, CG_UP);
            }
            SEAM(pc + 1);
        }
    }
#undef IN
#undef SEAM
#undef PHASE_BEGIN
#undef INP
#undef WSP
}


#ifdef SELFCHECK
constexpr int CHK_WORD = 1024;
__device__ __forceinline__ void chk_upd(unsigned* ctl, int idx, float got, float ref) { const float e = fabsf(got - ref) / (0.03f * fabsf(ref) + 0.03f); atomicMax(ctl + CHK_WORD + idx, __float_as_uint(e)); }
__device__ __forceinline__ int chk_token(int s) { const int tab[16] = {0, 1, 127, 128, 4095, 8191, 8192, 12345, 32767, 32768, 32769, 36863, 36864, 50000, 65534, 65535}; int t = 0;
#pragma unroll
    for (int i = 0; i < 16; ++i) t = (s & 15) == i ? tab[i] : t; return t; }
__global__ void __launch_bounds__(64) check_kernel(Args args, int after, int l) {
    const int s = blockIdx.x, lane = threadIdx.x; unsigned char* ws = args.ws; unsigned* ctl = (unsigned*)(ws + WS_CTL);
    const int tok = chk_token(s); float* X = args.out;
    const float* xin = tok < NTOK_P ? args.in[0] + (size_t)tok * 2048 : args.in[1] + (size_t)(tok - NTOK_P) * 2048;
    if (after == 1) {
        if (l == 0) {
            float ssx = 0.f; for (int k = lane; k < 2048; k += 64) ssx += xin[k] * xin[k]; ssx = wave_sum(ssx); const float rstd = 1.0f / sqrtf(ssx / 2048.f + EPS);
            const int vec = (s * 7) & 31, isk = vec >> 4, hc = vec & 15;
            const float* w_in = args.in[5]; const float* g_mix = args.in[4]; const int col = isk * 1024 + hc * 64 + lane;
            float z = 0.f; for (int k = 0; k < 2048; ++k) z += xin[k] * rstd * g_mix[k] * w_in[(size_t)k * 4096 + col];
            const float ss = wave_sum(z * z); const float g = (isk ? args.in[7] : args.in[6])[lane]; const float zn = z / sqrtf(ss / 64.f + EPS) * g;
            const float other = __shfl_xor(zn, 32); const int i = lane & 31; const int pos = tok_pos(tok);
            const float ang = (float)pos * powf(10000.f, -(float)i / 32.f); const float c = cosf(ang), sn = sinf(ang);
            const float ref = lane < 32 ? zn * c - other * sn : zn * c + other * sn;
            const bf16_t* Q = (const bf16_t*)(ws + (isk ? R_K : R_Q)); const float got = bf2f(Q[(size_t)tok * 1024 + hc * 64 + lane]);
            const float gother = __shfl_xor(got, 32);
            (void)gother; chk_upd(ctl, 0, got, ref);
            { const unsigned tv = ((const unsigned*)(ws + WS_COS))[pos * 32 + i]; typedef _Float16 h2 __attribute__((ext_vector_type(2))); const h2 hv = __builtin_bit_cast(h2, tv);
              chk_upd(ctl, 1, (float)hv.x, c); chk_upd(ctl, 1, (float)hv.y, sn); }
        }
        { const bf16_t* Q = (const bf16_t*)(ws + R_Q); bf16_t* sv = (bf16_t*)(ws + WS_CHK) + s * 128; const int h = s & 7; sv[lane] = Q[(size_t)tok * 1024 + h * 128 + lane]; sv[lane + 64] = Q[(size_t)tok * 1024 + h * 128 + 64 + lane]; }
    }
    if (after == 2) {
        const int h = s & 7; const bf16_t* sv = (const bf16_t*)(ws + WS_CHK) + s * 128; const int S = tok_seqlen(tok); const size_t t0 = (size_t)tok - tok_pos(tok);
        const bf16_t* K = (const bf16_t*)(ws + R_K) + t0 * 1024 + h * 128; const bf16_t* V = (const bf16_t*)(ws + R_V) + t0 * 1024 + h * 128;
        const float lam_init = 0.8f - 0.6f * expf(-0.3f * (float)l); float s1 = 0.f, s2 = 0.f;
        for (int i = 0; i < 64; ++i) { s1 += (args.in[8] + l * 64)[i] * (args.in[9] + l * 64)[i]; s2 += (args.in[10] + l * 64)[i] * (args.in[11] + l * 64)[i]; }
        const float lam = expf(s1) - expf(s2) + lam_init;
        float o[2][2];
        for (int c = 0; c < 2; ++c) { float mx = -1e30f;
            for (int k = lane; k < S; k += 64) { float d = 0.f; for (int e = 0; e < 64; ++e) d += bf2f(sv[c * 64 + e]) * bf2f(K[(size_t)k * 1024 + c * 64 + e]); mx = fmaxf(mx, d); }
            for (int o_ = 1; o_ < 64; o_ <<= 1) mx = fmaxf(mx, __shfl_xor(mx, o_));
            float lsum = 0.f, a0 = 0.f, a1 = 0.f;
            for (int k = 0; k < S; ++k) { float d = 0.f; for (int e = 0; e < 64; ++e) d += bf2f(sv[c * 64 + e]) * bf2f(K[(size_t)k * 1024 + c * 64 + e]);
                const float p = exp2f(d - mx); lsum += p; a0 += p * bf2f(V[(size_t)k * 1024 + lane]); a1 += p * bf2f(V[(size_t)k * 1024 + 64 + lane]); }
            o[c][0] = a0 / lsum; o[c][1] = a1 / lsum; }
        const float v0 = o[0][0] - lam * o[1][0], v1 = o[0][1] - lam * o[1][1]; const float ss = wave_sum(v0 * v0 + v1 * v1); const float rn = 1.0f / sqrtf(ss / 128.f + EPS) * (1.f - lam_init);
        const float* gsub = args.in[12] + l * 128; const bf16_t* A = (const bf16_t*)(ws + R_Q) + (size_t)tok * 1024 + h * 128;
        chk_upd(ctl, 2, bf2f(A[lane]), v0 * rn * gsub[lane]); chk_upd(ctl, 2, bf2f(A[64 + lane]), v1 * rn * gsub[64 + lane]);
    }
    if (after == 4 && l == 0) {
        const bf16_t* A = (const bf16_t*)(ws + R_Q) + (size_t)tok * 1024; const bf16_t* Pp = (const bf16_t*)(ws + R_POUT) + (size_t)tok * 1024; const float* w_out = args.in[15];
        const int col = (s * 131 + lane * 17) & 2047; float z = xin[col];
        for (int k = 0; k < 1024; ++k) z += bf2f(A[k]) * w_out[(size_t)k * 2048 + col];
        for (int k = 0; k < 1024; ++k) z += bf2f(Pp[k]) * w_out[(size_t)(1024 + k) * 2048 + col];
        chk_upd(ctl, 3, X[(size_t)tok * 2048 + col], z);
    }
    if (after == 8 && tok < FFN_CHUNK) {
        const bf16_t* HB = (const bf16_t*)(ws + WS_HB); const float* w_up = args.in[24] + (size_t)l * 2048 * UP_W; const float* g_ffn = args.in[23] + l * 2048;
        const float* cw = args.in[25] + (size_t)l * 3 * UP_W; const float* cb = args.in[26] + (size_t)l * UP_W;
        const int j = (s * 977 + lane * 53) % D_FF; const int pos = tok_pos(tok), S = tok_seqlen(tok); float u2[2];
        for (int half = 0; half < 2; ++half) { const int col = half * D_FF + j; float acc = cb[col];
            for (int tap = 0; tap < 3; ++tap) { const int pp = pos + tap - 1; if (pp < 0 || pp >= S) continue; const bf16_t* hr = HB + (size_t)(tok + tap - 1) * 2048; float d = 0.f;
                for (int k = 0; k < 2048; ++k) d += bf2f(hr[k]) * g_ffn[k] * w_up[(size_t)k * UP_W + col];
                const float rxx = ss_rstd(((const rss_t*)(ws + WS_ROWSS))[(size_t)(l * 3 + 2) * NTOK + tok + tap - 1]); acc += d * rxx * cw[(size_t)tap * UP_W + col]; }
            u2[half] = acc; }
        const float x = u2[0]; const float ref = 0.5f * x * (1.f + tanhf(0.7978845608028654f * (x + 0.044715f * x * x * x))) * u2[1];
        chk_upd(ctl, 4, bf2f(((const bf16_t*)(ws + R_G))[(size_t)tok * D_FF + j]), ref);
    }
    if (false) {
        const bf16_t* Gr = (const bf16_t*)(ws + R_G) + (size_t)tok * D_FF; const float* w_down = args.in[27] + (size_t)l * D_FF * 2048; const float* svx = (const float*)(ws + WS_CHK + 65536) + (size_t)s * 2048;
        const int col = (s * 131 + lane * 17) & 2047; float z = svx[col]; for (int k = 0; k < D_FF; ++k) z += bf2f(Gr[k]) * w_down[(size_t)k * 2048 + col];
        chk_upd(ctl, 5, X[(size_t)tok * 2048 + col], z);
    }
}
__global__ void __launch_bounds__(256) report_kernel(Args args) {
    unsigned* ctl = (unsigned*)(args.ws + WS_CTL); float* out = args.out;
    for (size_t i = (size_t)blockIdx.x * 256 + threadIdx.x; i < (size_t)NTOK * 2048; i += (size_t)gridDim.x * 256) {
        float v = 0.f;
        if (i == 0) { int mask = 0; for (int b = 0; b < 6; ++b) if (__uint_as_float(ctl[CHK_WORD + b]) > 1.0f) mask |= 1 << b; v = (10.f + (float)mask) * 1000.f; }
        out[i] = v; }
}
#endif

extern "C" void kernel_launch(void* const* d_in, const int* in_sizes, int n_in, void* d_out, int out_size, void* d_ws, size_t ws_size, hipStream_t stream) {
    static int grid = 0;
    if (grid == 0) {
        if (n_in != 28 || out_size != NTOK * D_MODEL || ws_size < WS_END) { fprintf(stderr, "kernel_launch: unexpected shapes: n_in %d out %d ws %zu (need >= %zu)\n", n_in, out_size, ws_size, (size_t)WS_END); grid = -1; return; }
        int dev = 0, cus = 0, per_cu = 0;
        if (hipGetDevice(&dev) != hipSuccess || hipDeviceGetAttribute(&cus, hipDeviceAttributeMultiprocessorCount, dev) != hipSuccess) { grid = -1; return; }
        if (hipFuncSetAttribute((const void*)trunk_fwd, hipFuncAttributeMaxDynamicSharedMemorySize, LDS_BYTES) != hipSuccess) { fprintf(stderr, "kernel_launch: hipFuncSetAttribute failed\n"); grid = -1; return; }
        if (hipOccupancyMaxActiveBlocksPerMultiprocessor(&per_cu, (const void*)trunk_fwd, NWAVES * 64, LDS_BYTES) != hipSuccess || per_cu < 1)
            fprintf(stderr, "kernel_launch: occupancy query reports %d workgroups per CU\n", per_cu);
        (void)hipGetLastError();
        grid = cus;
    }
    if (grid < 0) return;
    (void)hipMemsetAsync((char*)d_ws + WS_CTL, 0, CTL_ZERO_BYTES, stream);
    Args a{};
    for (int i = 0; i < 28; ++i) a.in[i] = (const float*)d_in[i];
    a.out = (float*)d_out; a.ws = (unsigned char*)d_ws;
#if ML_PER_PHASE
    for (int p = 0; p < N_PHASES; ++p) { a.ph_lo = p; a.ph_hi = p + 1; hipLaunchKernelGGL(trunk_fwd, dim3(grid), dim3(NWAVES * 64), LDS_BYTES, stream, a);
#ifdef SELFCHECK
        { const int l = p / PH_PER_LAYER, q = p % PH_PER_LAYER; if (l == SELFCHECK_LAYER && (q == 1 || q == 2 || q == 8)) hipLaunchKernelGGL(check_kernel, dim3(64), dim3(64), 0, stream, a, q, l); }
#endif
    }
#ifdef SELFCHECK
    hipLaunchKernelGGL(report_kernel, dim3(2048), dim3(256), 0, stream, a);
#endif
#else
    a.ph_lo = 0; a.ph_hi = N_PHASES;
    hipLaunchKernelGGL(trunk_fwd, dim3(grid), dim3(NWAVES * 64), LDS_BYTES, stream, a);
#endif
    const hipError_t le = hipPeekAtLastError();
    if (le != hipSuccess) fprintf(stderr, "kernel_launch: launch failed: %s\n", hipGetErrorName(le));
}
```

```cpp
#include <hip/hip_runtime.h>
#include <cstdio>
#include <cstdint>

#define SELFCHECK_LAYER 0
#ifndef ML_PER_PHASE
#define ML_PER_PHASE 0
#endif

#ifndef PHASE_MASK
#define PHASE_MASK 0xFFFFFFFFu
#endif
#define PH_EN(p) (((PHASE_MASK) >> (p)) & 1u)
#ifndef ATTN_NS
#define ATTN_NS att16
#endif
#define LAS __attribute__((address_space(3)))
#define GAS __attribute__((address_space(1)))
typedef unsigned short bf16_t;
typedef short bf16x8 __attribute__((ext_vector_type(8)));
typedef short s16x4 __attribute__((ext_vector_type(4)));
typedef float f32x4 __attribute__((ext_vector_type(4)));
typedef float f32x2 __attribute__((ext_vector_type(2)));
typedef float f32x16 __attribute__((ext_vector_type(16)));
typedef unsigned u32x4 __attribute__((ext_vector_type(4)));
typedef unsigned u32x2 __attribute__((ext_vector_type(2)));
typedef _Float16 h2_t __attribute__((ext_vector_type(2)));
typedef _Float16 f16x8 __attribute__((ext_vector_type(8)));

constexpr int D_MODEL = 2048, DEPTH = 2;
constexpr int NTOK = 65536;
constexpr int NTOK_P = 32768;
constexpr int S_P = 8192, S_S = 4096;
constexpr int NMEMROWS = 3072;
constexpr int IN_W = 4096, D_FF = 5632, UP_W = 11264;
constexpr float EPS = 1e-6f;
constexpr float QSCALE = 0.125f * 1.4426950408889634f;
constexpr int FFN_CHUNK = 32768, N_FFN_CHUNKS = 2;
constexpr int FFN_MT = FFN_CHUNK / 256, FFN_BT = 0;
constexpr int PH_PER_LAYER = 8 + 2 * N_FFN_CHUNKS;
constexpr int N_PHASES = DEPTH * PH_PER_LAYER;

constexpr size_t MiB = 1u << 20;
constexpr size_t WS_CTL = 0, CTL_ZERO_BYTES = 5 * MiB;
constexpr size_t WS_ROWSS = 1 * MiB;
constexpr size_t WS_COS = 5 * MiB;
constexpr size_t WS_QSS = 6 * MiB;
constexpr size_t WS_LPART = 14 * MiB;
constexpr size_t WS_MB = 18 * MiB;
constexpr size_t WS_KRAW = 30 * MiB;
constexpr size_t WS_KC = 54 * MiB;
constexpr size_t WS_VT = 66 * MiB;
constexpr size_t WS_CHK = 78 * MiB;
constexpr size_t WS_WIN = 79 * MiB, WS_WP = 95 * MiB, WS_WOUT = 96 * MiB, WS_WCQ = 104 * MiB, WS_WCKV = 112 * MiB, WS_WCO = 128 * MiB, WS_WUP = 136 * MiB, WS_WDOWN = 180 * MiB;
constexpr size_t WS_HB = 203 * MiB;
constexpr size_t WS_R = 459 * MiB;
constexpr size_t WS_CWT = 987 * MiB;
constexpr size_t WS_END = 988 * MiB;
typedef unsigned long long rss_t;
__device__ __forceinline__ rss_t ss_fix(float s) { return (rss_t)(s * 1048576.0f + 0.5f); }
__device__ __forceinline__ float ss_rstd(rss_t v) { return __builtin_amdgcn_rsqf((float)v * (1.0f / (1048576.0f * 2048.0f)) + 1e-6f); }
constexpr size_t R_Q = WS_R, R_K = WS_R + 128 * MiB, R_V = WS_R + 256 * MiB, R_U = WS_R + 384 * MiB;
constexpr size_t R_QC = WS_R, R_P = WS_R + 256 * MiB, R_VW = WS_R + 384 * MiB;
constexpr size_t R_G = WS_R;
constexpr int FFN_GSPLIT_ROW = 49152;
constexpr size_t FFN_EB_OUT_OFF = 192 * MiB;
constexpr size_t R_EB = WS_R + 384 * MiB;
constexpr size_t R_POUT = WS_R + 128 * MiB;
static_assert(R_G + (size_t)FFN_CHUNK * D_FF * 2 <= WS_END, "ws map");
constexpr int CW_BAR = 4096;

constexpr int RING_BYTES = 131072;
constexpr int LDSCTL_OFF = RING_BYTES, MISC_OFF = LDSCTL_OFF + 320, XCH_OFF = LDSCTL_OFF + 1024, GLX_OFF = XCH_OFF + 4096;
constexpr int LDS_BYTES = 151552;
constexpr int NWAVES = 8;

__device__ __forceinline__ unsigned cvt_pk_bf16(float lo, float hi) { unsigned r; asm volatile("v_cvt_pk_bf16_f32 %0, %1, %2" : "=v"(r) : "v"(lo), "v"(hi)); return r; }
__device__ __forceinline__ float bf2f(unsigned short b) { return __uint_as_float(((unsigned)b) << 16); }
__device__ __forceinline__ float bflo(unsigned w) { return __uint_as_float(w << 16); }
__device__ __forceinline__ float bfhi(unsigned w) { return __uint_as_float(w & 0xffff0000u); }
__device__ __forceinline__ int tok_pos(int row) { return row < NTOK_P ? (row & (S_P - 1)) : (row & (S_S - 1)); }
__device__ __forceinline__ int tok_seqlen(int row) { return row < NTOK_P ? S_P : S_S; }
__device__ __forceinline__ int tile_batch(int pm) { return pm < 128 ? (pm >> 5) : 4 + ((pm - 128) >> 4); }

namespace pg8 {
constexpr int BM = 256, BK = 64, HALF = 128, HTB = HALF * BK * 2, STAGE_BYTES = 8 * HTB, NXCD = 8, WGM = 4;
__host__ __device__ __forceinline__ int lds_byte(int r, int c) { const int st = (r >> 4) * 2 + (c >> 5), rr = r & 15, cc = c & 31, ob = rr * 64 + cc * 2; return st * 1024 + (ob ^ (((ob >> 9) & 1) << 5)); }
__host__ __device__ __forceinline__ void stage_rc(int b, int& R, int& C) { const int st = b / 1024, sb = b % 1024, swz = sb ^ (((sb >> 9) & 1) << 5); R = (st >> 1) * 16 + swz / 64; C = (st & 1) * 32 + (swz % 64) / 2; }
__host__ __device__ __forceinline__ int perm32(int rho) { const int n = rho >> 4, i = rho & 15; return 8 * (i >> 2) + 4 * n + (i & 3); }
struct Unit { int pm, pn; };
struct StaticOrder {
    int nM, nN, nwg, G, c, rv;
    __host__ __device__ void init(int nM_, int nN_, int G_, int c_, int rv_ = 0) { nM = nM_; nN = nN_; nwg = nM * nN; G = G_; c = c_; rv = rv_; }
    __host__ __device__ bool next(int i, Unit& u) const {
        const long L = (long)i * G + c; if (L >= nwg) return false;
        int wgid = (int)L; { const int q = nwg / NXCD, r = nwg % NXCD, xcd = wgid % NXCD; int off = wgid / NXCD; if (rv && r == 0) off = q - 1 - off; wgid = (xcd < r ? xcd * (q + 1) : r * (q + 1) + (xcd - r) * q) + off; }
        const int nig = WGM * nN, gid = wgid / nig, fm = gid * WGM, gsz = (nM - fm) < WGM ? (nM - fm) : WGM;
        u.pm = fm + ((wgid % nig) % gsz); u.pn = (wgid % nig) / gsz; return true;
    }
};
struct ProbBase { static constexpr bool GATHER = false; static constexpr bool F16 = false; int K, lda, ldb, tsplit; long long adelta; __device__ __forceinline__ unsigned rowoff(const Unit&, int) const { return 0u; } };

template <class Prob, class Epi, bool ALIGN_EPI, bool SP2>
__device__ __forceinline__ void gemm_phase(LAS unsigned char* lds, const Prob& P, const StaticOrder& S, const Epi& E) {
    static_assert(SP2, "only the two-super-phase loop is kept in this file");
    int tid_l = threadIdx.x; asm volatile("" : "+v"(tid_l));
    const int tid = tid_l, wid = __builtin_amdgcn_readfirstlane(tid >> 6), lane = tid & 63, wr = wid >> 2, wc = wid & 3, fr = lane & 15, fq = lane >> 4;
    const int K = P.K, nt = K / BK, lda = P.lda, ldb = P.ldb, tsplit = P.tsplit; const long long adelta = P.adelta;
    unsigned voffA[2], voffB[2];
#pragma unroll
    for (int i = 0; i < 2; ++i) { int R, C; stage_rc(tid * 16 + i * 8192, R, C); const int Rb = Epi::PERM ? ((R & ~31) + perm32(R & 31)) : R;
        voffA[i] = (unsigned)(R * lda + C) * 2u; voffB[i] = (unsigned)(Rb * ldb + C) * 2u; }
    const size_t kstep = (size_t)(BK * 2);
    const size_t hstepA = (size_t)HALF * lda * 2, hstepB = (size_t)HALF * ldb * 2;
    const unsigned ldsw = (unsigned)wid * 1024u;
    const int aoff = lds_byte(wr * 64 + fr, fq * 8), boff = lds_byte(wc * 32 + fr, fq * 8);
    unsigned vAc[2][2], vAn[2][2];
#define PG8_SA(b, h) (((b) * 2 + (h)) * HTB)
#define PG8_SB(b, h) ((4 + (b) * 2 + (h)) * HTB)
#define PG8_STAGE(bufoff, gbase, voff) do { _Pragma("unroll") for (int _i = 0; _i < 2; ++_i) \
        __builtin_amdgcn_global_load_lds((const unsigned*)((const char*)(gbase) + (voff)[_i]), (LAS unsigned*)(lds + (bufoff) + ldsw + _i * 8192), 16, 0, 0); } while (0)
#define PG8_STAGE_A(bufoff, kptr, h, NXT) do { if constexpr (Prob::GATHER) { _Pragma("unroll") for (int _i = 0; _i < 2; ++_i) \
        __builtin_amdgcn_global_load_lds((const unsigned*)((const char*)(kptr) + ((NXT) ? vAn[h][_i] : vAc[h][_i])), (LAS unsigned*)(lds + (bufoff) + ldsw + _i * 8192), 16, 0, 0); } \
        else { PG8_STAGE(bufoff, (kptr) + (h) * hstepA, voffA); } } while (0)
#define PG8_GATHER_OFFS(dst, unit) do { _Pragma("unroll") for (int _i = 0; _i < 2; ++_i) { int _R, _C; stage_rc(tid * 16 + _i * 8192, _R, _C); _Pragma("unroll") for (int _h = 0; _h < 2; ++_h) dst[_h][_i] = P.rowoff(unit, _R + 128 * _h) + (unsigned)_C * 2u; } } while (0)
#define PG8_LDA(dst, b, h) do { _Pragma("unroll") for (int m = 0; m < 4; ++m) _Pragma("unroll") for (int k = 0; k < 2; ++k) dst[m][k] = *(const LAS bf16x8*)(lds + PG8_SA(b, h) + aoff + m * 2048 + k * 1024); } while (0)
#define PG8_LDB(dst, b, h) do { _Pragma("unroll") for (int n = 0; n < 2; ++n) _Pragma("unroll") for (int k = 0; k < 2; ++k) dst[n][k] = *(const LAS bf16x8*)(lds + PG8_SB(b, h) + boff + n * 2048 + k * 1024); } while (0)
#define PG8_MMA(ai, bj, At, Bt) do { __builtin_amdgcn_s_setprio(1); _Pragma("unroll") for (int m = 0; m < 4; ++m) _Pragma("unroll") for (int n = 0; n < 2; ++n) _Pragma("unroll") for (int k = 0; k < 2; ++k) \
        { if constexpr (Prob::F16) acc[ai][bj][m][n] = __builtin_amdgcn_mfma_f32_16x16x32_f16(__builtin_bit_cast(f16x8, Bt[n][k]), __builtin_bit_cast(f16x8, At[m][k]), acc[ai][bj][m][n], 0, 0, 0); \
          else acc[ai][bj][m][n] = __builtin_amdgcn_mfma_f32_16x16x32_bf16(Bt[n][k], At[m][k], acc[ai][bj][m][n], 0, 0, 0); } __builtin_amdgcn_s_setprio(0); } while (0)
#define PG8_WAIT_V(n) asm volatile("s_waitcnt vmcnt(" #n ")" ::: "memory")
#define PG8_WAIT_L(n) asm volatile("s_waitcnt lgkmcnt(" #n ")" ::: "memory")
#define PG8_BAR __builtin_amdgcn_s_barrier()
#define PG8_SCHED __builtin_amdgcn_sched_barrier(0)
#define PG8_AK(base, t) ((base) + (size_t)(t) * kstep + (((t) >= tsplit) ? adelta : 0ll))
    Unit cur, nxt; int ui = 0;
    if (!S.next(0, cur)) return;
    f32x4 acc[2][2][4][2];
#pragma unroll
    for (int a = 0; a < 2; ++a)
#pragma unroll
        for (int b = 0; b < 2; ++b)
#pragma unroll
            for (int m = 0; m < 4; ++m)
#pragma unroll
                for (int n = 0; n < 2; ++n) acc[a][b][m][n] = (f32x4){0.f, 0.f, 0.f, 0.f};
    bf16x8 At[4][2], B0[2][2], B1[2][2];
    const char* cA = P.aptr(cur); const char* cB = P.bptr(cur);
    if constexpr (Prob::GATHER) { PG8_GATHER_OFFS(vAc, cur); }
    PG8_STAGE(PG8_SB(0, 0), cB, voffB); PG8_STAGE(PG8_SB(0, 1), cB + hstepB, voffB); PG8_STAGE_A(PG8_SA(0, 0), cA, 0, false); PG8_STAGE_A(PG8_SA(0, 1), cA, 1, false);
    if (wr == 1) PG8_BAR;
    PG8_WAIT_V(2); PG8_BAR;
    PG8_STAGE(PG8_SB(1, 0), cB + kstep, voffB); PG8_STAGE_A(PG8_SA(1, 0), PG8_AK(cA, 1), 0, false); PG8_STAGE(PG8_SB(1, 1), cB + hstepB + kstep, voffB);
    PG8_WAIT_V(6); PG8_BAR;
    for (;;) {
        const bool has_next = S.next(ui + 1, nxt);
        const char* nA = has_next ? P.aptr(nxt) : cA; const char* nB = has_next ? P.bptr(nxt) : cB;
        if constexpr (Prob::GATHER) { if (has_next) { PG8_GATHER_OFFS(vAn, nxt); } else {
#pragma unroll
            for (int _h = 0; _h < 2; ++_h)
#pragma unroll
                for (int _i = 0; _i < 2; ++_i) vAn[_h][_i] = vAc[_h][_i]; } }
        for (int t = 0; t < nt; t += 2) {
            const bool last = (t == nt - 2);
            const char* a1 = PG8_AK(cA, t + 1);
            const char* a2 = last ? nA : PG8_AK(cA, t + 2); const char* b2 = last ? nB : cB + (size_t)(t + 2) * kstep;
            const char* a3 = last ? PG8_AK(nA, 1) : PG8_AK(cA, t + 3); const char* b3 = b2 + kstep;
            PG8_LDB(B0, 0, 0); PG8_LDB(B1, 0, 1); PG8_SCHED; PG8_LDA(At, 0, 0); PG8_STAGE_A(PG8_SA(1, 1), a1, 1, false);
            PG8_WAIT_V(8); PG8_WAIT_L(0); PG8_BAR; PG8_MMA(0, 0, At, B0); PG8_MMA(0, 1, At, B1); PG8_BAR; PG8_SCHED;
            PG8_LDA(At, 0, 1); PG8_STAGE(PG8_SB(0, 0), b2, voffB); PG8_STAGE(PG8_SB(0, 1), b2 + hstepB, voffB); PG8_STAGE_A(PG8_SA(0, 0), a2, 0, last);
            PG8_WAIT_V(8); PG8_WAIT_L(0); PG8_BAR; PG8_MMA(1, 0, At, B0); PG8_MMA(1, 1, At, B1); PG8_BAR; PG8_SCHED;
            PG8_LDB(B0, 1, 0); PG8_LDB(B1, 1, 1); PG8_SCHED; PG8_LDA(At, 1, 0); PG8_STAGE_A(PG8_SA(0, 1), a2, 1, last);
            PG8_WAIT_V(8); PG8_WAIT_L(0); PG8_BAR; PG8_MMA(0, 0, At, B0); PG8_MMA(0, 1, At, B1); PG8_BAR; PG8_SCHED;
            PG8_LDA(At, 1, 1); PG8_STAGE(PG8_SB(1, 0), b3, voffB); PG8_STAGE(PG8_SB(1, 1), b3 + hstepB, voffB); PG8_STAGE_A(PG8_SA(1, 0), a3, 0, last);
            PG8_WAIT_V(8); PG8_WAIT_L(0); PG8_BAR; PG8_MMA(1, 0, At, B0); PG8_MMA(1, 1, At, B1); PG8_BAR; PG8_SCHED;
        }
        if constexpr (ALIGN_EPI) { if (wr == 0) PG8_BAR; }
        { int te = threadIdx.x; asm volatile("" : "+v"(te));
          const int we = __builtin_amdgcn_readfirstlane(te >> 6), le = te & 63; E(acc, cur, we >> 2, we & 3, le & 15, le >> 4); }
        if (!has_next) break;
        asm volatile("" : "+v"(voffA[0]), "+v"(voffA[1]), "+v"(voffB[0]), "+v"(voffB[1]));
#pragma unroll
        for (int a = 0; a < 2; ++a)
#pragma unroll
            for (int b = 0; b < 2; ++b)
#pragma unroll
                for (int m = 0; m < 4; ++m)
#pragma unroll
                    for (int n = 0; n < 2; ++n) acc[a][b][m][n] = (f32x4){0.f, 0.f, 0.f, 0.f};
        cur = nxt; cA = nA; cB = nB; ++ui;
        if constexpr (Prob::GATHER) {
#pragma unroll
            for (int _h = 0; _h < 2; ++_h)
#pragma unroll
                for (int _i = 0; _i < 2; ++_i) vAc[_h][_i] = vAn[_h][_i]; }
        if constexpr (ALIGN_EPI) { if (wr == 1) PG8_BAR; }
    }
    PG8_WAIT_V(0);
    if constexpr (!ALIGN_EPI) { if (wr == 0) PG8_BAR; }
    PG8_BAR;
#undef PG8_SA
#undef PG8_SB
#undef PG8_STAGE
#undef PG8_STAGE_A
#undef PG8_GATHER_OFFS
#undef PG8_LDA
#undef PG8_LDB
#undef PG8_MMA
#undef PG8_WAIT_V
#undef PG8_WAIT_L
#undef PG8_BAR
#undef PG8_SCHED
#undef PG8_AK
}

struct ProbSimple : ProbBase {
    const char* A; const char* B;
    __device__ __forceinline__ const char* aptr(const Unit& u) const { return A + (size_t)u.pm * 256 * lda * 2; }
    __device__ __forceinline__ const char* bptr(const Unit& u) const { return B + (size_t)u.pn * 256 * ldb * 2; }
};
struct ProbSimpleF16 : ProbSimple { static constexpr bool F16 = true; };
struct ProbDown : ProbBase {
    static constexpr bool F16 = true;
    const char* A; const char* A2; const char* B; int split;
    __device__ __forceinline__ const char* aptr(const Unit& u) const { return (u.pm < split ? A : A2) + (size_t)u.pm * 256 * lda * 2; }
    __device__ __forceinline__ const char* bptr(const Unit& u) const { return B + (size_t)u.pn * 256 * ldb * 2; }
};
struct ProbPool : ProbBase {
    const char* A; const char* B;
    __device__ __forceinline__ const char* aptr(const Unit& u) const { return A + ((size_t)u.pm * 256 * 1024 + (size_t)u.pn * 256) * 2; }
    __device__ __forceinline__ const char* bptr(const Unit& u) const { return B + (size_t)u.pn * 65536 * 2; }
};
struct ProbScores : ProbBase {
    const char* A; const char* B;
    __device__ __forceinline__ const char* aptr(const Unit& u) const { return A + ((size_t)u.pm * 256 * 2048 + (size_t)u.pn * 512) * 2; }
    __device__ __forceinline__ const char* bptr(const Unit& u) const { return B + ((size_t)tile_batch(u.pm) * 256 * 2048 + (size_t)u.pn * 512) * 2; }
};
struct ProbVW : ProbBase {
    const char* A; const char* B;
    __device__ __forceinline__ const char* aptr(const Unit& u) const { return A + ((size_t)u.pm * 256 * 2048 + (size_t)(u.pn & 3) * 512) * 2; }
    __device__ __forceinline__ const char* bptr(const Unit& u) const { return B + ((size_t)(u.pn >> 2) * 256 * 2048 + (size_t)(u.pn & 3) * 512) * 2; }
};
struct ProbFin : ProbBase {
    const char* A; const char* B;
    __device__ __forceinline__ const char* aptr(const Unit& u) const { return A + (size_t)u.pm * 256 * 1024 * 2; }
    __device__ __forceinline__ const char* bptr(const Unit& u) const { return B + ((size_t)tile_batch(u.pm) * 2048 + (size_t)u.pn * 256) * 1024 * 2; }
};
struct ProbPV : ProbBase {
    const char* A; const char* B;
    __device__ __forceinline__ const char* aptr(const Unit& u) const { return A + ((size_t)u.pm * 256 * 1024 + (size_t)(u.pn >> 1) * 256) * 2; }
    __device__ __forceinline__ const char* bptr(const Unit& u) const { return B + ((size_t)tile_batch(u.pm) * 2048 + (size_t)u.pn * 256) * 256 * 2; }
};

__device__ __forceinline__ u32x4 pack8(const f32x4& v0, const f32x4& v1) { u32x4 w; w.x = cvt_pk_bf16(v0[0], v0[1]); w.y = cvt_pk_bf16(v0[2], v0[3]); w.z = cvt_pk_bf16(v1[0], v1[1]); w.w = cvt_pk_bf16(v1[2], v1[3]); return w; }
__device__ __forceinline__ float sumsq4(const f32x4& x) { return (x[0] * x[0] + x[1] * x[1]) + (x[2] * x[2] + x[3] * x[3]); }
__device__ __forceinline__ float sum4(const f32x4& x) { return (x[0] + x[1]) + (x[2] + x[3]); }
__device__ __forceinline__ float red_fq(float s) { s += __shfl_xor(s, 16); s += __shfl_xor(s, 32); return s; }

struct EpiIn {
    static constexpr bool PERM = true;
    bf16_t* base; size_t spl; const unsigned* csT; const float* gq; const float* gk; const rss_t* rowss;
    __device__ __forceinline__ void operator()(const f32x4 (&acc)[2][2][4][2], const Unit& u, int wr, int wc, int fr, int fq) const {
        typedef _Float16 h2 __attribute__((ext_vector_type(2)));
        const int t = u.pn >> 2; bf16_t* O = base + (size_t)t * spl; const int colt = (u.pn & 3) * 256; const int row0 = u.pm * BM + wr * 64 + fr;
        if (t >= 2) {
            const int col0 = colt + wc * 32 + 8 * fq;
#pragma unroll
            for (int ai = 0; ai < 2; ++ai) { rss_t rx[4];
#pragma unroll
                for (int m = 0; m < 4; ++m) rx[m] = rowss[row0 + ai * HALF + m * 16];
#pragma unroll
                for (int m = 0; m < 4; ++m) { const float rxm = ss_rstd(rx[m]); bf16_t* rowp = O + (size_t)(row0 + ai * HALF + m * 16) * 1024 + col0;
#pragma unroll
                    for (int bj = 0; bj < 2; ++bj) *(u32x4*)(rowp + bj * HALF) = pack8(acc[ai][bj][m][0] * rxm, acc[ai][bj][m][1] * rxm); }
                asm volatile("" ::: "memory"); }
        } else {
            const float* g = t ? gk : gq; f32x4 g1[2], g2[2];
#pragma unroll
            for (int n = 0; n < 2; ++n) { g1[n] = *(const f32x4*)(g + 8 * fq + 4 * n); g2[n] = *(const f32x4*)(g + 32 + 8 * fq + 4 * n); }
            const int col0 = colt + 64 * wc + 8 * fq;
            u32x4 cs[2][2][2]; rss_t rx[2][2];
#define EPIIN_LOAD(AH) do { const int ai_ = (AH) >> 1, mb_ = ((AH) & 1) * 2; _Pragma("unroll") for (int mm = 0; mm < 2; ++mm) { const int m = mb_ + mm; const int pos = tok_pos(row0 + ai_ * HALF + m * 16); rx[(AH) & 1][mm] = rowss[row0 + ai_ * HALF + m * 16]; \
                _Pragma("unroll") for (int n = 0; n < 2; ++n) cs[(AH) & 1][mm][n] = *(const u32x4*)(csT + pos * 32 + 8 * fq + 4 * n); } } while (0)
            EPIIN_LOAD(0);
#pragma unroll
            for (int ah = 0; ah < 4; ++ah) { const int ai = ah >> 1, mb = (ah & 1) * 2;
                if (ah < 3) { EPIIN_LOAD(ah + 1); } asm volatile("" ::: "memory");
#pragma unroll
                for (int mm = 0; mm < 2; ++mm) { const int m = mb + mm; const int row = row0 + ai * HALF + m * 16;
                    float ss = (sumsq4(acc[ai][0][m][0]) + sumsq4(acc[ai][0][m][1])) + (sumsq4(acc[ai][1][m][0]) + sumsq4(acc[ai][1][m][1]));
                    ss = red_fq(ss);
                    const float rxm = ss_rstd(rx[ah & 1][mm]);
                    const float r = __builtin_amdgcn_rsqf(ss * rxm * rxm * (1.0f / 64.0f) + EPS) * rxm * (t ? 1.0f : QSCALE);
                    f32x4 o1[2], o2[2];
#pragma unroll
                    for (int n = 0; n < 2; ++n) { f32x4 c, s;
#pragma unroll
                        for (int j = 0; j < 4; ++j) { const unsigned w = cs[ah & 1][mm][n][j]; const h2 v = __builtin_bit_cast(h2, w); c[j] = (float)v.x; s[j] = (float)v.y; }
                        const f32x4 x1 = acc[ai][0][m][n] * r * g1[n], x2 = acc[ai][1][m][n] * r * g2[n];
                        o1[n] = x1 * c - x2 * s; o2[n] = x2 * c + x1 * s; }
                    bf16_t* rowp = O + (size_t)row * 1024 + col0;
                    *(u32x4*)(rowp) = pack8(o1[0], o1[1]); *(u32x4*)(rowp + 32) = pack8(o2[0], o2[1]); }
                asm volatile("" ::: "memory"); }
#undef EPIIN_LOAD
        }
    }
};
template <int MODE> struct EpiBf {
    static constexpr bool PERM = true;
    bf16_t* O; int ldc; float* aux; float* aux2; LAS float* xl;
    __device__ __forceinline__ void operator()(f32x4 (&acc)[2][2][4][2], const Unit& u, int wr, int wc, int fr, int fq) const {
        const int row0 = u.pm * BM + wr * 64 + fr; const int col0 = u.pn * BM + wc * 32 + 8 * fq;
        float rs[2][4];
        if constexpr (MODE == 2) {
            f32x4 qa[2][4][2];
#pragma unroll
            for (int ai = 0; ai < 2; ++ai)
#pragma unroll
                for (int m = 0; m < 4; ++m) { const float* p = aux + (size_t)(row0 + ai * HALF + m * 16) * 32 + u.pn * 8; qa[ai][m][0] = *(const f32x4*)p; qa[ai][m][1] = *(const f32x4*)(p + 4); }
#pragma unroll
            for (int ai = 0; ai < 2; ++ai)
#pragma unroll
                for (int m = 0; m < 4; ++m) { const float sc = __builtin_amdgcn_rsqf((sum4(qa[ai][m][0]) + sum4(qa[ai][m][1])) * (1.0f / 512.0f) + EPS) * (0.044194173824159216f * 1.4426950408889634f); float ps = 0.f;
#pragma unroll
                    for (int bj = 0; bj < 2; ++bj)
#pragma unroll
                        for (int n = 0; n < 2; ++n) { f32x4 p;
#pragma unroll
                            for (int j = 0; j < 4; ++j) p[j] = __builtin_amdgcn_exp2f(acc[ai][bj][m][n][j] * sc);
                            acc[ai][bj][m][n] = p; ps += sum4(p); }
                    ps = red_fq(ps);
                    if (fq == 0) xl[(ai * HALF + wr * 64 + m * 16 + fr) * 4 + wc] = ps; }
            asm volatile("s_waitcnt lgkmcnt(0)" ::: "memory"); __builtin_amdgcn_s_barrier(); asm volatile("" ::: "memory");
#pragma unroll
            for (int ai = 0; ai < 2; ++ai)
#pragma unroll
                for (int m = 0; m < 4; ++m) { const f32x4 lv = *(const LAS f32x4*)(xl + (ai * HALF + wr * 64 + m * 16 + fr) * 4); rs[ai][m] = __builtin_amdgcn_rcpf(sum4(lv)); }
        }
        if constexpr (MODE == 1 || MODE == 4) { rss_t rv[2][4];
#pragma unroll
            for (int ai = 0; ai < 2; ++ai)
#pragma unroll
                for (int m = 0; m < 4; ++m) rv[ai][m] = ((const rss_t*)aux2)[row0 + ai * HALF + m * 16];
#pragma unroll
            for (int ai = 0; ai < 2; ++ai)
#pragma unroll
                for (int m = 0; m < 4; ++m) rs[ai][m] = ss_rstd(rv[ai][m]);
        }
        if constexpr (MODE == 3) {
            f32x4 la[2][4];
#pragma unroll
            for (int ai = 0; ai < 2; ++ai)
#pragma unroll
                for (int m = 0; m < 4; ++m) la[ai][m] = *(const f32x4*)(aux2 + (size_t)(row0 + ai * HALF + m * 16) * 16 + (u.pn >> 1) * 4);
#pragma unroll
            for (int ai = 0; ai < 2; ++ai)
#pragma unroll
                for (int m = 0; m < 4; ++m) rs[ai][m] = __builtin_amdgcn_rcpf(sum4(la[ai][m]));
        }
        bf16_t* Ob = O; int colb = col0;
        if constexpr (MODE == 5) { Ob = O + (size_t)(u.pn >> 2) * 2048 * 1024; colb = (u.pn & 3) * 256 + wc * 32 + 8 * fq; }
#pragma unroll
        for (int ai = 0; ai < 2; ++ai)
#pragma unroll
            for (int m = 0; m < 4; ++m) { const int row = row0 + ai * HALF + m * 16; bf16_t* rowp = Ob + (size_t)row * ldc + colb;
                if constexpr (MODE == 0 || MODE == 5) {
#pragma unroll
                    for (int bj = 0; bj < 2; ++bj) *(u32x4*)(rowp + bj * HALF) = pack8(acc[ai][bj][m][0], acc[ai][bj][m][1]);
                } else if constexpr (MODE == 1) {
                    float ss = (sumsq4(acc[ai][0][m][0]) + sumsq4(acc[ai][0][m][1])) + (sumsq4(acc[ai][1][m][0]) + sumsq4(acc[ai][1][m][1]));
                    ss = red_fq(ss); const float rxx = rs[ai][m];
                    if (fq == 0) aux[(size_t)row * 32 + u.pn * 4 + wc] = ss * rxx * rxx;
#pragma unroll
                    for (int bj = 0; bj < 2; ++bj) *(u32x4*)(rowp + bj * HALF) = pack8(acc[ai][bj][m][0] * rxx, acc[ai][bj][m][1] * rxx);
                } else {
                    const float rxx = rs[ai][m];
#pragma unroll
                    for (int bj = 0; bj < 2; ++bj) *(u32x4*)(rowp + bj * HALF) = pack8(acc[ai][bj][m][0] * rxx, acc[ai][bj][m][1] * rxx);
                }
            }
    }
};
struct EpiRes {
    static constexpr bool PERM = true;
    bf16_t* XB; rss_t* rowss; float* OUT;
    __device__ __forceinline__ void load_half(u32x4 (&t)[4][2], int row0, int col0, int ai) const {
#pragma unroll
        for (int m = 0; m < 4; ++m) { const bf16_t* rowb = XB + (size_t)(row0 + ai * HALF + m * 16) * D_MODEL + col0;
#pragma unroll
            for (int bj = 0; bj < 2; ++bj) t[m][bj] = *(const u32x4*)(rowb + bj * HALF); }
    }
    __device__ __forceinline__ void add_half(f32x4 (&acc)[2][2][4][2], const u32x4 (&t)[4][2], int ai) const {
#pragma unroll
        for (int m = 0; m < 4; ++m)
#pragma unroll
            for (int bj = 0; bj < 2; ++bj) { const u32x4 w = t[m][bj];
#define ADDS_(d, x) asm("v_add_f32 %0, %1, %0" : "+v"(d) : "v"(x))
                ADDS_(acc[ai][bj][m][0][0], bflo(w.x)); ADDS_(acc[ai][bj][m][0][1], bfhi(w.x)); ADDS_(acc[ai][bj][m][0][2], bflo(w.y)); ADDS_(acc[ai][bj][m][0][3], bfhi(w.y));
                ADDS_(acc[ai][bj][m][1][0], bflo(w.z)); ADDS_(acc[ai][bj][m][1][1], bfhi(w.z)); ADDS_(acc[ai][bj][m][1][2], bflo(w.w)); ADDS_(acc[ai][bj][m][1][3], bfhi(w.w));
#undef ADDS_
            }
    }
    __device__ __forceinline__ void store_half(const f32x4 (&acc)[2][2][4][2], int row0, int col0, int ai, int fq) const {
#pragma unroll
        for (int m = 0; m < 4; ++m) { const int row = row0 + ai * HALF + m * 16; bf16_t* rowb = XB + (size_t)row * D_MODEL + col0; float ss = 0.f;
#pragma unroll
            for (int bj = 0; bj < 2; ++bj) { const f32x4 v0 = acc[ai][bj][m][0], v1 = acc[ai][bj][m][1];
                if (OUT) { float* rowp = OUT + (size_t)row * D_MODEL + col0 + bj * HALF; *(f32x4*)rowp = v0; *(f32x4*)(rowp + 4) = v1; }
                else { *(u32x4*)(rowb + bj * HALF) = pack8(v0, v1); ss += sumsq4(v0) + sumsq4(v1); } }
            if (rowss) { ss = red_fq(ss); if (fq == 0) atomicAdd(rowss + row, ss_fix(ss)); } }
    }
    __device__ __forceinline__ void operator()(f32x4 (&acc)[2][2][4][2], const Unit& u, int wr, int wc, int fr, int fq) const {
        const int row0 = u.pm * BM + wr * 64 + fr, col0 = u.pn * BM + wc * 32 + 8 * fq;
        u32x4 t[4][2];
        load_half(t, row0, col0, 0);
        add_half(acc, t, 0);
        asm volatile("" : "+v"(acc[0][0][0][0]), "+v"(acc[0][1][3][1]));
        load_half(t, row0, col0, 1);
        asm volatile("" ::: "memory");
        store_half(acc, row0, col0, 0, fq);
        add_half(acc, t, 1);
        store_half(acc, row0, col0, 1, fq);
    }
};
__device__ __forceinline__ int ffn_tile_row(int pm, int R, int chunk, bool& valid) {
    R = (R & ~63) | ((R & 15) << 2) | ((R >> 4) & 3);
    valid = true; (void)chunk; return pm * 256 + R;
}
struct ProbUp : ProbBase {
    static constexpr bool GATHER = true;
    const char* A; const char* B; int chunk;
    __device__ __forceinline__ const char* aptr(const Unit&) const { return A; }
    __device__ __forceinline__ const char* bptr(const Unit& u) const { return B + (size_t)u.pn * 256 * ldb * 2; }
    __device__ __forceinline__ unsigned rowoff(const Unit& u, int R) const { bool v; return (unsigned)ffn_tile_row(u.pm, R, chunk, v) * (unsigned)(lda * 2); }
};
__device__ __forceinline__ float dpp_ror1(float v) { return __builtin_bit_cast(float, __builtin_amdgcn_update_dpp(0, __builtin_bit_cast(int, v), 0x121, 0xf, 0xf, false)); }
__device__ __forceinline__ float dpp_ror15(float v) { return __builtin_bit_cast(float, __builtin_amdgcn_update_dpp(0, __builtin_bit_cast(int, v), 0x12F, 0xf, 0xf, false)); }
__device__ __forceinline__ h2_t u2h(unsigned u) { return __builtin_bit_cast(h2_t, u); }
__device__ __forceinline__ unsigned h2u(h2_t h) { return __builtin_bit_cast(unsigned, h); }
__device__ __forceinline__ unsigned dppu_ror1(unsigned v) { return (unsigned)__builtin_amdgcn_update_dpp(0, (int)v, 0x121, 0xf, 0xf, false); }
__device__ __forceinline__ unsigned dppu_ror15(unsigned v) { return (unsigned)__builtin_amdgcn_update_dpp(0, (int)v, 0x12F, 0xf, 0xf, false); }
#define H2X4_TRANS(OP, a, b, c, d) asm(OP " %0, %0 dst_sel:WORD_0 dst_unused:UNUSED_PRESERVE src0_sel:WORD_0\n\t" OP " %1, %1 dst_sel:WORD_0 dst_unused:UNUSED_PRESERVE src0_sel:WORD_0\n\t" \
    OP " %2, %2 dst_sel:WORD_0 dst_unused:UNUSED_PRESERVE src0_sel:WORD_0\n\t" OP " %3, %3 dst_sel:WORD_0 dst_unused:UNUSED_PRESERVE src0_sel:WORD_0\n\t"                                  \
    OP " %0, %0 dst_sel:WORD_1 dst_unused:UNUSED_PRESERVE src0_sel:WORD_1\n\t" OP " %1, %1 dst_sel:WORD_1 dst_unused:UNUSED_PRESERVE src0_sel:WORD_1\n\t"                                  \
    OP " %2, %2 dst_sel:WORD_1 dst_unused:UNUSED_PRESERVE src0_sel:WORD_1\n\t" OP " %3, %3 dst_sel:WORD_1 dst_unused:UNUSED_PRESERVE src0_sel:WORD_1\n\ts_nop 0" : "+v"(a), "+v"(b), "+v"(c), "+v"(d))
struct EpiGlu {
    static constexpr bool PERM = true;
    bf16_t* G; const rss_t* rowss; const u32x4* cwt; int chunk; LAS float* xl; bf16_t* EB; bf16_t* G2; int gsplit;
    __device__ __forceinline__ void operator()(f32x4 (&acc)[2][2][4][2], const Unit& u, int wr, int wc, int fr, int fq) const {
        const int ch0 = u.pn * 128 + wc * 32 + 8 * fq;
        const int tidw = (wr * 4 + wc) * 64 + fq * 16 + fr; LAS unsigned char* wl = (LAS unsigned char*)xl + 12288; LAS unsigned* xu = (LAS unsigned*)xl;
        u32x4 wrec = (u32x4){0u, 0u, 0u, 0u}; if (tidw < 128) wrec = cwt[u.pn * 128 + tidw];
        int rowi[2][4]; unsigned stmask = 0u; unsigned hh[2][2][4][4];
        { rss_t rv[2][4];
#pragma unroll
          for (int ai = 0; ai < 2; ++ai)
#pragma unroll
            for (int m = 0; m < 4; ++m) { const int RL = ai * HALF + wr * 64 + 4 * fr + m; bool valid; const int row = ffn_tile_row(u.pm, ai * HALF + wr * 64 + m * 16 + fr, chunk, valid); rowi[ai][m] = row; rv[ai][m] = rowss[row];
                const int gt = chunk * FFN_CHUNK + row, pos = tok_pos(gt), S = tok_seqlen(gt);
                const bool st = !((RL == 0 && pos != 0) || (RL == 255 && pos != S - 1)); (void)valid;
                stmask |= st ? (1u << (ai * 4 + m)) : 0u; }
#pragma unroll
          for (int ai = 0; ai < 2; ++ai)
#pragma unroll
            for (int m = 0; m < 4; ++m) { const float rx = ss_rstd(rv[ai][m]); const h2_t r2 = {(_Float16)rx, (_Float16)rx};
#pragma unroll
                for (int bj = 0; bj < 2; ++bj)
#pragma unroll
                    for (int n = 0; n < 2; ++n)
#pragma unroll
                        for (int jp = 0; jp < 2; ++jp) hh[ai][bj][m][2 * n + jp] = h2u(__builtin_bit_cast(h2_t, __builtin_amdgcn_cvt_pkrtz(acc[ai][bj][m][n][2 * jp], acc[ai][bj][m][n][2 * jp + 1])) * r2); } }
        if (wr == 0 && fr == 0) {
#pragma unroll
            for (int m = 0; m < 2; ++m)
#pragma unroll
                for (int bj = 0; bj < 2; ++bj) *(u32x4*)(EB + (size_t)(u.pm * 4 + m) * UP_W + bj * D_FF + ch0) = (u32x4){hh[0][bj][m][0], hh[0][bj][m][1], hh[0][bj][m][2], hh[0][bj][m][3]}; }
        if (wr == 1 && fr == 15) {
#pragma unroll
            for (int m = 2; m < 4; ++m)
#pragma unroll
                for (int bj = 0; bj < 2; ++bj) *(u32x4*)(EB + (size_t)(u.pm * 4 + m) * UP_W + bj * D_FF + ch0) = (u32x4){hh[1][bj][m][0], hh[1][bj][m][1], hh[1][bj][m][2], hh[1][bj][m][3]}; }
#pragma unroll
        for (int ai = 0; ai < 2; ++ai) { const int s1 = 2 * ai + wr + 1;
            if (fr == 0) {
#pragma unroll
                for (int bj = 0; bj < 2; ++bj) *(LAS u32x4*)(xu + ((s1 * 2 + 0) * 4 + wc) * 32 + bj * 16 + 4 * fq) = (u32x4){hh[ai][bj][0][0], hh[ai][bj][0][1], hh[ai][bj][0][2], hh[ai][bj][0][3]}; }
            if (fr == 15) {
#pragma unroll
                for (int bj = 0; bj < 2; ++bj) *(LAS u32x4*)(xu + ((s1 * 2 + 1) * 4 + wc) * 32 + bj * 16 + 4 * fq) = (u32x4){hh[ai][bj][3][0], hh[ai][bj][3][1], hh[ai][bj][3][2], hh[ai][bj][3][3]}; } }
        if (tidw < 128) *(LAS u32x4*)(wl + tidw * 16) = wrec;
        asm volatile("s_waitcnt lgkmcnt(0)" ::: "memory"); __builtin_amdgcn_s_barrier(); asm volatile("" ::: "memory");
        const h2_t c1 = {(_Float16)-0.10294324f, (_Float16)-0.10294324f}, c0 = {(_Float16)-2.3022082f, (_Float16)-2.3022082f}, one = {(_Float16)1.0f, (_Float16)1.0f};
        unsigned wq[2][2][4][2];
#pragma unroll
        for (int n = 0; n < 2; ++n) { unsigned (&wp)[2][4][2] = wq[n];
#pragma unroll
            for (int jp = 0; jp < 2; ++jp) { const int q = 2 * n + jp;
                const u32x4 wg = *(const LAS u32x4*)(wl + (wc * 16 + 4 * fq + q) * 32), wv = *(const LAS u32x4*)(wl + (wc * 16 + 4 * fq + q) * 32 + 16);
#pragma unroll
                for (int ai = 0; ai < 2; ++ai) { const int s1 = 2 * ai + wr + 1; h2_t cg[4], cv[4];
                    const LAS unsigned* xp = xu + (((s1 - 1) * 2 + 1) * 4 + wc) * 32 + 4 * fq + q; const LAS unsigned* xn = xu + (((s1 + 1) * 2 + 0) * 4 + wc) * 32 + 4 * fq + q;
                    { const unsigned pe = xp[0], ne = xn[0]; const unsigned r3 = dppu_ror1(hh[ai][0][3][q]), l0 = dppu_ror15(hh[ai][0][0][q]);
                      const h2_t w0 = u2h(wg.x), w1 = u2h(wg.y), w2 = u2h(wg.z), wb = u2h(wg.w);
#pragma unroll
                      for (int m = 0; m < 4; ++m) { const unsigned pv = m ? hh[ai][0][m ? m - 1 : 0][q] : (fr == 0 ? pe : r3), nx = m < 3 ? hh[ai][0][m < 3 ? m + 1 : 3][q] : (fr == 15 ? ne : l0);
                          cg[m] = wb + w0 * u2h(pv) + w1 * u2h(hh[ai][0][m][q]) + w2 * u2h(nx); } }
                    { const unsigned pe = xp[16], ne = xn[16]; const unsigned r3 = dppu_ror1(hh[ai][1][3][q]), l0 = dppu_ror15(hh[ai][1][0][q]);
                      const h2_t w0 = u2h(wv.x), w1 = u2h(wv.y), w2 = u2h(wv.z), wb = u2h(wv.w);
#pragma unroll
                      for (int m = 0; m < 4; ++m) { const unsigned pv = m ? hh[ai][1][m ? m - 1 : 0][q] : (fr == 0 ? pe : r3), nx = m < 3 ? hh[ai][1][m < 3 ? m + 1 : 3][q] : (fr == 15 ? ne : l0);
                          cv[m] = wb + w0 * u2h(pv) + w1 * u2h(hh[ai][1][m][q]) + w2 * u2h(nx); } }
                    unsigned e0 = h2u(cg[0] * (cg[0] * cg[0] * c1 + c0)), e1 = h2u(cg[1] * (cg[1] * cg[1] * c1 + c0)), e2 = h2u(cg[2] * (cg[2] * cg[2] * c1 + c0)), e3 = h2u(cg[3] * (cg[3] * cg[3] * c1 + c0));
                    H2X4_TRANS("v_exp_f16_sdwa", e0, e1, e2, e3);
                    e0 = h2u(u2h(e0) + one); e1 = h2u(u2h(e1) + one); e2 = h2u(u2h(e2) + one); e3 = h2u(u2h(e3) + one);
                    H2X4_TRANS("v_rcp_f16_sdwa", e0, e1, e2, e3);
                    wp[ai][0][jp] = h2u(cg[0] * u2h(e0) * cv[0]); wp[ai][1][jp] = h2u(cg[1] * u2h(e1) * cv[1]); wp[ai][2][jp] = h2u(cg[2] * u2h(e2) * cv[2]); wp[ai][3][jp] = h2u(cg[3] * u2h(e3) * cv[3]);
                    asm volatile("" : "+v"(wp[ai][0][jp]), "+v"(wp[ai][1][jp]), "+v"(wp[ai][2][jp]), "+v"(wp[ai][3][jp])); } }
            asm volatile("" ::: "memory"); }
#pragma unroll
        for (int ai = 0; ai < 2; ++ai)
#pragma unroll
            for (int m = 0; m < 4; ++m) { const u32x4 q = {wq[0][ai][m][0], wq[0][ai][m][1], wq[1][ai][m][0], wq[1][ai][m][1]}; if (stmask & (1u << (ai * 4 + m))) *(u32x4*)((u.pm < gsplit ? G : G2) + (size_t)rowi[ai][m] * D_FF + ch0) = q; }
    }
};
__device__ __forceinline__ void ffn_fix_item(const bf16_t* EB, const u32x4* cwt, bf16_t* G, bf16_t* G2, int gsplit_row, int t, int cb, int lane) {
    const int ti = (t >> 8) - 1, ch = cb * 512 + lane * 8;
    const bf16_t* ea = EB + (size_t)(ti * 4 + 2) * UP_W + ch; const bf16_t* ec = EB + (size_t)((ti + 1) * 4) * UP_W + ch;
    u32x4 ug[4], uv[4], w[8];
    ug[0] = *(const u32x4*)ea; uv[0] = *(const u32x4*)(ea + D_FF); ug[1] = *(const u32x4*)(ea + UP_W); uv[1] = *(const u32x4*)(ea + UP_W + D_FF);
    ug[2] = *(const u32x4*)ec; uv[2] = *(const u32x4*)(ec + D_FF); ug[3] = *(const u32x4*)(ec + UP_W); uv[3] = *(const u32x4*)(ec + UP_W + D_FF);
#pragma unroll
    for (int k = 0; k < 8; ++k) w[k] = cwt[(ch >> 1) * 2 + k];
    const h2_t c1 = {(_Float16)-0.10294324f, (_Float16)-0.10294324f}, c0 = {(_Float16)-2.3022082f, (_Float16)-2.3022082f}, one = {(_Float16)1.0f, (_Float16)1.0f};
    u32x4 oa, ob;
#pragma unroll
    for (int qp = 0; qp < 2; ++qp) { h2_t cg[4], cv[4];
#pragma unroll
        for (int qq = 0; qq < 2; ++qq) { const int q = 2 * qp + qq; const u32x4 wg = w[2 * q], wv = w[2 * q + 1];
            cg[2 * qq + 0] = u2h(wg.w) + u2h(wg.x) * u2h(ug[0][q]) + u2h(wg.y) * u2h(ug[1][q]) + u2h(wg.z) * u2h(ug[2][q]);
            cg[2 * qq + 1] = u2h(wg.w) + u2h(wg.x) * u2h(ug[1][q]) + u2h(wg.y) * u2h(ug[2][q]) + u2h(wg.z) * u2h(ug[3][q]);
            cv[2 * qq + 0] = u2h(wv.w) + u2h(wv.x) * u2h(uv[0][q]) + u2h(wv.y) * u2h(uv[1][q]) + u2h(wv.z) * u2h(uv[2][q]);
            cv[2 * qq + 1] = u2h(wv.w) + u2h(wv.x) * u2h(uv[1][q]) + u2h(wv.y) * u2h(uv[2][q]) + u2h(wv.z) * u2h(uv[3][q]); }
        unsigned e0 = h2u(cg[0] * (cg[0] * cg[0] * c1 + c0)), e1 = h2u(cg[1] * (cg[1] * cg[1] * c1 + c0)), e2 = h2u(cg[2] * (cg[2] * cg[2] * c1 + c0)), e3 = h2u(cg[3] * (cg[3] * cg[3] * c1 + c0));
        H2X4_TRANS("v_exp_f16_sdwa", e0, e1, e2, e3);
        e0 = h2u(u2h(e0) + one); e1 = h2u(u2h(e1) + one); e2 = h2u(u2h(e2) + one); e3 = h2u(u2h(e3) + one);
        H2X4_TRANS("v_rcp_f16_sdwa", e0, e1, e2, e3);
        oa[2 * qp] = h2u(cg[0] * u2h(e0) * cv[0]); ob[2 * qp] = h2u(cg[1] * u2h(e1) * cv[1]); oa[2 * qp + 1] = h2u(cg[2] * u2h(e2) * cv[2]); ob[2 * qp + 1] = h2u(cg[3] * u2h(e3) * cv[3]); }
    *(u32x4*)((t - 1 < gsplit_row ? G : G2) + (size_t)(t - 1) * D_FF + ch) = oa; *(u32x4*)((t < gsplit_row ? G : G2) + (size_t)t * D_FF + ch) = ob;
}
struct EpiKV {
    static constexpr bool PERM = false;
    float* kraw; bf16_t* vT;
    __device__ __forceinline__ void operator()(const f32x4 (&acc)[2][2][4][2], const Unit& u, int wr, int wc, int fr, int fq) const {
        const int key0 = wr * 64 + fr, col0 = u.pn * BM + wc * 32 + 4 * fq;
        if (u.pn < 8) {
#pragma unroll
            for (int ai = 0; ai < 2; ++ai)
#pragma unroll
                for (int m = 0; m < 4; ++m) { float* rowp = kraw + (size_t)(u.pm * BM + key0 + ai * HALF + m * 16) * 2048 + col0;
#pragma unroll
                    for (int bj = 0; bj < 2; ++bj)
#pragma unroll
                        for (int n = 0; n < 2; ++n) *(f32x4*)(rowp + bj * HALF + n * 16) = acc[ai][bj][m][n]; }
        } else {
#pragma unroll
            for (int ai = 0; ai < 2; ++ai)
#pragma unroll
                for (int m = 0; m < 4; ++m) { bf16_t* rowp = vT + (size_t)(u.pm * BM + key0 + ai * HALF + m * 16) * 2048 + (col0 - 2048);
#pragma unroll
                    for (int bj = 0; bj < 2; ++bj)
#pragma unroll
                        for (int n = 0; n < 2; ++n) { const f32x4 v = acc[ai][bj][m][n]; u32x2 w; w.x = cvt_pk_bf16(v[0], v[1]); w.y = cvt_pk_bf16(v[2], v[3]); *(u32x2*)(rowp + bj * HALF + n * 16) = w; } }
        }
    }
};
}

namespace att {
constexpr int KVBLK = 64, SHM_V = 16384, SHM_K = 16384, OFF_V = 0, OFF_K = 3 * SHM_V, OFF_WS = 3 * SHM_V + 3 * SHM_K, LDP = 1024;
#define KSWZ(row, colB) ((row) * 256 + ((colB) ^ (((row) & 15) << 4)))
#define SBAR() __builtin_amdgcn_sched_barrier(0)
__device__ __forceinline__ int crow(int r, int hi) { return (r & 3) + 8 * (r >> 2) + 4 * hi; }
__device__ __forceinline__ void partialSM(f32x16& p0) {
#pragma unroll
  for (int r = 0; r < 16; ++r) p0[r] = __builtin_amdgcn_exp2f(p0[r]);
}
__device__ __forceinline__ void finishSM(f32x16& p0, f32x16& p1, float& l_reg, bf16x8& pa0, bf16x8& pa1, bf16x8& pa2, bf16x8& pa3) {
#pragma unroll
  for (int r = 0; r < 16; ++r) p1[r] = __builtin_amdgcn_exp2f(p1[r]);
  float ps = 0;
#pragma unroll
  for (int r = 0; r < 16; ++r) ps += p0[r];
#pragma unroll
  for (int r = 0; r < 16; ++r) ps += p1[r];
  l_reg += ps;
#define PK4(P, BASE, OUT) do { unsigned a0 = cvt_pk_bf16(P[BASE + 0], P[BASE + 1]), a1 = cvt_pk_bf16(P[BASE + 2], P[BASE + 3]);   \
    unsigned b0 = cvt_pk_bf16(P[BASE + 4], P[BASE + 5]), b1 = cvt_pk_bf16(P[BASE + 6], P[BASE + 7]);                              \
    auto r0 = __builtin_amdgcn_permlane32_swap(a0, b0, false, false); auto r1 = __builtin_amdgcn_permlane32_swap(a1, b1, false, false); \
    u32x4 w = {r0[0], r1[0], r0[1], r1[1]}; OUT = __builtin_bit_cast(bf16x8, w); } while (0)
  PK4(p0, 0, pa0); PK4(p0, 8, pa1); PK4(p1, 0, pa2); PK4(p1, 8, pa3);
#undef PK4
}
__device__ __forceinline__ void finishSM_tail(f32x16& p0, f32x16& p1, float& l_reg, bf16x8& pa0, bf16x8& pa1, bf16x8& pa2, bf16x8& pa3) {
  float ps = 0;
#pragma unroll
  for (int r = 0; r < 16; ++r) ps += p0[r];
#pragma unroll
  for (int r = 0; r < 16; ++r) ps += p1[r];
  l_reg += ps;
#define PK4(P, BASE, OUT) do { unsigned a0 = cvt_pk_bf16(P[BASE + 0], P[BASE + 1]), a1 = cvt_pk_bf16(P[BASE + 2], P[BASE + 3]);   \
    unsigned b0 = cvt_pk_bf16(P[BASE + 4], P[BASE + 5]), b1 = cvt_pk_bf16(P[BASE + 6], P[BASE + 7]);                              \
    u32x4 w = {a0, a1, b0, b1}; OUT = __builtin_bit_cast(bf16x8, w); } while (0)
  PK4(p0, 0, pa0); PK4(p0, 8, pa1); PK4(p1, 0, pa2); PK4(p1, 8, pa3);
#undef PK4
}
__device__ __forceinline__ void qkt(f32x16& p0, f32x16& p1, const LAS unsigned char* Ks, const bf16x8* qr, int r32, int hi, int cbase) {
  p0 = f32x16{}; p1 = f32x16{}; bf16x8 b0[4], b1[4];
#pragma unroll
  for (int d0 = 0; d0 < 4; ++d0) { const int cb = cbase + (d0 * 16 + hi * 8) * 2;
    b0[d0] = *(const LAS bf16x8*)(Ks + KSWZ(r32, cb)); b1[d0] = *(const LAS bf16x8*)(Ks + KSWZ(32 + r32, cb)); }
#define QK_STEP(D, N) do { asm volatile("s_waitcnt lgkmcnt(" #N ")" ::: "memory"); SBAR(); \
    p0 = __builtin_amdgcn_mfma_f32_32x32x16_bf16(b0[D], qr[D], p0, 0, 0, 0); p1 = __builtin_amdgcn_mfma_f32_32x32x16_bf16(b1[D], qr[D], p1, 0, 0, 0); } while (0)
  QK_STEP(0, 6); QK_STEP(1, 4); QK_STEP(2, 2); QK_STEP(3, 0);
#undef QK_STEP
}
__device__ __forceinline__ int v_st(int k, int c) { const int kk = k; return ((kk >> 3) * 4 + (c >> 5)) * 512 + ((kk & 7) * 32 + (c & 31)) * 2; }
__device__ __forceinline__ int v_rd_base(int lane) { return ((lane & 3) << 3) | (((lane >> 2) & 3) << 6) | (((lane >> 4) & 1) << 5) | (((lane >> 5) & 1) << 8); }
constexpr int v_rd_off(int d0, int ks, int half) { return d0 * 512 + ks * 4096 + half * 2048; }
template <int OFF> __device__ __forceinline__ s16x4 tr_read(int vb) {
  s16x4 r; asm volatile("ds_read_b64_tr_b16 %0, %1 offset:%2" : "=&v"(r) : "v"(vb), "i"(OFF) : "memory"); return r;
}
struct VFrag { s16x4 l0, h0, l1, h1, l2, h2, l3, h3; };
template <int D0> __device__ __forceinline__ void pv_read(VFrag& f, int vb) {
  f.l0 = tr_read<v_rd_off(D0, 0, 0)>(vb); f.h0 = tr_read<v_rd_off(D0, 0, 1)>(vb); f.l1 = tr_read<v_rd_off(D0, 1, 0)>(vb); f.h1 = tr_read<v_rd_off(D0, 1, 1)>(vb);
  f.l2 = tr_read<v_rd_off(D0, 2, 0)>(vb); f.h2 = tr_read<v_rd_off(D0, 2, 1)>(vb); f.l3 = tr_read<v_rd_off(D0, 3, 0)>(vb); f.h3 = tr_read<v_rd_off(D0, 3, 1)>(vb);
}
__device__ __forceinline__ void pv_mma(f32x16& od, const VFrag& f, bf16x8 pa0, bf16x8 pa1, bf16x8 pa2, bf16x8 pa3) {
#define PKV(L, H) (bf16x8){L[0], L[1], L[2], L[3], H[0], H[1], H[2], H[3]}
  od = __builtin_amdgcn_mfma_f32_32x32x16_bf16(pa0, PKV(f.l0, f.h0), od, 0, 0, 0);
  od = __builtin_amdgcn_mfma_f32_32x32x16_bf16(pa1, PKV(f.l1, f.h1), od, 0, 0, 0);
  od = __builtin_amdgcn_mfma_f32_32x32x16_bf16(pa2, PKV(f.l2, f.h2), od, 0, 0, 0);
  od = __builtin_amdgcn_mfma_f32_32x32x16_bf16(pa3, PKV(f.l3, f.h3), od, 0, 0, 0);
#undef PKV
}
__device__ __forceinline__ void pv_d0(f32x16* o, int vb, bf16x8 pa0, bf16x8 pa1, bf16x8 pa2, bf16x8 pa3) {
  VFrag fa, fb;
  pv_read<0>(fa, vb); pv_read<1>(fb, vb);
  asm volatile("s_waitcnt lgkmcnt(8)" ::: "memory"); SBAR(); pv_mma(o[0], fa, pa0, pa1, pa2, pa3); SBAR();
  pv_read<2>(fa, vb);
  asm volatile("s_waitcnt lgkmcnt(8)" ::: "memory"); SBAR(); pv_mma(o[1], fb, pa0, pa1, pa2, pa3); SBAR();
  pv_read<3>(fb, vb);
  asm volatile("s_waitcnt lgkmcnt(8)" ::: "memory"); SBAR(); pv_mma(o[2], fa, pa0, pa1, pa2, pa3); SBAR();
  asm volatile("s_waitcnt lgkmcnt(0)" ::: "memory"); SBAR(); pv_mma(o[3], fb, pa0, pa1, pa2, pa3);
}
__device__ __forceinline__ void att_step(f32x16& s0, f32x16& s1, const LAS unsigned char* Ks, const bf16x8* qr, int r32, int hi, int cbase,
                                         f32x16& e0, f32x16& e1, float& l_reg, bf16x8& pa0, bf16x8& pa1, bf16x8& pa2, bf16x8& pa3, f32x16* o, int vb) {
  bf16x8 b0[4], b1[4]; VFrag fa, fb; float ps = 0.f; u32x4 w0, w1, w2, w3;
#pragma unroll
  for (int d0 = 0; d0 < 4; ++d0) { const int cb = cbase + (d0 * 16 + hi * 8) * 2;
    b0[d0] = *(const LAS bf16x8*)(Ks + KSWZ(r32, cb)); b1[d0] = *(const LAS bf16x8*)(Ks + KSWZ(32 + r32, cb)); }
  s0 = f32x16{}; s1 = f32x16{};
#define PACK_H(E, BASE, H, W) do { ps += E[BASE + 2 * H]; ps += E[BASE + 2 * H + 1]; ps += E[BASE + 4 + 2 * H]; ps += E[BASE + 5 + 2 * H];                       \
    const unsigned a_ = cvt_pk_bf16(E[BASE + 2 * H], E[BASE + 2 * H + 1]), b_ = cvt_pk_bf16(E[BASE + 4 + 2 * H], E[BASE + 5 + 2 * H]);                       \
    W[H] = a_; W[2 + H] = b_; } while (0)
#define QK_STEP(D, N, PRE, PK_A, PK_B) do { asm volatile("s_waitcnt lgkmcnt(" #N ")" ::: "memory"); PRE; SBAR();                                                  \
    s0 = __builtin_amdgcn_mfma_f32_32x32x16_bf16(b0[D], qr[D], s0, 0, 0, 0); SBAR(); PK_A; SBAR();                                                                 \
    s1 = __builtin_amdgcn_mfma_f32_32x32x16_bf16(b1[D], qr[D], s1, 0, 0, 0); SBAR(); PK_B; SBAR(); } while (0)
  QK_STEP(0, 6, (void)0, PACK_H(e0, 0, 0, w0), PACK_H(e0, 0, 1, w0));
  QK_STEP(1, 4, (void)0, PACK_H(e0, 8, 0, w1), PACK_H(e0, 8, 1, w1));
  QK_STEP(2, 2, (void)0, PACK_H(e1, 0, 0, w2), PACK_H(e1, 0, 1, w2));
  QK_STEP(3, 0, (pv_read<0>(fa, vb), pv_read<1>(fb, vb)), PACK_H(e1, 8, 0, w3), PACK_H(e1, 8, 1, w3));
#undef QK_STEP
#undef PACK_H
  l_reg += ps;
  pa0 = __builtin_bit_cast(bf16x8, w0); pa1 = __builtin_bit_cast(bf16x8, w1); pa2 = __builtin_bit_cast(bf16x8, w2); pa3 = __builtin_bit_cast(bf16x8, w3);
#define PKV(L, H) (bf16x8){L[0], L[1], L[2], L[3], H[0], H[1], H[2], H[3]}
#define EX2(X, I) do { X[I] = __builtin_amdgcn_exp2f(X[I]); X[I + 1] = __builtin_amdgcn_exp2f(X[I + 1]); } while (0)
#define PV_BLK(D0, F, N, X, XB) do { asm volatile("s_waitcnt lgkmcnt(" #N ")" ::: "memory"); SBAR();                                                              \
    o[D0] = __builtin_amdgcn_mfma_f32_32x32x16_bf16(pa0, PKV(F.l0, F.h0), o[D0], 0, 0, 0); SBAR(); EX2(X, XB + 0); SBAR();                                         \
    o[D0] = __builtin_amdgcn_mfma_f32_32x32x16_bf16(pa1, PKV(F.l1, F.h1), o[D0], 0, 0, 0); SBAR(); EX2(X, XB + 2); SBAR();                                         \
    o[D0] = __builtin_amdgcn_mfma_f32_32x32x16_bf16(pa2, PKV(F.l2, F.h2), o[D0], 0, 0, 0); SBAR(); EX2(X, XB + 4); SBAR();                                         \
    o[D0] = __builtin_amdgcn_mfma_f32_32x32x16_bf16(pa3, PKV(F.l3, F.h3), o[D0], 0, 0, 0); SBAR(); EX2(X, XB + 6); SBAR(); } while (0)
  PV_BLK(0, fa, 8, s0, 0); pv_read<2>(fa, vb);
  PV_BLK(1, fb, 8, s0, 8); pv_read<3>(fb, vb);
  PV_BLK(2, fa, 8, s1, 0);
  PV_BLK(3, fb, 0, s1, 8);
#undef PV_BLK
#undef EX2
#undef PKV
}
__device__ __forceinline__ void attn_unit(const bf16_t* Qg, const bf16_t* __restrict__ Kg, const bf16_t* __restrict__ Vg, bf16_t* Og, int seq, float lam, const float* gsub, float oscale, LAS unsigned char* lds) {
  int tid_l = threadIdx.x; asm volatile("" : "+v"(tid_l));
  const int tid = tid_l, wid = __builtin_amdgcn_readfirstlane(tid >> 6), lane = tid & 63, r32 = lane & 31, hi = lane >> 5;
  const int comp = wid & 1, rg = wid >> 1, cbase = comp * 128;
  LAS unsigned char* V_lds = lds + OFF_V; LAS unsigned char* K_lds = lds + OFF_K;
  LAS float* wsf = (LAS float*)(lds + OFF_WS) + wid * 64; LAS float* li_l = wsf;
  float l_reg = 0; f32x16 o[4] = {}; bf16x8 qr[4];
  const bf16_t* Qw = Qg + (size_t)(rg * 32 + r32) * LDP + comp * 64 + hi * 8;
#pragma unroll
  for (int d0 = 0; d0 < 4; ++d0) qr[d0] = *(const bf16x8*)(Qw + d0 * 16);
  unsigned koff[2], voff[2];
#pragma unroll
  for (int i = 0; i < 2; ++i) { const int L = (tid + 512 * i) * 16; { const int row = L >> 8, colB = (L & 255) ^ ((row & 15) << 4); koff[i] = (unsigned)(row * LDP * 2 + colB); }
    { const int sub = L >> 9, w = L & 511, kk = (sub >> 2) * 8 + (w >> 6), c = (sub & 3) * 32 + ((w & 63) >> 1), k = kk; voff[i] = (unsigned)(k * LDP * 2 + c * 2); } }
  const int vbb = (int)(unsigned)(size_t)V_lds + v_rd_base(lane);
  const int NT = seq / KVBLK; const size_t tstep = (size_t)KVBLK * LDP * 2;
#define DMA_K(t) do { const int t_ = (t) < NT ? (t) : NT - 1; const char* g_ = (const char*)Kg + (size_t)t_ * tstep; LAS unsigned char* d_ = K_lds + (t_ % 3) * SHM_K + wid * 1024; \
    __builtin_amdgcn_global_load_lds((const unsigned*)(g_ + koff[0]), (LAS unsigned*)d_, 16, 0, 0); __builtin_amdgcn_global_load_lds((const unsigned*)(g_ + koff[1]), (LAS unsigned*)(d_ + 8192), 16, 0, 0); } while (0)
#define DMA_V(t) do { const int t_ = (t) < NT ? (t) : NT - 1; const char* g_ = (const char*)Vg + (size_t)t_ * tstep; LAS unsigned char* d_ = V_lds + (t_ % 3) * SHM_V + wid * 1024; \
    __builtin_amdgcn_global_load_lds((const unsigned*)(g_ + voff[0]), (LAS unsigned*)d_, 16, 0, 0); __builtin_amdgcn_global_load_lds((const unsigned*)(g_ + voff[1]), (LAS unsigned*)(d_ + 8192), 16, 0, 0); } while (0)
#define WAIT4_BAR() do { asm volatile("s_waitcnt vmcnt(4)" ::: "memory"); __builtin_amdgcn_s_barrier(); asm volatile("" ::: "memory"); } while (0)
  f32x16 pA0, pA1, pB0, pB1; bf16x8 pa0, pa1, pa2, pa3;
  DMA_K(0); DMA_K(1); DMA_V(0);
  WAIT4_BAR();
  DMA_K(2); DMA_V(1);
  qkt(pA0, pA1, K_lds, qr, r32, hi, cbase); partialSM(pA0); partialSM(pA1);
  int sk = 1, sv = 0;
  for (int j = 1; j + 1 < NT; j += 2) {
    WAIT4_BAR(); DMA_K(j + 2); DMA_V(j + 1);
    SBAR(); att_step(pB0, pB1, K_lds + sk * SHM_K, qr, r32, hi, cbase, pA0, pA1, l_reg, pa0, pa1, pa2, pa3, o, vbb + sv * SHM_V); SBAR();
    sk = sk == 2 ? 0 : sk + 1; sv = sv == 2 ? 0 : sv + 1;
    WAIT4_BAR(); DMA_K(j + 3); DMA_V(j + 2);
    SBAR(); att_step(pA0, pA1, K_lds + sk * SHM_K, qr, r32, hi, cbase, pB0, pB1, l_reg, pa0, pa1, pa2, pa3, o, vbb + sv * SHM_V); SBAR();
    sk = sk == 2 ? 0 : sk + 1; sv = sv == 2 ? 0 : sv + 1;
  }
  WAIT4_BAR(); DMA_K(NT + 1); DMA_V(NT);
  SBAR(); att_step(pB0, pB1, K_lds + sk * SHM_K, qr, r32, hi, cbase, pA0, pA1, l_reg, pa0, pa1, pa2, pa3, o, vbb + sv * SHM_V); SBAR();
  sv = sv == 2 ? 0 : sv + 1;
  WAIT4_BAR();
  finishSM_tail(pB0, pB1, l_reg, pa0, pa1, pa2, pa3); SBAR();
  pv_d0(o, vbb + sv * SHM_V, pa0, pa1, pa2, pa3);
  asm volatile("s_waitcnt vmcnt(0)" ::: "memory");
#undef DMA_K
#undef DMA_V
#undef WAIT4_BAR
  { auto rr = __builtin_amdgcn_permlane32_swap(__float_as_uint(l_reg), __float_as_uint(l_reg), false, false); l_reg = __uint_as_float(rr[0]) + __uint_as_float(rr[1]); }
  if (hi == 0) li_l[r32] = l_reg; asm volatile("s_waitcnt lgkmcnt(0)" ::: "memory");
  float rli[16];
#pragma unroll
  for (int r = 0; r < 16; ++r) rli[r] = __builtin_amdgcn_rcpf(li_l[crow(r, hi)]);
  __syncthreads();
  LAS float* X = (LAS float*)(lds) + rg * 4096 + lane;
  if (comp == 1) {
#pragma unroll
    for (int d0 = 0; d0 < 4; ++d0)
#pragma unroll
      for (int r = 0; r < 16; ++r) X[(d0 * 16 + r) * 64] = o[d0][r] * rli[r] * lam;
  }
  __syncthreads();
  if (comp == 0) {
    float ss[16];
#pragma unroll
    for (int r = 0; r < 16; ++r) ss[r] = 0.f;
#pragma unroll
    for (int d0 = 0; d0 < 4; ++d0)
#pragma unroll
      for (int r = 0; r < 16; ++r) { const float v = o[d0][r] * rli[r] - X[(d0 * 16 + r) * 64]; o[d0][r] = v; ss[r] += v * v; }
#pragma unroll
    for (int r = 0; r < 16; ++r) { float s = ss[r]; s += __shfl_xor(s, 1); s += __shfl_xor(s, 2); s += __shfl_xor(s, 4); s += __shfl_xor(s, 8); s += __shfl_xor(s, 16);
      ss[r] = __builtin_amdgcn_rsqf(s * (1.0f / 128.0f) + EPS) * oscale; }
    bf16_t* Ow = Og + (size_t)(rg * 32) * LDP;
#pragma unroll
    for (int d0 = 0; d0 < 4; ++d0) { const float g = gsub[d0 * 32 + r32];
#pragma unroll
#ifdef PROBE_ZERO_ATTN
      for (int r = 0; r < 16; ++r) Ow[(size_t)crow(r, hi) * LDP + d0 * 32 + r32] = (bf16_t)0;
#else
      for (int r = 0; r < 16; ++r) Ow[(size_t)crow(r, hi) * LDP + d0 * 32 + r32] = (bf16_t)(cvt_pk_bf16(o[d0][r] * ss[r] * g, 0.f) & 0xffffu);
#endif
    }
  }
  __syncthreads();
}
}


namespace att16 {
using att::KVBLK; using att::SHM_V; using att::SHM_K; using att::LDP;
constexpr int OFF_V = 0, OFF_K = 4 * SHM_V;
typedef f32x4 S8[4][2];
__device__ __forceinline__ f32x4 mma16(bf16x8 a, bf16x8 b, f32x4 c) { return __builtin_amdgcn_mfma_f32_16x16x32_bf16(a, b, c, 0, 0, 0); }
template <int OFF> __device__ __forceinline__ s16x4 tr_read(int vb) { s16x4 r; asm volatile("ds_read_b64_tr_b16 %0, %1 offset:%2" : "=&v"(r) : "v"(vb), "i"(OFF) : "memory"); return r; }
struct VF { s16x4 l0, h0, l1, h1; };
constexpr int v_off(int db, int ks, int half) { return ks * 8192 + half * 4096 + (db >> 1) * 512; }
template <int DP> __device__ __forceinline__ void pv_read(VF& fe, VF& fo, int vbe, int vbo) {
  fe.l0 = tr_read<v_off(2 * DP, 0, 0)>(vbe); fe.h0 = tr_read<v_off(2 * DP, 0, 1)>(vbe); fe.l1 = tr_read<v_off(2 * DP, 1, 0)>(vbe); fe.h1 = tr_read<v_off(2 * DP, 1, 1)>(vbe);
  fo.l0 = tr_read<v_off(2 * DP + 1, 0, 0)>(vbo); fo.h0 = tr_read<v_off(2 * DP + 1, 0, 1)>(vbo); fo.l1 = tr_read<v_off(2 * DP + 1, 1, 0)>(vbo); fo.h1 = tr_read<v_off(2 * DP + 1, 1, 1)>(vbo);
}
#define PKV16(L, H) (bf16x8){L[0], L[1], L[2], L[3], H[0], H[1], H[2], H[3]}
__device__ __forceinline__ void kf_read(bf16x8 (&kf)[4][2], const LAS unsigned char* Ks, int c16, int g, int cbase) {
#pragma unroll
  for (int kb = 0; kb < 4; ++kb)
#pragma unroll
    for (int ks = 0; ks < 2; ++ks) kf[kb][ks] = *(const LAS bf16x8*)(Ks + KSWZ(16 * kb + c16, cbase + (32 * ks + 8 * g) * 2));
}
__device__ __forceinline__ void qk_first(S8& S, const LAS unsigned char* Ks, const bf16x8 (&qf)[2][2], int c16, int g, int cbase) {
  bf16x8 kf[4][2]; kf_read(kf, Ks, c16, g, cbase);
#pragma unroll
  for (int kb = 0; kb < 4; ++kb)
#pragma unroll
    for (int qb = 0; qb < 2; ++qb) { f32x4 a = {0.f, 0.f, 0.f, 0.f}; a = mma16(kf[kb][0], qf[qb][0], a); a = mma16(kf[kb][1], qf[qb][1], a);
#pragma unroll
      for (int r = 0; r < 4; ++r) a[r] = __builtin_amdgcn_exp2f(a[r]);
      S[kb][qb] = a; }
}
#define ADDF16(acc, x) asm("v_add_f32 %0, %1, %0" : "+v"(acc) : "v"(x))
#define PACK16(E, KS, QB, W) do { const f32x4& e_ = E[2 * (KS) + ((W) >> 1)][QB]; pw[KS][QB][W] = cvt_pk_bf16(e_[2 * ((W) & 1)], e_[2 * ((W) & 1) + 1]); } while (0)
#define LSUM16() do { const bf16x8 on_ = {0x3F80, 0x3F80, 0x3F80, 0x3F80, 0x3F80, 0x3F80, 0x3F80, 0x3F80};                                                        \
    l2[0] = mma16(on_, __builtin_bit_cast(bf16x8, pw[0][0]), l2[0]); l2[1] = mma16(on_, __builtin_bit_cast(bf16x8, pw[0][1]), l2[1]);                               \
    l2[0] = mma16(on_, __builtin_bit_cast(bf16x8, pw[1][0]), l2[0]); l2[1] = mma16(on_, __builtin_bit_cast(bf16x8, pw[1][1]), l2[1]); } while (0)
__device__ __forceinline__ void pack_all(const S8& E, u32x4 (&pw)[2][2]) {
#pragma unroll
  for (int ks = 0; ks < 2; ++ks)
#pragma unroll
    for (int qb = 0; qb < 2; ++qb) { PACK16(E, ks, qb, 0); PACK16(E, ks, qb, 1); PACK16(E, ks, qb, 2); PACK16(E, ks, qb, 3); }
}
#define PV16(DB, F) do { _Pragma("unroll") for (int qb_ = 0; qb_ < 2; ++qb_) { o[DB][qb_] = mma16(PKV16(F.l0, F.h0), __builtin_bit_cast(bf16x8, pw[0][qb_]), o[DB][qb_]); \
    o[DB][qb_] = mma16(PKV16(F.l1, F.h1), __builtin_bit_cast(bf16x8, pw[1][qb_]), o[DB][qb_]); } } while (0)
__device__ __forceinline__ void pv_last(f32x4 (&o)[8][2], const u32x4 (&pw)[2][2], int vbe, int vbo) {
  VF ae, ao, be, bo;
  pv_read<0>(ae, ao, vbe, vbo); pv_read<1>(be, bo, vbe, vbo);
  asm volatile("s_waitcnt lgkmcnt(8)" ::: "memory"); SBAR(); PV16(0, ae); PV16(1, ao); SBAR();
  pv_read<2>(ae, ao, vbe, vbo);
  asm volatile("s_waitcnt lgkmcnt(8)" ::: "memory"); SBAR(); PV16(2, be); PV16(3, bo); SBAR();
  pv_read<3>(be, bo, vbe, vbo);
  asm volatile("s_waitcnt lgkmcnt(8)" ::: "memory"); SBAR(); PV16(4, ae); PV16(5, ao); SBAR();
  asm volatile("s_waitcnt lgkmcnt(0)" ::: "memory"); SBAR(); PV16(6, be); PV16(7, bo);
}
__device__ __forceinline__ void att_step(S8& S, const LAS unsigned char* Ks, const bf16x8 (&qf)[2][2], int c16, int g, int cbase, const S8& E, f32x4 (&l2)[2], f32x4 (&o)[8][2], int vbe, int vbo) {
  bf16x8 kf[4][2]; u32x4 pw[2][2]; VF ae, ao, be, bo;
  kf_read(kf, Ks, c16, g, cbase);
#define QK16(KB, N, PRE, P0, P1, P2, P3) do { asm volatile("s_waitcnt lgkmcnt(" #N ")" ::: "memory"); PRE; SBAR(); f32x4 a0_ = {0.f, 0.f, 0.f, 0.f}, a1_ = {0.f, 0.f, 0.f, 0.f};  \
    a0_ = mma16(kf[KB][0], qf[0][0], a0_); SBAR(); P0; SBAR(); a1_ = mma16(kf[KB][0], qf[1][0], a1_); SBAR(); P1; SBAR();                                     \
    a0_ = mma16(kf[KB][1], qf[0][1], a0_); SBAR(); P2; SBAR(); a1_ = mma16(kf[KB][1], qf[1][1], a1_); SBAR(); P3; SBAR(); S[KB][0] = a0_; S[KB][1] = a1_; } while (0)
  QK16(0, 6, (void)0, PACK16(E, 0, 0, 0), PACK16(E, 0, 0, 1), PACK16(E, 0, 0, 2), PACK16(E, 0, 0, 3));
  QK16(1, 4, (void)0, PACK16(E, 0, 1, 0), PACK16(E, 0, 1, 1), PACK16(E, 0, 1, 2), PACK16(E, 0, 1, 3));
  QK16(2, 2, (void)0, PACK16(E, 1, 0, 0), PACK16(E, 1, 0, 1), PACK16(E, 1, 0, 2), PACK16(E, 1, 0, 3));
  QK16(3, 0, (pv_read<0>(ae, ao, vbe, vbo), pv_read<1>(be, bo, vbe, vbo)), PACK16(E, 1, 1, 0), PACK16(E, 1, 1, 1), PACK16(E, 1, 1, 2), PACK16(E, 1, 1, 3));
#undef QK16
#define EX1(KB, QB, R) S[KB][QB][R] = __builtin_amdgcn_exp2f(S[KB][QB][R])
#define PVX(DB, F, KB) do { o[DB][0] = mma16(PKV16(F.l0, F.h0), __builtin_bit_cast(bf16x8, pw[0][0]), o[DB][0]); SBAR(); EX1(KB, 0, 0); SBAR();                    \
    o[DB][1] = mma16(PKV16(F.l0, F.h0), __builtin_bit_cast(bf16x8, pw[0][1]), o[DB][1]); SBAR(); EX1(KB, 0, 1); SBAR();                                          \
    o[DB][0] = mma16(PKV16(F.l1, F.h1), __builtin_bit_cast(bf16x8, pw[1][0]), o[DB][0]); SBAR(); EX1(KB, 0, 2); SBAR();                                          \
    o[DB][1] = mma16(PKV16(F.l1, F.h1), __builtin_bit_cast(bf16x8, pw[1][1]), o[DB][1]); SBAR(); EX1(KB, 0, 3); SBAR(); } while (0)
#define PVY(DB, F, KB) do { o[DB][0] = mma16(PKV16(F.l0, F.h0), __builtin_bit_cast(bf16x8, pw[0][0]), o[DB][0]); SBAR(); EX1(KB, 1, 0); SBAR();                    \
    o[DB][1] = mma16(PKV16(F.l0, F.h0), __builtin_bit_cast(bf16x8, pw[0][1]), o[DB][1]); SBAR(); EX1(KB, 1, 1); SBAR();                                          \
    o[DB][0] = mma16(PKV16(F.l1, F.h1), __builtin_bit_cast(bf16x8, pw[1][0]), o[DB][0]); SBAR(); EX1(KB, 1, 2); SBAR();                                          \
    o[DB][1] = mma16(PKV16(F.l1, F.h1), __builtin_bit_cast(bf16x8, pw[1][1]), o[DB][1]); SBAR(); EX1(KB, 1, 3); SBAR(); } while (0)
  SBAR(); LSUM16(); SBAR();
  asm volatile("s_waitcnt lgkmcnt(8)" ::: "memory"); SBAR(); PVX(0, ae, 0); PVY(1, ao, 0); pv_read<2>(ae, ao, vbe, vbo);
  asm volatile("s_waitcnt lgkmcnt(8)" ::: "memory"); SBAR(); PVX(2, be, 1); PVY(3, bo, 1); pv_read<3>(be, bo, vbe, vbo);
  asm volatile("s_waitcnt lgkmcnt(8)" ::: "memory"); SBAR(); PVX(4, ae, 2); PVY(5, ao, 2);
  asm volatile("s_waitcnt lgkmcnt(0)" ::: "memory"); SBAR(); PVX(6, be, 3); PVY(7, bo, 3);
#undef PVX
#undef PVY
#undef EX1
}
__device__ __forceinline__ void attn_unit(const bf16_t* Qg, const bf16_t* __restrict__ Kg, const bf16_t* __restrict__ Vg, bf16_t* Og, int seq, float lam, const float* gsub, float oscale, LAS unsigned char* lds, bool rev) {
  int tid_l = threadIdx.x; asm volatile("" : "+v"(tid_l));
  const int tid = tid_l, wid = __builtin_amdgcn_readfirstlane(tid >> 6), lane = tid & 63, c16 = lane & 15, g = lane >> 4;
  const int comp = wid & 1, rg = wid >> 1, cbase = comp * 128;
  LAS unsigned char* V_lds = lds + OFF_V; LAS unsigned char* K_lds = lds + OFF_K;

  f32x4 l2[2] = {{0.f, 0.f, 0.f, 0.f}, {0.f, 0.f, 0.f, 0.f}}; f32x4 o[8][2]; bf16x8 qf[2][2];
#pragma unroll
  for (int db = 0; db < 8; ++db)
#pragma unroll
    for (int qb = 0; qb < 2; ++qb) o[db][qb] = (f32x4){0.f, 0.f, 0.f, 0.f};
#pragma unroll
  for (int qb = 0; qb < 2; ++qb)
#pragma unroll
    for (int ks = 0; ks < 2; ++ks) qf[qb][ks] = *(const bf16x8*)(Qg + (size_t)(rg * 32 + 16 * qb + c16) * LDP + comp * 64 + 32 * ks + 8 * g);
  unsigned koff[2], voff[2];
#pragma unroll
  for (int i = 0; i < 2; ++i) { const int L = (tid + 512 * i) * 16; { const int row = L >> 8, colB = (L & 255) ^ ((row & 15) << 4); koff[i] = (unsigned)(row * LDP * 2 + colB); }
    { const int sub = L >> 9, w = L & 511, k = (sub >> 2) * 8 + (w >> 6), cl = ((w & 63) >> 1) ^ (((k >> 2) & 1) << 4), c = (sub & 3) * 32 + cl; voff[i] = (unsigned)(k * LDP * 2 + c * 2); } }
  const int vb0 = (int)(unsigned)(size_t)V_lds + (g >> 1) * 2048 + (g & 1) * 256 + ((c16 >> 2) & 3) * 64 + (c16 & 3) * 8;
  const int vbe0 = vb0 + (g & 1) * 32, vbo0 = vb0 + ((g & 1) ^ 1) * 32;
  const int NT = seq / KVBLK; const size_t tstep = (size_t)KVBLK * LDP * 2;
#define DMA_K(t) do { const int t_ = (t) < NT ? (t) : NT - 1; const char* g_ = (const char*)Kg + (size_t)(rev ? NT - 1 - t_ : t_) * tstep; LAS unsigned char* d_ = K_lds + (t_ & 3) * SHM_K + wid * 1024; \
    __builtin_amdgcn_global_load_lds((const unsigned*)(g_ + koff[0]), (LAS unsigned*)d_, 16, 0, 0); __builtin_amdgcn_global_load_lds((const unsigned*)(g_ + koff[1]), (LAS unsigned*)(d_ + 8192), 16, 0, 0); } while (0)
#define DMA_V(t) do { const int t_ = (t) < NT ? (t) : NT - 1; const char* g_ = (const char*)Vg + (size_t)(rev ? NT - 1 - t_ : t_) * tstep; LAS unsigned char* d_ = V_lds + (t_ & 3) * SHM_V + wid * 1024; \
    __builtin_amdgcn_global_load_lds((const unsigned*)(g_ + voff[0]), (LAS unsigned*)d_, 16, 0, 0); __builtin_amdgcn_global_load_lds((const unsigned*)(g_ + voff[1]), (LAS unsigned*)(d_ + 8192), 16, 0, 0); } while (0)
#define WAIT4_BAR() do { asm volatile("s_waitcnt vmcnt(8)" ::: "memory"); __builtin_amdgcn_s_barrier(); asm volatile("" ::: "memory"); } while (0)
  S8 pA, pB;
  DMA_K(0); DMA_K(1); DMA_V(0); DMA_K(2); DMA_V(1);
  WAIT4_BAR();
  DMA_K(3); DMA_V(2);
  qk_first(pA, K_lds, qf, c16, g, cbase);
  for (int j = 1; j + 1 < NT; j += 2) {
    WAIT4_BAR(); DMA_K(j + 3); DMA_V(j + 2);
    SBAR(); att_step(pB, K_lds + (j & 3) * SHM_K, qf, c16, g, cbase, pA, l2, o, vbe0 + ((j - 1) & 3) * SHM_V, vbo0 + ((j - 1) & 3) * SHM_V); SBAR();
    WAIT4_BAR(); DMA_K(j + 4); DMA_V(j + 3);
    SBAR(); att_step(pA, K_lds + ((j + 1) & 3) * SHM_K, qf, c16, g, cbase, pB, l2, o, vbe0 + (j & 3) * SHM_V, vbo0 + (j & 3) * SHM_V); SBAR();
  }
  WAIT4_BAR(); DMA_K(NT + 2); DMA_V(NT + 1);
  SBAR(); att_step(pB, K_lds + ((NT - 1) & 3) * SHM_K, qf, c16, g, cbase, pA, l2, o, vbe0 + ((NT - 2) & 3) * SHM_V, vbo0 + ((NT - 2) & 3) * SHM_V); SBAR();
  WAIT4_BAR();
  const int sv = (NT - 1) & 3;
  { u32x4 pw[2][2]; pack_all(pB, pw); SBAR(); LSUM16(); SBAR(); pv_last(o, pw, vbe0 + sv * SHM_V, vbo0 + sv * SHM_V); }
  asm volatile("s_waitcnt vmcnt(0)" ::: "memory");
#undef DMA_K
#undef DMA_V
#undef WAIT4_BAR
  float rl[2];
#pragma unroll
  for (int qb = 0; qb < 2; ++qb) rl[qb] = __builtin_amdgcn_rcpf(l2[qb][0]);
  __syncthreads();
  LAS float* X = (LAS float*)(lds) + rg * 4096 + lane;
  if (comp == 1) {
#pragma unroll
    for (int db = 0; db < 8; ++db)
#pragma unroll
      for (int qb = 0; qb < 2; ++qb)
#pragma unroll
        for (int r = 0; r < 4; ++r) X[((db * 2 + qb) * 4 + r) * 64] = o[db][qb][r] * rl[qb] * lam;
  }
  __syncthreads();
  if (comp == 0) {
    float ss[2] = {0.f, 0.f};
#pragma unroll
    for (int db = 0; db < 8; ++db)
#pragma unroll
      for (int qb = 0; qb < 2; ++qb)
#pragma unroll
        for (int r = 0; r < 4; ++r) { const float v = o[db][qb][r] * rl[qb] - X[((db * 2 + qb) * 4 + r) * 64]; o[db][qb][r] = v; ss[qb] += v * v; }
#pragma unroll
    for (int qb = 0; qb < 2; ++qb) { float t = ss[qb]; t += __shfl_xor(t, 16); t += __shfl_xor(t, 32); ss[qb] = __builtin_amdgcn_rsqf(t * (1.0f / 128.0f) + EPS) * oscale; }
#pragma unroll
    for (int db = 0; db < 8; ++db) { const f32x4 gs = *(const f32x4*)(gsub + 16 * db + 4 * g);
#pragma unroll
      for (int qb = 0; qb < 2; ++qb) { const f32x4 v = o[db][qb] * gs * ss[qb]; u32x2 w; w.x = cvt_pk_bf16(v[0], v[1]); w.y = cvt_pk_bf16(v[2], v[3]);
        *(u32x2*)(Og + (size_t)(rg * 32 + 16 * qb + c16) * LDP + 16 * db + 4 * g) = w; } }
  }
  __syncthreads();
}
#undef PV16
#undef PACK16
#undef LSUM16
#undef ADDF16
#undef PKV16
}

#define XB_TMO      128
#define XB_XCNT(j)  (256  + 64 * (j))
#define XB_XSUB(j)  (1280 + 64 * (j))
#define XB_XGEN(j)  (2304 + 64 * (j))
#define XB_TOP      3328
#define XB_TOPGEN   3392
#define XCD_BAR_WORDS 3456
#define XB_SPIN_CAP (1u << 20)
__device__ __forceinline__ unsigned xb_ld(unsigned* p)              { return __hip_atomic_load(p, __ATOMIC_RELAXED, __HIP_MEMORY_SCOPE_AGENT); }
__device__ __forceinline__ unsigned xb_add(unsigned* p, unsigned v) { return __hip_atomic_fetch_add(p, v, __ATOMIC_RELAXED, __HIP_MEMORY_SCOPE_AGENT); }
__device__ __forceinline__ unsigned xb_xcc_id() { return (unsigned)__builtin_amdgcn_s_getreg((3 << 11) | 20) & 0xFu; }
#define XB_SPIN(cond, bar) do { unsigned _sp = 0; while (cond) { __builtin_amdgcn_s_sleep(1); \
    if ((++_sp & 255u) == 0u) { if (xb_ld(&(bar)[XB_TMO])) break; if (_sp > XB_SPIN_CAP) { atomicAdd(&(bar)[XB_TMO], 1u); break; } } } } while (0)
struct XcdBarrier { unsigned* bar; unsigned x; volatile LAS unsigned* st; };
__device__ __forceinline__ XcdBarrier xcd_barrier_post(unsigned* bar, volatile LAS unsigned* st) {
    XcdBarrier b; b.bar = bar; b.x = xb_xcc_id(); b.st = st;
    if (threadIdx.x == 0) (void)xb_add(&bar[XB_XCNT(b.x)], 1u);
    return b;
}
__device__ __forceinline__ void xcd_barrier_complete(unsigned* bar, unsigned x, unsigned& nloc, unsigned& nx) {
    const unsigned G = gridDim.x * gridDim.y * gridDim.z;
    unsigned sum, cnt, mine, sp = 0u;
    for (;;) {
        sum = 0u; cnt = 0u; mine = 0u;
#pragma unroll
        for (unsigned j = 0; j < 16; ++j) { const unsigned c = xb_ld(&bar[XB_XCNT(j)]); sum += c; cnt += (c > 0u) ? 1u : 0u; mine = (j == x) ? c : mine; }
        if (sum == G) break;
        __builtin_amdgcn_s_sleep(1);
        if ((++sp & 255u) == 0u) { if (xb_ld(&bar[XB_TMO])) break; if (sp > XB_SPIN_CAP) { atomicAdd(&bar[XB_TMO], 1u); break; } }
    }
    nloc = mine > 0u ? mine : 1u; nx = cnt > 0u ? cnt : 1u;
}
__device__ __forceinline__ void xcd_barrier(const XcdBarrier& b) {
    asm volatile("s_waitcnt vmcnt(0)" ::: "memory");
    __syncthreads();
    if (threadIdx.x == 0) {
        unsigned* bar = b.bar;
        __builtin_amdgcn_s_waitcnt(0);
        unsigned nloc = b.st[0], nx = b.st[1];
        if (nloc == 0u) { xcd_barrier_complete(bar, b.x, nloc, nx); b.st[0] = nloc; b.st[1] = nx; }
        const unsigned old = xb_add(&bar[XB_XSUB(b.x)], 1u);
        const unsigned gen = old / nloc;
        if (old + 1u == (gen + 1u) * nloc) {
            __builtin_amdgcn_fence(__ATOMIC_RELEASE, "agent");
            asm volatile("s_waitcnt vmcnt(0)" ::: "memory");
            const unsigned og = xb_add(&bar[XB_TOP], 1u);
            const unsigned tg = og / nx;
            if (og + 1u == (tg + 1u) * nx) xb_add(&bar[XB_TOPGEN], 1u);
            else XB_SPIN(xb_ld(&bar[XB_TOPGEN]) == tg, bar);
            __builtin_amdgcn_fence(__ATOMIC_ACQUIRE, "agent");
            xb_add(&bar[XB_XGEN(b.x)], 1u);
            asm volatile("s_waitcnt vmcnt(0)" ::: "memory");
        } else {
            XB_SPIN(xb_ld(&bar[XB_XGEN(b.x)]) == gen, bar);
            __builtin_amdgcn_fence(__ATOMIC_ACQUIRE, "agent");
            asm volatile("s_waitcnt vmcnt(0)" ::: "memory");
        }
    }
    __syncthreads();
}

#define LDS_WAIT() asm volatile("s_waitcnt lgkmcnt(0)" ::: "memory")
__device__ __forceinline__ float wave_sum(float v) {
#pragma unroll
    for (int o = 1; o < 64; o <<= 1) v += __shfl_xor(v, o);
    return v;
}
typedef __bf16 bf16n2_t __attribute__((ext_vector_type(2)));
__device__ __forceinline__ unsigned cvt2_bf16_native(float lo, float hi) { const bf16n2_t v = {(__bf16)lo, (__bf16)hi}; return __builtin_bit_cast(unsigned, v); }
__device__ __forceinline__ void pool_fold_item(const float* Wp, const float* ps, const float* Wol, bf16_t* WT, int g_, int nb, int lane) {
    const int c16 = lane & 15, kg = lane >> 4, n0 = nb * 64;
    bf16x8 bfr[4][8];
#pragma unroll
    for (int ks = 0; ks < 8; ++ks) { const int d0 = ks * 32 + 8 * kg; const f32x4 p0 = *(const f32x4*)(ps + d0), p1 = *(const f32x4*)(ps + d0 + 4);
#pragma unroll
        for (int nh = 0; nh < 2; ++nh) { float t[2][8];
#pragma unroll
            for (int nq = 0; nq < 2; ++nq) { const float* bp = Wol + (size_t)d0 * 2048 + n0 + 16 * (2 * nh + nq) + c16;
#pragma unroll
                for (int j = 0; j < 8; ++j) t[nq][j] = bp[j * 2048]; }
            __builtin_amdgcn_sched_barrier(0);
#pragma unroll
            for (int nq = 0; nq < 2; ++nq) { u32x4 w;
                w.x = cvt2_bf16_native(t[nq][0] * p0[0], t[nq][1] * p0[1]); w.y = cvt2_bf16_native(t[nq][2] * p0[2], t[nq][3] * p0[3]);
                w.z = cvt2_bf16_native(t[nq][4] * p1[0], t[nq][5] * p1[1]); w.w = cvt2_bf16_native(t[nq][6] * p1[2], t[nq][7] * p1[3]); bfr[2 * nh + nq][ks] = __builtin_bit_cast(bf16x8, w); }
            __builtin_amdgcn_sched_barrier(0); } }
    for (int cb = 0; cb < 16; ++cb) { f32x4 acc[4];
#pragma unroll
        for (int nbk = 0; nbk < 4; ++nbk) acc[nbk] = (f32x4){0.f, 0.f, 0.f, 0.f};
#pragma unroll
        for (int kh = 0; kh < 2; ++kh) { f32x4 av[4][2];
#pragma unroll
            for (int k4 = 0; k4 < 4; ++k4) { const float* ap = Wp + (size_t)(cb * 16 + c16) * 256 + (kh * 4 + k4) * 32 + 8 * kg; av[k4][0] = *(const f32x4*)ap; av[k4][1] = *(const f32x4*)(ap + 4); }
            __builtin_amdgcn_sched_barrier(0);
#pragma unroll
            for (int k4 = 0; k4 < 4; ++k4) { const f32x4 a0 = av[k4][0], a1 = av[k4][1];
                u32x4 w; w.x = cvt2_bf16_native(a0[0], a0[1]); w.y = cvt2_bf16_native(a0[2], a0[3]); w.z = cvt2_bf16_native(a1[0], a1[1]); w.w = cvt2_bf16_native(a1[2], a1[3]); const bf16x8 af = __builtin_bit_cast(bf16x8, w);
#pragma unroll
                for (int nbk = 0; nbk < 4; ++nbk) acc[nbk] = __builtin_amdgcn_mfma_f32_16x16x32_bf16(af, bfr[nbk][kh * 4 + k4], acc[nbk], 0, 0, 0); }
            __builtin_amdgcn_sched_barrier(0); }
#pragma unroll
        for (int nbk = 0; nbk < 4; ++nbk) { u32x2 o; o.x = cvt2_bf16_native(acc[nbk][0], acc[nbk][1]); o.y = cvt2_bf16_native(acc[nbk][2], acc[nbk][3]);
            *(u32x2*)(WT + (size_t)(n0 + 16 * nbk + c16) * 2048 + 1024 + g_ * 256 + cb * 16 + 4 * kg) = o; }
        __builtin_amdgcn_sched_barrier(0); }
}
__device__ __forceinline__ unsigned cvt_pk_f16_rne(float a, float b) { const h2_t v = {(_Float16)a, (_Float16)b}; return __builtin_bit_cast(unsigned, v); }
template <bool F16 = false>
__device__ __forceinline__ void tr_item(const float* W, int K, int N, bf16_t* WT, const float* rs, const float* cs, int perm_limit, LAS float* scr, int item, int lane) {
    const int nblk = N / 32, kb = item / nblk, nb = item % nblk, k0 = 64 * kb, n0 = 32 * nb;
    const float csv = cs ? cs[n0 + (lane & 31)] : 1.f;
    float wv[32], rv[32];
#pragma unroll
    for (int i = 0; i < 32; ++i) { const int kk = 2 * i + (lane >> 5); wv[i] = W[(size_t)(k0 + kk) * N + n0 + (lane & 31)]; rv[i] = rs ? rs[k0 + kk] : 1.f; }
#pragma unroll
    for (int i = 0; i < 32; ++i) { const int kk = 2 * i + (lane >> 5); scr[kk * 33 + (lane & 31)] = wv[i] * rv[i] * csv; }
    LDS_WAIT(); asm volatile("" ::: "memory");
    int d0 = n0; if (n0 < perm_limit) { const int tile = n0 >> 8, lb = (n0 >> 5) & 7; d0 = (tile << 8) + ((4 * (lb & 1) + (lb >> 1)) << 5); }
    if (perm_limit < 0) { const int isv = n0 >= D_FF, ch = n0 - (isv ? D_FF : 0); d0 = (ch >> 7) * 256 + isv * 128 + (ch & 127); }
    const int c = lane & 7;
#pragma unroll
    for (int j = 0; j < 4; ++j) { const int n = (lane >> 3) + 8 * j; const LAS float* s = scr + (8 * c) * 33 + n;
        u32x4 o;
        if constexpr (F16) { o.x = cvt_pk_f16_rne(s[0 * 33], s[1 * 33]); o.y = cvt_pk_f16_rne(s[2 * 33], s[3 * 33]); o.z = cvt_pk_f16_rne(s[4 * 33], s[5 * 33]); o.w = cvt_pk_f16_rne(s[6 * 33], s[7 * 33]); }
        else { o.x = cvt_pk_bf16(s[0 * 33], s[1 * 33]); o.y = cvt_pk_bf16(s[2 * 33], s[3 * 33]); o.z = cvt_pk_bf16(s[4 * 33], s[5 * 33]); o.w = cvt_pk_bf16(s[6 * 33], s[7 * 33]); }
        *(u32x4*)(WT + (size_t)(d0 + n) * K + k0 + 8 * c) = o; }
    LDS_WAIT(); asm volatile("" ::: "memory");
}
__device__ __forceinline__ void norm_row(const float* xrow, bf16_t* orow, float* crow_, int lane) {
    f32x4 v[8]; float s = 0.f;
#pragma unroll
    for (int j = 0; j < 4; ++j) { v[2 * j] = *(const f32x4*)(xrow + j * 512 + lane * 8); v[2 * j + 1] = *(const f32x4*)(xrow + j * 512 + lane * 8 + 4); s += pg8::sumsq4(v[2 * j]) + pg8::sumsq4(v[2 * j + 1]); }
    const float rstd = __builtin_amdgcn_rsqf(wave_sum(s) * (1.0f / D_MODEL) + EPS);
#pragma unroll
    for (int j = 0; j < 4; ++j) { if (crow_) { *(f32x4*)(crow_ + j * 512 + lane * 8) = v[2 * j]; *(f32x4*)(crow_ + j * 512 + lane * 8 + 4) = v[2 * j + 1]; }
        *(u32x4*)(orow + j * 512 + lane * 8) = pg8::pack8(v[2 * j] * rstd, v[2 * j + 1] * rstd); }
}

__device__ __forceinline__ void raw_row(const float* xrow, bf16_t* orow, rss_t* ssq, int lane) {
    f32x4 v[8]; float s = 0.f;
#pragma unroll
    for (int j = 0; j < 4; ++j) { v[2 * j] = *(const f32x4*)(xrow + j * 512 + lane * 8); v[2 * j + 1] = *(const f32x4*)(xrow + j * 512 + lane * 8 + 4); s += pg8::sumsq4(v[2 * j]) + pg8::sumsq4(v[2 * j + 1]); }
    s = wave_sum(s); if (lane == 0) *ssq = ss_fix(s);
#pragma unroll
    for (int j = 0; j < 4; ++j) *(u32x4*)(orow + j * 512 + lane * 8) = pg8::pack8(v[2 * j], v[2 * j + 1]);
}

template <int WIN> __device__ __forceinline__ void pool_item(const bf16_t* U, bf16_t* ZP, int r0, int ch, bool big) {
    constexpr int NR = 3 + 2 * WIN, SM = WIN / 2;
    const int pos0 = tok_pos(r0), S = tok_seqlen(r0);
    u32x4 v[NR];
#pragma unroll
    for (int k = 0; k < NR; ++k) { const int p = pos0 - WIN + k; v[k] = (p >= 0 && p < S) ? *(const u32x4*)(U + (size_t)(r0 - WIN + k) * 1024 + ch) : (u32x4){0u, 0u, 0u, 0u}; }
    float sb[8], ss[8];
#pragma unroll
    for (int j = 0; j < 8; ++j) { sb[j] = 0.f; ss[j] = 0.f; }
#define POOL_ACC(dst, k, sgn) do { const u32x4 w_ = v[k]; dst[0] += sgn bflo(w_.x); dst[1] += sgn bfhi(w_.x); dst[2] += sgn bflo(w_.y); dst[3] += sgn bfhi(w_.y); dst[4] += sgn bflo(w_.z); dst[5] += sgn bfhi(w_.z); dst[6] += sgn bflo(w_.w); dst[7] += sgn bfhi(w_.w); } while (0)
#pragma unroll
    for (int k = 0; k < 2 * WIN; ++k) { POOL_ACC(sb, k, +); if (k >= WIN - SM && k < WIN + SM) POOL_ACC(ss, k, +); }
#pragma unroll
    for (int i = 0; i < 4; ++i) {
        if (i > 0) { POOL_ACC(sb, i + 2 * WIN - 1, +); POOL_ACC(sb, i - 1, -); POOL_ACC(ss, i + WIN + SM - 1, +); POOL_ACC(ss, i + WIN - SM - 1, -); }
        const int pos = pos0 + i, w2 = big ? WIN : SM; const int lo_ = pos - w2 < 0 ? 0 : pos - w2, hi_ = pos + w2 > S ? S : pos + w2; const float inv = 1.0f / (float)(hi_ - lo_);
        const u32x4 c = v[WIN + i]; float s[8];
#pragma unroll
        for (int j = 0; j < 8; ++j) s[j] = (big ? sb[j] : ss[j]) * inv;
        u32x4 o; o.x = cvt_pk_bf16(s[0] - bflo(c.x), s[1] - bfhi(c.x)); o.y = cvt_pk_bf16(s[2] - bflo(c.y), s[3] - bfhi(c.y)); o.z = cvt_pk_bf16(s[4] - bflo(c.z), s[5] - bfhi(c.z)); o.w = cvt_pk_bf16(s[6] - bflo(c.w), s[7] - bfhi(c.w));
        *(u32x4*)(ZP + (size_t)(r0 + i) * 1024 + ch) = o; }
#undef POOL_ACC
}

struct Args { const float* in[28]; float* out; unsigned char* ws; int ph_lo, ph_hi; };

__global__ void __launch_bounds__(NWAVES * 64, 2) trunk_fwd(Args args) {
    extern __shared__ __attribute__((aligned(16))) unsigned char lds_raw[];
    LAS unsigned char* lds = (LAS unsigned char*)lds_raw;
    volatile LAS unsigned* MISC = (volatile LAS unsigned*)(lds + MISC_OFF);
    for (int u = threadIdx.x; u < (LDS_BYTES - LDSCTL_OFF) / 4; u += NWAVES * 64) ((LAS unsigned*)(lds + LDSCTL_OFF))[u] = 0u;
    __syncthreads();
    const int lo = args.ph_lo, hi = args.ph_hi;
    XcdBarrier bar; bar.bar = (unsigned*)(args.ws + WS_CTL) + CW_BAR; bar.x = 0; bar.st = nullptr;
    if (hi - lo > 1) bar = xcd_barrier_post((unsigned*)(args.ws + WS_CTL) + CW_BAR, MISC + 8);
#define IN(k) ({ int lo_ = lo, hi_ = hi; asm volatile("" : "+s"(lo_), "+s"(hi_)); lo_ <= (k) && (k) < hi_; })
#define SEAM(k) do { if (IN(k) && IN((k) + 1)) { XcdBarrier b2_ = bar; asm volatile("" : "+s"(b2_.bar), "+s"(b2_.x)); xcd_barrier(b2_); } } while (0)
#define PHASE_BEGIN() int tid = threadIdx.x; asm volatile("" : "+v"(tid)); int zo = 0; asm volatile("" : "+s"(zo)); \
    const int lane = tid & 63, wave = __builtin_amdgcn_readfirstlane(tid >> 6); const int G = gridDim.x, bx = blockIdx.x; \
    const int vcu = (G % 8 == 0) ? (bx % 8) * (G / 8) + bx / 8 : bx; const int gw = vcu * NWAVES + wave, NGW = G * NWAVES; \
    unsigned char* ws = args.ws + zo; float* X = args.out + zo; (void)lane; (void)wave; (void)gw; (void)NGW; (void)ws; (void)X; (void)vcu; (void)tid
#define INP(i) (args.in[(i) + zo])
#define WSP(T, off) ((T*)(ws + (off)))

#define CG_UP 1u
#define CG_DOWN 2u
#define CG_IN 4u
#define CG_CKV 8u
#define CG_OUT 16u
#define CG_CQ 32u
#define CG_CO 64u
#define CONV_ITEMS(L_, MASK_) do { const int l_ = (L_); constexpr unsigned m_ = (MASK_); __syncthreads(); LAS float* scr = (LAS float*)(lds + wave * 16384);                                         \
    constexpr int I_IN = 32 * 128, I_OUT = 16 * 64, I_CQ = 32 * 64, I_CKV = 32 * 128, I_CO = 32 * 64, I_UP = 32 * (UP_W / 32), I_DOWN = (D_FF / 64) * 64, I_P = 4 * 32;                                 \
    constexpr int n_ = ((m_ & CG_UP) ? I_UP : 0) + ((m_ & CG_DOWN) ? I_DOWN : 0) + ((m_ & CG_IN) ? I_IN : 0) + ((m_ & CG_CKV) ? I_CKV : 0) + ((m_ & CG_OUT) ? I_OUT + I_P : 0) + ((m_ & CG_CQ) ? I_CQ : 0) + ((m_ & CG_CO) ? I_CO : 0); \
    for (int it = gw; it < n_; it += NGW) { int r = it;                                                                                                                                            \
        if constexpr ((m_ & CG_UP) != 0) { if (r < I_UP) { tr_item(INP(24) + (size_t)l_ * 2048 * UP_W, 2048, UP_W, WSP(bf16_t, WS_WUP), INP(23) + l_ * 2048, nullptr, -1, scr, r, lane); continue; } r -= I_UP; } \
        if constexpr ((m_ & CG_DOWN) != 0) { if (r < I_DOWN) { tr_item<true>(INP(27) + (size_t)l_ * D_FF * 2048, D_FF, 2048, WSP(bf16_t, WS_WDOWN), nullptr, nullptr, 0, scr, r, lane); continue; } r -= I_DOWN; } \
        if constexpr ((m_ & CG_IN) != 0) { if (r < I_IN) { tr_item(INP(5) + (size_t)l_ * 2048 * 4096, 2048, 4096, WSP(bf16_t, WS_WIN), INP(4) + l_ * 2048, nullptr, 2048, scr, r, lane); continue; } r -= I_IN; } \
        if constexpr ((m_ & CG_CKV) != 0) { if (r < I_CKV) { tr_item(INP(19) + (size_t)l_ * 2048 * 4096, 2048, 4096, WSP(bf16_t, WS_WCKV), INP(17) + l_ * 2048, nullptr, 0, scr, r, lane); continue; } r -= I_CKV; } \
        if constexpr ((m_ & CG_OUT) != 0) { if (r < I_OUT) { tr_item(INP(15) + (size_t)l_ * 2048 * 2048, 2048, 2048, WSP(bf16_t, WS_WOUT), nullptr, nullptr, 0, scr, r, lane); continue; } r -= I_OUT;   \
            if (r < I_P) { const int g = r >> 5; pool_fold_item(INP(13) + (size_t)l_ * 4 * 65536 + (size_t)g * 65536, INP(14) + l_ * 1024 + g * 256, INP(15) + (size_t)l_ * 2048 * 2048 + (size_t)(1024 + g * 256) * 2048, WSP(bf16_t, WS_WOUT), g, r & 31, lane); continue; } r -= I_P; } \
        if constexpr ((m_ & CG_CQ) != 0) { if (r < I_CQ) { tr_item(INP(18) + (size_t)l_ * 2048 * 2048, 2048, 2048, WSP(bf16_t, WS_WCQ), INP(16) + l_ * 2048, nullptr, 0, scr, r, lane); continue; } r -= I_CQ; } \
        if constexpr ((m_ & CG_CO) != 0) { if (r < I_CO) { tr_item(INP(22) + (size_t)l_ * 2048 * 2048, 2048, 2048, WSP(bf16_t, WS_WCO), nullptr, nullptr, 0, scr, r, lane); continue; } r -= I_CO; } }   \
    if constexpr ((m_ & CG_UP) != 0) { const float* cw = INP(25) + (size_t)l_ * 3 * UP_W; const float* cb = INP(26) + (size_t)l_ * UP_W; u32x4* cwt = WSP(u32x4, WS_CWT);        \
        for (int it = vcu * 512 + tid; it < D_FF; it += G * 512) { const int p = it >> 1, isv = it & 1, ch = 2 * p + isv * D_FF; u32x4 w;                                                          \
            w.x = cvt_pk_f16_rne(cw[ch], cw[ch + 1]); w.y = cvt_pk_f16_rne(cw[UP_W + ch], cw[UP_W + ch + 1]); w.z = cvt_pk_f16_rne(cw[2 * UP_W + ch], cw[2 * UP_W + ch + 1]); w.w = cvt_pk_f16_rne(cb[ch], cb[ch + 1]); cwt[it] = w; } } } while (0)
    for (int l = 0; l < DEPTH; ++l) {
        const int pb = l * PH_PER_LAYER;
        if (PH_EN(0) && IN(pb + 0)) {
            PHASE_BEGIN();
            if (l == 0) CONV_ITEMS(0, CG_IN | CG_CKV);
            bf16_t* HB = WSP(bf16_t, WS_HB);
            if (l == 0) {
                unsigned* csT = WSP(unsigned, WS_COS);
                for (int e = (vcu * 512 + tid); e < 8192 * 32; e += G * 512) { const int pos = e >> 5, i = e & 31;
                    double inv = 1.0; const double b = 0.74989420933245582730;
                    for (int k = 0; k < i; ++k) inv *= b;
                    double rev = (double)pos * inv * 0.15915494309189533577; rev -= __builtin_floor(rev);
                    const float fr_ = (float)rev;
                    const _Float16 hc = (_Float16)__builtin_amdgcn_cosf(fr_), hs = (_Float16)__builtin_amdgcn_sinf(fr_);
                    csT[e] = (unsigned)__builtin_bit_cast(unsigned short, hc) | ((unsigned)__builtin_bit_cast(unsigned short, hs) << 16); }
                bf16_t* MB = WSP(bf16_t, WS_MB);
                for (int m = gw; m < NMEMROWS; m += NGW) { const float* src = m < 1024 ? INP(2) + (size_t)m * 2048 : INP(3) + (size_t)(m - 1024) * 2048; norm_row(src, MB + (size_t)m * 2048, nullptr, lane); }
                rss_t* rss0 = WSP(rss_t, WS_ROWSS);
                for (int m = gw; m < NTOK; m += NGW) { const float* src = m < NTOK_P ? INP(0) + (size_t)m * 2048 : INP(1) + (size_t)(m - NTOK_P) * 2048; raw_row(src, HB + (size_t)m * 2048, rss0 + m, lane); }
            }
        }
        if (l == 0) SEAM(pb + 0);
        if (PH_EN(1) && IN(pb + 1)) {
            PHASE_BEGIN(); pg8::StaticOrder SO;
            if (PH_EN(17)) { pg8::ProbSimple P; P.K = 2048; P.lda = 2048; P.ldb = 2048; P.tsplit = 1 << 30; P.adelta = 0; P.A = (const char*)WSP(bf16_t, WS_HB); P.B = (const char*)WSP(bf16_t, WS_WIN);
              SO.init(NTOK / 256, IN_W / 256, G, bx, 1);
              pg8::EpiIn E{WSP(bf16_t, R_Q), (size_t)NTOK * 1024, WSP(const unsigned, WS_COS), INP(6) + l * 64, INP(7) + l * 64, WSP(const rss_t, WS_ROWSS) + (size_t)(l * 3 + 0) * NTOK};
              pg8::gemm_phase<pg8::ProbSimple, pg8::EpiIn, true, true>(lds, P, SO, E); }
            if (PH_EN(16)) { pg8::ProbSimple P; P.K = 2048; P.lda = 2048; P.ldb = 2048; P.tsplit = 1 << 30; P.adelta = 0; P.A = (const char*)WSP(bf16_t, WS_MB); P.B = (const char*)WSP(bf16_t, WS_WCKV);
              SO.init(NMEMROWS / 256, 4096 / 256, G, bx);
              pg8::EpiKV E{WSP(float, WS_KRAW), WSP(bf16_t, WS_VT)};
              pg8::gemm_phase<pg8::ProbSimple, pg8::EpiKV, true, true>(lds, P, SO, E); }
            if (G == 256) { if (bx >= 192) { const int gw = (bx - 192) * NWAVES + wave, NGW = 64 * NWAVES; if (l == 0) CONV_ITEMS(0, CG_OUT | CG_CO | CG_CQ); else CONV_ITEMS(l, CG_DOWN); } }
            else { if (l == 0) CONV_ITEMS(0, CG_OUT | CG_CO | CG_CQ); else CONV_ITEMS(l, CG_DOWN); }
        }
        SEAM(pb + 1);
        if (PH_EN(2) && IN(pb + 2)) {
            if (PH_EN(18)) {
              PHASE_BEGIN();
              const float lam_init = 0.8f - 0.6f * __expf(-0.3f * (float)l);
              float s1 = 0.f, s2 = 0.f; const float* q1 = INP(8) + l * 64; const float* k1 = INP(9) + l * 64; const float* q2 = INP(10) + l * 64; const float* k2 = INP(11) + l * 64;
              for (int i = 0; i < 64; ++i) { s1 += q1[i] * k1[i]; s2 += q2[i] * k2[i]; }
              const float lam = __expf(s1) - __expf(s2) + lam_init;
              const float* gsub = INP(12) + l * 128;
              bf16_t* Qb = WSP(bf16_t, R_Q); const bf16_t* Kb = WSP(const bf16_t, R_K); const bf16_t* Vb = WSP(const bf16_t, R_V);
              __syncthreads();
              { const int NX = (G % 8 == 0) ? 8 : 1, xcd = bx % NX, j = bx / NX, nb = G / NX, npr = 2048 / NX;
                  for (int kk = j; kk < 2 * npr; kk += nb) { int pair, qt, S; size_t t0;
                      if (kk < npr) { pair = xcd + NX * (kk >> 6); qt = kk & 63; S = S_P; t0 = (size_t)(pair >> 3) * S_P; }
                      else { const int k2_ = kk - npr; pair = xcd + NX * (k2_ >> 5); qt = k2_ & 31; S = S_S; t0 = (size_t)NTOK_P + (size_t)(pair >> 3) * S_S; }
                      const int h = pair & 7; bf16_t* qp = Qb + (t0 + (size_t)qt * 128) * 1024 + h * 128;
                      ATTN_NS::attn_unit(qp, Kb + t0 * 1024 + h * 128, Vb + t0 * 1024 + h * 128, qp, S, lam, gsub, 1.f - lam_init, lds, kk < npr && ((kk / nb) & 1)); }
              }
            }
            if (PH_EN(14)) { PHASE_BEGIN(); const bf16_t* U = WSP(const bf16_t, R_U); bf16_t* ZP = (bf16_t*)X;
#ifdef PROBE_DOUBLE_PASSES
              int nrq = 2; asm volatile("" : "+s"(nrq)); for (int rq_ = 0; rq_ < nrq; ++rq_)
#endif
              for (int it = gw; it < (NTOK / 4) * 2; it += NGW) { const int r0 = (it >> 1) * 4, half = it & 1, ch = half * 512 + lane * 8;
                  if (half == 0) pool_item<2>(U, ZP, r0, ch, lane >= 32); else pool_item<8>(U, ZP, r0, ch, lane >= 32); } }
            if (PH_EN(15)) { PHASE_BEGIN(); const float* gcq = INP(20) + l * 512; const float* gck = INP(21) + l * 512; const float* KRAW = WSP(const float, WS_KRAW); bf16_t* KC = WSP(bf16_t, WS_KC);
              for (int it = gw; it < NMEMROWS * 4; it += NGW) { const int row = it >> 2, h = it & 3; const float* kr = KRAW + (size_t)row * 2048 + h * 512 + lane * 8;
                  const f32x4 a = *(const f32x4*)kr, b = *(const f32x4*)(kr + 4); const float ss = wave_sum(pg8::sumsq4(a) + pg8::sumsq4(b));
                  const float rk = __builtin_amdgcn_rsqf(ss * (1.0f / 512.0f) + EPS);
                  const f32x4 ga = *(const f32x4*)(gcq + lane * 8) * *(const f32x4*)(gck + lane * 8), gb = *(const f32x4*)(gcq + lane * 8 + 4) * *(const f32x4*)(gck + lane * 8 + 4);
                  *(u32x4*)(KC + (size_t)row * 2048 + h * 512 + lane * 8) = pg8::pack8(a * rk * ga, b * rk * gb); } }
            { PHASE_BEGIN(); if (l == 0) CONV_ITEMS(0, CG_UP); }
        }
        SEAM(pb + 2);
        if (PH_EN(4) && IN(pb + 4)) {
            PHASE_BEGIN(); pg8::StaticOrder SO;
            pg8::ProbSimple P; P.K = 2048; P.lda = 1024; P.ldb = 2048; P.tsplit = 16; P.adelta = (long long)((const char*)X - (const char*)(ws + R_Q)) - 16ll * 128; P.A = (const char*)(ws + R_Q);   P.B = (const char*)WSP(bf16_t, WS_WOUT);
            SO.init(NTOK / 256, 8, G, bx, 1);
            pg8::EpiRes E{WSP(bf16_t, WS_HB), WSP(rss_t, WS_ROWSS) + (size_t)(l * 3 + 1) * NTOK, nullptr};
            pg8::gemm_phase<pg8::ProbSimple, pg8::EpiRes, true, true>(lds, P, SO, E);
            if (PH_EN(3)) {

              pg8::ProbVW P2; P2.K = 512; P2.lda = 2048; P2.ldb = 2048; P2.tsplit = 1 << 30; P2.adelta = 0; P2.A = (const char*)WSP(bf16_t, WS_WCO); P2.B = (const char*)WSP(bf16_t, WS_VT);
              SO.init(8, 48, G, bx);
              pg8::EpiBf<5> E2{WSP(bf16_t, R_VW), 1024, nullptr, nullptr, nullptr};
              pg8::gemm_phase<pg8::ProbVW, pg8::EpiBf<5>, true, true>(lds, P2, SO, E2); }
            if (l == 0) CONV_ITEMS(0, CG_DOWN);
            if (l + 1 < DEPTH) CONV_ITEMS(l + 1, CG_IN | CG_CKV);
        }
        SEAM(pb + 4);
        if (PH_EN(5) && IN(pb + 5)) {
            PHASE_BEGIN(); pg8::StaticOrder SO;
            pg8::ProbSimple P; P.K = 2048; P.lda = 2048; P.ldb = 2048; P.tsplit = 1 << 30; P.adelta = 0; P.A = (const char*)WSP(bf16_t, WS_HB); P.B = (const char*)WSP(bf16_t, WS_WCQ);
            SO.init(NTOK / 256, 8, G, bx, 0);
            pg8::EpiBf<1> E{WSP(bf16_t, R_QC), 2048, WSP(float, WS_QSS), (float*)(WSP(rss_t, WS_ROWSS) + (size_t)(l * 3 + 1) * NTOK), nullptr};
            pg8::gemm_phase<pg8::ProbSimple, pg8::EpiBf<1>, true, true>(lds, P, SO, E);
            if (l + 1 < DEPTH) CONV_ITEMS(l + 1, CG_OUT | CG_CO);
        }
        SEAM(pb + 5);
        if (PH_EN(6) && IN(pb + 6)) {
            PHASE_BEGIN(); pg8::StaticOrder SO;
            pg8::ProbScores P; P.K = 512; P.lda = 2048; P.ldb = 2048; P.tsplit = 1 << 30; P.adelta = 0; P.A = (const char*)(ws + R_QC); P.B = (const char*)WSP(bf16_t, WS_KC);
            SO.init(NTOK / 256, 4, G, bx, 1);
            pg8::EpiBf<2> E{WSP(bf16_t, R_P), 1024, WSP(float, WS_QSS), nullptr, (LAS float*)(lds + XCH_OFF)};
            pg8::gemm_phase<pg8::ProbScores, pg8::EpiBf<2>, true, true>(lds, P, SO, E);
            if (l + 1 < DEPTH) CONV_ITEMS(l + 1, CG_CQ);
        }
        SEAM(pb + 6);
        if (PH_EN(8) && IN(pb + 7)) {
            PHASE_BEGIN(); pg8::StaticOrder SO;
            pg8::ProbFin P; P.K = 1024; P.lda = 1024; P.ldb = 1024; P.tsplit = 1 << 30; P.adelta = 0; P.A = (const char*)(ws + R_P); P.B = (const char*)WSP(bf16_t, R_VW);
            SO.init(NTOK / 256, 8, G, bx, 0);
            pg8::EpiRes E{WSP(bf16_t, WS_HB), WSP(rss_t, WS_ROWSS) + (size_t)(l * 3 + 2) * NTOK, nullptr};
            pg8::gemm_phase<pg8::ProbFin, pg8::EpiRes, true, true>(lds, P, SO, E);
        }
        SEAM(pb + 7);
        const bool whole = (l + 1 < DEPTH); const int nch = whole ? 1 : N_FFN_CHUNKS;
        for (int c = 0; c < nch; ++c) {
            const int pc = pb + 8 + 2 * c; const size_t r0 = (size_t)c * FFN_CHUNK; const int MT = whole ? NTOK / 256 : FFN_MT;
            if (PH_EN(11) && IN(pc)) {
                PHASE_BEGIN(); pg8::StaticOrder SO;
                pg8::ProbUp P; P.K = 2048; P.lda = 2048; P.ldb = 2048; P.tsplit = 1 << 30; P.adelta = 0; P.A = (const char*)(WSP(bf16_t, WS_HB) + r0 * 2048); P.B = (const char*)WSP(bf16_t, WS_WUP); P.chunk = c;
                SO.init(MT, D_FF / 128, G, bx, 1);
                bf16_t* G2p = (bf16_t*)((unsigned char*)X - (size_t)FFN_GSPLIT_ROW * D_FF * 2); bf16_t* EBp = whole ? (bf16_t*)((unsigned char*)X + FFN_EB_OUT_OFF) : WSP(bf16_t, R_EB);
                pg8::EpiGlu E{WSP(bf16_t, R_G), WSP(const rss_t, WS_ROWSS) + (size_t)(l * 3 + 2) * NTOK + r0, WSP(const u32x4, WS_CWT), c, (LAS float*)(lds + GLX_OFF), EBp, G2p, whole ? FFN_GSPLIT_ROW / 256 : (1 << 30)};
                pg8::gemm_phase<pg8::ProbUp, pg8::EpiGlu, true, true>(lds, P, SO, E);
            }
            SEAM(pc);
            if (PH_EN(13) && IN(pc + 1)) {
                PHASE_BEGIN(); pg8::StaticOrder SO;
                bf16_t* G2p = (bf16_t*)((unsigned char*)X - (size_t)FFN_GSPLIT_ROW * D_FF * 2);
                {
                  const bf16_t* EBp = whole ? (const bf16_t*)((unsigned char*)X + FFN_EB_OUT_OFF) : WSP(const bf16_t, R_EB); const u32x4* cwp = WSP(const u32x4, WS_CWT); bf16_t* Gp = WSP(bf16_t, R_G);
                  const int nb = whole ? 244 : (c == 0 ? 124 : 120), gsr = whole ? FFN_GSPLIT_ROW : (1 << 30);
                  for (int it = gw; it < nb * 11; it += NGW) { const int b = it / 11, cb = it - b * 11; int t;
                      if (whole ? b < 124 : c == 0) { const int sq = b / 31, bi = b - sq * 31; t = sq * S_P + 256 * (bi + 1); }
                      else { const int b2 = whole ? b - 124 : b, sq = b2 / 15, bi = b2 - sq * 15; t = (whole ? NTOK_P : 0) + sq * S_S + 256 * (bi + 1); }
                      pg8::ffn_fix_item(EBp, cwp, Gp, G2p, gsr, t, cb, lane); }
                  XcdBarrier b4_ = bar; asm volatile("" : "+s"(b4_.bar), "+s"(b4_.x)); xcd_barrier(b4_); }
                pg8::ProbDown P; P.K = D_FF; P.lda = D_FF; P.ldb = D_FF; P.tsplit = 1 << 30; P.adelta = 0; P.A = (const char*)(ws + R_G); P.A2 = (const char*)G2p; P.B = (const char*)WSP(bf16_t, WS_WDOWN); P.split = whole ? FFN_GSPLIT_ROW / 256 : (1 << 30);
                SO.init(MT, 8, G, bx, 0);
                pg8::EpiRes E{WSP(bf16_t, WS_HB) + r0 * 2048, (l + 1 < DEPTH) ? WSP(rss_t, WS_ROWSS) + (size_t)((l + 1) * 3 + 0) * NTOK + r0 : nullptr, (l + 1 < DEPTH) ? nullptr : X + r0 * 2048};
                pg8::gemm_phase<pg8::ProbDown, pg8::EpiRes, true, true>(lds, P, SO, E);
                if (c == nch - 1 && l + 1 < DEPTH) CONV_ITEMS(l + 1, CG_UP);
            }
            SEAM(pc + 1);
        }
    }
#undef IN
#undef SEAM
#undef PHASE_BEGIN
#undef INP
#undef WSP
}


#ifdef SELFCHECK
constexpr int CHK_WORD = 1024;
__device__ __forceinline__ void chk_upd(unsigned* ctl, int idx, float got, float ref) { const float e = fabsf(got - ref) / (0.03f * fabsf(ref) + 0.03f); atomicMax(ctl + CHK_WORD + idx, __float_as_uint(e)); }
__device__ __forceinline__ int chk_token(int s) { const int tab[16] = {0, 1, 127, 128, 4095, 8191, 8192, 12345, 32767, 32768, 32769, 36863, 36864, 50000, 65534, 65535}; int t = 0;
#pragma unroll
    for (int i = 0; i < 16; ++i) t = (s & 15) == i ? tab[i] : t; return t; }
__global__ void __launch_bounds__(64) check_kernel(Args args, int after, int l) {
    const int s = blockIdx.x, lane = threadIdx.x; unsigned char* ws = args.ws; unsigned* ctl = (unsigned*)(ws + WS_CTL);
    const int tok = chk_token(s); float* X = args.out;
    const float* xin = tok < NTOK_P ? args.in[0] + (size_t)tok * 2048 : args.in[1] + (size_t)(tok - NTOK_P) * 2048;
    if (after == 1) {
        if (l == 0) {
            float ssx = 0.f; for (int k = lane; k < 2048; k += 64) ssx += xin[k] * xin[k]; ssx = wave_sum(ssx); const float rstd = 1.0f / sqrtf(ssx / 2048.f + EPS);
            const int vec = (s * 7) & 31, isk = vec >> 4, hc = vec & 15;
            const float* w_in = args.in[5]; const float* g_mix = args.in[4]; const int col = isk * 1024 + hc * 64 + lane;
            float z = 0.f; for (int k = 0; k < 2048; ++k) z += xin[k] * rstd * g_mix[k] * w_in[(size_t)k * 4096 + col];
            const float ss = wave_sum(z * z); const float g = (isk ? args.in[7] : args.in[6])[lane]; const float zn = z / sqrtf(ss / 64.f + EPS) * g;
            const float other = __shfl_xor(zn, 32); const int i = lane & 31; const int pos = tok_pos(tok);
            const float ang = (float)pos * powf(10000.f, -(float)i / 32.f); const float c = cosf(ang), sn = sinf(ang);
            const float ref = lane < 32 ? zn * c - other * sn : zn * c + other * sn;
            const bf16_t* Q = (const bf16_t*)(ws + (isk ? R_K : R_Q)); const float got = bf2f(Q[(size_t)tok * 1024 + hc * 64 + lane]);
            const float gother = __shfl_xor(got, 32);
            (void)gother; chk_upd(ctl, 0, got, ref);
            { const unsigned tv = ((const unsigned*)(ws + WS_COS))[pos * 32 + i]; typedef _Float16 h2 __attribute__((ext_vector_type(2))); const h2 hv = __builtin_bit_cast(h2, tv);
              chk_upd(ctl, 1, (float)hv.x, c); chk_upd(ctl, 1, (float)hv.y, sn); }
        }
        { const bf16_t* Q = (const bf16_t*)(ws + R_Q); bf16_t* sv = (bf16_t*)(ws + WS_CHK) + s * 128; const int h = s & 7; sv[lane] = Q[(size_t)tok * 1024 + h * 128 + lane]; sv[lane + 64] = Q[(size_t)tok * 1024 + h * 128 + 64 + lane]; }
    }
    if (after == 2) {
        const int h = s & 7; const bf16_t* sv = (const bf16_t*)(ws + WS_CHK) + s * 128; const int S = tok_seqlen(tok); const size_t t0 = (size_t)tok - tok_pos(tok);
        const bf16_t* K = (const bf16_t*)(ws + R_K) + t0 * 1024 + h * 128; const bf16_t* V = (const bf16_t*)(ws + R_V) + t0 * 1024 + h * 128;
        const float lam_init = 0.8f - 0.6f * expf(-0.3f * (float)l); float s1 = 0.f, s2 = 0.f;
        for (int i = 0; i < 64; ++i) { s1 += (args.in[8] + l * 64)[i] * (args.in[9] + l * 64)[i]; s2 += (args.in[10] + l * 64)[i] * (args.in[11] + l * 64)[i]; }
        const float lam = expf(s1) - expf(s2) + lam_init;
        float o[2][2];
        for (int c = 0; c < 2; ++c) { float mx = -1e30f;
            for (int k = lane; k < S; k += 64) { float d = 0.f; for (int e = 0; e < 64; ++e) d += bf2f(sv[c * 64 + e]) * bf2f(K[(size_t)k * 1024 + c * 64 + e]); mx = fmaxf(mx, d); }
            for (int o_ = 1; o_ < 64; o_ <<= 1) mx = fmaxf(mx, __shfl_xor(mx, o_));
            float lsum = 0.f, a0 = 0.f, a1 = 0.f;
            for (int k = 0; k < S; ++k) { float d = 0.f; for (int e = 0; e < 64; ++e) d += bf2f(sv[c * 64 + e]) * bf2f(K[(size_t)k * 1024 + c * 64 + e]);
                const float p = exp2f(d - mx); lsum += p; a0 += p * bf2f(V[(size_t)k * 1024 + lane]); a1 += p * bf2f(V[(size_t)k * 1024 + 64 + lane]); }
            o[c][0] = a0 / lsum; o[c][1] = a1 / lsum; }
        const float v0 = o[0][0] - lam * o[1][0], v1 = o[0][1] - lam * o[1][1]; const float ss = wave_sum(v0 * v0 + v1 * v1); const float rn = 1.0f / sqrtf(ss / 128.f + EPS) * (1.f - lam_init);
        const float* gsub = args.in[12] + l * 128; const bf16_t* A = (const bf16_t*)(ws + R_Q) + (size_t)tok * 1024 + h * 128;
        chk_upd(ctl, 2, bf2f(A[lane]), v0 * rn * gsub[lane]); chk_upd(ctl, 2, bf2f(A[64 + lane]), v1 * rn * gsub[64 + lane]);
    }
    if (after == 4 && l == 0) {
        const bf16_t* A = (const bf16_t*)(ws + R_Q) + (size_t)tok * 1024; const bf16_t* Pp = (const bf16_t*)(ws + R_POUT) + (size_t)tok * 1024; const float* w_out = args.in[15];
        const int col = (s * 131 + lane * 17) & 2047; float z = xin[col];
        for (int k = 0; k < 1024; ++k) z += bf2f(A[k]) * w_out[(size_t)k * 2048 + col];
        for (int k = 0; k < 1024; ++k) z += bf2f(Pp[k]) * w_out[(size_t)(1024 + k) * 2048 + col];
        chk_upd(ctl, 3, X[(size_t)tok * 2048 + col], z);
    }
    if (after == 8 && tok < FFN_CHUNK) {
        const bf16_t* HB = (const bf16_t*)(ws + WS_HB); const float* w_up = args.in[24] + (size_t)l * 2048 * UP_W; const float* g_ffn = args.in[23] + l * 2048;
        const float* cw = args.in[25] + (size_t)l * 3 * UP_W; const float* cb = args.in[26] + (size_t)l * UP_W;
        const int j = (s * 977 + lane * 53) % D_FF; const int pos = tok_pos(tok), S = tok_seqlen(tok); float u2[2];
        for (int half = 0; half < 2; ++half) { const int col = half * D_FF + j; float acc = cb[col];
            for (int tap = 0; tap < 3; ++tap) { const int pp = pos + tap - 1; if (pp < 0 || pp >= S) continue; const bf16_t* hr = HB + (size_t)(tok + tap - 1) * 2048; float d = 0.f;
                for (int k = 0; k < 2048; ++k) d += bf2f(hr[k]) * g_ffn[k] * w_up[(size_t)k * UP_W + col];
                const float rxx = ss_rstd(((const rss_t*)(ws + WS_ROWSS))[(size_t)(l * 3 + 2) * NTOK + tok + tap - 1]); acc += d * rxx * cw[(size_t)tap * UP_W + col]; }
            u2[half] = acc; }
        const float x = u2[0]; const float ref = 0.5f * x * (1.f + tanhf(0.7978845608028654f * (x + 0.044715f * x * x * x))) * u2[1];
        chk_upd(ctl, 4, bf2f(((const bf16_t*)(ws + R_G))[(size_t)tok * D_FF + j]), ref);
    }
    if (false) {
        const bf16_t* Gr = (const bf16_t*)(ws + R_G) + (size_t)tok * D_FF; const float* w_down = args.in[27] + (size_t)l * D_FF * 2048; const float* svx = (const float*)(ws + WS_CHK + 65536) + (size_t)s * 2048;
        const int col = (s * 131 + lane * 17) & 2047; float z = svx[col]; for (int k = 0; k < D_FF; ++k) z += bf2f(Gr[k]) * w_down[(size_t)k * 2048 + col];
        chk_upd(ctl, 5, X[(size_t)tok * 2048 + col], z);
    }
}
__global__ void __launch_bounds__(256) report_kernel(Args args) {
    unsigned* ctl = (unsigned*)(args.ws + WS_CTL); float* out = args.out;
    for (size_t i = (size_t)blockIdx.x * 256 + threadIdx.x; i < (size_t)NTOK * 2048; i += (size_t)gridDim.x * 256) {
        float v = 0.f;
        if (i == 0) { int mask = 0; for (int b = 0; b < 6; ++b) if (__uint_as_float(ctl[CHK_WORD + b]) > 1.0f) mask |= 1 << b; v = (10.f + (float)mask) * 1000.f; }
        out[i] = v; }
}
#endif

extern "C" void kernel_launch(void* const* d_in, const int* in_sizes, int n_in, void* d_out, int out_size, void* d_ws, size_t ws_size, hipStream_t stream) {
    static int grid = 0;
    if (grid == 0) {
        if (n_in != 28 || out_size != NTOK * D_MODEL || ws_size < WS_END) { fprintf(stderr, "kernel_launch: unexpected shapes: n_in %d out %d ws %zu (need >= %zu)\n", n_in, out_size, ws_size, (size_t)WS_END); grid = -1; return; }
        int dev = 0, cus = 0, per_cu = 0;
        if (hipGetDevice(&dev) != hipSuccess || hipDeviceGetAttribute(&cus, hipDeviceAttributeMultiprocessorCount, dev) != hipSuccess) { grid = -1; return; }
        if (hipFuncSetAttribute((const void*)trunk_fwd, hipFuncAttributeMaxDynamicSharedMemorySize, LDS_BYTES) != hipSuccess) { fprintf(stderr, "kernel_launch: hipFuncSetAttribute failed\n"); grid = -1; return; }
        if (hipOccupancyMaxActiveBlocksPerMultiprocessor(&per_cu, (const void*)trunk_fwd, NWAVES * 64, LDS_BYTES) != hipSuccess || per_cu < 1)
            fprintf(stderr, "kernel_launch: occupancy query reports %d workgroups per CU\n", per_cu);
        (void)hipGetLastError();
        grid = cus;
    }
    if (grid < 0) return;
    (void)hipMemsetAsync((char*)d_ws + WS_CTL, 0, CTL_ZERO_BYTES, stream);
    Args a{};
    for (int i = 0; i < 28; ++i) a.in[i] = (const float*)d_in[i];
    a.out = (float*)d_out; a.ws = (unsigned char*)d_ws;
#if ML_PER_PHASE
    for (int p = 0; p < N_PHASES; ++p) { a.ph_lo = p; a.ph_hi = p + 1; hipLaunchKernelGGL(trunk_fwd, dim3(grid), dim3(NWAVES * 64), LDS_BYTES, stream, a);
#ifdef SELFCHECK
        { const int l = p / PH_PER_LAYER, q = p % PH_PER_LAYER; if (l == SELFCHECK_LAYER && (q == 1 || q == 2 || q == 8)) hipLaunchKernelGGL(check_kernel, dim3(64), dim3(64), 0, stream, a, q, l); }
#endif
    }
#ifdef SELFCHECK
    hipLaunchKernelGGL(report_kernel, dim3(2048), dim3(256), 0, stream, a);
#endif
#else
    a.ph_lo = 0; a.ph_hi = N_PHASES;
    hipLaunchKernelGGL(trunk_fwd, dim3(grid), dim3(NWAVES * 64), LDS_BYTES, stream, a);
#endif
    const hipError_t le = hipPeekAtLastError();
    if (le != hipSuccess) fprintf(stderr, "kernel_launch: launch failed: %s\n", hipGetErrorName(le));
}
```
